# Optimizing an MI355X kernel written in HIP

```python
import jax, jax.numpy as jnp
from jax import lax
import numpy as np


D_MODEL = 1024
BATCH = 16
SEQ = 2048
DEPTH = 1

CHUNK = 64
D_MIX = D_MODEL
D_POOL = D_MIX // 2
POOL_WINDOWS = (2, 4, 8, 16)
N_POOL_GROUPS = len(POOL_WINDOWS)
POOL_GROUP = D_POOL // N_POOL_GROUPS
D_SGU = D_MIX - D_POOL
SGU_HEADS = 4
SGU_HEAD_DIM = D_SGU // SGU_HEADS
SGU_BLOCK = 128
D_IN = D_POOL + 2 * D_SGU
PEER_HEADS = 8
N_KEYS = 128
N_EXPERTS = N_KEYS * N_KEYS
PEER_TOPK = 16
D_QUERY = 256
D_HALF = D_QUERY // 2
PEER_TOKEN_BLOCK = 128
EPS = 1e-6

kernel_name = "hybrid_pool_sgu_peer_block"


def rmsnorm(x, g):
    xf = x.astype(jnp.float32)
    y = xf * lax.rsqrt(jnp.mean(xf * xf, axis=-1, keepdims=True) + EPS)
    return (y * g.astype(jnp.float32)).astype(x.dtype)


def layernorm(x, g):
    xf = x.astype(jnp.float32)
    mu = jnp.mean(xf, axis=-1, keepdims=True)
    var = jnp.mean(jnp.square(xf - mu), axis=-1, keepdims=True)
    return ((xf - mu) * lax.rsqrt(var + EPS) * g.astype(jnp.float32)).astype(x.dtype)


def pool_mixer(a, pool_w, pool_scale):
    B, S, _ = a.shape
    af = a.astype(jnp.float32).reshape(B, S, N_POOL_GROUPS, POOL_GROUP)
    cs = jnp.cumsum(af, axis=1)
    pos = jnp.arange(S, dtype=jnp.float32)[None, :, None]
    outs = []
    for g, w in enumerate(POOL_WINDOWS):
        csg = cs[:, :, g]
        lagged = jnp.pad(csg, ((0, 0), (w, 0), (0, 0)))[:, :S]
        count = jnp.minimum(pos + 1.0, float(w))
        outs.append((csg - lagged) / count - af[:, :, g])
    d = jnp.stack(outs, axis=2).astype(a.dtype)
    y = jnp.einsum('bsgc,gcd->bsgd', d, pool_w)
    return y.reshape(B, S, D_POOL) * pool_scale


def sgu_mixer(uv, sgu_norm_g, sgu_w, sgu_b):
    B, S, _ = uv.shape
    uv = jax.nn.gelu(uv)
    u, v = uv[..., :D_SGU], uv[..., D_SGU:]
    v = layernorm(v, sgu_norm_g)
    ch = jnp.arange(SGU_BLOCK) // CHUNK
    mask = ch[None, :] <= ch[:, None]
    ws = jnp.where(mask[None], sgu_w, jnp.zeros_like(sgu_w))
    vb = v.reshape(B, S // SGU_BLOCK, SGU_BLOCK, SGU_HEADS, SGU_HEAD_DIM)
    gate = jnp.einsum('hij,bnjhc->bnihc', ws, vb) + jnp.transpose(sgu_b)[None, None, :, :, None]
    return u * gate.reshape(B, S, D_SGU)


def peer_ffn(h, wq, keys, u_tab, v_tab):
    B, S, D = h.shape
    xt = h.reshape((B * S) // PEER_TOKEN_BLOCK, PEER_TOKEN_BLOCK, D)

    def block(xb):
        T = xb.shape[0]
        q = (xb @ wq).reshape(T, PEER_HEADS, 2, D_HALF)
        s = jnp.einsum('thpd,phkd->thpk', q, keys).astype(jnp.float32)
        s_top, i_top = lax.top_k(s, PEER_TOPK)
        cand_s = s_top[:, :, 0, :, None] + s_top[:, :, 1, None, :]
        cand_i = i_top[:, :, 0, :, None] * N_KEYS + i_top[:, :, 1, None, :]
        cand_s = cand_s.reshape(T, PEER_HEADS, PEER_TOPK * PEER_TOPK)
        cand_i = cand_i.reshape(T, PEER_HEADS, PEER_TOPK * PEER_TOPK)
        best_s, best_pos = lax.top_k(cand_s, PEER_TOPK)
        idx = jnp.take_along_axis(cand_i, best_pos, axis=-1)
        gate = jax.nn.softmax(best_s, axis=-1)
        u = u_tab[idx]
        v = v_tab[idx]
        act = jax.nn.gelu(jnp.einsum('td,thkd->thk', xb, u).astype(jnp.float32))
        return jnp.einsum('thk,thkd->td', (gate * act).astype(xb.dtype), v)

    return lax.map(block, xt).reshape(B, S, D)


def setup_inputs(seed: int = 0) -> dict:
    key = jax.random.key(seed)
    ks = jax.random.split(key, 16)
    f32 = jnp.float32
    L, D = DEPTH, D_MODEL
    x = jax.random.normal(ks[0], (BATCH, SEQ, D), f32)
    norm1_g = 1.0 + 0.02 * jax.random.normal(ks[1], (L, D), f32)
    w_in = jax.random.normal(ks[2], (L, D, D_IN), f32) * D ** -0.5
    pool_w = jax.random.normal(ks[3], (L, N_POOL_GROUPS, POOL_GROUP, POOL_GROUP), f32) * POOL_GROUP ** -0.5
    pool_scale = 1.0 + 0.02 * jax.random.normal(ks[4], (L, D_POOL), f32)
    sgu_norm_g = 1.0 + 0.02 * jax.random.normal(ks[5], (L, D_SGU), f32)
    sgu_w = jax.random.normal(ks[6], (L, SGU_HEADS, SGU_BLOCK, SGU_BLOCK), f32) * SGU_BLOCK ** -0.5
    sgu_b = 1.0 + 0.02 * jax.random.normal(ks[7], (L, SGU_HEADS, SGU_BLOCK), f32)
    w_out = jax.random.normal(ks[8], (L, D_MIX, D), f32) * D_MIX ** -0.5
    norm2_g = 1.0 + 0.02 * jax.random.normal(ks[9], (L, D), f32)
    peer_wq = jax.random.normal(ks[10], (L, D, PEER_HEADS * D_QUERY), f32) * D ** -0.5
    peer_keys = jax.random.normal(ks[11], (L, 2, PEER_HEADS, N_KEYS, D_HALF), f32) * D_HALF ** -0.5
    peer_u = jax.random.normal(ks[12], (L, N_EXPERTS, D), f32) * D ** -0.5
    peer_v = jax.random.normal(ks[13], (L, N_EXPERTS, D), f32) * PEER_HEADS ** -0.5
    final_g = 1.0 + 0.02 * jax.random.normal(ks[14], (D,), f32)
    return {"x": x, "norm1_g": norm1_g, "w_in": w_in, "pool_w": pool_w,
            "pool_scale": pool_scale, "sgu_norm_g": sgu_norm_g, "sgu_w": sgu_w,
            "sgu_b": sgu_b, "w_out": w_out, "norm2_g": norm2_g, "peer_wq": peer_wq,
            "peer_keys": peer_keys, "peer_u": peer_u, "peer_v": peer_v,
            "final_g": final_g}


def reference(x, norm1_g, w_in, pool_w, pool_scale, sgu_norm_g, sgu_w, sgu_b,
              w_out, norm2_g, peer_wq, peer_keys, peer_u, peer_v, final_g):
    h = x
    for l in range(DEPTH):
        z = rmsnorm(h, norm1_g[l]) @ w_in[l]
        a = pool_mixer(z[..., :D_POOL], pool_w[l], pool_scale[l])
        b = sgu_mixer(z[..., D_POOL:], sgu_norm_g[l], sgu_w[l], sgu_b[l])
        h = h + jnp.concatenate([a, b], axis=-1) @ w_out[l]
        h = h + peer_ffn(rmsnorm(h, norm2_g[l]), peer_wq[l], peer_keys[l], peer_u[l], peer_v[l])
    return rmsnorm(h, final_g)
```

```cpp
#include <hip/hip_runtime.h>
#include <stdint.h>
#include <type_traits>

typedef unsigned short bf16_t;
typedef short bf16x8 __attribute__((ext_vector_type(8)));
typedef float f32x4 __attribute__((ext_vector_type(4)));
typedef unsigned u32x4 __attribute__((ext_vector_type(4)));
typedef unsigned u32x2 __attribute__((ext_vector_type(2)));
typedef unsigned u32x3 __attribute__((ext_vector_type(3)));
#define ROWB 768
typedef __bf16 bf2_t __attribute__((ext_vector_type(2)));
#define LAS __attribute__((address_space(3)))

#define T_TOK 32768
#define D_MODEL 1024
#define D_IN 1536
#define SEQ 2048
#define NEXP 16384
#define EPS 1e-6f

struct Params {
    const float *x, *norm1_g, *w_in, *pool_w, *pool_scale, *sgu_norm_g, *sgu_w, *sgu_b, *w_out, *norm2_g, *peer_wq, *peer_keys, *peer_u, *peer_v, *final_g;
    float* out;
    bf16_t *winT, *woutT, *wqT, *poolT, *wsM, *keysB;
    unsigned char *u8; unsigned char *v8; signed char *hq; int* hs;
    float *su, *sv, *sh;
    float *rstd1, *rstd2, *lnm, *lnr;
    bf16_t *xb, *zb, *dB, *vnT, *cB, *hb, *qB;
    int* idx; float* gate; float* coef;
    unsigned* bar;
};

__device__ __forceinline__ unsigned short f2bf(float f) {
    unsigned u = __float_as_uint(f);
    u += 0x7fffu + ((u >> 16) & 1u);
    return (unsigned short)(u >> 16);
}
__device__ __forceinline__ float bf2f(unsigned short h) { return __uint_as_float(((unsigned)h) << 16); }
__device__ __forceinline__ unsigned pack2(float a, float b) { return (unsigned)f2bf(a) | ((unsigned)f2bf(b) << 16); }
__device__ __forceinline__ float bflo(unsigned w) { return __uint_as_float(w << 16); }
__device__ __forceinline__ float bfhi(unsigned w) { return __uint_as_float(w & 0xffff0000u); }
__device__ __forceinline__ float gelu_t(float x) {
    const float y = 1.5957691216057308f * (x + 0.044715f * x * x * x);
    return x / (1.0f + __expf(-y));
}
__device__ __forceinline__ float wave_sum(float v) {
#pragma unroll
    for (int o = 32; o >= 1; o >>= 1) v += __shfl_xor(v, o);
    return v;
}
__device__ __forceinline__ float wave_max(float v) {
#pragma unroll
    for (int o = 32; o >= 1; o >>= 1) v = fmaxf(v, __shfl_xor(v, o));
    return v;
}

#define GEMM_LDS_BYTES (2 * 128 * 144)
template <bool SYNC_EPI = false, class Epi>
__device__ __forceinline__ void gemm128(const int tid, const bf16_t* __restrict__ A, int lda, const bf16_t* __restrict__ Bt, int ldb, int K, char* lds, const Epi& epi) {
    const int lane = tid & 63, wid = tid >> 6, wr = wid >> 1, wc = wid & 1, fr = lane & 15, fq = lane >> 4;
    constexpr int PITCH = 144;
    char* sA = lds; char* sB = lds + 128 * PITCH;
    f32x4 acc[4][4];
#pragma unroll
    for (int m = 0; m < 4; ++m)
#pragma unroll
        for (int n = 0; n < 4; ++n) acc[m][n] = (f32x4){0.f, 0.f, 0.f, 0.f};
    u32x4 ra[4], rb[4];
    const int lrow = tid >> 3, lch = tid & 7;
    const bf16_t* ga = A + (size_t)lrow * lda + lch * 8;
    const bf16_t* gb = Bt + (size_t)lrow * ldb + lch * 8;
#pragma unroll
    for (int j = 0; j < 4; ++j) { ra[j] = *(const u32x4*)(ga + (size_t)(32 * j) * lda); rb[j] = *(const u32x4*)(gb + (size_t)(32 * j) * ldb); }
    for (int k0 = 0; k0 < K; k0 += 64) {
        __syncthreads();
#pragma unroll
        for (int j = 0; j < 4; ++j) {
            *(u32x4*)(sA + (lrow + 32 * j) * PITCH + lch * 16) = ra[j];
            *(u32x4*)(sB + (lrow + 32 * j) * PITCH + lch * 16) = rb[j];
        }
        __syncthreads();
        if (k0 + 64 < K) {
#pragma unroll
            for (int j = 0; j < 4; ++j) { ra[j] = *(const u32x4*)(ga + (size_t)(32 * j) * lda + k0 + 64); rb[j] = *(const u32x4*)(gb + (size_t)(32 * j) * ldb + k0 + 64); }
        }
#pragma unroll
        for (int kk = 0; kk < 2; ++kk) {
            bf16x8 af[4], bfr[4];
#pragma unroll
            for (int m = 0; m < 4; ++m) af[m] = *(const bf16x8*)(sA + (wr * 64 + m * 16 + fr) * PITCH + (kk * 32 + fq * 8) * 2);
#pragma unroll
            for (int n = 0; n < 4; ++n) bfr[n] = *(const bf16x8*)(sB + (wc * 64 + n * 16 + fr) * PITCH + (kk * 32 + fq * 8) * 2);
#pragma unroll
            for (int m = 0; m < 4; ++m)
#pragma unroll
                for (int n = 0; n < 4; ++n) acc[m][n] = __builtin_amdgcn_mfma_f32_16x16x32_bf16(bfr[n], af[m], acc[m][n], 0, 0, 0);
        }
    }
    if (SYNC_EPI) __syncthreads();
#pragma unroll
    for (int m = 0; m < 4; ++m)
#pragma unroll
        for (int n = 0; n < 4; ++n) epi(wr * 64 + m * 16 + fr, wc * 64 + n * 16 + fq * 4, acc[m][n]);
}

__device__ __forceinline__ void transpose_tile(const int tid, const float* __restrict__ src, bf16_t* __restrict__ dst, int R, int C, const float* __restrict__ rscale, int tile, float* lds) {
    const int tilesC = C / 64, tr = tile / tilesC, tc = tile % tilesC;
    const int ty = tid >> 6, tx = tid & 63;
    __syncthreads();
#pragma unroll
    for (int i = 0; i < 16; ++i) {
        const int r = ty + 4 * i;
        float v = src[(size_t)(tr * 64 + r) * C + tc * 64 + tx];
        if (rscale) v *= rscale[tr * 64 + r];
        lds[r * 65 + tx] = v;
    }
    __syncthreads();
#pragma unroll
    for (int i = 0; i < 16; ++i) {
        const int c = ty + 4 * i;
        dst[(size_t)(tc * 64 + c) * R + tr * 64 + tx] = f2bf(lds[tx * 65 + c]);
    }
}

__device__ void phase_prep(const Params& p, char* lds) {
    const int nb = gridDim.x, b = blockIdx.x, tid = threadIdx.x;
    const int half = tid >> 8, ht = tid & 255, nh = 2 * nb, hb2 = 2 * b + half;
    float* fl = (float*)(lds + half * (64 * 65 * 4));
    for (int t = hb2; t < 16 * 24; t += nh) transpose_tile(ht, p.w_in, p.winT, 1024, 1536, p.norm1_g, t, fl);
    for (int t = hb2; t < 16 * 16; t += nh) transpose_tile(ht, p.w_out, p.woutT, 1024, 1024, nullptr, t, fl);
    for (int t = hb2; t < 16 * 32; t += nh) transpose_tile(ht, p.peer_wq, p.wqT, 1024, 2048, p.norm2_g, t, fl);
    for (int t = hb2; t < 16; t += nh) transpose_tile(ht, p.pool_w + (size_t)(t >> 2) * 16384, p.poolT + (size_t)(t >> 2) * 16384, 128, 128, nullptr, t & 3, fl);
    const size_t gtid = (size_t)b * blockDim.x + tid, gsz = (size_t)nb * blockDim.x;
    for (size_t i = gtid; i < 4 * 128 * 128; i += gsz) {
        const int j = (int)(i & 127), ii = (int)((i >> 7) & 127);
        const bool keep = (j >> 6) <= (ii >> 6);
        p.wsM[i] = keep ? f2bf(p.sgu_w[i]) : (bf16_t)0;
    }
    for (size_t i = gtid; i < 2 * 8 * 128 * 128; i += gsz) p.keysB[i] = f2bf(p.peer_keys[i]);
    {
        const int wave = (b * blockDim.x + tid) >> 6, nwaves = (nb * blockDim.x) >> 6, lane = tid & 63;
        float g16[16];
#pragma unroll
        for (int i = 0; i < 4; ++i) { const float4 g = ((const float4*)(p.norm2_g + lane * 16))[i]; g16[4 * i] = g.x; g16[4 * i + 1] = g.y; g16[4 * i + 2] = g.z; g16[4 * i + 3] = g.w; }
        auto quant_row = [&](const float (&f)[16], unsigned char* dst, float* scale_out) {
            float am = 0.f;
#pragma unroll
            for (int j = 0; j < 16; ++j) am = fmaxf(am, fabsf(f[j]));
            am = wave_max(am);
            const float inv = am > 0.f ? 31.0f / am : 0.f;
            int q[16];
#pragma unroll
            for (int j = 0; j < 16; ++j) q[j] = (int)rintf(f[j] * inv) + 32;
            u32x3 o;
#pragma unroll
            for (int i = 0; i < 3; ++i) {
                unsigned w = 0;
#pragma unroll
                for (int k = 0; k < 4; ++k) w |= (unsigned)(q[4 * i + k] | (((q[12 + k] >> (2 * i)) & 3) << 6)) << (8 * k);
                o[i] = w;
            }
            *(u32x3*)(dst + lane * 12) = o;
            if (lane == 0) *scale_out = am * (1.0f / 31.0f);
        };
        for (int e = wave; e < NEXP; e += nwaves) {
            const float4* su4 = (const float4*)(p.peer_u + (size_t)e * D_MODEL + lane * 16);
            const float4* sv4 = (const float4*)(p.peer_v + (size_t)e * D_MODEL + lane * 16);
            float4 a4[4], b4[4];
#pragma unroll
            for (int i = 0; i < 4; ++i) { a4[i] = su4[i]; b4[i] = sv4[i]; }
            float fu[16], fv[16];
#pragma unroll
            for (int i = 0; i < 4; ++i) {
                fu[4 * i] = a4[i].x * g16[4 * i]; fu[4 * i + 1] = a4[i].y * g16[4 * i + 1]; fu[4 * i + 2] = a4[i].z * g16[4 * i + 2]; fu[4 * i + 3] = a4[i].w * g16[4 * i + 3];
                fv[4 * i] = b4[i].x; fv[4 * i + 1] = b4[i].y; fv[4 * i + 2] = b4[i].z; fv[4 * i + 3] = b4[i].w;
            }
            {
                float am = 0.f;
#pragma unroll
                for (int j = 0; j < 16; ++j) am = fmaxf(am, fabsf(fu[j]));
                am = wave_max(am);
                const float inv = am > 0.f ? 127.0f / am : 0.f;
                u32x4 o;
#pragma unroll
                for (int i = 0; i < 4; ++i) {
                    unsigned w = 0;
#pragma unroll
                    for (int k = 0; k < 4; ++k) w |= (unsigned)(((int)rintf(fu[4 * i + k] * inv)) & 0xff) << (8 * k);
                    o[i] = w;
                }
                *(u32x4*)(p.u8 + (size_t)e * D_MODEL + lane * 16) = o;
                if (lane == 0) p.su[e] = am * (1.0f / 127.0f);
            }
            quant_row(fv, p.v8 + (size_t)e * ROWB, p.sv + e);
        }
    }
    const int wave = (b * blockDim.x + tid) >> 6, nwaves = (nb * blockDim.x) >> 6, lane = tid & 63;
    for (int t = wave; t < T_TOK; t += 2 * nwaves) {
        const int t1 = t + nwaves; const bool two = t1 < T_TOK;
        const float4* xr0 = (const float4*)(p.x + (size_t)t * D_MODEL);
        const float4* xr1 = (const float4*)(p.x + (size_t)(two ? t1 : t) * D_MODEL);
        float4 v0[4], v1[4];
#pragma unroll
        for (int i = 0; i < 4; ++i) { v0[i] = xr0[lane + 64 * i]; v1[i] = xr1[lane + 64 * i]; }
        float s0 = 0.f, s1 = 0.f;
#pragma unroll
        for (int i = 0; i < 4; ++i) {
            s0 += v0[i].x * v0[i].x + v0[i].y * v0[i].y + v0[i].z * v0[i].z + v0[i].w * v0[i].w;
            s1 += v1[i].x * v1[i].x + v1[i].y * v1[i].y + v1[i].z * v1[i].z + v1[i].w * v1[i].w;
            uint2 o; o.x = pack2(v0[i].x, v0[i].y); o.y = pack2(v0[i].z, v0[i].w);
            ((uint2*)(p.xb + (size_t)t * D_MODEL))[lane + 64 * i] = o;
            if (two) { uint2 o1; o1.x = pack2(v1[i].x, v1[i].y); o1.y = pack2(v1[i].z, v1[i].w); ((uint2*)(p.xb + (size_t)t1 * D_MODEL))[lane + 64 * i] = o1; }
        }
        s0 = wave_sum(s0); s1 = wave_sum(s1);
        if (lane == 0) { p.rstd1[t] = rsqrtf(s0 * (1.0f / D_MODEL) + EPS); if (two) p.rstd1[t1] = rsqrtf(s1 * (1.0f / D_MODEL) + EPS); }
    }
}

__device__ void phase_mix_prep(const Params& p, char* lds) {
    const size_t gtid = (size_t)blockIdx.x * blockDim.x + threadIdx.x, gsz = (size_t)gridDim.x * blockDim.x;
    {
        const int gw = (int)(gtid >> 6), ngw = (int)(gsz >> 6), ln = threadIdx.x & 63;
        for (int item = gw; item < (T_TOK / 4) * 4; item += ngw) {
            const int g = item & 3, t = (item >> 2) * 4 + (ln >> 4), c8 = g * 16 + (ln & 15), pos = t & (SEQ - 1);
            const bf16_t* zp = p.zb + (size_t)t * D_IN + c8 * 8;
            float s[8];
#pragma unroll
            for (int j = 0; j < 8; ++j) s[j] = 0.f;
            uint4 self = make_uint4(0, 0, 0, 0);
            auto body = [&](auto WC) {
                constexpr int W = decltype(WC)::value;
                uint4 v[W];
#pragma unroll
                for (int k = 0; k < W; ++k) v[k] = *(const uint4*)(zp - (size_t)(k <= pos ? k : 0) * D_IN);
                self = v[0];
#pragma unroll
                for (int k = 0; k < W; ++k) {
                    const float m = (k <= pos) ? 1.f : 0.f;
                    s[0] += m * bflo(v[k].x); s[1] += m * bfhi(v[k].x); s[2] += m * bflo(v[k].y); s[3] += m * bfhi(v[k].y);
                    s[4] += m * bflo(v[k].z); s[5] += m * bfhi(v[k].z); s[6] += m * bflo(v[k].w); s[7] += m * bfhi(v[k].w);
                }
            };
            if (g == 0) body(std::integral_constant<int, 2>{}); else if (g == 1) body(std::integral_constant<int, 4>{});
            else if (g == 2) body(std::integral_constant<int, 8>{}); else body(std::integral_constant<int, 16>{});
            const int w = 2 << g, n = (pos + 1 < w) ? pos + 1 : w;
            const float fn = (float)n;
            uint4 o;
            o.x = pack2(s[0] / fn - bflo(self.x), s[1] / fn - bfhi(self.x));
            o.y = pack2(s[2] / fn - bflo(self.y), s[3] / fn - bfhi(self.y));
            o.z = pack2(s[4] / fn - bflo(self.z), s[5] / fn - bfhi(self.z));
            o.w = pack2(s[6] / fn - bflo(self.w), s[7] / fn - bfhi(self.w));
            *(uint4*)(p.dB + (size_t)t * 512 + c8 * 8) = o;
        }
    }
    const int wave = (int)(gtid >> 6), nwaves = (int)(gsz >> 6), lane = threadIdx.x & 63;
    for (int t = wave; t < T_TOK; t += nwaves) {
        const uint4 v = *(const uint4*)(p.zb + (size_t)t * D_IN + 1024 + lane * 8);
        float f[8] = {bflo(v.x), bfhi(v.x), bflo(v.y), bfhi(v.y), bflo(v.z), bfhi(v.z), bflo(v.w), bfhi(v.w)};
        float s = 0.f;
#pragma unroll
        for (int j = 0; j < 8; ++j) s += f[j];
        const float mean = wave_sum(s) * (1.0f / 512.0f);
        float q = 0.f;
#pragma unroll
        for (int j = 0; j < 8; ++j) { f[j] -= mean; q += f[j] * f[j]; }
        const float rstd = rsqrtf(wave_sum(q) * (1.0f / 512.0f) + EPS);
        if (lane == 0) { p.lnm[t] = mean; p.lnr[t] = rstd; }
    }
}

typedef short s16x4 __attribute__((ext_vector_type(4)));
template <class Epi>
__device__ __forceinline__ void gemm128_sgu(const int tid, const bf16_t* __restrict__ A, const bf16_t* __restrict__ V  ,
                                            const float* __restrict__ lnm, const float* __restrict__ lnr, const float* __restrict__ gch, char* lds, const Epi& epi) {
    const int lane = tid & 63, wid = tid >> 6, wr = wid >> 1, wc = wid & 1, fr = lane & 15, fq = lane >> 4;
    constexpr int PITCH = 144, P2 = 288;
    char* sA = lds; char* sB = lds + 128 * PITCH;
    f32x4 acc[4][4];
#pragma unroll
    for (int m = 0; m < 4; ++m)
#pragma unroll
        for (int n = 0; n < 4; ++n) acc[m][n] = (f32x4){0.f, 0.f, 0.f, 0.f};
    u32x4 ra[4], rb[4]; float rm[4], rr[4];
    const int lrow = tid >> 3, lch = tid & 7;
    const int btok = tid >> 4, bch = tid & 15;
    const bf16_t* ga = A + (size_t)lrow * 128 + lch * 8;
    const bf16_t* gb = V + (size_t)btok * D_IN + bch * 8;
    float g8[8];
    { const float4 g0 = *(const float4*)(gch + bch * 8), g1 = *(const float4*)(gch + bch * 8 + 4); g8[0] = g0.x; g8[1] = g0.y; g8[2] = g0.z; g8[3] = g0.w; g8[4] = g1.x; g8[5] = g1.y; g8[6] = g1.z; g8[7] = g1.w; }
#pragma unroll
    for (int j = 0; j < 4; ++j) { ra[j] = *(const u32x4*)(ga + (size_t)(32 * j) * 128); rb[j] = *(const u32x4*)(gb + (size_t)(16 * j) * D_IN); rm[j] = lnm[btok + 16 * j]; rr[j] = lnr[btok + 16 * j]; }
    for (int k0 = 0; k0 < 128; k0 += 64) {
        __syncthreads();
#pragma unroll
        for (int j = 0; j < 4; ++j) {
            *(u32x4*)(sA + (lrow + 32 * j) * PITCH + lch * 16) = ra[j];
            u32x4 o;
#pragma unroll
            for (int i = 0; i < 4; ++i) {
                const unsigned w = rb[j][i];
                o[i] = pack2((bflo(w) - rm[j]) * rr[j] * g8[2 * i], (bfhi(w) - rm[j]) * rr[j] * g8[2 * i + 1]);
            }
            *(u32x4*)(sB + (btok + 16 * j) * P2 + bch * 16) = o;
        }
        __syncthreads();
        if (k0 + 64 < 128) {
#pragma unroll
            for (int j = 0; j < 4; ++j) { ra[j] = *(const u32x4*)(ga + (size_t)(32 * j) * 128 + 64); rb[j] = *(const u32x4*)(gb + (size_t)(64 + 16 * j) * D_IN); rm[j] = lnm[64 + btok + 16 * j]; rr[j] = lnr[64 + btok + 16 * j]; }
        }
#pragma unroll
        for (int kk = 0; kk < 2; ++kk) {
            bf16x8 af[4], bfr[4];
#pragma unroll
            for (int m = 0; m < 4; ++m) af[m] = *(const bf16x8*)(sA + (wr * 64 + m * 16 + fr) * PITCH + (kk * 32 + fq * 8) * 2);
#pragma unroll
            for (int n = 0; n < 4; ++n) {
                const char* bp = sB + (kk * 32 + fq * 8 + (fr >> 2)) * P2 + (wc * 64 + n * 16 + 4 * (fr & 3)) * 2;
                const s16x4 lo = __builtin_amdgcn_ds_read_tr16_b64_v4i16((LAS s16x4*)(bp));
                const s16x4 hi = __builtin_amdgcn_ds_read_tr16_b64_v4i16((LAS s16x4*)(bp + 4 * P2));
                bfr[n] = (bf16x8){lo[0], lo[1], lo[2], lo[3], hi[0], hi[1], hi[2], hi[3]};
            }
#pragma unroll
            for (int m = 0; m < 4; ++m)
#pragma unroll
                for (int n = 0; n < 4; ++n) acc[m][n] = __builtin_amdgcn_mfma_f32_16x16x32_bf16(bfr[n], af[m], acc[m][n], 0, 0, 0);
        }
    }
#pragma unroll
    for (int m = 0; m < 4; ++m)
#pragma unroll
        for (int n = 0; n < 4; ++n) epi(wr * 64 + m * 16 + fr, wc * 64 + n * 16 + fq * 4, acc[m][n]);
}

__device__ void phase_mix_gemm(const Params& p, char* lds) {
    const int npool = (T_TOK / 128) * 4, nsgu = (T_TOK / 128) * 4;
    const int half = threadIdx.x >> 8, ht = threadIdx.x & 255; lds += half * GEMM_LDS_BYTES;
    for (int tile = 2 * blockIdx.x + half; tile < npool + nsgu; tile += 2 * gridDim.x) {
        if (tile < npool) {
            const int tm = tile >> 2, g = tile & 3;
            const float* ps = p.pool_scale + g * 128; bf16_t* co = p.cB + (size_t)tm * 128 * D_MODEL + g * 128;
            gemm128(ht, p.dB + (size_t)tm * 128 * 512 + g * 128, 512, p.poolT + (size_t)g * 16384, 128, 128, lds,
                    [&](int r, int c, f32x4 v) {
                        const float4 s = *(const float4*)(ps + c);
                        uint2 o; o.x = pack2(v[0] * s.x, v[1] * s.y); o.y = pack2(v[2] * s.z, v[3] * s.w);
                        *(uint2*)(co + (size_t)r * D_MODEL + c) = o;
                    });
        } else {
            const int t2 = tile - npool, blk = t2 >> 2, h = t2 & 3;
            const float* sb = p.sgu_b + h * 128; const bf16_t* uo = p.zb + (size_t)blk * 128 * D_IN + 512 + h * 128;
            bf16_t* co = p.cB + (size_t)blk * 128 * D_MODEL + 512 + h * 128;
            gemm128_sgu(ht, p.wsM + (size_t)h * 16384, p.zb + (size_t)blk * 128 * D_IN + 1024 + h * 128, p.lnm + blk * 128, p.lnr + blk * 128, p.sgu_norm_g + h * 128, lds,
                    [&](int r, int c, f32x4 v) {
                        const float bb = sb[r];
                        const uint2 uu = *(const uint2*)(uo + (size_t)r * D_IN + c);
                        uint2 o;
                        o.x = pack2((v[0] + bb) * bflo(uu.x), (v[1] + bb) * bfhi(uu.x));
                        o.y = pack2((v[2] + bb) * bflo(uu.y), (v[3] + bb) * bfhi(uu.y));
                        *(uint2*)(co + (size_t)r * D_MODEL + c) = o;
                    });
        }
    }
}

__device__ __forceinline__ int wave_sum_i_uniform(int s) {
    s += __builtin_amdgcn_update_dpp(0, s, 0xB1, 0xf, 0xf, false);
    s += __builtin_amdgcn_update_dpp(0, s, 0x4E, 0xf, 0xf, false);
    s += __builtin_amdgcn_update_dpp(0, s, 0x141, 0xf, 0xf, false);
    s += __builtin_amdgcn_update_dpp(0, s, 0x140, 0xf, 0xf, false);
    return __builtin_amdgcn_readlane(s, 0) + __builtin_amdgcn_readlane(s, 16) + __builtin_amdgcn_readlane(s, 32) + __builtin_amdgcn_readlane(s, 48);
}
__device__ void phase_hstats(const Params& p, char* lds) {
    const int wave = (blockIdx.x * blockDim.x + threadIdx.x) >> 6, nwaves = (gridDim.x * blockDim.x) >> 6, lane = threadIdx.x & 63;
    for (int t = wave; t < T_TOK; t += nwaves) {
        const u32x4* hr = (const u32x4*)(p.hb + (size_t)t * D_MODEL + lane * 16);
        const u32x4 a = hr[0], c = hr[1];
        const float f[16] = {bflo(a.x), bfhi(a.x), bflo(a.y), bfhi(a.y), bflo(a.z), bfhi(a.z), bflo(a.w), bfhi(a.w),
                             bflo(c.x), bfhi(c.x), bflo(c.y), bfhi(c.y), bflo(c.z), bfhi(c.z), bflo(c.w), bfhi(c.w)};
        float ss = 0.f, am = 0.f;
#pragma unroll
        for (int j = 0; j < 16; ++j) { ss += f[j] * f[j]; am = fmaxf(am, fabsf(f[j])); }
        ss = wave_sum(ss); am = wave_max(am);
        const float inv = am > 0.f ? 127.0f / am : 0.f;
        u32x4 o;
#pragma unroll
        for (int i = 0; i < 4; ++i) {
            unsigned w = 0;
#pragma unroll
            for (int k = 0; k < 4; ++k) w |= (unsigned)(((int)rintf(f[4 * i + k] * inv)) & 0xff) << (8 * k);
            o[i] = w;
        }
        *(u32x4*)(p.hq + (size_t)t * D_MODEL + lane * 16) = o;
        int hsum = 0;
#pragma unroll
        for (int j = 0; j < 16; ++j) hsum += (int)rintf(f[j] * inv);
        hsum = wave_sum_i_uniform(hsum);
        if (lane == 0) { p.rstd2[t] = rsqrtf(ss * (1.0f / D_MODEL) + EPS); p.sh[t] = am * (1.0f / 127.0f); p.hs[t] = hsum; }
    }
}

__constant__ unsigned char kComb[64] = {
    0x00,0x01,0x02,0x03,0x04,0x05,0x06,0x07,0x08,0x09,0x0a,0x0b,0x0c,0x0d,0x0e,0x0f,
    0x10,0x11,0x12,0x13,0x14,0x15,0x16,0x17,
    0x20,0x21,0x22,0x23,0x24,
    0x30,0x31,0x32,0x33,
    0x40,0x41,0x42,
    0x50,0x51,
    0x60,0x61,
    0x70,0x71,
    0x80,0x90,0xa0,0xb0,0xc0,0xd0,0xe0,0xf0,
    0xff,0xff,0xff,0xff,0xff,0xff,0xff,0xff,0xff,0xff,0xff,0xff,0xff,0xff};

template <int CTRL> __device__ __forceinline__ int dpp_i(int v) { return __builtin_amdgcn_update_dpp(0, v, CTRL, 0xf, 0xf, false); }
__device__ __forceinline__ int row_allmax_i(int v) {
    v = max(v, dpp_i<0x128>(v)); v = max(v, dpp_i<0x124>(v)); v = max(v, dpp_i<0x122>(v)); v = max(v, dpp_i<0x121>(v));
    return v;
}
__device__ __forceinline__ float row_allsum_f(float v) {
    v += __int_as_float(dpp_i<0x128>(__float_as_int(v))); v += __int_as_float(dpp_i<0x124>(__float_as_int(v)));
    v += __int_as_float(dpp_i<0x122>(__float_as_int(v))); v += __int_as_float(dpp_i<0x121>(__float_as_int(v)));
    return v;
}
__device__ __forceinline__ int f2key(float f) { const int b = __float_as_int(f); return b ^ ((b >> 31) & 0x7fffffff); }
__device__ __forceinline__ float key2f(int k) { return __int_as_float(k ^ ((k >> 31) & 0x7fffffff)); }
#define KEY_MIN ((int)0x80000000)
#define CE(a, b) { const int hi_ = max(a, b), lo_ = min(a, b); a = hi_; b = lo_; }
__device__ __forceinline__ int top16_rows(int (&k)[8], int l15) {
    CE(k[0], k[1]) CE(k[2], k[3]) CE(k[4], k[5]) CE(k[6], k[7])
    CE(k[0], k[2]) CE(k[1], k[3]) CE(k[4], k[6]) CE(k[5], k[7])
    CE(k[1], k[2]) CE(k[5], k[6])
    CE(k[0], k[4]) CE(k[1], k[5]) CE(k[2], k[6]) CE(k[3], k[7])
    CE(k[2], k[4]) CE(k[3], k[5])
    CE(k[1], k[2]) CE(k[3], k[4]) CE(k[5], k[6])
    int res = KEY_MIN;
#pragma unroll
    for (int r = 0; r < 16; ++r) {
        const int m = row_allmax_i(k[0]);
        const bool own = (k[0] == m);
#pragma unroll
        for (int j = 0; j < 7; ++j) k[j] = own ? k[j + 1] : k[j];
        k[7] = own ? KEY_MIN : k[7];
        res = (l15 == r) ? m : res;
    }
    return res;
}
__device__ __forceinline__ void combine16(int A, int B, const int (&cbv)[4], int lane, int l15, int& eid_out, float& gate_out) {
    const int rowbase = lane & 48;
    int ck[4], eid[4];
#pragma unroll
    for (int c = 0; c < 4; ++c) {
        const int ci = (cbv[c] >> 4) & 15, cj = cbv[c] & 15;
        const int ka = __builtin_amdgcn_ds_bpermute((rowbase + ci) << 2, A);
        const int kb = __builtin_amdgcn_ds_bpermute((rowbase + cj) << 2, B);
        const float sm = key2f(ka & ~127) + key2f(kb & ~127);
        eid[c] = ((127 - (ka & 127)) << 7) | (127 - (kb & 127));
        ck[c] = (cbv[c] != 0xff) ? ((f2key(sm) & ~63) | (63 - (4 * l15 + c))) : KEY_MIN;
    }
    CE(ck[0], ck[1]) CE(ck[2], ck[3]) CE(ck[0], ck[2]) CE(ck[1], ck[3]) CE(ck[1], ck[2])
    int res = KEY_MIN;
#pragma unroll
    for (int r = 0; r < 16; ++r) {
        const int m = row_allmax_i(ck[0]);
        const bool own = (ck[0] == m);
        ck[0] = own ? ck[1] : ck[0]; ck[1] = own ? ck[2] : ck[1]; ck[2] = own ? ck[3] : ck[2]; ck[3] = own ? KEY_MIN : ck[3];
        res = (l15 == r) ? m : res;
    }
    const int slot = 63 - (res & 63);
    const int src = (rowbase + (slot >> 2)) << 2;
    const int e0 = __builtin_amdgcn_ds_bpermute(src, eid[0]), e1 = __builtin_amdgcn_ds_bpermute(src, eid[1]);
    const int e2 = __builtin_amdgcn_ds_bpermute(src, eid[2]), e3 = __builtin_amdgcn_ds_bpermute(src, eid[3]);
    const int sel = slot & 3;
    eid_out = sel == 0 ? e0 : (sel == 1 ? e1 : (sel == 2 ? e2 : e3));
    gate_out = key2f(res & ~63);
}

__device__ void phase_topk(const Params& p, char* lds) {
    const int half = threadIdx.x >> 8; lds += half * GEMM_LDS_BYTES;
    const int tid = threadIdx.x & 255, lane = tid & 63, wid = tid >> 6, fr = lane & 15, fq = lane >> 4;
    constexpr int PITCH = 144;
    char* sA = lds; char* sB = lds + 128 * PITCH;
    int cbv[4];
#pragma unroll
    for (int c = 0; c < 4; ++c) cbv[c] = kComb[4 * fr + c];
    const int lrow = tid >> 3, lch = tid & 7;
    const int ntiles = (T_TOK / 128) * 8;
    for (int tile = 2 * blockIdx.x + half; tile < ntiles; tile += 2 * gridDim.x) {
        const int tm = tile >> 3, h = tile & 7;
        int tA[2][4], tB[2][4];
#pragma unroll
        for (int m = 0; m < 2; ++m)
#pragma unroll
            for (int j = 0; j < 4; ++j) { tA[m][j] = 0; tB[m][j] = 0; }
#pragma unroll 1
        for (int pp = 0; pp < 2; ++pp) {
            const bf16_t* ga = p.qB + (size_t)(tm * 128 + lrow) * 2048 + h * 256 + pp * 128 + lch * 8;
            const bf16_t* gb = p.keysB + (size_t)(pp * 8 + h) * 16384 + (size_t)lrow * 128 + lch * 8;
            f32x4 acc[2][8];
#pragma unroll
            for (int m = 0; m < 2; ++m)
#pragma unroll
                for (int nb = 0; nb < 8; ++nb) acc[m][nb] = (f32x4){0.f, 0.f, 0.f, 0.f};
#pragma unroll 1
            for (int k0 = 0; k0 < 128; k0 += 64) {
                u32x4 ra[4], rb[4];
#pragma unroll
                for (int j = 0; j < 4; ++j) { ra[j] = *(const u32x4*)(ga + (size_t)(32 * j) * 2048 + k0); rb[j] = *(const u32x4*)(gb + (size_t)(32 * j) * 128 + k0); }
                __syncthreads();
#pragma unroll
                for (int j = 0; j < 4; ++j) {
                    *(u32x4*)(sA + (lrow + 32 * j) * PITCH + lch * 16) = ra[j];
                    *(u32x4*)(sB + (lrow + 32 * j) * PITCH + lch * 16) = rb[j];
                }
                __syncthreads();
#pragma unroll
                for (int kk = 0; kk < 2; ++kk) {
                    bf16x8 af[2], bfr[8];
#pragma unroll
                    for (int m = 0; m < 2; ++m) af[m] = *(const bf16x8*)(sA + (wid * 32 + m * 16 + fr) * PITCH + (kk * 32 + fq * 8) * 2);
#pragma unroll
                    for (int nb = 0; nb < 8; ++nb) bfr[nb] = *(const bf16x8*)(sB + (nb * 16 + fr) * PITCH + (kk * 32 + fq * 8) * 2);
#pragma unroll
                    for (int m = 0; m < 2; ++m)
#pragma unroll
                        for (int nb = 0; nb < 8; ++nb) acc[m][nb] = __builtin_amdgcn_mfma_f32_16x16x32_bf16(af[m], bfr[nb], acc[m][nb], 0, 0, 0);
                }
            }
#pragma unroll
            for (int m = 0; m < 2; ++m)
#pragma unroll
                for (int j = 0; j < 4; ++j) tA[m][j] = tB[m][j];
#pragma unroll 1
            for (int it = 0; it < 4; ++it) {
#pragma unroll
                for (int m = 0; m < 2; ++m) {
                    int k[8];
#pragma unroll
                    for (int nb = 0; nb < 8; ++nb) k[nb] = (f2key(acc[m][nb][0]) & ~127) | (127 - (16 * nb + fr));
                    const int r = top16_rows(k, fr);
                    tB[m][0] = tB[m][1]; tB[m][1] = tB[m][2]; tB[m][2] = tB[m][3]; tB[m][3] = r;
#pragma unroll
                    for (int nb = 0; nb < 8; ++nb) acc[m][nb] = (f32x4){acc[m][nb][1], acc[m][nb][2], acc[m][nb][3], acc[m][nb][0]};
                }
            }
        }
#pragma unroll 1
        for (int it = 0; it < 4; ++it) {
#pragma unroll
            for (int m = 0; m < 2; ++m) {
                int eid; float gt;
                combine16(tA[m][0], tB[m][0], cbv, lane, fr, eid, gt);
                const int t = tm * 128 + wid * 32 + m * 16 + fq * 4 + it;
                const size_t o = (size_t)t * 128 + h * 16 + fr;
                p.idx[o] = eid; p.gate[o] = gt;
                tA[m][0] = tA[m][1]; tA[m][1] = tA[m][2]; tA[m][2] = tA[m][3];
                tB[m][0] = tB[m][1]; tB[m][1] = tB[m][2]; tB[m][2] = tB[m][3];
            }
        }
    }
}

__device__ __forceinline__ int reduce16_rows(const int (&part)[16], bool b3, bool b2, bool b1, bool b0b) {
    int r8[8], r4[4], r2[2];
#pragma unroll
    for (int k = 0; k < 8; ++k) { const int keep = b3 ? part[8 + k] : part[k], send = b3 ? part[k] : part[8 + k]; r8[k] = keep + __builtin_amdgcn_update_dpp(0, send, 0x140, 0xf, 0xf, false); }
#pragma unroll
    for (int k = 0; k < 4; ++k) { const int keep = b2 ? r8[4 + k] : r8[k], send = b2 ? r8[k] : r8[4 + k]; r4[k] = keep + __builtin_amdgcn_update_dpp(0, send, 0x141, 0xf, 0xf, false); }
#pragma unroll
    for (int k = 0; k < 2; ++k) { const int keep = b1 ? r4[2 + k] : r4[k], send = b1 ? r4[k] : r4[2 + k]; r2[k] = keep + __builtin_amdgcn_update_dpp(0, send, 0x4E, 0xf, 0xf, false); }
    const int keep = b0b ? r2[1] : r2[0], send = b0b ? r2[0] : r2[1];
    int r1 = keep + __builtin_amdgcn_update_dpp(0, send, 0xB1, 0xf, 0xf, false);
    r1 += __shfl_xor(r1, 16); r1 += __shfl_xor(r1, 32);
    return r1;
}
#define TS_WBYTES (16384 + 128)
__device__ void phase_peer_dots(const Params& p, char* lds) {
    const int lane = threadIdx.x & 63, wid = __builtin_amdgcn_readfirstlane((int)(threadIdx.x >> 6)), l15 = lane & 15;
    const bool b3 = (lane & 8) != 0, b2 = (lane & 4) != 0, b1 = (lane & 2) != 0, b0b = (lane & 1) != 0;
    const int gw = blockIdx.x * (blockDim.x >> 6) + wid, ngw = gridDim.x * (blockDim.x >> 6);
    char* wl = lds + wid * TS_WBYTES;
    unsigned* list = (unsigned*)wl; int* dotsl = (int*)(wl + 4096); char* hql = wl + 8192; int* tks = (int*)(wl + 16384);
    const unsigned lane16 = (unsigned)lane * 16u;
    for (int tb = gw * 8; tb < T_TOK; tb += ngw * 8) {
#pragma unroll 1
        for (int j0 = 0; j0 < 8; j0 += 4) {
            u32x4 hraw[4][2];
#pragma unroll
            for (int jj = 0; jj < 4; ++jj) { const u32x4* hr = (const u32x4*)(p.hb + (size_t)(tb + j0 + jj) * D_MODEL); hraw[jj][0] = hr[2 * lane]; hraw[jj][1] = hr[2 * lane + 1]; }
#pragma unroll
            for (int jj = 0; jj < 4; ++jj) {
                const int j = j0 + jj;
                const u32x4 a = hraw[jj][0], c = hraw[jj][1];
                const float f[16] = {bflo(a.x), bfhi(a.x), bflo(a.y), bfhi(a.y), bflo(a.z), bfhi(a.z), bflo(a.w), bfhi(a.w),
                                     bflo(c.x), bfhi(c.x), bflo(c.y), bfhi(c.y), bflo(c.z), bfhi(c.z), bflo(c.w), bfhi(c.w)};
                float ss = 0.f, am = 0.f;
#pragma unroll
                for (int k = 0; k < 16; ++k) { ss += f[k] * f[k]; am = fmaxf(am, fabsf(f[k])); }
                ss = wave_sum(ss); am = wave_max(am);
                const float inv = am > 0.f ? 127.0f / am : 0.f;
                u32x4 o; int hsum = 0;
#pragma unroll
                for (int i = 0; i < 4; ++i) {
                    unsigned w = 0;
#pragma unroll
                    for (int k = 0; k < 4; ++k) { const int qv = (int)rintf(f[4 * i + k] * inv); hsum += qv; w |= (unsigned)(qv & 0xff) << (8 * k); }
                    o[i] = w;
                }
                *(u32x4*)(hql + j * 1024 + lane * 16) = o;
                hsum = wave_sum_i_uniform(hsum);
                const float r2 = rsqrtf(ss * (1.0f / D_MODEL) + EPS);
                if (lane == 0) { tks[4 * j] = hsum; tks[4 * j + 1] = __float_as_int(am * (1.0f / 127.0f) * r2); tks[4 * j + 2] = __float_as_int(r2); }
            }
        }
        int idv[8][2];
#pragma unroll
        for (int j = 0; j < 8; ++j) { const int* ir = p.idx + (size_t)(tb + j) * 128; idv[j][0] = ir[lane]; idv[j][1] = ir[64 + lane]; }
#pragma unroll 1
        for (int x = 0; x < 8; ++x) {
            int n = 0;
#pragma unroll
            for (int j = 0; j < 8; ++j)
#pragma unroll
                for (int r = 0; r < 2; ++r) {
                    const int e = idv[j][r];
                    const bool in = (e >> 11) == x;
                    const unsigned long long mk = __ballot(in);
                    const int rank = (int)__builtin_amdgcn_mbcnt_hi((unsigned)(mk >> 32), __builtin_amdgcn_mbcnt_lo((unsigned)mk, 0u));
                    if (in) list[n + rank] = ((unsigned)j << 21) | ((unsigned)(r * 64 + lane) << 14) | (unsigned)e;
                    n += (int)__builtin_popcountll(mk);
                }
            asm volatile("s_waitcnt lgkmcnt(0)" ::: "memory");
            u32x4 ua[16], ubf[16]; int enta = 0, entb = 0;
            auto issue = [&](int b0, u32x4 (&uu)[16], int& entv) {
                const int i = (b0 + l15 < n) ? b0 + l15 : n - 1;
                entv = (int)list[i];
#pragma unroll
                for (int j = 0; j < 16; ++j) { const int e = __builtin_amdgcn_readlane(entv, j) & 0x3fff; uu[j] = *(const u32x4*)(p.u8 + (size_t)e * D_MODEL + lane16); }
            };
            auto reduce = [&](int b0, const u32x4 (&uu)[16], int entv) {
                int part[16];
#pragma unroll
                for (int j = 0; j < 16; ++j) {
                    const int tl = __builtin_amdgcn_readlane(entv, j) >> 21;
                    const u32x4 hqv = *(const u32x4*)(hql + tl * 1024 + lane * 16);
                    int sacc = __builtin_amdgcn_sdot4((int)uu[j].x, (int)hqv.x, 0, false);
                    sacc = __builtin_amdgcn_sdot4((int)uu[j].y, (int)hqv.y, sacc, false);
                    sacc = __builtin_amdgcn_sdot4((int)uu[j].z, (int)hqv.z, sacc, false);
                    part[j] = __builtin_amdgcn_sdot4((int)uu[j].w, (int)hqv.w, sacc, false);
                }
                const int r1 = reduce16_rows(part, b3, b2, b1, b0b);
                if (lane < 16 && b0 + lane < n) dotsl[((unsigned)entv >> 21) * 128 + (((unsigned)entv >> 14) & 127u)] = r1;
            };
            if (n > 0) issue(0, ua, enta);
            for (int b0 = 0; b0 < n; b0 += 32) {
                if (b0 + 16 < n) issue(b0 + 16, ubf, entb);
                reduce(b0, ua, enta);
                if (b0 + 16 < n) {
                    if (b0 + 32 < n) issue(b0 + 32, ua, enta);
                    reduce(b0 + 16, ubf, entb);
                }
            }
            asm volatile("s_waitcnt lgkmcnt(0)" ::: "memory");
        }
#pragma unroll
        for (int j = 0; j < 8; ++j) {
            const int hs_t = tks[4 * j]; const float cs_t = __int_as_float(tks[4 * j + 1]), r2_t = __int_as_float(tks[4 * j + 2]);
            const float* gr = p.gate + (size_t)(tb + j) * 128; float* cr = p.coef + (size_t)(tb + j) * 128;
#pragma unroll
            for (int r = 0; r < 2; ++r) {
                const int e = idv[j][r];
                const float sc = gr[r * 64 + lane] * r2_t;
                const float ex = __expf(sc - key2f(row_allmax_i(f2key(sc))));
                const float gt = ex / row_allsum_f(ex);
                const float dotf = (float)dotsl[j * 128 + r * 64 + lane] * cs_t * p.su[e];
                cr[r * 64 + lane] = gt * gelu_t(dotf) * p.sv[e];
            }
        }
        asm volatile("s_waitcnt lgkmcnt(0)" ::: "memory");
    }
}

__device__ void phase_gather(const Params& p, char* lds) {
    const int wave = __builtin_amdgcn_readfirstlane((int)((blockIdx.x * blockDim.x + threadIdx.x) >> 6)), nwaves = (gridDim.x * blockDim.x) >> 6, lane = threadIdx.x & 63;
    const unsigned char* vb = p.v8 + lane * 12;
    for (int t = wave; t < T_TOK; t += nwaves) {
        int idr[2]; float coef[2];
        { const int* ir = p.idx + (size_t)t * 128; idr[0] = ir[lane]; idr[1] = ir[64 + lane]; }
        { const float* cr = p.coef + (size_t)t * 128; coef[0] = cr[lane]; coef[1] = cr[64 + lane]; }
        const float cmax = wave_max(fmaxf(fabsf(coef[0]), fabsf(coef[1])));
        const float qs = cmax > 0.f ? 127.0f / cmax : 0.f, cscale = cmax * (1.0f / 127.0f);
        const int cq0 = (int)rintf(coef[0] * qs), cq1 = (int)rintf(coef[1] * qs);
        const int csum_i = wave_sum_i_uniform(cq0 + cq1);
        unsigned cpk[2];
        {
            const int cqs[2] = {cq0, cq1};
#pragma unroll
            for (int hf = 0; hf < 2; ++hf) {
                const int bb = cqs[hf] & 0xff;
                cpk[hf] = (unsigned)__builtin_amdgcn_update_dpp(0, bb, 0x00, 0xf, 0xf, false) | ((unsigned)__builtin_amdgcn_update_dpp(0, bb, 0x55, 0xf, 0xf, false) << 8)
                        | ((unsigned)__builtin_amdgcn_update_dpp(0, bb, 0xAA, 0xf, 0xf, false) << 16) | ((unsigned)__builtin_amdgcn_update_dpp(0, bb, 0xFF, 0xf, 0xf, false) << 24);
            }
        }
        int acc[16];
#pragma unroll
        for (int j = 0; j < 16; ++j) acc[j] = 0;
        {
            u32x3 va[8], vbf[8];
            auto issue = [&](int pb, u32x3 (&vv)[8]) {
#pragma unroll
                for (int q = 0; q < 8; ++q) { const int e = __builtin_amdgcn_readlane(pb < 64 ? idr[0] : idr[1], (pb & 63) + q); vv[q] = *(const u32x3*)(vb + (size_t)e * ROWB); }
            };
            auto axpy = [&](int pb, const u32x3 (&vv)[8]) {
#pragma unroll
                for (int g4 = 0; g4 < 2; ++g4) {
                    const int cqd = __builtin_amdgcn_readlane((int)(pb < 64 ? cpk[0] : cpk[1]), (pb & 63) + 4 * g4);
                    unsigned dd[4][4];
#pragma unroll
                    for (int r = 0; r < 4; ++r) {
                        const unsigned w0 = vv[4 * g4 + r].x, w1 = vv[4 * g4 + r].y, w2 = vv[4 * g4 + r].z;
                        dd[r][0] = w0 & 0x3f3f3f3fu; dd[r][1] = w1 & 0x3f3f3f3fu; dd[r][2] = w2 & 0x3f3f3f3fu;
                        dd[r][3] = ((w0 >> 6) & 0x03030303u) | ((w1 >> 4) & 0x0c0c0c0cu) | ((w2 >> 2) & 0x30303030u);
                    }
#pragma unroll
                    for (int k = 0; k < 4; ++k) {
                        const unsigned p0 = __builtin_amdgcn_perm(dd[1][k], dd[0][k], 0x05010400u), p1 = __builtin_amdgcn_perm(dd[1][k], dd[0][k], 0x07030602u);
                        const unsigned q0 = __builtin_amdgcn_perm(dd[3][k], dd[2][k], 0x05010400u), q1 = __builtin_amdgcn_perm(dd[3][k], dd[2][k], 0x07030602u);
                        const unsigned t0 = __builtin_amdgcn_perm(q0, p0, 0x05040100u), t1 = __builtin_amdgcn_perm(q0, p0, 0x07060302u);
                        const unsigned t2 = __builtin_amdgcn_perm(q1, p1, 0x05040100u), t3 = __builtin_amdgcn_perm(q1, p1, 0x07060302u);
                        acc[4 * k + 0] = __builtin_amdgcn_sdot4((int)t0, cqd, acc[4 * k + 0], false);
                        acc[4 * k + 1] = __builtin_amdgcn_sdot4((int)t1, cqd, acc[4 * k + 1], false);
                        acc[4 * k + 2] = __builtin_amdgcn_sdot4((int)t2, cqd, acc[4 * k + 2], false);
                        acc[4 * k + 3] = __builtin_amdgcn_sdot4((int)t3, cqd, acc[4 * k + 3], false);
                    }
                }
            };
            issue(0, va);
#pragma unroll 1
            for (int pb = 0; pb < 128; pb += 16) {
                issue(pb + 8, vbf);
                axpy(pb, va);
                if (pb + 16 < 128) issue(pb + 16, va);
                axpy(pb + 8, vbf);
            }
        }
        const u32x4* hr = (const u32x4*)(p.hb + (size_t)t * D_MODEL + lane * 16);
        const u32x4 ha = hr[0], hc = hr[1];
        const float hf16[16] = {bflo(ha.x), bfhi(ha.x), bflo(ha.y), bfhi(ha.y), bflo(ha.z), bfhi(ha.z), bflo(ha.w), bfhi(ha.w),
                                bflo(hc.x), bfhi(hc.x), bflo(hc.y), bfhi(hc.y), bflo(hc.z), bfhi(hc.z), bflo(hc.w), bfhi(hc.w)};
        float res[16];
        float ss = 0.f;
#pragma unroll
        for (int j = 0; j < 16; ++j) { res[j] = hf16[j] + cscale * (float)(acc[j] - 32 * csum_i); ss += res[j] * res[j]; }
        ss = wave_sum(ss);
        const float r3 = rsqrtf(ss * (1.0f / D_MODEL) + EPS);
        float* o = p.out + (size_t)t * D_MODEL + lane * 16;
        const float* fg = p.final_g + lane * 16;
#pragma unroll
        for (int i = 0; i < 4; ++i) {
            const float4 g = ((const float4*)fg)[i];
            float4 ov; ov.x = res[4 * i] * r3 * g.x; ov.y = res[4 * i + 1] * r3 * g.y; ov.z = res[4 * i + 2] * r3 * g.z; ov.w = res[4 * i + 3] * r3 * g.w;
            ((float4*)o)[i] = ov;
        }
    }
}

namespace pg8 {
#define PG8_LAS __attribute__((address_space(3)))
constexpr int BM = 256, BK = 64, HALF = 128, HTB = HALF * BK * 2, STAGE_BYTES = 8 * HTB, NXCD = 8, WGM = 8;
__host__ __device__ __forceinline__ int lds_byte(int r, int c) { const int st = (r >> 4) * 2 + (c >> 5), rr = r & 15, cc = c & 31, ob = rr * 64 + cc * 2; return st * 1024 + (ob ^ (((ob >> 9) & 1) << 5)); }
__host__ __device__ __forceinline__ void stage_rc(int b, int& R, int& C) { const int st = b / 1024, sb = b % 1024, swz = sb ^ (((sb >> 9) & 1) << 5); R = (st >> 1) * 16 + swz / 64; C = (st & 1) * 32 + (swz % 64) / 2; }
__host__ __device__ __forceinline__ int perm32(int rho) { const int n = rho >> 4, i = rho & 15; return 8 * (i >> 2) + 4 * n + (i & 3); }
struct Unit { int pm, pn; };
struct Gemm { const bf16_t* A; const bf16_t* Bt; int M, N, K; };
struct StaticOrder {
    int nM, nN, nwg, G, c;
    __host__ __device__ void init(int M, int N, int G_, int c_) { nM = M / BM; nN = N / BM; nwg = nM * nN; G = G_; c = c_; }
    __host__ __device__ bool next(int i, Unit& u) const {
        const long L = (long)i * G + c; if (L >= nwg) return false;
        int wgid = (int)L; { const int q = nwg / NXCD, r = nwg % NXCD, xcd = wgid % NXCD, off = wgid / NXCD; wgid = (xcd < r ? xcd * (q + 1) : r * (q + 1) + (xcd - r) * q) + off; }
        const int nig = WGM * nN, gid = wgid / nig, fm = gid * WGM, gsz = (nM - fm) < WGM ? (nM - fm) : WGM;
        u.pm = fm + ((wgid % nig) % gsz); u.pn = (wgid % nig) / gsz; return true;
    }
    __device__ __forceinline__ void a_ready(const Unit&) const {}
    __device__ __forceinline__ void done(const Unit&) const {}
};
__device__ __forceinline__ unsigned cvt_pk_bf16(float lo, float hi) { unsigned r; asm volatile("v_cvt_pk_bf16_f32 %0, %1, %2" : "=v"(r) : "v"(lo), "v"(hi)); return r; }
struct EpiZ {
    static constexpr bool PERM = true, AFTER_DRAIN = false;
    bf16_t* O; const float* rs;
    __device__ __forceinline__ void operator()(const f32x4 (&acc)[2][2][4][2], const Unit& u, int wr, int wc, int fr, int fq) const {
        const int row0 = u.pm * BM + wr * 64 + fr, col0 = u.pn * BM + wc * 32 + 8 * fq; const bool act = u.pn >= 2;
#pragma unroll
        for (int ai = 0; ai < 2; ++ai)
#pragma unroll
            for (int m = 0; m < 4; ++m) { const int r = row0 + ai * HALF + m * 16; const float sc = rs[r]; bf16_t* rowp = O + (size_t)r * D_IN + col0;
#pragma unroll
                for (int bj = 0; bj < 2; ++bj) { f32x4 v0 = acc[ai][bj][m][0] * sc, v1 = acc[ai][bj][m][1] * sc;
                    if (act) { v0 = (f32x4){gelu_t(v0[0]), gelu_t(v0[1]), gelu_t(v0[2]), gelu_t(v0[3])}; v1 = (f32x4){gelu_t(v1[0]), gelu_t(v1[1]), gelu_t(v1[2]), gelu_t(v1[3])}; }
                    u32x4 w; w.x = cvt_pk_bf16(v0[0], v0[1]); w.y = cvt_pk_bf16(v0[2], v0[3]); w.z = cvt_pk_bf16(v1[0], v1[1]); w.w = cvt_pk_bf16(v1[2], v1[3]);
                    *(u32x4*)(rowp + bj * HALF) = w; } }
    }
};
struct EpiOut {
    static constexpr bool PERM = true, AFTER_DRAIN = false;
    bf16_t* O; const float* X;
    __device__ __forceinline__ void operator()(const f32x4 (&acc)[2][2][4][2], const Unit& u, int wr, int wc, int fr, int fq) const {
        const int row0 = u.pm * BM + wr * 64 + fr, col0 = u.pn * BM + wc * 32 + 8 * fq;
#pragma unroll
        for (int ai = 0; ai < 2; ++ai)
#pragma unroll
            for (int m = 0; m < 4; ++m) { const size_t off = (size_t)(row0 + ai * HALF + m * 16) * D_MODEL + col0;
#pragma unroll
                for (int bj = 0; bj < 2; ++bj) { const f32x4 x0 = *(const f32x4*)(X + off + bj * HALF), x1 = *(const f32x4*)(X + off + bj * HALF + 4);
                    const f32x4 v0 = acc[ai][bj][m][0] + x0, v1 = acc[ai][bj][m][1] + x1;
                    u32x4 w; w.x = cvt_pk_bf16(v0[0], v0[1]); w.y = cvt_pk_bf16(v0[2], v0[3]); w.z = cvt_pk_bf16(v1[0], v1[1]); w.w = cvt_pk_bf16(v1[2], v1[3]);
                    *(u32x4*)(O + off + bj * HALF) = w; } }
    }
};
struct EpiQ {
    static constexpr bool PERM = true, AFTER_DRAIN = false;
    bf16_t* O; const float* rs;
    __device__ __forceinline__ void operator()(const f32x4 (&acc)[2][2][4][2], const Unit& u, int wr, int wc, int fr, int fq) const {
        const int row0 = u.pm * BM + wr * 64 + fr, col0 = u.pn * BM + wc * 32 + 8 * fq;
#pragma unroll
        for (int ai = 0; ai < 2; ++ai)
#pragma unroll
            for (int m = 0; m < 4; ++m) { const int r = row0 + ai * HALF + m * 16; const float sc = rs[r]; bf16_t* rowp = O + (size_t)r * 2048 + col0;
#pragma unroll
                for (int bj = 0; bj < 2; ++bj) { const f32x4 v0 = acc[ai][bj][m][0] * sc, v1 = acc[ai][bj][m][1] * sc;
                    u32x4 w; w.x = cvt_pk_bf16(v0[0], v0[1]); w.y = cvt_pk_bf16(v0[2], v0[3]); w.z = cvt_pk_bf16(v1[0], v1[1]); w.w = cvt_pk_bf16(v1[2], v1[3]);
                    *(u32x4*)(rowp + bj * HALF) = w; } }
    }
};
struct OneUnit {
    Unit u;
    __device__ __forceinline__ bool next(int i, Unit& o) const { if (i) return false; o = u; return true; }
    __device__ __forceinline__ void a_ready(const Unit&) const {}
    __device__ __forceinline__ void done(const Unit&) const {}
};
#define QT_PITCH 272
#define QT_LDS_BYTES (2 * 256 * QT_PITCH)
struct EpiQTopk {
    static constexpr bool PERM = true, AFTER_DRAIN = true;
    const float* rs; const bf16_t* keysB; int* idx; float* gate;
    __device__ __forceinline__ void fused(f32x4 (&acc)[2][2][4][2], const Unit& u, int wr, int wc, int fr, int fq, PG8_LAS unsigned char* ldsp, int wid, int lane) const {
        char* sQ = (char*)ldsp;
        const int h = u.pn;
#pragma unroll
        for (int ai = 0; ai < 2; ++ai)
#pragma unroll
            for (int m = 0; m < 4; ++m) { const int r = ai * HALF + wr * 64 + m * 16 + fr;
#pragma unroll
                for (int bj = 0; bj < 2; ++bj) { const f32x4 v0 = acc[ai][bj][m][0], v1 = acc[ai][bj][m][1];
                    u32x4 w; w.x = cvt_pk_bf16(v0[0], v0[1]); w.y = cvt_pk_bf16(v0[2], v0[3]); w.z = cvt_pk_bf16(v1[0], v1[1]); w.w = cvt_pk_bf16(v1[2], v1[3]);
                    *(u32x4*)(sQ + bj * (256 * QT_PITCH) + r * QT_PITCH + (wc * 32 + fq * 8) * 2) = w; } }
        __syncthreads();
        int cbv[4];
#pragma unroll
        for (int c = 0; c < 4; ++c) cbv[c] = kComb[4 * fr + c];
        int tA[2][4], tB[2][4];
#pragma unroll
        for (int m = 0; m < 2; ++m)
#pragma unroll
            for (int j = 0; j < 4; ++j) { tA[m][j] = 0; tB[m][j] = 0; }
#pragma unroll 1
        for (int pp = 0; pp < 2; ++pp) {
            const bf16_t* kb = keysB + (size_t)(pp * 8 + h) * 16384 + (size_t)fr * 128 + fq * 8;
            const char* qa = sQ + pp * (256 * QT_PITCH) + (wid * 32 + fr) * QT_PITCH + fq * 16;
            f32x4 sc2[2][8];
#pragma unroll
            for (int m = 0; m < 2; ++m)
#pragma unroll
                for (int nb = 0; nb < 8; ++nb) sc2[m][nb] = (f32x4){0.f, 0.f, 0.f, 0.f};
#pragma unroll
            for (int kk = 0; kk < 4; ++kk) {
                bf16x8 kf[8], af[2];
#pragma unroll
                for (int nb = 0; nb < 8; ++nb) kf[nb] = *(const bf16x8*)(kb + (size_t)nb * 16 * 128 + kk * 32);
#pragma unroll
                for (int m = 0; m < 2; ++m) af[m] = *(const bf16x8*)(qa + m * 16 * QT_PITCH + kk * 64);
#pragma unroll
                for (int m = 0; m < 2; ++m)
#pragma unroll
                    for (int nb = 0; nb < 8; ++nb) sc2[m][nb] = __builtin_amdgcn_mfma_f32_16x16x32_bf16(af[m], kf[nb], sc2[m][nb], 0, 0, 0);
            }
#pragma unroll
            for (int m = 0; m < 2; ++m)
#pragma unroll
                for (int j = 0; j < 4; ++j) tA[m][j] = tB[m][j];
#pragma unroll 2
            for (int it = 0; it < 4; ++it) {
#pragma unroll
                for (int m = 0; m < 2; ++m) {
                    int k[8];
#pragma unroll
                    for (int nb = 0; nb < 8; ++nb) k[nb] = (f2key(sc2[m][nb][0]) & ~127) | (127 - (16 * nb + fr));
                    const int r = top16_rows(k, fr);
                    tB[m][0] = tB[m][1]; tB[m][1] = tB[m][2]; tB[m][2] = tB[m][3]; tB[m][3] = r;
#pragma unroll
                    for (int nb = 0; nb < 8; ++nb) sc2[m][nb] = (f32x4){sc2[m][nb][1], sc2[m][nb][2], sc2[m][nb][3], sc2[m][nb][0]};
                }
            }
        }
#pragma unroll 2
        for (int it = 0; it < 4; ++it) {
#pragma unroll
            for (int m = 0; m < 2; ++m) {
                int eid; float gt;
                combine16(tA[m][0], tB[m][0], cbv, lane, fr, eid, gt);
                const int t = u.pm * BM + wid * 32 + m * 16 + fq * 4 + it;
                const size_t o = (size_t)t * 128 + h * 16 + fr;
                idx[o] = eid; gate[o] = gt;
                tA[m][0] = tA[m][1]; tA[m][1] = tA[m][2]; tA[m][2] = tA[m][3];
                tB[m][0] = tB[m][1]; tB[m][1] = tB[m][2]; tB[m][2] = tB[m][3];
            }
        }
        __syncthreads();
    }
};
template <class Epi, class Sched>
__device__ __forceinline__ void gemm_phase(PG8_LAS unsigned char* lds, const Gemm g, const Sched& S, const Epi& E) {
    const int tid = threadIdx.x, wid = __builtin_amdgcn_readfirstlane(tid >> 6), lane = tid & 63, wr = wid >> 2, wc = wid & 3, fr = lane & 15, fq = lane >> 4;
    const int K = g.K, nt = K / BK;
    unsigned voffA[2], voffB[2];
#pragma unroll
    for (int i = 0; i < 2; ++i) { int R, C; stage_rc(tid * 16 + i * 8192, R, C); const int Rb = Epi::PERM ? ((R & ~31) + perm32(R & 31)) : R;
        voffA[i] = (unsigned)(R * K + C) * 2u; voffB[i] = (unsigned)(Rb * K + C) * 2u; }
    const size_t kstep = (size_t)(BK * 2);
    const size_t hstep = (size_t)HALF * K * 2;
    const size_t tstep = 2 * hstep;
    const unsigned ldsw = (unsigned)wid * 1024u;
    const int aoff = lds_byte(wr * 64 + fr, fq * 8), boff = lds_byte(wc * 32 + fr, fq * 8);
#define PG8_SA(b, h) (((b) * 2 + (h)) * HTB)
#define PG8_SB(b, h) ((4 + (b) * 2 + (h)) * HTB)
#define PG8_STAGE(bufoff, gbase, voff) do { _Pragma("unroll") for (int _i = 0; _i < 2; ++_i) \
        __builtin_amdgcn_global_load_lds((const unsigned*)((const char*)(gbase) + (voff)[_i]), (PG8_LAS unsigned*)(lds + (bufoff) + ldsw + _i * 8192), 16, 0, 0); } while (0)
#define PG8_LDA(dst, b, h) do { _Pragma("unroll") for (int m = 0; m < 4; ++m) _Pragma("unroll") for (int k = 0; k < 2; ++k) dst[m][k] = *(const PG8_LAS bf16x8*)(lds + PG8_SA(b, h) + aoff + m * 2048 + k * 1024); } while (0)
#define PG8_LDB(dst, b, h) do { _Pragma("unroll") for (int n = 0; n < 2; ++n) _Pragma("unroll") for (int k = 0; k < 2; ++k) dst[n][k] = *(const PG8_LAS bf16x8*)(lds + PG8_SB(b, h) + boff + n * 2048 + k * 1024); } while (0)
#define PG8_MMA(ai, bj, At, Bt) do { __builtin_amdgcn_s_setprio(1); _Pragma("unroll") for (int m = 0; m < 4; ++m) _Pragma("unroll") for (int n = 0; n < 2; ++n) _Pragma("unroll") for (int k = 0; k < 2; ++k) \
        acc[ai][bj][m][n] = __builtin_amdgcn_mfma_f32_16x16x32_bf16(Bt[n][k], At[m][k], acc[ai][bj][m][n], 0, 0, 0); __builtin_amdgcn_s_setprio(0); } while (0)
#define PG8_WAIT_V(n) asm volatile("s_waitcnt vmcnt(" #n ")" ::: "memory")
#define PG8_WAIT_L(n) asm volatile("s_waitcnt lgkmcnt(" #n ")" ::: "memory")
#define PG8_BAR __builtin_amdgcn_s_barrier()
#define PG8_SCHED __builtin_amdgcn_sched_barrier(0)
    Unit cur, nxt; int ui = 0;
    if (!S.next(0, cur)) return;
    f32x4 acc[2][2][4][2];
#pragma unroll
    for (int a = 0; a < 2; ++a)
#pragma unroll
        for (int b = 0; b < 2; ++b)
#pragma unroll
            for (int m = 0; m < 4; ++m)
#pragma unroll
                for (int n = 0; n < 2; ++n) acc[a][b][m][n] = (f32x4){0.f, 0.f, 0.f, 0.f};
    bf16x8 At[4][2], B0[2][2], B1[2][2];
    const char* cA = (const char*)g.A + (size_t)cur.pm * tstep; const char* cB = (const char*)g.Bt + (size_t)cur.pn * tstep;
    S.a_ready(cur);
    PG8_STAGE(PG8_SB(0, 0), cB, voffB); PG8_STAGE(PG8_SA(0, 0), cA, voffA); PG8_STAGE(PG8_SB(0, 1), cB + hstep, voffB); PG8_STAGE(PG8_SA(0, 1), cA + hstep, voffA);
    if (wr == 1) PG8_BAR;
    PG8_WAIT_V(4); PG8_BAR;
    PG8_STAGE(PG8_SB(1, 0), cB + kstep, voffB); PG8_STAGE(PG8_SA(1, 0), cA + kstep, voffA); PG8_STAGE(PG8_SB(1, 1), cB + hstep + kstep, voffB);
    PG8_WAIT_V(6); PG8_BAR;
    for (;;) {
        const bool has_next = S.next(ui + 1, nxt);
        const char* nA = has_next ? (const char*)g.A + (size_t)nxt.pm * tstep : cA; const char* nB = has_next ? (const char*)g.Bt + (size_t)nxt.pn * tstep : cB;
        for (int t = 0; t < nt; t += 2) {
            const bool last = (t == nt - 2);
            const char* a1 = cA + (size_t)(t + 1) * kstep;
            const char* a2 = last ? nA : cA + (size_t)(t + 2) * kstep; const char* b2 = last ? nB : cB + (size_t)(t + 2) * kstep;
            const char* a3 = a2 + kstep; const char* b3 = b2 + kstep;
            if (last && has_next) S.a_ready(nxt);
            PG8_LDB(B0, 0, 0); PG8_SCHED; PG8_LDA(At, 0, 0); PG8_STAGE(PG8_SA(1, 1), a1 + hstep, voffA);
            PG8_WAIT_L(8); PG8_BAR; PG8_WAIT_L(0); PG8_MMA(0, 0, At, B0); PG8_BAR; PG8_SCHED;
            PG8_LDB(B1, 0, 1); PG8_STAGE(PG8_SB(0, 0), b2, voffB);
            PG8_BAR; PG8_WAIT_L(0); PG8_MMA(0, 1, At, B1); PG8_BAR;
            PG8_LDA(At, 0, 1); PG8_STAGE(PG8_SA(0, 0), a2, voffA);
            PG8_BAR; PG8_WAIT_L(0); PG8_MMA(1, 0, At, B0); PG8_BAR; PG8_SCHED;
            PG8_STAGE(PG8_SB(0, 1), b2 + hstep, voffB);
            PG8_WAIT_V(6); PG8_BAR; PG8_MMA(1, 1, At, B1); PG8_BAR;
            PG8_LDB(B0, 1, 0); PG8_SCHED; PG8_LDA(At, 1, 0); PG8_STAGE(PG8_SA(0, 1), a2 + hstep, voffA);
            PG8_WAIT_L(8); PG8_BAR; PG8_WAIT_L(0); PG8_MMA(0, 0, At, B0); PG8_BAR; PG8_SCHED;
            PG8_LDB(B1, 1, 1); PG8_STAGE(PG8_SB(1, 0), b3, voffB);
            PG8_BAR; PG8_WAIT_L(0); PG8_MMA(0, 1, At, B1); PG8_BAR;
            PG8_LDA(At, 1, 1); PG8_STAGE(PG8_SA(1, 0), a3, voffA);
            PG8_BAR; PG8_WAIT_L(0); PG8_MMA(1, 0, At, B0); PG8_BAR; PG8_SCHED;
            PG8_STAGE(PG8_SB(1, 1), b3 + hstep, voffB);
            PG8_WAIT_V(6); PG8_BAR; PG8_MMA(1, 1, At, B1); PG8_BAR;
        }
            if constexpr (!Epi::AFTER_DRAIN) { E(acc, cur, wr, wc, fr, fq); S.done(cur); }
            if (!has_next) break;
#pragma unroll
        for (int a = 0; a < 2; ++a)
#pragma unroll
            for (int b = 0; b < 2; ++b)
#pragma unroll
                for (int m = 0; m < 4; ++m)
#pragma unroll
                    for (int n = 0; n < 2; ++n) acc[a][b][m][n] = (f32x4){0.f, 0.f, 0.f, 0.f};
        cur = nxt; cA = nA; cB = nB; ++ui;
    }
    PG8_WAIT_V(0);
    if (wr == 0) PG8_BAR;
    PG8_BAR;
    if constexpr (Epi::AFTER_DRAIN) { E.fused(acc, cur, wr, wc, fr, fq, lds, wid, lane); S.done(cur); }
#undef PG8_SA
#undef PG8_SB
#undef PG8_STAGE
#undef PG8_LDA
#undef PG8_LDB
#undef PG8_MMA
#undef PG8_WAIT_V
#undef PG8_WAIT_L
#undef PG8_BAR
#undef PG8_SCHED
}
}

__device__ void phase_gemm_z(const Params& p, char* lds) {
    pg8::StaticOrder S; S.init(T_TOK, D_IN, gridDim.x, blockIdx.x);
    pg8::gemm_phase<pg8::EpiZ, pg8::StaticOrder>((PG8_LAS unsigned char*)lds, pg8::Gemm{p.xb, p.winT, T_TOK, D_IN, D_MODEL}, S, pg8::EpiZ{p.zb, p.rstd1});
}
__device__ void phase_gemm_out(const Params& p, char* lds) {
    pg8::StaticOrder S; S.init(T_TOK, D_MODEL, gridDim.x, blockIdx.x);
    pg8::gemm_phase<pg8::EpiOut, pg8::StaticOrder>((PG8_LAS unsigned char*)lds, pg8::Gemm{p.cB, p.woutT, T_TOK, D_MODEL, D_MODEL}, S, pg8::EpiOut{p.hb, p.x});
}
__device__ void phase_gemm_q(const Params& p, char* lds) {
    pg8::StaticOrder S; S.init(T_TOK, 2048, gridDim.x, blockIdx.x);
    pg8::Unit u;
    for (int i = 0; S.next(i, u); ++i)
        pg8::gemm_phase<pg8::EpiQTopk, pg8::OneUnit>((PG8_LAS unsigned char*)lds, pg8::Gemm{p.hb, p.wqT, T_TOK, 2048, D_MODEL}, pg8::OneUnit{u}, pg8::EpiQTopk{p.rstd2, p.keysB, p.idx, p.gate});
}

#define XB_TMO      128
#define XB_XCNT(j)  (256  + 64 * (j))
#define XB_XSUB(j)  (1280 + 64 * (j))
#define XB_XGEN(j)  (2304 + 64 * (j))
#define XB_TOP      3328
#define XB_TOPGEN   3392
#define XCD_BAR_WORDS 3456
#define XB_SPIN_CAP (1u << 20)
__device__ __forceinline__ unsigned xb_ld(unsigned* p)              { return __hip_atomic_load(p, __ATOMIC_RELAXED, __HIP_MEMORY_SCOPE_AGENT); }
__device__ __forceinline__ unsigned xb_add(unsigned* p, unsigned v) { return __hip_atomic_fetch_add(p, v, __ATOMIC_RELAXED, __HIP_MEMORY_SCOPE_AGENT); }
__device__ __forceinline__ unsigned xb_xcc_id() { return (unsigned)__builtin_amdgcn_s_getreg((3 << 11) | 20) & 0xFu; }
#define XB_SPIN(cond, bar) do { unsigned _sp = 0; while (cond) { __builtin_amdgcn_s_sleep(1); \
    if ((++_sp & 255u) == 0u) { if (xb_ld(&(bar)[XB_TMO])) break; if (_sp > XB_SPIN_CAP) { atomicAdd(&(bar)[XB_TMO], 1u); break; } } } } while (0)
struct XcdBarrier { unsigned* bar; unsigned x; volatile LAS unsigned* st; };
__device__ __forceinline__ XcdBarrier xcd_barrier_post(unsigned* bar, volatile LAS unsigned* st) {
    XcdBarrier b; b.bar = bar; b.x = xb_xcc_id(); b.st = st;
    if (threadIdx.x == 0) (void)xb_add(&bar[XB_XCNT(b.x)], 1u);
    return b;
}
__device__ __forceinline__ void xcd_barrier_complete(unsigned* bar, unsigned x, unsigned& nloc, unsigned& nx) {
    const unsigned G = gridDim.x * gridDim.y * gridDim.z;
    unsigned sum, cnt, mine, sp = 0u;
    for (;;) {
        sum = 0u; cnt = 0u; mine = 0u;
#pragma unroll
        for (unsigned j = 0; j < 16; ++j) { const unsigned c = xb_ld(&bar[XB_XCNT(j)]); sum += c; cnt += (c > 0u) ? 1u : 0u; mine = (j == x) ? c : mine; }
        if (sum == G) break;
        __builtin_amdgcn_s_sleep(1);
        if ((++sp & 255u) == 0u) { if (xb_ld(&bar[XB_TMO])) break; if (sp > XB_SPIN_CAP) { atomicAdd(&bar[XB_TMO], 1u); break; } }
    }
    nloc = mine > 0u ? mine : 1u; nx = cnt > 0u ? cnt : 1u;
}
__device__ __forceinline__ void xcd_barrier(const XcdBarrier& b) {
    asm volatile("s_waitcnt vmcnt(0)" ::: "memory");
    __syncthreads();
    if (threadIdx.x == 0) {
        unsigned* bar = b.bar;
        __builtin_amdgcn_s_waitcnt(0);
        unsigned nloc = b.st[0], nx = b.st[1];
        if (nloc == 0u) { xcd_barrier_complete(bar, b.x, nloc, nx); b.st[0] = nloc; b.st[1] = nx; }
        const unsigned old = xb_add(&bar[XB_XSUB(b.x)], 1u);
        const unsigned gen = old / nloc;
        if (old + 1u == (gen + 1u) * nloc) {
            __builtin_amdgcn_fence(__ATOMIC_RELEASE, "agent");
            asm volatile("s_waitcnt vmcnt(0)" ::: "memory");
            const unsigned og = xb_add(&bar[XB_TOP], 1u);
            const unsigned tg = og / nx;
            if (og + 1u == (tg + 1u) * nx) xb_add(&bar[XB_TOPGEN], 1u);
            else XB_SPIN(xb_ld(&bar[XB_TOPGEN]) == tg, bar);
            __builtin_amdgcn_fence(__ATOMIC_ACQUIRE, "agent");
            xb_add(&bar[XB_XGEN(b.x)], 1u);
            asm volatile("s_waitcnt vmcnt(0)" ::: "memory");
        } else {
            XB_SPIN(xb_ld(&bar[XB_XGEN(b.x)]) == gen, bar);
            __builtin_amdgcn_fence(__ATOMIC_ACQUIRE, "agent");
            asm volatile("s_waitcnt vmcnt(0)" ::: "memory");
        }
    }
    __syncthreads();
}

#define MEGA_LDS_MAIN (QT_LDS_BYTES > pg8::STAGE_BYTES ? QT_LDS_BYTES : pg8::STAGE_BYTES)
#define MEGA_LDS_BYTES (MEGA_LDS_MAIN + 16)
extern __shared__ __attribute__((aligned(16))) char smem[];
__global__ void __launch_bounds__(512, 2) fwd_mega(Params p) {
    volatile LAS unsigned* st = (volatile LAS unsigned*)(smem + MEGA_LDS_MAIN);
    if (threadIdx.x < 4) st[threadIdx.x] = 0u;
    __syncthreads();
    const XcdBarrier xb = xcd_barrier_post(p.bar, st);
    phase_prep(p, smem);      xcd_barrier(xb);
    phase_gemm_z(p, smem);    xcd_barrier(xb);
    phase_mix_prep(p, smem);  xcd_barrier(xb);
    phase_mix_gemm(p, smem);  xcd_barrier(xb);
    phase_gemm_out(p, smem);  xcd_barrier(xb);
    phase_gemm_q(p, smem);    xcd_barrier(xb);
    phase_peer_dots(p, smem); xcd_barrier(xb);
    phase_gather(p, smem);
}

extern "C" void kernel_launch(void* const* d_in, const int* in_sizes, int n_in, void* d_out, int out_size, void* d_ws, size_t ws_size, hipStream_t stream) {
    static int grid_blocks = 0;
    if (grid_blocks == 0) {
        int dev = 0, cus = 0, per_cu = 0;
        (void)hipGetDevice(&dev);
        (void)hipDeviceGetAttribute(&cus, hipDeviceAttributeMultiprocessorCount, dev);
        (void)hipFuncSetAttribute((const void*)fwd_mega, hipFuncAttributeMaxDynamicSharedMemorySize, MEGA_LDS_BYTES);
        (void)hipOccupancyMaxActiveBlocksPerMultiprocessor(&per_cu, (const void*)fwd_mega, 512, MEGA_LDS_BYTES);
        if (per_cu > 1) per_cu = 1;
        if (per_cu < 1) per_cu = 1;
        grid_blocks = cus * per_cu;
    }
    Params p{};
    p.x = (const float*)d_in[0]; p.norm1_g = (const float*)d_in[1]; p.w_in = (const float*)d_in[2]; p.pool_w = (const float*)d_in[3];
    p.pool_scale = (const float*)d_in[4]; p.sgu_norm_g = (const float*)d_in[5]; p.sgu_w = (const float*)d_in[6]; p.sgu_b = (const float*)d_in[7];
    p.w_out = (const float*)d_in[8]; p.norm2_g = (const float*)d_in[9]; p.peer_wq = (const float*)d_in[10]; p.peer_keys = (const float*)d_in[11];
    p.peer_u = (const float*)d_in[12]; p.peer_v = (const float*)d_in[13]; p.final_g = (const float*)d_in[14];
    p.out = (float*)d_out;
    char* w = (char*)d_ws; size_t off = 0;
    auto take = [&](size_t bytes) { char* r = w + off; off += (bytes + 255) & ~(size_t)255; return r; };
    const size_t MiB = 1024 * 1024;
    p.u8 = (unsigned char*)take(16 * MiB); p.v8 = (unsigned char*)take(12 * MiB); p.hs = (int*)take(128 * 1024); p.hq = (signed char*)take(32 * MiB);
    p.su = (float*)take(64 * 1024); p.sv = (float*)take(64 * 1024); p.sh = (float*)take(128 * 1024);
    p.winT = (bf16_t*)take(3 * MiB); p.woutT = (bf16_t*)take(2 * MiB); p.wqT = (bf16_t*)take(4 * MiB);
    p.poolT = (bf16_t*)take(128 * 1024); p.wsM = (bf16_t*)take(128 * 1024); p.keysB = (bf16_t*)take(512 * 1024);
    p.bar = (unsigned*)take(XCD_BAR_WORDS * 4);
    p.rstd1 = (float*)take(128 * 1024); p.rstd2 = (float*)take(128 * 1024); p.lnm = (float*)take(128 * 1024); p.lnr = (float*)take(128 * 1024);
    p.idx = (int*)take(16 * MiB); p.gate = (float*)take(16 * MiB); p.coef = (float*)take(16 * MiB);
    p.cB = (bf16_t*)take(64 * MiB); p.hb = (bf16_t*)take(64 * MiB);
    char* r1 = take(224 * MiB);
    p.xb = (bf16_t*)r1; p.zb = (bf16_t*)(r1 + 64 * MiB); p.dB = (bf16_t*)(r1 + 160 * MiB); p.vnT = (bf16_t*)(r1 + 192 * MiB);
    p.qB = (bf16_t*)r1;
    (void)hipMemsetAsync(p.bar, 0, XCD_BAR_WORDS * 4, stream);
    hipLaunchKernelGGL(fwd_mega, dim3(grid_blocks), dim3(512), MEGA_LDS_BYTES, stream, p);
}
```

```cpp
#include <hip/hip_runtime.h>
#include <stdint.h>
#include <type_traits>

typedef unsigned short bf16_t;
typedef short bf16x8 __attribute__((ext_vector_type(8)));
typedef float f32x4 __attribute__((ext_vector_type(4)));
typedef unsigned u32x4 __attribute__((ext_vector_type(4)));
typedef unsigned u32x2 __attribute__((ext_vector_type(2)));
typedef unsigned u32x3 __attribute__((ext_vector_type(3)));
#define ROWB 768
typedef __bf16 bf2_t __attribute__((ext_vector_type(2)));
#define LAS __attribute__((address_space(3)))

#define T_TOK 32768
#define D_MODEL 1024
#define D_IN 1536
#define SEQ 2048
#define NEXP 16384
#define EPS 1e-6f

struct Params {
    const float *x, *norm1_g, *w_in, *pool_w, *pool_scale, *sgu_norm_g, *sgu_w, *sgu_b, *w_out, *norm2_g, *peer_wq, *peer_keys, *peer_u, *peer_v, *final_g;
    float* out;
    bf16_t *winT, *woutT, *wqT, *poolT, *wsM, *keysB;
    unsigned char *u8; unsigned char *v8; signed char *hq; int* hs;
    float *su, *sv, *sh;
    float *rstd1, *rstd2, *lnm, *lnr;
    bf16_t *xb, *zb, *dB, *vnT, *cB, *hb, *qB;
    int* idx; float* gate; float* coef;
    unsigned* bar;
};

__device__ __forceinline__ int tid_opaque() { int t = (int)threadIdx.x; asm volatile("" : "+v"(t)); return t; }
__device__ __forceinline__ unsigned short f2bf(float f) {
    unsigned u = __float_as_uint(f);
    u += 0x7fffu + ((u >> 16) & 1u);
    return (unsigned short)(u >> 16);
}
__device__ __forceinline__ float bf2f(unsigned short h) { return __uint_as_float(((unsigned)h) << 16); }
__device__ __forceinline__ unsigned pack2(float a, float b) { return (unsigned)f2bf(a) | ((unsigned)f2bf(b) << 16); }
__device__ __forceinline__ float bflo(unsigned w) { return __uint_as_float(w << 16); }
__device__ __forceinline__ float bfhi(unsigned w) { return __uint_as_float(w & 0xffff0000u); }
__device__ __forceinline__ float gelu_t(float x) {
    const float y = 1.5957691216057308f * (x + 0.044715f * x * x * x);
    return x / (1.0f + __expf(-y));
}
__device__ __forceinline__ float wave_sum(float v) {
#pragma unroll
    for (int o = 32; o >= 1; o >>= 1) v += __shfl_xor(v, o);
    return v;
}
__device__ __forceinline__ float wave_max(float v) {
#pragma unroll
    for (int o = 32; o >= 1; o >>= 1) v = fmaxf(v, __shfl_xor(v, o));
    return v;
}

#define GEMM_LDS_BYTES (2 * 128 * 144)
template <bool SYNC_EPI = false, class Epi>
__device__ __forceinline__ void gemm128(const int tid, const bf16_t* __restrict__ A, int lda, const bf16_t* __restrict__ Bt, int ldb, int K, char* lds, const Epi& epi) {
    const int lane = tid & 63, wid = tid >> 6, wr = wid >> 1, wc = wid & 1, fr = lane & 15, fq = lane >> 4;
    constexpr int PITCH = 144;
    char* sA = lds; char* sB = lds + 128 * PITCH;
    f32x4 acc[4][4];
#pragma unroll
    for (int m = 0; m < 4; ++m)
#pragma unroll
        for (int n = 0; n < 4; ++n) acc[m][n] = (f32x4){0.f, 0.f, 0.f, 0.f};
    u32x4 ra[4], rb[4];
    const int lrow = tid >> 3, lch = tid & 7;
    const bf16_t* ga = A + (size_t)lrow * lda + lch * 8;
    const bf16_t* gb = Bt + (size_t)lrow * ldb + lch * 8;
#pragma unroll
    for (int j = 0; j < 4; ++j) { ra[j] = *(const u32x4*)(ga + (size_t)(32 * j) * lda); rb[j] = *(const u32x4*)(gb + (size_t)(32 * j) * ldb); }
    for (int k0 = 0; k0 < K; k0 += 64) {
        __syncthreads();
#pragma unroll
        for (int j = 0; j < 4; ++j) {
            *(u32x4*)(sA + (lrow + 32 * j) * PITCH + lch * 16) = ra[j];
            *(u32x4*)(sB + (lrow + 32 * j) * PITCH + lch * 16) = rb[j];
        }
        __syncthreads();
        if (k0 + 64 < K) {
#pragma unroll
            for (int j = 0; j < 4; ++j) { ra[j] = *(const u32x4*)(ga + (size_t)(32 * j) * lda + k0 + 64); rb[j] = *(const u32x4*)(gb + (size_t)(32 * j) * ldb + k0 + 64); }
        }
#pragma unroll
        for (int kk = 0; kk < 2; ++kk) {
            bf16x8 af[4], bfr[4];
#pragma unroll
            for (int m = 0; m < 4; ++m) af[m] = *(const bf16x8*)(sA + (wr * 64 + m * 16 + fr) * PITCH + (kk * 32 + fq * 8) * 2);
#pragma unroll
            for (int n = 0; n < 4; ++n) bfr[n] = *(const bf16x8*)(sB + (wc * 64 + n * 16 + fr) * PITCH + (kk * 32 + fq * 8) * 2);
#pragma unroll
            for (int m = 0; m < 4; ++m)
#pragma unroll
                for (int n = 0; n < 4; ++n) acc[m][n] = __builtin_amdgcn_mfma_f32_16x16x32_bf16(bfr[n], af[m], acc[m][n], 0, 0, 0);
        }
    }
    if (SYNC_EPI) __syncthreads();
#pragma unroll
    for (int m = 0; m < 4; ++m)
#pragma unroll
        for (int n = 0; n < 4; ++n) epi(wr * 64 + m * 16 + fr, wc * 64 + n * 16 + fq * 4, acc[m][n]);
}

__device__ __forceinline__ void transpose_tile(const int tid, const float* __restrict__ src, bf16_t* __restrict__ dst, int R, int C, const float* __restrict__ rscale, int tile, float* lds) {
    const int tilesC = C / 64, tr = tile / tilesC, tc = tile % tilesC;
    const int ty = tid >> 6, tx = tid & 63;
    __syncthreads();
#pragma unroll
    for (int i = 0; i < 16; ++i) {
        const int r = ty + 4 * i;
        float v = src[(size_t)(tr * 64 + r) * C + tc * 64 + tx];
        if (rscale) v *= rscale[tr * 64 + r];
        lds[r * 65 + tx] = v;
    }
    __syncthreads();
#pragma unroll
    for (int i = 0; i < 16; ++i) {
        const int c = ty + 4 * i;
        dst[(size_t)(tc * 64 + c) * R + tr * 64 + tx] = f2bf(lds[tx * 65 + c]);
    }
}

__device__ void phase_prep(const Params& p, char* lds) {
    const int tidx_ = tid_opaque();
    const int nb = gridDim.x, b = blockIdx.x, tid = tidx_;
    const int half = tid >> 8, ht = tid & 255, nh = 2 * nb, hb2 = 2 * b + half;
    float* fl = (float*)(lds + half * (64 * 65 * 4));
    for (int t = hb2; t < 16 * 24; t += nh) transpose_tile(ht, p.w_in, p.winT, 1024, 1536, p.norm1_g, t, fl);
    for (int t = hb2; t < 16 * 16; t += nh) transpose_tile(ht, p.w_out, p.woutT, 1024, 1024, nullptr, t, fl);
    for (int t = hb2; t < 16 * 32; t += nh) transpose_tile(ht, p.peer_wq, p.wqT, 1024, 2048, p.norm2_g, t, fl);
    for (int t = hb2; t < 16; t += nh) transpose_tile(ht, p.pool_w + (size_t)(t >> 2) * 16384, p.poolT + (size_t)(t >> 2) * 16384, 128, 128, nullptr, t & 3, fl);
    const size_t gtid = (size_t)b * blockDim.x + tid, gsz = (size_t)nb * blockDim.x;
    for (size_t i = gtid; i < 4 * 128 * 128; i += gsz) {
        const int j = (int)(i & 127), ii = (int)((i >> 7) & 127);
        const bool keep = (j >> 6) <= (ii >> 6);
        p.wsM[i] = keep ? f2bf(p.sgu_w[i]) : (bf16_t)0;
    }
    for (size_t i = gtid; i < 2 * 8 * 128 * 128; i += gsz) p.keysB[i] = f2bf(p.peer_keys[i]);
    {
        const int wave = (b * blockDim.x + tid) >> 6, nwaves = (nb * blockDim.x) >> 6, lane = tid & 63;
        float g16[16];
#pragma unroll
        for (int i = 0; i < 4; ++i) { const float4 g = ((const float4*)(p.norm2_g + lane * 16))[i]; g16[4 * i] = g.x; g16[4 * i + 1] = g.y; g16[4 * i + 2] = g.z; g16[4 * i + 3] = g.w; }
        auto quant_row = [&](const float (&f)[16], unsigned char* dst, float* scale_out) {
            float am = 0.f;
#pragma unroll
            for (int j = 0; j < 16; ++j) am = fmaxf(am, fabsf(f[j]));
            am = wave_max(am);
            const float inv = am > 0.f ? 31.0f / am : 0.f;
            int q[16];
#pragma unroll
            for (int j = 0; j < 16; ++j) q[j] = (int)rintf(f[j] * inv) + 32;
            u32x3 o;
#pragma unroll
            for (int i = 0; i < 3; ++i) {
                unsigned w = 0;
#pragma unroll
                for (int k = 0; k < 4; ++k) w |= (unsigned)(q[4 * i + k] | (((q[12 + k] >> (2 * i)) & 3) << 6)) << (8 * k);
                o[i] = w;
            }
            *(u32x3*)(dst + lane * 12) = o;
            if (lane == 0) *scale_out = am * (1.0f / 31.0f);
        };
        for (int e = wave; e < NEXP; e += nwaves) {
            const float4* su4 = (const float4*)(p.peer_u + (size_t)e * D_MODEL + lane * 16);
            const float4* sv4 = (const float4*)(p.peer_v + (size_t)e * D_MODEL + lane * 16);
            float4 a4[4], b4[4];
#pragma unroll
            for (int i = 0; i < 4; ++i) { a4[i] = su4[i]; b4[i] = sv4[i]; }
            float fu[16], fv[16];
#pragma unroll
            for (int i = 0; i < 4; ++i) {
                fu[4 * i] = a4[i].x * g16[4 * i]; fu[4 * i + 1] = a4[i].y * g16[4 * i + 1]; fu[4 * i + 2] = a4[i].z * g16[4 * i + 2]; fu[4 * i + 3] = a4[i].w * g16[4 * i + 3];
                fv[4 * i] = b4[i].x; fv[4 * i + 1] = b4[i].y; fv[4 * i + 2] = b4[i].z; fv[4 * i + 3] = b4[i].w;
            }
            {
                float am = 0.f;
#pragma unroll
                for (int j = 0; j < 16; ++j) am = fmaxf(am, fabsf(fu[j]));
                am = wave_max(am);
                const float inv = am > 0.f ? 127.0f / am : 0.f;
                u32x4 o;
#pragma unroll
                for (int i = 0; i < 4; ++i) {
                    unsigned w = 0;
#pragma unroll
                    for (int k = 0; k < 4; ++k) w |= (unsigned)(((int)rintf(fu[4 * i + k] * inv)) & 0xff) << (8 * k);
                    o[i] = w;
                }
                *(u32x4*)(p.u8 + (size_t)e * D_MODEL + lane * 16) = o;
                if (lane == 0) p.su[e] = am * (1.0f / 127.0f);
            }
            quant_row(fv, p.v8 + (size_t)e * ROWB, p.sv + e);
        }
    }
    const int wave = (b * blockDim.x + tid) >> 6, nwaves = (nb * blockDim.x) >> 6, lane = tid & 63;
    for (int t = wave; t < T_TOK; t += 2 * nwaves) {
        const int t1 = t + nwaves; const bool two = t1 < T_TOK;
        const float4* xr0 = (const float4*)(p.x + (size_t)t * D_MODEL);
        const float4* xr1 = (const float4*)(p.x + (size_t)(two ? t1 : t) * D_MODEL);
        float4 v0[4], v1[4];
#pragma unroll
        for (int i = 0; i < 4; ++i) { v0[i] = xr0[lane + 64 * i]; v1[i] = xr1[lane + 64 * i]; }
        float s0 = 0.f, s1 = 0.f;
#pragma unroll
        for (int i = 0; i < 4; ++i) {
            s0 += v0[i].x * v0[i].x + v0[i].y * v0[i].y + v0[i].z * v0[i].z + v0[i].w * v0[i].w;
            s1 += v1[i].x * v1[i].x + v1[i].y * v1[i].y + v1[i].z * v1[i].z + v1[i].w * v1[i].w;
            uint2 o; o.x = pack2(v0[i].x, v0[i].y); o.y = pack2(v0[i].z, v0[i].w);
            ((uint2*)(p.xb + (size_t)t * D_MODEL))[lane + 64 * i] = o;
            if (two) { uint2 o1; o1.x = pack2(v1[i].x, v1[i].y); o1.y = pack2(v1[i].z, v1[i].w); ((uint2*)(p.xb + (size_t)t1 * D_MODEL))[lane + 64 * i] = o1; }
        }
        s0 = wave_sum(s0); s1 = wave_sum(s1);
        if (lane == 0) { p.rstd1[t] = rsqrtf(s0 * (1.0f / D_MODEL) + EPS); if (two) p.rstd1[t1] = rsqrtf(s1 * (1.0f / D_MODEL) + EPS); }
    }
}

__device__ void phase_mix_prep(const Params& p, char* lds) {
    const size_t gtid = (size_t)blockIdx.x * blockDim.x + threadIdx.x, gsz = (size_t)gridDim.x * blockDim.x;
    {
        const int gw = (int)(gtid >> 6), ngw = (int)(gsz >> 6), ln = threadIdx.x & 63;
        for (int item = gw; item < (T_TOK / 4) * 4; item += ngw) {
            const int g = item & 3, t = (item >> 2) * 4 + (ln >> 4), c8 = g * 16 + (ln & 15), pos = t & (SEQ - 1);
            const bf16_t* zp = p.zb + (size_t)t * D_IN + c8 * 8;
            float s[8];
#pragma unroll
            for (int j = 0; j < 8; ++j) s[j] = 0.f;
            uint4 self = make_uint4(0, 0, 0, 0);
            auto body = [&](auto WC) {
                constexpr int W = decltype(WC)::value;
                uint4 v[W];
#pragma unroll
                for (int k = 0; k < W; ++k) v[k] = *(const uint4*)(zp - (size_t)(k <= pos ? k : 0) * D_IN);
                self = v[0];
#pragma unroll
                for (int k = 0; k < W; ++k) {
                    const float m = (k <= pos) ? 1.f : 0.f;
                    s[0] += m * bflo(v[k].x); s[1] += m * bfhi(v[k].x); s[2] += m * bflo(v[k].y); s[3] += m * bfhi(v[k].y);
                    s[4] += m * bflo(v[k].z); s[5] += m * bfhi(v[k].z); s[6] += m * bflo(v[k].w); s[7] += m * bfhi(v[k].w);
                }
            };
            if (g == 0) body(std::integral_constant<int, 2>{}); else if (g == 1) body(std::integral_constant<int, 4>{});
            else if (g == 2) body(std::integral_constant<int, 8>{}); else body(std::integral_constant<int, 16>{});
            const int w = 2 << g, n = (pos + 1 < w) ? pos + 1 : w;
            const float fn = (float)n;
            uint4 o;
            o.x = pack2(s[0] / fn - bflo(self.x), s[1] / fn - bfhi(self.x));
            o.y = pack2(s[2] / fn - bflo(self.y), s[3] / fn - bfhi(self.y));
            o.z = pack2(s[4] / fn - bflo(self.z), s[5] / fn - bfhi(self.z));
            o.w = pack2(s[6] / fn - bflo(self.w), s[7] / fn - bfhi(self.w));
            *(uint4*)(p.dB + (size_t)t * 512 + c8 * 8) = o;
        }
    }
    const int wave = (int)(gtid >> 6), nwaves = (int)(gsz >> 6), lane = threadIdx.x & 63;
    for (int t = wave; t < T_TOK; t += nwaves) {
        const uint4 v = *(const uint4*)(p.zb + (size_t)t * D_IN + 1024 + lane * 8);
        float f[8] = {bflo(v.x), bfhi(v.x), bflo(v.y), bfhi(v.y), bflo(v.z), bfhi(v.z), bflo(v.w), bfhi(v.w)};
        float s = 0.f;
#pragma unroll
        for (int j = 0; j < 8; ++j) s += f[j];
        const float mean = wave_sum(s) * (1.0f / 512.0f);
        float q = 0.f;
#pragma unroll
        for (int j = 0; j < 8; ++j) { f[j] -= mean; q += f[j] * f[j]; }
        const float rstd = rsqrtf(wave_sum(q) * (1.0f / 512.0f) + EPS);
        if (lane == 0) { p.lnm[t] = mean; p.lnr[t] = rstd; }
    }
}

typedef short s16x4 __attribute__((ext_vector_type(4)));
template <class Epi>
__device__ __forceinline__ void gemm128_sgu(const int tid, const bf16_t* __restrict__ A, const bf16_t* __restrict__ V  ,
                                            const float* __restrict__ lnm, const float* __restrict__ lnr, const float* __restrict__ gch, char* lds, const Epi& epi) {
    const int lane = tid & 63, wid = tid >> 6, wr = wid >> 1, wc = wid & 1, fr = lane & 15, fq = lane >> 4;
    constexpr int PITCH = 144, P2 = 288;
    char* sA = lds; char* sB = lds + 128 * PITCH;
    f32x4 acc[4][4];
#pragma unroll
    for (int m = 0; m < 4; ++m)
#pragma unroll
        for (int n = 0; n < 4; ++n) acc[m][n] = (f32x4){0.f, 0.f, 0.f, 0.f};
    u32x4 ra[4], rb[4]; float rm[4], rr[4];
    const int lrow = tid >> 3, lch = tid & 7;
    const int btok = tid >> 4, bch = tid & 15;
    const bf16_t* ga = A + (size_t)lrow * 128 + lch * 8;
    const bf16_t* gb = V + (size_t)btok * D_IN + bch * 8;
    float g8[8];
    { const float4 g0 = *(const float4*)(gch + bch * 8), g1 = *(const float4*)(gch + bch * 8 + 4); g8[0] = g0.x; g8[1] = g0.y; g8[2] = g0.z; g8[3] = g0.w; g8[4] = g1.x; g8[5] = g1.y; g8[6] = g1.z; g8[7] = g1.w; }
#pragma unroll
    for (int j = 0; j < 4; ++j) { ra[j] = *(const u32x4*)(ga + (size_t)(32 * j) * 128); rb[j] = *(const u32x4*)(gb + (size_t)(16 * j) * D_IN); rm[j] = lnm[btok + 16 * j]; rr[j] = lnr[btok + 16 * j]; }
    for (int k0 = 0; k0 < 128; k0 += 64) {
        __syncthreads();
#pragma unroll
        for (int j = 0; j < 4; ++j) {
            *(u32x4*)(sA + (lrow + 32 * j) * PITCH + lch * 16) = ra[j];
            u32x4 o;
#pragma unroll
            for (int i = 0; i < 4; ++i) {
                const unsigned w = rb[j][i];
                o[i] = pack2((bflo(w) - rm[j]) * rr[j] * g8[2 * i], (bfhi(w) - rm[j]) * rr[j] * g8[2 * i + 1]);
            }
            *(u32x4*)(sB + (btok + 16 * j) * P2 + bch * 16) = o;
        }
        __syncthreads();
        if (k0 + 64 < 128) {
#pragma unroll
            for (int j = 0; j < 4; ++j) { ra[j] = *(const u32x4*)(ga + (size_t)(32 * j) * 128 + 64); rb[j] = *(const u32x4*)(gb + (size_t)(64 + 16 * j) * D_IN); rm[j] = lnm[64 + btok + 16 * j]; rr[j] = lnr[64 + btok + 16 * j]; }
        }
#pragma unroll
        for (int kk = 0; kk < 2; ++kk) {
            bf16x8 af[4], bfr[4];
#pragma unroll
            for (int m = 0; m < 4; ++m) af[m] = *(const bf16x8*)(sA + (wr * 64 + m * 16 + fr) * PITCH + (kk * 32 + fq * 8) * 2);
#pragma unroll
            for (int n = 0; n < 4; ++n) {
                const char* bp = sB + (kk * 32 + fq * 8 + (fr >> 2)) * P2 + (wc * 64 + n * 16 + 4 * (fr & 3)) * 2;
                const s16x4 lo = __builtin_amdgcn_ds_read_tr16_b64_v4i16((LAS s16x4*)(bp));
                const s16x4 hi = __builtin_amdgcn_ds_read_tr16_b64_v4i16((LAS s16x4*)(bp + 4 * P2));
                bfr[n] = (bf16x8){lo[0], lo[1], lo[2], lo[3], hi[0], hi[1], hi[2], hi[3]};
            }
#pragma unroll
            for (int m = 0; m < 4; ++m)
#pragma unroll
                for (int n = 0; n < 4; ++n) acc[m][n] = __builtin_amdgcn_mfma_f32_16x16x32_bf16(bfr[n], af[m], acc[m][n], 0, 0, 0);
        }
    }
#pragma unroll
    for (int m = 0; m < 4; ++m)
#pragma unroll
        for (int n = 0; n < 4; ++n) epi(wr * 64 + m * 16 + fr, wc * 64 + n * 16 + fq * 4, acc[m][n]);
}

#define PT_PITCH 272
#define MIXH_LDS (2 * 128 * PT_PITCH + 1024)
template <int W, class Epi>
__device__ __forceinline__ void pool_tile(const int tid, const bf16_t* __restrict__ zb0  , int pos0,
                                          const bf16_t* __restrict__ Bt, char* lds, const Epi& epi) {
    const int lane = tid & 63, wid = tid >> 6, wr = wid >> 1, wc = wid & 1, fr = lane & 15, fq = lane >> 4;
    char* sA = lds; char* sB = lds + 128 * PT_PITCH;
    __syncthreads();
#pragma unroll
    for (int j = 0; j < 8; ++j) { const int id = tid + 256 * j, row = id >> 4, ch = id & 15; *(u32x4*)(sB + row * PT_PITCH + ch * 16) = *(const u32x4*)(Bt + (size_t)row * 128 + ch * 8); }
#pragma unroll 1
    for (int j = 0; j < 8; ++j) {
        const int id = tid + 256 * j, row = id >> 4, ch = id & 15, pos = (pos0 + row) & (SEQ - 1);
        const bf16_t* zp = zb0 + (size_t)row * D_IN + ch * 8;
        u32x4 v[W];
#pragma unroll
        for (int k = 0; k < W; ++k) v[k] = *(const u32x4*)(zp - (size_t)(k <= pos ? k : 0) * D_IN);
        float sm[8];
#pragma unroll
        for (int i = 0; i < 8; ++i) sm[i] = 0.f;
#pragma unroll
        for (int k = 0; k < W; ++k) {
            const float m = (k <= pos) ? 1.f : 0.f;
#pragma unroll
            for (int i = 0; i < 4; ++i) { sm[2 * i] += m * bflo(v[k][i]); sm[2 * i + 1] += m * bfhi(v[k][i]); }
        }
        const float fn = (float)((pos + 1 < W) ? pos + 1 : W);
        u32x4 o;
#pragma unroll
        for (int i = 0; i < 4; ++i) o[i] = pack2(sm[2 * i] / fn - bflo(v[0][i]), sm[2 * i + 1] / fn - bfhi(v[0][i]));
        *(u32x4*)(sA + row * PT_PITCH + ch * 16) = o;
    }
    __syncthreads();
    f32x4 acc[4][4];
#pragma unroll
    for (int m = 0; m < 4; ++m)
#pragma unroll
        for (int n = 0; n < 4; ++n) acc[m][n] = (f32x4){0.f, 0.f, 0.f, 0.f};
#pragma unroll
    for (int kk = 0; kk < 4; ++kk) {
        bf16x8 af[4], bfr[4];
#pragma unroll
        for (int m = 0; m < 4; ++m) af[m] = *(const bf16x8*)(sA + (wr * 64 + m * 16 + fr) * PT_PITCH + (kk * 32 + fq * 8) * 2);
#pragma unroll
        for (int n = 0; n < 4; ++n) bfr[n] = *(const bf16x8*)(sB + (wc * 64 + n * 16 + fr) * PT_PITCH + (kk * 32 + fq * 8) * 2);
#pragma unroll
        for (int m = 0; m < 4; ++m)
#pragma unroll
            for (int n = 0; n < 4; ++n) acc[m][n] = __builtin_amdgcn_mfma_f32_16x16x32_bf16(bfr[n], af[m], acc[m][n], 0, 0, 0);
    }
#pragma unroll
    for (int m = 0; m < 4; ++m)
#pragma unroll
        for (int n = 0; n < 4; ++n) epi(wr * 64 + m * 16 + fr, wc * 64 + n * 16 + fq * 4, acc[m][n]);
}

__device__ void phase_mix_gemm(const Params& p, char* lds) {
    const int tidx_ = tid_opaque();
    const int npool = (T_TOK / 128) * 4, nsgu = (T_TOK / 128) * 4;
    const int half = tidx_ >> 8, ht = tidx_ & 255; lds += half * MIXH_LDS;
    for (int tile = 2 * blockIdx.x + half; tile < npool + nsgu; tile += 2 * gridDim.x) {
        if (tile < npool) {
            const int tm = tile >> 2, g = tile & 3;
            const float* ps = p.pool_scale + g * 128; bf16_t* co = p.cB + (size_t)tm * 128 * D_MODEL + g * 128;
            const bf16_t* z0 = p.zb + (size_t)tm * 128 * D_IN + g * 128; const bf16_t* bt = p.poolT + (size_t)g * 16384;
            auto epi = [&](int r, int c, f32x4 v) {
                const float4 sc = *(const float4*)(ps + c);
                uint2 o; o.x = pack2(v[0] * sc.x, v[1] * sc.y); o.y = pack2(v[2] * sc.z, v[3] * sc.w);
                *(uint2*)(co + (size_t)r * D_MODEL + c) = o;
            };
            if (g == 0) pool_tile<2>(ht, z0, tm * 128, bt, lds, epi); else if (g == 1) pool_tile<4>(ht, z0, tm * 128, bt, lds, epi);
            else if (g == 2) pool_tile<8>(ht, z0, tm * 128, bt, lds, epi); else pool_tile<16>(ht, z0, tm * 128, bt, lds, epi);
        } else {
            const int t2 = tile - npool, blk = t2 >> 2, h = t2 & 3;
            float* stm = (float*)(lds + GEMM_LDS_BYTES); float* str = stm + 128;
            __syncthreads();
            {
                const int tok = ht >> 1, hh = ht & 1;
                const u32x4* vp = (const u32x4*)(p.zb + (size_t)(blk * 128 + tok) * D_IN + 1024 + hh * 256);
                float s1 = 0.f, s2 = 0.f;
#pragma unroll 8
                for (int i = 0; i < 32; ++i) {
                    const u32x4 v = vp[i];
#pragma unroll
                    for (int k = 0; k < 4; ++k) { const float a = bflo(v[k]), c = bfhi(v[k]); s1 += a + c; s2 += a * a + c * c; }
                }
                s1 += __shfl_xor(s1, 1); s2 += __shfl_xor(s2, 1);
                const float mean = s1 * (1.0f / 512.0f), var = fmaxf(s2 * (1.0f / 512.0f) - mean * mean, 0.f);
                if (hh == 0) { stm[tok] = mean; str[tok] = rsqrtf(var + EPS); }
            }
            __syncthreads();
            const float* sb = p.sgu_b + h * 128; const bf16_t* uo = p.zb + (size_t)blk * 128 * D_IN + 512 + h * 128;
            bf16_t* co = p.cB + (size_t)blk * 128 * D_MODEL + 512 + h * 128;
            gemm128_sgu(ht, p.wsM + (size_t)h * 16384, p.zb + (size_t)blk * 128 * D_IN + 1024 + h * 128, stm, str, p.sgu_norm_g + h * 128, lds,
                    [&](int r, int c, f32x4 v) {
                        const float bb = sb[r];
                        const uint2 uu = *(const uint2*)(uo + (size_t)r * D_IN + c);
                        uint2 o;
                        o.x = pack2((v[0] + bb) * bflo(uu.x), (v[1] + bb) * bfhi(uu.x));
                        o.y = pack2((v[2] + bb) * bflo(uu.y), (v[3] + bb) * bfhi(uu.y));
                        *(uint2*)(co + (size_t)r * D_MODEL + c) = o;
                    });
        }
    }
}

__device__ __forceinline__ int wave_sum_i_uniform(int s) {
    s += __builtin_amdgcn_update_dpp(0, s, 0xB1, 0xf, 0xf, false);
    s += __builtin_amdgcn_update_dpp(0, s, 0x4E, 0xf, 0xf, false);
    s += __builtin_amdgcn_update_dpp(0, s, 0x141, 0xf, 0xf, false);
    s += __builtin_amdgcn_update_dpp(0, s, 0x140, 0xf, 0xf, false);
    return __builtin_amdgcn_readlane(s, 0) + __builtin_amdgcn_readlane(s, 16) + __builtin_amdgcn_readlane(s, 32) + __builtin_amdgcn_readlane(s, 48);
}
__device__ void phase_hstats(const Params& p, char* lds) {
    const int wave = (blockIdx.x * blockDim.x + threadIdx.x) >> 6, nwaves = (gridDim.x * blockDim.x) >> 6, lane = threadIdx.x & 63;
    for (int t = wave; t < T_TOK; t += nwaves) {
        const u32x4* hr = (const u32x4*)(p.hb + (size_t)t * D_MODEL + lane * 16);
        const u32x4 a = hr[0], c = hr[1];
        const float f[16] = {bflo(a.x), bfhi(a.x), bflo(a.y), bfhi(a.y), bflo(a.z), bfhi(a.z), bflo(a.w), bfhi(a.w),
                             bflo(c.x), bfhi(c.x), bflo(c.y), bfhi(c.y), bflo(c.z), bfhi(c.z), bflo(c.w), bfhi(c.w)};
        float ss = 0.f, am = 0.f;
#pragma unroll
        for (int j = 0; j < 16; ++j) { ss += f[j] * f[j]; am = fmaxf(am, fabsf(f[j])); }
        ss = wave_sum(ss); am = wave_max(am);
        const float inv = am > 0.f ? 127.0f / am : 0.f;
        u32x4 o;
#pragma unroll
        for (int i = 0; i < 4; ++i) {
            unsigned w = 0;
#pragma unroll
            for (int k = 0; k < 4; ++k) w |= (unsigned)(((int)rintf(f[4 * i + k] * inv)) & 0xff) << (8 * k);
            o[i] = w;
        }
        *(u32x4*)(p.hq + (size_t)t * D_MODEL + lane * 16) = o;
        int hsum = 0;
#pragma unroll
        for (int j = 0; j < 16; ++j) hsum += (int)rintf(f[j] * inv);
        hsum = wave_sum_i_uniform(hsum);
        if (lane == 0) { p.rstd2[t] = rsqrtf(ss * (1.0f / D_MODEL) + EPS); p.sh[t] = am * (1.0f / 127.0f); p.hs[t] = hsum; }
    }
}

__constant__ unsigned char kComb[64] = {
    0x00,0x01,0x02,0x03,0x04,0x05,0x06,0x07,0x08,0x09,0x0a,0x0b,0x0c,0x0d,0x0e,0x0f,
    0x10,0x11,0x12,0x13,0x14,0x15,0x16,0x17,
    0x20,0x21,0x22,0x23,0x24,
    0x30,0x31,0x32,0x33,
    0x40,0x41,0x42,
    0x50,0x51,
    0x60,0x61,
    0x70,0x71,
    0x80,0x90,0xa0,0xb0,0xc0,0xd0,0xe0,0xf0,
    0xff,0xff,0xff,0xff,0xff,0xff,0xff,0xff,0xff,0xff,0xff,0xff,0xff,0xff};

template <int CTRL> __device__ __forceinline__ int dpp_i(int v) { return __builtin_amdgcn_update_dpp(0, v, CTRL, 0xf, 0xf, false); }
__device__ __forceinline__ int row_allmax_i(int v) {
    v = max(v, dpp_i<0x128>(v)); v = max(v, dpp_i<0x124>(v)); v = max(v, dpp_i<0x122>(v)); v = max(v, dpp_i<0x121>(v));
    return v;
}
__device__ __forceinline__ float row_allsum_f(float v) {
    v += __int_as_float(dpp_i<0x128>(__float_as_int(v))); v += __int_as_float(dpp_i<0x124>(__float_as_int(v)));
    v += __int_as_float(dpp_i<0x122>(__float_as_int(v))); v += __int_as_float(dpp_i<0x121>(__float_as_int(v)));
    return v;
}
__device__ __forceinline__ int f2key(float f) { const int b = __float_as_int(f); return b ^ ((b >> 31) & 0x7fffffff); }
__device__ __forceinline__ float key2f(int k) { return __int_as_float(k ^ ((k >> 31) & 0x7fffffff)); }
#define KEY_MIN ((int)0x80000000)
#define CE(a, b) { const int hi_ = max(a, b), lo_ = min(a, b); a = hi_; b = lo_; }
__device__ __forceinline__ int top16_rows(int (&k)[8], int l15) {
    CE(k[0], k[1]) CE(k[2], k[3]) CE(k[4], k[5]) CE(k[6], k[7])
    CE(k[0], k[2]) CE(k[1], k[3]) CE(k[4], k[6]) CE(k[5], k[7])
    CE(k[1], k[2]) CE(k[5], k[6])
    CE(k[0], k[4]) CE(k[1], k[5]) CE(k[2], k[6]) CE(k[3], k[7])
    CE(k[2], k[4]) CE(k[3], k[5])
    CE(k[1], k[2]) CE(k[3], k[4]) CE(k[5], k[6])
    int res = KEY_MIN;
#pragma unroll
    for (int r = 0; r < 16; ++r) {
        const int m = row_allmax_i(k[0]);
        const bool own = (k[0] == m);
#pragma unroll
        for (int j = 0; j < 7; ++j) k[j] = own ? k[j + 1] : k[j];
        k[7] = own ? KEY_MIN : k[7];
        res = (l15 == r) ? m : res;
    }
    return res;
}
__device__ __forceinline__ void combine16(int A, int B, const int (&cbv)[4], int lane, int l15, int& eid_out, float& gate_out) {
    const int rowbase = lane & 48;
    int ck[4], eid[4];
#pragma unroll
    for (int c = 0; c < 4; ++c) {
        const int ci = (cbv[c] >> 4) & 15, cj = cbv[c] & 15;
        const int ka = __builtin_amdgcn_ds_bpermute((rowbase + ci) << 2, A);
        const int kb = __builtin_amdgcn_ds_bpermute((rowbase + cj) << 2, B);
        const float sm = key2f(ka & ~127) + key2f(kb & ~127);
        eid[c] = ((127 - (ka & 127)) << 7) | (127 - (kb & 127));
        ck[c] = (cbv[c] != 0xff) ? ((f2key(sm) & ~63) | (63 - (4 * l15 + c))) : KEY_MIN;
    }
    CE(ck[0], ck[1]) CE(ck[2], ck[3]) CE(ck[0], ck[2]) CE(ck[1], ck[3]) CE(ck[1], ck[2])
    int res = KEY_MIN;
#pragma unroll
    for (int r = 0; r < 16; ++r) {
        const int m = row_allmax_i(ck[0]);
        const bool own = (ck[0] == m);
        ck[0] = own ? ck[1] : ck[0]; ck[1] = own ? ck[2] : ck[1]; ck[2] = own ? ck[3] : ck[2]; ck[3] = own ? KEY_MIN : ck[3];
        res = (l15 == r) ? m : res;
    }
    const int slot = 63 - (res & 63);
    const int src = (rowbase + (slot >> 2)) << 2;
    const int e0 = __builtin_amdgcn_ds_bpermute(src, eid[0]), e1 = __builtin_amdgcn_ds_bpermute(src, eid[1]);
    const int e2 = __builtin_amdgcn_ds_bpermute(src, eid[2]), e3 = __builtin_amdgcn_ds_bpermute(src, eid[3]);
    const int sel = slot & 3;
    eid_out = sel == 0 ? e0 : (sel == 1 ? e1 : (sel == 2 ? e2 : e3));
    gate_out = key2f(res & ~63);
}

__device__ void phase_topk(const Params& p, char* lds) {
    const int half = threadIdx.x >> 8; lds += half * GEMM_LDS_BYTES;
    const int tid = threadIdx.x & 255, lane = tid & 63, wid = tid >> 6, fr = lane & 15, fq = lane >> 4;
    constexpr int PITCH = 144;
    char* sA = lds; char* sB = lds + 128 * PITCH;
    int cbv[4];
#pragma unroll
    for (int c = 0; c < 4; ++c) cbv[c] = kComb[4 * fr + c];
    const int lrow = tid >> 3, lch = tid & 7;
    const int ntiles = (T_TOK / 128) * 8;
    for (int tile = 2 * blockIdx.x + half; tile < ntiles; tile += 2 * gridDim.x) {
        const int tm = tile >> 3, h = tile & 7;
        int tA[2][4], tB[2][4];
#pragma unroll
        for (int m = 0; m < 2; ++m)
#pragma unroll
            for (int j = 0; j < 4; ++j) { tA[m][j] = 0; tB[m][j] = 0; }
#pragma unroll 1
        for (int pp = 0; pp < 2; ++pp) {
            const bf16_t* ga = p.qB + (size_t)(tm * 128 + lrow) * 2048 + h * 256 + pp * 128 + lch * 8;
            const bf16_t* gb = p.keysB + (size_t)(pp * 8 + h) * 16384 + (size_t)lrow * 128 + lch * 8;
            f32x4 acc[2][8];
#pragma unroll
            for (int m = 0; m < 2; ++m)
#pragma unroll
                for (int nb = 0; nb < 8; ++nb) acc[m][nb] = (f32x4){0.f, 0.f, 0.f, 0.f};
#pragma unroll 1
            for (int k0 = 0; k0 < 128; k0 += 64) {
                u32x4 ra[4], rb[4];
#pragma unroll
                for (int j = 0; j < 4; ++j) { ra[j] = *(const u32x4*)(ga + (size_t)(32 * j) * 2048 + k0); rb[j] = *(const u32x4*)(gb + (size_t)(32 * j) * 128 + k0); }
                __syncthreads();
#pragma unroll
                for (int j = 0; j < 4; ++j) {
                    *(u32x4*)(sA + (lrow + 32 * j) * PITCH + lch * 16) = ra[j];
                    *(u32x4*)(sB + (lrow + 32 * j) * PITCH + lch * 16) = rb[j];
                }
                __syncthreads();
#pragma unroll
                for (int kk = 0; kk < 2; ++kk) {
                    bf16x8 af[2], bfr[8];
#pragma unroll
                    for (int m = 0; m < 2; ++m) af[m] = *(const bf16x8*)(sA + (wid * 32 + m * 16 + fr) * PITCH + (kk * 32 + fq * 8) * 2);
#pragma unroll
                    for (int nb = 0; nb < 8; ++nb) bfr[nb] = *(const bf16x8*)(sB + (nb * 16 + fr) * PITCH + (kk * 32 + fq * 8) * 2);
#pragma unroll
                    for (int m = 0; m < 2; ++m)
#pragma unroll
                        for (int nb = 0; nb < 8; ++nb) acc[m][nb] = __builtin_amdgcn_mfma_f32_16x16x32_bf16(af[m], bfr[nb], acc[m][nb], 0, 0, 0);
                }
            }
#pragma unroll
            for (int m = 0; m < 2; ++m)
#pragma unroll
                for (int j = 0; j < 4; ++j) tA[m][j] = tB[m][j];
#pragma unroll 1
            for (int it = 0; it < 4; ++it) {
#pragma unroll
                for (int m = 0; m < 2; ++m) {
                    int k[8];
#pragma unroll
                    for (int nb = 0; nb < 8; ++nb) k[nb] = (f2key(acc[m][nb][0]) & ~127) | (127 - (16 * nb + fr));
                    const int r = top16_rows(k, fr);
                    tB[m][0] = tB[m][1]; tB[m][1] = tB[m][2]; tB[m][2] = tB[m][3]; tB[m][3] = r;
#pragma unroll
                    for (int nb = 0; nb < 8; ++nb) acc[m][nb] = (f32x4){acc[m][nb][1], acc[m][nb][2], acc[m][nb][3], acc[m][nb][0]};
                }
            }
        }
#pragma unroll 1
        for (int it = 0; it < 4; ++it) {
#pragma unroll
            for (int m = 0; m < 2; ++m) {
                int eid; float gt;
                combine16(tA[m][0], tB[m][0], cbv, lane, fr, eid, gt);
                const int t = tm * 128 + wid * 32 + m * 16 + fq * 4 + it;
                const size_t o = (size_t)t * 128 + h * 16 + fr;
                p.idx[o] = eid; p.gate[o] = gt;
                tA[m][0] = tA[m][1]; tA[m][1] = tA[m][2]; tA[m][2] = tA[m][3];
                tB[m][0] = tB[m][1]; tB[m][1] = tB[m][2]; tB[m][2] = tB[m][3];
            }
        }
    }
}

__device__ __forceinline__ int reduce16_rows(const int (&part)[16], bool b3, bool b2, bool b1, bool b0b) {
    int r8[8], r4[4], r2[2];
#pragma unroll
    for (int k = 0; k < 8; ++k) { const int keep = b3 ? part[8 + k] : part[k], send = b3 ? part[k] : part[8 + k]; r8[k] = keep + __builtin_amdgcn_update_dpp(0, send, 0x140, 0xf, 0xf, false); }
#pragma unroll
    for (int k = 0; k < 4; ++k) { const int keep = b2 ? r8[4 + k] : r8[k], send = b2 ? r8[k] : r8[4 + k]; r4[k] = keep + __builtin_amdgcn_update_dpp(0, send, 0x141, 0xf, 0xf, false); }
#pragma unroll
    for (int k = 0; k < 2; ++k) { const int keep = b1 ? r4[2 + k] : r4[k], send = b1 ? r4[k] : r4[2 + k]; r2[k] = keep + __builtin_amdgcn_update_dpp(0, send, 0x4E, 0xf, 0xf, false); }
    const int keep = b0b ? r2[1] : r2[0], send = b0b ? r2[0] : r2[1];
    int r1 = keep + __builtin_amdgcn_update_dpp(0, send, 0xB1, 0xf, 0xf, false);
    r1 += __shfl_xor(r1, 16); r1 += __shfl_xor(r1, 32);
    return r1;
}
#define TS_WBYTES (16384 + 128)
__device__ void phase_peer_dots(const Params& p, char* lds) {
    const int tidx_ = tid_opaque();
    const int lane = tidx_ & 63, wid = __builtin_amdgcn_readfirstlane((int)(tidx_ >> 6)), l15 = lane & 15;
    const bool b3 = (lane & 8) != 0, b2 = (lane & 4) != 0, b1 = (lane & 2) != 0, b0b = (lane & 1) != 0;
    const int gw = blockIdx.x * (blockDim.x >> 6) + wid, ngw = gridDim.x * (blockDim.x >> 6);
    char* wl = lds + wid * TS_WBYTES;
    unsigned* list = (unsigned*)wl; int* dotsl = (int*)(wl + 4096); char* hql = wl + 8192; int* tks = (int*)(wl + 16384);
    const unsigned lane16 = (unsigned)lane * 16u;
    for (int tb = gw * 8; tb < T_TOK; tb += ngw * 8) {
#pragma unroll 1
        for (int j0 = 0; j0 < 8; j0 += 4) {
            u32x4 hraw[4][2];
#pragma unroll
            for (int jj = 0; jj < 4; ++jj) { const u32x4* hr = (const u32x4*)(p.hb + (size_t)(tb + j0 + jj) * D_MODEL); hraw[jj][0] = hr[2 * lane]; hraw[jj][1] = hr[2 * lane + 1]; }
#pragma unroll
            for (int jj = 0; jj < 4; ++jj) {
                const int j = j0 + jj;
                const u32x4 a = hraw[jj][0], c = hraw[jj][1];
                const float f[16] = {bflo(a.x), bfhi(a.x), bflo(a.y), bfhi(a.y), bflo(a.z), bfhi(a.z), bflo(a.w), bfhi(a.w),
                                     bflo(c.x), bfhi(c.x), bflo(c.y), bfhi(c.y), bflo(c.z), bfhi(c.z), bflo(c.w), bfhi(c.w)};
                float ss = 0.f, am = 0.f;
#pragma unroll
                for (int k = 0; k < 16; ++k) { ss += f[k] * f[k]; am = fmaxf(am, fabsf(f[k])); }
                ss = wave_sum(ss); am = wave_max(am);
                const float inv = am > 0.f ? 127.0f / am : 0.f;
                u32x4 o; int hsum = 0;
#pragma unroll
                for (int i = 0; i < 4; ++i) {
                    unsigned w = 0;
#pragma unroll
                    for (int k = 0; k < 4; ++k) { const int qv = (int)rintf(f[4 * i + k] * inv); hsum += qv; w |= (unsigned)(qv & 0xff) << (8 * k); }
                    o[i] = w;
                }
                *(u32x4*)(hql + j * 1024 + lane * 16) = o;
                hsum = wave_sum_i_uniform(hsum);
                const float r2 = rsqrtf(ss * (1.0f / D_MODEL) + EPS);
                if (lane == 0) { tks[4 * j] = hsum; tks[4 * j + 1] = __float_as_int(am * (1.0f / 127.0f) * r2); tks[4 * j + 2] = __float_as_int(r2); }
            }
        }
        int idv[8][2];
#pragma unroll
        for (int j = 0; j < 8; ++j) { const int* ir = p.idx + (size_t)(tb + j) * 128; idv[j][0] = ir[lane]; idv[j][1] = ir[64 + lane]; }
#pragma unroll 1
        for (int x = 0; x < 8; ++x) {
            int n = 0;
#pragma unroll
            for (int j = 0; j < 8; ++j)
#pragma unroll
                for (int r = 0; r < 2; ++r) {
                    const int e = idv[j][r];
                    const bool in = (e >> 11) == x;
                    const unsigned long long mk = __ballot(in);
                    const int rank = (int)__builtin_amdgcn_mbcnt_hi((unsigned)(mk >> 32), __builtin_amdgcn_mbcnt_lo((unsigned)mk, 0u));
                    if (in) list[n + rank] = ((unsigned)j << 21) | ((unsigned)(r * 64 + lane) << 14) | (unsigned)e;
                    n += (int)__builtin_popcountll(mk);
                }
            asm volatile("s_waitcnt lgkmcnt(0)" ::: "memory");
            u32x4 ua[16], ubf[16]; int enta = 0, entb = 0;
            auto issue = [&](int b0, u32x4 (&uu)[16], int& entv) {
                const int i = (b0 + l15 < n) ? b0 + l15 : n - 1;
                entv = (int)list[i];
#pragma unroll
                for (int j = 0; j < 16; ++j) { const int e = __builtin_amdgcn_readlane(entv, j) & 0x3fff; uu[j] = *(const u32x4*)(p.u8 + (size_t)e * D_MODEL + lane16); }
            };
            auto reduce = [&](int b0, const u32x4 (&uu)[16], int entv) {
                int part[16];
#pragma unroll
                for (int j = 0; j < 16; ++j) {
                    const int tl = __builtin_amdgcn_readlane(entv, j) >> 21;
                    const u32x4 hqv = *(const u32x4*)(hql + tl * 1024 + lane * 16);
                    int sacc = __builtin_amdgcn_sdot4((int)uu[j].x, (int)hqv.x, 0, false);
                    sacc = __builtin_amdgcn_sdot4((int)uu[j].y, (int)hqv.y, sacc, false);
                    sacc = __builtin_amdgcn_sdot4((int)uu[j].z, (int)hqv.z, sacc, false);
                    part[j] = __builtin_amdgcn_sdot4((int)uu[j].w, (int)hqv.w, sacc, false);
                }
                const int r1 = reduce16_rows(part, b3, b2, b1, b0b);
                if (lane < 16 && b0 + lane < n) dotsl[((unsigned)entv >> 21) * 128 + (((unsigned)entv >> 14) & 127u)] = r1;
            };
            if (n > 0) issue(0, ua, enta);
            for (int b0 = 0; b0 < n; b0 += 32) {
                if (b0 + 16 < n) issue(b0 + 16, ubf, entb);
                reduce(b0, ua, enta);
                if (b0 + 16 < n) {
                    if (b0 + 32 < n) issue(b0 + 32, ua, enta);
                    reduce(b0 + 16, ubf, entb);
                }
            }
            asm volatile("s_waitcnt lgkmcnt(0)" ::: "memory");
        }
#pragma unroll
        for (int j = 0; j < 8; ++j) {
            const int hs_t = tks[4 * j]; const float cs_t = __int_as_float(tks[4 * j + 1]), r2_t = __int_as_float(tks[4 * j + 2]);
            const float* gr = p.gate + (size_t)(tb + j) * 128; float* cr = p.coef + (size_t)(tb + j) * 128;
#pragma unroll
            for (int r = 0; r < 2; ++r) {
                const int e = idv[j][r];
                const float sc = gr[r * 64 + lane] * r2_t;
                const float ex = __expf(sc - key2f(row_allmax_i(f2key(sc))));
                const float gt = ex / row_allsum_f(ex);
                const float dotf = (float)dotsl[j * 128 + r * 64 + lane] * cs_t * p.su[e];
                cr[r * 64 + lane] = gt * gelu_t(dotf) * p.sv[e];
            }
        }
        asm volatile("s_waitcnt lgkmcnt(0)" ::: "memory");
    }
}

__device__ void phase_gather(const Params& p, char* lds) {
    const int tidx_ = tid_opaque();
    const int wave = __builtin_amdgcn_readfirstlane((int)((blockIdx.x * blockDim.x + tidx_) >> 6)), nwaves = (gridDim.x * blockDim.x) >> 6, lane = tidx_ & 63;
    const unsigned char* vb = p.v8 + lane * 12;
    for (int t = wave; t < T_TOK; t += nwaves) {
        int idr[2]; float coef[2];
        { const int* ir = p.idx + (size_t)t * 128; idr[0] = ir[lane]; idr[1] = ir[64 + lane]; }
        { const float* cr = p.coef + (size_t)t * 128; coef[0] = cr[lane]; coef[1] = cr[64 + lane]; }
        const float cmax = wave_max(fmaxf(fabsf(coef[0]), fabsf(coef[1])));
        const float qs = cmax > 0.f ? 127.0f / cmax : 0.f, cscale = cmax * (1.0f / 127.0f);
        const int cq0 = (int)rintf(coef[0] * qs), cq1 = (int)rintf(coef[1] * qs);
        const int csum_i = wave_sum_i_uniform(cq0 + cq1);
        unsigned cpk[2];
        {
            const int cqs[2] = {cq0, cq1};
#pragma unroll
            for (int hf = 0; hf < 2; ++hf) {
                const int bb = cqs[hf] & 0xff;
                cpk[hf] = (unsigned)__builtin_amdgcn_update_dpp(0, bb, 0x00, 0xf, 0xf, false) | ((unsigned)__builtin_amdgcn_update_dpp(0, bb, 0x55, 0xf, 0xf, false) << 8)
                        | ((unsigned)__builtin_amdgcn_update_dpp(0, bb, 0xAA, 0xf, 0xf, false) << 16) | ((unsigned)__builtin_amdgcn_update_dpp(0, bb, 0xFF, 0xf, 0xf, false) << 24);
            }
        }
        int acc[16];
#pragma unroll
        for (int j = 0; j < 16; ++j) acc[j] = 0;
        {
            u32x3 va[8], vbf[8];
            auto issue = [&](int pb, u32x3 (&vv)[8]) {
#pragma unroll
                for (int q = 0; q < 8; ++q) { const int e = __builtin_amdgcn_readlane(pb < 64 ? idr[0] : idr[1], (pb & 63) + q); vv[q] = *(const u32x3*)(vb + (size_t)e * ROWB); }
            };
            auto axpy = [&](int pb, const u32x3 (&vv)[8]) {
#pragma unroll
                for (int g4 = 0; g4 < 2; ++g4) {
                    const int cqd = __builtin_amdgcn_readlane((int)(pb < 64 ? cpk[0] : cpk[1]), (pb & 63) + 4 * g4);
                    unsigned dd[4][4];
#pragma unroll
                    for (int r = 0; r < 4; ++r) {
                        const unsigned w0 = vv[4 * g4 + r].x, w1 = vv[4 * g4 + r].y, w2 = vv[4 * g4 + r].z;
                        dd[r][0] = w0 & 0x3f3f3f3fu; dd[r][1] = w1 & 0x3f3f3f3fu; dd[r][2] = w2 & 0x3f3f3f3fu;
                        dd[r][3] = ((w0 >> 6) & 0x03030303u) | ((w1 >> 4) & 0x0c0c0c0cu) | ((w2 >> 2) & 0x30303030u);
                    }
#pragma unroll
                    for (int k = 0; k < 4; ++k) {
                        const unsigned p0 = __builtin_amdgcn_perm(dd[1][k], dd[0][k], 0x05010400u), p1 = __builtin_amdgcn_perm(dd[1][k], dd[0][k], 0x07030602u);
                        const unsigned q0 = __builtin_amdgcn_perm(dd[3][k], dd[2][k], 0x05010400u), q1 = __builtin_amdgcn_perm(dd[3][k], dd[2][k], 0x07030602u);
                        const unsigned t0 = __builtin_amdgcn_perm(q0, p0, 0x05040100u), t1 = __builtin_amdgcn_perm(q0, p0, 0x07060302u);
                        const unsigned t2 = __builtin_amdgcn_perm(q1, p1, 0x05040100u), t3 = __builtin_amdgcn_perm(q1, p1, 0x07060302u);
                        acc[4 * k + 0] = __builtin_amdgcn_sdot4((int)t0, cqd, acc[4 * k + 0], false);
                        acc[4 * k + 1] = __builtin_amdgcn_sdot4((int)t1, cqd, acc[4 * k + 1], false);
                        acc[4 * k + 2] = __builtin_amdgcn_sdot4((int)t2, cqd, acc[4 * k + 2], false);
                        acc[4 * k + 3] = __builtin_amdgcn_sdot4((int)t3, cqd, acc[4 * k + 3], false);
                    }
                }
            };
            issue(0, va);
#pragma unroll 1
            for (int pb = 0; pb < 128; pb += 16) {
                issue(pb + 8, vbf);
                axpy(pb, va);
                if (pb + 16 < 128) issue(pb + 16, va);
                axpy(pb + 8, vbf);
            }
        }
        const u32x4* hr = (const u32x4*)(p.hb + (size_t)t * D_MODEL + lane * 16);
        const u32x4 ha = hr[0], hc = hr[1];
        const float hf16[16] = {bflo(ha.x), bfhi(ha.x), bflo(ha.y), bfhi(ha.y), bflo(ha.z), bfhi(ha.z), bflo(ha.w), bfhi(ha.w),
                                bflo(hc.x), bfhi(hc.x), bflo(hc.y), bfhi(hc.y), bflo(hc.z), bfhi(hc.z), bflo(hc.w), bfhi(hc.w)};
        float res[16];
        float ss = 0.f;
#pragma unroll
        for (int j = 0; j < 16; ++j) { res[j] = hf16[j] + cscale * (float)(acc[j] - 32 * csum_i); ss += res[j] * res[j]; }
        ss = wave_sum(ss);
        const float r3 = rsqrtf(ss * (1.0f / D_MODEL) + EPS);
        float* o = p.out + (size_t)t * D_MODEL + lane * 16;
        const float* fg = p.final_g + lane * 16;
#pragma unroll
        for (int i = 0; i < 4; ++i) {
            const float4 g = ((const float4*)fg)[i];
            float4 ov; ov.x = res[4 * i] * r3 * g.x; ov.y = res[4 * i + 1] * r3 * g.y; ov.z = res[4 * i + 2] * r3 * g.z; ov.w = res[4 * i + 3] * r3 * g.w;
            ((float4*)o)[i] = ov;
        }
    }
}

namespace pg8 {
#define PG8_LAS __attribute__((address_space(3)))
constexpr int BM = 256, BK = 64, HALF = 128, HTB = HALF * BK * 2, STAGE_BYTES = 8 * HTB, NXCD = 8, WGM = 8;
__host__ __device__ __forceinline__ int lds_byte(int r, int c) { const int st = (r >> 4) * 2 + (c >> 5), rr = r & 15, cc = c & 31, ob = rr * 64 + cc * 2; return st * 1024 + (ob ^ (((ob >> 9) & 1) << 5)); }
__host__ __device__ __forceinline__ void stage_rc(int b, int& R, int& C) { const int st = b / 1024, sb = b % 1024, swz = sb ^ (((sb >> 9) & 1) << 5); R = (st >> 1) * 16 + swz / 64; C = (st & 1) * 32 + (swz % 64) / 2; }
__host__ __device__ __forceinline__ int perm32(int rho) { const int n = rho >> 4, i = rho & 15; return 8 * (i >> 2) + 4 * n + (i & 3); }
struct Unit { int pm, pn; };
struct Gemm { const bf16_t* A; const bf16_t* Bt; int M, N, K; };
struct StaticOrder {
    int nM, nN, nwg, G, c;
    __host__ __device__ void init(int M, int N, int G_, int c_) { nM = M / BM; nN = N / BM; nwg = nM * nN; G = G_; c = c_; }
    __host__ __device__ bool next(int i, Unit& u) const {
        const long L = (long)i * G + c; if (L >= nwg) return false;
        int wgid = (int)L; { const int q = nwg / NXCD, r = nwg % NXCD, xcd = wgid % NXCD, off = wgid / NXCD; wgid = (xcd < r ? xcd * (q + 1) : r * (q + 1) + (xcd - r) * q) + off; }
        const int nig = WGM * nN, gid = wgid / nig, fm = gid * WGM, gsz = (nM - fm) < WGM ? (nM - fm) : WGM;
        u.pm = fm + ((wgid % nig) % gsz); u.pn = (wgid % nig) / gsz; return true;
    }
    __device__ __forceinline__ void a_ready(const Unit&) const {}
    __device__ __forceinline__ void done(const Unit&) const {}
};
__device__ __forceinline__ unsigned cvt_pk_bf16(float lo, float hi) { unsigned r; asm volatile("v_cvt_pk_bf16_f32 %0, %1, %2" : "=v"(r) : "v"(lo), "v"(hi)); return r; }
struct EpiZ {
    static constexpr bool PERM = true, AFTER_DRAIN = false;
    bf16_t* O; const float* rs;
    __device__ __forceinline__ void operator()(const f32x4 (&acc)[2][2][4][2], const Unit& u, int wr, int wc, int fr, int fq) const {
        const int row0 = u.pm * BM + wr * 64 + fr, col0 = u.pn * BM + wc * 32 + 8 * fq; const bool act = u.pn >= 2;
#pragma unroll
        for (int ai = 0; ai < 2; ++ai)
#pragma unroll
            for (int m = 0; m < 4; ++m) { const int r = row0 + ai * HALF + m * 16; const float sc = rs[r]; bf16_t* rowp = O + (size_t)r * D_IN + col0;
#pragma unroll
                for (int bj = 0; bj < 2; ++bj) { f32x4 v0 = acc[ai][bj][m][0] * sc, v1 = acc[ai][bj][m][1] * sc;
                    if (act) { v0 = (f32x4){gelu_t(v0[0]), gelu_t(v0[1]), gelu_t(v0[2]), gelu_t(v0[3])}; v1 = (f32x4){gelu_t(v1[0]), gelu_t(v1[1]), gelu_t(v1[2]), gelu_t(v1[3])}; }
                    u32x4 w; w.x = cvt_pk_bf16(v0[0], v0[1]); w.y = cvt_pk_bf16(v0[2], v0[3]); w.z = cvt_pk_bf16(v1[0], v1[1]); w.w = cvt_pk_bf16(v1[2], v1[3]);
                    *(u32x4*)(rowp + bj * HALF) = w; } }
    }
};
struct EpiOut {
    static constexpr bool PERM = true, AFTER_DRAIN = false;
    bf16_t* O; const float* X;
    __device__ __forceinline__ void operator()(const f32x4 (&acc)[2][2][4][2], const Unit& u, int wr, int wc, int fr, int fq) const {
        const int row0 = u.pm * BM + wr * 64 + fr, col0 = u.pn * BM + wc * 32 + 8 * fq;
#pragma unroll
        for (int ai = 0; ai < 2; ++ai)
#pragma unroll
            for (int m = 0; m < 4; ++m) { const size_t off = (size_t)(row0 + ai * HALF + m * 16) * D_MODEL + col0;
#pragma unroll
                for (int bj = 0; bj < 2; ++bj) { const f32x4 x0 = *(const f32x4*)(X + off + bj * HALF), x1 = *(const f32x4*)(X + off + bj * HALF + 4);
                    const f32x4 v0 = acc[ai][bj][m][0] + x0, v1 = acc[ai][bj][m][1] + x1;
                    u32x4 w; w.x = cvt_pk_bf16(v0[0], v0[1]); w.y = cvt_pk_bf16(v0[2], v0[3]); w.z = cvt_pk_bf16(v1[0], v1[1]); w.w = cvt_pk_bf16(v1[2], v1[3]);
                    *(u32x4*)(O + off + bj * HALF) = w; } }
    }
};
struct EpiQ {
    static constexpr bool PERM = true, AFTER_DRAIN = false;
    bf16_t* O; const float* rs;
    __device__ __forceinline__ void operator()(const f32x4 (&acc)[2][2][4][2], const Unit& u, int wr, int wc, int fr, int fq) const {
        const int row0 = u.pm * BM + wr * 64 + fr, col0 = u.pn * BM + wc * 32 + 8 * fq;
#pragma unroll
        for (int ai = 0; ai < 2; ++ai)
#pragma unroll
            for (int m = 0; m < 4; ++m) { const int r = row0 + ai * HALF + m * 16; const float sc = rs[r]; bf16_t* rowp = O + (size_t)r * 2048 + col0;
#pragma unroll
                for (int bj = 0; bj < 2; ++bj) { const f32x4 v0 = acc[ai][bj][m][0] * sc, v1 = acc[ai][bj][m][1] * sc;
                    u32x4 w; w.x = cvt_pk_bf16(v0[0], v0[1]); w.y = cvt_pk_bf16(v0[2], v0[3]); w.z = cvt_pk_bf16(v1[0], v1[1]); w.w = cvt_pk_bf16(v1[2], v1[3]);
                    *(u32x4*)(rowp + bj * HALF) = w; } }
    }
};
struct OneUnit {
    Unit u;
    __device__ __forceinline__ bool next(int i, Unit& o) const { if (i) return false; o = u; return true; }
    __device__ __forceinline__ void a_ready(const Unit&) const {}
    __device__ __forceinline__ void done(const Unit&) const {}
};
#define QT_PITCH 272
#define QT_LDS_BYTES (2 * 256 * QT_PITCH)
struct EpiQTopk {
    static constexpr bool PERM = true, AFTER_DRAIN = true;
    const float* rs; const bf16_t* keysB; int* idx; float* gate;
    __device__ __forceinline__ void fused(f32x4 (&acc)[2][2][4][2], const Unit& u, int wr, int wc, int fr, int fq, PG8_LAS unsigned char* ldsp, int wid, int lane) const {
        char* sQ = (char*)ldsp;
        const int h = u.pn;
#pragma unroll
        for (int ai = 0; ai < 2; ++ai)
#pragma unroll
            for (int m = 0; m < 4; ++m) { const int r = ai * HALF + wr * 64 + m * 16 + fr;
#pragma unroll
                for (int bj = 0; bj < 2; ++bj) { const f32x4 v0 = acc[ai][bj][m][0], v1 = acc[ai][bj][m][1];
                    u32x4 w; w.x = cvt_pk_bf16(v0[0], v0[1]); w.y = cvt_pk_bf16(v0[2], v0[3]); w.z = cvt_pk_bf16(v1[0], v1[1]); w.w = cvt_pk_bf16(v1[2], v1[3]);
                    *(u32x4*)(sQ + bj * (256 * QT_PITCH) + r * QT_PITCH + (wc * 32 + fq * 8) * 2) = w; } }
        __syncthreads();
        int cbv[4];
#pragma unroll
        for (int c = 0; c < 4; ++c) cbv[c] = kComb[4 * fr + c];
        int tA[2][4], tB[2][4];
#pragma unroll
        for (int m = 0; m < 2; ++m)
#pragma unroll
            for (int j = 0; j < 4; ++j) { tA[m][j] = 0; tB[m][j] = 0; }
#pragma unroll 1
        for (int pp = 0; pp < 2; ++pp) {
            const bf16_t* kb = keysB + (size_t)(pp * 8 + h) * 16384 + (size_t)fr * 128 + fq * 8;
            const char* qa = sQ + pp * (256 * QT_PITCH) + (wid * 32 + fr) * QT_PITCH + fq * 16;
            f32x4 sc2[2][8];
#pragma unroll
            for (int m = 0; m < 2; ++m)
#pragma unroll
                for (int nb = 0; nb < 8; ++nb) sc2[m][nb] = (f32x4){0.f, 0.f, 0.f, 0.f};
#pragma unroll
            for (int kk = 0; kk < 4; ++kk) {
                bf16x8 kf[8], af[2];
#pragma unroll
                for (int nb = 0; nb < 8; ++nb) kf[nb] = *(const bf16x8*)(kb + (size_t)nb * 16 * 128 + kk * 32);
#pragma unroll
                for (int m = 0; m < 2; ++m) af[m] = *(const bf16x8*)(qa + m * 16 * QT_PITCH + kk * 64);
#pragma unroll
                for (int m = 0; m < 2; ++m)
#pragma unroll
                    for (int nb = 0; nb < 8; ++nb) sc2[m][nb] = __builtin_amdgcn_mfma_f32_16x16x32_bf16(af[m], kf[nb], sc2[m][nb], 0, 0, 0);
            }
#pragma unroll
            for (int m = 0; m < 2; ++m)
#pragma unroll
                for (int j = 0; j < 4; ++j) tA[m][j] = tB[m][j];
#pragma unroll 2
            for (int it = 0; it < 4; ++it) {
#pragma unroll
                for (int m = 0; m < 2; ++m) {
                    int k[8];
#pragma unroll
                    for (int nb = 0; nb < 8; ++nb) k[nb] = (f2key(sc2[m][nb][0]) & ~127) | (127 - (16 * nb + fr));
                    const int r = top16_rows(k, fr);
                    tB[m][0] = tB[m][1]; tB[m][1] = tB[m][2]; tB[m][2] = tB[m][3]; tB[m][3] = r;
#pragma unroll
                    for (int nb = 0; nb < 8; ++nb) sc2[m][nb] = (f32x4){sc2[m][nb][1], sc2[m][nb][2], sc2[m][nb][3], sc2[m][nb][0]};
                }
            }
        }
#pragma unroll 2
        for (int it = 0; it < 4; ++it) {
#pragma unroll
            for (int m = 0; m < 2; ++m) {
                int eid; float gt;
                combine16(tA[m][0], tB[m][0], cbv, lane, fr, eid, gt);
                const int t = u.pm * BM + wid * 32 + m * 16 + fq * 4 + it;
                const size_t o = (size_t)t * 128 + h * 16 + fr;
                idx[o] = eid; gate[o] = gt;
                tA[m][0] = tA[m][1]; tA[m][1] = tA[m][2]; tA[m][2] = tA[m][3];
                tB[m][0] = tB[m][1]; tB[m][1] = tB[m][2]; tB[m][2] = tB[m][3];
            }
        }
        __syncthreads();
    }
};
template <class Epi, class Sched>
__device__ __forceinline__ void gemm_phase(PG8_LAS unsigned char* lds, const Gemm g, const Sched& S, const Epi& E) {
    const int tid = threadIdx.x, wid = __builtin_amdgcn_readfirstlane(tid >> 6), lane = tid & 63, wr = wid >> 2, wc = wid & 3, fr = lane & 15, fq = lane >> 4;
    const int K = g.K, nt = K / BK;
    unsigned voffA[2], voffB[2];
#pragma unroll
    for (int i = 0; i < 2; ++i) { int R, C; stage_rc(tid * 16 + i * 8192, R, C); const int Rb = Epi::PERM ? ((R & ~31) + perm32(R & 31)) : R;
        voffA[i] = (unsigned)(R * K + C) * 2u; voffB[i] = (unsigned)(Rb * K + C) * 2u; }
    const size_t kstep = (size_t)(BK * 2);
    const size_t hstep = (size_t)HALF * K * 2;
    const size_t tstep = 2 * hstep;
    const unsigned ldsw = (unsigned)wid * 1024u;
    const int aoff = lds_byte(wr * 64 + fr, fq * 8), boff = lds_byte(wc * 32 + fr, fq * 8);
#define PG8_SA(b, h) (((b) * 2 + (h)) * HTB)
#define PG8_SB(b, h) ((4 + (b) * 2 + (h)) * HTB)
#define PG8_STAGE(bufoff, gbase, voff) do { _Pragma("unroll") for (int _i = 0; _i < 2; ++_i) \
        __builtin_amdgcn_global_load_lds((const unsigned*)((const char*)(gbase) + (voff)[_i]), (PG8_LAS unsigned*)(lds + (bufoff) + ldsw + _i * 8192), 16, 0, 0); } while (0)
#define PG8_LDA(dst, b, h) do { _Pragma("unroll") for (int m = 0; m < 4; ++m) _Pragma("unroll") for (int k = 0; k < 2; ++k) dst[m][k] = *(const PG8_LAS bf16x8*)(lds + PG8_SA(b, h) + aoff + m * 2048 + k * 1024); } while (0)
#define PG8_LDB(dst, b, h) do { _Pragma("unroll") for (int n = 0; n < 2; ++n) _Pragma("unroll") for (int k = 0; k < 2; ++k) dst[n][k] = *(const PG8_LAS bf16x8*)(lds + PG8_SB(b, h) + boff + n * 2048 + k * 1024); } while (0)
#define PG8_MMA(ai, bj, At, Bt) do { __builtin_amdgcn_s_setprio(1); _Pragma("unroll") for (int m = 0; m < 4; ++m) _Pragma("unroll") for (int n = 0; n < 2; ++n) _Pragma("unroll") for (int k = 0; k < 2; ++k) \
        acc[ai][bj][m][n] = __builtin_amdgcn_mfma_f32_16x16x32_bf16(Bt[n][k], At[m][k], acc[ai][bj][m][n], 0, 0, 0); __builtin_amdgcn_s_setprio(0); } while (0)
#define PG8_WAIT_V(n) asm volatile("s_waitcnt vmcnt(" #n ")" ::: "memory")
#define PG8_WAIT_L(n) asm volatile("s_waitcnt lgkmcnt(" #n ")" ::: "memory")
#define PG8_BAR __builtin_amdgcn_s_barrier()
#define PG8_SCHED __builtin_amdgcn_sched_barrier(0)
    Unit cur, nxt; int ui = 0;
    if (!S.next(0, cur)) return;
    f32x4 acc[2][2][4][2];
#pragma unroll
    for (int a = 0; a < 2; ++a)
#pragma unroll
        for (int b = 0; b < 2; ++b)
#pragma unroll
            for (int m = 0; m < 4; ++m)
#pragma unroll
                for (int n = 0; n < 2; ++n) acc[a][b][m][n] = (f32x4){0.f, 0.f, 0.f, 0.f};
    bf16x8 At[4][2], B0[2][2], B1[2][2];
    const char* cA = (const char*)g.A + (size_t)cur.pm * tstep; const char* cB = (const char*)g.Bt + (size_t)cur.pn * tstep;
    S.a_ready(cur);
    PG8_STAGE(PG8_SB(0, 0), cB, voffB); PG8_STAGE(PG8_SA(0, 0), cA, voffA); PG8_STAGE(PG8_SB(0, 1), cB + hstep, voffB); PG8_STAGE(PG8_SA(0, 1), cA + hstep, voffA);
    if (wr == 1) PG8_BAR;
    PG8_WAIT_V(4); PG8_BAR;
    PG8_STAGE(PG8_SB(1, 0), cB + kstep, voffB); PG8_STAGE(PG8_SA(1, 0), cA + kstep, voffA); PG8_STAGE(PG8_SB(1, 1), cB + hstep + kstep, voffB);
    PG8_WAIT_V(6); PG8_BAR;
    for (;;) {
        const bool has_next = S.next(ui + 1, nxt);
        const char* nA = has_next ? (const char*)g.A + (size_t)nxt.pm * tstep : cA; const char* nB = has_next ? (const char*)g.Bt + (size_t)nxt.pn * tstep : cB;
        for (int t = 0; t < nt; t += 2) {
            const bool last = (t == nt - 2);
            const char* a1 = cA + (size_t)(t + 1) * kstep;
            const char* a2 = last ? nA : cA + (size_t)(t + 2) * kstep; const char* b2 = last ? nB : cB + (size_t)(t + 2) * kstep;
            const char* a3 = a2 + kstep; const char* b3 = b2 + kstep;
            if (last && has_next) S.a_ready(nxt);
            PG8_LDB(B0, 0, 0); PG8_SCHED; PG8_LDA(At, 0, 0); PG8_STAGE(PG8_SA(1, 1), a1 + hstep, voffA);
            PG8_WAIT_L(8); PG8_BAR; PG8_WAIT_L(0); PG8_MMA(0, 0, At, B0); PG8_BAR; PG8_SCHED;
            PG8_LDB(B1, 0, 1); PG8_STAGE(PG8_SB(0, 0), b2, voffB);
            PG8_BAR; PG8_WAIT_L(0); PG8_MMA(0, 1, At, B1); PG8_BAR;
            PG8_LDA(At, 0, 1); PG8_STAGE(PG8_SA(0, 0), a2, voffA);
            PG8_BAR; PG8_WAIT_L(0); PG8_MMA(1, 0, At, B0); PG8_BAR; PG8_SCHED;
            PG8_STAGE(PG8_SB(0, 1), b2 + hstep, voffB);
            PG8_WAIT_V(6); PG8_BAR; PG8_MMA(1, 1, At, B1); PG8_BAR;
            PG8_LDB(B0, 1, 0); PG8_SCHED; PG8_LDA(At, 1, 0); PG8_STAGE(PG8_SA(0, 1), a2 + hstep, voffA);
            PG8_WAIT_L(8); PG8_BAR; PG8_WAIT_L(0); PG8_MMA(0, 0, At, B0); PG8_BAR; PG8_SCHED;
            PG8_LDB(B1, 1, 1); PG8_STAGE(PG8_SB(1, 0), b3, voffB);
            PG8_BAR; PG8_WAIT_L(0); PG8_MMA(0, 1, At, B1); PG8_BAR;
            PG8_LDA(At, 1, 1); PG8_STAGE(PG8_SA(1, 0), a3, voffA);
            PG8_BAR; PG8_WAIT_L(0); PG8_MMA(1, 0, At, B0); PG8_BAR; PG8_SCHED;
            PG8_STAGE(PG8_SB(1, 1), b3 + hstep, voffB);
            PG8_WAIT_V(6); PG8_BAR; PG8_MMA(1, 1, At, B1); PG8_BAR;
        }
            if constexpr (!Epi::AFTER_DRAIN) { E(acc, cur, wr, wc, fr, fq); S.done(cur); }
            if (!has_next) break;
#pragma unroll
        for (int a = 0; a < 2; ++a)
#pragma unroll
            for (int b = 0; b < 2; ++b)
#pragma unroll
                for (int m = 0; m < 4; ++m)
#pragma unroll
                    for (int n = 0; n < 2; ++n) acc[a][b][m][n] = (f32x4){0.f, 0.f, 0.f, 0.f};
        cur = nxt; cA = nA; cB = nB; ++ui;
    }
    PG8_WAIT_V(0);
    if (wr == 0) PG8_BAR;
    PG8_BAR;
    if constexpr (Epi::AFTER_DRAIN) { E.fused(acc, cur, wr, wc, fr, fq, lds, wid, lane); S.done(cur); }
#undef PG8_SA
#undef PG8_SB
#undef PG8_STAGE
#undef PG8_LDA
#undef PG8_LDB
#undef PG8_MMA
#undef PG8_WAIT_V
#undef PG8_WAIT_L
#undef PG8_BAR
#undef PG8_SCHED
}
}

__device__ void phase_gemm_z(const Params& p, char* lds) {
    pg8::StaticOrder S; S.init(T_TOK, D_IN, gridDim.x, blockIdx.x);
    pg8::gemm_phase<pg8::EpiZ, pg8::StaticOrder>((PG8_LAS unsigned char*)lds, pg8::Gemm{p.xb, p.winT, T_TOK, D_IN, D_MODEL}, S, pg8::EpiZ{p.zb, p.rstd1});
}
__device__ void phase_gemm_out(const Params& p, char* lds) {
    pg8::StaticOrder S; S.init(T_TOK, D_MODEL, gridDim.x, blockIdx.x);
    pg8::gemm_phase<pg8::EpiOut, pg8::StaticOrder>((PG8_LAS unsigned char*)lds, pg8::Gemm{p.cB, p.woutT, T_TOK, D_MODEL, D_MODEL}, S, pg8::EpiOut{p.hb, p.x});
}
__device__ void phase_gemm_q(const Params& p, char* lds) {
    pg8::StaticOrder S; S.init(T_TOK, 2048, gridDim.x, blockIdx.x);
    pg8::Unit u;
    for (int i = 0; S.next(i, u); ++i)
        pg8::gemm_phase<pg8::EpiQTopk, pg8::OneUnit>((PG8_LAS unsigned char*)lds, pg8::Gemm{p.hb, p.wqT, T_TOK, 2048, D_MODEL}, pg8::OneUnit{u}, pg8::EpiQTopk{p.rstd2, p.keysB, p.idx, p.gate});
}

#define XB_TMO      128
#define XB_XCNT(j)  (256  + 64 * (j))
#define XB_XSUB(j)  (1280 + 64 * (j))
#define XB_XGEN(j)  (2304 + 64 * (j))
#define XB_TOP      3328
#define XB_TOPGEN   3392
#define XCD_BAR_WORDS 3456
#define XB_SPIN_CAP (1u << 20)
__device__ __forceinline__ unsigned xb_ld(unsigned* p)              { return __hip_atomic_load(p, __ATOMIC_RELAXED, __HIP_MEMORY_SCOPE_AGENT); }
__device__ __forceinline__ unsigned xb_add(unsigned* p, unsigned v) { return __hip_atomic_fetch_add(p, v, __ATOMIC_RELAXED, __HIP_MEMORY_SCOPE_AGENT); }
__device__ __forceinline__ unsigned xb_xcc_id() { return (unsigned)__builtin_amdgcn_s_getreg((3 << 11) | 20) & 0xFu; }
#define XB_SPIN(cond, bar) do { unsigned _sp = 0; while (cond) { __builtin_amdgcn_s_sleep(1); \
    if ((++_sp & 255u) == 0u) { if (xb_ld(&(bar)[XB_TMO])) break; if (_sp > XB_SPIN_CAP) { atomicAdd(&(bar)[XB_TMO], 1u); break; } } } } while (0)
struct XcdBarrier { unsigned* bar; unsigned x; volatile LAS unsigned* st; };
__device__ __forceinline__ XcdBarrier xcd_barrier_post(unsigned* bar, volatile LAS unsigned* st) {
    XcdBarrier b; b.bar = bar; b.x = xb_xcc_id(); b.st = st;
    if (threadIdx.x == 0) (void)xb_add(&bar[XB_XCNT(b.x)], 1u);
    return b;
}
__device__ __forceinline__ void xcd_barrier_complete(unsigned* bar, unsigned x, unsigned& nloc, unsigned& nx) {
    const unsigned G = gridDim.x * gridDim.y * gridDim.z;
    unsigned sum, cnt, mine, sp = 0u;
    for (;;) {
        sum = 0u; cnt = 0u; mine = 0u;
#pragma unroll
        for (unsigned j = 0; j < 16; ++j) { const unsigned c = xb_ld(&bar[XB_XCNT(j)]); sum += c; cnt += (c > 0u) ? 1u : 0u; mine = (j == x) ? c : mine; }
        if (sum == G) break;
        __builtin_amdgcn_s_sleep(1);
        if ((++sp & 255u) == 0u) { if (xb_ld(&bar[XB_TMO])) break; if (sp > XB_SPIN_CAP) { atomicAdd(&bar[XB_TMO], 1u); break; } }
    }
    nloc = mine > 0u ? mine : 1u; nx = cnt > 0u ? cnt : 1u;
}
__device__ __forceinline__ void xcd_barrier(const XcdBarrier& b) {
    asm volatile("s_waitcnt vmcnt(0)" ::: "memory");
    __syncthreads();
    if (threadIdx.x == 0) {
        unsigned* bar = b.bar;
        __builtin_amdgcn_s_waitcnt(0);
        unsigned nloc = b.st[0], nx = b.st[1];
        if (nloc == 0u) { xcd_barrier_complete(bar, b.x, nloc, nx); b.st[0] = nloc; b.st[1] = nx; }
        const unsigned old = xb_add(&bar[XB_XSUB(b.x)], 1u);
        const unsigned gen = old / nloc;
        if (old + 1u == (gen + 1u) * nloc) {
            __builtin_amdgcn_fence(__ATOMIC_RELEASE, "agent");
            asm volatile("s_waitcnt vmcnt(0)" ::: "memory");
            const unsigned og = xb_add(&bar[XB_TOP], 1u);
            const unsigned tg = og / nx;
            if (og + 1u == (tg + 1u) * nx) xb_add(&bar[XB_TOPGEN], 1u);
            else XB_SPIN(xb_ld(&bar[XB_TOPGEN]) == tg, bar);
            __builtin_amdgcn_fence(__ATOMIC_ACQUIRE, "agent");
            xb_add(&bar[XB_XGEN(b.x)], 1u);
            asm volatile("s_waitcnt vmcnt(0)" ::: "memory");
        } else {
            XB_SPIN(xb_ld(&bar[XB_XGEN(b.x)]) == gen, bar);
            __builtin_amdgcn_fence(__ATOMIC_ACQUIRE, "agent");
            asm volatile("s_waitcnt vmcnt(0)" ::: "memory");
        }
    }
    __syncthreads();
}

#define MEGA_LDS_MAX2(a, b) ((a) > (b) ? (a) : (b))
#define MEGA_LDS_MAIN MEGA_LDS_MAX2(MEGA_LDS_MAX2(QT_LDS_BYTES, pg8::STAGE_BYTES), MEGA_LDS_MAX2(8 * TS_WBYTES, 2 * MIXH_LDS))
#define MEGA_LDS_BYTES (MEGA_LDS_MAIN + 16)
extern __shared__ __attribute__((aligned(16))) char smem[];
__global__ void __launch_bounds__(512, 2) fwd_mega(Params p) {
    volatile LAS unsigned* st = (volatile LAS unsigned*)(smem + MEGA_LDS_MAIN);
    if (threadIdx.x < 4) st[threadIdx.x] = 0u;
    __syncthreads();
    const XcdBarrier xb = xcd_barrier_post(p.bar, st);
    phase_prep(p, smem);      xcd_barrier(xb);
    phase_gemm_z(p, smem);    xcd_barrier(xb);
    phase_mix_gemm(p, smem);  xcd_barrier(xb);
    phase_gemm_out(p, smem);  xcd_barrier(xb);
    phase_gemm_q(p, smem);    xcd_barrier(xb);
    phase_peer_dots(p, smem); xcd_barrier(xb);
    phase_gather(p, smem);
}

extern "C" void kernel_launch(void* const* d_in, const int* in_sizes, int n_in, void* d_out, int out_size, void* d_ws, size_t ws_size, hipStream_t stream) {
    static int grid_blocks = 0;
    if (grid_blocks == 0) {
        int dev = 0, cus = 0, per_cu = 0;
        (void)hipGetDevice(&dev);
        (void)hipDeviceGetAttribute(&cus, hipDeviceAttributeMultiprocessorCount, dev);
        (void)hipFuncSetAttribute((const void*)fwd_mega, hipFuncAttributeMaxDynamicSharedMemorySize, MEGA_LDS_BYTES);
        (void)hipOccupancyMaxActiveBlocksPerMultiprocessor(&per_cu, (const void*)fwd_mega, 512, MEGA_LDS_BYTES);
        if (per_cu > 1) per_cu = 1;
        if (per_cu < 1) per_cu = 1;
        grid_blocks = cus * per_cu;
    }
    Params p{};
    p.x = (const float*)d_in[0]; p.norm1_g = (const float*)d_in[1]; p.w_in = (const float*)d_in[2]; p.pool_w = (const float*)d_in[3];
    p.pool_scale = (const float*)d_in[4]; p.sgu_norm_g = (const float*)d_in[5]; p.sgu_w = (const float*)d_in[6]; p.sgu_b = (const float*)d_in[7];
    p.w_out = (const float*)d_in[8]; p.norm2_g = (const float*)d_in[9]; p.peer_wq = (const float*)d_in[10]; p.peer_keys = (const float*)d_in[11];
    p.peer_u = (const float*)d_in[12]; p.peer_v = (const float*)d_in[13]; p.final_g = (const float*)d_in[14];
    p.out = (float*)d_out;
    char* w = (char*)d_ws; size_t off = 0;
    auto take = [&](size_t bytes) { char* r = w + off; off += (bytes + 255) & ~(size_t)255; return r; };
    const size_t MiB = 1024 * 1024;
    p.u8 = (unsigned char*)take(16 * MiB); p.v8 = (unsigned char*)take(12 * MiB); p.hs = (int*)take(128 * 1024); p.hq = (signed char*)take(32 * MiB);
    p.su = (float*)take(64 * 1024); p.sv = (float*)take(64 * 1024); p.sh = (float*)take(128 * 1024);
    p.winT = (bf16_t*)take(3 * MiB); p.woutT = (bf16_t*)take(2 * MiB); p.wqT = (bf16_t*)take(4 * MiB);
    p.poolT = (bf16_t*)take(128 * 1024); p.wsM = (bf16_t*)take(128 * 1024); p.keysB = (bf16_t*)take(512 * 1024);
    p.bar = (unsigned*)take(XCD_BAR_WORDS * 4);
    p.rstd1 = (float*)take(128 * 1024); p.rstd2 = (float*)take(128 * 1024); p.lnm = (float*)take(128 * 1024); p.lnr = (float*)take(128 * 1024);
    p.idx = (int*)take(16 * MiB); p.gate = (float*)take(16 * MiB); p.coef = (float*)take(16 * MiB);
    p.cB = (bf16_t*)take(64 * MiB); p.hb = (bf16_t*)take(64 * MiB);
    char* r1 = take(224 * MiB);
    p.xb = (bf16_t*)r1; p.zb = (bf16_t*)(r1 + 64 * MiB); p.dB = (bf16_t*)(r1 + 160 * MiB); p.vnT = (bf16_t*)(r1 + 192 * MiB);
    p.qB = (bf16_t*)r1;
    (void)hipMemsetAsync(p.bar, 0, XCD_BAR_WORDS * 4, stream);
    hipLaunchKernelGGL(fwd_mega, dim3(grid_blocks), dim3(512), MEGA_LDS_BYTES, stream, p);
}
```

```cpp
#include <hip/hip_runtime.h>
#include <stdint.h>
#include <type_traits>

typedef unsigned short bf16_t;
typedef short bf16x8 __attribute__((ext_vector_type(8)));
typedef float f32x4 __attribute__((ext_vector_type(4)));
typedef unsigned u32x4 __attribute__((ext_vector_type(4)));
typedef unsigned u32x2 __attribute__((ext_vector_type(2)));
typedef unsigned u32x3 __attribute__((ext_vector_type(3)));
#define ROWB 768
typedef __bf16 bf2_t __attribute__((ext_vector_type(2)));
#define LAS __attribute__((address_space(3)))

#define T_TOK 32768
#define D_MODEL 1024
#define D_IN 1536
#define SEQ 2048
#define NEXP 16384
#define EPS 1e-6f

struct Params {
    const float *x, *norm1_g, *w_in, *pool_w, *pool_scale, *sgu_norm_g, *sgu_w, *sgu_b, *w_out, *norm2_g, *peer_wq, *peer_keys, *peer_u, *peer_v, *final_g;
    float* out;
    bf16_t *winT, *woutT, *wqT, *poolT, *wsM, *keysB;
    unsigned char *u8, *v8;
    float *su, *sv;
    float *rstd1;
    bf16_t *xb, *zb, *cB, *hb;
    int* idx; float* gate; float* coef;
    unsigned* bar;
};

__device__ __forceinline__ int tid_opaque() { int t = (int)threadIdx.x; asm volatile("" : "+v"(t)); return t; }
__device__ __forceinline__ unsigned short f2bf(float f) {
    unsigned u = __float_as_uint(f);
    u += 0x7fffu + ((u >> 16) & 1u);
    return (unsigned short)(u >> 16);
}
__device__ __forceinline__ float bf2f(unsigned short h) { return __uint_as_float(((unsigned)h) << 16); }
__device__ __forceinline__ unsigned pack2(float a, float b) { return (unsigned)f2bf(a) | ((unsigned)f2bf(b) << 16); }
__device__ __forceinline__ float bflo(unsigned w) { return __uint_as_float(w << 16); }
__device__ __forceinline__ float bfhi(unsigned w) { return __uint_as_float(w & 0xffff0000u); }
__device__ __forceinline__ float gelu_t(float x) {
    const float y = 1.5957691216057308f * (x + 0.044715f * x * x * x);
    return x / (1.0f + __expf(-y));
}
__device__ __forceinline__ float wave_sum(float v) {
#pragma unroll
    for (int o = 32; o >= 1; o >>= 1) v += __shfl_xor(v, o);
    return v;
}
__device__ __forceinline__ float wave_max(float v) {
#pragma unroll
    for (int o = 32; o >= 1; o >>= 1) v = fmaxf(v, __shfl_xor(v, o));
    return v;
}

#define GEMM_LDS_BYTES (2 * 128 * 144)
__device__ __forceinline__ void transpose_tile(const int tid, const float* __restrict__ src, bf16_t* __restrict__ dst, int R, int C, const float* __restrict__ rscale, int tile, float* lds) {
    const int tilesC = C / 64, tr = tile / tilesC, tc = tile % tilesC;
    const int ty = tid >> 6, tx = tid & 63;
    __syncthreads();
#pragma unroll
    for (int i = 0; i < 16; ++i) {
        const int r = ty + 4 * i;
        float v = src[(size_t)(tr * 64 + r) * C + tc * 64 + tx];
        if (rscale) v *= rscale[tr * 64 + r];
        lds[r * 65 + tx] = v;
    }
    __syncthreads();
#pragma unroll
    for (int i = 0; i < 16; ++i) {
        const int c = ty + 4 * i;
        dst[(size_t)(tc * 64 + c) * R + tr * 64 + tx] = f2bf(lds[tx * 65 + c]);
    }
}

__device__ void phase_prep(const Params& p, char* lds) {
    const int tidx_ = tid_opaque();
    const int nb = gridDim.x, b = blockIdx.x, tid = tidx_;
    const int half = tid >> 8, ht = tid & 255, nh = 2 * nb, hb2 = 2 * b + half;
    float* fl = (float*)(lds + half * (64 * 65 * 4));
    for (int t = hb2; t < 16 * 24; t += nh) transpose_tile(ht, p.w_in, p.winT, 1024, 1536, p.norm1_g, t, fl);
    for (int t = hb2; t < 16 * 16; t += nh) transpose_tile(ht, p.w_out, p.woutT, 1024, 1024, nullptr, t, fl);
    for (int t = hb2; t < 16 * 32; t += nh) transpose_tile(ht, p.peer_wq, p.wqT, 1024, 2048, p.norm2_g, t, fl);
    for (int t = hb2; t < 16; t += nh) transpose_tile(ht, p.pool_w + (size_t)(t >> 2) * 16384, p.poolT + (size_t)(t >> 2) * 16384, 128, 128, nullptr, t & 3, fl);
    const size_t gtid = (size_t)b * blockDim.x + tid, gsz = (size_t)nb * blockDim.x;
    for (size_t i = gtid; i < 4 * 128 * 128; i += gsz) {
        const int j = (int)(i & 127), ii = (int)((i >> 7) & 127);
        const bool keep = (j >> 6) <= (ii >> 6);
        p.wsM[i] = keep ? f2bf(p.sgu_w[i]) : (bf16_t)0;
    }
    for (size_t i = gtid; i < 2 * 8 * 128 * 128; i += gsz) p.keysB[i] = f2bf(p.peer_keys[i]);
    {
        const int wave = (b * blockDim.x + tid) >> 6, nwaves = (nb * blockDim.x) >> 6, lane = tid & 63;
        float g16[16];
#pragma unroll
        for (int i = 0; i < 4; ++i) { const float4 g = ((const float4*)(p.norm2_g + lane * 16))[i]; g16[4 * i] = g.x; g16[4 * i + 1] = g.y; g16[4 * i + 2] = g.z; g16[4 * i + 3] = g.w; }
        auto quant_row = [&](const float (&f)[16], unsigned char* dst, float* scale_out) {
            float am = 0.f;
#pragma unroll
            for (int j = 0; j < 16; ++j) am = fmaxf(am, fabsf(f[j]));
            am = wave_max(am);
            const float inv = am > 0.f ? 31.0f / am : 0.f;
            int q[16];
#pragma unroll
            for (int j = 0; j < 16; ++j) q[j] = (int)rintf(f[j] * inv) + 32;
            u32x3 o;
#pragma unroll
            for (int i = 0; i < 3; ++i) {
                unsigned w = 0;
#pragma unroll
                for (int k = 0; k < 4; ++k) w |= (unsigned)(q[4 * i + k] | (((q[12 + k] >> (2 * i)) & 3) << 6)) << (8 * k);
                o[i] = w;
            }
            *(u32x3*)(dst + lane * 12) = o;
            if (lane == 0) *scale_out = am * (1.0f / 31.0f);
        };
        for (int e = wave; e < NEXP; e += nwaves) {
            const float4* su4 = (const float4*)(p.peer_u + (size_t)e * D_MODEL + lane * 16);
            const float4* sv4 = (const float4*)(p.peer_v + (size_t)e * D_MODEL + lane * 16);
            float4 a4[4], b4[4];
#pragma unroll
            for (int i = 0; i < 4; ++i) { a4[i] = su4[i]; b4[i] = sv4[i]; }
            float fu[16], fv[16];
#pragma unroll
            for (int i = 0; i < 4; ++i) {
                fu[4 * i] = a4[i].x * g16[4 * i]; fu[4 * i + 1] = a4[i].y * g16[4 * i + 1]; fu[4 * i + 2] = a4[i].z * g16[4 * i + 2]; fu[4 * i + 3] = a4[i].w * g16[4 * i + 3];
                fv[4 * i] = b4[i].x; fv[4 * i + 1] = b4[i].y; fv[4 * i + 2] = b4[i].z; fv[4 * i + 3] = b4[i].w;
            }
            {
                float am = 0.f;
#pragma unroll
                for (int j = 0; j < 16; ++j) am = fmaxf(am, fabsf(fu[j]));
                am = wave_max(am);
                const float inv = am > 0.f ? 127.0f / am : 0.f;
                u32x4 o;
#pragma unroll
                for (int i = 0; i < 4; ++i) {
                    unsigned w = 0;
#pragma unroll
                    for (int k = 0; k < 4; ++k) w |= (unsigned)(((int)rintf(fu[4 * i + k] * inv)) & 0xff) << (8 * k);
                    o[i] = w;
                }
                *(u32x4*)(p.u8 + (size_t)e * D_MODEL + lane * 16) = o;
                if (lane == 0) p.su[e] = am * (1.0f / 127.0f);
            }
            quant_row(fv, p.v8 + (size_t)e * ROWB, p.sv + e);
        }
    }
    const int wave = (b * blockDim.x + tid) >> 6, nwaves = (nb * blockDim.x) >> 6, lane = tid & 63;
    for (int t = wave; t < T_TOK; t += 2 * nwaves) {
        const int t1 = t + nwaves; const bool two = t1 < T_TOK;
        const float4* xr0 = (const float4*)(p.x + (size_t)t * D_MODEL);
        const float4* xr1 = (const float4*)(p.x + (size_t)(two ? t1 : t) * D_MODEL);
        float4 v0[4], v1[4];
#pragma unroll
        for (int i = 0; i < 4; ++i) { v0[i] = xr0[lane + 64 * i]; v1[i] = xr1[lane + 64 * i]; }
        float s0 = 0.f, s1 = 0.f;
#pragma unroll
        for (int i = 0; i < 4; ++i) {
            s0 += v0[i].x * v0[i].x + v0[i].y * v0[i].y + v0[i].z * v0[i].z + v0[i].w * v0[i].w;
            s1 += v1[i].x * v1[i].x + v1[i].y * v1[i].y + v1[i].z * v1[i].z + v1[i].w * v1[i].w;
            uint2 o; o.x = pack2(v0[i].x, v0[i].y); o.y = pack2(v0[i].z, v0[i].w);
            ((uint2*)(p.xb + (size_t)t * D_MODEL))[lane + 64 * i] = o;
            if (two) { uint2 o1; o1.x = pack2(v1[i].x, v1[i].y); o1.y = pack2(v1[i].z, v1[i].w); ((uint2*)(p.xb + (size_t)t1 * D_MODEL))[lane + 64 * i] = o1; }
        }
        s0 = wave_sum(s0); s1 = wave_sum(s1);
        if (lane == 0) { p.rstd1[t] = rsqrtf(s0 * (1.0f / D_MODEL) + EPS); if (two) p.rstd1[t1] = rsqrtf(s1 * (1.0f / D_MODEL) + EPS); }
    }
}

typedef short s16x4 __attribute__((ext_vector_type(4)));
template <class Epi>
__device__ __forceinline__ void gemm128_sgu(const int tid, const bf16_t* __restrict__ A, const bf16_t* __restrict__ V  ,
                                            const float* __restrict__ lnm, const float* __restrict__ lnr, const float* __restrict__ gch, char* lds, const Epi& epi) {
    const int lane = tid & 63, wid = tid >> 6, wr = wid >> 1, wc = wid & 1, fr = lane & 15, fq = lane >> 4;
    constexpr int PITCH = 144, P2 = 288;
    char* sA = lds; char* sB = lds + 128 * PITCH;
    f32x4 acc[4][4];
#pragma unroll
    for (int m = 0; m < 4; ++m)
#pragma unroll
        for (int n = 0; n < 4; ++n) acc[m][n] = (f32x4){0.f, 0.f, 0.f, 0.f};
    u32x4 ra[4], rb[4]; float rm[4], rr[4];
    const int lrow = tid >> 3, lch = tid & 7;
    const int btok = tid >> 4, bch = tid & 15;
    const bf16_t* ga = A + (size_t)lrow * 128 + lch * 8;
    const bf16_t* gb = V + (size_t)btok * D_IN + bch * 8;
    float g8[8];
    { const float4 g0 = *(const float4*)(gch + bch * 8), g1 = *(const float4*)(gch + bch * 8 + 4); g8[0] = g0.x; g8[1] = g0.y; g8[2] = g0.z; g8[3] = g0.w; g8[4] = g1.x; g8[5] = g1.y; g8[6] = g1.z; g8[7] = g1.w; }
#pragma unroll
    for (int j = 0; j < 4; ++j) { ra[j] = *(const u32x4*)(ga + (size_t)(32 * j) * 128); rb[j] = *(const u32x4*)(gb + (size_t)(16 * j) * D_IN); rm[j] = lnm[btok + 16 * j]; rr[j] = lnr[btok + 16 * j]; }
    for (int k0 = 0; k0 < 128; k0 += 64) {
        __syncthreads();
#pragma unroll
        for (int j = 0; j < 4; ++j) {
            *(u32x4*)(sA + (lrow + 32 * j) * PITCH + lch * 16) = ra[j];
            u32x4 o;
#pragma unroll
            for (int i = 0; i < 4; ++i) {
                const unsigned w = rb[j][i];
                o[i] = pack2((bflo(w) - rm[j]) * rr[j] * g8[2 * i], (bfhi(w) - rm[j]) * rr[j] * g8[2 * i + 1]);
            }
            *(u32x4*)(sB + (btok + 16 * j) * P2 + bch * 16) = o;
        }
        __syncthreads();
        if (k0 + 64 < 128) {
#pragma unroll
            for (int j = 0; j < 4; ++j) { ra[j] = *(const u32x4*)(ga + (size_t)(32 * j) * 128 + 64); rb[j] = *(const u32x4*)(gb + (size_t)(64 + 16 * j) * D_IN); rm[j] = lnm[64 + btok + 16 * j]; rr[j] = lnr[64 + btok + 16 * j]; }
        }
#pragma unroll
        for (int kk = 0; kk < 2; ++kk) {
            bf16x8 af[4], bfr[4];
#pragma unroll
            for (int m = 0; m < 4; ++m) af[m] = *(const bf16x8*)(sA + (wr * 64 + m * 16 + fr) * PITCH + (kk * 32 + fq * 8) * 2);
#pragma unroll
            for (int n = 0; n < 4; ++n) {
                const char* bp = sB + (kk * 32 + fq * 8 + (fr >> 2)) * P2 + (wc * 64 + n * 16 + 4 * (fr & 3)) * 2;
                const s16x4 lo = __builtin_amdgcn_ds_read_tr16_b64_v4i16((LAS s16x4*)(bp));
                const s16x4 hi = __builtin_amdgcn_ds_read_tr16_b64_v4i16((LAS s16x4*)(bp + 4 * P2));
                bfr[n] = (bf16x8){lo[0], lo[1], lo[2], lo[3], hi[0], hi[1], hi[2], hi[3]};
            }
#pragma unroll
            for (int m = 0; m < 4; ++m)
#pragma unroll
                for (int n = 0; n < 4; ++n) acc[m][n] = __builtin_amdgcn_mfma_f32_16x16x32_bf16(bfr[n], af[m], acc[m][n], 0, 0, 0);
        }
    }
#pragma unroll
    for (int m = 0; m < 4; ++m)
#pragma unroll
        for (int n = 0; n < 4; ++n) epi(wr * 64 + m * 16 + fr, wc * 64 + n * 16 + fq * 4, acc[m][n]);
}

#define PT_PITCH 272
#define MIXH_LDS (2 * 128 * PT_PITCH + 1024)
template <int W, class Epi>
__device__ __forceinline__ void pool_tile(const int tid, const bf16_t* __restrict__ zb0  , int pos0,
                                          const bf16_t* __restrict__ Bt, char* lds, const Epi& epi) {
    const int lane = tid & 63, wid = tid >> 6, wr = wid >> 1, wc = wid & 1, fr = lane & 15, fq = lane >> 4;
    char* sA = lds; char* sB = lds + 128 * PT_PITCH;
    __syncthreads();
#pragma unroll
    for (int j = 0; j < 8; ++j) { const int id = tid + 256 * j, row = id >> 4, ch = id & 15; *(u32x4*)(sB + row * PT_PITCH + ch * 16) = *(const u32x4*)(Bt + (size_t)row * 128 + ch * 8); }
#pragma unroll 1
    for (int j = 0; j < 8; ++j) {
        const int id = tid + 256 * j, row = id >> 4, ch = id & 15, pos = (pos0 + row) & (SEQ - 1);
        const bf16_t* zp = zb0 + (size_t)row * D_IN + ch * 8;
        u32x4 v[W];
#pragma unroll
        for (int k = 0; k < W; ++k) v[k] = *(const u32x4*)(zp - (size_t)(k <= pos ? k : 0) * D_IN);
        float sm[8];
#pragma unroll
        for (int i = 0; i < 8; ++i) sm[i] = 0.f;
#pragma unroll
        for (int k = 0; k < W; ++k) {
            const float m = (k <= pos) ? 1.f : 0.f;
#pragma unroll
            for (int i = 0; i < 4; ++i) { sm[2 * i] += m * bflo(v[k][i]); sm[2 * i + 1] += m * bfhi(v[k][i]); }
        }
        const float fn = (float)((pos + 1 < W) ? pos + 1 : W);
        u32x4 o;
#pragma unroll
        for (int i = 0; i < 4; ++i) o[i] = pack2(sm[2 * i] / fn - bflo(v[0][i]), sm[2 * i + 1] / fn - bfhi(v[0][i]));
        *(u32x4*)(sA + row * PT_PITCH + ch * 16) = o;
    }
    __syncthreads();
    f32x4 acc[4][4];
#pragma unroll
    for (int m = 0; m < 4; ++m)
#pragma unroll
        for (int n = 0; n < 4; ++n) acc[m][n] = (f32x4){0.f, 0.f, 0.f, 0.f};
#pragma unroll
    for (int kk = 0; kk < 4; ++kk) {
        bf16x8 af[4], bfr[4];
#pragma unroll
        for (int m = 0; m < 4; ++m) af[m] = *(const bf16x8*)(sA + (wr * 64 + m * 16 + fr) * PT_PITCH + (kk * 32 + fq * 8) * 2);
#pragma unroll
        for (int n = 0; n < 4; ++n) bfr[n] = *(const bf16x8*)(sB + (wc * 64 + n * 16 + fr) * PT_PITCH + (kk * 32 + fq * 8) * 2);
#pragma unroll
        for (int m = 0; m < 4; ++m)
#pragma unroll
            for (int n = 0; n < 4; ++n) acc[m][n] = __builtin_amdgcn_mfma_f32_16x16x32_bf16(bfr[n], af[m], acc[m][n], 0, 0, 0);
    }
#pragma unroll
    for (int m = 0; m < 4; ++m)
#pragma unroll
        for (int n = 0; n < 4; ++n) epi(wr * 64 + m * 16 + fr, wc * 64 + n * 16 + fq * 4, acc[m][n]);
}

__device__ void phase_mix_gemm(const Params& p, char* lds) {
    const int tidx_ = tid_opaque();
    const int npool = (T_TOK / 128) * 4, nsgu = (T_TOK / 128) * 4;
    const int half = tidx_ >> 8, ht = tidx_ & 255; lds += half * MIXH_LDS;
    for (int tile = 2 * blockIdx.x + half; tile < npool + nsgu; tile += 2 * gridDim.x) {
        if (tile < npool) {
            const int tm = tile >> 2, g = tile & 3;
            const float* ps = p.pool_scale + g * 128; bf16_t* co = p.cB + (size_t)tm * 128 * D_MODEL + g * 128;
            const bf16_t* z0 = p.zb + (size_t)tm * 128 * D_IN + g * 128; const bf16_t* bt = p.poolT + (size_t)g * 16384;
            auto epi = [&](int r, int c, f32x4 v) {
                const float4 sc = *(const float4*)(ps + c);
                uint2 o; o.x = pack2(v[0] * sc.x, v[1] * sc.y); o.y = pack2(v[2] * sc.z, v[3] * sc.w);
                *(uint2*)(co + (size_t)r * D_MODEL + c) = o;
            };
            if (g == 0) pool_tile<2>(ht, z0, tm * 128, bt, lds, epi); else if (g == 1) pool_tile<4>(ht, z0, tm * 128, bt, lds, epi);
            else if (g == 2) pool_tile<8>(ht, z0, tm * 128, bt, lds, epi); else pool_tile<16>(ht, z0, tm * 128, bt, lds, epi);
        } else {
            const int t2 = tile - npool, blk = t2 >> 2, h = t2 & 3;
            float* stm = (float*)(lds + GEMM_LDS_BYTES); float* str = stm + 128;
            __syncthreads();
            {
                const int tok = ht >> 1, hh = ht & 1;
                const u32x4* vp = (const u32x4*)(p.zb + (size_t)(blk * 128 + tok) * D_IN + 1024 + hh * 256);
                float s1 = 0.f, s2 = 0.f;
#pragma unroll 8
                for (int i = 0; i < 32; ++i) {
                    const u32x4 v = vp[i];
#pragma unroll
                    for (int k = 0; k < 4; ++k) { const float a = bflo(v[k]), c = bfhi(v[k]); s1 += a + c; s2 += a * a + c * c; }
                }
                s1 += __shfl_xor(s1, 1); s2 += __shfl_xor(s2, 1);
                const float mean = s1 * (1.0f / 512.0f), var = fmaxf(s2 * (1.0f / 512.0f) - mean * mean, 0.f);
                if (hh == 0) { stm[tok] = mean; str[tok] = rsqrtf(var + EPS); }
            }
            __syncthreads();
            const float* sb = p.sgu_b + h * 128; const bf16_t* uo = p.zb + (size_t)blk * 128 * D_IN + 512 + h * 128;
            bf16_t* co = p.cB + (size_t)blk * 128 * D_MODEL + 512 + h * 128;
            gemm128_sgu(ht, p.wsM + (size_t)h * 16384, p.zb + (size_t)blk * 128 * D_IN + 1024 + h * 128, stm, str, p.sgu_norm_g + h * 128, lds,
                    [&](int r, int c, f32x4 v) {
                        const float bb = sb[r];
                        const uint2 uu = *(const uint2*)(uo + (size_t)r * D_IN + c);
                        uint2 o;
                        o.x = pack2((v[0] + bb) * bflo(uu.x), (v[1] + bb) * bfhi(uu.x));
                        o.y = pack2((v[2] + bb) * bflo(uu.y), (v[3] + bb) * bfhi(uu.y));
                        *(uint2*)(co + (size_t)r * D_MODEL + c) = o;
                    });
        }
    }
}

__device__ __forceinline__ int wave_sum_i_uniform(int s) {
    s += __builtin_amdgcn_update_dpp(0, s, 0xB1, 0xf, 0xf, false);
    s += __builtin_amdgcn_update_dpp(0, s, 0x4E, 0xf, 0xf, false);
    s += __builtin_amdgcn_update_dpp(0, s, 0x141, 0xf, 0xf, false);
    s += __builtin_amdgcn_update_dpp(0, s, 0x140, 0xf, 0xf, false);
    return __builtin_amdgcn_readlane(s, 0) + __builtin_amdgcn_readlane(s, 16) + __builtin_amdgcn_readlane(s, 32) + __builtin_amdgcn_readlane(s, 48);
}
__constant__ unsigned char kComb[64] = {
    0x00,0x01,0x02,0x03,0x04,0x05,0x06,0x07,0x08,0x09,0x0a,0x0b,0x0c,0x0d,0x0e,0x0f,
    0x10,0x11,0x12,0x13,0x14,0x15,0x16,0x17,
    0x20,0x21,0x22,0x23,0x24,
    0x30,0x31,0x32,0x33,
    0x40,0x41,0x42,
    0x50,0x51,
    0x60,0x61,
    0x70,0x71,
    0x80,0x90,0xa0,0xb0,0xc0,0xd0,0xe0,0xf0,
    0xff,0xff,0xff,0xff,0xff,0xff,0xff,0xff,0xff,0xff,0xff,0xff,0xff,0xff};

template <int CTRL> __device__ __forceinline__ int dpp_i(int v) { return __builtin_amdgcn_update_dpp(0, v, CTRL, 0xf, 0xf, false); }
__device__ __forceinline__ int row_allmax_i(int v) {
    v = max(v, dpp_i<0x128>(v)); v = max(v, dpp_i<0x124>(v)); v = max(v, dpp_i<0x122>(v)); v = max(v, dpp_i<0x121>(v));
    return v;
}
__device__ __forceinline__ float row_allsum_f(float v) {
    v += __int_as_float(dpp_i<0x128>(__float_as_int(v))); v += __int_as_float(dpp_i<0x124>(__float_as_int(v)));
    v += __int_as_float(dpp_i<0x122>(__float_as_int(v))); v += __int_as_float(dpp_i<0x121>(__float_as_int(v)));
    return v;
}
__device__ __forceinline__ int f2key(float f) { const int b = __float_as_int(f); return b ^ ((b >> 31) & 0x7fffffff); }
__device__ __forceinline__ float key2f(int k) { return __int_as_float(k ^ ((k >> 31) & 0x7fffffff)); }
#define KEY_MIN ((int)0x80000000)
#define CE(a, b) { const int hi_ = max(a, b), lo_ = min(a, b); a = hi_; b = lo_; }
__device__ __forceinline__ int top16_rows(int (&k)[8], int l15) {
    CE(k[0], k[1]) CE(k[2], k[3]) CE(k[4], k[5]) CE(k[6], k[7])
    CE(k[0], k[2]) CE(k[1], k[3]) CE(k[4], k[6]) CE(k[5], k[7])
    CE(k[1], k[2]) CE(k[5], k[6])
    CE(k[0], k[4]) CE(k[1], k[5]) CE(k[2], k[6]) CE(k[3], k[7])
    CE(k[2], k[4]) CE(k[3], k[5])
    CE(k[1], k[2]) CE(k[3], k[4]) CE(k[5], k[6])
    int res = KEY_MIN;
#pragma unroll
    for (int r = 0; r < 16; ++r) {
        const int m = row_allmax_i(k[0]);
        const bool own = (k[0] == m);
#pragma unroll
        for (int j = 0; j < 7; ++j) k[j] = own ? k[j + 1] : k[j];
        k[7] = own ? KEY_MIN : k[7];
        res = (l15 == r) ? m : res;
    }
    return res;
}
__device__ __forceinline__ void combine16(int A, int B, const int (&cbv)[4], int lane, int l15, int& eid_out, float& gate_out) {
    const int rowbase = lane & 48;
    int ck[4], eid[4];
#pragma unroll
    for (int c = 0; c < 4; ++c) {
        const int ci = (cbv[c] >> 4) & 15, cj = cbv[c] & 15;
        const int ka = __builtin_amdgcn_ds_bpermute((rowbase + ci) << 2, A);
        const int kb = __builtin_amdgcn_ds_bpermute((rowbase + cj) << 2, B);
        const float sm = key2f(ka & ~127) + key2f(kb & ~127);
        eid[c] = ((127 - (ka & 127)) << 7) | (127 - (kb & 127));
        ck[c] = (cbv[c] != 0xff) ? ((f2key(sm) & ~63) | (63 - (4 * l15 + c))) : KEY_MIN;
    }
    CE(ck[0], ck[1]) CE(ck[2], ck[3]) CE(ck[0], ck[2]) CE(ck[1], ck[3]) CE(ck[1], ck[2])
    int res = KEY_MIN;
#pragma unroll
    for (int r = 0; r < 16; ++r) {
        const int m = row_allmax_i(ck[0]);
        const bool own = (ck[0] == m);
        ck[0] = own ? ck[1] : ck[0]; ck[1] = own ? ck[2] : ck[1]; ck[2] = own ? ck[3] : ck[2]; ck[3] = own ? KEY_MIN : ck[3];
        res = (l15 == r) ? m : res;
    }
    const int slot = 63 - (res & 63);
    const int src = (rowbase + (slot >> 2)) << 2;
    const int e0 = __builtin_amdgcn_ds_bpermute(src, eid[0]), e1 = __builtin_amdgcn_ds_bpermute(src, eid[1]);
    const int e2 = __builtin_amdgcn_ds_bpermute(src, eid[2]), e3 = __builtin_amdgcn_ds_bpermute(src, eid[3]);
    const int sel = slot & 3;
    eid_out = sel == 0 ? e0 : (sel == 1 ? e1 : (sel == 2 ? e2 : e3));
    gate_out = key2f(res & ~63);
}

__device__ __forceinline__ int reduce16_rows(const int (&part)[16], bool b3, bool b2, bool b1, bool b0b) {
    int r8[8], r4[4], r2[2];
#pragma unroll
    for (int k = 0; k < 8; ++k) { const int keep = b3 ? part[8 + k] : part[k], send = b3 ? part[k] : part[8 + k]; r8[k] = keep + __builtin_amdgcn_update_dpp(0, send, 0x140, 0xf, 0xf, false); }
#pragma unroll
    for (int k = 0; k < 4; ++k) { const int keep = b2 ? r8[4 + k] : r8[k], send = b2 ? r8[k] : r8[4 + k]; r4[k] = keep + __builtin_amdgcn_update_dpp(0, send, 0x141, 0xf, 0xf, false); }
#pragma unroll
    for (int k = 0; k < 2; ++k) { const int keep = b1 ? r4[2 + k] : r4[k], send = b1 ? r4[k] : r4[2 + k]; r2[k] = keep + __builtin_amdgcn_update_dpp(0, send, 0x4E, 0xf, 0xf, false); }
    const int keep = b0b ? r2[1] : r2[0], send = b0b ? r2[0] : r2[1];
    int r1 = keep + __builtin_amdgcn_update_dpp(0, send, 0xB1, 0xf, 0xf, false);
    r1 += __shfl_xor(r1, 16); r1 += __shfl_xor(r1, 32);
    return r1;
}
#define TS_WBYTES (16384 + 128)
__device__ void phase_peer_dots(const Params& p, char* lds) {
    const int tidx_ = tid_opaque();
    const int lane = tidx_ & 63, wid = __builtin_amdgcn_readfirstlane((int)(tidx_ >> 6)), l15 = lane & 15;
    const bool b3 = (lane & 8) != 0, b2 = (lane & 4) != 0, b1 = (lane & 2) != 0, b0b = (lane & 1) != 0;
    const int gw = blockIdx.x * (blockDim.x >> 6) + wid, ngw = gridDim.x * (blockDim.x >> 6);
    char* wl = lds + wid * TS_WBYTES;
    unsigned* list = (unsigned*)wl; int* dotsl = (int*)(wl + 4096); char* hql = wl + 8192; int* tks = (int*)(wl + 16384);
    const unsigned lane16 = (unsigned)lane * 16u;
    for (int tb = gw * 8; tb < T_TOK; tb += ngw * 8) {
#pragma unroll 1
        for (int j0 = 0; j0 < 8; j0 += 4) {
            u32x4 hraw[4][2];
#pragma unroll
            for (int jj = 0; jj < 4; ++jj) { const u32x4* hr = (const u32x4*)(p.hb + (size_t)(tb + j0 + jj) * D_MODEL); hraw[jj][0] = hr[2 * lane]; hraw[jj][1] = hr[2 * lane + 1]; }
#pragma unroll
            for (int jj = 0; jj < 4; ++jj) {
                const int j = j0 + jj;
                const u32x4 a = hraw[jj][0], c = hraw[jj][1];
                const float f[16] = {bflo(a.x), bfhi(a.x), bflo(a.y), bfhi(a.y), bflo(a.z), bfhi(a.z), bflo(a.w), bfhi(a.w),
                                     bflo(c.x), bfhi(c.x), bflo(c.y), bfhi(c.y), bflo(c.z), bfhi(c.z), bflo(c.w), bfhi(c.w)};
                float ss = 0.f, am = 0.f;
#pragma unroll
                for (int k = 0; k < 16; ++k) { ss += f[k] * f[k]; am = fmaxf(am, fabsf(f[k])); }
                ss = wave_sum(ss); am = wave_max(am);
                const float inv = am > 0.f ? 127.0f / am : 0.f;
                u32x4 o; int hsum = 0;
#pragma unroll
                for (int i = 0; i < 4; ++i) {
                    unsigned w = 0;
#pragma unroll
                    for (int k = 0; k < 4; ++k) { const int qv = (int)rintf(f[4 * i + k] * inv); hsum += qv; w |= (unsigned)(qv & 0xff) << (8 * k); }
                    o[i] = w;
                }
                *(u32x4*)(hql + j * 1024 + lane * 16) = o;
                hsum = wave_sum_i_uniform(hsum);
                const float r2 = rsqrtf(ss * (1.0f / D_MODEL) + EPS);
                if (lane == 0) { tks[4 * j] = hsum; tks[4 * j + 1] = __float_as_int(am * (1.0f / 127.0f) * r2); tks[4 * j + 2] = __float_as_int(r2); }
            }
        }
        int idv[8][2];
#pragma unroll
        for (int j = 0; j < 8; ++j) { const int* ir = p.idx + (size_t)(tb + j) * 128; idv[j][0] = ir[lane]; idv[j][1] = ir[64 + lane]; }
#pragma unroll 1
        for (int x = 0; x < 8; ++x) {
            int n = 0;
#pragma unroll
            for (int j = 0; j < 8; ++j)
#pragma unroll
                for (int r = 0; r < 2; ++r) {
                    const int e = idv[j][r];
                    const bool in = (e >> 11) == x;
                    const unsigned long long mk = __ballot(in);
                    const int rank = (int)__builtin_amdgcn_mbcnt_hi((unsigned)(mk >> 32), __builtin_amdgcn_mbcnt_lo((unsigned)mk, 0u));
                    if (in) list[n + rank] = ((unsigned)j << 21) | ((unsigned)(r * 64 + lane) << 14) | (unsigned)e;
                    n += (int)__builtin_popcountll(mk);
                }
            asm volatile("s_waitcnt lgkmcnt(0)" ::: "memory");
            u32x4 ua[16], ubf[16]; int enta = 0, entb = 0;
            auto issue = [&](int b0, u32x4 (&uu)[16], int& entv) {
                const int i = (b0 + l15 < n) ? b0 + l15 : n - 1;
                entv = (int)list[i];
#pragma unroll
                for (int j = 0; j < 16; ++j) { const int e = __builtin_amdgcn_readlane(entv, j) & 0x3fff; uu[j] = *(const u32x4*)(p.u8 + (size_t)e * D_MODEL + lane16); }
            };
            auto reduce = [&](int b0, const u32x4 (&uu)[16], int entv) {
                int part[16];
#pragma unroll
                for (int j = 0; j < 16; ++j) {
                    const int tl = __builtin_amdgcn_readlane(entv, j) >> 21;
                    const u32x4 hqv = *(const u32x4*)(hql + tl * 1024 + lane * 16);
                    int sacc = __builtin_amdgcn_sdot4((int)uu[j].x, (int)hqv.x, 0, false);
                    sacc = __builtin_amdgcn_sdot4((int)uu[j].y, (int)hqv.y, sacc, false);
                    sacc = __builtin_amdgcn_sdot4((int)uu[j].z, (int)hqv.z, sacc, false);
                    part[j] = __builtin_amdgcn_sdot4((int)uu[j].w, (int)hqv.w, sacc, false);
                }
                const int r1 = reduce16_rows(part, b3, b2, b1, b0b);
                if (lane < 16 && b0 + lane < n) dotsl[((unsigned)entv >> 21) * 128 + (((unsigned)entv >> 14) & 127u)] = r1;
            };
            if (n > 0) issue(0, ua, enta);
            for (int b0 = 0; b0 < n; b0 += 32) {
                if (b0 + 16 < n) issue(b0 + 16, ubf, entb);
                reduce(b0, ua, enta);
                if (b0 + 16 < n) {
                    if (b0 + 32 < n) issue(b0 + 32, ua, enta);
                    reduce(b0 + 16, ubf, entb);
                }
            }
            asm volatile("s_waitcnt lgkmcnt(0)" ::: "memory");
        }
#pragma unroll
        for (int j = 0; j < 8; ++j) {
            const int hs_t = tks[4 * j]; const float cs_t = __int_as_float(tks[4 * j + 1]), r2_t = __int_as_float(tks[4 * j + 2]);
            const float* gr = p.gate + (size_t)(tb + j) * 128; float* cr = p.coef + (size_t)(tb + j) * 128;
#pragma unroll
            for (int r = 0; r < 2; ++r) {
                const int e = idv[j][r];
                const float sc = gr[r * 64 + lane] * r2_t;
                const float ex = __expf(sc - key2f(row_allmax_i(f2key(sc))));
                const float gt = ex / row_allsum_f(ex);
                const float dotf = (float)dotsl[j * 128 + r * 64 + lane] * cs_t * p.su[e];
                cr[r * 64 + lane] = gt * gelu_t(dotf) * p.sv[e];
            }
        }
        asm volatile("s_waitcnt lgkmcnt(0)" ::: "memory");
    }
}

__device__ void phase_gather(const Params& p, char* lds) {
    const int tidx_ = tid_opaque();
    const int wave = __builtin_amdgcn_readfirstlane((int)((blockIdx.x * blockDim.x + tidx_) >> 6)), nwaves = (gridDim.x * blockDim.x) >> 6, lane = tidx_ & 63;
    const unsigned char* vb = p.v8 + lane * 12;
    for (int t = wave; t < T_TOK; t += nwaves) {
        int idr[2]; float coef[2];
        { const int* ir = p.idx + (size_t)t * 128; idr[0] = ir[lane]; idr[1] = ir[64 + lane]; }
        { const float* cr = p.coef + (size_t)t * 128; coef[0] = cr[lane]; coef[1] = cr[64 + lane]; }
        const float cmax = wave_max(fmaxf(fabsf(coef[0]), fabsf(coef[1])));
        const float qs = cmax > 0.f ? 127.0f / cmax : 0.f, cscale = cmax * (1.0f / 127.0f);
        const int cq0 = (int)rintf(coef[0] * qs), cq1 = (int)rintf(coef[1] * qs);
        const int csum_i = wave_sum_i_uniform(cq0 + cq1);
        unsigned cpk[2];
        {
            const int cqs[2] = {cq0, cq1};
#pragma unroll
            for (int hf = 0; hf < 2; ++hf) {
                const int bb = cqs[hf] & 0xff;
                cpk[hf] = (unsigned)__builtin_amdgcn_update_dpp(0, bb, 0x00, 0xf, 0xf, false) | ((unsigned)__builtin_amdgcn_update_dpp(0, bb, 0x55, 0xf, 0xf, false) << 8)
                        | ((unsigned)__builtin_amdgcn_update_dpp(0, bb, 0xAA, 0xf, 0xf, false) << 16) | ((unsigned)__builtin_amdgcn_update_dpp(0, bb, 0xFF, 0xf, 0xf, false) << 24);
            }
        }
        int acc[16];
#pragma unroll
        for (int j = 0; j < 16; ++j) acc[j] = 0;
        {
            u32x3 va[8], vbf[8];
            auto issue = [&](int pb, u32x3 (&vv)[8]) {
#pragma unroll
                for (int q = 0; q < 8; ++q) { const int e = __builtin_amdgcn_readlane(pb < 64 ? idr[0] : idr[1], (pb & 63) + q); vv[q] = *(const u32x3*)(vb + (size_t)e * ROWB); }
            };
            auto axpy = [&](int pb, const u32x3 (&vv)[8]) {
#pragma unroll
                for (int g4 = 0; g4 < 2; ++g4) {
                    const int cqd = __builtin_amdgcn_readlane((int)(pb < 64 ? cpk[0] : cpk[1]), (pb & 63) + 4 * g4);
                    unsigned dd[4][4];
#pragma unroll
                    for (int r = 0; r < 4; ++r) {
                        const unsigned w0 = vv[4 * g4 + r].x, w1 = vv[4 * g4 + r].y, w2 = vv[4 * g4 + r].z;
                        dd[r][0] = w0 & 0x3f3f3f3fu; dd[r][1] = w1 & 0x3f3f3f3fu; dd[r][2] = w2 & 0x3f3f3f3fu;
                        dd[r][3] = ((w0 >> 6) & 0x03030303u) | ((w1 >> 4) & 0x0c0c0c0cu) | ((w2 >> 2) & 0x30303030u);
                    }
#pragma unroll
                    for (int k = 0; k < 4; ++k) {
                        const unsigned p0 = __builtin_amdgcn_perm(dd[1][k], dd[0][k], 0x05010400u), p1 = __builtin_amdgcn_perm(dd[1][k], dd[0][k], 0x07030602u);
                        const unsigned q0 = __builtin_amdgcn_perm(dd[3][k], dd[2][k], 0x05010400u), q1 = __builtin_amdgcn_perm(dd[3][k], dd[2][k], 0x07030602u);
                        const unsigned t0 = __builtin_amdgcn_perm(q0, p0, 0x05040100u), t1 = __builtin_amdgcn_perm(q0, p0, 0x07060302u);
                        const unsigned t2 = __builtin_amdgcn_perm(q1, p1, 0x05040100u), t3 = __builtin_amdgcn_perm(q1, p1, 0x07060302u);
                        acc[4 * k + 0] = __builtin_amdgcn_sdot4((int)t0, cqd, acc[4 * k + 0], false);
                        acc[4 * k + 1] = __builtin_amdgcn_sdot4((int)t1, cqd, acc[4 * k + 1], false);
                        acc[4 * k + 2] = __builtin_amdgcn_sdot4((int)t2, cqd, acc[4 * k + 2], false);
                        acc[4 * k + 3] = __builtin_amdgcn_sdot4((int)t3, cqd, acc[4 * k + 3], false);
                    }
                }
            };
            issue(0, va);
#pragma unroll 1
            for (int pb = 0; pb < 128; pb += 16) {
                issue(pb + 8, vbf);
                axpy(pb, va);
                if (pb + 16 < 128) issue(pb + 16, va);
                axpy(pb + 8, vbf);
            }
        }
        const u32x4* hr = (const u32x4*)(p.hb + (size_t)t * D_MODEL + lane * 16);
        const u32x4 ha = hr[0], hc = hr[1];
        const float hf16[16] = {bflo(ha.x), bfhi(ha.x), bflo(ha.y), bfhi(ha.y), bflo(ha.z), bfhi(ha.z), bflo(ha.w), bfhi(ha.w),
                                bflo(hc.x), bfhi(hc.x), bflo(hc.y), bfhi(hc.y), bflo(hc.z), bfhi(hc.z), bflo(hc.w), bfhi(hc.w)};
        float res[16];
        float ss = 0.f;
#pragma unroll
        for (int j = 0; j < 16; ++j) { res[j] = hf16[j] + cscale * (float)(acc[j] - 32 * csum_i); ss += res[j] * res[j]; }
        ss = wave_sum(ss);
        const float r3 = rsqrtf(ss * (1.0f / D_MODEL) + EPS);
        float* o = p.out + (size_t)t * D_MODEL + lane * 16;
        const float* fg = p.final_g + lane * 16;
#pragma unroll
        for (int i = 0; i < 4; ++i) {
            const float4 g = ((const float4*)fg)[i];
            float4 ov; ov.x = res[4 * i] * r3 * g.x; ov.y = res[4 * i + 1] * r3 * g.y; ov.z = res[4 * i + 2] * r3 * g.z; ov.w = res[4 * i + 3] * r3 * g.w;
            ((float4*)o)[i] = ov;
        }
    }
}

namespace pg8 {
#define PG8_LAS __attribute__((address_space(3)))
constexpr int BM = 256, BK = 64, HALF = 128, HTB = HALF * BK * 2, STAGE_BYTES = 8 * HTB, NXCD = 8, WGM = 8;
__host__ __device__ __forceinline__ int lds_byte(int r, int c) { const int st = (r >> 4) * 2 + (c >> 5), rr = r & 15, cc = c & 31, ob = rr * 64 + cc * 2; return st * 1024 + (ob ^ (((ob >> 9) & 1) << 5)); }
__host__ __device__ __forceinline__ void stage_rc(int b, int& R, int& C) { const int st = b / 1024, sb = b % 1024, swz = sb ^ (((sb >> 9) & 1) << 5); R = (st >> 1) * 16 + swz / 64; C = (st & 1) * 32 + (swz % 64) / 2; }
__host__ __device__ __forceinline__ int perm32(int rho) { const int n = rho >> 4, i = rho & 15; return 8 * (i >> 2) + 4 * n + (i & 3); }
struct Unit { int pm, pn; };
struct Gemm { const bf16_t* A; const bf16_t* Bt; int M, N, K; };
struct StaticOrder {
    int nM, nN, nwg, G, c;
    __host__ __device__ void init(int M, int N, int G_, int c_) { nM = M / BM; nN = N / BM; nwg = nM * nN; G = G_; c = c_; }
    __host__ __device__ bool next(int i, Unit& u) const {
        const long L = (long)i * G + c; if (L >= nwg) return false;
        int wgid = (int)L; { const int q = nwg / NXCD, r = nwg % NXCD, xcd = wgid % NXCD, off = wgid / NXCD; wgid = (xcd < r ? xcd * (q + 1) : r * (q + 1) + (xcd - r) * q) + off; }
        const int nig = WGM * nN, gid = wgid / nig, fm = gid * WGM, gsz = (nM - fm) < WGM ? (nM - fm) : WGM;
        u.pm = fm + ((wgid % nig) % gsz); u.pn = (wgid % nig) / gsz; return true;
    }
    __device__ __forceinline__ void a_ready(const Unit&) const {}
    __device__ __forceinline__ void done(const Unit&) const {}
};
__device__ __forceinline__ unsigned cvt_pk_bf16(float lo, float hi) { unsigned r; asm volatile("v_cvt_pk_bf16_f32 %0, %1, %2" : "=v"(r) : "v"(lo), "v"(hi)); return r; }
struct EpiZ {
    static constexpr bool PERM = true, AFTER_DRAIN = false;
    bf16_t* O; const float* rs;
    __device__ __forceinline__ void operator()(const f32x4 (&acc)[2][2][4][2], const Unit& u, int wr, int wc, int fr, int fq) const {
        const int row0 = u.pm * BM + wr * 64 + fr, col0 = u.pn * BM + wc * 32 + 8 * fq; const bool act = u.pn >= 2;
#pragma unroll
        for (int ai = 0; ai < 2; ++ai)
#pragma unroll
            for (int m = 0; m < 4; ++m) { const int r = row0 + ai * HALF + m * 16; const float sc = rs[r]; bf16_t* rowp = O + (size_t)r * D_IN + col0;
#pragma unroll
                for (int bj = 0; bj < 2; ++bj) { f32x4 v0 = acc[ai][bj][m][0] * sc, v1 = acc[ai][bj][m][1] * sc;
                    if (act) { v0 = (f32x4){gelu_t(v0[0]), gelu_t(v0[1]), gelu_t(v0[2]), gelu_t(v0[3])}; v1 = (f32x4){gelu_t(v1[0]), gelu_t(v1[1]), gelu_t(v1[2]), gelu_t(v1[3])}; }
                    u32x4 w; w.x = cvt_pk_bf16(v0[0], v0[1]); w.y = cvt_pk_bf16(v0[2], v0[3]); w.z = cvt_pk_bf16(v1[0], v1[1]); w.w = cvt_pk_bf16(v1[2], v1[3]);
                    *(u32x4*)(rowp + bj * HALF) = w; } }
    }
};
struct EpiOut {
    static constexpr bool PERM = true, AFTER_DRAIN = false;
    bf16_t* O; const float* X;
    __device__ __forceinline__ void operator()(const f32x4 (&acc)[2][2][4][2], const Unit& u, int wr, int wc, int fr, int fq) const {
        const int row0 = u.pm * BM + wr * 64 + fr, col0 = u.pn * BM + wc * 32 + 8 * fq;
#pragma unroll
        for (int ai = 0; ai < 2; ++ai)
#pragma unroll
            for (int m = 0; m < 4; ++m) { const size_t off = (size_t)(row0 + ai * HALF + m * 16) * D_MODEL + col0;
#pragma unroll
                for (int bj = 0; bj < 2; ++bj) { const f32x4 x0 = *(const f32x4*)(X + off + bj * HALF), x1 = *(const f32x4*)(X + off + bj * HALF + 4);
                    const f32x4 v0 = acc[ai][bj][m][0] + x0, v1 = acc[ai][bj][m][1] + x1;
                    u32x4 w; w.x = cvt_pk_bf16(v0[0], v0[1]); w.y = cvt_pk_bf16(v0[2], v0[3]); w.z = cvt_pk_bf16(v1[0], v1[1]); w.w = cvt_pk_bf16(v1[2], v1[3]);
                    *(u32x4*)(O + off + bj * HALF) = w; } }
    }
};
struct OneUnit {
    Unit u;
    __device__ __forceinline__ bool next(int i, Unit& o) const { if (i) return false; o = u; return true; }
    __device__ __forceinline__ void a_ready(const Unit&) const {}
    __device__ __forceinline__ void done(const Unit&) const {}
};
#define QT_PITCH 272
#define QT_LDS_BYTES (2 * 256 * QT_PITCH)
struct EpiQTopk {
    static constexpr bool PERM = true, AFTER_DRAIN = true;
    const bf16_t* keysB; int* idx; float* gate;
    __device__ __forceinline__ void fused(f32x4 (&acc)[2][2][4][2], const Unit& u, int wr, int wc, int fr, int fq, PG8_LAS unsigned char* ldsp, int wid, int lane) const {
        char* sQ = (char*)ldsp;
        const int h = u.pn;
#pragma unroll
        for (int ai = 0; ai < 2; ++ai)
#pragma unroll
            for (int m = 0; m < 4; ++m) { const int r = ai * HALF + wr * 64 + m * 16 + fr;
#pragma unroll
                for (int bj = 0; bj < 2; ++bj) { const f32x4 v0 = acc[ai][bj][m][0], v1 = acc[ai][bj][m][1];
                    u32x4 w; w.x = cvt_pk_bf16(v0[0], v0[1]); w.y = cvt_pk_bf16(v0[2], v0[3]); w.z = cvt_pk_bf16(v1[0], v1[1]); w.w = cvt_pk_bf16(v1[2], v1[3]);
                    *(u32x4*)(sQ + bj * (256 * QT_PITCH) + r * QT_PITCH + (wc * 32 + fq * 8) * 2) = w; } }
        __syncthreads();
        int cbv[4];
#pragma unroll
        for (int c = 0; c < 4; ++c) cbv[c] = kComb[4 * fr + c];
        int tA[2][4], tB[2][4];
#pragma unroll
        for (int m = 0; m < 2; ++m)
#pragma unroll
            for (int j = 0; j < 4; ++j) { tA[m][j] = 0; tB[m][j] = 0; }
#pragma unroll 1
        for (int pp = 0; pp < 2; ++pp) {
            const bf16_t* kb = keysB + (size_t)(pp * 8 + h) * 16384 + (size_t)fr * 128 + fq * 8;
            const char* qa = sQ + pp * (256 * QT_PITCH) + (wid * 32 + fr) * QT_PITCH + fq * 16;
            f32x4 sc2[2][8];
#pragma unroll
            for (int m = 0; m < 2; ++m)
#pragma unroll
                for (int nb = 0; nb < 8; ++nb) sc2[m][nb] = (f32x4){0.f, 0.f, 0.f, 0.f};
#pragma unroll
            for (int kk = 0; kk < 4; ++kk) {
                bf16x8 kf[8], af[2];
#pragma unroll
                for (int nb = 0; nb < 8; ++nb) kf[nb] = *(const bf16x8*)(kb + (size_t)nb * 16 * 128 + kk * 32);
#pragma unroll
                for (int m = 0; m < 2; ++m) af[m] = *(const bf16x8*)(qa + m * 16 * QT_PITCH + kk * 64);
#pragma unroll
                for (int m = 0; m < 2; ++m)
#pragma unroll
                    for (int nb = 0; nb < 8; ++nb) sc2[m][nb] = __builtin_amdgcn_mfma_f32_16x16x32_bf16(af[m], kf[nb], sc2[m][nb], 0, 0, 0);
            }
#pragma unroll
            for (int m = 0; m < 2; ++m)
#pragma unroll
                for (int j = 0; j < 4; ++j) tA[m][j] = tB[m][j];
#pragma unroll 2
            for (int it = 0; it < 4; ++it) {
#pragma unroll
                for (int m = 0; m < 2; ++m) {
                    int k[8];
#pragma unroll
                    for (int nb = 0; nb < 8; ++nb) k[nb] = (f2key(sc2[m][nb][0]) & ~127) | (127 - (16 * nb + fr));
                    const int r = top16_rows(k, fr);
                    tB[m][0] = tB[m][1]; tB[m][1] = tB[m][2]; tB[m][2] = tB[m][3]; tB[m][3] = r;
#pragma unroll
                    for (int nb = 0; nb < 8; ++nb) sc2[m][nb] = (f32x4){sc2[m][nb][1], sc2[m][nb][2], sc2[m][nb][3], sc2[m][nb][0]};
                }
            }
        }
#pragma unroll 2
        for (int it = 0; it < 4; ++it) {
#pragma unroll
            for (int m = 0; m < 2; ++m) {
                int eid; float gt;
                combine16(tA[m][0], tB[m][0], cbv, lane, fr, eid, gt);
                const int t = u.pm * BM + wid * 32 + m * 16 + fq * 4 + it;
                const size_t o = (size_t)t * 128 + h * 16 + fr;
                idx[o] = eid; gate[o] = gt;
                tA[m][0] = tA[m][1]; tA[m][1] = tA[m][2]; tA[m][2] = tA[m][3];
                tB[m][0] = tB[m][1]; tB[m][1] = tB[m][2]; tB[m][2] = tB[m][3];
            }
        }
        __syncthreads();
    }
};
template <class Epi, class Sched>
__device__ __forceinline__ void gemm_phase(PG8_LAS unsigned char* lds, const Gemm g, const Sched& S, const Epi& E) {
    const int tid = threadIdx.x, wid = __builtin_amdgcn_readfirstlane(tid >> 6), lane = tid & 63, wr = wid >> 2, wc = wid & 3, fr = lane & 15, fq = lane >> 4;
    const int K = g.K, nt = K / BK;
    unsigned voffA[2], voffB[2];
#pragma unroll
    for (int i = 0; i < 2; ++i) { int R, C; stage_rc(tid * 16 + i * 8192, R, C); const int Rb = Epi::PERM ? ((R & ~31) + perm32(R & 31)) : R;
        voffA[i] = (unsigned)(R * K + C) * 2u; voffB[i] = (unsigned)(Rb * K + C) * 2u; }
    const size_t kstep = (size_t)(BK * 2);
    const size_t hstep = (size_t)HALF * K * 2;
    const size_t tstep = 2 * hstep;
    const unsigned ldsw = (unsigned)wid * 1024u;
    const int aoff = lds_byte(wr * 64 + fr, fq * 8), boff = lds_byte(wc * 32 + fr, fq * 8);
#define PG8_SA(b, h) (((b) * 2 + (h)) * HTB)
#define PG8_SB(b, h) ((4 + (b) * 2 + (h)) * HTB)
#define PG8_STAGE(bufoff, gbase, voff) do { _Pragma("unroll") for (int _i = 0; _i < 2; ++_i) \
        __builtin_amdgcn_global_load_lds((const unsigned*)((const char*)(gbase) + (voff)[_i]), (PG8_LAS unsigned*)(lds + (bufoff) + ldsw + _i * 8192), 16, 0, 0); } while (0)
#define PG8_LDA(dst, b, h) do { _Pragma("unroll") for (int m = 0; m < 4; ++m) _Pragma("unroll") for (int k = 0; k < 2; ++k) dst[m][k] = *(const PG8_LAS bf16x8*)(lds + PG8_SA(b, h) + aoff + m * 2048 + k * 1024); } while (0)
#define PG8_LDB(dst, b, h) do { _Pragma("unroll") for (int n = 0; n < 2; ++n) _Pragma("unroll") for (int k = 0; k < 2; ++k) dst[n][k] = *(const PG8_LAS bf16x8*)(lds + PG8_SB(b, h) + boff + n * 2048 + k * 1024); } while (0)
#define PG8_MMA(ai, bj, At, Bt) do { __builtin_amdgcn_s_setprio(1); _Pragma("unroll") for (int m = 0; m < 4; ++m) _Pragma("unroll") for (int n = 0; n < 2; ++n) _Pragma("unroll") for (int k = 0; k < 2; ++k) \
        acc[ai][bj][m][n] = __builtin_amdgcn_mfma_f32_16x16x32_bf16(Bt[n][k], At[m][k], acc[ai][bj][m][n], 0, 0, 0); __builtin_amdgcn_s_setprio(0); } while (0)
#define PG8_WAIT_V(n) asm volatile("s_waitcnt vmcnt(" #n ")" ::: "memory")
#define PG8_WAIT_L(n) asm volatile("s_waitcnt lgkmcnt(" #n ")" ::: "memory")
#define PG8_BAR __builtin_amdgcn_s_barrier()
#define PG8_SCHED __builtin_amdgcn_sched_barrier(0)
    Unit cur, nxt; int ui = 0;
    if (!S.next(0, cur)) return;
    f32x4 acc[2][2][4][2];
#pragma unroll
    for (int a = 0; a < 2; ++a)
#pragma unroll
        for (int b = 0; b < 2; ++b)
#pragma unroll
            for (int m = 0; m < 4; ++m)
#pragma unroll
                for (int n = 0; n < 2; ++n) acc[a][b][m][n] = (f32x4){0.f, 0.f, 0.f, 0.f};
    bf16x8 At[4][2], B0[2][2], B1[2][2];
    const char* cA = (const char*)g.A + (size_t)cur.pm * tstep; const char* cB = (const char*)g.Bt + (size_t)cur.pn * tstep;
    S.a_ready(cur);
    PG8_STAGE(PG8_SB(0, 0), cB, voffB); PG8_STAGE(PG8_SA(0, 0), cA, voffA); PG8_STAGE(PG8_SB(0, 1), cB + hstep, voffB); PG8_STAGE(PG8_SA(0, 1), cA + hstep, voffA);
    if (wr == 1) PG8_BAR;
    PG8_WAIT_V(4); PG8_BAR;
    PG8_STAGE(PG8_SB(1, 0), cB + kstep, voffB); PG8_STAGE(PG8_SA(1, 0), cA + kstep, voffA); PG8_STAGE(PG8_SB(1, 1), cB + hstep + kstep, voffB);
    PG8_WAIT_V(6); PG8_BAR;
    for (;;) {
        const bool has_next = S.next(ui + 1, nxt);
        const char* nA = has_next ? (const char*)g.A + (size_t)nxt.pm * tstep : cA; const char* nB = has_next ? (const char*)g.Bt + (size_t)nxt.pn * tstep : cB;
        for (int t = 0; t < nt; t += 2) {
            const bool last = (t == nt - 2);
            const char* a1 = cA + (size_t)(t + 1) * kstep;
            const char* a2 = last ? nA : cA + (size_t)(t + 2) * kstep; const char* b2 = last ? nB : cB + (size_t)(t + 2) * kstep;
            const char* a3 = a2 + kstep; const char* b3 = b2 + kstep;
            if (last && has_next) S.a_ready(nxt);
            PG8_LDB(B0, 0, 0); PG8_SCHED; PG8_LDA(At, 0, 0); PG8_STAGE(PG8_SA(1, 1), a1 + hstep, voffA);
            PG8_WAIT_L(8); PG8_BAR; PG8_WAIT_L(0); PG8_MMA(0, 0, At, B0); PG8_BAR; PG8_SCHED;
            PG8_LDB(B1, 0, 1); PG8_STAGE(PG8_SB(0, 0), b2, voffB);
            PG8_BAR; PG8_WAIT_L(0); PG8_MMA(0, 1, At, B1); PG8_BAR;
            PG8_LDA(At, 0, 1); PG8_STAGE(PG8_SA(0, 0), a2, voffA);
            PG8_BAR; PG8_WAIT_L(0); PG8_MMA(1, 0, At, B0); PG8_BAR; PG8_SCHED;
            PG8_STAGE(PG8_SB(0, 1), b2 + hstep, voffB);
            PG8_WAIT_V(6); PG8_BAR; PG8_MMA(1, 1, At, B1); PG8_BAR;
            PG8_LDB(B0, 1, 0); PG8_SCHED; PG8_LDA(At, 1, 0); PG8_STAGE(PG8_SA(0, 1), a2 + hstep, voffA);
            PG8_WAIT_L(8); PG8_BAR; PG8_WAIT_L(0); PG8_MMA(0, 0, At, B0); PG8_BAR; PG8_SCHED;
            PG8_LDB(B1, 1, 1); PG8_STAGE(PG8_SB(1, 0), b3, voffB);
            PG8_BAR; PG8_WAIT_L(0); PG8_MMA(0, 1, At, B1); PG8_BAR;
            PG8_LDA(At, 1, 1); PG8_STAGE(PG8_SA(1, 0), a3, voffA);
            PG8_BAR; PG8_WAIT_L(0); PG8_MMA(1, 0, At, B0); PG8_BAR; PG8_SCHED;
            PG8_STAGE(PG8_SB(1, 1), b3 + hstep, voffB);
            PG8_WAIT_V(6); PG8_BAR; PG8_MMA(1, 1, At, B1); PG8_BAR;
        }
            if constexpr (!Epi::AFTER_DRAIN) { E(acc, cur, wr, wc, fr, fq); S.done(cur); }
            if (!has_next) break;
#pragma unroll
        for (int a = 0; a < 2; ++a)
#pragma unroll
            for (int b = 0; b < 2; ++b)
#pragma unroll
                for (int m = 0; m < 4; ++m)
#pragma unroll
                    for (int n = 0; n < 2; ++n) acc[a][b][m][n] = (f32x4){0.f, 0.f, 0.f, 0.f};
        cur = nxt; cA = nA; cB = nB; ++ui;
    }
    PG8_WAIT_V(0);
    if (wr == 0) PG8_BAR;
    PG8_BAR;
    if constexpr (Epi::AFTER_DRAIN) { E.fused(acc, cur, wr, wc, fr, fq, lds, wid, lane); S.done(cur); }
#undef PG8_SA
#undef PG8_SB
#undef PG8_STAGE
#undef PG8_LDA
#undef PG8_LDB
#undef PG8_MMA
#undef PG8_WAIT_V
#undef PG8_WAIT_L
#undef PG8_BAR
#undef PG8_SCHED
}
}

__device__ void phase_gemm_z(const Params& p, char* lds) {
    pg8::StaticOrder S; S.init(T_TOK, D_IN, gridDim.x, blockIdx.x);
    pg8::gemm_phase<pg8::EpiZ, pg8::StaticOrder>((PG8_LAS unsigned char*)lds, pg8::Gemm{p.xb, p.winT, T_TOK, D_IN, D_MODEL}, S, pg8::EpiZ{p.zb, p.rstd1});
}
__device__ void phase_gemm_out(const Params& p, char* lds) {
    pg8::StaticOrder S; S.init(T_TOK, D_MODEL, gridDim.x, blockIdx.x);
    pg8::gemm_phase<pg8::EpiOut, pg8::StaticOrder>((PG8_LAS unsigned char*)lds, pg8::Gemm{p.cB, p.woutT, T_TOK, D_MODEL, D_MODEL}, S, pg8::EpiOut{p.hb, p.x});
}
__device__ void phase_gemm_q(const Params& p, char* lds) {
    pg8::StaticOrder S; S.init(T_TOK, 2048, gridDim.x, blockIdx.x);
    pg8::Unit u;
    for (int i = 0; S.next(i, u); ++i)
        pg8::gemm_phase<pg8::EpiQTopk, pg8::OneUnit>((PG8_LAS unsigned char*)lds, pg8::Gemm{p.hb, p.wqT, T_TOK, 2048, D_MODEL}, pg8::OneUnit{u}, pg8::EpiQTopk{p.keysB, p.idx, p.gate});
}

#define XB_TMO      128
#define XB_XCNT(j)  (256  + 64 * (j))
#define XB_XSUB(j)  (1280 + 64 * (j))
#define XB_XGEN(j)  (2304 + 64 * (j))
#define XB_TOP      3328
#define XB_TOPGEN   3392
#define XCD_BAR_WORDS 3456
#define XB_SPIN_CAP (1u << 20)
__device__ __forceinline__ unsigned xb_ld(unsigned* p)              { return __hip_atomic_load(p, __ATOMIC_RELAXED, __HIP_MEMORY_SCOPE_AGENT); }
__device__ __forceinline__ unsigned xb_add(unsigned* p, unsigned v) { return __hip_atomic_fetch_add(p, v, __ATOMIC_RELAXED, __HIP_MEMORY_SCOPE_AGENT); }
__device__ __forceinline__ unsigned xb_xcc_id() { return (unsigned)__builtin_amdgcn_s_getreg((3 << 11) | 20) & 0xFu; }
#define XB_SPIN(cond, bar) do { unsigned _sp = 0; while (cond) { __builtin_amdgcn_s_sleep(1); \
    if ((++_sp & 255u) == 0u) { if (xb_ld(&(bar)[XB_TMO])) break; if (_sp > XB_SPIN_CAP) { atomicAdd(&(bar)[XB_TMO], 1u); break; } } } } while (0)
struct XcdBarrier { unsigned* bar; unsigned x; volatile LAS unsigned* st; };
__device__ __forceinline__ XcdBarrier xcd_barrier_post(unsigned* bar, volatile LAS unsigned* st) {
    XcdBarrier b; b.bar = bar; b.x = xb_xcc_id(); b.st = st;
    if (threadIdx.x == 0) (void)xb_add(&bar[XB_XCNT(b.x)], 1u);
    return b;
}
__device__ __forceinline__ void xcd_barrier_complete(unsigned* bar, unsigned x, unsigned& nloc, unsigned& nx) {
    const unsigned G = gridDim.x * gridDim.y * gridDim.z;
    unsigned sum, cnt, mine, sp = 0u;
    for (;;) {
        sum = 0u; cnt = 0u; mine = 0u;
#pragma unroll
        for (unsigned j = 0; j < 16; ++j) { const unsigned c = xb_ld(&bar[XB_XCNT(j)]); sum += c; cnt += (c > 0u) ? 1u : 0u; mine = (j == x) ? c : mine; }
        if (sum == G) break;
        __builtin_amdgcn_s_sleep(1);
        if ((++sp & 255u) == 0u) { if (xb_ld(&bar[XB_TMO])) break; if (sp > XB_SPIN_CAP) { atomicAdd(&bar[XB_TMO], 1u); break; } }
    }
    nloc = mine > 0u ? mine : 1u; nx = cnt > 0u ? cnt : 1u;
}
__device__ __forceinline__ void xcd_barrier(const XcdBarrier& b) {
    asm volatile("s_waitcnt vmcnt(0)" ::: "memory");
    __syncthreads();
    if (threadIdx.x == 0) {
        unsigned* bar = b.bar;
        __builtin_amdgcn_s_waitcnt(0);
        unsigned nloc = b.st[0], nx = b.st[1];
        if (nloc == 0u) { xcd_barrier_complete(bar, b.x, nloc, nx); b.st[0] = nloc; b.st[1] = nx; }
        const unsigned old = xb_add(&bar[XB_XSUB(b.x)], 1u);
        const unsigned gen = old / nloc;
        if (old + 1u == (gen + 1u) * nloc) {
            __builtin_amdgcn_fence(__ATOMIC_RELEASE, "agent");
            asm volatile("s_waitcnt vmcnt(0)" ::: "memory");
            const unsigned og = xb_add(&bar[XB_TOP], 1u);
            const unsigned tg = og / nx;
            if (og + 1u == (tg + 1u) * nx) xb_add(&bar[XB_TOPGEN], 1u);
            else XB_SPIN(xb_ld(&bar[XB_TOPGEN]) == tg, bar);
            __builtin_amdgcn_fence(__ATOMIC_ACQUIRE, "agent");
            xb_add(&bar[XB_XGEN(b.x)], 1u);
            asm volatile("s_waitcnt vmcnt(0)" ::: "memory");
        } else {
            XB_SPIN(xb_ld(&bar[XB_XGEN(b.x)]) == gen, bar);
            __builtin_amdgcn_fence(__ATOMIC_ACQUIRE, "agent");
            asm volatile("s_waitcnt vmcnt(0)" ::: "memory");
        }
    }
    __syncthreads();
}

#define MEGA_LDS_MAX2(a, b) ((a) > (b) ? (a) : (b))
#define MEGA_LDS_MAIN MEGA_LDS_MAX2(MEGA_LDS_MAX2(QT_LDS_BYTES, pg8::STAGE_BYTES), MEGA_LDS_MAX2(8 * TS_WBYTES, 2 * MIXH_LDS))
#define MEGA_LDS_BYTES (MEGA_LDS_MAIN + 16)
extern __shared__ __attribute__((aligned(16))) char smem[];
__global__ void __launch_bounds__(512, 2) fwd_mega(Params p) {
    volatile LAS unsigned* st = (volatile LAS unsigned*)(smem + MEGA_LDS_MAIN);
    if (threadIdx.x < 4) st[threadIdx.x] = 0u;
    __syncthreads();
    const XcdBarrier xb = xcd_barrier_post(p.bar, st);
    phase_prep(p, smem);      xcd_barrier(xb);
    phase_gemm_z(p, smem);    xcd_barrier(xb);
    phase_mix_gemm(p, smem);  xcd_barrier(xb);
    phase_gemm_out(p, smem);  xcd_barrier(xb);
    phase_gemm_q(p, smem);    xcd_barrier(xb);
    phase_peer_dots(p, smem); xcd_barrier(xb);
    phase_gather(p, smem);
}

extern "C" void kernel_launch(void* const* d_in, const int* in_sizes, int n_in, void* d_out, int out_size, void* d_ws, size_t ws_size, hipStream_t stream) {
    static int grid_blocks = 0;
    if (grid_blocks == 0) {
        int dev = 0, cus = 0, per_cu = 0;
        (void)hipGetDevice(&dev);
        (void)hipDeviceGetAttribute(&cus, hipDeviceAttributeMultiprocessorCount, dev);
        (void)hipFuncSetAttribute((const void*)fwd_mega, hipFuncAttributeMaxDynamicSharedMemorySize, MEGA_LDS_BYTES);
        (void)hipOccupancyMaxActiveBlocksPerMultiprocessor(&per_cu, (const void*)fwd_mega, 512, MEGA_LDS_BYTES);
        if (per_cu > 1) per_cu = 1;
        if (per_cu < 1) per_cu = 1;
        grid_blocks = cus * per_cu;
    }
    Params p{};
    p.x = (const float*)d_in[0]; p.norm1_g = (const float*)d_in[1]; p.w_in = (const float*)d_in[2]; p.pool_w = (const float*)d_in[3];
    p.pool_scale = (const float*)d_in[4]; p.sgu_norm_g = (const float*)d_in[5]; p.sgu_w = (const float*)d_in[6]; p.sgu_b = (const float*)d_in[7];
    p.w_out = (const float*)d_in[8]; p.norm2_g = (const float*)d_in[9]; p.peer_wq = (const float*)d_in[10]; p.peer_keys = (const float*)d_in[11];
    p.peer_u = (const float*)d_in[12]; p.peer_v = (const float*)d_in[13]; p.final_g = (const float*)d_in[14];
    p.out = (float*)d_out;
    char* w = (char*)d_ws; size_t off = 0;
    auto take = [&](size_t bytes) { char* r = w + off; off += (bytes + 255) & ~(size_t)255; return r; };
    const size_t MiB = 1024 * 1024;
    p.u8 = (unsigned char*)take(16 * MiB); p.v8 = (unsigned char*)take(12 * MiB);
    p.su = (float*)take(64 * 1024); p.sv = (float*)take(64 * 1024);
    p.winT = (bf16_t*)take(3 * MiB); p.woutT = (bf16_t*)take(2 * MiB); p.wqT = (bf16_t*)take(4 * MiB);
    p.poolT = (bf16_t*)take(128 * 1024); p.wsM = (bf16_t*)take(128 * 1024); p.keysB = (bf16_t*)take(512 * 1024);
    p.bar = (unsigned*)take(XCD_BAR_WORDS * 4);
    p.rstd1 = (float*)take(128 * 1024);
    p.idx = (int*)take(16 * MiB); p.gate = (float*)take(16 * MiB); p.coef = (float*)take(16 * MiB);
    p.xb = (bf16_t*)take(64 * MiB); p.zb = (bf16_t*)take(96 * MiB); p.cB = (bf16_t*)take(64 * MiB); p.hb = (bf16_t*)take(64 * MiB);
    (void)hipMemsetAsync(p.bar, 0, XCD_BAR_WORDS * 4, stream);
    hipLaunchKernelGGL(fwd_mega, dim3(grid_blocks), dim3(512), MEGA_LDS_BYTES, stream, p);
}
```

```cpp
#include <hip/hip_runtime.h>
#include <stdint.h>
#include <type_traits>

typedef unsigned short bf16_t;
typedef short bf16x8 __attribute__((ext_vector_type(8)));
typedef float f32x4 __attribute__((ext_vector_type(4)));
typedef unsigned u32x4 __attribute__((ext_vector_type(4)));
typedef unsigned u32x2 __attribute__((ext_vector_type(2)));
typedef unsigned u32x3 __attribute__((ext_vector_type(3)));
#define ROWB 768
typedef __bf16 bf2_t __attribute__((ext_vector_type(2)));
#define LAS __attribute__((address_space(3)))

#define T_TOK 32768
#define D_MODEL 1024
#define D_IN 1536
#define SEQ 2048
#define NEXP 16384
#define EPS 1e-6f

struct Params {
    const float *x, *norm1_g, *w_in, *pool_w, *pool_scale, *sgu_norm_g, *sgu_w, *sgu_b, *w_out, *norm2_g, *peer_wq, *peer_keys, *peer_u, *peer_v, *final_g;
    float* out;
    bf16_t *winT, *woutT, *wqT, *poolT, *wsM, *keysB;
    unsigned char *u8, *v8;
    float *su, *sv;
    float *rstd1;
    bf16_t *xb, *zb, *cB, *hb;
    int* idx; float* gate; float* coef;
    unsigned* bar;
};

__device__ __forceinline__ int tid_opaque() { int t = (int)threadIdx.x; asm volatile("" : "+v"(t)); return t; }
__device__ __forceinline__ unsigned short f2bf(float f) {
    unsigned u = __float_as_uint(f);
    u += 0x7fffu + ((u >> 16) & 1u);
    return (unsigned short)(u >> 16);
}
__device__ __forceinline__ float bf2f(unsigned short h) { return __uint_as_float(((unsigned)h) << 16); }
__device__ __forceinline__ unsigned pack2(float a, float b) { return (unsigned)f2bf(a) | ((unsigned)f2bf(b) << 16); }
__device__ __forceinline__ float bflo(unsigned w) { return __uint_as_float(w << 16); }
__device__ __forceinline__ float bfhi(unsigned w) { return __uint_as_float(w & 0xffff0000u); }
__device__ __forceinline__ float gelu_t(float x) {
    const float y = 1.5957691216057308f * (x + 0.044715f * x * x * x);
    return x / (1.0f + __expf(-y));
}
__device__ __forceinline__ float wave_sum(float v) {
#pragma unroll
    for (int o = 32; o >= 1; o >>= 1) v += __shfl_xor(v, o);
    return v;
}
__device__ __forceinline__ float wave_max(float v) {
#pragma unroll
    for (int o = 32; o >= 1; o >>= 1) v = fmaxf(v, __shfl_xor(v, o));
    return v;
}

#define GEMM_LDS_BYTES (2 * 128 * 144)
__device__ __forceinline__ void transpose_tile(const int tid, const float* __restrict__ src, bf16_t* __restrict__ dst, int R, int C, const float* __restrict__ rscale, int tile, float* lds) {
    const int tilesC = C / 64, tr = tile / tilesC, tc = tile % tilesC;
    const int ty = tid >> 6, tx = tid & 63;
    __syncthreads();
#pragma unroll
    for (int i = 0; i < 16; ++i) {
        const int r = ty + 4 * i;
        float v = src[(size_t)(tr * 64 + r) * C + tc * 64 + tx];
        if (rscale) v *= rscale[tr * 64 + r];
        lds[r * 65 + tx] = v;
    }
    __syncthreads();
#pragma unroll
    for (int i = 0; i < 16; ++i) {
        const int c = ty + 4 * i;
        dst[(size_t)(tc * 64 + c) * R + tr * 64 + tx] = f2bf(lds[tx * 65 + c]);
    }
}

__device__ void phase_prep(const Params& p, char* lds) {
    const int tidx_ = tid_opaque();
    const int nb = gridDim.x, b = blockIdx.x, tid = tidx_;
    const int half = tid >> 8, ht = tid & 255, nh = 2 * nb, hb2 = 2 * b + half;
    float* fl = (float*)(lds + half * (64 * 65 * 4));
    for (int t = hb2; t < 16 * 24; t += nh) transpose_tile(ht, p.w_in, p.winT, 1024, 1536, p.norm1_g, t, fl);
    for (int t = hb2; t < 16 * 16; t += nh) transpose_tile(ht, p.w_out, p.woutT, 1024, 1024, nullptr, t, fl);
    for (int t = hb2; t < 16 * 32; t += nh) transpose_tile(ht, p.peer_wq, p.wqT, 1024, 2048, p.norm2_g, t, fl);
    for (int t = hb2; t < 16; t += nh) transpose_tile(ht, p.pool_w + (size_t)(t >> 2) * 16384, p.poolT + (size_t)(t >> 2) * 16384, 128, 128, nullptr, t & 3, fl);
    const size_t gtid = (size_t)b * blockDim.x + tid, gsz = (size_t)nb * blockDim.x;
    for (size_t i = gtid; i < 4 * 128 * 128; i += gsz) {
        const int j = (int)(i & 127), ii = (int)((i >> 7) & 127);
        const bool keep = (j >> 6) <= (ii >> 6);
        p.wsM[i] = keep ? f2bf(p.sgu_w[i]) : (bf16_t)0;
    }
    for (size_t i = gtid; i < 2 * 8 * 128 * 128; i += gsz) p.keysB[i] = f2bf(p.peer_keys[i]);
    {
        const int wave = (b * blockDim.x + tid) >> 6, nwaves = (nb * blockDim.x) >> 6, lane = tid & 63;
        float g16[16];
#pragma unroll
        for (int i = 0; i < 4; ++i) { const float4 g = ((const float4*)(p.norm2_g + lane * 16))[i]; g16[4 * i] = g.x; g16[4 * i + 1] = g.y; g16[4 * i + 2] = g.z; g16[4 * i + 3] = g.w; }
        auto quant_row = [&](const float (&f)[16], unsigned char* dst, float* scale_out) {
            float am = 0.f;
#pragma unroll
            for (int j = 0; j < 16; ++j) am = fmaxf(am, fabsf(f[j]));
            am = wave_max(am);
            const float inv = am > 0.f ? 31.0f / am : 0.f;
            int q[16];
#pragma unroll
            for (int j = 0; j < 16; ++j) q[j] = (int)rintf(f[j] * inv) + 32;
            u32x3 o;
#pragma unroll
            for (int i = 0; i < 3; ++i) {
                unsigned w = 0;
#pragma unroll
                for (int k = 0; k < 4; ++k) w |= (unsigned)(q[4 * i + k] | (((q[12 + k] >> (2 * i)) & 3) << 6)) << (8 * k);
                o[i] = w;
            }
            *(u32x3*)(dst + lane * 12) = o;
            if (lane == 0) *scale_out = am * (1.0f / 31.0f);
        };
        for (int e = wave; e < NEXP; e += nwaves) {
            const float4* su4 = (const float4*)(p.peer_u + (size_t)e * D_MODEL + lane * 16);
            const float4* sv4 = (const float4*)(p.peer_v + (size_t)e * D_MODEL + lane * 16);
            float4 a4[4], b4[4];
#pragma unroll
            for (int i = 0; i < 4; ++i) { a4[i] = su4[i]; b4[i] = sv4[i]; }
            float fu[16], fv[16];
#pragma unroll
            for (int i = 0; i < 4; ++i) {
                fu[4 * i] = a4[i].x * g16[4 * i]; fu[4 * i + 1] = a4[i].y * g16[4 * i + 1]; fu[4 * i + 2] = a4[i].z * g16[4 * i + 2]; fu[4 * i + 3] = a4[i].w * g16[4 * i + 3];
                fv[4 * i] = b4[i].x; fv[4 * i + 1] = b4[i].y; fv[4 * i + 2] = b4[i].z; fv[4 * i + 3] = b4[i].w;
            }
            {
                float am = 0.f;
#pragma unroll
                for (int j = 0; j < 16; ++j) am = fmaxf(am, fabsf(fu[j]));
                am = wave_max(am);
                const float inv = am > 0.f ? 127.0f / am : 0.f;
                u32x4 o;
#pragma unroll
                for (int i = 0; i < 4; ++i) {
                    unsigned w = 0;
#pragma unroll
                    for (int k = 0; k < 4; ++k) w |= (unsigned)(((int)rintf(fu[4 * i + k] * inv)) & 0xff) << (8 * k);
                    o[i] = w;
                }
                *(u32x4*)(p.u8 + (size_t)e * D_MODEL + lane * 16) = o;
                if (lane == 0) p.su[e] = am * (1.0f / 127.0f);
            }
            quant_row(fv, p.v8 + (size_t)e * ROWB, p.sv + e);
        }
    }
    const int wave = (b * blockDim.x + tid) >> 6, nwaves = (nb * blockDim.x) >> 6, lane = tid & 63;
    for (int t = wave; t < T_TOK; t += 2 * nwaves) {
        const int t1 = t + nwaves; const bool two = t1 < T_TOK;
        const float4* xr0 = (const float4*)(p.x + (size_t)t * D_MODEL);
        const float4* xr1 = (const float4*)(p.x + (size_t)(two ? t1 : t) * D_MODEL);
        float4 v0[4], v1[4];
#pragma unroll
        for (int i = 0; i < 4; ++i) { v0[i] = xr0[lane + 64 * i]; v1[i] = xr1[lane + 64 * i]; }
        float s0 = 0.f, s1 = 0.f;
#pragma unroll
        for (int i = 0; i < 4; ++i) {
            s0 += v0[i].x * v0[i].x + v0[i].y * v0[i].y + v0[i].z * v0[i].z + v0[i].w * v0[i].w;
            s1 += v1[i].x * v1[i].x + v1[i].y * v1[i].y + v1[i].z * v1[i].z + v1[i].w * v1[i].w;
            uint2 o; o.x = pack2(v0[i].x, v0[i].y); o.y = pack2(v0[i].z, v0[i].w);
            ((uint2*)(p.xb + (size_t)t * D_MODEL))[lane + 64 * i] = o;
            if (two) { uint2 o1; o1.x = pack2(v1[i].x, v1[i].y); o1.y = pack2(v1[i].z, v1[i].w); ((uint2*)(p.xb + (size_t)t1 * D_MODEL))[lane + 64 * i] = o1; }
        }
        s0 = wave_sum(s0); s1 = wave_sum(s1);
        if (lane == 0) { p.rstd1[t] = rsqrtf(s0 * (1.0f / D_MODEL) + EPS); if (two) p.rstd1[t1] = rsqrtf(s1 * (1.0f / D_MODEL) + EPS); }
    }
}

typedef short s16x4 __attribute__((ext_vector_type(4)));
template <class Epi>
__device__ __forceinline__ void gemm128_sgu(const int tid, const bf16_t* __restrict__ A, const bf16_t* __restrict__ V  ,
                                            const float* __restrict__ lnm, const float* __restrict__ lnr, const float* __restrict__ gch, char* lds, const Epi& epi) {
    const int lane = tid & 63, wid = tid >> 6, wr = wid >> 1, wc = wid & 1, fr = lane & 15, fq = lane >> 4;
    constexpr int PITCH = 144, P2 = 288;
    char* sA = lds; char* sB = lds + 128 * PITCH;
    f32x4 acc[4][4];
#pragma unroll
    for (int m = 0; m < 4; ++m)
#pragma unroll
        for (int n = 0; n < 4; ++n) acc[m][n] = (f32x4){0.f, 0.f, 0.f, 0.f};
    u32x4 ra[4], rb[4]; float rm[4], rr[4];
    const int lrow = tid >> 3, lch = tid & 7;
    const int btok = tid >> 4, bch = tid & 15;
    const bf16_t* ga = A + (size_t)lrow * 128 + lch * 8;
    const bf16_t* gb = V + (size_t)btok * D_IN + bch * 8;
    float g8[8];
    { const float4 g0 = *(const float4*)(gch + bch * 8), g1 = *(const float4*)(gch + bch * 8 + 4); g8[0] = g0.x; g8[1] = g0.y; g8[2] = g0.z; g8[3] = g0.w; g8[4] = g1.x; g8[5] = g1.y; g8[6] = g1.z; g8[7] = g1.w; }
#pragma unroll
    for (int j = 0; j < 4; ++j) { ra[j] = *(const u32x4*)(ga + (size_t)(32 * j) * 128); rb[j] = *(const u32x4*)(gb + (size_t)(16 * j) * D_IN); rm[j] = lnm[btok + 16 * j]; rr[j] = lnr[btok + 16 * j]; }
    for (int k0 = 0; k0 < 128; k0 += 64) {
        __syncthreads();
#pragma unroll
        for (int j = 0; j < 4; ++j) {
            *(u32x4*)(sA + (lrow + 32 * j) * PITCH + lch * 16) = ra[j];
            u32x4 o;
#pragma unroll
            for (int i = 0; i < 4; ++i) {
                const unsigned w = rb[j][i];
                o[i] = pack2((bflo(w) - rm[j]) * rr[j] * g8[2 * i], (bfhi(w) - rm[j]) * rr[j] * g8[2 * i + 1]);
            }
            *(u32x4*)(sB + (btok + 16 * j) * P2 + bch * 16) = o;
        }
        __syncthreads();
        if (k0 + 64 < 128) {
#pragma unroll
            for (int j = 0; j < 4; ++j) { ra[j] = *(const u32x4*)(ga + (size_t)(32 * j) * 128 + 64); rb[j] = *(const u32x4*)(gb + (size_t)(64 + 16 * j) * D_IN); rm[j] = lnm[64 + btok + 16 * j]; rr[j] = lnr[64 + btok + 16 * j]; }
        }
#pragma unroll
        for (int kk = 0; kk < 2; ++kk) {
            bf16x8 af[4], bfr[4];
#pragma unroll
            for (int m = 0; m < 4; ++m) af[m] = *(const bf16x8*)(sA + (wr * 64 + m * 16 + fr) * PITCH + (kk * 32 + fq * 8) * 2);
#pragma unroll
            for (int n = 0; n < 4; ++n) {
                const char* bp = sB + (kk * 32 + fq * 8 + (fr >> 2)) * P2 + (wc * 64 + n * 16 + 4 * (fr & 3)) * 2;
                const s16x4 lo = __builtin_amdgcn_ds_read_tr16_b64_v4i16((LAS s16x4*)(bp));
                const s16x4 hi = __builtin_amdgcn_ds_read_tr16_b64_v4i16((LAS s16x4*)(bp + 4 * P2));
                bfr[n] = (bf16x8){lo[0], lo[1], lo[2], lo[3], hi[0], hi[1], hi[2], hi[3]};
            }
#pragma unroll
            for (int m = 0; m < 4; ++m)
#pragma unroll
                for (int n = 0; n < 4; ++n) acc[m][n] = __builtin_amdgcn_mfma_f32_16x16x32_bf16(bfr[n], af[m], acc[m][n], 0, 0, 0);
        }
    }
#pragma unroll
    for (int m = 0; m < 4; ++m)
#pragma unroll
        for (int n = 0; n < 4; ++n) epi(wr * 64 + m * 16 + fr, wc * 64 + n * 16 + fq * 4, acc[m][n]);
}

#define PT_PITCH 272
#define MIXH_LDS (2 * 128 * PT_PITCH + 1024)
template <int W, class Epi>
__device__ __forceinline__ void pool_tile(const int tid, const bf16_t* __restrict__ zb0  , int pos0,
                                          const bf16_t* __restrict__ Bt, char* lds, const Epi& epi) {
    const int lane = tid & 63, wid = tid >> 6, wr = wid >> 1, wc = wid & 1, fr = lane & 15, fq = lane >> 4;
    char* sA = lds; char* sB = lds + 128 * PT_PITCH;
    __syncthreads();
#pragma unroll
    for (int j = 0; j < 8; ++j) { const int id = tid + 256 * j, row = id >> 4, ch = id & 15; *(u32x4*)(sB + row * PT_PITCH + ch * 16) = *(const u32x4*)(Bt + (size_t)row * 128 + ch * 8); }
#pragma unroll 1
    for (int j = 0; j < 8; ++j) {
        const int id = tid + 256 * j, row = id >> 4, ch = id & 15, pos = (pos0 + row) & (SEQ - 1);
        const bf16_t* zp = zb0 + (size_t)row * D_IN + ch * 8;
        u32x4 v[W];
#pragma unroll
        for (int k = 0; k < W; ++k) v[k] = *(const u32x4*)(zp - (size_t)(k <= pos ? k : 0) * D_IN);
        float sm[8];
#pragma unroll
        for (int i = 0; i < 8; ++i) sm[i] = 0.f;
#pragma unroll
        for (int k = 0; k < W; ++k) {
            const float m = (k <= pos) ? 1.f : 0.f;
#pragma unroll
            for (int i = 0; i < 4; ++i) { sm[2 * i] += m * bflo(v[k][i]); sm[2 * i + 1] += m * bfhi(v[k][i]); }
        }
        const float fn = (float)((pos + 1 < W) ? pos + 1 : W);
        u32x4 o;
#pragma unroll
        for (int i = 0; i < 4; ++i) o[i] = pack2(sm[2 * i] / fn - bflo(v[0][i]), sm[2 * i + 1] / fn - bfhi(v[0][i]));
        *(u32x4*)(sA + row * PT_PITCH + ch * 16) = o;
    }
    __syncthreads();
    f32x4 acc[4][4];
#pragma unroll
    for (int m = 0; m < 4; ++m)
#pragma unroll
        for (int n = 0; n < 4; ++n) acc[m][n] = (f32x4){0.f, 0.f, 0.f, 0.f};
#pragma unroll
    for (int kk = 0; kk < 4; ++kk) {
        bf16x8 af[4], bfr[4];
#pragma unroll
        for (int m = 0; m < 4; ++m) af[m] = *(const bf16x8*)(sA + (wr * 64 + m * 16 + fr) * PT_PITCH + (kk * 32 + fq * 8) * 2);
#pragma unroll
        for (int n = 0; n < 4; ++n) bfr[n] = *(const bf16x8*)(sB + (wc * 64 + n * 16 + fr) * PT_PITCH + (kk * 32 + fq * 8) * 2);
#pragma unroll
        for (int m = 0; m < 4; ++m)
#pragma unroll
            for (int n = 0; n < 4; ++n) acc[m][n] = __builtin_amdgcn_mfma_f32_16x16x32_bf16(bfr[n], af[m], acc[m][n], 0, 0, 0);
    }
#pragma unroll
    for (int m = 0; m < 4; ++m)
#pragma unroll
        for (int n = 0; n < 4; ++n) epi(wr * 64 + m * 16 + fr, wc * 64 + n * 16 + fq * 4, acc[m][n]);
}

__device__ void phase_mix_gemm(const Params& p, char* lds) {
    const int tidx_ = tid_opaque();
    const int npool = (T_TOK / 128) * 4, nsgu = (T_TOK / 128) * 4;
    const int half = tidx_ >> 8, ht = tidx_ & 255; lds += half * MIXH_LDS;
    for (int tile = 2 * blockIdx.x + half; tile < npool + nsgu; tile += 2 * gridDim.x) {
        if (tile < npool) {
            const int tm = tile >> 2, g = tile & 3;
            const float* ps = p.pool_scale + g * 128; bf16_t* co = p.cB + (size_t)tm * 128 * D_MODEL + g * 128;
            const bf16_t* z0 = p.zb + (size_t)tm * 128 * D_IN + g * 128; const bf16_t* bt = p.poolT + (size_t)g * 16384;
            auto epi = [&](int r, int c, f32x4 v) {
                const float4 sc = *(const float4*)(ps + c);
                uint2 o; o.x = pack2(v[0] * sc.x, v[1] * sc.y); o.y = pack2(v[2] * sc.z, v[3] * sc.w);
                *(uint2*)(co + (size_t)r * D_MODEL + c) = o;
            };
            if (g == 0) pool_tile<2>(ht, z0, tm * 128, bt, lds, epi); else if (g == 1) pool_tile<4>(ht, z0, tm * 128, bt, lds, epi);
            else if (g == 2) pool_tile<8>(ht, z0, tm * 128, bt, lds, epi); else pool_tile<16>(ht, z0, tm * 128, bt, lds, epi);
        } else {
            const int t2 = tile - npool, blk = t2 >> 2, h = t2 & 3;
            float* stm = (float*)(lds + GEMM_LDS_BYTES); float* str = stm + 128;
            __syncthreads();
            {
                const int tok = ht >> 1, hh = ht & 1;
                const u32x4* vp = (const u32x4*)(p.zb + (size_t)(blk * 128 + tok) * D_IN + 1024 + hh * 256);
                float s1 = 0.f, s2 = 0.f;
#pragma unroll 8
                for (int i = 0; i < 32; ++i) {
                    const u32x4 v = vp[i];
#pragma unroll
                    for (int k = 0; k < 4; ++k) { const float a = bflo(v[k]), c = bfhi(v[k]); s1 += a + c; s2 += a * a + c * c; }
                }
                s1 += __shfl_xor(s1, 1); s2 += __shfl_xor(s2, 1);
                const float mean = s1 * (1.0f / 512.0f), var = fmaxf(s2 * (1.0f / 512.0f) - mean * mean, 0.f);
                if (hh == 0) { stm[tok] = mean; str[tok] = rsqrtf(var + EPS); }
            }
            __syncthreads();
            const float* sb = p.sgu_b + h * 128; const bf16_t* uo = p.zb + (size_t)blk * 128 * D_IN + 512 + h * 128;
            bf16_t* co = p.cB + (size_t)blk * 128 * D_MODEL + 512 + h * 128;
            gemm128_sgu(ht, p.wsM + (size_t)h * 16384, p.zb + (size_t)blk * 128 * D_IN + 1024 + h * 128, stm, str, p.sgu_norm_g + h * 128, lds,
                    [&](int r, int c, f32x4 v) {
                        const float bb = sb[r];
                        const uint2 uu = *(const uint2*)(uo + (size_t)r * D_IN + c);
                        uint2 o;
                        o.x = pack2((v[0] + bb) * bflo(uu.x), (v[1] + bb) * bfhi(uu.x));
                        o.y = pack2((v[2] + bb) * bflo(uu.y), (v[3] + bb) * bfhi(uu.y));
                        *(uint2*)(co + (size_t)r * D_MODEL + c) = o;
                    });
        }
    }
}

__device__ __forceinline__ int wave_sum_i_uniform(int s) {
    s += __builtin_amdgcn_update_dpp(0, s, 0xB1, 0xf, 0xf, false);
    s += __builtin_amdgcn_update_dpp(0, s, 0x4E, 0xf, 0xf, false);
    s += __builtin_amdgcn_update_dpp(0, s, 0x141, 0xf, 0xf, false);
    s += __builtin_amdgcn_update_dpp(0, s, 0x140, 0xf, 0xf, false);
    return __builtin_amdgcn_readlane(s, 0) + __builtin_amdgcn_readlane(s, 16) + __builtin_amdgcn_readlane(s, 32) + __builtin_amdgcn_readlane(s, 48);
}
__constant__ unsigned char kComb[64] = {
    0x00,0x01,0x02,0x03,0x04,0x05,0x06,0x07,0x08,0x09,0x0a,0x0b,0x0c,0x0d,0x0e,0x0f,
    0x10,0x11,0x12,0x13,0x14,0x15,0x16,0x17,
    0x20,0x21,0x22,0x23,0x24,
    0x30,0x31,0x32,0x33,
    0x40,0x41,0x42,
    0x50,0x51,
    0x60,0x61,
    0x70,0x71,
    0x80,0x90,0xa0,0xb0,0xc0,0xd0,0xe0,0xf0,
    0xff,0xff,0xff,0xff,0xff,0xff,0xff,0xff,0xff,0xff,0xff,0xff,0xff,0xff};

template <int CTRL> __device__ __forceinline__ int dpp_i(int v) { return __builtin_amdgcn_update_dpp(0, v, CTRL, 0xf, 0xf, false); }
__device__ __forceinline__ int row_allmax_i(int v) {
    v = max(v, dpp_i<0x128>(v)); v = max(v, dpp_i<0x124>(v)); v = max(v, dpp_i<0x122>(v)); v = max(v, dpp_i<0x121>(v));
    return v;
}
__device__ __forceinline__ float row_allsum_f(float v) {
    v += __int_as_float(dpp_i<0x128>(__float_as_int(v))); v += __int_as_float(dpp_i<0x124>(__float_as_int(v)));
    v += __int_as_float(dpp_i<0x122>(__float_as_int(v))); v += __int_as_float(dpp_i<0x121>(__float_as_int(v)));
    return v;
}
__device__ __forceinline__ int f2key(float f) { const int b = __float_as_int(f); return b ^ ((b >> 31) & 0x7fffffff); }
__device__ __forceinline__ float key2f(int k) { return __int_as_float(k ^ ((k >> 31) & 0x7fffffff)); }
#define KEY_MIN ((int)0x80000000)
#define CE(a, b) { const int hi_ = max(a, b), lo_ = min(a, b); a = hi_; b = lo_; }
__device__ __forceinline__ int top16_rows(int (&k)[8], int l15) {
    CE(k[0], k[1]) CE(k[2], k[3]) CE(k[4], k[5]) CE(k[6], k[7])
    CE(k[0], k[2]) CE(k[1], k[3]) CE(k[4], k[6]) CE(k[5], k[7])
    CE(k[1], k[2]) CE(k[5], k[6])
    CE(k[0], k[4]) CE(k[1], k[5]) CE(k[2], k[6]) CE(k[3], k[7])
    CE(k[2], k[4]) CE(k[3], k[5])
    CE(k[1], k[2]) CE(k[3], k[4]) CE(k[5], k[6])
    int res = KEY_MIN;
#pragma unroll
    for (int r = 0; r < 16; ++r) {
        const int m = row_allmax_i(k[0]);
        const bool own = (k[0] == m);
#pragma unroll
        for (int j = 0; j < 7; ++j) k[j] = own ? k[j + 1] : k[j];
        k[7] = own ? KEY_MIN : k[7];
        res = (l15 == r) ? m : res;
    }
    return res;
}
__device__ __forceinline__ void combine16(int A, int B, const int (&cbv)[4], int lane, int l15, int& eid_out, float& gate_out) {
    const int rowbase = lane & 48;
    int ck[4], eid[4];
#pragma unroll
    for (int c = 0; c < 4; ++c) {
        const int ci = (cbv[c] >> 4) & 15, cj = cbv[c] & 15;
        const int ka = __builtin_amdgcn_ds_bpermute((rowbase + ci) << 2, A);
        const int kb = __builtin_amdgcn_ds_bpermute((rowbase + cj) << 2, B);
        const float sm = key2f(ka & ~127) + key2f(kb & ~127);
        eid[c] = ((127 - (ka & 127)) << 7) | (127 - (kb & 127));
        ck[c] = (cbv[c] != 0xff) ? ((f2key(sm) & ~63) | (63 - (4 * l15 + c))) : KEY_MIN;
    }
    CE(ck[0], ck[1]) CE(ck[2], ck[3]) CE(ck[0], ck[2]) CE(ck[1], ck[3]) CE(ck[1], ck[2])
    int res = KEY_MIN;
#pragma unroll
    for (int r = 0; r < 16; ++r) {
        const int m = row_allmax_i(ck[0]);
        const bool own = (ck[0] == m);
        ck[0] = own ? ck[1] : ck[0]; ck[1] = own ? ck[2] : ck[1]; ck[2] = own ? ck[3] : ck[2]; ck[3] = own ? KEY_MIN : ck[3];
        res = (l15 == r) ? m : res;
    }
    const int slot = 63 - (res & 63);
    const int src = (rowbase + (slot >> 2)) << 2;
    const int e0 = __builtin_amdgcn_ds_bpermute(src, eid[0]), e1 = __builtin_amdgcn_ds_bpermute(src, eid[1]);
    const int e2 = __builtin_amdgcn_ds_bpermute(src, eid[2]), e3 = __builtin_amdgcn_ds_bpermute(src, eid[3]);
    const int sel = slot & 3;
    eid_out = sel == 0 ? e0 : (sel == 1 ? e1 : (sel == 2 ? e2 : e3));
    gate_out = key2f(res & ~63);
}

__device__ __forceinline__ int reduce16_rows(const int (&part)[16], bool b3, bool b2, bool b1, bool b0b) {
    int r8[8], r4[4], r2[2];
#pragma unroll
    for (int k = 0; k < 8; ++k) { const int keep = b3 ? part[8 + k] : part[k], send = b3 ? part[k] : part[8 + k]; r8[k] = keep + __builtin_amdgcn_update_dpp(0, send, 0x140, 0xf, 0xf, false); }
#pragma unroll
    for (int k = 0; k < 4; ++k) { const int keep = b2 ? r8[4 + k] : r8[k], send = b2 ? r8[k] : r8[4 + k]; r4[k] = keep + __builtin_amdgcn_update_dpp(0, send, 0x141, 0xf, 0xf, false); }
#pragma unroll
    for (int k = 0; k < 2; ++k) { const int keep = b1 ? r4[2 + k] : r4[k], send = b1 ? r4[k] : r4[2 + k]; r2[k] = keep + __builtin_amdgcn_update_dpp(0, send, 0x4E, 0xf, 0xf, false); }
    const int keep = b0b ? r2[1] : r2[0], send = b0b ? r2[0] : r2[1];
    int r1 = keep + __builtin_amdgcn_update_dpp(0, send, 0xB1, 0xf, 0xf, false);
    r1 += __shfl_xor(r1, 16); r1 += __shfl_xor(r1, 32);
    return r1;
}
#define TS_WBYTES (16384 + 128)
__device__ void phase_peer_dots(const Params& p, char* lds) {
    const int tidx_ = tid_opaque();
    const int lane = tidx_ & 63, wid = __builtin_amdgcn_readfirstlane((int)(tidx_ >> 6)), l15 = lane & 15;
    const bool b3 = (lane & 8) != 0, b2 = (lane & 4) != 0, b1 = (lane & 2) != 0, b0b = (lane & 1) != 0;
    const int gw = blockIdx.x * (blockDim.x >> 6) + wid, ngw = gridDim.x * (blockDim.x >> 6);
    char* wl = lds + wid * TS_WBYTES;
    unsigned* list = (unsigned*)wl; int* dotsl = (int*)(wl + 4096); char* hql = wl + 8192; int* tks = (int*)(wl + 16384);
    const unsigned lane16 = (unsigned)lane * 16u;
    for (int tb = gw * 8; tb < T_TOK; tb += ngw * 8) {
#pragma unroll 1
        for (int j0 = 0; j0 < 8; j0 += 4) {
            u32x4 hraw[4][2];
#pragma unroll
            for (int jj = 0; jj < 4; ++jj) { const u32x4* hr = (const u32x4*)(p.hb + (size_t)(tb + j0 + jj) * D_MODEL); hraw[jj][0] = hr[2 * lane]; hraw[jj][1] = hr[2 * lane + 1]; }
#pragma unroll
            for (int jj = 0; jj < 4; ++jj) {
                const int j = j0 + jj;
                const u32x4 a = hraw[jj][0], c = hraw[jj][1];
                const float f[16] = {bflo(a.x), bfhi(a.x), bflo(a.y), bfhi(a.y), bflo(a.z), bfhi(a.z), bflo(a.w), bfhi(a.w),
                                     bflo(c.x), bfhi(c.x), bflo(c.y), bfhi(c.y), bflo(c.z), bfhi(c.z), bflo(c.w), bfhi(c.w)};
                float ss = 0.f, am = 0.f;
#pragma unroll
                for (int k = 0; k < 16; ++k) { ss += f[k] * f[k]; am = fmaxf(am, fabsf(f[k])); }
                ss = wave_sum(ss); am = wave_max(am);
                const float inv = am > 0.f ? 127.0f / am : 0.f;
                u32x4 o; int hsum = 0;
#pragma unroll
                for (int i = 0; i < 4; ++i) {
                    unsigned w = 0;
#pragma unroll
                    for (int k = 0; k < 4; ++k) { const int qv = (int)rintf(f[4 * i + k] * inv); hsum += qv; w |= (unsigned)(qv & 0xff) << (8 * k); }
                    o[i] = w;
                }
                *(u32x4*)(hql + j * 1024 + lane * 16) = o;
                hsum = wave_sum_i_uniform(hsum);
                const float r2 = rsqrtf(ss * (1.0f / D_MODEL) + EPS);
                if (lane == 0) { tks[4 * j] = hsum; tks[4 * j + 1] = __float_as_int(am * (1.0f / 127.0f) * r2); tks[4 * j + 2] = __float_as_int(r2); }
            }
        }
        int idv[8][2];
#pragma unroll
        for (int j = 0; j < 8; ++j) { const int* ir = p.idx + (size_t)(tb + j) * 128; idv[j][0] = ir[lane]; idv[j][1] = ir[64 + lane]; }
#pragma unroll 1
        for (int x = 0; x < 8; ++x) {
            int n = 0;
#pragma unroll
            for (int j = 0; j < 8; ++j)
#pragma unroll
                for (int r = 0; r < 2; ++r) {
                    const int e = idv[j][r];
                    const bool in = (e >> 11) == x;
                    const unsigned long long mk = __ballot(in);
                    const int rank = (int)__builtin_amdgcn_mbcnt_hi((unsigned)(mk >> 32), __builtin_amdgcn_mbcnt_lo((unsigned)mk, 0u));
                    if (in) list[n + rank] = ((unsigned)j << 21) | ((unsigned)(r * 64 + lane) << 14) | (unsigned)e;
                    n += (int)__builtin_popcountll(mk);
                }
            asm volatile("s_waitcnt lgkmcnt(0)" ::: "memory");
            u32x4 ua[16], ubf[16]; int enta = 0, entb = 0;
            auto issue = [&](int b0, u32x4 (&uu)[16], int& entv) {
                const int i = (b0 + l15 < n) ? b0 + l15 : n - 1;
                entv = (int)list[i];
#pragma unroll
                for (int j = 0; j < 16; ++j) { const int e = __builtin_amdgcn_readlane(entv, j) & 0x3fff; uu[j] = *(const u32x4*)(p.u8 + (size_t)e * D_MODEL + lane16); }
            };
            auto reduce = [&](int b0, const u32x4 (&uu)[16], int entv) {
                int part[16];
#pragma unroll
                for (int j = 0; j < 16; ++j) {
                    const int tl = __builtin_amdgcn_readlane(entv, j) >> 21;
                    const u32x4 hqv = *(const u32x4*)(hql + tl * 1024 + lane * 16);
                    int sacc = __builtin_amdgcn_sdot4((int)uu[j].x, (int)hqv.x, 0, false);
                    sacc = __builtin_amdgcn_sdot4((int)uu[j].y, (int)hqv.y, sacc, false);
                    sacc = __builtin_amdgcn_sdot4((int)uu[j].z, (int)hqv.z, sacc, false);
                    part[j] = __builtin_amdgcn_sdot4((int)uu[j].w, (int)hqv.w, sacc, false);
                }
                const int r1 = reduce16_rows(part, b3, b2, b1, b0b);
                if (lane < 16 && b0 + lane < n) dotsl[((unsigned)entv >> 21) * 128 + (((unsigned)entv >> 14) & 127u)] = r1;
            };
            if (n > 0) issue(0, ua, enta);
            for (int b0 = 0; b0 < n; b0 += 32) {
                if (b0 + 16 < n) issue(b0 + 16, ubf, entb);
                reduce(b0, ua, enta);
                if (b0 + 16 < n) {
                    if (b0 + 32 < n) issue(b0 + 32, ua, enta);
                    reduce(b0 + 16, ubf, entb);
                }
            }
            asm volatile("s_waitcnt lgkmcnt(0)" ::: "memory");
        }
#pragma unroll
        for (int j = 0; j < 8; ++j) {
            const int hs_t = tks[4 * j]; const float cs_t = __int_as_float(tks[4 * j + 1]), r2_t = __int_as_float(tks[4 * j + 2]);
            const float* gr = p.gate + (size_t)(tb + j) * 128; float* cr = p.coef + (size_t)(tb + j) * 128;
#pragma unroll
            for (int r = 0; r < 2; ++r) {
                const int e = idv[j][r];
                const float sc = gr[r * 64 + lane] * r2_t;
                const float ex = __expf(sc - key2f(row_allmax_i(f2key(sc))));
                const float gt = ex / row_allsum_f(ex);
                const float dotf = (float)dotsl[j * 128 + r * 64 + lane] * cs_t * p.su[e];
                cr[r * 64 + lane] = gt * gelu_t(dotf) * p.sv[e];
            }
        }
        asm volatile("s_waitcnt lgkmcnt(0)" ::: "memory");
    }
}

__device__ void phase_gather(const Params& p, char* lds) {
    const int tidx_ = tid_opaque();
    const int wave = __builtin_amdgcn_readfirstlane((int)((blockIdx.x * blockDim.x + tidx_) >> 6)), nwaves = (gridDim.x * blockDim.x) >> 6, lane = tidx_ & 63;
    const unsigned char* vb = p.v8 + lane * 12;
    for (int t = wave; t < T_TOK; t += nwaves) {
        int idr[2]; float coef[2];
        { const int* ir = p.idx + (size_t)t * 128; idr[0] = ir[lane]; idr[1] = ir[64 + lane]; }
        { const float* cr = p.coef + (size_t)t * 128; coef[0] = cr[lane]; coef[1] = cr[64 + lane]; }
        const float cmax = wave_max(fmaxf(fabsf(coef[0]), fabsf(coef[1])));
        const float qs = cmax > 0.f ? 127.0f / cmax : 0.f, cscale = cmax * (1.0f / 127.0f);
        const int cq0 = (int)rintf(coef[0] * qs), cq1 = (int)rintf(coef[1] * qs);
        const int csum_i = wave_sum_i_uniform(cq0 + cq1);
        unsigned cpk[2];
        {
            const int cqs[2] = {cq0, cq1};
#pragma unroll
            for (int hf = 0; hf < 2; ++hf) {
                const int bb = cqs[hf] & 0xff;
                cpk[hf] = (unsigned)__builtin_amdgcn_update_dpp(0, bb, 0x00, 0xf, 0xf, false) | ((unsigned)__builtin_amdgcn_update_dpp(0, bb, 0x55, 0xf, 0xf, false) << 8)
                        | ((unsigned)__builtin_amdgcn_update_dpp(0, bb, 0xAA, 0xf, 0xf, false) << 16) | ((unsigned)__builtin_amdgcn_update_dpp(0, bb, 0xFF, 0xf, 0xf, false) << 24);
            }
        }
        int acc[16];
#pragma unroll
        for (int j = 0; j < 16; ++j) acc[j] = 0;
        {
            u32x3 va[8], vbf[8];
            auto issue = [&](int pb, u32x3 (&vv)[8]) {
#pragma unroll
                for (int q = 0; q < 8; ++q) { const int e = __builtin_amdgcn_readlane(pb < 64 ? idr[0] : idr[1], (pb & 63) + q); vv[q] = *(const u32x3*)(vb + (size_t)e * ROWB); }
            };
            auto axpy = [&](int pb, const u32x3 (&vv)[8]) {
#pragma unroll
                for (int g4 = 0; g4 < 2; ++g4) {
                    const int cqd = __builtin_amdgcn_readlane((int)(pb < 64 ? cpk[0] : cpk[1]), (pb & 63) + 4 * g4);
                    unsigned dd[4][4];
#pragma unroll
                    for (int r = 0; r < 4; ++r) {
                        const unsigned w0 = vv[4 * g4 + r].x, w1 = vv[4 * g4 + r].y, w2 = vv[4 * g4 + r].z;
                        dd[r][0] = w0 & 0x3f3f3f3fu; dd[r][1] = w1 & 0x3f3f3f3fu; dd[r][2] = w2 & 0x3f3f3f3fu;
                        dd[r][3] = ((w0 >> 6) & 0x03030303u) | ((w1 >> 4) & 0x0c0c0c0cu) | ((w2 >> 2) & 0x30303030u);
                    }
#pragma unroll
                    for (int k = 0; k < 4; ++k) {
                        const unsigned p0 = __builtin_amdgcn_perm(dd[1][k], dd[0][k], 0x05010400u), p1 = __builtin_amdgcn_perm(dd[1][k], dd[0][k], 0x07030602u);
                        const unsigned q0 = __builtin_amdgcn_perm(dd[3][k], dd[2][k], 0x05010400u), q1 = __builtin_amdgcn_perm(dd[3][k], dd[2][k], 0x07030602u);
                        const unsigned t0 = __builtin_amdgcn_perm(q0, p0, 0x05040100u), t1 = __builtin_amdgcn_perm(q0, p0, 0x07060302u);
                        const unsigned t2 = __builtin_amdgcn_perm(q1, p1, 0x05040100u), t3 = __builtin_amdgcn_perm(q1, p1, 0x07060302u);
                        acc[4 * k + 0] = __builtin_amdgcn_sdot4((int)t0, cqd, acc[4 * k + 0], false);
                        acc[4 * k + 1] = __builtin_amdgcn_sdot4((int)t1, cqd, acc[4 * k + 1], false);
                        acc[4 * k + 2] = __builtin_amdgcn_sdot4((int)t2, cqd, acc[4 * k + 2], false);
                        acc[4 * k + 3] = __builtin_amdgcn_sdot4((int)t3, cqd, acc[4 * k + 3], false);
                    }
                }
            };
            issue(0, va);
#pragma unroll 1
            for (int pb = 0; pb < 128; pb += 16) {
                issue(pb + 8, vbf);
                axpy(pb, va);
                if (pb + 16 < 128) issue(pb + 16, va);
                axpy(pb + 8, vbf);
            }
        }
        const u32x4* hr = (const u32x4*)(p.hb + (size_t)t * D_MODEL + lane * 16);
        const u32x4 ha = hr[0], hc = hr[1];
        const float hf16[16] = {bflo(ha.x), bfhi(ha.x), bflo(ha.y), bfhi(ha.y), bflo(ha.z), bfhi(ha.z), bflo(ha.w), bfhi(ha.w),
                                bflo(hc.x), bfhi(hc.x), bflo(hc.y), bfhi(hc.y), bflo(hc.z), bfhi(hc.z), bflo(hc.w), bfhi(hc.w)};
        float res[16];
        float ss = 0.f;
#pragma unroll
        for (int j = 0; j < 16; ++j) { res[j] = hf16[j] + cscale * (float)(acc[j] - 32 * csum_i); ss += res[j] * res[j]; }
        ss = wave_sum(ss);
        const float r3 = rsqrtf(ss * (1.0f / D_MODEL) + EPS);
        float* o = p.out + (size_t)t * D_MODEL + lane * 16;
        const float* fg = p.final_g + lane * 16;
#pragma unroll
        for (int i = 0; i < 4; ++i) {
            const float4 g = ((const float4*)fg)[i];
            float4 ov; ov.x = res[4 * i] * r3 * g.x; ov.y = res[4 * i + 1] * r3 * g.y; ov.z = res[4 * i + 2] * r3 * g.z; ov.w = res[4 * i + 3] * r3 * g.w;
            ((float4*)o)[i] = ov;
        }
    }
}

namespace pg8 {
#define PG8_LAS __attribute__((address_space(3)))
constexpr int BM = 256, BK = 64, HALF = 128, HTB = HALF * BK * 2, STAGE_BYTES = 8 * HTB, NXCD = 8, WGM = 8;
__host__ __device__ __forceinline__ int lds_byte(int r, int c) { const int st = (r >> 4) * 2 + (c >> 5), rr = r & 15, cc = c & 31, ob = rr * 64 + cc * 2; return st * 1024 + (ob ^ (((ob >> 9) & 1) << 5)); }
__host__ __device__ __forceinline__ void stage_rc(int b, int& R, int& C) { const int st = b / 1024, sb = b % 1024, swz = sb ^ (((sb >> 9) & 1) << 5); R = (st >> 1) * 16 + swz / 64; C = (st & 1) * 32 + (swz % 64) / 2; }
__host__ __device__ __forceinline__ int perm32(int rho) { const int n = rho >> 4, i = rho & 15; return 8 * (i >> 2) + 4 * n + (i & 3); }
struct Unit { int pm, pn; };
struct Gemm { const bf16_t* A; const bf16_t* Bt; int M, N, K; };
struct StaticOrder {
    int nM, nN, nwg, G, c;
    __host__ __device__ void init(int M, int N, int G_, int c_) { nM = M / BM; nN = N / BM; nwg = nM * nN; G = G_; c = c_; }
    __host__ __device__ bool next(int i, Unit& u) const {
        const long L = (long)i * G + c; if (L >= nwg) return false;
        int wgid = (int)L; { const int q = nwg / NXCD, r = nwg % NXCD, xcd = wgid % NXCD, off = wgid / NXCD; wgid = (xcd < r ? xcd * (q + 1) : r * (q + 1) + (xcd - r) * q) + off; }
        const int nig = WGM * nN, gid = wgid / nig, fm = gid * WGM, gsz = (nM - fm) < WGM ? (nM - fm) : WGM;
        u.pm = fm + ((wgid % nig) % gsz); u.pn = (wgid % nig) / gsz; return true;
    }
    __device__ __forceinline__ void a_ready(const Unit&) const {}
    __device__ __forceinline__ void done(const Unit&) const {}
};
__device__ __forceinline__ unsigned cvt_pk_bf16(float lo, float hi) { unsigned r; asm volatile("v_cvt_pk_bf16_f32 %0, %1, %2" : "=v"(r) : "v"(lo), "v"(hi)); return r; }
struct EpiZ {
    static constexpr bool PERM = true, AFTER_DRAIN = false;
    bf16_t* O; const float* rs;
    __device__ __forceinline__ void operator()(const f32x4 (&acc)[2][2][4][2], const Unit& u, int wr, int wc, int fr, int fq) const {
        const int row0 = u.pm * BM + wr * 64 + fr, col0 = u.pn * BM + wc * 32 + 8 * fq; const bool act = u.pn >= 2;
#pragma unroll
        for (int ai = 0; ai < 2; ++ai)
#pragma unroll
            for (int m = 0; m < 4; ++m) { const int r = row0 + ai * HALF + m * 16; const float sc = rs[r]; bf16_t* rowp = O + (size_t)r * D_IN + col0;
#pragma unroll
                for (int bj = 0; bj < 2; ++bj) { f32x4 v0 = acc[ai][bj][m][0] * sc, v1 = acc[ai][bj][m][1] * sc;
                    if (act) { v0 = (f32x4){gelu_t(v0[0]), gelu_t(v0[1]), gelu_t(v0[2]), gelu_t(v0[3])}; v1 = (f32x4){gelu_t(v1[0]), gelu_t(v1[1]), gelu_t(v1[2]), gelu_t(v1[3])}; }
                    u32x4 w; w.x = cvt_pk_bf16(v0[0], v0[1]); w.y = cvt_pk_bf16(v0[2], v0[3]); w.z = cvt_pk_bf16(v1[0], v1[1]); w.w = cvt_pk_bf16(v1[2], v1[3]);
                    *(u32x4*)(rowp + bj * HALF) = w; } }
    }
};
struct EpiOut {
    static constexpr bool PERM = true, AFTER_DRAIN = false;
    bf16_t* O; const bf16_t* X;
    __device__ __forceinline__ void operator()(const f32x4 (&acc)[2][2][4][2], const Unit& u, int wr, int wc, int fr, int fq) const {
        const int row0 = u.pm * BM + wr * 64 + fr, col0 = u.pn * BM + wc * 32 + 8 * fq;
#pragma unroll
        for (int ai = 0; ai < 2; ++ai)
#pragma unroll
            for (int m = 0; m < 4; ++m) { const size_t off = (size_t)(row0 + ai * HALF + m * 16) * D_MODEL + col0;
#pragma unroll
                for (int bj = 0; bj < 2; ++bj) { const u32x4 xx = *(const u32x4*)(X + off + bj * HALF);
                    const f32x4 v0 = acc[ai][bj][m][0] + (f32x4){bflo(xx.x), bfhi(xx.x), bflo(xx.y), bfhi(xx.y)}, v1 = acc[ai][bj][m][1] + (f32x4){bflo(xx.z), bfhi(xx.z), bflo(xx.w), bfhi(xx.w)};
                    u32x4 w; w.x = cvt_pk_bf16(v0[0], v0[1]); w.y = cvt_pk_bf16(v0[2], v0[3]); w.z = cvt_pk_bf16(v1[0], v1[1]); w.w = cvt_pk_bf16(v1[2], v1[3]);
                    *(u32x4*)(O + off + bj * HALF) = w; } }
    }
};
struct OneUnit {
    Unit u;
    __device__ __forceinline__ bool next(int i, Unit& o) const { if (i) return false; o = u; return true; }
    __device__ __forceinline__ void a_ready(const Unit&) const {}
    __device__ __forceinline__ void done(const Unit&) const {}
};
#define QT_PITCH 272
#define QT_LDS_BYTES (2 * 256 * QT_PITCH)
struct EpiQTopk {
    static constexpr bool PERM = true, AFTER_DRAIN = true;
    const bf16_t* keysB; int* idx; float* gate;
    __device__ __forceinline__ void fused(f32x4 (&acc)[2][2][4][2], const Unit& u, int wr, int wc, int fr, int fq, PG8_LAS unsigned char* ldsp, int wid, int lane) const {
        char* sQ = (char*)ldsp;
        const int h = u.pn;
#pragma unroll
        for (int ai = 0; ai < 2; ++ai)
#pragma unroll
            for (int m = 0; m < 4; ++m) { const int r = ai * HALF + wr * 64 + m * 16 + fr;
#pragma unroll
                for (int bj = 0; bj < 2; ++bj) { const f32x4 v0 = acc[ai][bj][m][0], v1 = acc[ai][bj][m][1];
                    u32x4 w; w.x = cvt_pk_bf16(v0[0], v0[1]); w.y = cvt_pk_bf16(v0[2], v0[3]); w.z = cvt_pk_bf16(v1[0], v1[1]); w.w = cvt_pk_bf16(v1[2], v1[3]);
                    *(u32x4*)(sQ + bj * (256 * QT_PITCH) + r * QT_PITCH + (wc * 32 + fq * 8) * 2) = w; } }
        __syncthreads();
        int cbv[4];
#pragma unroll
        for (int c = 0; c < 4; ++c) cbv[c] = kComb[4 * fr + c];
        int tA[2][4], tB[2][4];
#pragma unroll
        for (int m = 0; m < 2; ++m)
#pragma unroll
            for (int j = 0; j < 4; ++j) { tA[m][j] = 0; tB[m][j] = 0; }
#pragma unroll 1
        for (int pp = 0; pp < 2; ++pp) {
            const bf16_t* kb = keysB + (size_t)(pp * 8 + h) * 16384 + (size_t)fr * 128 + fq * 8;
            const char* qa = sQ + pp * (256 * QT_PITCH) + (wid * 32 + fr) * QT_PITCH + fq * 16;
            f32x4 sc2[2][8];
#pragma unroll
            for (int m = 0; m < 2; ++m)
#pragma unroll
                for (int nb = 0; nb < 8; ++nb) sc2[m][nb] = (f32x4){0.f, 0.f, 0.f, 0.f};
#pragma unroll
            for (int kk = 0; kk < 4; ++kk) {
                bf16x8 kf[8], af[2];
#pragma unroll
                for (int nb = 0; nb < 8; ++nb) kf[nb] = *(const bf16x8*)(kb + (size_t)nb * 16 * 128 + kk * 32);
#pragma unroll
                for (int m = 0; m < 2; ++m) af[m] = *(const bf16x8*)(qa + m * 16 * QT_PITCH + kk * 64);
#pragma unroll
                for (int m = 0; m < 2; ++m)
#pragma unroll
                    for (int nb = 0; nb < 8; ++nb) sc2[m][nb] = __builtin_amdgcn_mfma_f32_16x16x32_bf16(af[m], kf[nb], sc2[m][nb], 0, 0, 0);
            }
#pragma unroll
            for (int m = 0; m < 2; ++m)
#pragma unroll
                for (int j = 0; j < 4; ++j) tA[m][j] = tB[m][j];
#pragma unroll 2
            for (int it = 0; it < 4; ++it) {
#pragma unroll
                for (int m = 0; m < 2; ++m) {
                    int k[8];
#pragma unroll
                    for (int nb = 0; nb < 8; ++nb) k[nb] = (f2key(sc2[m][nb][0]) & ~127) | (127 - (16 * nb + fr));
                    const int r = top16_rows(k, fr);
                    tB[m][0] = tB[m][1]; tB[m][1] = tB[m][2]; tB[m][2] = tB[m][3]; tB[m][3] = r;
#pragma unroll
                    for (int nb = 0; nb < 8; ++nb) sc2[m][nb] = (f32x4){sc2[m][nb][1], sc2[m][nb][2], sc2[m][nb][3], sc2[m][nb][0]};
                }
            }
        }
#pragma unroll 2
        for (int it = 0; it < 4; ++it) {
#pragma unroll
            for (int m = 0; m < 2; ++m) {
                int eid; float gt;
                combine16(tA[m][0], tB[m][0], cbv, lane, fr, eid, gt);
                const int t = u.pm * BM + wid * 32 + m * 16 + fq * 4 + it;
                const size_t o = (size_t)t * 128 + h * 16 + fr;
                idx[o] = eid; gate[o] = gt;
                tA[m][0] = tA[m][1]; tA[m][1] = tA[m][2]; tA[m][2] = tA[m][3];
                tB[m][0] = tB[m][1]; tB[m][1] = tB[m][2]; tB[m][2] = tB[m][3];
            }
        }
        __syncthreads();
    }
};
template <class Epi, class Sched>
__device__ __forceinline__ void gemm_phase(PG8_LAS unsigned char* lds, const Gemm g, const Sched& S, const Epi& E) {
    const int tid = threadIdx.x, wid = __builtin_amdgcn_readfirstlane(tid >> 6), lane = tid & 63, wr = wid >> 2, wc = wid & 3, fr = lane & 15, fq = lane >> 4;
    const int K = g.K, nt = K / BK;
    unsigned voffA[2], voffB[2];
#pragma unroll
    for (int i = 0; i < 2; ++i) { int R, C; stage_rc(tid * 16 + i * 8192, R, C); const int Rb = Epi::PERM ? ((R & ~31) + perm32(R & 31)) : R;
        voffA[i] = (unsigned)(R * K + C) * 2u; voffB[i] = (unsigned)(Rb * K + C) * 2u; }
    const size_t kstep = (size_t)(BK * 2);
    const size_t hstep = (size_t)HALF * K * 2;
    const size_t tstep = 2 * hstep;
    const unsigned ldsw = (unsigned)wid * 1024u;
    const int aoff = lds_byte(wr * 64 + fr, fq * 8), boff = lds_byte(wc * 32 + fr, fq * 8);
#define PG8_SA(b, h) (((b) * 2 + (h)) * HTB)
#define PG8_SB(b, h) ((4 + (b) * 2 + (h)) * HTB)
#define PG8_STAGE(bufoff, gbase, voff) do { _Pragma("unroll") for (int _i = 0; _i < 2; ++_i) \
        __builtin_amdgcn_global_load_lds((const unsigned*)((const char*)(gbase) + (voff)[_i]), (PG8_LAS unsigned*)(lds + (bufoff) + ldsw + _i * 8192), 16, 0, 0); } while (0)
#define PG8_LDA(dst, b, h) do { _Pragma("unroll") for (int m = 0; m < 4; ++m) _Pragma("unroll") for (int k = 0; k < 2; ++k) dst[m][k] = *(const PG8_LAS bf16x8*)(lds + PG8_SA(b, h) + aoff + m * 2048 + k * 1024); } while (0)
#define PG8_LDB(dst, b, h) do { _Pragma("unroll") for (int n = 0; n < 2; ++n) _Pragma("unroll") for (int k = 0; k < 2; ++k) dst[n][k] = *(const PG8_LAS bf16x8*)(lds + PG8_SB(b, h) + boff + n * 2048 + k * 1024); } while (0)
#define PG8_MMA(ai, bj, At, Bt) do { __builtin_amdgcn_s_setprio(1); _Pragma("unroll") for (int m = 0; m < 4; ++m) _Pragma("unroll") for (int n = 0; n < 2; ++n) _Pragma("unroll") for (int k = 0; k < 2; ++k) \
        acc[ai][bj][m][n] = __builtin_amdgcn_mfma_f32_16x16x32_bf16(Bt[n][k], At[m][k], acc[ai][bj][m][n], 0, 0, 0); __builtin_amdgcn_s_setprio(0); } while (0)
#define PG8_WAIT_V(n) asm volatile("s_waitcnt vmcnt(" #n ")" ::: "memory")
#define PG8_WAIT_L(n) asm volatile("s_waitcnt lgkmcnt(" #n ")" ::: "memory")
#define PG8_BAR __builtin_amdgcn_s_barrier()
#define PG8_SCHED __builtin_amdgcn_sched_barrier(0)
    Unit cur, nxt; int ui = 0;
    if (!S.next(0, cur)) return;
    f32x4 acc[2][2][4][2];
#pragma unroll
    for (int a = 0; a < 2; ++a)
#pragma unroll
        for (int b = 0; b < 2; ++b)
#pragma unroll
            for (int m = 0; m < 4; ++m)
#pragma unroll
                for (int n = 0; n < 2; ++n) acc[a][b][m][n] = (f32x4){0.f, 0.f, 0.f, 0.f};
    bf16x8 At[4][2], B0[2][2], B1[2][2];
    const char* cA = (const char*)g.A + (size_t)cur.pm * tstep; const char* cB = (const char*)g.Bt + (size_t)cur.pn * tstep;
    S.a_ready(cur);
    PG8_STAGE(PG8_SB(0, 0), cB, voffB); PG8_STAGE(PG8_SA(0, 0), cA, voffA); PG8_STAGE(PG8_SB(0, 1), cB + hstep, voffB); PG8_STAGE(PG8_SA(0, 1), cA + hstep, voffA);
    if (wr == 1) PG8_BAR;
    PG8_WAIT_V(4); PG8_BAR;
    PG8_STAGE(PG8_SB(1, 0), cB + kstep, voffB); PG8_STAGE(PG8_SA(1, 0), cA + kstep, voffA); PG8_STAGE(PG8_SB(1, 1), cB + hstep + kstep, voffB);
    PG8_WAIT_V(6); PG8_BAR;
    for (;;) {
        const bool has_next = S.next(ui + 1, nxt);
        const char* nA = has_next ? (const char*)g.A + (size_t)nxt.pm * tstep : cA; const char* nB = has_next ? (const char*)g.Bt + (size_t)nxt.pn * tstep : cB;
        for (int t = 0; t < nt; t += 2) {
            const bool last = (t == nt - 2);
            const char* a1 = cA + (size_t)(t + 1) * kstep;
            const char* a2 = last ? nA : cA + (size_t)(t + 2) * kstep; const char* b2 = last ? nB : cB + (size_t)(t + 2) * kstep;
            const char* a3 = a2 + kstep; const char* b3 = b2 + kstep;
            if (last && has_next) S.a_ready(nxt);
            PG8_LDB(B0, 0, 0); PG8_SCHED; PG8_LDA(At, 0, 0); PG8_STAGE(PG8_SA(1, 1), a1 + hstep, voffA);
            PG8_WAIT_L(8); PG8_BAR; PG8_WAIT_L(0); PG8_MMA(0, 0, At, B0); PG8_BAR; PG8_SCHED;
            PG8_LDB(B1, 0, 1); PG8_STAGE(PG8_SB(0, 0), b2, voffB);
            PG8_BAR; PG8_WAIT_L(0); PG8_MMA(0, 1, At, B1); PG8_BAR;
            PG8_LDA(At, 0, 1); PG8_STAGE(PG8_SA(0, 0), a2, voffA);
            PG8_BAR; PG8_WAIT_L(0); PG8_MMA(1, 0, At, B0); PG8_BAR; PG8_SCHED;
            PG8_STAGE(PG8_SB(0, 1), b2 + hstep, voffB);
            PG8_WAIT_V(6); PG8_BAR; PG8_MMA(1, 1, At, B1); PG8_BAR;
            PG8_LDB(B0, 1, 0); PG8_SCHED; PG8_LDA(At, 1, 0); PG8_STAGE(PG8_SA(0, 1), a2 + hstep, voffA);
            PG8_WAIT_L(8); PG8_BAR; PG8_WAIT_L(0); PG8_MMA(0, 0, At, B0); PG8_BAR; PG8_SCHED;
            PG8_LDB(B1, 1, 1); PG8_STAGE(PG8_SB(1, 0), b3, voffB);
            PG8_BAR; PG8_WAIT_L(0); PG8_MMA(0, 1, At, B1); PG8_BAR;
            PG8_LDA(At, 1, 1); PG8_STAGE(PG8_SA(1, 0), a3, voffA);
            PG8_BAR; PG8_WAIT_L(0); PG8_MMA(1, 0, At, B0); PG8_BAR; PG8_SCHED;
            PG8_STAGE(PG8_SB(1, 1), b3 + hstep, voffB);
            PG8_WAIT_V(6); PG8_BAR; PG8_MMA(1, 1, At, B1); PG8_BAR;
        }
            if constexpr (!Epi::AFTER_DRAIN) { E(acc, cur, wr, wc, fr, fq); S.done(cur); }
            if (!has_next) break;
#pragma unroll
        for (int a = 0; a < 2; ++a)
#pragma unroll
            for (int b = 0; b < 2; ++b)
#pragma unroll
                for (int m = 0; m < 4; ++m)
#pragma unroll
                    for (int n = 0; n < 2; ++n) acc[a][b][m][n] = (f32x4){0.f, 0.f, 0.f, 0.f};
        cur = nxt; cA = nA; cB = nB; ++ui;
    }
    PG8_WAIT_V(0);
    if (wr == 0) PG8_BAR;
    PG8_BAR;
    if constexpr (Epi::AFTER_DRAIN) { E.fused(acc, cur, wr, wc, fr, fq, lds, wid, lane); S.done(cur); }
#undef PG8_SA
#undef PG8_SB
#undef PG8_STAGE
#undef PG8_LDA
#undef PG8_LDB
#undef PG8_MMA
#undef PG8_WAIT_V
#undef PG8_WAIT_L
#undef PG8_BAR
#undef PG8_SCHED
}
}

__device__ void phase_gemm_z(const Params& p, char* lds) {
    pg8::StaticOrder S; S.init(T_TOK, D_IN, gridDim.x, blockIdx.x);
    pg8::gemm_phase<pg8::EpiZ, pg8::StaticOrder>((PG8_LAS unsigned char*)lds, pg8::Gemm{p.xb, p.winT, T_TOK, D_IN, D_MODEL}, S, pg8::EpiZ{p.zb, p.rstd1});
}
__device__ void phase_gemm_out(const Params& p, char* lds) {
    pg8::StaticOrder S; S.init(T_TOK, D_MODEL, gridDim.x, blockIdx.x);
    pg8::gemm_phase<pg8::EpiOut, pg8::StaticOrder>((PG8_LAS unsigned char*)lds, pg8::Gemm{p.cB, p.woutT, T_TOK, D_MODEL, D_MODEL}, S, pg8::EpiOut{p.hb, p.xb});
}
__device__ void phase_gemm_q(const Params& p, char* lds) {
    pg8::StaticOrder S; S.init(T_TOK, 2048, gridDim.x, blockIdx.x);
    pg8::Unit u;
    for (int i = 0; S.next(i, u); ++i)
        pg8::gemm_phase<pg8::EpiQTopk, pg8::OneUnit>((PG8_LAS unsigned char*)lds, pg8::Gemm{p.hb, p.wqT, T_TOK, 2048, D_MODEL}, pg8::OneUnit{u}, pg8::EpiQTopk{p.keysB, p.idx, p.gate});
}

#define XB_TMO      128
#define XB_XCNT(j)  (256  + 64 * (j))
#define XB_XSUB(j)  (1280 + 64 * (j))
#define XB_XGEN(j)  (2304 + 64 * (j))
#define XB_TOP      3328
#define XB_TOPGEN   3392
#define XCD_BAR_WORDS 3456
#define XB_SPIN_CAP (1u << 20)
__device__ __forceinline__ unsigned xb_ld(unsigned* p)              { return __hip_atomic_load(p, __ATOMIC_RELAXED, __HIP_MEMORY_SCOPE_AGENT); }
__device__ __forceinline__ unsigned xb_add(unsigned* p, unsigned v) { return __hip_atomic_fetch_add(p, v, __ATOMIC_RELAXED, __HIP_MEMORY_SCOPE_AGENT); }
__device__ __forceinline__ unsigned xb_xcc_id() { return (unsigned)__builtin_amdgcn_s_getreg((3 << 11) | 20) & 0xFu; }
#define XB_SPIN(cond, bar) do { unsigned _sp = 0; while (cond) { __builtin_amdgcn_s_sleep(1); \
    if ((++_sp & 255u) == 0u) { if (xb_ld(&(bar)[XB_TMO])) break; if (_sp > XB_SPIN_CAP) { atomicAdd(&(bar)[XB_TMO], 1u); break; } } } } while (0)
struct XcdBarrier { unsigned* bar; unsigned x; volatile LAS unsigned* st; };
__device__ __forceinline__ XcdBarrier xcd_barrier_post(unsigned* bar, volatile LAS unsigned* st) {
    XcdBarrier b; b.bar = bar; b.x = xb_xcc_id(); b.st = st;
    if (threadIdx.x == 0) (void)xb_add(&bar[XB_XCNT(b.x)], 1u);
    return b;
}
__device__ __forceinline__ void xcd_barrier_complete(unsigned* bar, unsigned x, unsigned& nloc, unsigned& nx) {
    const unsigned G = gridDim.x * gridDim.y * gridDim.z;
    unsigned sum, cnt, mine, sp = 0u;
    for (;;) {
        sum = 0u; cnt = 0u; mine = 0u;
#pragma unroll
        for (unsigned j = 0; j < 16; ++j) { const unsigned c = xb_ld(&bar[XB_XCNT(j)]); sum += c; cnt += (c > 0u) ? 1u : 0u; mine = (j == x) ? c : mine; }
        if (sum == G) break;
        __builtin_amdgcn_s_sleep(1);
        if ((++sp & 255u) == 0u) { if (xb_ld(&bar[XB_TMO])) break; if (sp > XB_SPIN_CAP) { atomicAdd(&bar[XB_TMO], 1u); break; } }
    }
    nloc = mine > 0u ? mine : 1u; nx = cnt > 0u ? cnt : 1u;
}
__device__ __forceinline__ void xcd_barrier(const XcdBarrier& b) {
    asm volatile("s_waitcnt vmcnt(0)" ::: "memory");
    __syncthreads();
    if (threadIdx.x == 0) {
        unsigned* bar = b.bar;
        __builtin_amdgcn_s_waitcnt(0);
        unsigned nloc = b.st[0], nx = b.st[1];
        if (nloc == 0u) { xcd_barrier_complete(bar, b.x, nloc, nx); b.st[0] = nloc; b.st[1] = nx; }
        const unsigned old = xb_add(&bar[XB_XSUB(b.x)], 1u);
        const unsigned gen = old / nloc;
        if (old + 1u == (gen + 1u) * nloc) {
            __builtin_amdgcn_fence(__ATOMIC_RELEASE, "agent");
            asm volatile("s_waitcnt vmcnt(0)" ::: "memory");
            const unsigned og = xb_add(&bar[XB_TOP], 1u);
            const unsigned tg = og / nx;
            if (og + 1u == (tg + 1u) * nx) xb_add(&bar[XB_TOPGEN], 1u);
            else XB_SPIN(xb_ld(&bar[XB_TOPGEN]) == tg, bar);
            __builtin_amdgcn_fence(__ATOMIC_ACQUIRE, "agent");
            xb_add(&bar[XB_XGEN(b.x)], 1u);
            asm volatile("s_waitcnt vmcnt(0)" ::: "memory");
        } else {
            XB_SPIN(xb_ld(&bar[XB_XGEN(b.x)]) == gen, bar);
            __builtin_amdgcn_fence(__ATOMIC_ACQUIRE, "agent");
            asm volatile("s_waitcnt vmcnt(0)" ::: "memory");
        }
    }
    __syncthreads();
}

#define MEGA_LDS_MAX2(a, b) ((a) > (b) ? (a) : (b))
#define MEGA_LDS_MAIN MEGA_LDS_MAX2(MEGA_LDS_MAX2(QT_LDS_BYTES, pg8::STAGE_BYTES), MEGA_LDS_MAX2(8 * TS_WBYTES, 2 * MIXH_LDS))
#define MEGA_LDS_BYTES (MEGA_LDS_MAIN + 16)
extern __shared__ __attribute__((aligned(16))) char smem[];
__global__ void __launch_bounds__(512, 2) fwd_mega(Params p) {
    volatile LAS unsigned* st = (volatile LAS unsigned*)(smem + MEGA_LDS_MAIN);
    if (threadIdx.x < 4) st[threadIdx.x] = 0u;
    __syncthreads();
    const XcdBarrier xb = xcd_barrier_post(p.bar, st);
    phase_prep(p, smem);      xcd_barrier(xb);
    phase_gemm_z(p, smem);    xcd_barrier(xb);
    phase_mix_gemm(p, smem);  xcd_barrier(xb);
    phase_gemm_out(p, smem);  xcd_barrier(xb);
    phase_gemm_q(p, smem);    xcd_barrier(xb);
    phase_peer_dots(p, smem); xcd_barrier(xb);
    phase_gather(p, smem);
}

extern "C" void kernel_launch(void* const* d_in, const int* in_sizes, int n_in, void* d_out, int out_size, void* d_ws, size_t ws_size, hipStream_t stream) {
    static int grid_blocks = 0;
    if (grid_blocks == 0) {
        int dev = 0, cus = 0, per_cu = 0;
        (void)hipGetDevice(&dev);
        (void)hipDeviceGetAttribute(&cus, hipDeviceAttributeMultiprocessorCount, dev);
        (void)hipFuncSetAttribute((const void*)fwd_mega, hipFuncAttributeMaxDynamicSharedMemorySize, MEGA_LDS_BYTES);
        (void)hipOccupancyMaxActiveBlocksPerMultiprocessor(&per_cu, (const void*)fwd_mega, 512, MEGA_LDS_BYTES);
        if (per_cu > 1) per_cu = 1;
        if (per_cu < 1) per_cu = 1;
        grid_blocks = cus * per_cu;
    }
    Params p{};
    p.x = (const float*)d_in[0]; p.norm1_g = (const float*)d_in[1]; p.w_in = (const float*)d_in[2]; p.pool_w = (const float*)d_in[3];
    p.pool_scale = (const float*)d_in[4]; p.sgu_norm_g = (const float*)d_in[5]; p.sgu_w = (const float*)d_in[6]; p.sgu_b = (const float*)d_in[7];
    p.w_out = (const float*)d_in[8]; p.norm2_g = (const float*)d_in[9]; p.peer_wq = (const float*)d_in[10]; p.peer_keys = (const float*)d_in[11];
    p.peer_u = (const float*)d_in[12]; p.peer_v = (const float*)d_in[13]; p.final_g = (const float*)d_in[14];
    p.out = (float*)d_out;
    char* w = (char*)d_ws; size_t off = 0;
    auto take = [&](size_t bytes) { char* r = w + off; off += (bytes + 255) & ~(size_t)255; return r; };
    const size_t MiB = 1024 * 1024;
    p.u8 = (unsigned char*)take(16 * MiB); p.v8 = (unsigned char*)take(12 * MiB);
    p.su = (float*)take(64 * 1024); p.sv = (float*)take(64 * 1024);
    p.winT = (bf16_t*)take(3 * MiB); p.woutT = (bf16_t*)take(2 * MiB); p.wqT = (bf16_t*)take(4 * MiB);
    p.poolT = (bf16_t*)take(128 * 1024); p.wsM = (bf16_t*)take(128 * 1024); p.keysB = (bf16_t*)take(512 * 1024);
    p.bar = (unsigned*)take(XCD_BAR_WORDS * 4);
    p.rstd1 = (float*)take(128 * 1024);
    p.idx = (int*)take(16 * MiB); p.gate = (float*)take(16 * MiB); p.coef = (float*)take(16 * MiB);
    p.xb = (bf16_t*)take(64 * MiB); p.zb = (bf16_t*)take(96 * MiB); p.cB = (bf16_t*)take(64 * MiB); p.hb = (bf16_t*)take(64 * MiB);
    (void)hipMemsetAsync(p.bar, 0, XCD_BAR_WORDS * 4, stream);
    hipLaunchKernelGGL(fwd_mega, dim3(grid_blocks), dim3(512), MEGA_LDS_BYTES, stream, p);
}
```

```cpp
#include <hip/hip_runtime.h>
#include <stdint.h>
#include <type_traits>

typedef unsigned short bf16_t;
typedef short bf16x8 __attribute__((ext_vector_type(8)));
typedef float f32x4 __attribute__((ext_vector_type(4)));
typedef unsigned u32x4 __attribute__((ext_vector_type(4)));
typedef unsigned u32x2 __attribute__((ext_vector_type(2)));
typedef unsigned u32x3 __attribute__((ext_vector_type(3)));
#define ROWB 768
typedef __bf16 bf2_t __attribute__((ext_vector_type(2)));
#define LAS __attribute__((address_space(3)))

#define T_TOK 32768
#define D_MODEL 1024
#define D_IN 1536
#define SEQ 2048
#define NEXP 16384
#define EPS 1e-6f

struct Params {
    const float *x, *norm1_g, *w_in, *pool_w, *pool_scale, *sgu_norm_g, *sgu_w, *sgu_b, *w_out, *norm2_g, *peer_wq, *peer_keys, *peer_u, *peer_v, *final_g;
    float* out;
    bf16_t *winT, *woutT, *wqT, *poolT, *wsM, *keysB;
    unsigned char *u8, *v8;
    float *su, *sv;
    float *rstd1;
    bf16_t *xb, *zb, *cB, *hb;
    int* idx; float* gate; float* coef;
    unsigned* bar;
};

__device__ __forceinline__ int tid_opaque() { int t = (int)threadIdx.x; asm volatile("" : "+v"(t)); return t; }
__device__ __forceinline__ unsigned short f2bf(float f) {
    unsigned u = __float_as_uint(f);
    u += 0x7fffu + ((u >> 16) & 1u);
    return (unsigned short)(u >> 16);
}
__device__ __forceinline__ float bf2f(unsigned short h) { return __uint_as_float(((unsigned)h) << 16); }
__device__ __forceinline__ unsigned pack2(float a, float b) { return (unsigned)f2bf(a) | ((unsigned)f2bf(b) << 16); }
__device__ __forceinline__ float bflo(unsigned w) { return __uint_as_float(w << 16); }
__device__ __forceinline__ float bfhi(unsigned w) { return __uint_as_float(w & 0xffff0000u); }
__device__ __forceinline__ float gelu_t(float x) {
    const float y = 1.5957691216057308f * (x + 0.044715f * x * x * x);
    return x * __builtin_amdgcn_rcpf(1.0f + __expf(-y));
}
__device__ __forceinline__ float wave_sum(float v) {
#pragma unroll
    for (int o = 32; o >= 1; o >>= 1) v += __shfl_xor(v, o);
    return v;
}
__device__ __forceinline__ float wave_max(float v) {
#pragma unroll
    for (int o = 32; o >= 1; o >>= 1) v = fmaxf(v, __shfl_xor(v, o));
    return v;
}

#define GEMM_LDS_BYTES (2 * 128 * 144)
__device__ __forceinline__ void transpose_tile(const int tid, const float* __restrict__ src, bf16_t* __restrict__ dst, int R, int C, const float* __restrict__ rscale, int tile, float* lds) {
    const int tilesC = C / 64, tr = tile / tilesC, tc = tile % tilesC;
    const int ty = tid >> 6, tx = tid & 63;
    __syncthreads();
#pragma unroll
    for (int i = 0; i < 16; ++i) {
        const int r = ty + 4 * i;
        float v = src[(size_t)(tr * 64 + r) * C + tc * 64 + tx];
        if (rscale) v *= rscale[tr * 64 + r];
        lds[r * 65 + tx] = v;
    }
    __syncthreads();
#pragma unroll
    for (int i = 0; i < 16; ++i) {
        const int c = ty + 4 * i;
        dst[(size_t)(tc * 64 + c) * R + tr * 64 + tx] = f2bf(lds[tx * 65 + c]);
    }
}

__device__ void phase_prep(const Params& p, char* lds) {
    const int tidx_ = tid_opaque();
    const int nb = gridDim.x, b = blockIdx.x, tid = tidx_;
    const int half = tid >> 8, ht = tid & 255, nh = 2 * nb, hb2 = 2 * b + half;
    float* fl = (float*)(lds + half * (64 * 65 * 4));
    for (int t = hb2; t < 16 * 24; t += nh) transpose_tile(ht, p.w_in, p.winT, 1024, 1536, p.norm1_g, t, fl);
    for (int t = hb2; t < 16 * 16; t += nh) transpose_tile(ht, p.w_out, p.woutT, 1024, 1024, nullptr, t, fl);
    for (int t = hb2; t < 16 * 32; t += nh) transpose_tile(ht, p.peer_wq, p.wqT, 1024, 2048, p.norm2_g, t, fl);
    for (int t = hb2; t < 16; t += nh) transpose_tile(ht, p.pool_w + (size_t)(t >> 2) * 16384, p.poolT + (size_t)(t >> 2) * 16384, 128, 128, nullptr, t & 3, fl);
    const size_t gtid = (size_t)b * blockDim.x + tid, gsz = (size_t)nb * blockDim.x;
    for (size_t i = gtid; i < 4 * 128 * 128; i += gsz) {
        const int j = (int)(i & 127), ii = (int)((i >> 7) & 127);
        const bool keep = (j >> 6) <= (ii >> 6);
        p.wsM[i] = keep ? f2bf(p.sgu_w[i]) : (bf16_t)0;
    }
    for (size_t i = gtid; i < 2 * 8 * 128 * 128; i += gsz) p.keysB[i] = f2bf(p.peer_keys[i]);
    {
        const int wave = (b * blockDim.x + tid) >> 6, nwaves = (nb * blockDim.x) >> 6, lane = tid & 63;
        float g16[16];
#pragma unroll
        for (int i = 0; i < 4; ++i) { const float4 g = ((const float4*)(p.norm2_g + lane * 16))[i]; g16[4 * i] = g.x; g16[4 * i + 1] = g.y; g16[4 * i + 2] = g.z; g16[4 * i + 3] = g.w; }
        auto quant_row = [&](const float (&f)[16], unsigned char* dst, float* scale_out) {
            float am = 0.f;
#pragma unroll
            for (int j = 0; j < 16; ++j) am = fmaxf(am, fabsf(f[j]));
            am = wave_max(am);
            const float inv = am > 0.f ? 31.0f / am : 0.f;
            int q[16];
#pragma unroll
            for (int j = 0; j < 16; ++j) q[j] = (int)rintf(f[j] * inv) + 32;
            u32x3 o;
#pragma unroll
            for (int i = 0; i < 3; ++i) {
                unsigned w = 0;
#pragma unroll
                for (int k = 0; k < 4; ++k) w |= (unsigned)(q[4 * i + k] | (((q[12 + k] >> (2 * i)) & 3) << 6)) << (8 * k);
                o[i] = w;
            }
            *(u32x3*)(dst + lane * 12) = o;
            if (lane == 0) *scale_out = am * (1.0f / 31.0f);
        };
        for (int e = wave; e < NEXP; e += nwaves) {
            const float4* su4 = (const float4*)(p.peer_u + (size_t)e * D_MODEL + lane * 16);
            const float4* sv4 = (const float4*)(p.peer_v + (size_t)e * D_MODEL + lane * 16);
            float4 a4[4], b4[4];
#pragma unroll
            for (int i = 0; i < 4; ++i) { a4[i] = su4[i]; b4[i] = sv4[i]; }
            float fu[16], fv[16];
#pragma unroll
            for (int i = 0; i < 4; ++i) {
                fu[4 * i] = a4[i].x * g16[4 * i]; fu[4 * i + 1] = a4[i].y * g16[4 * i + 1]; fu[4 * i + 2] = a4[i].z * g16[4 * i + 2]; fu[4 * i + 3] = a4[i].w * g16[4 * i + 3];
                fv[4 * i] = b4[i].x; fv[4 * i + 1] = b4[i].y; fv[4 * i + 2] = b4[i].z; fv[4 * i + 3] = b4[i].w;
            }
            {
                float am = 0.f;
#pragma unroll
                for (int j = 0; j < 16; ++j) am = fmaxf(am, fabsf(fu[j]));
                am = wave_max(am);
                const float inv = am > 0.f ? 127.0f / am : 0.f;
                u32x4 o;
#pragma unroll
                for (int i = 0; i < 4; ++i) {
                    unsigned w = 0;
#pragma unroll
                    for (int k = 0; k < 4; ++k) w |= (unsigned)(((int)rintf(fu[4 * i + k] * inv)) & 0xff) << (8 * k);
                    o[i] = w;
                }
                *(u32x4*)(p.u8 + (size_t)e * D_MODEL + lane * 16) = o;
                if (lane == 0) p.su[e] = am * (1.0f / 127.0f);
            }
            quant_row(fv, p.v8 + (size_t)e * ROWB, p.sv + e);
        }
    }
    const int wave = (b * blockDim.x + tid) >> 6, nwaves = (nb * blockDim.x) >> 6, lane = tid & 63;
    for (int t = wave; t < T_TOK; t += 2 * nwaves) {
        const int t1 = t + nwaves; const bool two = t1 < T_TOK;
        const float4* xr0 = (const float4*)(p.x + (size_t)t * D_MODEL);
        const float4* xr1 = (const float4*)(p.x + (size_t)(two ? t1 : t) * D_MODEL);
        float4 v0[4], v1[4];
#pragma unroll
        for (int i = 0; i < 4; ++i) { v0[i] = xr0[lane + 64 * i]; v1[i] = xr1[lane + 64 * i]; }
        float s0 = 0.f, s1 = 0.f;
#pragma unroll
        for (int i = 0; i < 4; ++i) {
            s0 += v0[i].x * v0[i].x + v0[i].y * v0[i].y + v0[i].z * v0[i].z + v0[i].w * v0[i].w;
            s1 += v1[i].x * v1[i].x + v1[i].y * v1[i].y + v1[i].z * v1[i].z + v1[i].w * v1[i].w;
            uint2 o; o.x = pack2(v0[i].x, v0[i].y); o.y = pack2(v0[i].z, v0[i].w);
            ((uint2*)(p.xb + (size_t)t * D_MODEL))[lane + 64 * i] = o;
            if (two) { uint2 o1; o1.x = pack2(v1[i].x, v1[i].y); o1.y = pack2(v1[i].z, v1[i].w); ((uint2*)(p.xb + (size_t)t1 * D_MODEL))[lane + 64 * i] = o1; }
        }
        s0 = wave_sum(s0); s1 = wave_sum(s1);
        if (lane == 0) { p.rstd1[t] = rsqrtf(s0 * (1.0f / D_MODEL) + EPS); if (two) p.rstd1[t1] = rsqrtf(s1 * (1.0f / D_MODEL) + EPS); }
    }
}

typedef short s16x4 __attribute__((ext_vector_type(4)));
template <class Epi>
__device__ __forceinline__ void gemm128_sgu(const int tid, const bf16_t* __restrict__ A, const bf16_t* __restrict__ V  ,
                                            const float* __restrict__ lnm, const float* __restrict__ lnr, const float* __restrict__ gch, char* lds, const Epi& epi) {
    const int lane = tid & 63, wid = tid >> 6, wr = wid >> 1, wc = wid & 1, fr = lane & 15, fq = lane >> 4;
    constexpr int PITCH = 144, P2 = 288;
    char* sA = lds; char* sB = lds + 128 * PITCH;
    f32x4 acc[4][4];
#pragma unroll
    for (int m = 0; m < 4; ++m)
#pragma unroll
        for (int n = 0; n < 4; ++n) acc[m][n] = (f32x4){0.f, 0.f, 0.f, 0.f};
    u32x4 ra[4], rb[4]; float rm[4], rr[4];
    const int lrow = tid >> 3, lch = tid & 7;
    const int btok = tid >> 4, bch = tid & 15;
    const bf16_t* ga = A + (size_t)lrow * 128 + lch * 8;
    const bf16_t* gb = V + (size_t)btok * D_IN + bch * 8;
    float g8[8];
    { const float4 g0 = *(const float4*)(gch + bch * 8), g1 = *(const float4*)(gch + bch * 8 + 4); g8[0] = g0.x; g8[1] = g0.y; g8[2] = g0.z; g8[3] = g0.w; g8[4] = g1.x; g8[5] = g1.y; g8[6] = g1.z; g8[7] = g1.w; }
#pragma unroll
    for (int j = 0; j < 4; ++j) { ra[j] = *(const u32x4*)(ga + (size_t)(32 * j) * 128); rb[j] = *(const u32x4*)(gb + (size_t)(16 * j) * D_IN); rm[j] = lnm[btok + 16 * j]; rr[j] = lnr[btok + 16 * j]; }
    for (int k0 = 0; k0 < 128; k0 += 64) {
        __syncthreads();
#pragma unroll
        for (int j = 0; j < 4; ++j) {
            *(u32x4*)(sA + (lrow + 32 * j) * PITCH + lch * 16) = ra[j];
            u32x4 o;
#pragma unroll
            for (int i = 0; i < 4; ++i) {
                const unsigned w = rb[j][i];
                o[i] = pack2((bflo(w) - rm[j]) * rr[j] * g8[2 * i], (bfhi(w) - rm[j]) * rr[j] * g8[2 * i + 1]);
            }
            *(u32x4*)(sB + (btok + 16 * j) * P2 + bch * 16) = o;
        }
        __syncthreads();
        if (k0 + 64 < 128) {
#pragma unroll
            for (int j = 0; j < 4; ++j) { ra[j] = *(const u32x4*)(ga + (size_t)(32 * j) * 128 + 64); rb[j] = *(const u32x4*)(gb + (size_t)(64 + 16 * j) * D_IN); rm[j] = lnm[64 + btok + 16 * j]; rr[j] = lnr[64 + btok + 16 * j]; }
        }
#pragma unroll
        for (int kk = 0; kk < 2; ++kk) {
            bf16x8 af[4], bfr[4];
#pragma unroll
            for (int m = 0; m < 4; ++m) af[m] = *(const bf16x8*)(sA + (wr * 64 + m * 16 + fr) * PITCH + (kk * 32 + fq * 8) * 2);
#pragma unroll
            for (int n = 0; n < 4; ++n) {
                const char* bp = sB + (kk * 32 + fq * 8 + (fr >> 2)) * P2 + (wc * 64 + n * 16 + 4 * (fr & 3)) * 2;
                const s16x4 lo = __builtin_amdgcn_ds_read_tr16_b64_v4i16((LAS s16x4*)(bp));
                const s16x4 hi = __builtin_amdgcn_ds_read_tr16_b64_v4i16((LAS s16x4*)(bp + 4 * P2));
                bfr[n] = (bf16x8){lo[0], lo[1], lo[2], lo[3], hi[0], hi[1], hi[2], hi[3]};
            }
#pragma unroll
            for (int m = 0; m < 4; ++m)
#pragma unroll
                for (int n = 0; n < 4; ++n) acc[m][n] = __builtin_amdgcn_mfma_f32_16x16x32_bf16(bfr[n], af[m], acc[m][n], 0, 0, 0);
        }
    }
#pragma unroll
    for (int m = 0; m < 4; ++m)
#pragma unroll
        for (int n = 0; n < 4; ++n) epi(wr * 64 + m * 16 + fr, wc * 64 + n * 16 + fq * 4, acc[m][n]);
}

#define PT_PITCH 272
#define MIXH_LDS (2 * 128 * PT_PITCH + 1024)
template <int W, class Epi>
__device__ __forceinline__ void pool_tile(const int tid, const bf16_t* __restrict__ zb0  , int pos0,
                                          const bf16_t* __restrict__ Bt, char* lds, const Epi& epi) {
    const int lane = tid & 63, wid = tid >> 6, wr = wid >> 1, wc = wid & 1, fr = lane & 15, fq = lane >> 4;
    char* sA = lds; char* sB = lds + 128 * PT_PITCH;
    __syncthreads();
#pragma unroll
    for (int j = 0; j < 8; ++j) { const int id = tid + 256 * j, row = id >> 4, ch = id & 15; *(u32x4*)(sB + row * PT_PITCH + ch * 16) = *(const u32x4*)(Bt + (size_t)row * 128 + ch * 8); }
#pragma unroll 1
    for (int j = 0; j < 8; ++j) {
        const int id = tid + 256 * j, row = id >> 4, ch = id & 15, pos = (pos0 + row) & (SEQ - 1);
        const bf16_t* zp = zb0 + (size_t)row * D_IN + ch * 8;
        u32x4 v[W];
#pragma unroll
        for (int k = 0; k < W; ++k) v[k] = *(const u32x4*)(zp - (size_t)(k <= pos ? k : 0) * D_IN);
        float sm[8];
#pragma unroll
        for (int i = 0; i < 8; ++i) sm[i] = 0.f;
#pragma unroll
        for (int k = 0; k < W; ++k) {
            const float m = (k <= pos) ? 1.f : 0.f;
#pragma unroll
            for (int i = 0; i < 4; ++i) { sm[2 * i] += m * bflo(v[k][i]); sm[2 * i + 1] += m * bfhi(v[k][i]); }
        }
        const float fn = (float)((pos + 1 < W) ? pos + 1 : W);
        u32x4 o;
#pragma unroll
        for (int i = 0; i < 4; ++i) o[i] = pack2(sm[2 * i] / fn - bflo(v[0][i]), sm[2 * i + 1] / fn - bfhi(v[0][i]));
        *(u32x4*)(sA + row * PT_PITCH + ch * 16) = o;
    }
    __syncthreads();
    f32x4 acc[4][4];
#pragma unroll
    for (int m = 0; m < 4; ++m)
#pragma unroll
        for (int n = 0; n < 4; ++n) acc[m][n] = (f32x4){0.f, 0.f, 0.f, 0.f};
#pragma unroll
    for (int kk = 0; kk < 4; ++kk) {
        bf16x8 af[4], bfr[4];
#pragma unroll
        for (int m = 0; m < 4; ++m) af[m] = *(const bf16x8*)(sA + (wr * 64 + m * 16 + fr) * PT_PITCH + (kk * 32 + fq * 8) * 2);
#pragma unroll
        for (int n = 0; n < 4; ++n) bfr[n] = *(const bf16x8*)(sB + (wc * 64 + n * 16 + fr) * PT_PITCH + (kk * 32 + fq * 8) * 2);
#pragma unroll
        for (int m = 0; m < 4; ++m)
#pragma unroll
            for (int n = 0; n < 4; ++n) acc[m][n] = __builtin_amdgcn_mfma_f32_16x16x32_bf16(bfr[n], af[m], acc[m][n], 0, 0, 0);
    }
#pragma unroll
    for (int m = 0; m < 4; ++m)
#pragma unroll
        for (int n = 0; n < 4; ++n) epi(wr * 64 + m * 16 + fr, wc * 64 + n * 16 + fq * 4, acc[m][n]);
}

__device__ void phase_mix_gemm(const Params& p, char* lds) {
    const int tidx_ = tid_opaque();
    const int npool = (T_TOK / 128) * 4, nsgu = (T_TOK / 128) * 4;
    const int half = tidx_ >> 8, ht = tidx_ & 255; lds += half * MIXH_LDS;
    for (int tile = 2 * blockIdx.x + half; tile < npool + nsgu; tile += 2 * gridDim.x) {
        if (tile < npool) {
            const int tm = tile >> 2, g = tile & 3;
            const float* ps = p.pool_scale + g * 128; bf16_t* co = p.cB + (size_t)tm * 128 * D_MODEL + g * 128;
            const bf16_t* z0 = p.zb + (size_t)tm * 128 * D_IN + g * 128; const bf16_t* bt = p.poolT + (size_t)g * 16384;
            auto epi = [&](int r, int c, f32x4 v) {
                const float4 sc = *(const float4*)(ps + c);
                uint2 o; o.x = pack2(v[0] * sc.x, v[1] * sc.y); o.y = pack2(v[2] * sc.z, v[3] * sc.w);
                *(uint2*)(co + (size_t)r * D_MODEL + c) = o;
            };
            if (g == 0) pool_tile<2>(ht, z0, tm * 128, bt, lds, epi); else if (g == 1) pool_tile<4>(ht, z0, tm * 128, bt, lds, epi);
            else if (g == 2) pool_tile<8>(ht, z0, tm * 128, bt, lds, epi); else pool_tile<16>(ht, z0, tm * 128, bt, lds, epi);
        } else {
            const int t2 = tile - npool, blk = t2 >> 2, h = t2 & 3;
            float* stm = (float*)(lds + GEMM_LDS_BYTES); float* str = stm + 128;
            __syncthreads();
            {
                const int tok = ht >> 1, hh = ht & 1;
                const u32x4* vp = (const u32x4*)(p.zb + (size_t)(blk * 128 + tok) * D_IN + 1024 + hh * 256);
                float s1 = 0.f, s2 = 0.f;
#pragma unroll 8
                for (int i = 0; i < 32; ++i) {
                    const u32x4 v = vp[i];
#pragma unroll
                    for (int k = 0; k < 4; ++k) { const float a = bflo(v[k]), c = bfhi(v[k]); s1 += a + c; s2 += a * a + c * c; }
                }
                s1 += __shfl_xor(s1, 1); s2 += __shfl_xor(s2, 1);
                const float mean = s1 * (1.0f / 512.0f), var = fmaxf(s2 * (1.0f / 512.0f) - mean * mean, 0.f);
                if (hh == 0) { stm[tok] = mean; str[tok] = rsqrtf(var + EPS); }
            }
            __syncthreads();
            const float* sb = p.sgu_b + h * 128; const bf16_t* uo = p.zb + (size_t)blk * 128 * D_IN + 512 + h * 128;
            bf16_t* co = p.cB + (size_t)blk * 128 * D_MODEL + 512 + h * 128;
            gemm128_sgu(ht, p.wsM + (size_t)h * 16384, p.zb + (size_t)blk * 128 * D_IN + 1024 + h * 128, stm, str, p.sgu_norm_g + h * 128, lds,
                    [&](int r, int c, f32x4 v) {
                        const float bb = sb[r];
                        const uint2 uu = *(const uint2*)(uo + (size_t)r * D_IN + c);
                        uint2 o;
                        o.x = pack2((v[0] + bb) * bflo(uu.x), (v[1] + bb) * bfhi(uu.x));
                        o.y = pack2((v[2] + bb) * bflo(uu.y), (v[3] + bb) * bfhi(uu.y));
                        *(uint2*)(co + (size_t)r * D_MODEL + c) = o;
                    });
        }
    }
}

__device__ __forceinline__ int wave_sum_i_uniform(int s) {
    s += __builtin_amdgcn_update_dpp(0, s, 0xB1, 0xf, 0xf, false);
    s += __builtin_amdgcn_update_dpp(0, s, 0x4E, 0xf, 0xf, false);
    s += __builtin_amdgcn_update_dpp(0, s, 0x141, 0xf, 0xf, false);
    s += __builtin_amdgcn_update_dpp(0, s, 0x140, 0xf, 0xf, false);
    return __builtin_amdgcn_readlane(s, 0) + __builtin_amdgcn_readlane(s, 16) + __builtin_amdgcn_readlane(s, 32) + __builtin_amdgcn_readlane(s, 48);
}
__constant__ unsigned char kComb[64] = {
    0x00,0x01,0x02,0x03,0x04,0x05,0x06,0x07,0x08,0x09,0x0a,0x0b,0x0c,0x0d,0x0e,0x0f,
    0x10,0x11,0x12,0x13,0x14,0x15,0x16,0x17,
    0x20,0x21,0x22,0x23,0x24,
    0x30,0x31,0x32,0x33,
    0x40,0x41,0x42,
    0x50,0x51,
    0x60,0x61,
    0x70,0x71,
    0x80,0x90,0xa0,0xb0,0xc0,0xd0,0xe0,0xf0,
    0xff,0xff,0xff,0xff,0xff,0xff,0xff,0xff,0xff,0xff,0xff,0xff,0xff,0xff};

template <int CTRL> __device__ __forceinline__ int dpp_i(int v) { return __builtin_amdgcn_update_dpp(0, v, CTRL, 0xf, 0xf, false); }
__device__ __forceinline__ int row_allmax_i(int v) {
    v = max(v, dpp_i<0x128>(v)); v = max(v, dpp_i<0x124>(v)); v = max(v, dpp_i<0x122>(v)); v = max(v, dpp_i<0x121>(v));
    return v;
}
__device__ __forceinline__ float row_allsum_f(float v) {
    v += __int_as_float(dpp_i<0x128>(__float_as_int(v))); v += __int_as_float(dpp_i<0x124>(__float_as_int(v)));
    v += __int_as_float(dpp_i<0x122>(__float_as_int(v))); v += __int_as_float(dpp_i<0x121>(__float_as_int(v)));
    return v;
}
__device__ __forceinline__ int f2key(float f) { const int b = __float_as_int(f); return b ^ ((b >> 31) & 0x7fffffff); }
__device__ __forceinline__ float key2f(int k) { return __int_as_float(k ^ ((k >> 31) & 0x7fffffff)); }
#define KEY_MIN ((int)0x80000000)
#define CE(a, b) { const int hi_ = max(a, b), lo_ = min(a, b); a = hi_; b = lo_; }
__device__ __forceinline__ int top16_rows(int (&k)[8], int l15) {
    CE(k[0], k[1]) CE(k[2], k[3]) CE(k[4], k[5]) CE(k[6], k[7])
    CE(k[0], k[2]) CE(k[1], k[3]) CE(k[4], k[6]) CE(k[5], k[7])
    CE(k[1], k[2]) CE(k[5], k[6])
    CE(k[0], k[4]) CE(k[1], k[5]) CE(k[2], k[6]) CE(k[3], k[7])
    CE(k[2], k[4]) CE(k[3], k[5])
    CE(k[1], k[2]) CE(k[3], k[4]) CE(k[5], k[6])
    int res = KEY_MIN;
#pragma unroll
    for (int r = 0; r < 16; ++r) {
        const int m = row_allmax_i(k[0]);
        const bool own = (k[0] == m);
#pragma unroll
        for (int j = 0; j < 7; ++j) k[j] = own ? k[j + 1] : k[j];
        k[7] = own ? KEY_MIN : k[7];
        res = (l15 == r) ? m : res;
    }
    return res;
}
__device__ __forceinline__ void combine16(int A, int B, const int (&cbv)[4], int lane, int l15, int& eid_out, float& gate_out) {
    const int rowbase = lane & 48;
    int ck[4], eid[4];
#pragma unroll
    for (int c = 0; c < 4; ++c) {
        const int ci = (cbv[c] >> 4) & 15, cj = cbv[c] & 15;
        const int ka = __builtin_amdgcn_ds_bpermute((rowbase + ci) << 2, A);
        const int kb = __builtin_amdgcn_ds_bpermute((rowbase + cj) << 2, B);
        const float sm = key2f(ka & ~127) + key2f(kb & ~127);
        eid[c] = ((127 - (ka & 127)) << 7) | (127 - (kb & 127));
        ck[c] = (cbv[c] != 0xff) ? ((f2key(sm) & ~63) | (63 - (4 * l15 + c))) : KEY_MIN;
    }
    CE(ck[0], ck[1]) CE(ck[2], ck[3]) CE(ck[0], ck[2]) CE(ck[1], ck[3]) CE(ck[1], ck[2])
    int res = KEY_MIN;
#pragma unroll
    for (int r = 0; r < 16; ++r) {
        const int m = row_allmax_i(ck[0]);
        const bool own = (ck[0] == m);
        ck[0] = own ? ck[1] : ck[0]; ck[1] = own ? ck[2] : ck[1]; ck[2] = own ? ck[3] : ck[2]; ck[3] = own ? KEY_MIN : ck[3];
        res = (l15 == r) ? m : res;
    }
    const int slot = 63 - (res & 63);
    const int src = (rowbase + (slot >> 2)) << 2;
    const int e0 = __builtin_amdgcn_ds_bpermute(src, eid[0]), e1 = __builtin_amdgcn_ds_bpermute(src, eid[1]);
    const int e2 = __builtin_amdgcn_ds_bpermute(src, eid[2]), e3 = __builtin_amdgcn_ds_bpermute(src, eid[3]);
    const int sel = slot & 3;
    eid_out = sel == 0 ? e0 : (sel == 1 ? e1 : (sel == 2 ? e2 : e3));
    gate_out = key2f(res & ~63);
}

__device__ __forceinline__ int reduce16_rows(const int (&part)[16], bool b3, bool b2, bool b1, bool b0b) {
    int r8[8], r4[4], r2[2];
#pragma unroll
    for (int k = 0; k < 8; ++k) { const int keep = b3 ? part[8 + k] : part[k], send = b3 ? part[k] : part[8 + k]; r8[k] = keep + __builtin_amdgcn_update_dpp(0, send, 0x140, 0xf, 0xf, false); }
#pragma unroll
    for (int k = 0; k < 4; ++k) { const int keep = b2 ? r8[4 + k] : r8[k], send = b2 ? r8[k] : r8[4 + k]; r4[k] = keep + __builtin_amdgcn_update_dpp(0, send, 0x141, 0xf, 0xf, false); }
#pragma unroll
    for (int k = 0; k < 2; ++k) { const int keep = b1 ? r4[2 + k] : r4[k], send = b1 ? r4[k] : r4[2 + k]; r2[k] = keep + __builtin_amdgcn_update_dpp(0, send, 0x4E, 0xf, 0xf, false); }
    const int keep = b0b ? r2[1] : r2[0], send = b0b ? r2[0] : r2[1];
    int r1 = keep + __builtin_amdgcn_update_dpp(0, send, 0xB1, 0xf, 0xf, false);
    r1 += __shfl_xor(r1, 16); r1 += __shfl_xor(r1, 32);
    return r1;
}
#define TS_WBYTES (16384 + 128)
__device__ void phase_peer_dots(const Params& p, char* lds) {
    const int tidx_ = tid_opaque();
    const int lane = tidx_ & 63, wid = __builtin_amdgcn_readfirstlane((int)(tidx_ >> 6)), l15 = lane & 15;
    const bool b3 = (lane & 8) != 0, b2 = (lane & 4) != 0, b1 = (lane & 2) != 0, b0b = (lane & 1) != 0;
    const int gw = blockIdx.x * (blockDim.x >> 6) + wid, ngw = gridDim.x * (blockDim.x >> 6);
    char* wl = lds + wid * TS_WBYTES;
    unsigned* list = (unsigned*)wl; int* dotsl = (int*)(wl + 4096); char* hql = wl + 8192; int* tks = (int*)(wl + 16384);
    const unsigned lane16 = (unsigned)lane * 16u;
    for (int tb = gw * 8; tb < T_TOK; tb += ngw * 8) {
#pragma unroll 1
        for (int j0 = 0; j0 < 8; j0 += 4) {
            u32x4 hraw[4][2];
#pragma unroll
            for (int jj = 0; jj < 4; ++jj) { const u32x4* hr = (const u32x4*)(p.hb + (size_t)(tb + j0 + jj) * D_MODEL); hraw[jj][0] = hr[2 * lane]; hraw[jj][1] = hr[2 * lane + 1]; }
#pragma unroll
            for (int jj = 0; jj < 4; ++jj) {
                const int j = j0 + jj;
                const u32x4 a = hraw[jj][0], c = hraw[jj][1];
                const float f[16] = {bflo(a.x), bfhi(a.x), bflo(a.y), bfhi(a.y), bflo(a.z), bfhi(a.z), bflo(a.w), bfhi(a.w),
                                     bflo(c.x), bfhi(c.x), bflo(c.y), bfhi(c.y), bflo(c.z), bfhi(c.z), bflo(c.w), bfhi(c.w)};
                float ss = 0.f, am = 0.f;
#pragma unroll
                for (int k = 0; k < 16; ++k) { ss += f[k] * f[k]; am = fmaxf(am, fabsf(f[k])); }
                ss = wave_sum(ss); am = wave_max(am);
                const float inv = am > 0.f ? 127.0f / am : 0.f;
                u32x4 o; int hsum = 0;
#pragma unroll
                for (int i = 0; i < 4; ++i) {
                    unsigned w = 0;
#pragma unroll
                    for (int k = 0; k < 4; ++k) { const int qv = (int)rintf(f[4 * i + k] * inv); hsum += qv; w |= (unsigned)(qv & 0xff) << (8 * k); }
                    o[i] = w;
                }
                *(u32x4*)(hql + j * 1024 + lane * 16) = o;
                hsum = wave_sum_i_uniform(hsum);
                const float r2 = rsqrtf(ss * (1.0f / D_MODEL) + EPS);
                if (lane == 0) { tks[4 * j] = hsum; tks[4 * j + 1] = __float_as_int(am * (1.0f / 127.0f) * r2); tks[4 * j + 2] = __float_as_int(r2); }
            }
        }
        int idv[8][2];
#pragma unroll
        for (int j = 0; j < 8; ++j) { const int* ir = p.idx + (size_t)(tb + j) * 128; idv[j][0] = ir[lane]; idv[j][1] = ir[64 + lane]; }
#pragma unroll 1
        for (int x = 0; x < 8; ++x) {
            int n = 0;
#pragma unroll
            for (int j = 0; j < 8; ++j)
#pragma unroll
                for (int r = 0; r < 2; ++r) {
                    const int e = idv[j][r];
                    const bool in = (e >> 11) == x;
                    const unsigned long long mk = __ballot(in);
                    const int rank = (int)__builtin_amdgcn_mbcnt_hi((unsigned)(mk >> 32), __builtin_amdgcn_mbcnt_lo((unsigned)mk, 0u));
                    if (in) list[n + rank] = ((unsigned)j << 21) | ((unsigned)(r * 64 + lane) << 14) | (unsigned)e;
                    n += (int)__builtin_popcountll(mk);
                }
            asm volatile("s_waitcnt lgkmcnt(0)" ::: "memory");
            u32x4 ua[16], ubf[16]; int enta = 0, entb = 0;
            auto issue = [&](int b0, u32x4 (&uu)[16], int& entv) {
                const int i = (b0 + l15 < n) ? b0 + l15 : n - 1;
                entv = (int)list[i];
#pragma unroll
                for (int j = 0; j < 16; ++j) { const int e = __builtin_amdgcn_readlane(entv, j) & 0x3fff; uu[j] = *(const u32x4*)(p.u8 + (size_t)e * D_MODEL + lane16); }
            };
            auto reduce = [&](int b0, const u32x4 (&uu)[16], int entv) {
                int part[16];
#pragma unroll
                for (int j = 0; j < 16; ++j) {
                    const int tl = __builtin_amdgcn_readlane(entv, j) >> 21;
                    const u32x4 hqv = *(const u32x4*)(hql + tl * 1024 + lane * 16);
                    int sacc = __builtin_amdgcn_sdot4((int)uu[j].x, (int)hqv.x, 0, false);
                    sacc = __builtin_amdgcn_sdot4((int)uu[j].y, (int)hqv.y, sacc, false);
                    sacc = __builtin_amdgcn_sdot4((int)uu[j].z, (int)hqv.z, sacc, false);
                    part[j] = __builtin_amdgcn_sdot4((int)uu[j].w, (int)hqv.w, sacc, false);
                }
                const int r1 = reduce16_rows(part, b3, b2, b1, b0b);
                if (lane < 16 && b0 + lane < n) dotsl[((unsigned)entv >> 21) * 128 + (((unsigned)entv >> 14) & 127u)] = r1;
            };
            if (n > 0) issue(0, ua, enta);
            for (int b0 = 0; b0 < n; b0 += 32) {
                if (b0 + 16 < n) issue(b0 + 16, ubf, entb);
                reduce(b0, ua, enta);
                if (b0 + 16 < n) {
                    if (b0 + 32 < n) issue(b0 + 32, ua, enta);
                    reduce(b0 + 16, ubf, entb);
                }
            }
            asm volatile("s_waitcnt lgkmcnt(0)" ::: "memory");
        }
#pragma unroll
        for (int j = 0; j < 8; ++j) {
            const int hs_t = tks[4 * j]; const float cs_t = __int_as_float(tks[4 * j + 1]), r2_t = __int_as_float(tks[4 * j + 2]);
            const float* gr = p.gate + (size_t)(tb + j) * 128; float* cr = p.coef + (size_t)(tb + j) * 128;
#pragma unroll
            for (int r = 0; r < 2; ++r) {
                const int e = idv[j][r];
                const float sc = gr[r * 64 + lane] * r2_t;
                const float ex = __expf(sc - key2f(row_allmax_i(f2key(sc))));
                const float gt = ex / row_allsum_f(ex);
                const float dotf = (float)dotsl[j * 128 + r * 64 + lane] * cs_t * p.su[e];
                cr[r * 64 + lane] = gt * gelu_t(dotf) * p.sv[e];
            }
        }
        asm volatile("s_waitcnt lgkmcnt(0)" ::: "memory");
    }
}

__device__ void phase_gather(const Params& p, char* lds) {
    const int tidx_ = tid_opaque();
    const int wave = __builtin_amdgcn_readfirstlane((int)((blockIdx.x * blockDim.x + tidx_) >> 6)), nwaves = (gridDim.x * blockDim.x) >> 6, lane = tidx_ & 63;
    const unsigned char* vb = p.v8 + lane * 12;
    for (int t = wave; t < T_TOK; t += nwaves) {
        int idr[2]; float coef[2];
        { const int* ir = p.idx + (size_t)t * 128; idr[0] = ir[lane]; idr[1] = ir[64 + lane]; }
        { const float* cr = p.coef + (size_t)t * 128; coef[0] = cr[lane]; coef[1] = cr[64 + lane]; }
        const float cmax = wave_max(fmaxf(fabsf(coef[0]), fabsf(coef[1])));
        const float qs = cmax > 0.f ? 127.0f / cmax : 0.f, cscale = cmax * (1.0f / 127.0f);
        const int cq0 = (int)rintf(coef[0] * qs), cq1 = (int)rintf(coef[1] * qs);
        const int csum_i = wave_sum_i_uniform(cq0 + cq1);
        unsigned cpk[2];
        {
            const int cqs[2] = {cq0, cq1};
#pragma unroll
            for (int hf = 0; hf < 2; ++hf) {
                const int bb = cqs[hf] & 0xff;
                cpk[hf] = (unsigned)__builtin_amdgcn_update_dpp(0, bb, 0x00, 0xf, 0xf, false) | ((unsigned)__builtin_amdgcn_update_dpp(0, bb, 0x55, 0xf, 0xf, false) << 8)
                        | ((unsigned)__builtin_amdgcn_update_dpp(0, bb, 0xAA, 0xf, 0xf, false) << 16) | ((unsigned)__builtin_amdgcn_update_dpp(0, bb, 0xFF, 0xf, 0xf, false) << 24);
            }
        }
        int acc[16];
#pragma unroll
        for (int j = 0; j < 16; ++j) acc[j] = 0;
        {
            u32x3 va[8], vbf[8];
            auto issue = [&](int pb, u32x3 (&vv)[8]) {
#pragma unroll
                for (int q = 0; q < 8; ++q) { const int e = __builtin_amdgcn_readlane(pb < 64 ? idr[0] : idr[1], (pb & 63) + q); vv[q] = *(const u32x3*)(vb + (size_t)e * ROWB); }
            };
            auto axpy = [&](int pb, const u32x3 (&vv)[8]) {
#pragma unroll
                for (int g4 = 0; g4 < 2; ++g4) {
                    const int cqd = __builtin_amdgcn_readlane((int)(pb < 64 ? cpk[0] : cpk[1]), (pb & 63) + 4 * g4);
                    unsigned dd[4][4];
#pragma unroll
                    for (int r = 0; r < 4; ++r) {
                        const unsigned w0 = vv[4 * g4 + r].x, w1 = vv[4 * g4 + r].y, w2 = vv[4 * g4 + r].z;
                        dd[r][0] = w0 & 0x3f3f3f3fu; dd[r][1] = w1 & 0x3f3f3f3fu; dd[r][2] = w2 & 0x3f3f3f3fu;
                        dd[r][3] = ((w0 >> 6) & 0x03030303u) | ((w1 >> 4) & 0x0c0c0c0cu) | ((w2 >> 2) & 0x30303030u);
                    }
#pragma unroll
                    for (int k = 0; k < 4; ++k) {
                        const unsigned p0 = __builtin_amdgcn_perm(dd[1][k], dd[0][k], 0x05010400u), p1 = __builtin_amdgcn_perm(dd[1][k], dd[0][k], 0x07030602u);
                        const unsigned q0 = __builtin_amdgcn_perm(dd[3][k], dd[2][k], 0x05010400u), q1 = __builtin_amdgcn_perm(dd[3][k], dd[2][k], 0x07030602u);
                        const unsigned t0 = __builtin_amdgcn_perm(q0, p0, 0x05040100u), t1 = __builtin_amdgcn_perm(q0, p0, 0x07060302u);
                        const unsigned t2 = __builtin_amdgcn_perm(q1, p1, 0x05040100u), t3 = __builtin_amdgcn_perm(q1, p1, 0x07060302u);
                        acc[4 * k + 0] = __builtin_amdgcn_sdot4((int)t0, cqd, acc[4 * k + 0], false);
                        acc[4 * k + 1] = __builtin_amdgcn_sdot4((int)t1, cqd, acc[4 * k + 1], false);
                        acc[4 * k + 2] = __builtin_amdgcn_sdot4((int)t2, cqd, acc[4 * k + 2], false);
                        acc[4 * k + 3] = __builtin_amdgcn_sdot4((int)t3, cqd, acc[4 * k + 3], false);
                    }
                }
            };
            issue(0, va);
#pragma unroll 1
            for (int pb = 0; pb < 128; pb += 16) {
                issue(pb + 8, vbf);
                axpy(pb, va);
                if (pb + 16 < 128) issue(pb + 16, va);
                axpy(pb + 8, vbf);
            }
        }
        const u32x4* hr = (const u32x4*)(p.hb + (size_t)t * D_MODEL + lane * 16);
        const u32x4 ha = hr[0], hc = hr[1];
        const float hf16[16] = {bflo(ha.x), bfhi(ha.x), bflo(ha.y), bfhi(ha.y), bflo(ha.z), bfhi(ha.z), bflo(ha.w), bfhi(ha.w),
                                bflo(hc.x), bfhi(hc.x), bflo(hc.y), bfhi(hc.y), bflo(hc.z), bfhi(hc.z), bflo(hc.w), bfhi(hc.w)};
        float res[16];
        float ss = 0.f;
#pragma unroll
        for (int j = 0; j < 16; ++j) { res[j] = hf16[j] + cscale * (float)(acc[j] - 32 * csum_i); ss += res[j] * res[j]; }
        ss = wave_sum(ss);
        const float r3 = rsqrtf(ss * (1.0f / D_MODEL) + EPS);
        float* o = p.out + (size_t)t * D_MODEL + lane * 16;
        const float* fg = p.final_g + lane * 16;
#pragma unroll
        for (int i = 0; i < 4; ++i) {
            const float4 g = ((const float4*)fg)[i];
            float4 ov; ov.x = res[4 * i] * r3 * g.x; ov.y = res[4 * i + 1] * r3 * g.y; ov.z = res[4 * i + 2] * r3 * g.z; ov.w = res[4 * i + 3] * r3 * g.w;
            ((float4*)o)[i] = ov;
        }
    }
}

namespace pg8 {
#define PG8_LAS __attribute__((address_space(3)))
constexpr int BM = 256, BK = 64, HALF = 128, HTB = HALF * BK * 2, STAGE_BYTES = 8 * HTB, NXCD = 8, WGM = 8;
__host__ __device__ __forceinline__ int lds_byte(int r, int c) { const int st = (r >> 4) * 2 + (c >> 5), rr = r & 15, cc = c & 31, ob = rr * 64 + cc * 2; return st * 1024 + (ob ^ (((ob >> 9) & 1) << 5)); }
__host__ __device__ __forceinline__ void stage_rc(int b, int& R, int& C) { const int st = b / 1024, sb = b % 1024, swz = sb ^ (((sb >> 9) & 1) << 5); R = (st >> 1) * 16 + swz / 64; C = (st & 1) * 32 + (swz % 64) / 2; }
__host__ __device__ __forceinline__ int perm32(int rho) { const int n = rho >> 4, i = rho & 15; return 8 * (i >> 2) + 4 * n + (i & 3); }
struct Unit { int pm, pn; };
struct Gemm { const bf16_t* A; const bf16_t* Bt; int M, N, K; };
struct StaticOrder {
    int nM, nN, nwg, G, c;
    __host__ __device__ void init(int M, int N, int G_, int c_) { nM = M / BM; nN = N / BM; nwg = nM * nN; G = G_; c = c_; }
    __host__ __device__ bool next(int i, Unit& u) const {
        const long L = (long)i * G + c; if (L >= nwg) return false;
        int wgid = (int)L; { const int q = nwg / NXCD, r = nwg % NXCD, xcd = wgid % NXCD, off = wgid / NXCD; wgid = (xcd < r ? xcd * (q + 1) : r * (q + 1) + (xcd - r) * q) + off; }
        const int nig = WGM * nN, gid = wgid / nig, fm = gid * WGM, gsz = (nM - fm) < WGM ? (nM - fm) : WGM;
        u.pm = fm + ((wgid % nig) % gsz); u.pn = (wgid % nig) / gsz; return true;
    }
    __device__ __forceinline__ void a_ready(const Unit&) const {}
    __device__ __forceinline__ void done(const Unit&) const {}
};
__device__ __forceinline__ unsigned cvt_pk_bf16(float lo, float hi) { unsigned r; asm volatile("v_cvt_pk_bf16_f32 %0, %1, %2" : "=v"(r) : "v"(lo), "v"(hi)); return r; }
struct EpiZ {
    static constexpr bool PERM = true, AFTER_DRAIN = false;
    bf16_t* O; const float* rs;
    __device__ __forceinline__ void operator()(const f32x4 (&acc)[2][2][4][2], const Unit& u, int wr, int wc, int fr, int fq) const {
        const int row0 = u.pm * BM + wr * 64 + fr, col0 = u.pn * BM + wc * 32 + 8 * fq; const bool act = u.pn >= 2;
#pragma unroll
        for (int ai = 0; ai < 2; ++ai)
#pragma unroll
            for (int m = 0; m < 4; ++m) { const int r = row0 + ai * HALF + m * 16; const float sc = rs[r]; bf16_t* rowp = O + (size_t)r * D_IN + col0;
#pragma unroll
                for (int bj = 0; bj < 2; ++bj) { f32x4 v0 = acc[ai][bj][m][0] * sc, v1 = acc[ai][bj][m][1] * sc;
                    if (act) { v0 = (f32x4){gelu_t(v0[0]), gelu_t(v0[1]), gelu_t(v0[2]), gelu_t(v0[3])}; v1 = (f32x4){gelu_t(v1[0]), gelu_t(v1[1]), gelu_t(v1[2]), gelu_t(v1[3])}; }
                    u32x4 w; w.x = cvt_pk_bf16(v0[0], v0[1]); w.y = cvt_pk_bf16(v0[2], v0[3]); w.z = cvt_pk_bf16(v1[0], v1[1]); w.w = cvt_pk_bf16(v1[2], v1[3]);
                    *(u32x4*)(rowp + bj * HALF) = w; } }
    }
};
struct EpiOut {
    static constexpr bool PERM = true, AFTER_DRAIN = false;
    bf16_t* O; const bf16_t* X;
    __device__ __forceinline__ void operator()(const f32x4 (&acc)[2][2][4][2], const Unit& u, int wr, int wc, int fr, int fq) const {
        const int row0 = u.pm * BM + wr * 64 + fr, col0 = u.pn * BM + wc * 32 + 8 * fq;
#pragma unroll
        for (int ai = 0; ai < 2; ++ai)
#pragma unroll
            for (int m = 0; m < 4; ++m) { const size_t off = (size_t)(row0 + ai * HALF + m * 16) * D_MODEL + col0;
#pragma unroll
                for (int bj = 0; bj < 2; ++bj) { const u32x4 xx = *(const u32x4*)(X + off + bj * HALF);
                    const f32x4 v0 = acc[ai][bj][m][0] + (f32x4){bflo(xx.x), bfhi(xx.x), bflo(xx.y), bfhi(xx.y)}, v1 = acc[ai][bj][m][1] + (f32x4){bflo(xx.z), bfhi(xx.z), bflo(xx.w), bfhi(xx.w)};
                    u32x4 w; w.x = cvt_pk_bf16(v0[0], v0[1]); w.y = cvt_pk_bf16(v0[2], v0[3]); w.z = cvt_pk_bf16(v1[0], v1[1]); w.w = cvt_pk_bf16(v1[2], v1[3]);
                    *(u32x4*)(O + off + bj * HALF) = w; } }
    }
};
struct OneUnit {
    Unit u;
    __device__ __forceinline__ bool next(int i, Unit& o) const { if (i) return false; o = u; return true; }
    __device__ __forceinline__ void a_ready(const Unit&) const {}
    __device__ __forceinline__ void done(const Unit&) const {}
};
#define QT_PITCH 272
#define QT_LDS_BYTES (2 * 256 * QT_PITCH)
struct EpiQTopk {
    static constexpr bool PERM = true, AFTER_DRAIN = true;
    const bf16_t* keysB; int* idx; float* gate;
    __device__ __forceinline__ void fused(f32x4 (&acc)[2][2][4][2], const Unit& u, int wr, int wc, int fr, int fq, PG8_LAS unsigned char* ldsp, int wid, int lane) const {
        char* sQ = (char*)ldsp;
        const int h = u.pn;
#pragma unroll
        for (int ai = 0; ai < 2; ++ai)
#pragma unroll
            for (int m = 0; m < 4; ++m) { const int r = ai * HALF + wr * 64 + m * 16 + fr;
#pragma unroll
                for (int bj = 0; bj < 2; ++bj) { const f32x4 v0 = acc[ai][bj][m][0], v1 = acc[ai][bj][m][1];
                    u32x4 w; w.x = cvt_pk_bf16(v0[0], v0[1]); w.y = cvt_pk_bf16(v0[2], v0[3]); w.z = cvt_pk_bf16(v1[0], v1[1]); w.w = cvt_pk_bf16(v1[2], v1[3]);
                    *(u32x4*)(sQ + bj * (256 * QT_PITCH) + r * QT_PITCH + (wc * 32 + fq * 8) * 2) = w; } }
        __syncthreads();
        int cbv[4];
#pragma unroll
        for (int c = 0; c < 4; ++c) cbv[c] = kComb[4 * fr + c];
        int tA[2][4], tB[2][4];
#pragma unroll
        for (int m = 0; m < 2; ++m)
#pragma unroll
            for (int j = 0; j < 4; ++j) { tA[m][j] = 0; tB[m][j] = 0; }
#pragma unroll 1
        for (int pp = 0; pp < 2; ++pp) {
            const bf16_t* kb = keysB + (size_t)(pp * 8 + h) * 16384 + (size_t)fr * 128 + fq * 8;
            const char* qa = sQ + pp * (256 * QT_PITCH) + (wid * 32 + fr) * QT_PITCH + fq * 16;
            f32x4 sc2[2][8];
#pragma unroll
            for (int m = 0; m < 2; ++m)
#pragma unroll
                for (int nb = 0; nb < 8; ++nb) sc2[m][nb] = (f32x4){0.f, 0.f, 0.f, 0.f};
#pragma unroll
            for (int kk = 0; kk < 4; ++kk) {
                bf16x8 kf[8], af[2];
#pragma unroll
                for (int nb = 0; nb < 8; ++nb) kf[nb] = *(const bf16x8*)(kb + (size_t)nb * 16 * 128 + kk * 32);
#pragma unroll
                for (int m = 0; m < 2; ++m) af[m] = *(const bf16x8*)(qa + m * 16 * QT_PITCH + kk * 64);
#pragma unroll
                for (int m = 0; m < 2; ++m)
#pragma unroll
                    for (int nb = 0; nb < 8; ++nb) sc2[m][nb] = __builtin_amdgcn_mfma_f32_16x16x32_bf16(af[m], kf[nb], sc2[m][nb], 0, 0, 0);
            }
#pragma unroll
            for (int m = 0; m < 2; ++m)
#pragma unroll
                for (int j = 0; j < 4; ++j) tA[m][j] = tB[m][j];
#pragma unroll 2
            for (int it = 0; it < 4; ++it) {
#pragma unroll
                for (int m = 0; m < 2; ++m) {
                    int k[8];
#pragma unroll
                    for (int nb = 0; nb < 8; ++nb) k[nb] = (f2key(sc2[m][nb][0]) & ~127) | (127 - (16 * nb + fr));
                    const int r = top16_rows(k, fr);
                    tB[m][0] = tB[m][1]; tB[m][1] = tB[m][2]; tB[m][2] = tB[m][3]; tB[m][3] = r;
#pragma unroll
                    for (int nb = 0; nb < 8; ++nb) sc2[m][nb] = (f32x4){sc2[m][nb][1], sc2[m][nb][2], sc2[m][nb][3], sc2[m][nb][0]};
                }
            }
        }
#pragma unroll 2
        for (int it = 0; it < 4; ++it) {
#pragma unroll
            for (int m = 0; m < 2; ++m) {
                int eid; float gt;
                combine16(tA[m][0], tB[m][0], cbv, lane, fr, eid, gt);
                const int t = u.pm * BM + wid * 32 + m * 16 + fq * 4 + it;
                const size_t o = (size_t)t * 128 + h * 16 + fr;
                idx[o] = eid; gate[o] = gt;
                tA[m][0] = tA[m][1]; tA[m][1] = tA[m][2]; tA[m][2] = tA[m][3];
                tB[m][0] = tB[m][1]; tB[m][1] = tB[m][2]; tB[m][2] = tB[m][3];
            }
        }
        __syncthreads();
    }
};
template <class Epi, class Sched>
__device__ __forceinline__ void gemm_phase(PG8_LAS unsigned char* lds, const Gemm g, const Sched& S, const Epi& E) {
    const int tid = threadIdx.x, wid = __builtin_amdgcn_readfirstlane(tid >> 6), lane = tid & 63, wr = wid >> 2, wc = wid & 3, fr = lane & 15, fq = lane >> 4;
    const int K = g.K, nt = K / BK;
    unsigned voffA[2], voffB[2];
#pragma unroll
    for (int i = 0; i < 2; ++i) { int R, C; stage_rc(tid * 16 + i * 8192, R, C); const int Rb = Epi::PERM ? ((R & ~31) + perm32(R & 31)) : R;
        voffA[i] = (unsigned)(R * K + C) * 2u; voffB[i] = (unsigned)(Rb * K + C) * 2u; }
    const size_t kstep = (size_t)(BK * 2);
    const size_t hstep = (size_t)HALF * K * 2;
    const size_t tstep = 2 * hstep;
    const unsigned ldsw = (unsigned)wid * 1024u;
    const int aoff = lds_byte(wr * 64 + fr, fq * 8), boff = lds_byte(wc * 32 + fr, fq * 8);
#define PG8_SA(b, h) (((b) * 2 + (h)) * HTB)
#define PG8_SB(b, h) ((4 + (b) * 2 + (h)) * HTB)
#define PG8_STAGE(bufoff, gbase, voff) do { _Pragma("unroll") for (int _i = 0; _i < 2; ++_i) \
        __builtin_amdgcn_global_load_lds((const unsigned*)((const char*)(gbase) + (voff)[_i]), (PG8_LAS unsigned*)(lds + (bufoff) + ldsw + _i * 8192), 16, 0, 0); } while (0)
#define PG8_LDA(dst, b, h) do { _Pragma("unroll") for (int m = 0; m < 4; ++m) _Pragma("unroll") for (int k = 0; k < 2; ++k) dst[m][k] = *(const PG8_LAS bf16x8*)(lds + PG8_SA(b, h) + aoff + m * 2048 + k * 1024); } while (0)
#define PG8_LDB(dst, b, h) do { _Pragma("unroll") for (int n = 0; n < 2; ++n) _Pragma("unroll") for (int k = 0; k < 2; ++k) dst[n][k] = *(const PG8_LAS bf16x8*)(lds + PG8_SB(b, h) + boff + n * 2048 + k * 1024); } while (0)
#define PG8_MMA(ai, bj, At, Bt) do { __builtin_amdgcn_s_setprio(1); _Pragma("unroll") for (int m = 0; m < 4; ++m) _Pragma("unroll") for (int n = 0; n < 2; ++n) _Pragma("unroll") for (int k = 0; k < 2; ++k) \
        acc[ai][bj][m][n] = __builtin_amdgcn_mfma_f32_16x16x32_bf16(Bt[n][k], At[m][k], acc[ai][bj][m][n], 0, 0, 0); __builtin_amdgcn_s_setprio(0); } while (0)
#define PG8_WAIT_V(n) asm volatile("s_waitcnt vmcnt(" #n ")" ::: "memory")
#define PG8_WAIT_L(n) asm volatile("s_waitcnt lgkmcnt(" #n ")" ::: "memory")
#define PG8_BAR __builtin_amdgcn_s_barrier()
#define PG8_SCHED __builtin_amdgcn_sched_barrier(0)
    Unit cur, nxt; int ui = 0;
    if (!S.next(0, cur)) return;
    f32x4 acc[2][2][4][2];
#pragma unroll
    for (int a = 0; a < 2; ++a)
#pragma unroll
        for (int b = 0; b < 2; ++b)
#pragma unroll
            for (int m = 0; m < 4; ++m)
#pragma unroll
                for (int n = 0; n < 2; ++n) acc[a][b][m][n] = (f32x4){0.f, 0.f, 0.f, 0.f};
    bf16x8 At[4][2], B0[2][2], B1[2][2];
    const char* cA = (const char*)g.A + (size_t)cur.pm * tstep; const char* cB = (const char*)g.Bt + (size_t)cur.pn * tstep;
    S.a_ready(cur);
    PG8_STAGE(PG8_SB(0, 0), cB, voffB); PG8_STAGE(PG8_SA(0, 0), cA, voffA); PG8_STAGE(PG8_SB(0, 1), cB + hstep, voffB); PG8_STAGE(PG8_SA(0, 1), cA + hstep, voffA);
    if (wr == 1) PG8_BAR;
    PG8_WAIT_V(4); PG8_BAR;
    PG8_STAGE(PG8_SB(1, 0), cB + kstep, voffB); PG8_STAGE(PG8_SA(1, 0), cA + kstep, voffA); PG8_STAGE(PG8_SB(1, 1), cB + hstep + kstep, voffB);
    PG8_WAIT_V(6); PG8_BAR;
    for (;;) {
        const bool has_next = S.next(ui + 1, nxt);
        const char* nA = has_next ? (const char*)g.A + (size_t)nxt.pm * tstep : cA; const char* nB = has_next ? (const char*)g.Bt + (size_t)nxt.pn * tstep : cB;
        for (int t = 0; t < nt; t += 2) {
            const bool last = (t == nt - 2);
            const char* a1 = cA + (size_t)(t + 1) * kstep;
            const char* a2 = last ? nA : cA + (size_t)(t + 2) * kstep; const char* b2 = last ? nB : cB + (size_t)(t + 2) * kstep;
            const char* a3 = a2 + kstep; const char* b3 = b2 + kstep;
            if (last && has_next) S.a_ready(nxt);
            PG8_LDB(B0, 0, 0); PG8_SCHED; PG8_LDA(At, 0, 0); PG8_STAGE(PG8_SA(1, 1), a1 + hstep, voffA);
            PG8_WAIT_L(8); PG8_BAR; PG8_WAIT_L(0); PG8_MMA(0, 0, At, B0); PG8_BAR; PG8_SCHED;
            PG8_LDB(B1, 0, 1); PG8_STAGE(PG8_SB(0, 0), b2, voffB);
            PG8_BAR; PG8_WAIT_L(0); PG8_MMA(0, 1, At, B1); PG8_BAR;
            PG8_LDA(At, 0, 1); PG8_STAGE(PG8_SA(0, 0), a2, voffA);
            PG8_BAR; PG8_WAIT_L(0); PG8_MMA(1, 0, At, B0); PG8_BAR; PG8_SCHED;
            PG8_STAGE(PG8_SB(0, 1), b2 + hstep, voffB);
            PG8_WAIT_V(6); PG8_BAR; PG8_MMA(1, 1, At, B1); PG8_BAR;
            PG8_LDB(B0, 1, 0); PG8_SCHED; PG8_LDA(At, 1, 0); PG8_STAGE(PG8_SA(0, 1), a2 + hstep, voffA);
            PG8_WAIT_L(8); PG8_BAR; PG8_WAIT_L(0); PG8_MMA(0, 0, At, B0); PG8_BAR; PG8_SCHED;
            PG8_LDB(B1, 1, 1); PG8_STAGE(PG8_SB(1, 0), b3, voffB);
            PG8_BAR; PG8_WAIT_L(0); PG8_MMA(0, 1, At, B1); PG8_BAR;
            PG8_LDA(At, 1, 1); PG8_STAGE(PG8_SA(1, 0), a3, voffA);
            PG8_BAR; PG8_WAIT_L(0); PG8_MMA(1, 0, At, B0); PG8_BAR; PG8_SCHED;
            PG8_STAGE(PG8_SB(1, 1), b3 + hstep, voffB);
            PG8_WAIT_V(6); PG8_BAR; PG8_MMA(1, 1, At, B1); PG8_BAR;
        }
            if constexpr (!Epi::AFTER_DRAIN) { E(acc, cur, wr, wc, fr, fq); S.done(cur); }
            if (!has_next) break;
#pragma unroll
        for (int a = 0; a < 2; ++a)
#pragma unroll
            for (int b = 0; b < 2; ++b)
#pragma unroll
                for (int m = 0; m < 4; ++m)
#pragma unroll
                    for (int n = 0; n < 2; ++n) acc[a][b][m][n] = (f32x4){0.f, 0.f, 0.f, 0.f};
        cur = nxt; cA = nA; cB = nB; ++ui;
    }
    PG8_WAIT_V(0);
    if (wr == 0) PG8_BAR;
    PG8_BAR;
    if constexpr (Epi::AFTER_DRAIN) { E.fused(acc, cur, wr, wc, fr, fq, lds, wid, lane); S.done(cur); }
#undef PG8_SA
#undef PG8_SB
#undef PG8_STAGE
#undef PG8_LDA
#undef PG8_LDB
#undef PG8_MMA
#undef PG8_WAIT_V
#undef PG8_WAIT_L
#undef PG8_BAR
#undef PG8_SCHED
}
}

__device__ void phase_gemm_z(const Params& p, char* lds) {
    pg8::StaticOrder S; S.init(T_TOK, D_IN, gridDim.x, blockIdx.x);
    pg8::gemm_phase<pg8::EpiZ, pg8::StaticOrder>((PG8_LAS unsigned char*)lds, pg8::Gemm{p.xb, p.winT, T_TOK, D_IN, D_MODEL}, S, pg8::EpiZ{p.zb, p.rstd1});
}
__device__ void phase_gemm_out(const Params& p, char* lds) {
    pg8::StaticOrder S; S.init(T_TOK, D_MODEL, gridDim.x, blockIdx.x);
    pg8::gemm_phase<pg8::EpiOut, pg8::StaticOrder>((PG8_LAS unsigned char*)lds, pg8::Gemm{p.cB, p.woutT, T_TOK, D_MODEL, D_MODEL}, S, pg8::EpiOut{p.hb, p.xb});
}
__device__ void phase_gemm_q(const Params& p, char* lds) {
    pg8::StaticOrder S; S.init(T_TOK, 2048, gridDim.x, blockIdx.x);
    pg8::Unit u;
    for (int i = 0; S.next(i, u); ++i)
        pg8::gemm_phase<pg8::EpiQTopk, pg8::OneUnit>((PG8_LAS unsigned char*)lds, pg8::Gemm{p.hb, p.wqT, T_TOK, 2048, D_MODEL}, pg8::OneUnit{u}, pg8::EpiQTopk{p.keysB, p.idx, p.gate});
}

#define XB_TMO      128
#define XB_XCNT(j)  (256  + 64 * (j))
#define XB_XSUB(j)  (1280 + 64 * (j))
#define XB_XGEN(j)  (2304 + 64 * (j))
#define XB_TOP      3328
#define XB_TOPGEN   3392
#define XCD_BAR_WORDS 3456
#define XB_SPIN_CAP (1u << 20)
__device__ __forceinline__ unsigned xb_ld(unsigned* p)              { return __hip_atomic_load(p, __ATOMIC_RELAXED, __HIP_MEMORY_SCOPE_AGENT); }
__device__ __forceinline__ unsigned xb_add(unsigned* p, unsigned v) { return __hip_atomic_fetch_add(p, v, __ATOMIC_RELAXED, __HIP_MEMORY_SCOPE_AGENT); }
__device__ __forceinline__ unsigned xb_xcc_id() { return (unsigned)__builtin_amdgcn_s_getreg((3 << 11) | 20) & 0xFu; }
#define XB_SPIN(cond, bar) do { unsigned _sp = 0; while (cond) { __builtin_amdgcn_s_sleep(1); \
    if ((++_sp & 255u) == 0u) { if (xb_ld(&(bar)[XB_TMO])) break; if (_sp > XB_SPIN_CAP) { atomicAdd(&(bar)[XB_TMO], 1u); break; } } } } while (0)
struct XcdBarrier { unsigned* bar; unsigned x; volatile LAS unsigned* st; };
__device__ __forceinline__ XcdBarrier xcd_barrier_post(unsigned* bar, volatile LAS unsigned* st) {
    XcdBarrier b; b.bar = bar; b.x = xb_xcc_id(); b.st = st;
    if (threadIdx.x == 0) (void)xb_add(&bar[XB_XCNT(b.x)], 1u);
    return b;
}
__device__ __forceinline__ void xcd_barrier_complete(unsigned* bar, unsigned x, unsigned& nloc, unsigned& nx) {
    const unsigned G = gridDim.x * gridDim.y * gridDim.z;
    unsigned sum, cnt, mine, sp = 0u;
    for (;;) {
        sum = 0u; cnt = 0u; mine = 0u;
#pragma unroll
        for (unsigned j = 0; j < 16; ++j) { const unsigned c = xb_ld(&bar[XB_XCNT(j)]); sum += c; cnt += (c > 0u) ? 1u : 0u; mine = (j == x) ? c : mine; }
        if (sum == G) break;
        __builtin_amdgcn_s_sleep(1);
        if ((++sp & 255u) == 0u) { if (xb_ld(&bar[XB_TMO])) break; if (sp > XB_SPIN_CAP) { atomicAdd(&bar[XB_TMO], 1u); break; } }
    }
    nloc = mine > 0u ? mine : 1u; nx = cnt > 0u ? cnt : 1u;
}
__device__ __forceinline__ void xcd_barrier(const XcdBarrier& b) {
    asm volatile("s_waitcnt vmcnt(0)" ::: "memory");
    __syncthreads();
    if (threadIdx.x == 0) {
        unsigned* bar = b.bar;
        __builtin_amdgcn_s_waitcnt(0);
        unsigned nloc = b.st[0], nx = b.st[1];
        if (nloc == 0u) { xcd_barrier_complete(bar, b.x, nloc, nx); b.st[0] = nloc; b.st[1] = nx; }
        const unsigned old = xb_add(&bar[XB_XSUB(b.x)], 1u);
        const unsigned gen = old / nloc;
        if (old + 1u == (gen + 1u) * nloc) {
            __builtin_amdgcn_fence(__ATOMIC_RELEASE, "agent");
            asm volatile("s_waitcnt vmcnt(0)" ::: "memory");
            const unsigned og = xb_add(&bar[XB_TOP], 1u);
            const unsigned tg = og / nx;
            if (og + 1u == (tg + 1u) * nx) xb_add(&bar[XB_TOPGEN], 1u);
            else XB_SPIN(xb_ld(&bar[XB_TOPGEN]) == tg, bar);
            __builtin_amdgcn_fence(__ATOMIC_ACQUIRE, "agent");
            xb_add(&bar[XB_XGEN(b.x)], 1u);
            asm volatile("s_waitcnt vmcnt(0)" ::: "memory");
        } else {
            XB_SPIN(xb_ld(&bar[XB_XGEN(b.x)]) == gen, bar);
            __builtin_amdgcn_fence(__ATOMIC_ACQUIRE, "agent");
            asm volatile("s_waitcnt vmcnt(0)" ::: "memory");
        }
    }
    __syncthreads();
}

#define MEGA_LDS_MAX2(a, b) ((a) > (b) ? (a) : (b))
#define MEGA_LDS_MAIN MEGA_LDS_MAX2(MEGA_LDS_MAX2(QT_LDS_BYTES, pg8::STAGE_BYTES), MEGA_LDS_MAX2(8 * TS_WBYTES, 2 * MIXH_LDS))
#define MEGA_LDS_BYTES (MEGA_LDS_MAIN + 16)
extern __shared__ __attribute__((aligned(16))) char smem[];
__global__ void __launch_bounds__(512, 2) fwd_mega(Params p) {
    volatile LAS unsigned* st = (volatile LAS unsigned*)(smem + MEGA_LDS_MAIN);
    if (threadIdx.x < 4) st[threadIdx.x] = 0u;
    __syncthreads();
    const XcdBarrier xb = xcd_barrier_post(p.bar, st);
    phase_prep(p, smem);      xcd_barrier(xb);
    phase_gemm_z(p, smem);    xcd_barrier(xb);
    phase_mix_gemm(p, smem);  xcd_barrier(xb);
    phase_gemm_out(p, smem);  xcd_barrier(xb);
    phase_gemm_q(p, smem);    xcd_barrier(xb);
    phase_peer_dots(p, smem); xcd_barrier(xb);
    phase_gather(p, smem);
}

extern "C" void kernel_launch(void* const* d_in, const int* in_sizes, int n_in, void* d_out, int out_size, void* d_ws, size_t ws_size, hipStream_t stream) {
    static int grid_blocks = 0;
    if (grid_blocks == 0) {
        int dev = 0, cus = 0, per_cu = 0;
        (void)hipGetDevice(&dev);
        (void)hipDeviceGetAttribute(&cus, hipDeviceAttributeMultiprocessorCount, dev);
        (void)hipFuncSetAttribute((const void*)fwd_mega, hipFuncAttributeMaxDynamicSharedMemorySize, MEGA_LDS_BYTES);
        (void)hipOccupancyMaxActiveBlocksPerMultiprocessor(&per_cu, (const void*)fwd_mega, 512, MEGA_LDS_BYTES);
        if (per_cu > 1) per_cu = 1;
        if (per_cu < 1) per_cu = 1;
        grid_blocks = cus * per_cu;
    }
    Params p{};
    p.x = (const float*)d_in[0]; p.norm1_g = (const float*)d_in[1]; p.w_in = (const float*)d_in[2]; p.pool_w = (const float*)d_in[3];
    p.pool_scale = (const float*)d_in[4]; p.sgu_norm_g = (const float*)d_in[5]; p.sgu_w = (const float*)d_in[6]; p.sgu_b = (const float*)d_in[7];
    p.w_out = (const float*)d_in[8]; p.norm2_g = (const float*)d_in[9]; p.peer_wq = (const float*)d_in[10]; p.peer_keys = (const float*)d_in[11];
    p.peer_u = (const float*)d_in[12]; p.peer_v = (const float*)d_in[13]; p.final_g = (const float*)d_in[14];
    p.out = (float*)d_out;
    char* w = (char*)d_ws; size_t off = 0;
    auto take = [&](size_t bytes) { char* r = w + off; off += (bytes + 255) & ~(size_t)255; return r; };
    const size_t MiB = 1024 * 1024;
    p.u8 = (unsigned char*)take(16 * MiB); p.v8 = (unsigned char*)take(12 * MiB);
    p.su = (float*)take(64 * 1024); p.sv = (float*)take(64 * 1024);
    p.winT = (bf16_t*)take(3 * MiB); p.woutT = (bf16_t*)take(2 * MiB); p.wqT = (bf16_t*)take(4 * MiB);
    p.poolT = (bf16_t*)take(128 * 1024); p.wsM = (bf16_t*)take(128 * 1024); p.keysB = (bf16_t*)take(512 * 1024);
    p.bar = (unsigned*)take(XCD_BAR_WORDS * 4);
    p.rstd1 = (float*)take(128 * 1024);
    p.idx = (int*)take(16 * MiB); p.gate = (float*)take(16 * MiB); p.coef = (float*)take(16 * MiB);
    p.xb = (bf16_t*)take(64 * MiB); p.zb = (bf16_t*)take(96 * MiB); p.cB = (bf16_t*)take(64 * MiB); p.hb = (bf16_t*)take(64 * MiB);
    (void)hipMemsetAsync(p.bar, 0, XCD_BAR_WORDS * 4, stream);
    hipLaunchKernelGGL(fwd_mega, dim3(grid_blocks), dim3(512), MEGA_LDS_BYTES, stream, p);
}
```

```cpp
#include <hip/hip_runtime.h>
#include <stdint.h>
#include <type_traits>

typedef unsigned short bf16_t;
typedef short bf16x8 __attribute__((ext_vector_type(8)));
typedef float f32x4 __attribute__((ext_vector_type(4)));
typedef unsigned u32x4 __attribute__((ext_vector_type(4)));
typedef unsigned u32x2 __attribute__((ext_vector_type(2)));
typedef unsigned u32x3 __attribute__((ext_vector_type(3)));
#define ROWB 768
typedef __bf16 bf2_t __attribute__((ext_vector_type(2)));
#define LAS __attribute__((address_space(3)))

#define T_TOK 32768
#define D_MODEL 1024
#define D_IN 1536
#define SEQ 2048
#define NEXP 16384
#define EPS 1e-6f

struct Params {
    const float *x, *norm1_g, *w_in, *pool_w, *pool_scale, *sgu_norm_g, *sgu_w, *sgu_b, *w_out, *norm2_g, *peer_wq, *peer_keys, *peer_u, *peer_v, *final_g;
    float* out;
    bf16_t *winT, *woutT, *wqT, *poolT, *wsM, *keysB;
    unsigned char *u8, *v8;
    float *su, *sv;
    float *rstd1;
    bf16_t *xb, *zb, *cB, *hb;
    int* idx; float* gate; float* coef;
    unsigned* bar;
};

__device__ __forceinline__ int tid_opaque() { int t = (int)threadIdx.x; asm volatile("" : "+v"(t)); return t; }
__device__ __forceinline__ unsigned short f2bf(float f) {
    unsigned u = __float_as_uint(f);
    u += 0x7fffu + ((u >> 16) & 1u);
    return (unsigned short)(u >> 16);
}
__device__ __forceinline__ float bf2f(unsigned short h) { return __uint_as_float(((unsigned)h) << 16); }
__device__ __forceinline__ unsigned pack2(float a, float b) { return (unsigned)f2bf(a) | ((unsigned)f2bf(b) << 16); }
__device__ __forceinline__ float bflo(unsigned w) { return __uint_as_float(w << 16); }
__device__ __forceinline__ float bfhi(unsigned w) { return __uint_as_float(w & 0xffff0000u); }
__device__ __forceinline__ float gelu_t(float x) {
    const float y = 1.5957691216057308f * (x + 0.044715f * x * x * x);
    return x * __builtin_amdgcn_rcpf(1.0f + __expf(-y));
}
__device__ __forceinline__ float wave_sum(float v) {
#pragma unroll
    for (int o = 32; o >= 1; o >>= 1) v += __shfl_xor(v, o);
    return v;
}
__device__ __forceinline__ float wave_max(float v) {
#pragma unroll
    for (int o = 32; o >= 1; o >>= 1) v = fmaxf(v, __shfl_xor(v, o));
    return v;
}

#define GEMM_LDS_BYTES (2 * 128 * 144)
__device__ __forceinline__ void transpose_tile(const int tid, const float* __restrict__ src, bf16_t* __restrict__ dst, int R, int C, const float* __restrict__ rscale, int tile, float* lds) {
    const int tilesC = C / 64, tr = tile / tilesC, tc = tile % tilesC;
    const int ty = tid >> 6, tx = tid & 63;
    __syncthreads();
#pragma unroll
    for (int i = 0; i < 16; ++i) {
        const int r = ty + 4 * i;
        float v = src[(size_t)(tr * 64 + r) * C + tc * 64 + tx];
        if (rscale) v *= rscale[tr * 64 + r];
        lds[r * 65 + tx] = v;
    }
    __syncthreads();
#pragma unroll
    for (int i = 0; i < 16; ++i) {
        const int c = ty + 4 * i;
        dst[(size_t)(tc * 64 + c) * R + tr * 64 + tx] = f2bf(lds[tx * 65 + c]);
    }
}

__device__ void phase_prep(const Params& p, char* lds) {
    const int tidx_ = tid_opaque();
    const int nb = gridDim.x, b = blockIdx.x, tid = tidx_;
    const int half = tid >> 8, ht = tid & 255, nh = 2 * nb, hb2 = 2 * b + half;
    float* fl = (float*)(lds + half * (64 * 65 * 4));
    for (int t = hb2; t < 16 * 24; t += nh) transpose_tile(ht, p.w_in, p.winT, 1024, 1536, p.norm1_g, t, fl);
    for (int t = hb2; t < 16 * 16; t += nh) transpose_tile(ht, p.w_out, p.woutT, 1024, 1024, nullptr, t, fl);
    for (int t = hb2; t < 16 * 32; t += nh) transpose_tile(ht, p.peer_wq, p.wqT, 1024, 2048, p.norm2_g, t, fl);
    for (int t = hb2; t < 16; t += nh) transpose_tile(ht, p.pool_w + (size_t)(t >> 2) * 16384, p.poolT + (size_t)(t >> 2) * 16384, 128, 128, nullptr, t & 3, fl);
    const size_t gtid = (size_t)b * blockDim.x + tid, gsz = (size_t)nb * blockDim.x;
    for (size_t i = gtid; i < 4 * 128 * 128; i += gsz) {
        const int j = (int)(i & 127), ii = (int)((i >> 7) & 127);
        const bool keep = (j >> 6) <= (ii >> 6);
        p.wsM[i] = keep ? f2bf(p.sgu_w[i]) : (bf16_t)0;
    }
    for (size_t i = gtid; i < 2 * 8 * 128 * 128; i += gsz) p.keysB[i] = f2bf(p.peer_keys[i]);
    {
        const int wave = (b * blockDim.x + tid) >> 6, nwaves = (nb * blockDim.x) >> 6, lane = tid & 63;
        float g16[16];
#pragma unroll
        for (int i = 0; i < 4; ++i) { const float4 g = ((const float4*)(p.norm2_g + lane * 16))[i]; g16[4 * i] = g.x; g16[4 * i + 1] = g.y; g16[4 * i + 2] = g.z; g16[4 * i + 3] = g.w; }
        auto quant_row = [&](const float (&f)[16], unsigned char* dst, float* scale_out) {
            float am = 0.f;
#pragma unroll
            for (int j = 0; j < 16; ++j) am = fmaxf(am, fabsf(f[j]));
            am = wave_max(am);
            const float inv = am > 0.f ? 31.0f / am : 0.f;
            int q[16];
#pragma unroll
            for (int j = 0; j < 16; ++j) q[j] = (int)rintf(f[j] * inv) + 32;
            u32x3 o;
#pragma unroll
            for (int i = 0; i < 3; ++i) {
                unsigned w = 0;
#pragma unroll
                for (int k = 0; k < 4; ++k) w |= (unsigned)(q[4 * i + k] | (((q[12 + k] >> (2 * i)) & 3) << 6)) << (8 * k);
                o[i] = w;
            }
            *(u32x3*)(dst + lane * 12) = o;
            if (lane == 0) *scale_out = am * (1.0f / 31.0f);
        };
        for (int e = wave; e < NEXP; e += nwaves) {
            const float4* su4 = (const float4*)(p.peer_u + (size_t)e * D_MODEL + lane * 16);
            const float4* sv4 = (const float4*)(p.peer_v + (size_t)e * D_MODEL + lane * 16);
            float4 a4[4], b4[4];
#pragma unroll
            for (int i = 0; i < 4; ++i) { a4[i] = su4[i]; b4[i] = sv4[i]; }
            float fu[16], fv[16];
#pragma unroll
            for (int i = 0; i < 4; ++i) {
                fu[4 * i] = a4[i].x * g16[4 * i]; fu[4 * i + 1] = a4[i].y * g16[4 * i + 1]; fu[4 * i + 2] = a4[i].z * g16[4 * i + 2]; fu[4 * i + 3] = a4[i].w * g16[4 * i + 3];
                fv[4 * i] = b4[i].x; fv[4 * i + 1] = b4[i].y; fv[4 * i + 2] = b4[i].z; fv[4 * i + 3] = b4[i].w;
            }
            {
                float am = 0.f;
#pragma unroll
                for (int j = 0; j < 16; ++j) am = fmaxf(am, fabsf(fu[j]));
                am = wave_max(am);
                const float inv = am > 0.f ? 127.0f / am : 0.f;
                u32x4 o;
#pragma unroll
                for (int i = 0; i < 4; ++i) {
                    unsigned w = 0;
#pragma unroll
                    for (int k = 0; k < 4; ++k) w |= (unsigned)(((int)rintf(fu[4 * i + k] * inv)) & 0xff) << (8 * k);
                    o[i] = w;
                }
                *(u32x4*)(p.u8 + (size_t)e * D_MODEL + lane * 16) = o;
                if (lane == 0) p.su[e] = am * (1.0f / 127.0f);
            }
            quant_row(fv, p.v8 + (size_t)e * ROWB, p.sv + e);
        }
    }
    const int wave = (b * blockDim.x + tid) >> 6, nwaves = (nb * blockDim.x) >> 6, lane = tid & 63;
    for (int t = wave; t < T_TOK; t += 2 * nwaves) {
        const int t1 = t + nwaves; const bool two = t1 < T_TOK;
        const float4* xr0 = (const float4*)(p.x + (size_t)t * D_MODEL);
        const float4* xr1 = (const float4*)(p.x + (size_t)(two ? t1 : t) * D_MODEL);
        float4 v0[4], v1[4];
#pragma unroll
        for (int i = 0; i < 4; ++i) { v0[i] = xr0[lane + 64 * i]; v1[i] = xr1[lane + 64 * i]; }
        float s0 = 0.f, s1 = 0.f;
#pragma unroll
        for (int i = 0; i < 4; ++i) {
            s0 += v0[i].x * v0[i].x + v0[i].y * v0[i].y + v0[i].z * v0[i].z + v0[i].w * v0[i].w;
            s1 += v1[i].x * v1[i].x + v1[i].y * v1[i].y + v1[i].z * v1[i].z + v1[i].w * v1[i].w;
            uint2 o; o.x = pack2(v0[i].x, v0[i].y); o.y = pack2(v0[i].z, v0[i].w);
            ((uint2*)(p.xb + (size_t)t * D_MODEL))[lane + 64 * i] = o;
            if (two) { uint2 o1; o1.x = pack2(v1[i].x, v1[i].y); o1.y = pack2(v1[i].z, v1[i].w); ((uint2*)(p.xb + (size_t)t1 * D_MODEL))[lane + 64 * i] = o1; }
        }
        s0 = wave_sum(s0); s1 = wave_sum(s1);
        if (lane == 0) { p.rstd1[t] = rsqrtf(s0 * (1.0f / D_MODEL) + EPS); if (two) p.rstd1[t1] = rsqrtf(s1 * (1.0f / D_MODEL) + EPS); }
    }
}

typedef short s16x4 __attribute__((ext_vector_type(4)));
template <class Epi>
__device__ __forceinline__ void gemm128_sgu(const int tid, const bf16_t* __restrict__ A, const bf16_t* __restrict__ V  ,
                                            const float* __restrict__ lnm, const float* __restrict__ lnr, const float* __restrict__ gch, char* lds, const Epi& epi) {
    const int lane = tid & 63, wid = tid >> 6, wr = wid >> 1, wc = wid & 1, fr = lane & 15, fq = lane >> 4;
    constexpr int PITCH = 144, P2 = 288;
    char* sA = lds; char* sB = lds + 128 * PITCH;
    f32x4 acc[4][4];
#pragma unroll
    for (int m = 0; m < 4; ++m)
#pragma unroll
        for (int n = 0; n < 4; ++n) acc[m][n] = (f32x4){0.f, 0.f, 0.f, 0.f};
    u32x4 ra[4], rb[4]; float rm[4], rr[4];
    const int lrow = tid >> 3, lch = tid & 7;
    const int btok = tid >> 4, bch = tid & 15;
    const bf16_t* ga = A + (size_t)lrow * 128 + lch * 8;
    const bf16_t* gb = V + (size_t)btok * D_IN + bch * 8;
    float g8[8];
    { const float4 g0 = *(const float4*)(gch + bch * 8), g1 = *(const float4*)(gch + bch * 8 + 4); g8[0] = g0.x; g8[1] = g0.y; g8[2] = g0.z; g8[3] = g0.w; g8[4] = g1.x; g8[5] = g1.y; g8[6] = g1.z; g8[7] = g1.w; }
#pragma unroll
    for (int j = 0; j < 4; ++j) { ra[j] = *(const u32x4*)(ga + (size_t)(32 * j) * 128); rb[j] = *(const u32x4*)(gb + (size_t)(16 * j) * D_IN); rm[j] = lnm[btok + 16 * j]; rr[j] = lnr[btok + 16 * j]; }
    for (int k0 = 0; k0 < 128; k0 += 64) {
        __syncthreads();
#pragma unroll
        for (int j = 0; j < 4; ++j) {
            *(u32x4*)(sA + (lrow + 32 * j) * PITCH + lch * 16) = ra[j];
            u32x4 o;
#pragma unroll
            for (int i = 0; i < 4; ++i) {
                const unsigned w = rb[j][i];
                o[i] = pack2((bflo(w) - rm[j]) * rr[j] * g8[2 * i], (bfhi(w) - rm[j]) * rr[j] * g8[2 * i + 1]);
            }
            *(u32x4*)(sB + (btok + 16 * j) * P2 + bch * 16) = o;
        }
        __syncthreads();
        if (k0 + 64 < 128) {
#pragma unroll
            for (int j = 0; j < 4; ++j) { ra[j] = *(const u32x4*)(ga + (size_t)(32 * j) * 128 + 64); rb[j] = *(const u32x4*)(gb + (size_t)(64 + 16 * j) * D_IN); rm[j] = lnm[64 + btok + 16 * j]; rr[j] = lnr[64 + btok + 16 * j]; }
        }
#pragma unroll
        for (int kk = 0; kk < 2; ++kk) {
            bf16x8 af[4], bfr[4];
#pragma unroll
            for (int m = 0; m < 4; ++m) af[m] = *(const bf16x8*)(sA + (wr * 64 + m * 16 + fr) * PITCH + (kk * 32 + fq * 8) * 2);
#pragma unroll
            for (int n = 0; n < 4; ++n) {
                const char* bp = sB + (kk * 32 + fq * 8 + (fr >> 2)) * P2 + (wc * 64 + n * 16 + 4 * (fr & 3)) * 2;
                const s16x4 lo = __builtin_amdgcn_ds_read_tr16_b64_v4i16((LAS s16x4*)(bp));
                const s16x4 hi = __builtin_amdgcn_ds_read_tr16_b64_v4i16((LAS s16x4*)(bp + 4 * P2));
                bfr[n] = (bf16x8){lo[0], lo[1], lo[2], lo[3], hi[0], hi[1], hi[2], hi[3]};
            }
#pragma unroll
            for (int m = 0; m < 4; ++m)
#pragma unroll
                for (int n = 0; n < 4; ++n) acc[m][n] = __builtin_amdgcn_mfma_f32_16x16x32_bf16(bfr[n], af[m], acc[m][n], 0, 0, 0);
        }
    }
#pragma unroll
    for (int m = 0; m < 4; ++m)
#pragma unroll
        for (int n = 0; n < 4; ++n) epi(wr * 64 + m * 16 + fr, wc * 64 + n * 16 + fq * 4, acc[m][n]);
}

#define PT_PITCH 272
#define MIXH_LDS (2 * 128 * PT_PITCH + 1024)
template <int W, class Epi>
__device__ __forceinline__ void pool_tile(const int tid, const bf16_t* __restrict__ zb0  , int pos0,
                                          const bf16_t* __restrict__ Bt, char* lds, const Epi& epi) {
    const int lane = tid & 63, wid = tid >> 6, wr = wid >> 1, wc = wid & 1, fr = lane & 15, fq = lane >> 4;
    char* sA = lds; char* sB = lds + 128 * PT_PITCH;
    __syncthreads();
#pragma unroll
    for (int j = 0; j < 8; ++j) { const int id = tid + 256 * j, row = id >> 4, ch = id & 15; *(u32x4*)(sB + row * PT_PITCH + ch * 16) = *(const u32x4*)(Bt + (size_t)row * 128 + ch * 8); }
    {
        const int seg = tid >> 5, hc = tid & 31, r0 = seg * 16;
        const bool at_start = (pos0 & (SEQ - 1)) == 0;
        const bf16_t* zp = zb0 + hc * 4;
        u32x2 v[W + 16];
#pragma unroll
        for (int i = 0; i < W + 16; ++i) { const int rr = r0 - W + i; const bool ok = !(at_start && rr < 0); v[i] = *(const u32x2*)(zp + (ptrdiff_t)(ok ? rr : 0) * D_IN); }
        float sm[4] = {0.f, 0.f, 0.f, 0.f};
#pragma unroll
        for (int i = 1; i <= W; ++i) {
            const float m = (at_start && (r0 - W + i) < 0) ? 0.f : 1.f;
            sm[0] += m * bflo(v[i].x); sm[1] += m * bfhi(v[i].x); sm[2] += m * bflo(v[i].y); sm[3] += m * bfhi(v[i].y);
        }
#pragma unroll
        for (int o = 0; o < 16; ++o) {
            if (o > 0) {
                const float md = (at_start && (r0 + o - W) < 0) ? 0.f : 1.f;
                sm[0] += bflo(v[W + o].x) - md * bflo(v[o].x); sm[1] += bfhi(v[W + o].x) - md * bfhi(v[o].x);
                sm[2] += bflo(v[W + o].y) - md * bflo(v[o].y); sm[3] += bfhi(v[W + o].y) - md * bfhi(v[o].y);
            }
            const int pos = (pos0 + r0 + o) & (SEQ - 1);
            const float rn = 1.0f / (float)((pos + 1 < W) ? pos + 1 : W);
            u32x2 ov;
            ov.x = pack2(sm[0] * rn - bflo(v[W + o].x), sm[1] * rn - bfhi(v[W + o].x));
            ov.y = pack2(sm[2] * rn - bflo(v[W + o].y), sm[3] * rn - bfhi(v[W + o].y));
            *(u32x2*)(sA + (r0 + o) * PT_PITCH + hc * 8) = ov;
        }
    }
    __syncthreads();
    f32x4 acc[4][4];
#pragma unroll
    for (int m = 0; m < 4; ++m)
#pragma unroll
        for (int n = 0; n < 4; ++n) acc[m][n] = (f32x4){0.f, 0.f, 0.f, 0.f};
#pragma unroll
    for (int kk = 0; kk < 4; ++kk) {
        bf16x8 af[4], bfr[4];
#pragma unroll
        for (int m = 0; m < 4; ++m) af[m] = *(const bf16x8*)(sA + (wr * 64 + m * 16 + fr) * PT_PITCH + (kk * 32 + fq * 8) * 2);
#pragma unroll
        for (int n = 0; n < 4; ++n) bfr[n] = *(const bf16x8*)(sB + (wc * 64 + n * 16 + fr) * PT_PITCH + (kk * 32 + fq * 8) * 2);
#pragma unroll
        for (int m = 0; m < 4; ++m)
#pragma unroll
            for (int n = 0; n < 4; ++n) acc[m][n] = __builtin_amdgcn_mfma_f32_16x16x32_bf16(bfr[n], af[m], acc[m][n], 0, 0, 0);
    }
#pragma unroll
    for (int m = 0; m < 4; ++m)
#pragma unroll
        for (int n = 0; n < 4; ++n) epi(wr * 64 + m * 16 + fr, wc * 64 + n * 16 + fq * 4, acc[m][n]);
}

__device__ void phase_mix_gemm(const Params& p, char* lds) {
    const int tidx_ = tid_opaque();
    const int npool = (T_TOK / 128) * 4, nsgu = (T_TOK / 128) * 4;
    const int half = tidx_ >> 8, ht = tidx_ & 255; lds += half * MIXH_LDS;
    for (int tile = 2 * blockIdx.x + half; tile < npool + nsgu; tile += 2 * gridDim.x) {
        if (tile < npool) {
            const int tm = tile >> 2, g = tile & 3;
            const float* ps = p.pool_scale + g * 128; bf16_t* co = p.cB + (size_t)tm * 128 * D_MODEL + g * 128;
            const bf16_t* z0 = p.zb + (size_t)tm * 128 * D_IN + g * 128; const bf16_t* bt = p.poolT + (size_t)g * 16384;
            auto epi = [&](int r, int c, f32x4 v) {
                const float4 sc = *(const float4*)(ps + c);
                uint2 o; o.x = pack2(v[0] * sc.x, v[1] * sc.y); o.y = pack2(v[2] * sc.z, v[3] * sc.w);
                *(uint2*)(co + (size_t)r * D_MODEL + c) = o;
            };
            if (g == 0) pool_tile<2>(ht, z0, tm * 128, bt, lds, epi); else if (g == 1) pool_tile<4>(ht, z0, tm * 128, bt, lds, epi);
            else if (g == 2) pool_tile<8>(ht, z0, tm * 128, bt, lds, epi); else pool_tile<16>(ht, z0, tm * 128, bt, lds, epi);
        } else {
            const int t2 = tile - npool, blk = t2 >> 2, h = t2 & 3;
            float* stm = (float*)(lds + GEMM_LDS_BYTES); float* str = stm + 128;
            __syncthreads();
            {
                const int tok = ht >> 1, hh = ht & 1;
                const u32x4* vp = (const u32x4*)(p.zb + (size_t)(blk * 128 + tok) * D_IN + 1024 + hh * 256);
                float s1 = 0.f, s2 = 0.f;
#pragma unroll 8
                for (int i = 0; i < 32; ++i) {
                    const u32x4 v = vp[i];
#pragma unroll
                    for (int k = 0; k < 4; ++k) { const float a = bflo(v[k]), c = bfhi(v[k]); s1 += a + c; s2 += a * a + c * c; }
                }
                s1 += __shfl_xor(s1, 1); s2 += __shfl_xor(s2, 1);
                const float mean = s1 * (1.0f / 512.0f), var = fmaxf(s2 * (1.0f / 512.0f) - mean * mean, 0.f);
                if (hh == 0) { stm[tok] = mean; str[tok] = rsqrtf(var + EPS); }
            }
            __syncthreads();
            const float* sb = p.sgu_b + h * 128; const bf16_t* uo = p.zb + (size_t)blk * 128 * D_IN + 512 + h * 128;
            bf16_t* co = p.cB + (size_t)blk * 128 * D_MODEL + 512 + h * 128;
            gemm128_sgu(ht, p.wsM + (size_t)h * 16384, p.zb + (size_t)blk * 128 * D_IN + 1024 + h * 128, stm, str, p.sgu_norm_g + h * 128, lds,
                    [&](int r, int c, f32x4 v) {
                        const float bb = sb[r];
                        const uint2 uu = *(const uint2*)(uo + (size_t)r * D_IN + c);
                        uint2 o;
                        o.x = pack2((v[0] + bb) * bflo(uu.x), (v[1] + bb) * bfhi(uu.x));
                        o.y = pack2((v[2] + bb) * bflo(uu.y), (v[3] + bb) * bfhi(uu.y));
                        *(uint2*)(co + (size_t)r * D_MODEL + c) = o;
                    });
        }
    }
}

__device__ __forceinline__ int wave_sum_i_uniform(int s) {
    s += __builtin_amdgcn_update_dpp(0, s, 0xB1, 0xf, 0xf, false);
    s += __builtin_amdgcn_update_dpp(0, s, 0x4E, 0xf, 0xf, false);
    s += __builtin_amdgcn_update_dpp(0, s, 0x141, 0xf, 0xf, false);
    s += __builtin_amdgcn_update_dpp(0, s, 0x140, 0xf, 0xf, false);
    return __builtin_amdgcn_readlane(s, 0) + __builtin_amdgcn_readlane(s, 16) + __builtin_amdgcn_readlane(s, 32) + __builtin_amdgcn_readlane(s, 48);
}
__constant__ unsigned char kComb[64] = {
    0x00,0x01,0x02,0x03,0x04,0x05,0x06,0x07,0x08,0x09,0x0a,0x0b,0x0c,0x0d,0x0e,0x0f,
    0x10,0x11,0x12,0x13,0x14,0x15,0x16,0x17,
    0x20,0x21,0x22,0x23,0x24,
    0x30,0x31,0x32,0x33,
    0x40,0x41,0x42,
    0x50,0x51,
    0x60,0x61,
    0x70,0x71,
    0x80,0x90,0xa0,0xb0,0xc0,0xd0,0xe0,0xf0,
    0xff,0xff,0xff,0xff,0xff,0xff,0xff,0xff,0xff,0xff,0xff,0xff,0xff,0xff};

template <int CTRL> __device__ __forceinline__ int dpp_i(int v) { return __builtin_amdgcn_update_dpp(0, v, CTRL, 0xf, 0xf, false); }
__device__ __forceinline__ int row_allmax_i(int v) {
    v = max(v, dpp_i<0x128>(v)); v = max(v, dpp_i<0x124>(v)); v = max(v, dpp_i<0x122>(v)); v = max(v, dpp_i<0x121>(v));
    return v;
}
__device__ __forceinline__ float row_allsum_f(float v) {
    v += __int_as_float(dpp_i<0x128>(__float_as_int(v))); v += __int_as_float(dpp_i<0x124>(__float_as_int(v)));
    v += __int_as_float(dpp_i<0x122>(__float_as_int(v))); v += __int_as_float(dpp_i<0x121>(__float_as_int(v)));
    return v;
}
__device__ __forceinline__ int f2key(float f) { const int b = __float_as_int(f); return b ^ ((b >> 31) & 0x7fffffff); }
__device__ __forceinline__ float key2f(int k) { return __int_as_float(k ^ ((k >> 31) & 0x7fffffff)); }
#define KEY_MIN ((int)0x80000000)
#define CE(a, b) { const int hi_ = max(a, b), lo_ = min(a, b); a = hi_; b = lo_; }
__device__ __forceinline__ int top16_rows(int (&k)[8], int l15) {
    CE(k[0], k[1]) CE(k[2], k[3]) CE(k[4], k[5]) CE(k[6], k[7])
    CE(k[0], k[2]) CE(k[1], k[3]) CE(k[4], k[6]) CE(k[5], k[7])
    CE(k[1], k[2]) CE(k[5], k[6])
    CE(k[0], k[4]) CE(k[1], k[5]) CE(k[2], k[6]) CE(k[3], k[7])
    CE(k[2], k[4]) CE(k[3], k[5])
    CE(k[1], k[2]) CE(k[3], k[4]) CE(k[5], k[6])
    int res = KEY_MIN;
#pragma unroll
    for (int r = 0; r < 16; ++r) {
        const int m = row_allmax_i(k[0]);
        const bool own = (k[0] == m);
#pragma unroll
        for (int j = 0; j < 7; ++j) k[j] = own ? k[j + 1] : k[j];
        k[7] = own ? KEY_MIN : k[7];
        res = (l15 == r) ? m : res;
    }
    return res;
}
__device__ __forceinline__ void combine16(int A, int B, const int (&cbv)[4], int lane, int l15, int& eid_out, float& gate_out) {
    const int rowbase = lane & 48;
    int ck[4], eid[4];
#pragma unroll
    for (int c = 0; c < 4; ++c) {
        const int ci = (cbv[c] >> 4) & 15, cj = cbv[c] & 15;
        const int ka = __builtin_amdgcn_ds_bpermute((rowbase + ci) << 2, A);
        const int kb = __builtin_amdgcn_ds_bpermute((rowbase + cj) << 2, B);
        const float sm = key2f(ka & ~127) + key2f(kb & ~127);
        eid[c] = ((127 - (ka & 127)) << 7) | (127 - (kb & 127));
        ck[c] = (cbv[c] != 0xff) ? ((f2key(sm) & ~63) | (63 - (4 * l15 + c))) : KEY_MIN;
    }
    CE(ck[0], ck[1]) CE(ck[2], ck[3]) CE(ck[0], ck[2]) CE(ck[1], ck[3]) CE(ck[1], ck[2])
    int res = KEY_MIN;
#pragma unroll
    for (int r = 0; r < 16; ++r) {
        const int m = row_allmax_i(ck[0]);
        const bool own = (ck[0] == m);
        ck[0] = own ? ck[1] : ck[0]; ck[1] = own ? ck[2] : ck[1]; ck[2] = own ? ck[3] : ck[2]; ck[3] = own ? KEY_MIN : ck[3];
        res = (l15 == r) ? m : res;
    }
    const int slot = 63 - (res & 63);
    const int src = (rowbase + (slot >> 2)) << 2;
    const int e0 = __builtin_amdgcn_ds_bpermute(src, eid[0]), e1 = __builtin_amdgcn_ds_bpermute(src, eid[1]);
    const int e2 = __builtin_amdgcn_ds_bpermute(src, eid[2]), e3 = __builtin_amdgcn_ds_bpermute(src, eid[3]);
    const int sel = slot & 3;
    eid_out = sel == 0 ? e0 : (sel == 1 ? e1 : (sel == 2 ? e2 : e3));
    gate_out = key2f(res & ~63);
}

__device__ __forceinline__ int reduce16_rows(const int (&part)[16], bool b3, bool b2, bool b1, bool b0b) {
    int r8[8], r4[4], r2[2];
#pragma unroll
    for (int k = 0; k < 8; ++k) { const int keep = b3 ? part[8 + k] : part[k], send = b3 ? part[k] : part[8 + k]; r8[k] = keep + __builtin_amdgcn_update_dpp(0, send, 0x140, 0xf, 0xf, false); }
#pragma unroll
    for (int k = 0; k < 4; ++k) { const int keep = b2 ? r8[4 + k] : r8[k], send = b2 ? r8[k] : r8[4 + k]; r4[k] = keep + __builtin_amdgcn_update_dpp(0, send, 0x141, 0xf, 0xf, false); }
#pragma unroll
    for (int k = 0; k < 2; ++k) { const int keep = b1 ? r4[2 + k] : r4[k], send = b1 ? r4[k] : r4[2 + k]; r2[k] = keep + __builtin_amdgcn_update_dpp(0, send, 0x4E, 0xf, 0xf, false); }
    const int keep = b0b ? r2[1] : r2[0], send = b0b ? r2[0] : r2[1];
    int r1 = keep + __builtin_amdgcn_update_dpp(0, send, 0xB1, 0xf, 0xf, false);
    r1 += __shfl_xor(r1, 16); r1 += __shfl_xor(r1, 32);
    return r1;
}
#define TS_WBYTES (16384 + 128)
__device__ void phase_peer_dots(const Params& p, char* lds) {
    const int tidx_ = tid_opaque();
    const int lane = tidx_ & 63, wid = __builtin_amdgcn_readfirstlane((int)(tidx_ >> 6)), l15 = lane & 15;
    const bool b3 = (lane & 8) != 0, b2 = (lane & 4) != 0, b1 = (lane & 2) != 0, b0b = (lane & 1) != 0;
    const int gw = blockIdx.x * (blockDim.x >> 6) + wid, ngw = gridDim.x * (blockDim.x >> 6);
    char* wl = lds + wid * TS_WBYTES;
    unsigned* list = (unsigned*)wl; int* dotsl = (int*)(wl + 4096); char* hql = wl + 8192; int* tks = (int*)(wl + 16384);
    const unsigned lane16 = (unsigned)lane * 16u;
    for (int tb = gw * 8; tb < T_TOK; tb += ngw * 8) {
#pragma unroll 1
        for (int j0 = 0; j0 < 8; j0 += 4) {
            u32x4 hraw[4][2];
#pragma unroll
            for (int jj = 0; jj < 4; ++jj) { const u32x4* hr = (const u32x4*)(p.hb + (size_t)(tb + j0 + jj) * D_MODEL); hraw[jj][0] = hr[2 * lane]; hraw[jj][1] = hr[2 * lane + 1]; }
#pragma unroll
            for (int jj = 0; jj < 4; ++jj) {
                const int j = j0 + jj;
                const u32x4 a = hraw[jj][0], c = hraw[jj][1];
                const float f[16] = {bflo(a.x), bfhi(a.x), bflo(a.y), bfhi(a.y), bflo(a.z), bfhi(a.z), bflo(a.w), bfhi(a.w),
                                     bflo(c.x), bfhi(c.x), bflo(c.y), bfhi(c.y), bflo(c.z), bfhi(c.z), bflo(c.w), bfhi(c.w)};
                float ss = 0.f, am = 0.f;
#pragma unroll
                for (int k = 0; k < 16; ++k) { ss += f[k] * f[k]; am = fmaxf(am, fabsf(f[k])); }
                ss = wave_sum(ss); am = wave_max(am);
                const float inv = am > 0.f ? 127.0f / am : 0.f;
                u32x4 o; int hsum = 0;
#pragma unroll
                for (int i = 0; i < 4; ++i) {
                    unsigned w = 0;
#pragma unroll
                    for (int k = 0; k < 4; ++k) { const int qv = (int)rintf(f[4 * i + k] * inv); hsum += qv; w |= (unsigned)(qv & 0xff) << (8 * k); }
                    o[i] = w;
                }
                *(u32x4*)(hql + j * 1024 + lane * 16) = o;
                hsum = wave_sum_i_uniform(hsum);
                const float r2 = rsqrtf(ss * (1.0f / D_MODEL) + EPS);
                if (lane == 0) { tks[4 * j] = hsum; tks[4 * j + 1] = __float_as_int(am * (1.0f / 127.0f) * r2); tks[4 * j + 2] = __float_as_int(r2); }
            }
        }
        int idv[8][2];
#pragma unroll
        for (int j = 0; j < 8; ++j) { const int* ir = p.idx + (size_t)(tb + j) * 128; idv[j][0] = ir[lane]; idv[j][1] = ir[64 + lane]; }
#pragma unroll 1
        for (int x = 0; x < 8; ++x) {
            int n = 0;
#pragma unroll
            for (int j = 0; j < 8; ++j)
#pragma unroll
                for (int r = 0; r < 2; ++r) {
                    const int e = idv[j][r];
                    const bool in = (e >> 11) == x;
                    const unsigned long long mk = __ballot(in);
                    const int rank = (int)__builtin_amdgcn_mbcnt_hi((unsigned)(mk >> 32), __builtin_amdgcn_mbcnt_lo((unsigned)mk, 0u));
                    if (in) list[n + rank] = ((unsigned)j << 21) | ((unsigned)(r * 64 + lane) << 14) | (unsigned)e;
                    n += (int)__builtin_popcountll(mk);
                }
            asm volatile("s_waitcnt lgkmcnt(0)" ::: "memory");
            u32x4 ua[16], ubf[16]; int enta = 0, entb = 0;
            auto issue = [&](int b0, u32x4 (&uu)[16], int& entv) {
                const int i = (b0 + l15 < n) ? b0 + l15 : n - 1;
                entv = (int)list[i];
#pragma unroll
                for (int j = 0; j < 16; ++j) { const int e = __builtin_amdgcn_readlane(entv, j) & 0x3fff; uu[j] = *(const u32x4*)(p.u8 + (size_t)e * D_MODEL + lane16); }
            };
            auto reduce = [&](int b0, const u32x4 (&uu)[16], int entv) {
                int part[16];
#pragma unroll
                for (int j = 0; j < 16; ++j) {
                    const int tl = __builtin_amdgcn_readlane(entv, j) >> 21;
                    const u32x4 hqv = *(const u32x4*)(hql + tl * 1024 + lane * 16);
                    int sacc = __builtin_amdgcn_sdot4((int)uu[j].x, (int)hqv.x, 0, false);
                    sacc = __builtin_amdgcn_sdot4((int)uu[j].y, (int)hqv.y, sacc, false);
                    sacc = __builtin_amdgcn_sdot4((int)uu[j].z, (int)hqv.z, sacc, false);
                    part[j] = __builtin_amdgcn_sdot4((int)uu[j].w, (int)hqv.w, sacc, false);
                }
                const int r1 = reduce16_rows(part, b3, b2, b1, b0b);
                if (lane < 16 && b0 + lane < n) dotsl[((unsigned)entv >> 21) * 128 + (((unsigned)entv >> 14) & 127u)] = r1;
            };
            if (n > 0) issue(0, ua, enta);
            for (int b0 = 0; b0 < n; b0 += 32) {
                if (b0 + 16 < n) issue(b0 + 16, ubf, entb);
                reduce(b0, ua, enta);
                if (b0 + 16 < n) {
                    if (b0 + 32 < n) issue(b0 + 32, ua, enta);
                    reduce(b0 + 16, ubf, entb);
                }
            }
            asm volatile("s_waitcnt lgkmcnt(0)" ::: "memory");
        }
#pragma unroll
        for (int j = 0; j < 8; ++j) {
            const int hs_t = tks[4 * j]; const float cs_t = __int_as_float(tks[4 * j + 1]), r2_t = __int_as_float(tks[4 * j + 2]);
            const float* gr = p.gate + (size_t)(tb + j) * 128; float* cr = p.coef + (size_t)(tb + j) * 128;
#pragma unroll
            for (int r = 0; r < 2; ++r) {
                const int e = idv[j][r];
                const float sc = gr[r * 64 + lane] * r2_t;
                const float ex = __expf(sc - key2f(row_allmax_i(f2key(sc))));
                const float gt = ex / row_allsum_f(ex);
                const float dotf = (float)dotsl[j * 128 + r * 64 + lane] * cs_t * p.su[e];
                cr[r * 64 + lane] = gt * gelu_t(dotf) * p.sv[e];
            }
        }
        asm volatile("s_waitcnt lgkmcnt(0)" ::: "memory");
    }
}

__device__ void phase_gather(const Params& p, char* lds) {
    const int tidx_ = tid_opaque();
    const int wave = __builtin_amdgcn_readfirstlane((int)((blockIdx.x * blockDim.x + tidx_) >> 6)), nwaves = (gridDim.x * blockDim.x) >> 6, lane = tidx_ & 63;
    const unsigned char* vb = p.v8 + lane * 12;
    for (int t = wave; t < T_TOK; t += nwaves) {
        int idr[2]; float coef[2];
        { const int* ir = p.idx + (size_t)t * 128; idr[0] = ir[lane]; idr[1] = ir[64 + lane]; }
        { const float* cr = p.coef + (size_t)t * 128; coef[0] = cr[lane]; coef[1] = cr[64 + lane]; }
        const float cmax = wave_max(fmaxf(fabsf(coef[0]), fabsf(coef[1])));
        const float qs = cmax > 0.f ? 127.0f / cmax : 0.f, cscale = cmax * (1.0f / 127.0f);
        const int cq0 = (int)rintf(coef[0] * qs), cq1 = (int)rintf(coef[1] * qs);
        const int csum_i = wave_sum_i_uniform(cq0 + cq1);
        unsigned cpk[2];
        {
            const int cqs[2] = {cq0, cq1};
#pragma unroll
            for (int hf = 0; hf < 2; ++hf) {
                const int bb = cqs[hf] & 0xff;
                cpk[hf] = (unsigned)__builtin_amdgcn_update_dpp(0, bb, 0x00, 0xf, 0xf, false) | ((unsigned)__builtin_amdgcn_update_dpp(0, bb, 0x55, 0xf, 0xf, false) << 8)
                        | ((unsigned)__builtin_amdgcn_update_dpp(0, bb, 0xAA, 0xf, 0xf, false) << 16) | ((unsigned)__builtin_amdgcn_update_dpp(0, bb, 0xFF, 0xf, 0xf, false) << 24);
            }
        }
        int acc[16];
#pragma unroll
        for (int j = 0; j < 16; ++j) acc[j] = 0;
        {
            u32x3 va[8], vbf[8];
            auto issue = [&](int pb, u32x3 (&vv)[8]) {
#pragma unroll
                for (int q = 0; q < 8; ++q) { const int e = __builtin_amdgcn_readlane(pb < 64 ? idr[0] : idr[1], (pb & 63) + q); vv[q] = *(const u32x3*)(vb + (size_t)e * ROWB); }
            };
            auto axpy = [&](int pb, const u32x3 (&vv)[8]) {
#pragma unroll
                for (int g4 = 0; g4 < 2; ++g4) {
                    const int cqd = __builtin_amdgcn_readlane((int)(pb < 64 ? cpk[0] : cpk[1]), (pb & 63) + 4 * g4);
                    unsigned dd[4][4];
#pragma unroll
                    for (int r = 0; r < 4; ++r) {
                        const unsigned w0 = vv[4 * g4 + r].x, w1 = vv[4 * g4 + r].y, w2 = vv[4 * g4 + r].z;
                        dd[r][0] = w0 & 0x3f3f3f3fu; dd[r][1] = w1 & 0x3f3f3f3fu; dd[r][2] = w2 & 0x3f3f3f3fu;
                        dd[r][3] = ((w0 >> 6) & 0x03030303u) | ((w1 >> 4) & 0x0c0c0c0cu) | ((w2 >> 2) & 0x30303030u);
                    }
#pragma unroll
                    for (int k = 0; k < 4; ++k) {
                        const unsigned p0 = __builtin_amdgcn_perm(dd[1][k], dd[0][k], 0x05010400u), p1 = __builtin_amdgcn_perm(dd[1][k], dd[0][k], 0x07030602u);
                        const unsigned q0 = __builtin_amdgcn_perm(dd[3][k], dd[2][k], 0x05010400u), q1 = __builtin_amdgcn_perm(dd[3][k], dd[2][k], 0x07030602u);
                        const unsigned t0 = __builtin_amdgcn_perm(q0, p0, 0x05040100u), t1 = __builtin_amdgcn_perm(q0, p0, 0x07060302u);
                        const unsigned t2 = __builtin_amdgcn_perm(q1, p1, 0x05040100u), t3 = __builtin_amdgcn_perm(q1, p1, 0x07060302u);
                        acc[4 * k + 0] = __builtin_amdgcn_sdot4((int)t0, cqd, acc[4 * k + 0], false);
                        acc[4 * k + 1] = __builtin_amdgcn_sdot4((int)t1, cqd, acc[4 * k + 1], false);
                        acc[4 * k + 2] = __builtin_amdgcn_sdot4((int)t2, cqd, acc[4 * k + 2], false);
                        acc[4 * k + 3] = __builtin_amdgcn_sdot4((int)t3, cqd, acc[4 * k + 3], false);
                    }
                }
            };
            issue(0, va);
#pragma unroll 1
            for (int pb = 0; pb < 128; pb += 16) {
                issue(pb + 8, vbf);
                axpy(pb, va);
                if (pb + 16 < 128) issue(pb + 16, va);
                axpy(pb + 8, vbf);
            }
        }
        const u32x4* hr = (const u32x4*)(p.hb + (size_t)t * D_MODEL + lane * 16);
        const u32x4 ha = hr[0], hc = hr[1];
        const float hf16[16] = {bflo(ha.x), bfhi(ha.x), bflo(ha.y), bfhi(ha.y), bflo(ha.z), bfhi(ha.z), bflo(ha.w), bfhi(ha.w),
                                bflo(hc.x), bfhi(hc.x), bflo(hc.y), bfhi(hc.y), bflo(hc.z), bfhi(hc.z), bflo(hc.w), bfhi(hc.w)};
        float res[16];
        float ss = 0.f;
#pragma unroll
        for (int j = 0; j < 16; ++j) { res[j] = hf16[j] + cscale * (float)(acc[j] - 32 * csum_i); ss += res[j] * res[j]; }
        ss = wave_sum(ss);
        const float r3 = rsqrtf(ss * (1.0f / D_MODEL) + EPS);
        float* o = p.out + (size_t)t * D_MODEL + lane * 16;
        const float* fg = p.final_g + lane * 16;
#pragma unroll
        for (int i = 0; i < 4; ++i) {
            const float4 g = ((const float4*)fg)[i];
            float4 ov; ov.x = res[4 * i] * r3 * g.x; ov.y = res[4 * i + 1] * r3 * g.y; ov.z = res[4 * i + 2] * r3 * g.z; ov.w = res[4 * i + 3] * r3 * g.w;
            ((float4*)o)[i] = ov;
        }
    }
}

namespace pg8 {
#define PG8_LAS __attribute__((address_space(3)))
constexpr int BM = 256, BK = 64, HALF = 128, HTB = HALF * BK * 2, STAGE_BYTES = 8 * HTB, NXCD = 8, WGM = 8;
__host__ __device__ __forceinline__ int lds_byte(int r, int c) { const int st = (r >> 4) * 2 + (c >> 5), rr = r & 15, cc = c & 31, ob = rr * 64 + cc * 2; return st * 1024 + (ob ^ (((ob >> 9) & 1) << 5)); }
__host__ __device__ __forceinline__ void stage_rc(int b, int& R, int& C) { const int st = b / 1024, sb = b % 1024, swz = sb ^ (((sb >> 9) & 1) << 5); R = (st >> 1) * 16 + swz / 64; C = (st & 1) * 32 + (swz % 64) / 2; }
__host__ __device__ __forceinline__ int perm32(int rho) { const int n = rho >> 4, i = rho & 15; return 8 * (i >> 2) + 4 * n + (i & 3); }
struct Unit { int pm, pn; };
struct Gemm { const bf16_t* A; const bf16_t* Bt; int M, N, K; };
struct StaticOrder {
    int nM, nN, nwg, G, c;
    __host__ __device__ void init(int M, int N, int G_, int c_) { nM = M / BM; nN = N / BM; nwg = nM * nN; G = G_; c = c_; }
    __host__ __device__ bool next(int i, Unit& u) const {
        const long L = (long)i * G + c; if (L >= nwg) return false;
        int wgid = (int)L; { const int q = nwg / NXCD, r = nwg % NXCD, xcd = wgid % NXCD, off = wgid / NXCD; wgid = (xcd < r ? xcd * (q + 1) : r * (q + 1) + (xcd - r) * q) + off; }
        const int nig = WGM * nN, gid = wgid / nig, fm = gid * WGM, gsz = (nM - fm) < WGM ? (nM - fm) : WGM;
        u.pm = fm + ((wgid % nig) % gsz); u.pn = (wgid % nig) / gsz; return true;
    }
    __device__ __forceinline__ void a_ready(const Unit&) const {}
    __device__ __forceinline__ void done(const Unit&) const {}
};
__device__ __forceinline__ unsigned cvt_pk_bf16(float lo, float hi) { unsigned r; asm volatile("v_cvt_pk_bf16_f32 %0, %1, %2" : "=v"(r) : "v"(lo), "v"(hi)); return r; }
struct EpiZ {
    static constexpr bool PERM = true, AFTER_DRAIN = false;
    bf16_t* O; const float* rs;
    __device__ __forceinline__ void operator()(const f32x4 (&acc)[2][2][4][2], const Unit& u, int wr, int wc, int fr, int fq) const {
        const int row0 = u.pm * BM + wr * 64 + fr, col0 = u.pn * BM + wc * 32 + 8 * fq; const bool act = u.pn >= 2;
#pragma unroll
        for (int ai = 0; ai < 2; ++ai)
#pragma unroll
            for (int m = 0; m < 4; ++m) { const int r = row0 + ai * HALF + m * 16; const float sc = rs[r]; bf16_t* rowp = O + (size_t)r * D_IN + col0;
#pragma unroll
                for (int bj = 0; bj < 2; ++bj) { f32x4 v0 = acc[ai][bj][m][0] * sc, v1 = acc[ai][bj][m][1] * sc;
                    if (act) { v0 = (f32x4){gelu_t(v0[0]), gelu_t(v0[1]), gelu_t(v0[2]), gelu_t(v0[3])}; v1 = (f32x4){gelu_t(v1[0]), gelu_t(v1[1]), gelu_t(v1[2]), gelu_t(v1[3])}; }
                    u32x4 w; w.x = cvt_pk_bf16(v0[0], v0[1]); w.y = cvt_pk_bf16(v0[2], v0[3]); w.z = cvt_pk_bf16(v1[0], v1[1]); w.w = cvt_pk_bf16(v1[2], v1[3]);
                    *(u32x4*)(rowp + bj * HALF) = w; } }
    }
};
struct EpiOut {
    static constexpr bool PERM = true, AFTER_DRAIN = false;
    bf16_t* O; const bf16_t* X;
    __device__ __forceinline__ void operator()(const f32x4 (&acc)[2][2][4][2], const Unit& u, int wr, int wc, int fr, int fq) const {
        const int row0 = u.pm * BM + wr * 64 + fr, col0 = u.pn * BM + wc * 32 + 8 * fq;
#pragma unroll
        for (int ai = 0; ai < 2; ++ai)
#pragma unroll
            for (int m = 0; m < 4; ++m) { const size_t off = (size_t)(row0 + ai * HALF + m * 16) * D_MODEL + col0;
#pragma unroll
                for (int bj = 0; bj < 2; ++bj) { const u32x4 xx = *(const u32x4*)(X + off + bj * HALF);
                    const f32x4 v0 = acc[ai][bj][m][0] + (f32x4){bflo(xx.x), bfhi(xx.x), bflo(xx.y), bfhi(xx.y)}, v1 = acc[ai][bj][m][1] + (f32x4){bflo(xx.z), bfhi(xx.z), bflo(xx.w), bfhi(xx.w)};
                    u32x4 w; w.x = cvt_pk_bf16(v0[0], v0[1]); w.y = cvt_pk_bf16(v0[2], v0[3]); w.z = cvt_pk_bf16(v1[0], v1[1]); w.w = cvt_pk_bf16(v1[2], v1[3]);
                    *(u32x4*)(O + off + bj * HALF) = w; } }
    }
};
struct OneUnit {
    Unit u;
    __device__ __forceinline__ bool next(int i, Unit& o) const { if (i) return false; o = u; return true; }
    __device__ __forceinline__ void a_ready(const Unit&) const {}
    __device__ __forceinline__ void done(const Unit&) const {}
};
#define QT_PITCH 272
#define QT_LDS_BYTES (2 * 256 * QT_PITCH)
struct EpiQTopk {
    static constexpr bool PERM = true, AFTER_DRAIN = true;
    const bf16_t* keysB; int* idx; float* gate;
    __device__ __forceinline__ void fused(f32x4 (&acc)[2][2][4][2], const Unit& u, int wr, int wc, int fr, int fq, PG8_LAS unsigned char* ldsp, int wid, int lane) const {
        char* sQ = (char*)ldsp;
        const int h = u.pn;
#pragma unroll
        for (int ai = 0; ai < 2; ++ai)
#pragma unroll
            for (int m = 0; m < 4; ++m) { const int r = ai * HALF + wr * 64 + m * 16 + fr;
#pragma unroll
                for (int bj = 0; bj < 2; ++bj) { const f32x4 v0 = acc[ai][bj][m][0], v1 = acc[ai][bj][m][1];
                    u32x4 w; w.x = cvt_pk_bf16(v0[0], v0[1]); w.y = cvt_pk_bf16(v0[2], v0[3]); w.z = cvt_pk_bf16(v1[0], v1[1]); w.w = cvt_pk_bf16(v1[2], v1[3]);
                    *(u32x4*)(sQ + bj * (256 * QT_PITCH) + r * QT_PITCH + (wc * 32 + fq * 8) * 2) = w; } }
        __syncthreads();
        int cbv[4];
#pragma unroll
        for (int c = 0; c < 4; ++c) cbv[c] = kComb[4 * fr + c];
        int tA[2][4], tB[2][4];
#pragma unroll
        for (int m = 0; m < 2; ++m)
#pragma unroll
            for (int j = 0; j < 4; ++j) { tA[m][j] = 0; tB[m][j] = 0; }
#pragma unroll 1
        for (int pp = 0; pp < 2; ++pp) {
            const bf16_t* kb = keysB + (size_t)(pp * 8 + h) * 16384 + (size_t)fr * 128 + fq * 8;
            const char* qa = sQ + pp * (256 * QT_PITCH) + (wid * 32 + fr) * QT_PITCH + fq * 16;
            f32x4 sc2[2][8];
#pragma unroll
            for (int m = 0; m < 2; ++m)
#pragma unroll
                for (int nb = 0; nb < 8; ++nb) sc2[m][nb] = (f32x4){0.f, 0.f, 0.f, 0.f};
#pragma unroll
            for (int kk = 0; kk < 4; ++kk) {
                bf16x8 kf[8], af[2];
#pragma unroll
                for (int nb = 0; nb < 8; ++nb) kf[nb] = *(const bf16x8*)(kb + (size_t)nb * 16 * 128 + kk * 32);
#pragma unroll
                for (int m = 0; m < 2; ++m) af[m] = *(const bf16x8*)(qa + m * 16 * QT_PITCH + kk * 64);
#pragma unroll
                for (int m = 0; m < 2; ++m)
#pragma unroll
                    for (int nb = 0; nb < 8; ++nb) sc2[m][nb] = __builtin_amdgcn_mfma_f32_16x16x32_bf16(af[m], kf[nb], sc2[m][nb], 0, 0, 0);
            }
#pragma unroll
            for (int m = 0; m < 2; ++m)
#pragma unroll
                for (int j = 0; j < 4; ++j) tA[m][j] = tB[m][j];
#pragma unroll 2
            for (int it = 0; it < 4; ++it) {
#pragma unroll
                for (int m = 0; m < 2; ++m) {
                    int k[8];
#pragma unroll
                    for (int nb = 0; nb < 8; ++nb) k[nb] = (f2key(sc2[m][nb][0]) & ~127) | (127 - (16 * nb + fr));
                    const int r = top16_rows(k, fr);
                    tB[m][0] = tB[m][1]; tB[m][1] = tB[m][2]; tB[m][2] = tB[m][3]; tB[m][3] = r;
#pragma unroll
                    for (int nb = 0; nb < 8; ++nb) sc2[m][nb] = (f32x4){sc2[m][nb][1], sc2[m][nb][2], sc2[m][nb][3], sc2[m][nb][0]};
                }
            }
        }
#pragma unroll 2
        for (int it = 0; it < 4; ++it) {
#pragma unroll
            for (int m = 0; m < 2; ++m) {
                int eid; float gt;
                combine16(tA[m][0], tB[m][0], cbv, lane, fr, eid, gt);
                const int t = u.pm * BM + wid * 32 + m * 16 + fq * 4 + it;
                const size_t o = (size_t)t * 128 + h * 16 + fr;
                idx[o] = eid; gate[o] = gt;
                tA[m][0] = tA[m][1]; tA[m][1] = tA[m][2]; tA[m][2] = tA[m][3];
                tB[m][0] = tB[m][1]; tB[m][1] = tB[m][2]; tB[m][2] = tB[m][3];
            }
        }
        __syncthreads();
    }
};
template <class Epi, class Sched>
__device__ __forceinline__ void gemm_phase(PG8_LAS unsigned char* lds, const Gemm g, const Sched& S, const Epi& E) {
    const int tid = tid_opaque(), wid = __builtin_amdgcn_readfirstlane(tid >> 6), lane = tid & 63, wr = wid >> 2, wc = wid & 3, fr = lane & 15, fq = lane >> 4;
    const int K = g.K, nt = K / BK;
    unsigned voffA[2], voffB[2];
#pragma unroll
    for (int i = 0; i < 2; ++i) { int R, C; stage_rc(tid * 16 + i * 8192, R, C); const int Rb = Epi::PERM ? ((R & ~31) + perm32(R & 31)) : R;
        voffA[i] = (unsigned)(R * K + C) * 2u; voffB[i] = (unsigned)(Rb * K + C) * 2u; }
    const size_t kstep = (size_t)(BK * 2);
    const size_t hstep = (size_t)HALF * K * 2;
    const size_t tstep = 2 * hstep;
    const unsigned ldsw = (unsigned)wid * 1024u;
    const int aoff = lds_byte(wr * 64 + fr, fq * 8), boff = lds_byte(wc * 32 + fr, fq * 8);
#define PG8_SA(b, h) (((b) * 2 + (h)) * HTB)
#define PG8_SB(b, h) ((4 + (b) * 2 + (h)) * HTB)
#define PG8_STAGE(bufoff, gbase, voff) do { _Pragma("unroll") for (int _i = 0; _i < 2; ++_i) \
        __builtin_amdgcn_global_load_lds((const unsigned*)((const char*)(gbase) + (voff)[_i]), (PG8_LAS unsigned*)(lds + (bufoff) + ldsw + _i * 8192), 16, 0, 0); } while (0)
#define PG8_LDA(dst, b, h) do { _Pragma("unroll") for (int m = 0; m < 4; ++m) _Pragma("unroll") for (int k = 0; k < 2; ++k) dst[m][k] = *(const PG8_LAS bf16x8*)(lds + PG8_SA(b, h) + aoff + m * 2048 + k * 1024); } while (0)
#define PG8_LDB(dst, b, h) do { _Pragma("unroll") for (int n = 0; n < 2; ++n) _Pragma("unroll") for (int k = 0; k < 2; ++k) dst[n][k] = *(const PG8_LAS bf16x8*)(lds + PG8_SB(b, h) + boff + n * 2048 + k * 1024); } while (0)
#define PG8_MMA(ai, bj, At, Bt) do { __builtin_amdgcn_s_setprio(1); _Pragma("unroll") for (int m = 0; m < 4; ++m) _Pragma("unroll") for (int n = 0; n < 2; ++n) _Pragma("unroll") for (int k = 0; k < 2; ++k) \
        acc[ai][bj][m][n] = __builtin_amdgcn_mfma_f32_16x16x32_bf16(Bt[n][k], At[m][k], acc[ai][bj][m][n], 0, 0, 0); __builtin_amdgcn_s_setprio(0); } while (0)
#define PG8_WAIT_V(n) asm volatile("s_waitcnt vmcnt(" #n ")" ::: "memory")
#define PG8_WAIT_L(n) asm volatile("s_waitcnt lgkmcnt(" #n ")" ::: "memory")
#define PG8_BAR __builtin_amdgcn_s_barrier()
#define PG8_SCHED __builtin_amdgcn_sched_barrier(0)
    Unit cur, nxt; int ui = 0;
    if (!S.next(0, cur)) return;
    f32x4 acc[2][2][4][2];
#pragma unroll
    for (int a = 0; a < 2; ++a)
#pragma unroll
        for (int b = 0; b < 2; ++b)
#pragma unroll
            for (int m = 0; m < 4; ++m)
#pragma unroll
                for (int n = 0; n < 2; ++n) acc[a][b][m][n] = (f32x4){0.f, 0.f, 0.f, 0.f};
    bf16x8 At[4][2], B0[2][2], B1[2][2];
    const char* cA = (const char*)g.A + (size_t)cur.pm * tstep; const char* cB = (const char*)g.Bt + (size_t)cur.pn * tstep;
    S.a_ready(cur);
    PG8_STAGE(PG8_SB(0, 0), cB, voffB); PG8_STAGE(PG8_SA(0, 0), cA, voffA); PG8_STAGE(PG8_SB(0, 1), cB + hstep, voffB); PG8_STAGE(PG8_SA(0, 1), cA + hstep, voffA);
    if (wr == 1) PG8_BAR;
    PG8_WAIT_V(4); PG8_BAR;
    PG8_STAGE(PG8_SB(1, 0), cB + kstep, voffB); PG8_STAGE(PG8_SA(1, 0), cA + kstep, voffA); PG8_STAGE(PG8_SB(1, 1), cB + hstep + kstep, voffB);
    PG8_WAIT_V(6); PG8_BAR;
    for (;;) {
        const bool has_next = S.next(ui + 1, nxt);
        const char* nA = has_next ? (const char*)g.A + (size_t)nxt.pm * tstep : cA; const char* nB = has_next ? (const char*)g.Bt + (size_t)nxt.pn * tstep : cB;
        for (int t = 0; t < nt; t += 2) {
            const bool last = (t == nt - 2);
            const char* a1 = cA + (size_t)(t + 1) * kstep;
            const char* a2 = last ? nA : cA + (size_t)(t + 2) * kstep; const char* b2 = last ? nB : cB + (size_t)(t + 2) * kstep;
            const char* a3 = a2 + kstep; const char* b3 = b2 + kstep;
            if (last && has_next) S.a_ready(nxt);
            PG8_LDB(B0, 0, 0); PG8_SCHED; PG8_LDA(At, 0, 0); PG8_STAGE(PG8_SA(1, 1), a1 + hstep, voffA);
            PG8_WAIT_L(8); PG8_BAR; PG8_WAIT_L(0); PG8_MMA(0, 0, At, B0); PG8_BAR; PG8_SCHED;
            PG8_LDB(B1, 0, 1); PG8_STAGE(PG8_SB(0, 0), b2, voffB);
            PG8_BAR; PG8_WAIT_L(0); PG8_MMA(0, 1, At, B1); PG8_BAR;
            PG8_LDA(At, 0, 1); PG8_STAGE(PG8_SA(0, 0), a2, voffA);
            PG8_BAR; PG8_WAIT_L(0); PG8_MMA(1, 0, At, B0); PG8_BAR; PG8_SCHED;
            PG8_STAGE(PG8_SB(0, 1), b2 + hstep, voffB);
            PG8_WAIT_V(6); PG8_BAR; PG8_MMA(1, 1, At, B1); PG8_BAR;
            PG8_LDB(B0, 1, 0); PG8_SCHED; PG8_LDA(At, 1, 0); PG8_STAGE(PG8_SA(0, 1), a2 + hstep, voffA);
            PG8_WAIT_L(8); PG8_BAR; PG8_WAIT_L(0); PG8_MMA(0, 0, At, B0); PG8_BAR; PG8_SCHED;
            PG8_LDB(B1, 1, 1); PG8_STAGE(PG8_SB(1, 0), b3, voffB);
            PG8_BAR; PG8_WAIT_L(0); PG8_MMA(0, 1, At, B1); PG8_BAR;
            PG8_LDA(At, 1, 1); PG8_STAGE(PG8_SA(1, 0), a3, voffA);
            PG8_BAR; PG8_WAIT_L(0); PG8_MMA(1, 0, At, B0); PG8_BAR; PG8_SCHED;
            PG8_STAGE(PG8_SB(1, 1), b3 + hstep, voffB);
            PG8_WAIT_V(6); PG8_BAR; PG8_MMA(1, 1, At, B1); PG8_BAR;
        }
            if constexpr (!Epi::AFTER_DRAIN) { E(acc, cur, wr, wc, fr, fq); S.done(cur); }
            if (!has_next) break;
#pragma unroll
        for (int a = 0; a < 2; ++a)
#pragma unroll
            for (int b = 0; b < 2; ++b)
#pragma unroll
                for (int m = 0; m < 4; ++m)
#pragma unroll
                    for (int n = 0; n < 2; ++n) acc[a][b][m][n] = (f32x4){0.f, 0.f, 0.f, 0.f};
        cur = nxt; cA = nA; cB = nB; ++ui;
    }
    PG8_WAIT_V(0);
    if (wr == 0) PG8_BAR;
    PG8_BAR;
    if constexpr (Epi::AFTER_DRAIN) { E.fused(acc, cur, wr, wc, fr, fq, lds, wid, lane); S.done(cur); }
#undef PG8_SA
#undef PG8_SB
#undef PG8_STAGE
#undef PG8_LDA
#undef PG8_LDB
#undef PG8_MMA
#undef PG8_WAIT_V
#undef PG8_WAIT_L
#undef PG8_BAR
#undef PG8_SCHED
}
}

__device__ void phase_gemm_z(const Params& p, char* lds) {
    pg8::StaticOrder S; S.init(T_TOK, D_IN, gridDim.x, blockIdx.x);
    pg8::gemm_phase<pg8::EpiZ, pg8::StaticOrder>((PG8_LAS unsigned char*)lds, pg8::Gemm{p.xb, p.winT, T_TOK, D_IN, D_MODEL}, S, pg8::EpiZ{p.zb, p.rstd1});
}
__device__ void phase_gemm_out(const Params& p, char* lds) {
    pg8::StaticOrder S; S.init(T_TOK, D_MODEL, gridDim.x, blockIdx.x);
    pg8::gemm_phase<pg8::EpiOut, pg8::StaticOrder>((PG8_LAS unsigned char*)lds, pg8::Gemm{p.cB, p.woutT, T_TOK, D_MODEL, D_MODEL}, S, pg8::EpiOut{p.hb, p.xb});
}
__device__ void phase_gemm_q(const Params& p, char* lds) {
    pg8::StaticOrder S; S.init(T_TOK, 2048, gridDim.x, blockIdx.x);
    pg8::Unit u;
    for (int i = 0; S.next(i, u); ++i)
        pg8::gemm_phase<pg8::EpiQTopk, pg8::OneUnit>((PG8_LAS unsigned char*)lds, pg8::Gemm{p.hb, p.wqT, T_TOK, 2048, D_MODEL}, pg8::OneUnit{u}, pg8::EpiQTopk{p.keysB, p.idx, p.gate});
}

#define XB_TMO      128
#define XB_XCNT(j)  (256  + 64 * (j))
#define XB_XSUB(j)  (1280 + 64 * (j))
#define XB_XGEN(j)  (2304 + 64 * (j))
#define XB_TOP      3328
#define XB_TOPGEN   3392
#define XCD_BAR_WORDS 3456
#define XB_SPIN_CAP (1u << 20)
__device__ __forceinline__ unsigned xb_ld(unsigned* p)              { return __hip_atomic_load(p, __ATOMIC_RELAXED, __HIP_MEMORY_SCOPE_AGENT); }
__device__ __forceinline__ unsigned xb_add(unsigned* p, unsigned v) { return __hip_atomic_fetch_add(p, v, __ATOMIC_RELAXED, __HIP_MEMORY_SCOPE_AGENT); }
__device__ __forceinline__ unsigned xb_xcc_id() { return (unsigned)__builtin_amdgcn_s_getreg((3 << 11) | 20) & 0xFu; }
#define XB_SPIN(cond, bar) do { unsigned _sp = 0; while (cond) { __builtin_amdgcn_s_sleep(1); \
    if ((++_sp & 255u) == 0u) { if (xb_ld(&(bar)[XB_TMO])) break; if (_sp > XB_SPIN_CAP) { atomicAdd(&(bar)[XB_TMO], 1u); break; } } } } while (0)
struct XcdBarrier { unsigned* bar; unsigned x; volatile LAS unsigned* st; };
__device__ __forceinline__ XcdBarrier xcd_barrier_post(unsigned* bar, volatile LAS unsigned* st) {
    XcdBarrier b; b.bar = bar; b.x = xb_xcc_id(); b.st = st;
    if (threadIdx.x == 0) (void)xb_add(&bar[XB_XCNT(b.x)], 1u);
    return b;
}
__device__ __forceinline__ void xcd_barrier_complete(unsigned* bar, unsigned x, unsigned& nloc, unsigned& nx) {
    const unsigned G = gridDim.x * gridDim.y * gridDim.z;
    unsigned sum, cnt, mine, sp = 0u;
    for (;;) {
        sum = 0u; cnt = 0u; mine = 0u;
#pragma unroll
        for (unsigned j = 0; j < 16; ++j) { const unsigned c = xb_ld(&bar[XB_XCNT(j)]); sum += c; cnt += (c > 0u) ? 1u : 0u; mine = (j == x) ? c : mine; }
        if (sum == G) break;
        __builtin_amdgcn_s_sleep(1);
        if ((++sp & 255u) == 0u) { if (xb_ld(&bar[XB_TMO])) break; if (sp > XB_SPIN_CAP) { atomicAdd(&bar[XB_TMO], 1u); break; } }
    }
    nloc = mine > 0u ? mine : 1u; nx = cnt > 0u ? cnt : 1u;
}
__device__ __forceinline__ void xcd_barrier(const XcdBarrier& b) {
    asm volatile("s_waitcnt vmcnt(0)" ::: "memory");
    __syncthreads();
    if (threadIdx.x == 0) {
        unsigned* bar = b.bar;
        __builtin_amdgcn_s_waitcnt(0);
        unsigned nloc = b.st[0], nx = b.st[1];
        if (nloc == 0u) { xcd_barrier_complete(bar, b.x, nloc, nx); b.st[0] = nloc; b.st[1] = nx; }
        const unsigned old = xb_add(&bar[XB_XSUB(b.x)], 1u);
        const unsigned gen = old / nloc;
        if (old + 1u == (gen + 1u) * nloc) {
            __builtin_amdgcn_fence(__ATOMIC_RELEASE, "agent");
            asm volatile("s_waitcnt vmcnt(0)" ::: "memory");
            const unsigned og = xb_add(&bar[XB_TOP], 1u);
            const unsigned tg = og / nx;
            if (og + 1u == (tg + 1u) * nx) xb_add(&bar[XB_TOPGEN], 1u);
            else XB_SPIN(xb_ld(&bar[XB_TOPGEN]) == tg, bar);
            __builtin_amdgcn_fence(__ATOMIC_ACQUIRE, "agent");
            xb_add(&bar[XB_XGEN(b.x)], 1u);
            asm volatile("s_waitcnt vmcnt(0)" ::: "memory");
        } else {
            XB_SPIN(xb_ld(&bar[XB_XGEN(b.x)]) == gen, bar);
            __builtin_amdgcn_fence(__ATOMIC_ACQUIRE, "agent");
            asm volatile("s_waitcnt vmcnt(0)" ::: "memory");
        }
    }
    __syncthreads();
}

#define MEGA_LDS_MAX2(a, b) ((a) > (b) ? (a) : (b))
#define MEGA_LDS_MAIN MEGA_LDS_MAX2(MEGA_LDS_MAX2(QT_LDS_BYTES, pg8::STAGE_BYTES), MEGA_LDS_MAX2(8 * TS_WBYTES, 2 * MIXH_LDS))
#define MEGA_LDS_BYTES (MEGA_LDS_MAIN + 16)
extern __shared__ __attribute__((aligned(16))) char smem[];
__global__ void __launch_bounds__(512, 2) fwd_mega(Params p) {
    volatile LAS unsigned* st = (volatile LAS unsigned*)(smem + MEGA_LDS_MAIN);
    if (threadIdx.x < 4) st[threadIdx.x] = 0u;
    __syncthreads();
    const XcdBarrier xb = xcd_barrier_post(p.bar, st);
    phase_prep(p, smem);      xcd_barrier(xb);
    phase_gemm_z(p, smem);    xcd_barrier(xb);
    phase_mix_gemm(p, smem);  xcd_barrier(xb);
    phase_gemm_out(p, smem);  xcd_barrier(xb);
    phase_gemm_q(p, smem);    xcd_barrier(xb);
    phase_peer_dots(p, smem); xcd_barrier(xb);
    phase_gather(p, smem);
}

extern "C" void kernel_launch(void* const* d_in, const int* in_sizes, int n_in, void* d_out, int out_size, void* d_ws, size_t ws_size, hipStream_t stream) {
    static int grid_blocks = 0;
    if (grid_blocks == 0) {
        int dev = 0, cus = 0, per_cu = 0;
        (void)hipGetDevice(&dev);
        (void)hipDeviceGetAttribute(&cus, hipDeviceAttributeMultiprocessorCount, dev);
        (void)hipFuncSetAttribute((const void*)fwd_mega, hipFuncAttributeMaxDynamicSharedMemorySize, MEGA_LDS_BYTES);
        (void)hipOccupancyMaxActiveBlocksPerMultiprocessor(&per_cu, (const void*)fwd_mega, 512, MEGA_LDS_BYTES);
        if (per_cu > 1) per_cu = 1;
        if (per_cu < 1) per_cu = 1;
        grid_blocks = cus * per_cu;
    }
    Params p{};
    p.x = (const float*)d_in[0]; p.norm1_g = (const float*)d_in[1]; p.w_in = (const float*)d_in[2]; p.pool_w = (const float*)d_in[3];
    p.pool_scale = (const float*)d_in[4]; p.sgu_norm_g = (const float*)d_in[5]; p.sgu_w = (const float*)d_in[6]; p.sgu_b = (const float*)d_in[7];
    p.w_out = (const float*)d_in[8]; p.norm2_g = (const float*)d_in[9]; p.peer_wq = (const float*)d_in[10]; p.peer_keys = (const float*)d_in[11];
    p.peer_u = (const float*)d_in[12]; p.peer_v = (const float*)d_in[13]; p.final_g = (const float*)d_in[14];
    p.out = (float*)d_out;
    char* w = (char*)d_ws; size_t off = 0;
    auto take = [&](size_t bytes) { char* r = w + off; off += (bytes + 255) & ~(size_t)255; return r; };
    const size_t MiB = 1024 * 1024;
    p.u8 = (unsigned char*)take(16 * MiB); p.v8 = (unsigned char*)take(12 * MiB);
    p.su = (float*)take(64 * 1024); p.sv = (float*)take(64 * 1024);
    p.winT = (bf16_t*)take(3 * MiB); p.woutT = (bf16_t*)take(2 * MiB); p.wqT = (bf16_t*)take(4 * MiB);
    p.poolT = (bf16_t*)take(128 * 1024); p.wsM = (bf16_t*)take(128 * 1024); p.keysB = (bf16_t*)take(512 * 1024);
    p.bar = (unsigned*)take(XCD_BAR_WORDS * 4);
    p.rstd1 = (float*)take(128 * 1024);
    p.idx = (int*)take(16 * MiB); p.gate = (float*)take(16 * MiB); p.coef = (float*)take(16 * MiB);
    p.xb = (bf16_t*)take(64 * MiB); p.zb = (bf16_t*)take(96 * MiB); p.cB = (bf16_t*)take(64 * MiB); p.hb = (bf16_t*)take(64 * MiB);
    (void)hipMemsetAsync(p.bar, 0, XCD_BAR_WORDS * 4, stream);
    hipLaunchKernelGGL(fwd_mega, dim3(grid_blocks), dim3(512), MEGA_LDS_BYTES, stream, p);
}
```

```cpp
#include <hip/hip_runtime.h>
#include <stdint.h>
#include <type_traits>

typedef unsigned short bf16_t;
typedef short bf16x8 __attribute__((ext_vector_type(8)));
typedef float f32x4 __attribute__((ext_vector_type(4)));
typedef unsigned u32x4 __attribute__((ext_vector_type(4)));
typedef unsigned u32x2 __attribute__((ext_vector_type(2)));
typedef unsigned u32x3 __attribute__((ext_vector_type(3)));
#define ROWB 768
typedef __bf16 bf2_t __attribute__((ext_vector_type(2)));
#define LAS __attribute__((address_space(3)))

#define T_TOK 32768
#define D_MODEL 1024
#define D_IN 1536
#define SEQ 2048
#define NEXP 16384
#define EPS 1e-6f

struct Params {
    const float *x, *norm1_g, *w_in, *pool_w, *pool_scale, *sgu_norm_g, *sgu_w, *sgu_b, *w_out, *norm2_g, *peer_wq, *peer_keys, *peer_u, *peer_v, *final_g;
    float* out;
    bf16_t *winT, *woutT, *wqT, *poolT, *wsM, *keysB;
    unsigned char *u8, *v8;
    float *su, *sv;
    float *rstd1;
    bf16_t *xb, *zb, *cB, *hb;
    int* idx; float* gate; float* coef;
    unsigned* bar;
};

__device__ __forceinline__ int tid_opaque() { int t = (int)threadIdx.x; asm volatile("" : "+v"(t)); return t; }
__device__ __forceinline__ unsigned short f2bf(float f) {
    unsigned u = __float_as_uint(f);
    u += 0x7fffu + ((u >> 16) & 1u);
    return (unsigned short)(u >> 16);
}
__device__ __forceinline__ float bf2f(unsigned short h) { return __uint_as_float(((unsigned)h) << 16); }
__device__ __forceinline__ unsigned pack2(float a, float b) { return (unsigned)f2bf(a) | ((unsigned)f2bf(b) << 16); }
__device__ __forceinline__ float bflo(unsigned w) { return __uint_as_float(w << 16); }
__device__ __forceinline__ float bfhi(unsigned w) { return __uint_as_float(w & 0xffff0000u); }
__device__ __forceinline__ float gelu_t(float x) {
    const float y = 1.5957691216057308f * (x + 0.044715f * x * x * x);
    return x * __builtin_amdgcn_rcpf(1.0f + __expf(-y));
}
__device__ __forceinline__ float wave_sum(float v) {
#pragma unroll
    for (int o = 32; o >= 1; o >>= 1) v += __shfl_xor(v, o);
    return v;
}
__device__ __forceinline__ float wave_max(float v) {
#pragma unroll
    for (int o = 32; o >= 1; o >>= 1) v = fmaxf(v, __shfl_xor(v, o));
    return v;
}

#define GEMM_LDS_BYTES (2 * 128 * 144)
__device__ __forceinline__ void transpose_tile(const int tid, const float* __restrict__ src, bf16_t* __restrict__ dst, int R, int C, const float* __restrict__ rscale, int tile, float* lds) {
    const int tilesC = C / 64, tr = tile / tilesC, tc = tile % tilesC;
    const int ty = tid >> 6, tx = tid & 63;
    __syncthreads();
#pragma unroll
    for (int i = 0; i < 16; ++i) {
        const int r = ty + 4 * i;
        float v = src[(size_t)(tr * 64 + r) * C + tc * 64 + tx];
        if (rscale) v *= rscale[tr * 64 + r];
        lds[r * 65 + tx] = v;
    }
    __syncthreads();
#pragma unroll
    for (int i = 0; i < 16; ++i) {
        const int c = ty + 4 * i;
        dst[(size_t)(tc * 64 + c) * R + tr * 64 + tx] = f2bf(lds[tx * 65 + c]);
    }
}

__device__ void phase_prep(const Params& p, char* lds) {
    const int tidx_ = tid_opaque();
    const int nb = gridDim.x, b = blockIdx.x, tid = tidx_;
    const int half = tid >> 8, ht = tid & 255, nh = 2 * nb, hb2 = 2 * b + half;
    float* fl = (float*)(lds + half * (64 * 65 * 4));
    for (int t = hb2; t < 16 * 24; t += nh) transpose_tile(ht, p.w_in, p.winT, 1024, 1536, p.norm1_g, t, fl);
    for (int t = hb2; t < 16 * 16; t += nh) transpose_tile(ht, p.w_out, p.woutT, 1024, 1024, nullptr, t, fl);
    for (int t = hb2; t < 16 * 32; t += nh) transpose_tile(ht, p.peer_wq, p.wqT, 1024, 2048, p.norm2_g, t, fl);
    for (int t = hb2; t < 16; t += nh) transpose_tile(ht, p.pool_w + (size_t)(t >> 2) * 16384, p.poolT + (size_t)(t >> 2) * 16384, 128, 128, nullptr, t & 3, fl);
    const size_t gtid = (size_t)b * blockDim.x + tid, gsz = (size_t)nb * blockDim.x;
    for (size_t i = gtid; i < 4 * 128 * 128; i += gsz) {
        const int j = (int)(i & 127), ii = (int)((i >> 7) & 127);
        const bool keep = (j >> 6) <= (ii >> 6);
        p.wsM[i] = keep ? f2bf(p.sgu_w[i]) : (bf16_t)0;
    }
    for (size_t o = gtid; o < 2 * 8 * 128 * 128; o += gsz) {
        const int j = (int)(o & 7), ln = (int)((o >> 3) & 63), nb = (int)((o >> 9) & 7), kk = (int)((o >> 12) & 3), ph = (int)(o >> 14);
        p.keysB[o] = f2bf(p.peer_keys[(size_t)ph * 16384 + (size_t)(16 * nb + (ln & 15)) * 128 + 32 * kk + 8 * (ln >> 4) + j]);
    }
    {
        const int wave = (b * blockDim.x + tid) >> 6, nwaves = (nb * blockDim.x) >> 6, lane = tid & 63;
        float g16[16];
#pragma unroll
        for (int i = 0; i < 4; ++i) { const float4 g = ((const float4*)(p.norm2_g + lane * 16))[i]; g16[4 * i] = g.x; g16[4 * i + 1] = g.y; g16[4 * i + 2] = g.z; g16[4 * i + 3] = g.w; }
        auto quant_row = [&](const float (&f)[16], unsigned char* dst, float* scale_out) {
            float am = 0.f;
#pragma unroll
            for (int j = 0; j < 16; ++j) am = fmaxf(am, fabsf(f[j]));
            am = wave_max(am);
            const float inv = am > 0.f ? 31.0f / am : 0.f;
            int q[16];
#pragma unroll
            for (int j = 0; j < 16; ++j) q[j] = (int)rintf(f[j] * inv) + 32;
            u32x3 o;
#pragma unroll
            for (int i = 0; i < 3; ++i) {
                unsigned w = 0;
#pragma unroll
                for (int k = 0; k < 4; ++k) w |= (unsigned)(q[4 * i + k] | (((q[12 + k] >> (2 * i)) & 3) << 6)) << (8 * k);
                o[i] = w;
            }
            *(u32x3*)(dst + lane * 12) = o;
            if (lane == 0) *scale_out = am * (1.0f / 31.0f);
        };
        for (int e = wave; e < NEXP; e += nwaves) {
            const float4* su4 = (const float4*)(p.peer_u + (size_t)e * D_MODEL + lane * 16);
            const float4* sv4 = (const float4*)(p.peer_v + (size_t)e * D_MODEL + lane * 16);
            float4 a4[4], b4[4];
#pragma unroll
            for (int i = 0; i < 4; ++i) { a4[i] = su4[i]; b4[i] = sv4[i]; }
            float fu[16], fv[16];
#pragma unroll
            for (int i = 0; i < 4; ++i) {
                fu[4 * i] = a4[i].x * g16[4 * i]; fu[4 * i + 1] = a4[i].y * g16[4 * i + 1]; fu[4 * i + 2] = a4[i].z * g16[4 * i + 2]; fu[4 * i + 3] = a4[i].w * g16[4 * i + 3];
                fv[4 * i] = b4[i].x; fv[4 * i + 1] = b4[i].y; fv[4 * i + 2] = b4[i].z; fv[4 * i + 3] = b4[i].w;
            }
            {
                float am = 0.f;
#pragma unroll
                for (int j = 0; j < 16; ++j) am = fmaxf(am, fabsf(fu[j]));
                am = wave_max(am);
                const float inv = am > 0.f ? 127.0f / am : 0.f;
                u32x4 o;
#pragma unroll
                for (int i = 0; i < 4; ++i) {
                    unsigned w = 0;
#pragma unroll
                    for (int k = 0; k < 4; ++k) w |= (unsigned)(((int)rintf(fu[4 * i + k] * inv)) & 0xff) << (8 * k);
                    o[i] = w;
                }
                *(u32x4*)(p.u8 + (size_t)e * D_MODEL + lane * 16) = o;
                if (lane == 0) p.su[e] = am * (1.0f / 127.0f);
            }
            quant_row(fv, p.v8 + (size_t)e * ROWB, p.sv + e);
        }
    }
    const int wave = (b * blockDim.x + tid) >> 6, nwaves = (nb * blockDim.x) >> 6, lane = tid & 63;
    for (int t = wave; t < T_TOK; t += 2 * nwaves) {
        const int t1 = t + nwaves; const bool two = t1 < T_TOK;
        const float4* xr0 = (const float4*)(p.x + (size_t)t * D_MODEL);
        const float4* xr1 = (const float4*)(p.x + (size_t)(two ? t1 : t) * D_MODEL);
        float4 v0[4], v1[4];
#pragma unroll
        for (int i = 0; i < 4; ++i) { v0[i] = xr0[lane + 64 * i]; v1[i] = xr1[lane + 64 * i]; }
        float s0 = 0.f, s1 = 0.f;
#pragma unroll
        for (int i = 0; i < 4; ++i) {
            s0 += v0[i].x * v0[i].x + v0[i].y * v0[i].y + v0[i].z * v0[i].z + v0[i].w * v0[i].w;
            s1 += v1[i].x * v1[i].x + v1[i].y * v1[i].y + v1[i].z * v1[i].z + v1[i].w * v1[i].w;
            uint2 o; o.x = pack2(v0[i].x, v0[i].y); o.y = pack2(v0[i].z, v0[i].w);
            ((uint2*)(p.xb + (size_t)t * D_MODEL))[lane + 64 * i] = o;
            if (two) { uint2 o1; o1.x = pack2(v1[i].x, v1[i].y); o1.y = pack2(v1[i].z, v1[i].w); ((uint2*)(p.xb + (size_t)t1 * D_MODEL))[lane + 64 * i] = o1; }
        }
        s0 = wave_sum(s0); s1 = wave_sum(s1);
        if (lane == 0) { p.rstd1[t] = rsqrtf(s0 * (1.0f / D_MODEL) + EPS); if (two) p.rstd1[t1] = rsqrtf(s1 * (1.0f / D_MODEL) + EPS); }
    }
}

typedef short s16x4 __attribute__((ext_vector_type(4)));
template <class Epi>
__device__ __forceinline__ void gemm128_sgu(const int tid, const bf16_t* __restrict__ A, const bf16_t* __restrict__ V  ,
                                            const float* __restrict__ lnm, const float* __restrict__ lnr, const float* __restrict__ gch, char* lds, const Epi& epi) {
    const int lane = tid & 63, wid = tid >> 6, wr = wid >> 1, wc = wid & 1, fr = lane & 15, fq = lane >> 4;
    constexpr int PITCH = 144, P2 = 288;
    char* sA = lds; char* sB = lds + 128 * PITCH;
    f32x4 acc[4][4];
#pragma unroll
    for (int m = 0; m < 4; ++m)
#pragma unroll
        for (int n = 0; n < 4; ++n) acc[m][n] = (f32x4){0.f, 0.f, 0.f, 0.f};
    u32x4 ra[4], rb[4]; float rm[4], rr[4];
    const int lrow = tid >> 3, lch = tid & 7;
    const int btok = tid >> 4, bch = tid & 15;
    const bf16_t* ga = A + (size_t)lrow * 128 + lch * 8;
    const bf16_t* gb = V + (size_t)btok * D_IN + bch * 8;
    float g8[8];
    { const float4 g0 = *(const float4*)(gch + bch * 8), g1 = *(const float4*)(gch + bch * 8 + 4); g8[0] = g0.x; g8[1] = g0.y; g8[2] = g0.z; g8[3] = g0.w; g8[4] = g1.x; g8[5] = g1.y; g8[6] = g1.z; g8[7] = g1.w; }
#pragma unroll
    for (int j = 0; j < 4; ++j) { ra[j] = *(const u32x4*)(ga + (size_t)(32 * j) * 128); rb[j] = *(const u32x4*)(gb + (size_t)(16 * j) * D_IN); rm[j] = lnm[btok + 16 * j]; rr[j] = lnr[btok + 16 * j]; }
    for (int k0 = 0; k0 < 128; k0 += 64) {
        __syncthreads();
#pragma unroll
        for (int j = 0; j < 4; ++j) {
            *(u32x4*)(sA + (lrow + 32 * j) * PITCH + lch * 16) = ra[j];
            u32x4 o;
#pragma unroll
            for (int i = 0; i < 4; ++i) {
                const unsigned w = rb[j][i];
                o[i] = pack2((bflo(w) - rm[j]) * rr[j] * g8[2 * i], (bfhi(w) - rm[j]) * rr[j] * g8[2 * i + 1]);
            }
            *(u32x4*)(sB + (btok + 16 * j) * P2 + bch * 16) = o;
        }
        __syncthreads();
        if (k0 + 64 < 128) {
#pragma unroll
            for (int j = 0; j < 4; ++j) { ra[j] = *(const u32x4*)(ga + (size_t)(32 * j) * 128 + 64); rb[j] = *(const u32x4*)(gb + (size_t)(64 + 16 * j) * D_IN); rm[j] = lnm[64 + btok + 16 * j]; rr[j] = lnr[64 + btok + 16 * j]; }
        }
#pragma unroll
        for (int kk = 0; kk < 2; ++kk) {
            bf16x8 af[4], bfr[4];
#pragma unroll
            for (int m = 0; m < 4; ++m) af[m] = *(const bf16x8*)(sA + (wr * 64 + m * 16 + fr) * PITCH + (kk * 32 + fq * 8) * 2);
#pragma unroll
            for (int n = 0; n < 4; ++n) {
                const char* bp = sB + (kk * 32 + fq * 8 + (fr >> 2)) * P2 + (wc * 64 + n * 16 + 4 * (fr & 3)) * 2;
                const s16x4 lo = __builtin_amdgcn_ds_read_tr16_b64_v4i16((LAS s16x4*)(bp));
                const s16x4 hi = __builtin_amdgcn_ds_read_tr16_b64_v4i16((LAS s16x4*)(bp + 4 * P2));
                bfr[n] = (bf16x8){lo[0], lo[1], lo[2], lo[3], hi[0], hi[1], hi[2], hi[3]};
            }
#pragma unroll
            for (int m = 0; m < 4; ++m)
#pragma unroll
                for (int n = 0; n < 4; ++n) acc[m][n] = __builtin_amdgcn_mfma_f32_16x16x32_bf16(bfr[n], af[m], acc[m][n], 0, 0, 0);
        }
    }
#pragma unroll
    for (int m = 0; m < 4; ++m)
#pragma unroll
        for (int n = 0; n < 4; ++n) epi(wr * 64 + m * 16 + fr, wc * 64 + n * 16 + fq * 4, acc[m][n]);
}

#define PT_PITCH 272
#define MIXH_LDS (2 * 128 * PT_PITCH + 1024)
template <int W, class Epi>
__device__ __forceinline__ void pool_tile(const int tid, const bf16_t* __restrict__ zb0  , int pos0,
                                          const bf16_t* __restrict__ Bt, char* lds, const Epi& epi) {
    const int lane = tid & 63, wid = tid >> 6, wr = wid >> 1, wc = wid & 1, fr = lane & 15, fq = lane >> 4;
    char* sA = lds; char* sB = lds + 128 * PT_PITCH;
    __syncthreads();
#pragma unroll
    for (int j = 0; j < 8; ++j) { const int id = tid + 256 * j, row = id >> 4, ch = id & 15; *(u32x4*)(sB + row * PT_PITCH + ch * 16) = *(const u32x4*)(Bt + (size_t)row * 128 + ch * 8); }
    {
        const int seg = tid >> 5, hc = tid & 31, r0 = seg * 16;
        const bool at_start = (pos0 & (SEQ - 1)) == 0;
        const bf16_t* zp = zb0 + hc * 4;
        u32x2 v[W + 16];
#pragma unroll
        for (int i = 0; i < W + 16; ++i) { const int rr = r0 - W + i; const bool ok = !(at_start && rr < 0); v[i] = *(const u32x2*)(zp + (ptrdiff_t)(ok ? rr : 0) * D_IN); }
        float sm[4] = {0.f, 0.f, 0.f, 0.f};
#pragma unroll
        for (int i = 1; i <= W; ++i) {
            const float m = (at_start && (r0 - W + i) < 0) ? 0.f : 1.f;
            sm[0] += m * bflo(v[i].x); sm[1] += m * bfhi(v[i].x); sm[2] += m * bflo(v[i].y); sm[3] += m * bfhi(v[i].y);
        }
#pragma unroll
        for (int o = 0; o < 16; ++o) {
            if (o > 0) {
                const float md = (at_start && (r0 + o - W) < 0) ? 0.f : 1.f;
                sm[0] += bflo(v[W + o].x) - md * bflo(v[o].x); sm[1] += bfhi(v[W + o].x) - md * bfhi(v[o].x);
                sm[2] += bflo(v[W + o].y) - md * bflo(v[o].y); sm[3] += bfhi(v[W + o].y) - md * bfhi(v[o].y);
            }
            const int pos = (pos0 + r0 + o) & (SEQ - 1);
            const float rn = 1.0f / (float)((pos + 1 < W) ? pos + 1 : W);
            u32x2 ov;
            ov.x = pack2(sm[0] * rn - bflo(v[W + o].x), sm[1] * rn - bfhi(v[W + o].x));
            ov.y = pack2(sm[2] * rn - bflo(v[W + o].y), sm[3] * rn - bfhi(v[W + o].y));
            *(u32x2*)(sA + (r0 + o) * PT_PITCH + hc * 8) = ov;
        }
    }
    __syncthreads();
    f32x4 acc[4][4];
#pragma unroll
    for (int m = 0; m < 4; ++m)
#pragma unroll
        for (int n = 0; n < 4; ++n) acc[m][n] = (f32x4){0.f, 0.f, 0.f, 0.f};
#pragma unroll
    for (int kk = 0; kk < 4; ++kk) {
        bf16x8 af[4], bfr[4];
#pragma unroll
        for (int m = 0; m < 4; ++m) af[m] = *(const bf16x8*)(sA + (wr * 64 + m * 16 + fr) * PT_PITCH + (kk * 32 + fq * 8) * 2);
#pragma unroll
        for (int n = 0; n < 4; ++n) bfr[n] = *(const bf16x8*)(sB + (wc * 64 + n * 16 + fr) * PT_PITCH + (kk * 32 + fq * 8) * 2);
#pragma unroll
        for (int m = 0; m < 4; ++m)
#pragma unroll
            for (int n = 0; n < 4; ++n) acc[m][n] = __builtin_amdgcn_mfma_f32_16x16x32_bf16(bfr[n], af[m], acc[m][n], 0, 0, 0);
    }
#pragma unroll
    for (int m = 0; m < 4; ++m)
#pragma unroll
        for (int n = 0; n < 4; ++n) epi(wr * 64 + m * 16 + fr, wc * 64 + n * 16 + fq * 4, acc[m][n]);
}

__device__ void phase_mix_gemm(const Params& p, char* lds) {
    const int tidx_ = tid_opaque();
    const int npool = (T_TOK / 128) * 4, nsgu = (T_TOK / 128) * 4;
    const int half = tidx_ >> 8, ht = tidx_ & 255; lds += half * MIXH_LDS;
    for (int tile = 2 * blockIdx.x + half; tile < npool + nsgu; tile += 2 * gridDim.x) {
        if (tile < npool) {
            const int tm = tile >> 2, g = tile & 3;
            const float* ps = p.pool_scale + g * 128; bf16_t* co = p.cB + (size_t)tm * 128 * D_MODEL + g * 128;
            const bf16_t* z0 = p.zb + (size_t)tm * 128 * D_IN + g * 128; const bf16_t* bt = p.poolT + (size_t)g * 16384;
            auto epi = [&](int r, int c, f32x4 v) {
                const float4 sc = *(const float4*)(ps + c);
                uint2 o; o.x = pack2(v[0] * sc.x, v[1] * sc.y); o.y = pack2(v[2] * sc.z, v[3] * sc.w);
                *(uint2*)(co + (size_t)r * D_MODEL + c) = o;
            };
            if (g == 0) pool_tile<2>(ht, z0, tm * 128, bt, lds, epi); else if (g == 1) pool_tile<4>(ht, z0, tm * 128, bt, lds, epi);
            else if (g == 2) pool_tile<8>(ht, z0, tm * 128, bt, lds, epi); else pool_tile<16>(ht, z0, tm * 128, bt, lds, epi);
        } else {
            const int t2 = tile - npool, blk = t2 >> 2, h = t2 & 3;
            float* stm = (float*)(lds + GEMM_LDS_BYTES); float* str = stm + 128;
            __syncthreads();
            {
                const int tok = ht >> 1, hh = ht & 1;
                const u32x4* vp = (const u32x4*)(p.zb + (size_t)(blk * 128 + tok) * D_IN + 1024 + hh * 256);
                float s1 = 0.f, s2 = 0.f;
#pragma unroll 8
                for (int i = 0; i < 32; ++i) {
                    const u32x4 v = vp[i];
#pragma unroll
                    for (int k = 0; k < 4; ++k) { const float a = bflo(v[k]), c = bfhi(v[k]); s1 += a + c; s2 += a * a + c * c; }
                }
                s1 += __shfl_xor(s1, 1); s2 += __shfl_xor(s2, 1);
                const float mean = s1 * (1.0f / 512.0f), var = fmaxf(s2 * (1.0f / 512.0f) - mean * mean, 0.f);
                if (hh == 0) { stm[tok] = mean; str[tok] = rsqrtf(var + EPS); }
            }
            __syncthreads();
            const float* sb = p.sgu_b + h * 128; const bf16_t* uo = p.zb + (size_t)blk * 128 * D_IN + 512 + h * 128;
            bf16_t* co = p.cB + (size_t)blk * 128 * D_MODEL + 512 + h * 128;
            gemm128_sgu(ht, p.wsM + (size_t)h * 16384, p.zb + (size_t)blk * 128 * D_IN + 1024 + h * 128, stm, str, p.sgu_norm_g + h * 128, lds,
                    [&](int r, int c, f32x4 v) {
                        const float bb = sb[r];
                        const uint2 uu = *(const uint2*)(uo + (size_t)r * D_IN + c);
                        uint2 o;
                        o.x = pack2((v[0] + bb) * bflo(uu.x), (v[1] + bb) * bfhi(uu.x));
                        o.y = pack2((v[2] + bb) * bflo(uu.y), (v[3] + bb) * bfhi(uu.y));
                        *(uint2*)(co + (size_t)r * D_MODEL + c) = o;
                    });
        }
    }
}

__device__ __forceinline__ int wave_sum_i_uniform(int s) {
    s += __builtin_amdgcn_update_dpp(0, s, 0xB1, 0xf, 0xf, false);
    s += __builtin_amdgcn_update_dpp(0, s, 0x4E, 0xf, 0xf, false);
    s += __builtin_amdgcn_update_dpp(0, s, 0x141, 0xf, 0xf, false);
    s += __builtin_amdgcn_update_dpp(0, s, 0x140, 0xf, 0xf, false);
    return __builtin_amdgcn_readlane(s, 0) + __builtin_amdgcn_readlane(s, 16) + __builtin_amdgcn_readlane(s, 32) + __builtin_amdgcn_readlane(s, 48);
}
__constant__ unsigned char kComb[64] = {
    0x00,0x01,0x02,0x03,0x04,0x05,0x06,0x07,0x08,0x09,0x0a,0x0b,0x0c,0x0d,0x0e,0x0f,
    0x10,0x11,0x12,0x13,0x14,0x15,0x16,0x17,
    0x20,0x21,0x22,0x23,0x24,
    0x30,0x31,0x32,0x33,
    0x40,0x41,0x42,
    0x50,0x51,
    0x60,0x61,
    0x70,0x71,
    0x80,0x90,0xa0,0xb0,0xc0,0xd0,0xe0,0xf0,
    0xff,0xff,0xff,0xff,0xff,0xff,0xff,0xff,0xff,0xff,0xff,0xff,0xff,0xff};

template <int CTRL> __device__ __forceinline__ int dpp_i(int v) { return __builtin_amdgcn_update_dpp(0, v, CTRL, 0xf, 0xf, false); }
__device__ __forceinline__ int row_allmax_i(int v) {
    v = max(v, dpp_i<0x128>(v)); v = max(v, dpp_i<0x124>(v)); v = max(v, dpp_i<0x122>(v)); v = max(v, dpp_i<0x121>(v));
    return v;
}
__device__ __forceinline__ float row_allsum_f(float v) {
    v += __int_as_float(dpp_i<0x128>(__float_as_int(v))); v += __int_as_float(dpp_i<0x124>(__float_as_int(v)));
    v += __int_as_float(dpp_i<0x122>(__float_as_int(v))); v += __int_as_float(dpp_i<0x121>(__float_as_int(v)));
    return v;
}
__device__ __forceinline__ int f2key(float f) { const int b = __float_as_int(f); return b ^ ((b >> 31) & 0x7fffffff); }
__device__ __forceinline__ float key2f(int k) { return __int_as_float(k ^ ((k >> 31) & 0x7fffffff)); }
#define KEY_MIN ((int)0x80000000)
#define CE(a, b) { const int hi_ = max(a, b), lo_ = min(a, b); a = hi_; b = lo_; }
__device__ __forceinline__ int top16_rows(int (&k)[8], int l15) {
    CE(k[0], k[1]) CE(k[2], k[3]) CE(k[4], k[5]) CE(k[6], k[7])
    CE(k[0], k[2]) CE(k[1], k[3]) CE(k[4], k[6]) CE(k[5], k[7])
    CE(k[1], k[2]) CE(k[5], k[6])
    CE(k[0], k[4]) CE(k[1], k[5]) CE(k[2], k[6]) CE(k[3], k[7])
    CE(k[2], k[4]) CE(k[3], k[5])
    CE(k[1], k[2]) CE(k[3], k[4]) CE(k[5], k[6])
    int res = KEY_MIN;
#pragma unroll
    for (int r = 0; r < 16; ++r) {
        const int m = row_allmax_i(k[0]);
        const bool own = (k[0] == m);
#pragma unroll
        for (int j = 0; j < 7; ++j) k[j] = own ? k[j + 1] : k[j];
        k[7] = own ? KEY_MIN : k[7];
        res = (l15 == r) ? m : res;
    }
    return res;
}
__device__ __forceinline__ void combine16(int A, int B, const int (&cbv)[4], int lane, int l15, int& eid_out, float& gate_out) {
    const int rowbase = lane & 48;
    int ck[4], eid[4];
#pragma unroll
    for (int c = 0; c < 4; ++c) {
        const int ci = (cbv[c] >> 4) & 15, cj = cbv[c] & 15;
        const int ka = __builtin_amdgcn_ds_bpermute((rowbase + ci) << 2, A);
        const int kb = __builtin_amdgcn_ds_bpermute((rowbase + cj) << 2, B);
        const float sm = key2f(ka & ~127) + key2f(kb & ~127);
        eid[c] = ((127 - (ka & 127)) << 7) | (127 - (kb & 127));
        ck[c] = (cbv[c] != 0xff) ? ((f2key(sm) & ~63) | (63 - (4 * l15 + c))) : KEY_MIN;
    }
    CE(ck[0], ck[1]) CE(ck[2], ck[3]) CE(ck[0], ck[2]) CE(ck[1], ck[3]) CE(ck[1], ck[2])
    int res = KEY_MIN;
#pragma unroll
    for (int r = 0; r < 16; ++r) {
        const int m = row_allmax_i(ck[0]);
        const bool own = (ck[0] == m);
        ck[0] = own ? ck[1] : ck[0]; ck[1] = own ? ck[2] : ck[1]; ck[2] = own ? ck[3] : ck[2]; ck[3] = own ? KEY_MIN : ck[3];
        res = (l15 == r) ? m : res;
    }
    const int slot = 63 - (res & 63);
    const int src = (rowbase + (slot >> 2)) << 2;
    const int e0 = __builtin_amdgcn_ds_bpermute(src, eid[0]), e1 = __builtin_amdgcn_ds_bpermute(src, eid[1]);
    const int e2 = __builtin_amdgcn_ds_bpermute(src, eid[2]), e3 = __builtin_amdgcn_ds_bpermute(src, eid[3]);
    const int sel = slot & 3;
    eid_out = sel == 0 ? e0 : (sel == 1 ? e1 : (sel == 2 ? e2 : e3));
    gate_out = key2f(res & ~63);
}

__device__ __forceinline__ int reduce16_rows(const int (&part)[16], bool b3, bool b2, bool b1, bool b0b) {
    int r8[8], r4[4], r2[2];
#pragma unroll
    for (int k = 0; k < 8; ++k) { const int keep = b3 ? part[8 + k] : part[k], send = b3 ? part[k] : part[8 + k]; r8[k] = keep + __builtin_amdgcn_update_dpp(0, send, 0x140, 0xf, 0xf, false); }
#pragma unroll
    for (int k = 0; k < 4; ++k) { const int keep = b2 ? r8[4 + k] : r8[k], send = b2 ? r8[k] : r8[4 + k]; r4[k] = keep + __builtin_amdgcn_update_dpp(0, send, 0x141, 0xf, 0xf, false); }
#pragma unroll
    for (int k = 0; k < 2; ++k) { const int keep = b1 ? r4[2 + k] : r4[k], send = b1 ? r4[k] : r4[2 + k]; r2[k] = keep + __builtin_amdgcn_update_dpp(0, send, 0x4E, 0xf, 0xf, false); }
    const int keep = b0b ? r2[1] : r2[0], send = b0b ? r2[0] : r2[1];
    int r1 = keep + __builtin_amdgcn_update_dpp(0, send, 0xB1, 0xf, 0xf, false);
    r1 += __shfl_xor(r1, 16); r1 += __shfl_xor(r1, 32);
    return r1;
}
#define TS_WBYTES (16384 + 128)
__device__ void phase_peer_dots(const Params& p, char* lds) {
    const int tidx_ = tid_opaque();
    const int lane = tidx_ & 63, wid = __builtin_amdgcn_readfirstlane((int)(tidx_ >> 6)), l15 = lane & 15;
    const bool b3 = (lane & 8) != 0, b2 = (lane & 4) != 0, b1 = (lane & 2) != 0, b0b = (lane & 1) != 0;
    const int gw = blockIdx.x * (blockDim.x >> 6) + wid, ngw = gridDim.x * (blockDim.x >> 6);
    char* wl = lds + wid * TS_WBYTES;
    unsigned* list = (unsigned*)wl; int* dotsl = (int*)(wl + 4096); char* hql = wl + 8192; int* tks = (int*)(wl + 16384);
    const unsigned lane16 = (unsigned)lane * 16u;
    for (int tb = gw * 8; tb < T_TOK; tb += ngw * 8) {
#pragma unroll 1
        for (int j0 = 0; j0 < 8; j0 += 4) {
            u32x4 hraw[4][2];
#pragma unroll
            for (int jj = 0; jj < 4; ++jj) { const u32x4* hr = (const u32x4*)(p.hb + (size_t)(tb + j0 + jj) * D_MODEL); hraw[jj][0] = hr[2 * lane]; hraw[jj][1] = hr[2 * lane + 1]; }
#pragma unroll
            for (int jj = 0; jj < 4; ++jj) {
                const int j = j0 + jj;
                const u32x4 a = hraw[jj][0], c = hraw[jj][1];
                const float f[16] = {bflo(a.x), bfhi(a.x), bflo(a.y), bfhi(a.y), bflo(a.z), bfhi(a.z), bflo(a.w), bfhi(a.w),
                                     bflo(c.x), bfhi(c.x), bflo(c.y), bfhi(c.y), bflo(c.z), bfhi(c.z), bflo(c.w), bfhi(c.w)};
                float ss = 0.f, am = 0.f;
#pragma unroll
                for (int k = 0; k < 16; ++k) { ss += f[k] * f[k]; am = fmaxf(am, fabsf(f[k])); }
                ss = wave_sum(ss); am = wave_max(am);
                const float inv = am > 0.f ? 127.0f / am : 0.f;
                u32x4 o; int hsum = 0;
#pragma unroll
                for (int i = 0; i < 4; ++i) {
                    unsigned w = 0;
#pragma unroll
                    for (int k = 0; k < 4; ++k) { const int qv = (int)rintf(f[4 * i + k] * inv); hsum += qv; w |= (unsigned)(qv & 0xff) << (8 * k); }
                    o[i] = w;
                }
                *(u32x4*)(hql + j * 1024 + lane * 16) = o;
                hsum = wave_sum_i_uniform(hsum);
                const float r2 = rsqrtf(ss * (1.0f / D_MODEL) + EPS);
                if (lane == 0) { tks[4 * j] = hsum; tks[4 * j + 1] = __float_as_int(am * (1.0f / 127.0f) * r2); tks[4 * j + 2] = __float_as_int(r2); }
            }
        }
        int idv[8][2];
#pragma unroll
        for (int j = 0; j < 8; ++j) { const int* ir = p.idx + (size_t)(tb + j) * 128; idv[j][0] = ir[lane]; idv[j][1] = ir[64 + lane]; }
#pragma unroll 1
        for (int x = 0; x < 8; ++x) {
            int n = 0;
#pragma unroll
            for (int j = 0; j < 8; ++j)
#pragma unroll
                for (int r = 0; r < 2; ++r) {
                    const int e = idv[j][r];
                    const bool in = (e >> 11) == x;
                    const unsigned long long mk = __ballot(in);
                    const int rank = (int)__builtin_amdgcn_mbcnt_hi((unsigned)(mk >> 32), __builtin_amdgcn_mbcnt_lo((unsigned)mk, 0u));
                    if (in) list[n + rank] = ((unsigned)j << 21) | ((unsigned)(r * 64 + lane) << 14) | (unsigned)e;
                    n += (int)__builtin_popcountll(mk);
                }
            asm volatile("s_waitcnt lgkmcnt(0)" ::: "memory");
            u32x4 ua[16], ubf[16]; int enta = 0, entb = 0;
            auto issue = [&](int b0, u32x4 (&uu)[16], int& entv) {
                const int i = (b0 + l15 < n) ? b0 + l15 : n - 1;
                entv = (int)list[i];
#pragma unroll
                for (int j = 0; j < 16; ++j) { const int e = __builtin_amdgcn_readlane(entv, j) & 0x3fff; uu[j] = *(const u32x4*)(p.u8 + (size_t)e * D_MODEL + lane16); }
            };
            auto reduce = [&](int b0, const u32x4 (&uu)[16], int entv) {
                int part[16];
#pragma unroll
                for (int j = 0; j < 16; ++j) {
                    const int tl = __builtin_amdgcn_readlane(entv, j) >> 21;
                    const u32x4 hqv = *(const u32x4*)(hql + tl * 1024 + lane * 16);
                    int sacc = __builtin_amdgcn_sdot4((int)uu[j].x, (int)hqv.x, 0, false);
                    sacc = __builtin_amdgcn_sdot4((int)uu[j].y, (int)hqv.y, sacc, false);
                    sacc = __builtin_amdgcn_sdot4((int)uu[j].z, (int)hqv.z, sacc, false);
                    part[j] = __builtin_amdgcn_sdot4((int)uu[j].w, (int)hqv.w, sacc, false);
                }
                const int r1 = reduce16_rows(part, b3, b2, b1, b0b);
                if (lane < 16 && b0 + lane < n) dotsl[((unsigned)entv >> 21) * 128 + (((unsigned)entv >> 14) & 127u)] = r1;
            };
            if (n > 0) issue(0, ua, enta);
            for (int b0 = 0; b0 < n; b0 += 32) {
                if (b0 + 16 < n) issue(b0 + 16, ubf, entb);
                reduce(b0, ua, enta);
                if (b0 + 16 < n) {
                    if (b0 + 32 < n) issue(b0 + 32, ua, enta);
                    reduce(b0 + 16, ubf, entb);
                }
            }
            asm volatile("s_waitcnt lgkmcnt(0)" ::: "memory");
        }
#pragma unroll
        for (int j = 0; j < 8; ++j) {
            const int hs_t = tks[4 * j]; const float cs_t = __int_as_float(tks[4 * j + 1]), r2_t = __int_as_float(tks[4 * j + 2]);
            const float* gr = p.gate + (size_t)(tb + j) * 128; float* cr = p.coef + (size_t)(tb + j) * 128;
#pragma unroll
            for (int r = 0; r < 2; ++r) {
                const int e = idv[j][r];
                const float sc = gr[r * 64 + lane] * r2_t;
                const float ex = __expf(sc - key2f(row_allmax_i(f2key(sc))));
                const float gt = ex / row_allsum_f(ex);
                const float dotf = (float)dotsl[j * 128 + r * 64 + lane] * cs_t * p.su[e];
                cr[r * 64 + lane] = gt * gelu_t(dotf) * p.sv[e];
            }
        }
        asm volatile("s_waitcnt lgkmcnt(0)" ::: "memory");
    }
}

__device__ void phase_gather(const Params& p, char* lds) {
    const int tidx_ = tid_opaque();
    const int wave = __builtin_amdgcn_readfirstlane((int)((blockIdx.x * blockDim.x + tidx_) >> 6)), nwaves = (gridDim.x * blockDim.x) >> 6, lane = tidx_ & 63;
    const unsigned char* vb = p.v8 + lane * 12;
    for (int t = wave; t < T_TOK; t += nwaves) {
        int idr[2]; float coef[2];
        { const int* ir = p.idx + (size_t)t * 128; idr[0] = ir[lane]; idr[1] = ir[64 + lane]; }
        { const float* cr = p.coef + (size_t)t * 128; coef[0] = cr[lane]; coef[1] = cr[64 + lane]; }
        const float cmax = wave_max(fmaxf(fabsf(coef[0]), fabsf(coef[1])));
        const float qs = cmax > 0.f ? 127.0f / cmax : 0.f, cscale = cmax * (1.0f / 127.0f);
        const int cq0 = (int)rintf(coef[0] * qs), cq1 = (int)rintf(coef[1] * qs);
        const int csum_i = wave_sum_i_uniform(cq0 + cq1);
        unsigned cpk[2];
        {
            const int cqs[2] = {cq0, cq1};
#pragma unroll
            for (int hf = 0; hf < 2; ++hf) {
                const int bb = cqs[hf] & 0xff;
                cpk[hf] = (unsigned)__builtin_amdgcn_update_dpp(0, bb, 0x00, 0xf, 0xf, false) | ((unsigned)__builtin_amdgcn_update_dpp(0, bb, 0x55, 0xf, 0xf, false) << 8)
                        | ((unsigned)__builtin_amdgcn_update_dpp(0, bb, 0xAA, 0xf, 0xf, false) << 16) | ((unsigned)__builtin_amdgcn_update_dpp(0, bb, 0xFF, 0xf, 0xf, false) << 24);
            }
        }
        int acc[16];
#pragma unroll
        for (int j = 0; j < 16; ++j) acc[j] = 0;
        {
            u32x3 va[8], vbf[8];
            auto issue = [&](int pb, u32x3 (&vv)[8]) {
#pragma unroll
                for (int q = 0; q < 8; ++q) { const int e = __builtin_amdgcn_readlane(pb < 64 ? idr[0] : idr[1], (pb & 63) + q); vv[q] = *(const u32x3*)(vb + (size_t)e * ROWB); }
            };
            auto axpy = [&](int pb, const u32x3 (&vv)[8]) {
#pragma unroll
                for (int g4 = 0; g4 < 2; ++g4) {
                    const int cqd = __builtin_amdgcn_readlane((int)(pb < 64 ? cpk[0] : cpk[1]), (pb & 63) + 4 * g4);
                    unsigned dd[4][4];
#pragma unroll
                    for (int r = 0; r < 4; ++r) {
                        const unsigned w0 = vv[4 * g4 + r].x, w1 = vv[4 * g4 + r].y, w2 = vv[4 * g4 + r].z;
                        dd[r][0] = w0 & 0x3f3f3f3fu; dd[r][1] = w1 & 0x3f3f3f3fu; dd[r][2] = w2 & 0x3f3f3f3fu;
                        dd[r][3] = ((w0 >> 6) & 0x03030303u) | ((w1 >> 4) & 0x0c0c0c0cu) | ((w2 >> 2) & 0x30303030u);
                    }
#pragma unroll
                    for (int k = 0; k < 4; ++k) {
                        const unsigned p0 = __builtin_amdgcn_perm(dd[1][k], dd[0][k], 0x05010400u), p1 = __builtin_amdgcn_perm(dd[1][k], dd[0][k], 0x07030602u);
                        const unsigned q0 = __builtin_amdgcn_perm(dd[3][k], dd[2][k], 0x05010400u), q1 = __builtin_amdgcn_perm(dd[3][k], dd[2][k], 0x07030602u);
                        const unsigned t0 = __builtin_amdgcn_perm(q0, p0, 0x05040100u), t1 = __builtin_amdgcn_perm(q0, p0, 0x07060302u);
                        const unsigned t2 = __builtin_amdgcn_perm(q1, p1, 0x05040100u), t3 = __builtin_amdgcn_perm(q1, p1, 0x07060302u);
                        acc[4 * k + 0] = __builtin_amdgcn_sdot4((int)t0, cqd, acc[4 * k + 0], false);
                        acc[4 * k + 1] = __builtin_amdgcn_sdot4((int)t1, cqd, acc[4 * k + 1], false);
                        acc[4 * k + 2] = __builtin_amdgcn_sdot4((int)t2, cqd, acc[4 * k + 2], false);
                        acc[4 * k + 3] = __builtin_amdgcn_sdot4((int)t3, cqd, acc[4 * k + 3], false);
                    }
                }
            };
            issue(0, va);
#pragma unroll 1
            for (int pb = 0; pb < 128; pb += 16) {
                issue(pb + 8, vbf);
                axpy(pb, va);
                if (pb + 16 < 128) issue(pb + 16, va);
                axpy(pb + 8, vbf);
            }
        }
        const u32x4* hr = (const u32x4*)(p.hb + (size_t)t * D_MODEL + lane * 16);
        const u32x4 ha = hr[0], hc = hr[1];
        const float hf16[16] = {bflo(ha.x), bfhi(ha.x), bflo(ha.y), bfhi(ha.y), bflo(ha.z), bfhi(ha.z), bflo(ha.w), bfhi(ha.w),
                                bflo(hc.x), bfhi(hc.x), bflo(hc.y), bfhi(hc.y), bflo(hc.z), bfhi(hc.z), bflo(hc.w), bfhi(hc.w)};
        float res[16];
        float ss = 0.f;
#pragma unroll
        for (int j = 0; j < 16; ++j) { res[j] = hf16[j] + cscale * (float)(acc[j] - 32 * csum_i); ss += res[j] * res[j]; }
        ss = wave_sum(ss);
        const float r3 = rsqrtf(ss * (1.0f / D_MODEL) + EPS);
        float* o = p.out + (size_t)t * D_MODEL + lane * 16;
        const float* fg = p.final_g + lane * 16;
#pragma unroll
        for (int i = 0; i < 4; ++i) {
            const float4 g = ((const float4*)fg)[i];
            float4 ov; ov.x = res[4 * i] * r3 * g.x; ov.y = res[4 * i + 1] * r3 * g.y; ov.z = res[4 * i + 2] * r3 * g.z; ov.w = res[4 * i + 3] * r3 * g.w;
            ((float4*)o)[i] = ov;
        }
    }
}

namespace pg8 {
#define PG8_LAS __attribute__((address_space(3)))
constexpr int BM = 256, BK = 64, HALF = 128, HTB = HALF * BK * 2, STAGE_BYTES = 8 * HTB, NXCD = 8, WGM = 8;
__host__ __device__ __forceinline__ int lds_byte(int r, int c) { const int st = (r >> 4) * 2 + (c >> 5), rr = r & 15, cc = c & 31, ob = rr * 64 + cc * 2; return st * 1024 + (ob ^ (((ob >> 9) & 1) << 5)); }
__host__ __device__ __forceinline__ void stage_rc(int b, int& R, int& C) { const int st = b / 1024, sb = b % 1024, swz = sb ^ (((sb >> 9) & 1) << 5); R = (st >> 1) * 16 + swz / 64; C = (st & 1) * 32 + (swz % 64) / 2; }
__host__ __device__ __forceinline__ int perm32(int rho) { const int n = rho >> 4, i = rho & 15; return 8 * (i >> 2) + 4 * n + (i & 3); }
struct Unit { int pm, pn; };
struct Gemm { const bf16_t* A; const bf16_t* Bt; int M, N, K; };
struct StaticOrder {
    int nM, nN, nwg, G, c;
    __host__ __device__ void init(int M, int N, int G_, int c_) { nM = M / BM; nN = N / BM; nwg = nM * nN; G = G_; c = c_; }
    __host__ __device__ bool next(int i, Unit& u) const {
        const long L = (long)i * G + c; if (L >= nwg) return false;
        int wgid = (int)L; { const int q = nwg / NXCD, r = nwg % NXCD, xcd = wgid % NXCD, off = wgid / NXCD; wgid = (xcd < r ? xcd * (q + 1) : r * (q + 1) + (xcd - r) * q) + off; }
        const int nig = WGM * nN, gid = wgid / nig, fm = gid * WGM, gsz = (nM - fm) < WGM ? (nM - fm) : WGM;
        u.pm = fm + ((wgid % nig) % gsz); u.pn = (wgid % nig) / gsz; return true;
    }
    __device__ __forceinline__ void a_ready(const Unit&) const {}
    __device__ __forceinline__ void done(const Unit&) const {}
};
__device__ __forceinline__ unsigned cvt_pk_bf16(float lo, float hi) { unsigned r; asm volatile("v_cvt_pk_bf16_f32 %0, %1, %2" : "=v"(r) : "v"(lo), "v"(hi)); return r; }
struct EpiZ {
    static constexpr bool PERM = true, AFTER_DRAIN = false;
    bf16_t* O; const float* rs;
    __device__ __forceinline__ void operator()(const f32x4 (&acc)[2][2][4][2], const Unit& u, int wr, int wc, int fr, int fq) const {
        const int row0 = u.pm * BM + wr * 64 + fr, col0 = u.pn * BM + wc * 32 + 8 * fq; const bool act = u.pn >= 2;
#pragma unroll
        for (int ai = 0; ai < 2; ++ai)
#pragma unroll
            for (int m = 0; m < 4; ++m) { const int r = row0 + ai * HALF + m * 16; const float sc = rs[r]; bf16_t* rowp = O + (size_t)r * D_IN + col0;
#pragma unroll
                for (int bj = 0; bj < 2; ++bj) { f32x4 v0 = acc[ai][bj][m][0] * sc, v1 = acc[ai][bj][m][1] * sc;
                    if (act) { v0 = (f32x4){gelu_t(v0[0]), gelu_t(v0[1]), gelu_t(v0[2]), gelu_t(v0[3])}; v1 = (f32x4){gelu_t(v1[0]), gelu_t(v1[1]), gelu_t(v1[2]), gelu_t(v1[3])}; }
                    u32x4 w; w.x = cvt_pk_bf16(v0[0], v0[1]); w.y = cvt_pk_bf16(v0[2], v0[3]); w.z = cvt_pk_bf16(v1[0], v1[1]); w.w = cvt_pk_bf16(v1[2], v1[3]);
                    *(u32x4*)(rowp + bj * HALF) = w; } }
    }
};
struct EpiOut {
    static constexpr bool PERM = true, AFTER_DRAIN = false;
    bf16_t* O; const bf16_t* X;
    __device__ __forceinline__ void operator()(const f32x4 (&acc)[2][2][4][2], const Unit& u, int wr, int wc, int fr, int fq) const {
        const int row0 = u.pm * BM + wr * 64 + fr, col0 = u.pn * BM + wc * 32 + 8 * fq;
#pragma unroll
        for (int ai = 0; ai < 2; ++ai)
#pragma unroll
            for (int m = 0; m < 4; ++m) { const size_t off = (size_t)(row0 + ai * HALF + m * 16) * D_MODEL + col0;
#pragma unroll
                for (int bj = 0; bj < 2; ++bj) { const u32x4 xx = *(const u32x4*)(X + off + bj * HALF);
                    const f32x4 v0 = acc[ai][bj][m][0] + (f32x4){bflo(xx.x), bfhi(xx.x), bflo(xx.y), bfhi(xx.y)}, v1 = acc[ai][bj][m][1] + (f32x4){bflo(xx.z), bfhi(xx.z), bflo(xx.w), bfhi(xx.w)};
                    u32x4 w; w.x = cvt_pk_bf16(v0[0], v0[1]); w.y = cvt_pk_bf16(v0[2], v0[3]); w.z = cvt_pk_bf16(v1[0], v1[1]); w.w = cvt_pk_bf16(v1[2], v1[3]);
                    *(u32x4*)(O + off + bj * HALF) = w; } }
    }
};
struct OneUnit {
    Unit u;
    __device__ __forceinline__ bool next(int i, Unit& o) const { if (i) return false; o = u; return true; }
    __device__ __forceinline__ void a_ready(const Unit&) const {}
    __device__ __forceinline__ void done(const Unit&) const {}
};
#define QT_PITCH 272
#define QT_LDS_BYTES (2 * 256 * QT_PITCH)
struct EpiQTopk {
    static constexpr bool PERM = true, AFTER_DRAIN = true;
    const bf16_t* keysB; int* idx; float* gate;
    __device__ __forceinline__ void fused(f32x4 (&acc)[2][2][4][2], const Unit& u, int wr, int wc, int fr, int fq, PG8_LAS unsigned char* ldsp, int wid, int lane) const {
        char* sQ = (char*)ldsp;
        const int h = u.pn;
#pragma unroll
        for (int ai = 0; ai < 2; ++ai)
#pragma unroll
            for (int m = 0; m < 4; ++m) { const int r = ai * HALF + wr * 64 + m * 16 + fr;
#pragma unroll
                for (int bj = 0; bj < 2; ++bj) { const f32x4 v0 = acc[ai][bj][m][0], v1 = acc[ai][bj][m][1];
                    u32x4 w; w.x = cvt_pk_bf16(v0[0], v0[1]); w.y = cvt_pk_bf16(v0[2], v0[3]); w.z = cvt_pk_bf16(v1[0], v1[1]); w.w = cvt_pk_bf16(v1[2], v1[3]);
                    *(u32x4*)(sQ + bj * (256 * QT_PITCH) + r * QT_PITCH + (wc * 32 + fq * 8) * 2) = w; } }
        __syncthreads();
        int cbv[4];
#pragma unroll
        for (int c = 0; c < 4; ++c) cbv[c] = kComb[4 * fr + c];
        int tA[2][4], tB[2][4];
#pragma unroll
        for (int m = 0; m < 2; ++m)
#pragma unroll
            for (int j = 0; j < 4; ++j) { tA[m][j] = 0; tB[m][j] = 0; }
#pragma unroll 1
        for (int pp = 0; pp < 2; ++pp) {
            const bf16_t* kb = keysB + (size_t)(pp * 8 + h) * 16384 + lane * 8;
            const char* qa = sQ + pp * (256 * QT_PITCH) + (wid * 32 + fr) * QT_PITCH + fq * 16;
            f32x4 sc2[2][8];
#pragma unroll
            for (int m = 0; m < 2; ++m)
#pragma unroll
                for (int nb = 0; nb < 8; ++nb) sc2[m][nb] = (f32x4){0.f, 0.f, 0.f, 0.f};
#pragma unroll
            for (int kk = 0; kk < 4; ++kk) {
                bf16x8 kf[8], af[2];
#pragma unroll
                for (int nb = 0; nb < 8; ++nb) kf[nb] = *(const bf16x8*)(kb + (kk * 8 + nb) * 512);
#pragma unroll
                for (int m = 0; m < 2; ++m) af[m] = *(const bf16x8*)(qa + m * 16 * QT_PITCH + kk * 64);
#pragma unroll
                for (int m = 0; m < 2; ++m)
#pragma unroll
                    for (int nb = 0; nb < 8; ++nb) sc2[m][nb] = __builtin_amdgcn_mfma_f32_16x16x32_bf16(af[m], kf[nb], sc2[m][nb], 0, 0, 0);
            }
#pragma unroll
            for (int m = 0; m < 2; ++m)
#pragma unroll
                for (int j = 0; j < 4; ++j) tA[m][j] = tB[m][j];
#pragma unroll 2
            for (int it = 0; it < 4; ++it) {
#pragma unroll
                for (int m = 0; m < 2; ++m) {
                    int k[8];
#pragma unroll
                    for (int nb = 0; nb < 8; ++nb) k[nb] = (f2key(sc2[m][nb][0]) & ~127) | (127 - (16 * nb + fr));
                    const int r = top16_rows(k, fr);
                    tB[m][0] = tB[m][1]; tB[m][1] = tB[m][2]; tB[m][2] = tB[m][3]; tB[m][3] = r;
#pragma unroll
                    for (int nb = 0; nb < 8; ++nb) sc2[m][nb] = (f32x4){sc2[m][nb][1], sc2[m][nb][2], sc2[m][nb][3], sc2[m][nb][0]};
                }
            }
        }
#pragma unroll 2
        for (int it = 0; it < 4; ++it) {
#pragma unroll
            for (int m = 0; m < 2; ++m) {
                int eid; float gt;
                combine16(tA[m][0], tB[m][0], cbv, lane, fr, eid, gt);
                const int t = u.pm * BM + wid * 32 + m * 16 + fq * 4 + it;
                const size_t o = (size_t)t * 128 + h * 16 + fr;
                idx[o] = eid; gate[o] = gt;
                tA[m][0] = tA[m][1]; tA[m][1] = tA[m][2]; tA[m][2] = tA[m][3];
                tB[m][0] = tB[m][1]; tB[m][1] = tB[m][2]; tB[m][2] = tB[m][3];
            }
        }
        __syncthreads();
    }
};
template <class Epi, class Sched>
__device__ __forceinline__ void gemm_phase(PG8_LAS unsigned char* lds, const Gemm g, const Sched& S, const Epi& E) {
    const int tid = tid_opaque(), wid = __builtin_amdgcn_readfirstlane(tid >> 6), lane = tid & 63, wr = wid >> 2, wc = wid & 3, fr = lane & 15, fq = lane >> 4;
    const int K = g.K, nt = K / BK;
    unsigned voffA[2], voffB[2];
#pragma unroll
    for (int i = 0; i < 2; ++i) { int R, C; stage_rc(tid * 16 + i * 8192, R, C); const int Rb = Epi::PERM ? ((R & ~31) + perm32(R & 31)) : R;
        voffA[i] = (unsigned)(R * K + C) * 2u; voffB[i] = (unsigned)(Rb * K + C) * 2u; }
    const size_t kstep = (size_t)(BK * 2);
    const size_t hstep = (size_t)HALF * K * 2;
    const size_t tstep = 2 * hstep;
    const unsigned ldsw = (unsigned)wid * 1024u;
    const int aoff = lds_byte(wr * 64 + fr, fq * 8), boff = lds_byte(wc * 32 + fr, fq * 8);
#define PG8_SA(b, h) (((b) * 2 + (h)) * HTB)
#define PG8_SB(b, h) ((4 + (b) * 2 + (h)) * HTB)
#define PG8_STAGE(bufoff, gbase, voff) do { _Pragma("unroll") for (int _i = 0; _i < 2; ++_i) \
        __builtin_amdgcn_global_load_lds((const unsigned*)((const char*)(gbase) + (voff)[_i]), (PG8_LAS unsigned*)(lds + (bufoff) + ldsw + _i * 8192), 16, 0, 0); } while (0)
#define PG8_LDA(dst, b, h) do { _Pragma("unroll") for (int m = 0; m < 4; ++m) _Pragma("unroll") for (int k = 0; k < 2; ++k) dst[m][k] = *(const PG8_LAS bf16x8*)(lds + PG8_SA(b, h) + aoff + m * 2048 + k * 1024); } while (0)
#define PG8_LDB(dst, b, h) do { _Pragma("unroll") for (int n = 0; n < 2; ++n) _Pragma("unroll") for (int k = 0; k < 2; ++k) dst[n][k] = *(const PG8_LAS bf16x8*)(lds + PG8_SB(b, h) + boff + n * 2048 + k * 1024); } while (0)
#define PG8_MMA(ai, bj, At, Bt) do { __builtin_amdgcn_s_setprio(1); _Pragma("unroll") for (int m = 0; m < 4; ++m) _Pragma("unroll") for (int n = 0; n < 2; ++n) _Pragma("unroll") for (int k = 0; k < 2; ++k) \
        acc[ai][bj][m][n] = __builtin_amdgcn_mfma_f32_16x16x32_bf16(Bt[n][k], At[m][k], acc[ai][bj][m][n], 0, 0, 0); __builtin_amdgcn_s_setprio(0); } while (0)
#define PG8_WAIT_V(n) asm volatile("s_waitcnt vmcnt(" #n ")" ::: "memory")
#define PG8_WAIT_L(n) asm volatile("s_waitcnt lgkmcnt(" #n ")" ::: "memory")
#define PG8_BAR __builtin_amdgcn_s_barrier()
#define PG8_SCHED __builtin_amdgcn_sched_barrier(0)
    Unit cur, nxt; int ui = 0;
    if (!S.next(0, cur)) return;
    f32x4 acc[2][2][4][2];
#pragma unroll
    for (int a = 0; a < 2; ++a)
#pragma unroll
        for (int b = 0; b < 2; ++b)
#pragma unroll
            for (int m = 0; m < 4; ++m)
#pragma unroll
                for (int n = 0; n < 2; ++n) acc[a][b][m][n] = (f32x4){0.f, 0.f, 0.f, 0.f};
    bf16x8 At[4][2], B0[2][2], B1[2][2];
    const char* cA = (const char*)g.A + (size_t)cur.pm * tstep; const char* cB = (const char*)g.Bt + (size_t)cur.pn * tstep;
    S.a_ready(cur);
    PG8_STAGE(PG8_SB(0, 0), cB, voffB); PG8_STAGE(PG8_SA(0, 0), cA, voffA); PG8_STAGE(PG8_SB(0, 1), cB + hstep, voffB); PG8_STAGE(PG8_SA(0, 1), cA + hstep, voffA);
    if (wr == 1) PG8_BAR;
    PG8_WAIT_V(4); PG8_BAR;
    PG8_STAGE(PG8_SB(1, 0), cB + kstep, voffB); PG8_STAGE(PG8_SA(1, 0), cA + kstep, voffA); PG8_STAGE(PG8_SB(1, 1), cB + hstep + kstep, voffB);
    PG8_WAIT_V(6); PG8_BAR;
    for (;;) {
        const bool has_next = S.next(ui + 1, nxt);
        const char* nA = has_next ? (const char*)g.A + (size_t)nxt.pm * tstep : cA; const char* nB = has_next ? (const char*)g.Bt + (size_t)nxt.pn * tstep : cB;
        for (int t = 0; t < nt; t += 2) {
            const bool last = (t == nt - 2);
            const char* a1 = cA + (size_t)(t + 1) * kstep;
            const char* a2 = last ? nA : cA + (size_t)(t + 2) * kstep; const char* b2 = last ? nB : cB + (size_t)(t + 2) * kstep;
            const char* a3 = a2 + kstep; const char* b3 = b2 + kstep;
            if (last && has_next) S.a_ready(nxt);
            PG8_LDB(B0, 0, 0); PG8_SCHED; PG8_LDA(At, 0, 0); PG8_STAGE(PG8_SA(1, 1), a1 + hstep, voffA);
            PG8_WAIT_L(8); PG8_BAR; PG8_WAIT_L(0); PG8_MMA(0, 0, At, B0); PG8_BAR; PG8_SCHED;
            PG8_LDB(B1, 0, 1); PG8_STAGE(PG8_SB(0, 0), b2, voffB);
            PG8_BAR; PG8_WAIT_L(0); PG8_MMA(0, 1, At, B1); PG8_BAR;
            PG8_LDA(At, 0, 1); PG8_STAGE(PG8_SA(0, 0), a2, voffA);
            PG8_BAR; PG8_WAIT_L(0); PG8_MMA(1, 0, At, B0); PG8_BAR; PG8_SCHED;
            PG8_STAGE(PG8_SB(0, 1), b2 + hstep, voffB);
            PG8_WAIT_V(6); PG8_BAR; PG8_MMA(1, 1, At, B1); PG8_BAR;
            PG8_LDB(B0, 1, 0); PG8_SCHED; PG8_LDA(At, 1, 0); PG8_STAGE(PG8_SA(0, 1), a2 + hstep, voffA);
            PG8_WAIT_L(8); PG8_BAR; PG8_WAIT_L(0); PG8_MMA(0, 0, At, B0); PG8_BAR; PG8_SCHED;
            PG8_LDB(B1, 1, 1); PG8_STAGE(PG8_SB(1, 0), b3, voffB);
            PG8_BAR; PG8_WAIT_L(0); PG8_MMA(0, 1, At, B1); PG8_BAR;
            PG8_LDA(At, 1, 1); PG8_STAGE(PG8_SA(1, 0), a3, voffA);
            PG8_BAR; PG8_WAIT_L(0); PG8_MMA(1, 0, At, B0); PG8_BAR; PG8_SCHED;
            PG8_STAGE(PG8_SB(1, 1), b3 + hstep, voffB);
            PG8_WAIT_V(6); PG8_BAR; PG8_MMA(1, 1, At, B1); PG8_BAR;
        }
            if constexpr (!Epi::AFTER_DRAIN) { E(acc, cur, wr, wc, fr, fq); S.done(cur); }
            if (!has_next) break;
#pragma unroll
        for (int a = 0; a < 2; ++a)
#pragma unroll
            for (int b = 0; b < 2; ++b)
#pragma unroll
                for (int m = 0; m < 4; ++m)
#pragma unroll
                    for (int n = 0; n < 2; ++n) acc[a][b][m][n] = (f32x4){0.f, 0.f, 0.f, 0.f};
        cur = nxt; cA = nA; cB = nB; ++ui;
    }
    PG8_WAIT_V(0);
    if (wr == 0) PG8_BAR;
    PG8_BAR;
    if constexpr (Epi::AFTER_DRAIN) { E.fused(acc, cur, wr, wc, fr, fq, lds, wid, lane); S.done(cur); }
#undef PG8_SA
#undef PG8_SB
#undef PG8_STAGE
#undef PG8_LDA
#undef PG8_LDB
#undef PG8_MMA
#undef PG8_WAIT_V
#undef PG8_WAIT_L
#undef PG8_BAR
#undef PG8_SCHED
}
}

__device__ void phase_gemm_z(const Params& p, char* lds) {
    pg8::StaticOrder S; S.init(T_TOK, D_IN, gridDim.x, blockIdx.x);
    pg8::gemm_phase<pg8::EpiZ, pg8::StaticOrder>((PG8_LAS unsigned char*)lds, pg8::Gemm{p.xb, p.winT, T_TOK, D_IN, D_MODEL}, S, pg8::EpiZ{p.zb, p.rstd1});
}
__device__ void phase_gemm_out(const Params& p, char* lds) {
    pg8::StaticOrder S; S.init(T_TOK, D_MODEL, gridDim.x, blockIdx.x);
    pg8::gemm_phase<pg8::EpiOut, pg8::StaticOrder>((PG8_LAS unsigned char*)lds, pg8::Gemm{p.cB, p.woutT, T_TOK, D_MODEL, D_MODEL}, S, pg8::EpiOut{p.hb, p.xb});
}
__device__ void phase_gemm_q(const Params& p, char* lds) {
    pg8::StaticOrder S; S.init(T_TOK, 2048, gridDim.x, blockIdx.x);
    pg8::Unit u;
    for (int i = 0; S.next(i, u); ++i)
        pg8::gemm_phase<pg8::EpiQTopk, pg8::OneUnit>((PG8_LAS unsigned char*)lds, pg8::Gemm{p.hb, p.wqT, T_TOK, 2048, D_MODEL}, pg8::OneUnit{u}, pg8::EpiQTopk{p.keysB, p.idx, p.gate});
}

#define XB_TMO      128
#define XB_XCNT(j)  (256  + 64 * (j))
#define XB_XSUB(j)  (1280 + 64 * (j))
#define XB_XGEN(j)  (2304 + 64 * (j))
#define XB_TOP      3328
#define XB_TOPGEN   3392
#define XCD_BAR_WORDS 3456
#define XB_SPIN_CAP (1u << 20)
__device__ __forceinline__ unsigned xb_ld(unsigned* p)              { return __hip_atomic_load(p, __ATOMIC_RELAXED, __HIP_MEMORY_SCOPE_AGENT); }
__device__ __forceinline__ unsigned xb_add(unsigned* p, unsigned v) { return __hip_atomic_fetch_add(p, v, __ATOMIC_RELAXED, __HIP_MEMORY_SCOPE_AGENT); }
__device__ __forceinline__ unsigned xb_xcc_id() { return (unsigned)__builtin_amdgcn_s_getreg((3 << 11) | 20) & 0xFu; }
#define XB_SPIN(cond, bar) do { unsigned _sp = 0; while (cond) { __builtin_amdgcn_s_sleep(1); \
    if ((++_sp & 255u) == 0u) { if (xb_ld(&(bar)[XB_TMO])) break; if (_sp > XB_SPIN_CAP) { atomicAdd(&(bar)[XB_TMO], 1u); break; } } } } while (0)
struct XcdBarrier { unsigned* bar; unsigned x; volatile LAS unsigned* st; };
__device__ __forceinline__ XcdBarrier xcd_barrier_post(unsigned* bar, volatile LAS unsigned* st) {
    XcdBarrier b; b.bar = bar; b.x = xb_xcc_id(); b.st = st;
    if (threadIdx.x == 0) (void)xb_add(&bar[XB_XCNT(b.x)], 1u);
    return b;
}
__device__ __forceinline__ void xcd_barrier_complete(unsigned* bar, unsigned x, unsigned& nloc, unsigned& nx) {
    const unsigned G = gridDim.x * gridDim.y * gridDim.z;
    unsigned sum, cnt, mine, sp = 0u;
    for (;;) {
        sum = 0u; cnt = 0u; mine = 0u;
#pragma unroll
        for (unsigned j = 0; j < 16; ++j) { const unsigned c = xb_ld(&bar[XB_XCNT(j)]); sum += c; cnt += (c > 0u) ? 1u : 0u; mine = (j == x) ? c : mine; }
        if (sum == G) break;
        __builtin_amdgcn_s_sleep(1);
        if ((++sp & 255u) == 0u) { if (xb_ld(&bar[XB_TMO])) break; if (sp > XB_SPIN_CAP) { atomicAdd(&bar[XB_TMO], 1u); break; } }
    }
    nloc = mine > 0u ? mine : 1u; nx = cnt > 0u ? cnt : 1u;
}
__device__ __forceinline__ void xcd_barrier(const XcdBarrier& b) {
    asm volatile("s_waitcnt vmcnt(0)" ::: "memory");
    __syncthreads();
    if (threadIdx.x == 0) {
        unsigned* bar = b.bar;
        __builtin_amdgcn_s_waitcnt(0);
        unsigned nloc = b.st[0], nx = b.st[1];
        if (nloc == 0u) { xcd_barrier_complete(bar, b.x, nloc, nx); b.st[0] = nloc; b.st[1] = nx; }
        const unsigned old = xb_add(&bar[XB_XSUB(b.x)], 1u);
        const unsigned gen = old / nloc;
        if (old + 1u == (gen + 1u) * nloc) {
            __builtin_amdgcn_fence(__ATOMIC_RELEASE, "agent");
            asm volatile("s_waitcnt vmcnt(0)" ::: "memory");
            const unsigned og = xb_add(&bar[XB_TOP], 1u);
            const unsigned tg = og / nx;
            if (og + 1u == (tg + 1u) * nx) xb_add(&bar[XB_TOPGEN], 1u);
            else XB_SPIN(xb_ld(&bar[XB_TOPGEN]) == tg, bar);
            __builtin_amdgcn_fence(__ATOMIC_ACQUIRE, "agent");
            xb_add(&bar[XB_XGEN(b.x)], 1u);
            asm volatile("s_waitcnt vmcnt(0)" ::: "memory");
        } else {
            XB_SPIN(xb_ld(&bar[XB_XGEN(b.x)]) == gen, bar);
            __builtin_amdgcn_fence(__ATOMIC_ACQUIRE, "agent");
            asm volatile("s_waitcnt vmcnt(0)" ::: "memory");
        }
    }
    __syncthreads();
}

#define MEGA_LDS_MAX2(a, b) ((a) > (b) ? (a) : (b))
#define MEGA_LDS_MAIN MEGA_LDS_MAX2(MEGA_LDS_MAX2(QT_LDS_BYTES, pg8::STAGE_BYTES), MEGA_LDS_MAX2(8 * TS_WBYTES, 2 * MIXH_LDS))
#define MEGA_LDS_BYTES (MEGA_LDS_MAIN + 16)
extern __shared__ __attribute__((aligned(16))) char smem[];
__global__ void __launch_bounds__(512, 2) fwd_mega(Params p) {
    volatile LAS unsigned* st = (volatile LAS unsigned*)(smem + MEGA_LDS_MAIN);
    if (threadIdx.x < 4) st[threadIdx.x] = 0u;
    __syncthreads();
    const XcdBarrier xb = xcd_barrier_post(p.bar, st);
    phase_prep(p, smem);      xcd_barrier(xb);
    phase_gemm_z(p, smem);    xcd_barrier(xb);
    phase_mix_gemm(p, smem);  xcd_barrier(xb);
    phase_gemm_out(p, smem);  xcd_barrier(xb);
    phase_gemm_q(p, smem);    xcd_barrier(xb);
    phase_peer_dots(p, smem); xcd_barrier(xb);
    phase_gather(p, smem);
}

extern "C" void kernel_launch(void* const* d_in, const int* in_sizes, int n_in, void* d_out, int out_size, void* d_ws, size_t ws_size, hipStream_t stream) {
    static int grid_blocks = 0;
    if (grid_blocks == 0) {
        int dev = 0, cus = 0, per_cu = 0;
        (void)hipGetDevice(&dev);
        (void)hipDeviceGetAttribute(&cus, hipDeviceAttributeMultiprocessorCount, dev);
        (void)hipFuncSetAttribute((const void*)fwd_mega, hipFuncAttributeMaxDynamicSharedMemorySize, MEGA_LDS_BYTES);
        (void)hipOccupancyMaxActiveBlocksPerMultiprocessor(&per_cu, (const void*)fwd_mega, 512, MEGA_LDS_BYTES);
        if (per_cu > 1) per_cu = 1;
        if (per_cu < 1) per_cu = 1;
        grid_blocks = cus * per_cu;
    }
    Params p{};
    p.x = (const float*)d_in[0]; p.norm1_g = (const float*)d_in[1]; p.w_in = (const float*)d_in[2]; p.pool_w = (const float*)d_in[3];
    p.pool_scale = (const float*)d_in[4]; p.sgu_norm_g = (const float*)d_in[5]; p.sgu_w = (const float*)d_in[6]; p.sgu_b = (const float*)d_in[7];
    p.w_out = (const float*)d_in[8]; p.norm2_g = (const float*)d_in[9]; p.peer_wq = (const float*)d_in[10]; p.peer_keys = (const float*)d_in[11];
    p.peer_u = (const float*)d_in[12]; p.peer_v = (const float*)d_in[13]; p.final_g = (const float*)d_in[14];
    p.out = (float*)d_out;
    char* w = (char*)d_ws; size_t off = 0;
    auto take = [&](size_t bytes) { char* r = w + off; off += (bytes + 255) & ~(size_t)255; return r; };
    const size_t MiB = 1024 * 1024;
    p.u8 = (unsigned char*)take(16 * MiB); p.v8 = (unsigned char*)take(12 * MiB);
    p.su = (float*)take(64 * 1024); p.sv = (float*)take(64 * 1024);
    p.winT = (bf16_t*)take(3 * MiB); p.woutT = (bf16_t*)take(2 * MiB); p.wqT = (bf16_t*)take(4 * MiB);
    p.poolT = (bf16_t*)take(128 * 1024); p.wsM = (bf16_t*)take(128 * 1024); p.keysB = (bf16_t*)take(512 * 1024);
    p.bar = (unsigned*)take(XCD_BAR_WORDS * 4);
    p.rstd1 = (float*)take(128 * 1024);
    p.idx = (int*)take(16 * MiB); p.gate = (float*)take(16 * MiB); p.coef = (float*)take(16 * MiB);
    p.xb = (bf16_t*)take(64 * MiB); p.zb = (bf16_t*)take(96 * MiB); p.cB = (bf16_t*)take(64 * MiB); p.hb = (bf16_t*)take(64 * MiB);
    (void)hipMemsetAsync(p.bar, 0, XCD_BAR_WORDS * 4, stream);
    hipLaunchKernelGGL(fwd_mega, dim3(grid_blocks), dim3(512), MEGA_LDS_BYTES, stream, p);
}
```

```cpp
#include <hip/hip_runtime.h>
#include <stdint.h>
#include <type_traits>

typedef unsigned short bf16_t;
typedef short bf16x8 __attribute__((ext_vector_type(8)));
typedef float f32x4 __attribute__((ext_vector_type(4)));
typedef unsigned u32x4 __attribute__((ext_vector_type(4)));
typedef unsigned u32x2 __attribute__((ext_vector_type(2)));
typedef unsigned u32x3 __attribute__((ext_vector_type(3)));
#define ROWB 768
typedef __bf16 bf2_t __attribute__((ext_vector_type(2)));
#define LAS __attribute__((address_space(3)))

#define T_TOK 32768
#define D_MODEL 1024
#define D_IN 1536
#define SEQ 2048
#define NEXP 16384
#define EPS 1e-6f

struct Params {
    const float *x, *norm1_g, *w_in, *pool_w, *pool_scale, *sgu_norm_g, *sgu_w, *sgu_b, *w_out, *norm2_g, *peer_wq, *peer_keys, *peer_u, *peer_v, *final_g;
    float* out;
    bf16_t *winT, *woutT, *wqT, *poolT, *wsM, *keysB;
    unsigned char *u8, *v8;
    float2* suv;
    float *rstd1;
    bf16_t *xb, *zb, *cB, *hb;
    int* idx; float* gate; float* coef;
    unsigned* bar;
};

__device__ __forceinline__ int tid_opaque() { int t = (int)threadIdx.x; asm volatile("" : "+v"(t)); return t; }
__device__ __forceinline__ unsigned short f2bf(float f) {
    unsigned u = __float_as_uint(f);
    u += 0x7fffu + ((u >> 16) & 1u);
    return (unsigned short)(u >> 16);
}
__device__ __forceinline__ float bf2f(unsigned short h) { return __uint_as_float(((unsigned)h) << 16); }
__device__ __forceinline__ unsigned pack2(float a, float b) { return (unsigned)f2bf(a) | ((unsigned)f2bf(b) << 16); }
__device__ __forceinline__ float bflo(unsigned w) { return __uint_as_float(w << 16); }
__device__ __forceinline__ float bfhi(unsigned w) { return __uint_as_float(w & 0xffff0000u); }
__device__ __forceinline__ float gelu_t(float x) {
    const float y = 1.5957691216057308f * (x + 0.044715f * x * x * x);
    return x * __builtin_amdgcn_rcpf(1.0f + __expf(-y));
}
__device__ __forceinline__ float wave_sum(float v) {
#pragma unroll
    for (int o = 32; o >= 1; o >>= 1) v += __shfl_xor(v, o);
    return v;
}
__device__ __forceinline__ float wave_max(float v) {
#pragma unroll
    for (int o = 32; o >= 1; o >>= 1) v = fmaxf(v, __shfl_xor(v, o));
    return v;
}

#define GEMM_LDS_BYTES (2 * 128 * 144)
__device__ __forceinline__ void transpose_tile(const int tid, const float* __restrict__ src, bf16_t* __restrict__ dst, int R, int C, const float* __restrict__ rscale, int tile, float* lds) {
    const int tilesC = C / 64, tr = tile / tilesC, tc = tile % tilesC;
    const int ty = tid >> 6, tx = tid & 63;
    __syncthreads();
#pragma unroll
    for (int i = 0; i < 16; ++i) {
        const int r = ty + 4 * i;
        float v = src[(size_t)(tr * 64 + r) * C + tc * 64 + tx];
        if (rscale) v *= rscale[tr * 64 + r];
        lds[r * 65 + tx] = v;
    }
    __syncthreads();
#pragma unroll
    for (int i = 0; i < 16; ++i) {
        const int c = ty + 4 * i;
        dst[(size_t)(tc * 64 + c) * R + tr * 64 + tx] = f2bf(lds[tx * 65 + c]);
    }
}

__device__ void phase_prep(const Params& p, char* lds) {
    const int tidx_ = tid_opaque();
    const int nb = gridDim.x, b = blockIdx.x, tid = tidx_;
    const int half = tid >> 8, ht = tid & 255, nh = 2 * nb, hb2 = 2 * b + half;
    float* fl = (float*)(lds + half * (64 * 65 * 4));
    for (int t = hb2; t < 16 * 24; t += nh) transpose_tile(ht, p.w_in, p.winT, 1024, 1536, p.norm1_g, t, fl);
    for (int t = hb2; t < 16 * 16; t += nh) transpose_tile(ht, p.w_out, p.woutT, 1024, 1024, nullptr, t, fl);
    for (int t = hb2; t < 16 * 32; t += nh) transpose_tile(ht, p.peer_wq, p.wqT, 1024, 2048, p.norm2_g, t, fl);
    for (int t = hb2; t < 16; t += nh) transpose_tile(ht, p.pool_w + (size_t)(t >> 2) * 16384, p.poolT + (size_t)(t >> 2) * 16384, 128, 128, nullptr, t & 3, fl);
    const size_t gtid = (size_t)b * blockDim.x + tid, gsz = (size_t)nb * blockDim.x;
    for (size_t i = gtid; i < 4 * 128 * 128; i += gsz) {
        const int j = (int)(i & 127), ii = (int)((i >> 7) & 127);
        const bool keep = (j >> 6) <= (ii >> 6);
        p.wsM[i] = keep ? f2bf(p.sgu_w[i]) : (bf16_t)0;
    }
    for (size_t o = gtid; o < 2 * 8 * 128 * 128; o += gsz) {
        const int j = (int)(o & 7), ln = (int)((o >> 3) & 63), nb = (int)((o >> 9) & 7), kk = (int)((o >> 12) & 3), ph = (int)(o >> 14);
        p.keysB[o] = f2bf(p.peer_keys[(size_t)ph * 16384 + (size_t)(16 * nb + (ln & 15)) * 128 + 32 * kk + 8 * (ln >> 4) + j]);
    }
    {
        const int wave = (b * blockDim.x + tid) >> 6, nwaves = (nb * blockDim.x) >> 6, lane = tid & 63;
        float g16[16];
#pragma unroll
        for (int i = 0; i < 4; ++i) { const float4 g = ((const float4*)(p.norm2_g + lane * 16))[i]; g16[4 * i] = g.x; g16[4 * i + 1] = g.y; g16[4 * i + 2] = g.z; g16[4 * i + 3] = g.w; }
        auto quant_row = [&](const float (&f)[16], unsigned char* dst, float* scale_out) {
            float am = 0.f;
#pragma unroll
            for (int j = 0; j < 16; ++j) am = fmaxf(am, fabsf(f[j]));
            am = wave_max(am);
            const float inv = am > 0.f ? 31.0f / am : 0.f;
            int q[16];
#pragma unroll
            for (int j = 0; j < 16; ++j) q[j] = (int)rintf(f[j] * inv) + 32;
            u32x3 o;
#pragma unroll
            for (int i = 0; i < 3; ++i) {
                unsigned w = 0;
#pragma unroll
                for (int k = 0; k < 4; ++k) w |= (unsigned)(q[4 * i + k] | (((q[12 + k] >> (2 * i)) & 3) << 6)) << (8 * k);
                o[i] = w;
            }
            *(u32x3*)(dst + lane * 12) = o;
            if (lane == 0) *scale_out = am * (1.0f / 31.0f);
        };
        for (int e = wave; e < NEXP; e += nwaves) {
            const float4* su4 = (const float4*)(p.peer_u + (size_t)e * D_MODEL + lane * 16);
            const float4* sv4 = (const float4*)(p.peer_v + (size_t)e * D_MODEL + lane * 16);
            float4 a4[4], b4[4];
#pragma unroll
            for (int i = 0; i < 4; ++i) { a4[i] = su4[i]; b4[i] = sv4[i]; }
            float fu[16], fv[16];
#pragma unroll
            for (int i = 0; i < 4; ++i) {
                fu[4 * i] = a4[i].x * g16[4 * i]; fu[4 * i + 1] = a4[i].y * g16[4 * i + 1]; fu[4 * i + 2] = a4[i].z * g16[4 * i + 2]; fu[4 * i + 3] = a4[i].w * g16[4 * i + 3];
                fv[4 * i] = b4[i].x; fv[4 * i + 1] = b4[i].y; fv[4 * i + 2] = b4[i].z; fv[4 * i + 3] = b4[i].w;
            }
            {
                float am = 0.f;
#pragma unroll
                for (int j = 0; j < 16; ++j) am = fmaxf(am, fabsf(fu[j]));
                am = wave_max(am);
                const float inv = am > 0.f ? 127.0f / am : 0.f;
                u32x4 o;
#pragma unroll
                for (int i = 0; i < 4; ++i) {
                    unsigned w = 0;
#pragma unroll
                    for (int k = 0; k < 4; ++k) w |= (unsigned)(((int)rintf(fu[4 * i + k] * inv)) & 0xff) << (8 * k);
                    o[i] = w;
                }
                *(u32x4*)(p.u8 + (size_t)e * D_MODEL + lane * 16) = o;
                if (lane == 0) p.suv[e].x = am * (1.0f / 127.0f);
            }
            quant_row(fv, p.v8 + (size_t)e * ROWB, &p.suv[e].y);
        }
    }
    const int wave = (b * blockDim.x + tid) >> 6, nwaves = (nb * blockDim.x) >> 6, lane = tid & 63;
    for (int t = wave; t < T_TOK; t += 2 * nwaves) {
        const int t1 = t + nwaves; const bool two = t1 < T_TOK;
        const float4* xr0 = (const float4*)(p.x + (size_t)t * D_MODEL);
        const float4* xr1 = (const float4*)(p.x + (size_t)(two ? t1 : t) * D_MODEL);
        float4 v0[4], v1[4];
#pragma unroll
        for (int i = 0; i < 4; ++i) { v0[i] = xr0[lane + 64 * i]; v1[i] = xr1[lane + 64 * i]; }
        float s0 = 0.f, s1 = 0.f;
#pragma unroll
        for (int i = 0; i < 4; ++i) {
            s0 += v0[i].x * v0[i].x + v0[i].y * v0[i].y + v0[i].z * v0[i].z + v0[i].w * v0[i].w;
            s1 += v1[i].x * v1[i].x + v1[i].y * v1[i].y + v1[i].z * v1[i].z + v1[i].w * v1[i].w;
            uint2 o; o.x = pack2(v0[i].x, v0[i].y); o.y = pack2(v0[i].z, v0[i].w);
            ((uint2*)(p.xb + (size_t)t * D_MODEL))[lane + 64 * i] = o;
            if (two) { uint2 o1; o1.x = pack2(v1[i].x, v1[i].y); o1.y = pack2(v1[i].z, v1[i].w); ((uint2*)(p.xb + (size_t)t1 * D_MODEL))[lane + 64 * i] = o1; }
        }
        s0 = wave_sum(s0); s1 = wave_sum(s1);
        if (lane == 0) { p.rstd1[t] = rsqrtf(s0 * (1.0f / D_MODEL) + EPS); if (two) p.rstd1[t1] = rsqrtf(s1 * (1.0f / D_MODEL) + EPS); }
    }
}

typedef short s16x4 __attribute__((ext_vector_type(4)));
template <class Epi>
__device__ __forceinline__ void gemm128_sgu(const int tid, const bf16_t* __restrict__ A, const bf16_t* __restrict__ V  ,
                                            const float* __restrict__ lnm, const float* __restrict__ lnr, const float* __restrict__ gch, char* lds, const Epi& epi) {
    const int lane = tid & 63, wid = tid >> 6, wr = wid >> 1, wc = wid & 1, fr = lane & 15, fq = lane >> 4;
    constexpr int PITCH = 144, P2 = 288;
    char* sA = lds; char* sB = lds + 128 * PITCH;
    f32x4 acc[4][4];
#pragma unroll
    for (int m = 0; m < 4; ++m)
#pragma unroll
        for (int n = 0; n < 4; ++n) acc[m][n] = (f32x4){0.f, 0.f, 0.f, 0.f};
    u32x4 ra[4], rb[4]; float rm[4], rr[4];
    const int lrow = tid >> 3, lch = tid & 7;
    const int btok = tid >> 4, bch = tid & 15;
    const bf16_t* ga = A + (size_t)lrow * 128 + lch * 8;
    const bf16_t* gb = V + (size_t)btok * D_IN + bch * 8;
    float g8[8];
    { const float4 g0 = *(const float4*)(gch + bch * 8), g1 = *(const float4*)(gch + bch * 8 + 4); g8[0] = g0.x; g8[1] = g0.y; g8[2] = g0.z; g8[3] = g0.w; g8[4] = g1.x; g8[5] = g1.y; g8[6] = g1.z; g8[7] = g1.w; }
#pragma unroll
    for (int j = 0; j < 4; ++j) { ra[j] = *(const u32x4*)(ga + (size_t)(32 * j) * 128); rb[j] = *(const u32x4*)(gb + (size_t)(16 * j) * D_IN); rm[j] = lnm[btok + 16 * j]; rr[j] = lnr[btok + 16 * j]; }
    for (int k0 = 0; k0 < 128; k0 += 64) {
        __syncthreads();
#pragma unroll
        for (int j = 0; j < 4; ++j) {
            *(u32x4*)(sA + (lrow + 32 * j) * PITCH + lch * 16) = ra[j];
            u32x4 o;
#pragma unroll
            for (int i = 0; i < 4; ++i) {
                const unsigned w = rb[j][i];
                o[i] = pack2((bflo(w) - rm[j]) * rr[j] * g8[2 * i], (bfhi(w) - rm[j]) * rr[j] * g8[2 * i + 1]);
            }
            *(u32x4*)(sB + (btok + 16 * j) * P2 + bch * 16) = o;
        }
        __syncthreads();
        if (k0 + 64 < 128) {
#pragma unroll
            for (int j = 0; j < 4; ++j) { ra[j] = *(const u32x4*)(ga + (size_t)(32 * j) * 128 + 64); rb[j] = *(const u32x4*)(gb + (size_t)(64 + 16 * j) * D_IN); rm[j] = lnm[64 + btok + 16 * j]; rr[j] = lnr[64 + btok + 16 * j]; }
        }
#pragma unroll
        for (int kk = 0; kk < 2; ++kk) {
            bf16x8 af[4], bfr[4];
#pragma unroll
            for (int m = 0; m < 4; ++m) af[m] = *(const bf16x8*)(sA + (wr * 64 + m * 16 + fr) * PITCH + (kk * 32 + fq * 8) * 2);
#pragma unroll
            for (int n = 0; n < 4; ++n) {
                const char* bp = sB + (kk * 32 + fq * 8 + (fr >> 2)) * P2 + (wc * 64 + n * 16 + 4 * (fr & 3)) * 2;
                const s16x4 lo = __builtin_amdgcn_ds_read_tr16_b64_v4i16((LAS s16x4*)(bp));
                const s16x4 hi = __builtin_amdgcn_ds_read_tr16_b64_v4i16((LAS s16x4*)(bp + 4 * P2));
                bfr[n] = (bf16x8){lo[0], lo[1], lo[2], lo[3], hi[0], hi[1], hi[2], hi[3]};
            }
#pragma unroll
            for (int m = 0; m < 4; ++m)
#pragma unroll
                for (int n = 0; n < 4; ++n) acc[m][n] = __builtin_amdgcn_mfma_f32_16x16x32_bf16(bfr[n], af[m], acc[m][n], 0, 0, 0);
        }
    }
#pragma unroll
    for (int m = 0; m < 4; ++m)
#pragma unroll
        for (int n = 0; n < 4; ++n) epi(wr * 64 + m * 16 + fr, wc * 64 + n * 16 + fq * 4, acc[m][n]);
}

#define PT_PITCH 272
#define MIXH_LDS (2 * 128 * PT_PITCH + 1024)
template <int W, class Epi>
__device__ __forceinline__ void pool_tile(const int tid, const bf16_t* __restrict__ zb0  , int pos0,
                                          const bf16_t* __restrict__ Bt, char* lds, const Epi& epi) {
    const int lane = tid & 63, wid = tid >> 6, wr = wid >> 1, wc = wid & 1, fr = lane & 15, fq = lane >> 4;
    char* sA = lds; char* sB = lds + 128 * PT_PITCH;
    __syncthreads();
#pragma unroll
    for (int j = 0; j < 8; ++j) { const int id = tid + 256 * j, row = id >> 4, ch = id & 15; *(u32x4*)(sB + row * PT_PITCH + ch * 16) = *(const u32x4*)(Bt + (size_t)row * 128 + ch * 8); }
    {
        const int seg = tid >> 5, hc = tid & 31, r0 = seg * 16;
        const bool at_start = (pos0 & (SEQ - 1)) == 0;
        const bf16_t* zp = zb0 + hc * 4;
        u32x2 v[W + 16];
#pragma unroll
        for (int i = 0; i < W + 16; ++i) { const int rr = r0 - W + i; const bool ok = !(at_start && rr < 0); v[i] = *(const u32x2*)(zp + (ptrdiff_t)(ok ? rr : 0) * D_IN); }
        float sm[4] = {0.f, 0.f, 0.f, 0.f};
#pragma unroll
        for (int i = 1; i <= W; ++i) {
            const float m = (at_start && (r0 - W + i) < 0) ? 0.f : 1.f;
            sm[0] += m * bflo(v[i].x); sm[1] += m * bfhi(v[i].x); sm[2] += m * bflo(v[i].y); sm[3] += m * bfhi(v[i].y);
        }
#pragma unroll
        for (int o = 0; o < 16; ++o) {
            if (o > 0) {
                const float md = (at_start && (r0 + o - W) < 0) ? 0.f : 1.f;
                sm[0] += bflo(v[W + o].x) - md * bflo(v[o].x); sm[1] += bfhi(v[W + o].x) - md * bfhi(v[o].x);
                sm[2] += bflo(v[W + o].y) - md * bflo(v[o].y); sm[3] += bfhi(v[W + o].y) - md * bfhi(v[o].y);
            }
            const int pos = (pos0 + r0 + o) & (SEQ - 1);
            const float rn = 1.0f / (float)((pos + 1 < W) ? pos + 1 : W);
            u32x2 ov;
            ov.x = pack2(sm[0] * rn - bflo(v[W + o].x), sm[1] * rn - bfhi(v[W + o].x));
            ov.y = pack2(sm[2] * rn - bflo(v[W + o].y), sm[3] * rn - bfhi(v[W + o].y));
            *(u32x2*)(sA + (r0 + o) * PT_PITCH + hc * 8) = ov;
        }
    }
    __syncthreads();
    f32x4 acc[4][4];
#pragma unroll
    for (int m = 0; m < 4; ++m)
#pragma unroll
        for (int n = 0; n < 4; ++n) acc[m][n] = (f32x4){0.f, 0.f, 0.f, 0.f};
#pragma unroll
    for (int kk = 0; kk < 4; ++kk) {
        bf16x8 af[4], bfr[4];
#pragma unroll
        for (int m = 0; m < 4; ++m) af[m] = *(const bf16x8*)(sA + (wr * 64 + m * 16 + fr) * PT_PITCH + (kk * 32 + fq * 8) * 2);
#pragma unroll
        for (int n = 0; n < 4; ++n) bfr[n] = *(const bf16x8*)(sB + (wc * 64 + n * 16 + fr) * PT_PITCH + (kk * 32 + fq * 8) * 2);
#pragma unroll
        for (int m = 0; m < 4; ++m)
#pragma unroll
            for (int n = 0; n < 4; ++n) acc[m][n] = __builtin_amdgcn_mfma_f32_16x16x32_bf16(bfr[n], af[m], acc[m][n], 0, 0, 0);
    }
#pragma unroll
    for (int m = 0; m < 4; ++m)
#pragma unroll
        for (int n = 0; n < 4; ++n) epi(wr * 64 + m * 16 + fr, wc * 64 + n * 16 + fq * 4, acc[m][n]);
}

__device__ void phase_mix_gemm(const Params& p, char* lds) {
    const int tidx_ = tid_opaque();
    const int npool = (T_TOK / 128) * 4, nsgu = (T_TOK / 128) * 4;
    const int half = tidx_ >> 8, ht = tidx_ & 255; lds += half * MIXH_LDS;
    for (int tile = 2 * blockIdx.x + half; tile < npool + nsgu; tile += 2 * gridDim.x) {
        if (tile < npool) {
            const int tm = tile >> 2, g = tile & 3;
            const float* ps = p.pool_scale + g * 128; bf16_t* co = p.cB + (size_t)tm * 128 * D_MODEL + g * 128;
            const bf16_t* z0 = p.zb + (size_t)tm * 128 * D_IN + g * 128; const bf16_t* bt = p.poolT + (size_t)g * 16384;
            auto epi = [&](int r, int c, f32x4 v) {
                const float4 sc = *(const float4*)(ps + c);
                uint2 o; o.x = pack2(v[0] * sc.x, v[1] * sc.y); o.y = pack2(v[2] * sc.z, v[3] * sc.w);
                *(uint2*)(co + (size_t)r * D_MODEL + c) = o;
            };
            if (g == 0) pool_tile<2>(ht, z0, tm * 128, bt, lds, epi); else if (g == 1) pool_tile<4>(ht, z0, tm * 128, bt, lds, epi);
            else if (g == 2) pool_tile<8>(ht, z0, tm * 128, bt, lds, epi); else pool_tile<16>(ht, z0, tm * 128, bt, lds, epi);
        } else {
            const int t2 = tile - npool, blk = t2 >> 2, h = t2 & 3;
            float* stm = (float*)(lds + GEMM_LDS_BYTES); float* str = stm + 128;
            __syncthreads();
            {
                const int tok = ht >> 1, hh = ht & 1;
                const u32x4* vp = (const u32x4*)(p.zb + (size_t)(blk * 128 + tok) * D_IN + 1024 + hh * 256);
                float s1 = 0.f, s2 = 0.f;
#pragma unroll 8
                for (int i = 0; i < 32; ++i) {
                    const u32x4 v = vp[i];
#pragma unroll
                    for (int k = 0; k < 4; ++k) { const float a = bflo(v[k]), c = bfhi(v[k]); s1 += a + c; s2 += a * a + c * c; }
                }
                s1 += __shfl_xor(s1, 1); s2 += __shfl_xor(s2, 1);
                const float mean = s1 * (1.0f / 512.0f), var = fmaxf(s2 * (1.0f / 512.0f) - mean * mean, 0.f);
                if (hh == 0) { stm[tok] = mean; str[tok] = rsqrtf(var + EPS); }
            }
            __syncthreads();
            const float* sb = p.sgu_b + h * 128; const bf16_t* uo = p.zb + (size_t)blk * 128 * D_IN + 512 + h * 128;
            bf16_t* co = p.cB + (size_t)blk * 128 * D_MODEL + 512 + h * 128;
            gemm128_sgu(ht, p.wsM + (size_t)h * 16384, p.zb + (size_t)blk * 128 * D_IN + 1024 + h * 128, stm, str, p.sgu_norm_g + h * 128, lds,
                    [&](int r, int c, f32x4 v) {
                        const float bb = sb[r];
                        const uint2 uu = *(const uint2*)(uo + (size_t)r * D_IN + c);
                        uint2 o;
                        o.x = pack2((v[0] + bb) * bflo(uu.x), (v[1] + bb) * bfhi(uu.x));
                        o.y = pack2((v[2] + bb) * bflo(uu.y), (v[3] + bb) * bfhi(uu.y));
                        *(uint2*)(co + (size_t)r * D_MODEL + c) = o;
                    });
        }
    }
}

__device__ __forceinline__ int wave_sum_i_uniform(int s) {
    s += __builtin_amdgcn_update_dpp(0, s, 0xB1, 0xf, 0xf, false);
    s += __builtin_amdgcn_update_dpp(0, s, 0x4E, 0xf, 0xf, false);
    s += __builtin_amdgcn_update_dpp(0, s, 0x141, 0xf, 0xf, false);
    s += __builtin_amdgcn_update_dpp(0, s, 0x140, 0xf, 0xf, false);
    return __builtin_amdgcn_readlane(s, 0) + __builtin_amdgcn_readlane(s, 16) + __builtin_amdgcn_readlane(s, 32) + __builtin_amdgcn_readlane(s, 48);
}
__constant__ unsigned char kComb[64] = {
    0x00,0x01,0x02,0x03,0x04,0x05,0x06,0x07,0x08,0x09,0x0a,0x0b,0x0c,0x0d,0x0e,0x0f,
    0x10,0x11,0x12,0x13,0x14,0x15,0x16,0x17,
    0x20,0x21,0x22,0x23,0x24,
    0x30,0x31,0x32,0x33,
    0x40,0x41,0x42,
    0x50,0x51,
    0x60,0x61,
    0x70,0x71,
    0x80,0x90,0xa0,0xb0,0xc0,0xd0,0xe0,0xf0,
    0xff,0xff,0xff,0xff,0xff,0xff,0xff,0xff,0xff,0xff,0xff,0xff,0xff,0xff};

template <int CTRL> __device__ __forceinline__ int dpp_i(int v) { return __builtin_amdgcn_update_dpp(0, v, CTRL, 0xf, 0xf, false); }
__device__ __forceinline__ int row_allmax_i(int v) {
    v = max(v, dpp_i<0x128>(v)); v = max(v, dpp_i<0x124>(v)); v = max(v, dpp_i<0x122>(v)); v = max(v, dpp_i<0x121>(v));
    return v;
}
__device__ __forceinline__ float row_allsum_f(float v) {
    v += __int_as_float(dpp_i<0x128>(__float_as_int(v))); v += __int_as_float(dpp_i<0x124>(__float_as_int(v)));
    v += __int_as_float(dpp_i<0x122>(__float_as_int(v))); v += __int_as_float(dpp_i<0x121>(__float_as_int(v)));
    return v;
}
__device__ __forceinline__ int f2key(float f) { const int b = __float_as_int(f); return b ^ ((b >> 31) & 0x7fffffff); }
__device__ __forceinline__ float key2f(int k) { return __int_as_float(k ^ ((k >> 31) & 0x7fffffff)); }
#define KEY_MIN ((int)0x80000000)
#define CE(a, b) { const int hi_ = max(a, b), lo_ = min(a, b); a = hi_; b = lo_; }
__device__ __forceinline__ int top16_rows(int (&k)[8], int l15) {
    CE(k[0], k[1]) CE(k[2], k[3]) CE(k[4], k[5]) CE(k[6], k[7])
    CE(k[0], k[2]) CE(k[1], k[3]) CE(k[4], k[6]) CE(k[5], k[7])
    CE(k[1], k[2]) CE(k[5], k[6])
    CE(k[0], k[4]) CE(k[1], k[5]) CE(k[2], k[6]) CE(k[3], k[7])
    CE(k[2], k[4]) CE(k[3], k[5])
    CE(k[1], k[2]) CE(k[3], k[4]) CE(k[5], k[6])
    int res = KEY_MIN;
#pragma unroll
    for (int r = 0; r < 16; ++r) {
        const int m = row_allmax_i(k[0]);
        const bool own = (k[0] == m);
#pragma unroll
        for (int j = 0; j < 7; ++j) k[j] = own ? k[j + 1] : k[j];
        k[7] = own ? KEY_MIN : k[7];
        res = (l15 == r) ? m : res;
    }
    return res;
}
__device__ __forceinline__ void combine16(int A, int B, const int (&cbv)[4], int lane, int l15, int& eid_out, float& gate_out) {
    const int rowbase = lane & 48;
    int ck[4], eid[4];
#pragma unroll
    for (int c = 0; c < 4; ++c) {
        const int ci = (cbv[c] >> 4) & 15, cj = cbv[c] & 15;
        const int ka = __builtin_amdgcn_ds_bpermute((rowbase + ci) << 2, A);
        const int kb = __builtin_amdgcn_ds_bpermute((rowbase + cj) << 2, B);
        const float sm = key2f(ka & ~127) + key2f(kb & ~127);
        eid[c] = ((127 - (ka & 127)) << 7) | (127 - (kb & 127));
        ck[c] = (cbv[c] != 0xff) ? ((f2key(sm) & ~63) | (63 - (4 * l15 + c))) : KEY_MIN;
    }
    CE(ck[0], ck[1]) CE(ck[2], ck[3]) CE(ck[0], ck[2]) CE(ck[1], ck[3]) CE(ck[1], ck[2])
    int res = KEY_MIN;
#pragma unroll
    for (int r = 0; r < 16; ++r) {
        const int m = row_allmax_i(ck[0]);
        const bool own = (ck[0] == m);
        ck[0] = own ? ck[1] : ck[0]; ck[1] = own ? ck[2] : ck[1]; ck[2] = own ? ck[3] : ck[2]; ck[3] = own ? KEY_MIN : ck[3];
        res = (l15 == r) ? m : res;
    }
    const int slot = 63 - (res & 63);
    const int src = (rowbase + (slot >> 2)) << 2;
    const int e0 = __builtin_amdgcn_ds_bpermute(src, eid[0]), e1 = __builtin_amdgcn_ds_bpermute(src, eid[1]);
    const int e2 = __builtin_amdgcn_ds_bpermute(src, eid[2]), e3 = __builtin_amdgcn_ds_bpermute(src, eid[3]);
    const int sel = slot & 3;
    eid_out = sel == 0 ? e0 : (sel == 1 ? e1 : (sel == 2 ? e2 : e3));
    gate_out = key2f(res & ~63);
}

__device__ __forceinline__ int reduce16_rows(const int (&part)[16], bool b3, bool b2, bool b1, bool b0b) {
    int r8[8], r4[4], r2[2];
#pragma unroll
    for (int k = 0; k < 8; ++k) { const int keep = b3 ? part[8 + k] : part[k], send = b3 ? part[k] : part[8 + k]; r8[k] = keep + __builtin_amdgcn_update_dpp(0, send, 0x140, 0xf, 0xf, false); }
#pragma unroll
    for (int k = 0; k < 4; ++k) { const int keep = b2 ? r8[4 + k] : r8[k], send = b2 ? r8[k] : r8[4 + k]; r4[k] = keep + __builtin_amdgcn_update_dpp(0, send, 0x141, 0xf, 0xf, false); }
#pragma unroll
    for (int k = 0; k < 2; ++k) { const int keep = b1 ? r4[2 + k] : r4[k], send = b1 ? r4[k] : r4[2 + k]; r2[k] = keep + __builtin_amdgcn_update_dpp(0, send, 0x4E, 0xf, 0xf, false); }
    const int keep = b0b ? r2[1] : r2[0], send = b0b ? r2[0] : r2[1];
    int r1 = keep + __builtin_amdgcn_update_dpp(0, send, 0xB1, 0xf, 0xf, false);
    r1 += __shfl_xor(r1, 16); r1 += __shfl_xor(r1, 32);
    return r1;
}
#define TS_WBYTES (16384 + 128)
__device__ void phase_peer_dots(const Params& p, char* lds) {
    const int tidx_ = tid_opaque();
    const int lane = tidx_ & 63, wid = __builtin_amdgcn_readfirstlane((int)(tidx_ >> 6)), l15 = lane & 15;
    const bool b3 = (lane & 8) != 0, b2 = (lane & 4) != 0, b1 = (lane & 2) != 0, b0b = (lane & 1) != 0;
    const int gw = blockIdx.x * (blockDim.x >> 6) + wid, ngw = gridDim.x * (blockDim.x >> 6);
    char* wl = lds + wid * TS_WBYTES;
    unsigned* list = (unsigned*)wl; int* dotsl = (int*)(wl + 4096); char* hql = wl + 8192; int* tks = (int*)(wl + 16384);
    const unsigned lane16 = (unsigned)lane * 16u;
    for (int tb = gw * 8; tb < T_TOK; tb += ngw * 8) {
#pragma unroll 1
        for (int j0 = 0; j0 < 8; j0 += 4) {
            u32x4 hraw[4][2];
#pragma unroll
            for (int jj = 0; jj < 4; ++jj) { const u32x4* hr = (const u32x4*)(p.hb + (size_t)(tb + j0 + jj) * D_MODEL); hraw[jj][0] = hr[2 * lane]; hraw[jj][1] = hr[2 * lane + 1]; }
#pragma unroll
            for (int jj = 0; jj < 4; ++jj) {
                const int j = j0 + jj;
                const u32x4 a = hraw[jj][0], c = hraw[jj][1];
                const float f[16] = {bflo(a.x), bfhi(a.x), bflo(a.y), bfhi(a.y), bflo(a.z), bfhi(a.z), bflo(a.w), bfhi(a.w),
                                     bflo(c.x), bfhi(c.x), bflo(c.y), bfhi(c.y), bflo(c.z), bfhi(c.z), bflo(c.w), bfhi(c.w)};
                float ss = 0.f, am = 0.f;
#pragma unroll
                for (int k = 0; k < 16; ++k) { ss += f[k] * f[k]; am = fmaxf(am, fabsf(f[k])); }
                ss = wave_sum(ss); am = wave_max(am);
                const float inv = am > 0.f ? 127.0f / am : 0.f;
                u32x4 o; int hsum = 0;
#pragma unroll
                for (int i = 0; i < 4; ++i) {
                    unsigned w = 0;
#pragma unroll
                    for (int k = 0; k < 4; ++k) { const int qv = (int)rintf(f[4 * i + k] * inv); hsum += qv; w |= (unsigned)(qv & 0xff) << (8 * k); }
                    o[i] = w;
                }
                *(u32x4*)(hql + j * 1024 + lane * 16) = o;
                hsum = wave_sum_i_uniform(hsum);
                const float r2 = rsqrtf(ss * (1.0f / D_MODEL) + EPS);
                if (lane == 0) { tks[4 * j] = hsum; tks[4 * j + 1] = __float_as_int(am * (1.0f / 127.0f) * r2); tks[4 * j + 2] = __float_as_int(r2); }
            }
        }
        int idv[8][2];
#pragma unroll
        for (int j = 0; j < 8; ++j) { const int* ir = p.idx + (size_t)(tb + j) * 128; idv[j][0] = ir[lane]; idv[j][1] = ir[64 + lane]; }
#pragma unroll 1
        for (int x = 0; x < 8; ++x) {
            int n = 0;
#pragma unroll
            for (int j = 0; j < 8; ++j)
#pragma unroll
                for (int r = 0; r < 2; ++r) {
                    const int e = idv[j][r];
                    const bool in = (e >> 11) == x;
                    const unsigned long long mk = __ballot(in);
                    const int rank = (int)__builtin_amdgcn_mbcnt_hi((unsigned)(mk >> 32), __builtin_amdgcn_mbcnt_lo((unsigned)mk, 0u));
                    if (in) list[n + rank] = ((unsigned)j << 21) | ((unsigned)(r * 64 + lane) << 14) | (unsigned)e;
                    n += (int)__builtin_popcountll(mk);
                }
            asm volatile("s_waitcnt lgkmcnt(0)" ::: "memory");
            u32x4 ua[16], ubf[16]; int enta = 0, entb = 0;
            auto issue = [&](int b0, u32x4 (&uu)[16], int& entv) {
                const int i = (b0 + l15 < n) ? b0 + l15 : n - 1;
                entv = (int)list[i];
#pragma unroll
                for (int j = 0; j < 16; ++j) { const int e = __builtin_amdgcn_readlane(entv, j) & 0x3fff; uu[j] = *(const u32x4*)(p.u8 + (size_t)e * D_MODEL + lane16); }
            };
            auto reduce = [&](int b0, const u32x4 (&uu)[16], int entv) {
                int part[16];
#pragma unroll
                for (int j = 0; j < 16; ++j) {
                    const int tl = __builtin_amdgcn_readlane(entv, j) >> 21;
                    const u32x4 hqv = *(const u32x4*)(hql + tl * 1024 + lane * 16);
                    int sacc = __builtin_amdgcn_sdot4((int)uu[j].x, (int)hqv.x, 0, false);
                    sacc = __builtin_amdgcn_sdot4((int)uu[j].y, (int)hqv.y, sacc, false);
                    sacc = __builtin_amdgcn_sdot4((int)uu[j].z, (int)hqv.z, sacc, false);
                    part[j] = __builtin_amdgcn_sdot4((int)uu[j].w, (int)hqv.w, sacc, false);
                }
                const int r1 = reduce16_rows(part, b3, b2, b1, b0b);
                if (lane < 16 && b0 + lane < n) dotsl[((unsigned)entv >> 21) * 128 + (((unsigned)entv >> 14) & 127u)] = r1;
            };
            if (n > 0) issue(0, ua, enta);
            for (int b0 = 0; b0 < n; b0 += 32) {
                if (b0 + 16 < n) issue(b0 + 16, ubf, entb);
                reduce(b0, ua, enta);
                if (b0 + 16 < n) {
                    if (b0 + 32 < n) issue(b0 + 32, ua, enta);
                    reduce(b0 + 16, ubf, entb);
                }
            }
            asm volatile("s_waitcnt lgkmcnt(0)" ::: "memory");
        }
#pragma unroll
        for (int j = 0; j < 8; ++j) {
            const int hs_t = tks[4 * j]; const float cs_t = __int_as_float(tks[4 * j + 1]), r2_t = __int_as_float(tks[4 * j + 2]);
            const float* gr = p.gate + (size_t)(tb + j) * 128; float* cr = p.coef + (size_t)(tb + j) * 128;
#pragma unroll
            for (int r = 0; r < 2; ++r) {
                const int e = idv[j][r];
                const float sc = gr[r * 64 + lane] * r2_t;
                const float ex = __expf(sc - key2f(row_allmax_i(f2key(sc))));
                const float gt = ex / row_allsum_f(ex);
                const float2 sc2 = p.suv[e];
                const float dotf = (float)dotsl[j * 128 + r * 64 + lane] * cs_t * sc2.x;
                cr[r * 64 + lane] = gt * gelu_t(dotf) * sc2.y;
            }
        }
        asm volatile("s_waitcnt lgkmcnt(0)" ::: "memory");
    }
}

__device__ void phase_gather(const Params& p, char* lds) {
    const int tidx_ = tid_opaque();
    const int wave = __builtin_amdgcn_readfirstlane((int)((blockIdx.x * blockDim.x + tidx_) >> 6)), nwaves = (gridDim.x * blockDim.x) >> 6, lane = tidx_ & 63;
    const unsigned char* vb = p.v8 + lane * 12;
    for (int t = wave; t < T_TOK; t += nwaves) {
        int idr[2]; float coef[2];
        { const int* ir = p.idx + (size_t)t * 128; idr[0] = ir[lane]; idr[1] = ir[64 + lane]; }
        { const float* cr = p.coef + (size_t)t * 128; coef[0] = cr[lane]; coef[1] = cr[64 + lane]; }
        const float cmax = wave_max(fmaxf(fabsf(coef[0]), fabsf(coef[1])));
        const float qs = cmax > 0.f ? 127.0f / cmax : 0.f, cscale = cmax * (1.0f / 127.0f);
        const int cq0 = (int)rintf(coef[0] * qs), cq1 = (int)rintf(coef[1] * qs);
        const int csum_i = wave_sum_i_uniform(cq0 + cq1);
        unsigned cpk[2];
        {
            const int cqs[2] = {cq0, cq1};
#pragma unroll
            for (int hf = 0; hf < 2; ++hf) {
                const int bb = cqs[hf] & 0xff;
                cpk[hf] = (unsigned)__builtin_amdgcn_update_dpp(0, bb, 0x00, 0xf, 0xf, false) | ((unsigned)__builtin_amdgcn_update_dpp(0, bb, 0x55, 0xf, 0xf, false) << 8)
                        | ((unsigned)__builtin_amdgcn_update_dpp(0, bb, 0xAA, 0xf, 0xf, false) << 16) | ((unsigned)__builtin_amdgcn_update_dpp(0, bb, 0xFF, 0xf, 0xf, false) << 24);
            }
        }
        int acc[16];
#pragma unroll
        for (int j = 0; j < 16; ++j) acc[j] = 0;
        {
            u32x3 va[8], vbf[8];
            auto issue = [&](int pb, u32x3 (&vv)[8]) {
#pragma unroll
                for (int q = 0; q < 8; ++q) { const int e = __builtin_amdgcn_readlane(pb < 64 ? idr[0] : idr[1], (pb & 63) + q); vv[q] = *(const u32x3*)(vb + (size_t)e * ROWB); }
            };
            auto axpy = [&](int pb, const u32x3 (&vv)[8]) {
#pragma unroll
                for (int g4 = 0; g4 < 2; ++g4) {
                    const int cqd = __builtin_amdgcn_readlane((int)(pb < 64 ? cpk[0] : cpk[1]), (pb & 63) + 4 * g4);
                    unsigned dd[4][4];
#pragma unroll
                    for (int r = 0; r < 4; ++r) {
                        const unsigned w0 = vv[4 * g4 + r].x, w1 = vv[4 * g4 + r].y, w2 = vv[4 * g4 + r].z;
                        dd[r][0] = w0 & 0x3f3f3f3fu; dd[r][1] = w1 & 0x3f3f3f3fu; dd[r][2] = w2 & 0x3f3f3f3fu;
                        dd[r][3] = ((w0 >> 6) & 0x03030303u) | ((w1 >> 4) & 0x0c0c0c0cu) | ((w2 >> 2) & 0x30303030u);
                    }
#pragma unroll
                    for (int k = 0; k < 4; ++k) {
                        const unsigned p0 = __builtin_amdgcn_perm(dd[1][k], dd[0][k], 0x05010400u), p1 = __builtin_amdgcn_perm(dd[1][k], dd[0][k], 0x07030602u);
                        const unsigned q0 = __builtin_amdgcn_perm(dd[3][k], dd[2][k], 0x05010400u), q1 = __builtin_amdgcn_perm(dd[3][k], dd[2][k], 0x07030602u);
                        const unsigned t0 = __builtin_amdgcn_perm(q0, p0, 0x05040100u), t1 = __builtin_amdgcn_perm(q0, p0, 0x07060302u);
                        const unsigned t2 = __builtin_amdgcn_perm(q1, p1, 0x05040100u), t3 = __builtin_amdgcn_perm(q1, p1, 0x07060302u);
                        acc[4 * k + 0] = __builtin_amdgcn_sdot4((int)t0, cqd, acc[4 * k + 0], false);
                        acc[4 * k + 1] = __builtin_amdgcn_sdot4((int)t1, cqd, acc[4 * k + 1], false);
                        acc[4 * k + 2] = __builtin_amdgcn_sdot4((int)t2, cqd, acc[4 * k + 2], false);
                        acc[4 * k + 3] = __builtin_amdgcn_sdot4((int)t3, cqd, acc[4 * k + 3], false);
                    }
                }
            };
            issue(0, va);
#pragma unroll 1
            for (int pb = 0; pb < 128; pb += 16) {
                issue(pb + 8, vbf);
                axpy(pb, va);
                if (pb + 16 < 128) issue(pb + 16, va);
                axpy(pb + 8, vbf);
            }
        }
        const u32x4* hr = (const u32x4*)(p.hb + (size_t)t * D_MODEL + lane * 16);
        const u32x4 ha = hr[0], hc = hr[1];
        const float hf16[16] = {bflo(ha.x), bfhi(ha.x), bflo(ha.y), bfhi(ha.y), bflo(ha.z), bfhi(ha.z), bflo(ha.w), bfhi(ha.w),
                                bflo(hc.x), bfhi(hc.x), bflo(hc.y), bfhi(hc.y), bflo(hc.z), bfhi(hc.z), bflo(hc.w), bfhi(hc.w)};
        float res[16];
        float ss = 0.f;
#pragma unroll
        for (int j = 0; j < 16; ++j) { res[j] = hf16[j] + cscale * (float)(acc[j] - 32 * csum_i); ss += res[j] * res[j]; }
        ss = wave_sum(ss);
        const float r3 = rsqrtf(ss * (1.0f / D_MODEL) + EPS);
        float* o = p.out + (size_t)t * D_MODEL + lane * 16;
        const float* fg = p.final_g + lane * 16;
#pragma unroll
        for (int i = 0; i < 4; ++i) {
            const float4 g = ((const float4*)fg)[i];
            float4 ov; ov.x = res[4 * i] * r3 * g.x; ov.y = res[4 * i + 1] * r3 * g.y; ov.z = res[4 * i + 2] * r3 * g.z; ov.w = res[4 * i + 3] * r3 * g.w;
            ((float4*)o)[i] = ov;
        }
    }
}

namespace pg8 {
#define PG8_LAS __attribute__((address_space(3)))
constexpr int BM = 256, BK = 64, HALF = 128, HTB = HALF * BK * 2, STAGE_BYTES = 8 * HTB, NXCD = 8, WGM = 8;
__host__ __device__ __forceinline__ int lds_byte(int r, int c) { const int st = (r >> 4) * 2 + (c >> 5), rr = r & 15, cc = c & 31, ob = rr * 64 + cc * 2; return st * 1024 + (ob ^ (((ob >> 9) & 1) << 5)); }
__host__ __device__ __forceinline__ void stage_rc(int b, int& R, int& C) { const int st = b / 1024, sb = b % 1024, swz = sb ^ (((sb >> 9) & 1) << 5); R = (st >> 1) * 16 + swz / 64; C = (st & 1) * 32 + (swz % 64) / 2; }
__host__ __device__ __forceinline__ int perm32(int rho) { const int n = rho >> 4, i = rho & 15; return 8 * (i >> 2) + 4 * n + (i & 3); }
struct Unit { int pm, pn; };
struct Gemm { const bf16_t* A; const bf16_t* Bt; int M, N, K; };
struct StaticOrder {
    int nM, nN, nwg, G, c;
    __host__ __device__ void init(int M, int N, int G_, int c_) { nM = M / BM; nN = N / BM; nwg = nM * nN; G = G_; c = c_; }
    __host__ __device__ bool next(int i, Unit& u) const {
        const long L = (long)i * G + c; if (L >= nwg) return false;
        int wgid = (int)L; { const int q = nwg / NXCD, r = nwg % NXCD, xcd = wgid % NXCD, off = wgid / NXCD; wgid = (xcd < r ? xcd * (q + 1) : r * (q + 1) + (xcd - r) * q) + off; }
        const int nig = WGM * nN, gid = wgid / nig, fm = gid * WGM, gsz = (nM - fm) < WGM ? (nM - fm) : WGM;
        u.pm = fm + ((wgid % nig) % gsz); u.pn = (wgid % nig) / gsz; return true;
    }
    __device__ __forceinline__ void a_ready(const Unit&) const {}
    __device__ __forceinline__ void done(const Unit&) const {}
};
__device__ __forceinline__ unsigned cvt_pk_bf16(float lo, float hi) { unsigned r; asm volatile("v_cvt_pk_bf16_f32 %0, %1, %2" : "=v"(r) : "v"(lo), "v"(hi)); return r; }
struct EpiZ {
    static constexpr bool PERM = true, AFTER_DRAIN = false;
    bf16_t* O; const float* rs;
    __device__ __forceinline__ void operator()(const f32x4 (&acc)[2][2][4][2], const Unit& u, int wr, int wc, int fr, int fq) const {
        const int row0 = u.pm * BM + wr * 64 + fr, col0 = u.pn * BM + wc * 32 + 8 * fq; const bool act = u.pn >= 2;
#pragma unroll
        for (int ai = 0; ai < 2; ++ai)
#pragma unroll
            for (int m = 0; m < 4; ++m) { const int r = row0 + ai * HALF + m * 16; const float sc = rs[r]; bf16_t* rowp = O + (size_t)r * D_IN + col0;
#pragma unroll
                for (int bj = 0; bj < 2; ++bj) { f32x4 v0 = acc[ai][bj][m][0] * sc, v1 = acc[ai][bj][m][1] * sc;
                    if (act) { v0 = (f32x4){gelu_t(v0[0]), gelu_t(v0[1]), gelu_t(v0[2]), gelu_t(v0[3])}; v1 = (f32x4){gelu_t(v1[0]), gelu_t(v1[1]), gelu_t(v1[2]), gelu_t(v1[3])}; }
                    u32x4 w; w.x = cvt_pk_bf16(v0[0], v0[1]); w.y = cvt_pk_bf16(v0[2], v0[3]); w.z = cvt_pk_bf16(v1[0], v1[1]); w.w = cvt_pk_bf16(v1[2], v1[3]);
                    *(u32x4*)(rowp + bj * HALF) = w; } }
    }
};
struct EpiOut {
    static constexpr bool PERM = true, AFTER_DRAIN = false;
    bf16_t* O; const bf16_t* X;
    __device__ __forceinline__ void operator()(const f32x4 (&acc)[2][2][4][2], const Unit& u, int wr, int wc, int fr, int fq) const {
        const int row0 = u.pm * BM + wr * 64 + fr, col0 = u.pn * BM + wc * 32 + 8 * fq;
#pragma unroll
        for (int ai = 0; ai < 2; ++ai)
#pragma unroll
            for (int m = 0; m < 4; ++m) { const size_t off = (size_t)(row0 + ai * HALF + m * 16) * D_MODEL + col0;
#pragma unroll
                for (int bj = 0; bj < 2; ++bj) { const u32x4 xx = *(const u32x4*)(X + off + bj * HALF);
                    const f32x4 v0 = acc[ai][bj][m][0] + (f32x4){bflo(xx.x), bfhi(xx.x), bflo(xx.y), bfhi(xx.y)}, v1 = acc[ai][bj][m][1] + (f32x4){bflo(xx.z), bfhi(xx.z), bflo(xx.w), bfhi(xx.w)};
                    u32x4 w; w.x = cvt_pk_bf16(v0[0], v0[1]); w.y = cvt_pk_bf16(v0[2], v0[3]); w.z = cvt_pk_bf16(v1[0], v1[1]); w.w = cvt_pk_bf16(v1[2], v1[3]);
                    *(u32x4*)(O + off + bj * HALF) = w; } }
    }
};
struct OneUnit {
    Unit u;
    __device__ __forceinline__ bool next(int i, Unit& o) const { if (i) return false; o = u; return true; }
    __device__ __forceinline__ void a_ready(const Unit&) const {}
    __device__ __forceinline__ void done(const Unit&) const {}
};
#define QT_PITCH 272
#define QT_LDS_BYTES (2 * 256 * QT_PITCH)
struct EpiQTopk {
    static constexpr bool PERM = true, AFTER_DRAIN = true;
    const bf16_t* keysB; int* idx; float* gate;
    __device__ __forceinline__ void fused(f32x4 (&acc)[2][2][4][2], const Unit& u, int wr, int wc, int fr, int fq, PG8_LAS unsigned char* ldsp, int wid, int lane) const {
        char* sQ = (char*)ldsp;
        const int h = u.pn;
#pragma unroll
        for (int ai = 0; ai < 2; ++ai)
#pragma unroll
            for (int m = 0; m < 4; ++m) { const int r = ai * HALF + wr * 64 + m * 16 + fr;
#pragma unroll
                for (int bj = 0; bj < 2; ++bj) { const f32x4 v0 = acc[ai][bj][m][0], v1 = acc[ai][bj][m][1];
                    u32x4 w; w.x = cvt_pk_bf16(v0[0], v0[1]); w.y = cvt_pk_bf16(v0[2], v0[3]); w.z = cvt_pk_bf16(v1[0], v1[1]); w.w = cvt_pk_bf16(v1[2], v1[3]);
                    *(u32x4*)(sQ + bj * (256 * QT_PITCH) + r * QT_PITCH + (wc * 32 + fq * 8) * 2) = w; } }
        __syncthreads();
        int cbv[4];
#pragma unroll
        for (int c = 0; c < 4; ++c) cbv[c] = kComb[4 * fr + c];
        int tA[2][4], tB[2][4];
#pragma unroll
        for (int m = 0; m < 2; ++m)
#pragma unroll
            for (int j = 0; j < 4; ++j) { tA[m][j] = 0; tB[m][j] = 0; }
#pragma unroll 1
        for (int pp = 0; pp < 2; ++pp) {
            const bf16_t* kb = keysB + (size_t)(pp * 8 + h) * 16384 + lane * 8;
            const char* qa = sQ + pp * (256 * QT_PITCH) + (wid * 32 + fr) * QT_PITCH + fq * 16;
            f32x4 sc2[2][8];
#pragma unroll
            for (int m = 0; m < 2; ++m)
#pragma unroll
                for (int nb = 0; nb < 8; ++nb) sc2[m][nb] = (f32x4){0.f, 0.f, 0.f, 0.f};
#pragma unroll
            for (int kk = 0; kk < 4; ++kk) {
                bf16x8 kf[8], af[2];
#pragma unroll
                for (int nb = 0; nb < 8; ++nb) kf[nb] = *(const bf16x8*)(kb + (kk * 8 + nb) * 512);
#pragma unroll
                for (int m = 0; m < 2; ++m) af[m] = *(const bf16x8*)(qa + m * 16 * QT_PITCH + kk * 64);
#pragma unroll
                for (int m = 0; m < 2; ++m)
#pragma unroll
                    for (int nb = 0; nb < 8; ++nb) sc2[m][nb] = __builtin_amdgcn_mfma_f32_16x16x32_bf16(af[m], kf[nb], sc2[m][nb], 0, 0, 0);
            }
#pragma unroll
            for (int m = 0; m < 2; ++m)
#pragma unroll
                for (int j = 0; j < 4; ++j) tA[m][j] = tB[m][j];
#pragma unroll 2
            for (int it = 0; it < 4; ++it) {
#pragma unroll
                for (int m = 0; m < 2; ++m) {
                    int k[8];
#pragma unroll
                    for (int nb = 0; nb < 8; ++nb) k[nb] = (f2key(sc2[m][nb][0]) & ~127) | (127 - (16 * nb + fr));
                    const int r = top16_rows(k, fr);
                    tB[m][0] = tB[m][1]; tB[m][1] = tB[m][2]; tB[m][2] = tB[m][3]; tB[m][3] = r;
#pragma unroll
                    for (int nb = 0; nb < 8; ++nb) sc2[m][nb] = (f32x4){sc2[m][nb][1], sc2[m][nb][2], sc2[m][nb][3], sc2[m][nb][0]};
                }
            }
        }
#pragma unroll 2
        for (int it = 0; it < 4; ++it) {
#pragma unroll
            for (int m = 0; m < 2; ++m) {
                int eid; float gt;
                combine16(tA[m][0], tB[m][0], cbv, lane, fr, eid, gt);
                const int t = u.pm * BM + wid * 32 + m * 16 + fq * 4 + it;
                const size_t o = (size_t)t * 128 + h * 16 + fr;
                idx[o] = eid; gate[o] = gt;
                tA[m][0] = tA[m][1]; tA[m][1] = tA[m][2]; tA[m][2] = tA[m][3];
                tB[m][0] = tB[m][1]; tB[m][1] = tB[m][2]; tB[m][2] = tB[m][3];
            }
        }
        __syncthreads();
    }
};
template <class Epi, class Sched>
__device__ __forceinline__ void gemm_phase(PG8_LAS unsigned char* lds, const Gemm g, const Sched& S, const Epi& E) {
    const int tid = tid_opaque(), wid = __builtin_amdgcn_readfirstlane(tid >> 6), lane = tid & 63, wr = wid >> 2, wc = wid & 3, fr = lane & 15, fq = lane >> 4;
    const int K = g.K, nt = K / BK;
    unsigned voffA[2], voffB[2];
#pragma unroll
    for (int i = 0; i < 2; ++i) { int R, C; stage_rc(tid * 16 + i * 8192, R, C); const int Rb = Epi::PERM ? ((R & ~31) + perm32(R & 31)) : R;
        voffA[i] = (unsigned)(R * K + C) * 2u; voffB[i] = (unsigned)(Rb * K + C) * 2u; }
    const size_t kstep = (size_t)(BK * 2);
    const size_t hstep = (size_t)HALF * K * 2;
    const size_t tstep = 2 * hstep;
    const unsigned ldsw = (unsigned)wid * 1024u;
    const int aoff = lds_byte(wr * 64 + fr, fq * 8), boff = lds_byte(wc * 32 + fr, fq * 8);
#define PG8_SA(b, h) (((b) * 2 + (h)) * HTB)
#define PG8_SB(b, h) ((4 + (b) * 2 + (h)) * HTB)
#define PG8_STAGE(bufoff, gbase, voff) do { _Pragma("unroll") for (int _i = 0; _i < 2; ++_i) \
        __builtin_amdgcn_global_load_lds((const unsigned*)((const char*)(gbase) + (voff)[_i]), (PG8_LAS unsigned*)(lds + (bufoff) + ldsw + _i * 8192), 16, 0, 0); } while (0)
#define PG8_LDA(dst, b, h) do { _Pragma("unroll") for (int m = 0; m < 4; ++m) _Pragma("unroll") for (int k = 0; k < 2; ++k) dst[m][k] = *(const PG8_LAS bf16x8*)(lds + PG8_SA(b, h) + aoff + m * 2048 + k * 1024); } while (0)
#define PG8_LDB(dst, b, h) do { _Pragma("unroll") for (int n = 0; n < 2; ++n) _Pragma("unroll") for (int k = 0; k < 2; ++k) dst[n][k] = *(const PG8_LAS bf16x8*)(lds + PG8_SB(b, h) + boff + n * 2048 + k * 1024); } while (0)
#define PG8_MMA(ai, bj, At, Bt) do { __builtin_amdgcn_s_setprio(1); _Pragma("unroll") for (int m = 0; m < 4; ++m) _Pragma("unroll") for (int n = 0; n < 2; ++n) _Pragma("unroll") for (int k = 0; k < 2; ++k) \
        acc[ai][bj][m][n] = __builtin_amdgcn_mfma_f32_16x16x32_bf16(Bt[n][k], At[m][k], acc[ai][bj][m][n], 0, 0, 0); __builtin_amdgcn_s_setprio(0); } while (0)
#define PG8_WAIT_V(n) asm volatile("s_waitcnt vmcnt(" #n ")" ::: "memory")
#define PG8_WAIT_L(n) asm volatile("s_waitcnt lgkmcnt(" #n ")" ::: "memory")
#define PG8_BAR __builtin_amdgcn_s_barrier()
#define PG8_SCHED __builtin_amdgcn_sched_barrier(0)
    Unit cur, nxt; int ui = 0;
    if (!S.next(0, cur)) return;
    f32x4 acc[2][2][4][2];
#pragma unroll
    for (int a = 0; a < 2; ++a)
#pragma unroll
        for (int b = 0; b < 2; ++b)
#pragma unroll
            for (int m = 0; m < 4; ++m)
#pragma unroll
                for (int n = 0; n < 2; ++n) acc[a][b][m][n] = (f32x4){0.f, 0.f, 0.f, 0.f};
    bf16x8 At[4][2], B0[2][2], B1[2][2];
    const char* cA = (const char*)g.A + (size_t)cur.pm * tstep; const char* cB = (const char*)g.Bt + (size_t)cur.pn * tstep;
    S.a_ready(cur);
    PG8_STAGE(PG8_SB(0, 0), cB, voffB); PG8_STAGE(PG8_SA(0, 0), cA, voffA); PG8_STAGE(PG8_SB(0, 1), cB + hstep, voffB); PG8_STAGE(PG8_SA(0, 1), cA + hstep, voffA);
    if (wr == 1) PG8_BAR;
    PG8_WAIT_V(4); PG8_BAR;
    PG8_STAGE(PG8_SB(1, 0), cB + kstep, voffB); PG8_STAGE(PG8_SA(1, 0), cA + kstep, voffA); PG8_STAGE(PG8_SB(1, 1), cB + hstep + kstep, voffB);
    PG8_WAIT_V(6); PG8_BAR;
    for (;;) {
        const bool has_next = S.next(ui + 1, nxt);
        const char* nA = has_next ? (const char*)g.A + (size_t)nxt.pm * tstep : cA; const char* nB = has_next ? (const char*)g.Bt + (size_t)nxt.pn * tstep : cB;
        for (int t = 0; t < nt; t += 2) {
            const bool last = (t == nt - 2);
            const char* a1 = cA + (size_t)(t + 1) * kstep;
            const char* a2 = last ? nA : cA + (size_t)(t + 2) * kstep; const char* b2 = last ? nB : cB + (size_t)(t + 2) * kstep;
            const char* a3 = a2 + kstep; const char* b3 = b2 + kstep;
            if (last && has_next) S.a_ready(nxt);
            PG8_LDB(B0, 0, 0); PG8_SCHED; PG8_LDA(At, 0, 0); PG8_STAGE(PG8_SA(1, 1), a1 + hstep, voffA);
            PG8_WAIT_L(8); PG8_BAR; PG8_WAIT_L(0); PG8_MMA(0, 0, At, B0); PG8_BAR; PG8_SCHED;
            PG8_LDB(B1, 0, 1); PG8_STAGE(PG8_SB(0, 0), b2, voffB);
            PG8_BAR; PG8_WAIT_L(0); PG8_MMA(0, 1, At, B1); PG8_BAR;
            PG8_LDA(At, 0, 1); PG8_STAGE(PG8_SA(0, 0), a2, voffA);
            PG8_BAR; PG8_WAIT_L(0); PG8_MMA(1, 0, At, B0); PG8_BAR; PG8_SCHED;
            PG8_STAGE(PG8_SB(0, 1), b2 + hstep, voffB);
            PG8_WAIT_V(6); PG8_BAR; PG8_MMA(1, 1, At, B1); PG8_BAR;
            PG8_LDB(B0, 1, 0); PG8_SCHED; PG8_LDA(At, 1, 0); PG8_STAGE(PG8_SA(0, 1), a2 + hstep, voffA);
            PG8_WAIT_L(8); PG8_BAR; PG8_WAIT_L(0); PG8_MMA(0, 0, At, B0); PG8_BAR; PG8_SCHED;
            PG8_LDB(B1, 1, 1); PG8_STAGE(PG8_SB(1, 0), b3, voffB);
            PG8_BAR; PG8_WAIT_L(0); PG8_MMA(0, 1, At, B1); PG8_BAR;
            PG8_LDA(At, 1, 1); PG8_STAGE(PG8_SA(1, 0), a3, voffA);
            PG8_BAR; PG8_WAIT_L(0); PG8_MMA(1, 0, At, B0); PG8_BAR; PG8_SCHED;
            PG8_STAGE(PG8_SB(1, 1), b3 + hstep, voffB);
            PG8_WAIT_V(6); PG8_BAR; PG8_MMA(1, 1, At, B1); PG8_BAR;
        }
            if constexpr (!Epi::AFTER_DRAIN) { E(acc, cur, wr, wc, fr, fq); S.done(cur); }
            if (!has_next) break;
#pragma unroll
        for (int a = 0; a < 2; ++a)
#pragma unroll
            for (int b = 0; b < 2; ++b)
#pragma unroll
                for (int m = 0; m < 4; ++m)
#pragma unroll
                    for (int n = 0; n < 2; ++n) acc[a][b][m][n] = (f32x4){0.f, 0.f, 0.f, 0.f};
        cur = nxt; cA = nA; cB = nB; ++ui;
    }
    PG8_WAIT_V(0);
    if (wr == 0) PG8_BAR;
    PG8_BAR;
    if constexpr (Epi::AFTER_DRAIN) { E.fused(acc, cur, wr, wc, fr, fq, lds, wid, lane); S.done(cur); }
#undef PG8_SA
#undef PG8_SB
#undef PG8_STAGE
#undef PG8_LDA
#undef PG8_LDB
#undef PG8_MMA
#undef PG8_WAIT_V
#undef PG8_WAIT_L
#undef PG8_BAR
#undef PG8_SCHED
}
}

__device__ void phase_gemm_z(const Params& p, char* lds) {
    pg8::StaticOrder S; S.init(T_TOK, D_IN, gridDim.x, blockIdx.x);
    pg8::gemm_phase<pg8::EpiZ, pg8::StaticOrder>((PG8_LAS unsigned char*)lds, pg8::Gemm{p.xb, p.winT, T_TOK, D_IN, D_MODEL}, S, pg8::EpiZ{p.zb, p.rstd1});
}
__device__ void phase_gemm_out(const Params& p, char* lds) {
    pg8::StaticOrder S; S.init(T_TOK, D_MODEL, gridDim.x, blockIdx.x);
    pg8::gemm_phase<pg8::EpiOut, pg8::StaticOrder>((PG8_LAS unsigned char*)lds, pg8::Gemm{p.cB, p.woutT, T_TOK, D_MODEL, D_MODEL}, S, pg8::EpiOut{p.hb, p.xb});
}
__device__ void phase_gemm_q(const Params& p, char* lds) {
    pg8::StaticOrder S; S.init(T_TOK, 2048, gridDim.x, blockIdx.x);
    pg8::Unit u;
    for (int i = 0; S.next(i, u); ++i)
        pg8::gemm_phase<pg8::EpiQTopk, pg8::OneUnit>((PG8_LAS unsigned char*)lds, pg8::Gemm{p.hb, p.wqT, T_TOK, 2048, D_MODEL}, pg8::OneUnit{u}, pg8::EpiQTopk{p.keysB, p.idx, p.gate});
}

#define XB_TMO      128
#define XB_XCNT(j)  (256  + 64 * (j))
#define XB_XSUB(j)  (1280 + 64 * (j))
#define XB_XGEN(j)  (2304 + 64 * (j))
#define XB_TOP      3328
#define XB_TOPGEN   3392
#define XCD_BAR_WORDS 3456
#define XB_SPIN_CAP (1u << 20)
__device__ __forceinline__ unsigned xb_ld(unsigned* p)              { return __hip_atomic_load(p, __ATOMIC_RELAXED, __HIP_MEMORY_SCOPE_AGENT); }
__device__ __forceinline__ unsigned xb_add(unsigned* p, unsigned v) { return __hip_atomic_fetch_add(p, v, __ATOMIC_RELAXED, __HIP_MEMORY_SCOPE_AGENT); }
__device__ __forceinline__ unsigned xb_xcc_id() { return (unsigned)__builtin_amdgcn_s_getreg((3 << 11) | 20) & 0xFu; }
#define XB_SPIN(cond, bar) do { unsigned _sp = 0; while (cond) { __builtin_amdgcn_s_sleep(1); \
    if ((++_sp & 255u) == 0u) { if (xb_ld(&(bar)[XB_TMO])) break; if (_sp > XB_SPIN_CAP) { atomicAdd(&(bar)[XB_TMO], 1u); break; } } } } while (0)
struct XcdBarrier { unsigned* bar; unsigned x; volatile LAS unsigned* st; };
__device__ __forceinline__ XcdBarrier xcd_barrier_post(unsigned* bar, volatile LAS unsigned* st) {
    XcdBarrier b; b.bar = bar; b.x = xb_xcc_id(); b.st = st;
    if (threadIdx.x == 0) (void)xb_add(&bar[XB_XCNT(b.x)], 1u);
    return b;
}
__device__ __forceinline__ void xcd_barrier_complete(unsigned* bar, unsigned x, unsigned& nloc, unsigned& nx) {
    const unsigned G = gridDim.x * gridDim.y * gridDim.z;
    unsigned sum, cnt, mine, sp = 0u;
    for (;;) {
        sum = 0u; cnt = 0u; mine = 0u;
#pragma unroll
        for (unsigned j = 0; j < 16; ++j) { const unsigned c = xb_ld(&bar[XB_XCNT(j)]); sum += c; cnt += (c > 0u) ? 1u : 0u; mine = (j == x) ? c : mine; }
        if (sum == G) break;
        __builtin_amdgcn_s_sleep(1);
        if ((++sp & 255u) == 0u) { if (xb_ld(&bar[XB_TMO])) break; if (sp > XB_SPIN_CAP) { atomicAdd(&bar[XB_TMO], 1u); break; } }
    }
    nloc = mine > 0u ? mine : 1u; nx = cnt > 0u ? cnt : 1u;
}
__device__ __forceinline__ void xcd_barrier(const XcdBarrier& b) {
    asm volatile("s_waitcnt vmcnt(0)" ::: "memory");
    __syncthreads();
    if (threadIdx.x == 0) {
        unsigned* bar = b.bar;
        __builtin_amdgcn_s_waitcnt(0);
        unsigned nloc = b.st[0], nx = b.st[1];
        if (nloc == 0u) { xcd_barrier_complete(bar, b.x, nloc, nx); b.st[0] = nloc; b.st[1] = nx; }
        const unsigned old = xb_add(&bar[XB_XSUB(b.x)], 1u);
        const unsigned gen = old / nloc;
        if (old + 1u == (gen + 1u) * nloc) {
            __builtin_amdgcn_fence(__ATOMIC_RELEASE, "agent");
            asm volatile("s_waitcnt vmcnt(0)" ::: "memory");
            const unsigned og = xb_add(&bar[XB_TOP], 1u);
            const unsigned tg = og / nx;
            if (og + 1u == (tg + 1u) * nx) xb_add(&bar[XB_TOPGEN], 1u);
            else XB_SPIN(xb_ld(&bar[XB_TOPGEN]) == tg, bar);
            __builtin_amdgcn_fence(__ATOMIC_ACQUIRE, "agent");
            xb_add(&bar[XB_XGEN(b.x)], 1u);
            asm volatile("s_waitcnt vmcnt(0)" ::: "memory");
        } else {
            XB_SPIN(xb_ld(&bar[XB_XGEN(b.x)]) == gen, bar);
            __builtin_amdgcn_fence(__ATOMIC_ACQUIRE, "agent");
            asm volatile("s_waitcnt vmcnt(0)" ::: "memory");
        }
    }
    __syncthreads();
}

#define MEGA_LDS_MAX2(a, b) ((a) > (b) ? (a) : (b))
#define MEGA_LDS_MAIN MEGA_LDS_MAX2(MEGA_LDS_MAX2(QT_LDS_BYTES, pg8::STAGE_BYTES), MEGA_LDS_MAX2(8 * TS_WBYTES, 2 * MIXH_LDS))
#define MEGA_LDS_BYTES (MEGA_LDS_MAIN + 16)
extern __shared__ __attribute__((aligned(16))) char smem[];
__global__ void __launch_bounds__(512, 2) fwd_mega(Params p) {
    volatile LAS unsigned* st = (volatile LAS unsigned*)(smem + MEGA_LDS_MAIN);
    if (threadIdx.x < 4) st[threadIdx.x] = 0u;
    __syncthreads();
    const XcdBarrier xb = xcd_barrier_post(p.bar, st);
    phase_prep(p, smem);      xcd_barrier(xb);
    phase_gemm_z(p, smem);    xcd_barrier(xb);
    phase_mix_gemm(p, smem);  xcd_barrier(xb);
    phase_gemm_out(p, smem);  xcd_barrier(xb);
    phase_gemm_q(p, smem);    xcd_barrier(xb);
    phase_peer_dots(p, smem); xcd_barrier(xb);
    phase_gather(p, smem);
}

extern "C" void kernel_launch(void* const* d_in, const int* in_sizes, int n_in, void* d_out, int out_size, void* d_ws, size_t ws_size, hipStream_t stream) {
    static int grid_blocks = 0;
    if (grid_blocks == 0) {
        int dev = 0, cus = 0, per_cu = 0;
        (void)hipGetDevice(&dev);
        (void)hipDeviceGetAttribute(&cus, hipDeviceAttributeMultiprocessorCount, dev);
        (void)hipFuncSetAttribute((const void*)fwd_mega, hipFuncAttributeMaxDynamicSharedMemorySize, MEGA_LDS_BYTES);
        (void)hipOccupancyMaxActiveBlocksPerMultiprocessor(&per_cu, (const void*)fwd_mega, 512, MEGA_LDS_BYTES);
        if (per_cu > 1) per_cu = 1;
        if (per_cu < 1) per_cu = 1;
        grid_blocks = cus * per_cu;
    }
    Params p{};
    p.x = (const float*)d_in[0]; p.norm1_g = (const float*)d_in[1]; p.w_in = (const float*)d_in[2]; p.pool_w = (const float*)d_in[3];
    p.pool_scale = (const float*)d_in[4]; p.sgu_norm_g = (const float*)d_in[5]; p.sgu_w = (const float*)d_in[6]; p.sgu_b = (const float*)d_in[7];
    p.w_out = (const float*)d_in[8]; p.norm2_g = (const float*)d_in[9]; p.peer_wq = (const float*)d_in[10]; p.peer_keys = (const float*)d_in[11];
    p.peer_u = (const float*)d_in[12]; p.peer_v = (const float*)d_in[13]; p.final_g = (const float*)d_in[14];
    p.out = (float*)d_out;
    char* w = (char*)d_ws; size_t off = 0;
    auto take = [&](size_t bytes) { char* r = w + off; off += (bytes + 255) & ~(size_t)255; return r; };
    const size_t MiB = 1024 * 1024;
    p.u8 = (unsigned char*)take(16 * MiB); p.v8 = (unsigned char*)take(12 * MiB);
    p.suv = (float2*)take(128 * 1024);
    p.winT = (bf16_t*)take(3 * MiB); p.woutT = (bf16_t*)take(2 * MiB); p.wqT = (bf16_t*)take(4 * MiB);
    p.poolT = (bf16_t*)take(128 * 1024); p.wsM = (bf16_t*)take(128 * 1024); p.keysB = (bf16_t*)take(512 * 1024);
    p.bar = (unsigned*)take(XCD_BAR_WORDS * 4);
    p.rstd1 = (float*)take(128 * 1024);
    p.idx = (int*)take(16 * MiB); p.gate = (float*)take(16 * MiB); p.coef = (float*)take(16 * MiB);
    p.xb = (bf16_t*)take(64 * MiB); p.zb = (bf16_t*)take(96 * MiB); p.cB = (bf16_t*)take(64 * MiB); p.hb = (bf16_t*)take(64 * MiB);
    (void)hipMemsetAsync(p.bar, 0, XCD_BAR_WORDS * 4, stream);
    hipLaunchKernelGGL(fwd_mega, dim3(grid_blocks), dim3(512), MEGA_LDS_BYTES, stream, p);
}
```

```cpp
#include <hip/hip_runtime.h>
#include <stdint.h>
#include <type_traits>

typedef unsigned short bf16_t;
typedef short bf16x8 __attribute__((ext_vector_type(8)));
typedef float f32x4 __attribute__((ext_vector_type(4)));
typedef unsigned u32x4 __attribute__((ext_vector_type(4)));
typedef unsigned u32x2 __attribute__((ext_vector_type(2)));
typedef unsigned u32x3 __attribute__((ext_vector_type(3)));
typedef int i32x4 __attribute__((ext_vector_type(4)));
#define ROWB 768
typedef __bf16 bf2_t __attribute__((ext_vector_type(2)));
#define LAS __attribute__((address_space(3)))

#define T_TOK 32768
#define D_MODEL 1024
#define D_IN 1536
#define SEQ 2048
#define NEXP 16384
#define EPS 1e-6f

struct Params {
    const float *x, *norm1_g, *w_in, *pool_w, *pool_scale, *sgu_norm_g, *sgu_w, *sgu_b, *w_out, *norm2_g, *peer_wq, *peer_keys, *peer_u, *peer_v, *final_g;
    float* out;
    bf16_t *winT, *woutT, *wqT, *poolT, *wsM, *keysB;
    unsigned char *u8, *v8;
    float2* suv;
    float *rstd1;
    signed char *xq, *winT8; unsigned* swb;
    bf16_t *xb, *zb, *cB, *hb;
    int* idx; float* gate; float* coef;
    unsigned* bar;
};

__device__ __forceinline__ int tid_opaque() { int t = (int)threadIdx.x; asm volatile("" : "+v"(t)); return t; }
__device__ __forceinline__ unsigned short f2bf(float f) {
    unsigned u = __float_as_uint(f);
    u += 0x7fffu + ((u >> 16) & 1u);
    return (unsigned short)(u >> 16);
}
__device__ __forceinline__ float bf2f(unsigned short h) { return __uint_as_float(((unsigned)h) << 16); }
__device__ __forceinline__ unsigned pack2(float a, float b) { return (unsigned)f2bf(a) | ((unsigned)f2bf(b) << 16); }
__device__ __forceinline__ float bflo(unsigned w) { return __uint_as_float(w << 16); }
__device__ __forceinline__ float bfhi(unsigned w) { return __uint_as_float(w & 0xffff0000u); }
__device__ __forceinline__ float gelu_t(float x) {
    const float y = 1.5957691216057308f * (x + 0.044715f * x * x * x);
    return x * __builtin_amdgcn_rcpf(1.0f + __expf(-y));
}
__device__ __forceinline__ float wave_sum(float v) {
#pragma unroll
    for (int o = 32; o >= 1; o >>= 1) v += __shfl_xor(v, o);
    return v;
}
__device__ __forceinline__ float wave_max(float v) {
#pragma unroll
    for (int o = 32; o >= 1; o >>= 1) v = fmaxf(v, __shfl_xor(v, o));
    return v;
}

#define GEMM_LDS_BYTES (2 * 128 * 144)
__device__ __forceinline__ void transpose_tile(const int tid, const float* __restrict__ src, bf16_t* __restrict__ dst, int R, int C, const float* __restrict__ rscale, int tile, float* lds) {
    const int tilesC = C / 64, tr = tile / tilesC, tc = tile % tilesC;
    const int ty = tid >> 6, tx = tid & 63;
    __syncthreads();
#pragma unroll
    for (int i = 0; i < 16; ++i) {
        const int r = ty + 4 * i;
        float v = src[(size_t)(tr * 64 + r) * C + tc * 64 + tx];
        if (rscale) v *= rscale[tr * 64 + r];
        lds[r * 65 + tx] = v;
    }
    __syncthreads();
#pragma unroll
    for (int i = 0; i < 16; ++i) {
        const int c = ty + 4 * i;
        dst[(size_t)(tc * 64 + c) * R + tr * 64 + tx] = f2bf(lds[tx * 65 + c]);
    }
}

__device__ __forceinline__ void prep_w8_tiles(const Params& p, char* lds, int tid) {
    const int half = tid >> 8, ht = tid & 255, ty = ht >> 6, tx = ht & 63;
    float* fl = (float*)(lds + half * (64 * 65 * 4));
    for (int t = 2 * blockIdx.x + half; t < 16 * 24; t += 2 * gridDim.x) {
        const int tr = t / 24, tc = t % 24;
        if (ht == 0) {
            unsigned spins = 0;
            while (__hip_atomic_load(p.swb + 1536 + tc, __ATOMIC_RELAXED, __HIP_MEMORY_SCOPE_AGENT) < 16u && ++spins < (1u << 22)) __builtin_amdgcn_s_sleep(2);
        }
        __syncthreads();
#pragma unroll
        for (int i = 0; i < 16; ++i) {
            const int r = ty + 4 * i;
            fl[r * 65 + tx] = p.w_in[(size_t)(tr * 64 + r) * 1536 + tc * 64 + tx] * p.norm1_g[tr * 64 + r];
        }
        __syncthreads();
#pragma unroll
        for (int i = 0; i < 16; ++i) {
            const int c = ty + 4 * i;
            const float am = __uint_as_float(__hip_atomic_load(p.swb + tc * 64 + c, __ATOMIC_RELAXED, __HIP_MEMORY_SCOPE_AGENT));
            const float inv = am > 0.f ? 127.0f / am : 0.f;
            p.winT8[(size_t)(tc * 64 + c) * 1024 + tr * 64 + tx] = (signed char)(int)rintf(fl[tx * 65 + c] * inv);
        }
    }
}

__device__ void phase_prep(const Params& p, char* lds) {
    const int tidx_ = tid_opaque();
    const int nb = gridDim.x, b = blockIdx.x, tid = tidx_;
    const int half = tid >> 8, ht = tid & 255, nh = 2 * nb, hb2 = 2 * b + half;
    float* fl = (float*)(lds + half * (64 * 65 * 4));
    for (int t = hb2; t < 16 * 24; t += nh) {
        const int tr = t / 24, tc = t % 24, ty = ht >> 6, tx = ht & 63;
        float am = 0.f;
#pragma unroll
        for (int i = 0; i < 16; ++i) { const int r = tr * 64 + ty + 4 * i; am = fmaxf(am, fabsf(p.w_in[(size_t)r * 1536 + tc * 64 + tx] * p.norm1_g[r])); }
        (void)__hip_atomic_fetch_max(p.swb + tc * 64 + tx, __float_as_uint(am), __ATOMIC_RELAXED, __HIP_MEMORY_SCOPE_AGENT);
        asm volatile("s_waitcnt vmcnt(0)" ::: "memory");
        __syncthreads();
        if (ht == 0) (void)__hip_atomic_fetch_add(p.swb + 1536 + tc, 1u, __ATOMIC_RELAXED, __HIP_MEMORY_SCOPE_AGENT);
    }
    for (int t = hb2; t < 16 * 16; t += nh) transpose_tile(ht, p.w_out, p.woutT, 1024, 1024, nullptr, t, fl);
    for (int t = hb2; t < 16 * 32; t += nh) transpose_tile(ht, p.peer_wq, p.wqT, 1024, 2048, p.norm2_g, t, fl);
    for (int t = hb2; t < 16; t += nh) transpose_tile(ht, p.pool_w + (size_t)(t >> 2) * 16384, p.poolT + (size_t)(t >> 2) * 16384, 128, 128, nullptr, t & 3, fl);
    const size_t gtid = (size_t)b * blockDim.x + tid, gsz = (size_t)nb * blockDim.x;
    for (size_t i = gtid; i < 4 * 128 * 128; i += gsz) {
        const int j = (int)(i & 127), ii = (int)((i >> 7) & 127);
        const bool keep = (j >> 6) <= (ii >> 6);
        p.wsM[i] = keep ? f2bf(p.sgu_w[i]) : (bf16_t)0;
    }
    for (size_t o = gtid; o < 2 * 8 * 128 * 128; o += gsz) {
        const int j = (int)(o & 7), ln = (int)((o >> 3) & 63), nb = (int)((o >> 9) & 7), kk = (int)((o >> 12) & 3), ph = (int)(o >> 14);
        p.keysB[o] = f2bf(p.peer_keys[(size_t)ph * 16384 + (size_t)(16 * nb + (ln & 15)) * 128 + 32 * kk + 8 * (ln >> 4) + j]);
    }
    {
        const int wave = (b * blockDim.x + tid) >> 6, nwaves = (nb * blockDim.x) >> 6, lane = tid & 63;
        float g16[16];
#pragma unroll
        for (int i = 0; i < 4; ++i) { const float4 g = ((const float4*)(p.norm2_g + lane * 16))[i]; g16[4 * i] = g.x; g16[4 * i + 1] = g.y; g16[4 * i + 2] = g.z; g16[4 * i + 3] = g.w; }
        auto quant_row = [&](const float (&f)[16], unsigned char* dst, float* scale_out) {
            float am = 0.f;
#pragma unroll
            for (int j = 0; j < 16; ++j) am = fmaxf(am, fabsf(f[j]));
            am = wave_max(am);
            const float inv = am > 0.f ? 31.0f / am : 0.f;
            int q[16];
#pragma unroll
            for (int j = 0; j < 16; ++j) q[j] = (int)rintf(f[j] * inv) + 32;
            u32x3 o;
#pragma unroll
            for (int i = 0; i < 3; ++i) {
                unsigned w = 0;
#pragma unroll
                for (int k = 0; k < 4; ++k) w |= (unsigned)(q[4 * i + k] | (((q[12 + k] >> (2 * i)) & 3) << 6)) << (8 * k);
                o[i] = w;
            }
            *(u32x3*)(dst + lane * 12) = o;
            if (lane == 0) *scale_out = am * (1.0f / 31.0f);
        };
        for (int e = wave; e < NEXP; e += nwaves) {
            const float4* su4 = (const float4*)(p.peer_u + (size_t)e * D_MODEL + lane * 16);
            const float4* sv4 = (const float4*)(p.peer_v + (size_t)e * D_MODEL + lane * 16);
            float4 a4[4], b4[4];
#pragma unroll
            for (int i = 0; i < 4; ++i) { a4[i] = su4[i]; b4[i] = sv4[i]; }
            float fu[16], fv[16];
#pragma unroll
            for (int i = 0; i < 4; ++i) {
                fu[4 * i] = a4[i].x * g16[4 * i]; fu[4 * i + 1] = a4[i].y * g16[4 * i + 1]; fu[4 * i + 2] = a4[i].z * g16[4 * i + 2]; fu[4 * i + 3] = a4[i].w * g16[4 * i + 3];
                fv[4 * i] = b4[i].x; fv[4 * i + 1] = b4[i].y; fv[4 * i + 2] = b4[i].z; fv[4 * i + 3] = b4[i].w;
            }
            {
                float am = 0.f;
#pragma unroll
                for (int j = 0; j < 16; ++j) am = fmaxf(am, fabsf(fu[j]));
                am = wave_max(am);
                const float inv = am > 0.f ? 127.0f / am : 0.f;
                u32x4 o;
#pragma unroll
                for (int i = 0; i < 4; ++i) {
                    unsigned w = 0;
#pragma unroll
                    for (int k = 0; k < 4; ++k) w |= (unsigned)(((int)rintf(fu[4 * i + k] * inv)) & 0xff) << (8 * k);
                    o[i] = w;
                }
                *(u32x4*)(p.u8 + (size_t)e * D_MODEL + lane * 16) = o;
                if (lane == 0) p.suv[e].x = am * (1.0f / 127.0f);
            }
            quant_row(fv, p.v8 + (size_t)e * ROWB, &p.suv[e].y);
        }
    }
    const int wave = (b * blockDim.x + tid) >> 6, nwaves = (nb * blockDim.x) >> 6, lane = tid & 63;
    for (int t = wave; t < T_TOK; t += 2 * nwaves) {
        const int t1 = t + nwaves; const bool two = t1 < T_TOK;
        const float4* xr0 = (const float4*)(p.x + (size_t)t * D_MODEL);
        const float4* xr1 = (const float4*)(p.x + (size_t)(two ? t1 : t) * D_MODEL);
        float4 v0[4], v1[4];
#pragma unroll
        for (int i = 0; i < 4; ++i) { v0[i] = xr0[lane + 64 * i]; v1[i] = xr1[lane + 64 * i]; }
        float s0 = 0.f, s1 = 0.f, a0 = 0.f, a1 = 0.f;
#pragma unroll
        for (int i = 0; i < 4; ++i) {
            s0 += v0[i].x * v0[i].x + v0[i].y * v0[i].y + v0[i].z * v0[i].z + v0[i].w * v0[i].w;
            s1 += v1[i].x * v1[i].x + v1[i].y * v1[i].y + v1[i].z * v1[i].z + v1[i].w * v1[i].w;
            a0 = fmaxf(fmaxf(a0, fmaxf(fabsf(v0[i].x), fabsf(v0[i].y))), fmaxf(fabsf(v0[i].z), fabsf(v0[i].w)));
            a1 = fmaxf(fmaxf(a1, fmaxf(fabsf(v1[i].x), fabsf(v1[i].y))), fmaxf(fabsf(v1[i].z), fabsf(v1[i].w)));
            uint2 o; o.x = pack2(v0[i].x, v0[i].y); o.y = pack2(v0[i].z, v0[i].w);
            ((uint2*)(p.xb + (size_t)t * D_MODEL))[lane + 64 * i] = o;
            if (two) { uint2 o1; o1.x = pack2(v1[i].x, v1[i].y); o1.y = pack2(v1[i].z, v1[i].w); ((uint2*)(p.xb + (size_t)t1 * D_MODEL))[lane + 64 * i] = o1; }
        }
        s0 = wave_sum(s0); s1 = wave_sum(s1); a0 = wave_max(a0); a1 = wave_max(a1);
        const float i0 = a0 > 0.f ? 127.0f / a0 : 0.f, i1 = a1 > 0.f ? 127.0f / a1 : 0.f;
#pragma unroll
        for (int i = 0; i < 4; ++i) {
            const unsigned q0 = ((unsigned)((int)rintf(v0[i].x * i0) & 0xff)) | ((unsigned)((int)rintf(v0[i].y * i0) & 0xff) << 8) | ((unsigned)((int)rintf(v0[i].z * i0) & 0xff) << 16) | ((unsigned)((int)rintf(v0[i].w * i0) & 0xff) << 24);
            ((unsigned*)(p.xq + (size_t)t * D_MODEL))[lane + 64 * i] = q0;
            if (two) {
                const unsigned q1 = ((unsigned)((int)rintf(v1[i].x * i1) & 0xff)) | ((unsigned)((int)rintf(v1[i].y * i1) & 0xff) << 8) | ((unsigned)((int)rintf(v1[i].z * i1) & 0xff) << 16) | ((unsigned)((int)rintf(v1[i].w * i1) & 0xff) << 24);
                ((unsigned*)(p.xq + (size_t)t1 * D_MODEL))[lane + 64 * i] = q1;
            }
        }
        if (lane == 0) {
            p.rstd1[t] = rsqrtf(s0 * (1.0f / D_MODEL) + EPS) * a0 * (1.0f / 127.0f);
            if (two) p.rstd1[t1] = rsqrtf(s1 * (1.0f / D_MODEL) + EPS) * a1 * (1.0f / 127.0f);
        }
    }
    prep_w8_tiles(p, lds, tid);
}

typedef short s16x4 __attribute__((ext_vector_type(4)));
template <class Epi>
__device__ __forceinline__ void gemm128_sgu(const int tid, const bf16_t* __restrict__ A, const bf16_t* __restrict__ V  ,
                                            const float* __restrict__ lnm, const float* __restrict__ lnr, const float* __restrict__ gch, char* lds, const Epi& epi) {
    const int lane = tid & 63, wid = tid >> 6, wr = wid >> 1, wc = wid & 1, fr = lane & 15, fq = lane >> 4;
    constexpr int PITCH = 144, P2 = 288;
    char* sA = lds; char* sB = lds + 128 * PITCH;
    f32x4 acc[4][4];
#pragma unroll
    for (int m = 0; m < 4; ++m)
#pragma unroll
        for (int n = 0; n < 4; ++n) acc[m][n] = (f32x4){0.f, 0.f, 0.f, 0.f};
    u32x4 ra[4], rb[4]; float rm[4], rr[4];
    const int lrow = tid >> 3, lch = tid & 7;
    const int btok = tid >> 4, bch = tid & 15;
    const bf16_t* ga = A + (size_t)lrow * 128 + lch * 8;
    const bf16_t* gb = V + (size_t)btok * D_IN + bch * 8;
    float g8[8];
    { const float4 g0 = *(const float4*)(gch + bch * 8), g1 = *(const float4*)(gch + bch * 8 + 4); g8[0] = g0.x; g8[1] = g0.y; g8[2] = g0.z; g8[3] = g0.w; g8[4] = g1.x; g8[5] = g1.y; g8[6] = g1.z; g8[7] = g1.w; }
#pragma unroll
    for (int j = 0; j < 4; ++j) { ra[j] = *(const u32x4*)(ga + (size_t)(32 * j) * 128); rb[j] = *(const u32x4*)(gb + (size_t)(16 * j) * D_IN); rm[j] = lnm[btok + 16 * j]; rr[j] = lnr[btok + 16 * j]; }
    for (int k0 = 0; k0 < 128; k0 += 64) {
        __syncthreads();
#pragma unroll
        for (int j = 0; j < 4; ++j) {
            *(u32x4*)(sA + (lrow + 32 * j) * PITCH + lch * 16) = ra[j];
            u32x4 o;
#pragma unroll
            for (int i = 0; i < 4; ++i) {
                const unsigned w = rb[j][i];
                o[i] = pack2((bflo(w) - rm[j]) * rr[j] * g8[2 * i], (bfhi(w) - rm[j]) * rr[j] * g8[2 * i + 1]);
            }
            *(u32x4*)(sB + (btok + 16 * j) * P2 + bch * 16) = o;
        }
        __syncthreads();
        if (k0 + 64 < 128) {
#pragma unroll
            for (int j = 0; j < 4; ++j) { ra[j] = *(const u32x4*)(ga + (size_t)(32 * j) * 128 + 64); rb[j] = *(const u32x4*)(gb + (size_t)(64 + 16 * j) * D_IN); rm[j] = lnm[64 + btok + 16 * j]; rr[j] = lnr[64 + btok + 16 * j]; }
        }
#pragma unroll
        for (int kk = 0; kk < 2; ++kk) {
            bf16x8 af[4], bfr[4];
#pragma unroll
            for (int m = 0; m < 4; ++m) af[m] = *(const bf16x8*)(sA + (wr * 64 + m * 16 + fr) * PITCH + (kk * 32 + fq * 8) * 2);
#pragma unroll
            for (int n = 0; n < 4; ++n) {
                const char* bp = sB + (kk * 32 + fq * 8 + (fr >> 2)) * P2 + (wc * 64 + n * 16 + 4 * (fr & 3)) * 2;
                const s16x4 lo = __builtin_amdgcn_ds_read_tr16_b64_v4i16((LAS s16x4*)(bp));
                const s16x4 hi = __builtin_amdgcn_ds_read_tr16_b64_v4i16((LAS s16x4*)(bp + 4 * P2));
                bfr[n] = (bf16x8){lo[0], lo[1], lo[2], lo[3], hi[0], hi[1], hi[2], hi[3]};
            }
#pragma unroll
            for (int m = 0; m < 4; ++m)
#pragma unroll
                for (int n = 0; n < 4; ++n) acc[m][n] = __builtin_amdgcn_mfma_f32_16x16x32_bf16(bfr[n], af[m], acc[m][n], 0, 0, 0);
        }
    }
#pragma unroll
    for (int m = 0; m < 4; ++m)
#pragma unroll
        for (int n = 0; n < 4; ++n) epi(wr * 64 + m * 16 + fr, wc * 64 + n * 16 + fq * 4, acc[m][n]);
}

#define PT_PITCH 272
#define MIXH_LDS (2 * 128 * PT_PITCH + 1024)
template <int W, class Epi>
__device__ __forceinline__ void pool_tile(const int tid, const bf16_t* __restrict__ zb0  , int pos0,
                                          const bf16_t* __restrict__ Bt, char* lds, const Epi& epi) {
    const int lane = tid & 63, wid = tid >> 6, wr = wid >> 1, wc = wid & 1, fr = lane & 15, fq = lane >> 4;
    char* sA = lds; char* sB = lds + 128 * PT_PITCH;
    __syncthreads();
#pragma unroll
    for (int j = 0; j < 8; ++j) { const int id = tid + 256 * j, row = id >> 4, ch = id & 15; *(u32x4*)(sB + row * PT_PITCH + ch * 16) = *(const u32x4*)(Bt + (size_t)row * 128 + ch * 8); }
    {
        const int seg = tid >> 5, hc = tid & 31, r0 = seg * 16;
        const bool at_start = (pos0 & (SEQ - 1)) == 0;
        const bf16_t* zp = zb0 + hc * 4;
        u32x2 v[W + 16];
#pragma unroll
        for (int i = 0; i < W + 16; ++i) { const int rr = r0 - W + i; const bool ok = !(at_start && rr < 0); v[i] = *(const u32x2*)(zp + (ptrdiff_t)(ok ? rr : 0) * D_IN); }
        float sm[4] = {0.f, 0.f, 0.f, 0.f};
#pragma unroll
        for (int i = 1; i <= W; ++i) {
            const float m = (at_start && (r0 - W + i) < 0) ? 0.f : 1.f;
            sm[0] += m * bflo(v[i].x); sm[1] += m * bfhi(v[i].x); sm[2] += m * bflo(v[i].y); sm[3] += m * bfhi(v[i].y);
        }
#pragma unroll
        for (int o = 0; o < 16; ++o) {
            if (o > 0) {
                const float md = (at_start && (r0 + o - W) < 0) ? 0.f : 1.f;
                sm[0] += bflo(v[W + o].x) - md * bflo(v[o].x); sm[1] += bfhi(v[W + o].x) - md * bfhi(v[o].x);
                sm[2] += bflo(v[W + o].y) - md * bflo(v[o].y); sm[3] += bfhi(v[W + o].y) - md * bfhi(v[o].y);
            }
            const int pos = (pos0 + r0 + o) & (SEQ - 1);
            const float rn = 1.0f / (float)((pos + 1 < W) ? pos + 1 : W);
            u32x2 ov;
            ov.x = pack2(sm[0] * rn - bflo(v[W + o].x), sm[1] * rn - bfhi(v[W + o].x));
            ov.y = pack2(sm[2] * rn - bflo(v[W + o].y), sm[3] * rn - bfhi(v[W + o].y));
            *(u32x2*)(sA + (r0 + o) * PT_PITCH + hc * 8) = ov;
        }
    }
    __syncthreads();
    f32x4 acc[4][4];
#pragma unroll
    for (int m = 0; m < 4; ++m)
#pragma unroll
        for (int n = 0; n < 4; ++n) acc[m][n] = (f32x4){0.f, 0.f, 0.f, 0.f};
#pragma unroll
    for (int kk = 0; kk < 4; ++kk) {
        bf16x8 af[4], bfr[4];
#pragma unroll
        for (int m = 0; m < 4; ++m) af[m] = *(const bf16x8*)(sA + (wr * 64 + m * 16 + fr) * PT_PITCH + (kk * 32 + fq * 8) * 2);
#pragma unroll
        for (int n = 0; n < 4; ++n) bfr[n] = *(const bf16x8*)(sB + (wc * 64 + n * 16 + fr) * PT_PITCH + (kk * 32 + fq * 8) * 2);
#pragma unroll
        for (int m = 0; m < 4; ++m)
#pragma unroll
            for (int n = 0; n < 4; ++n) acc[m][n] = __builtin_amdgcn_mfma_f32_16x16x32_bf16(bfr[n], af[m], acc[m][n], 0, 0, 0);
    }
#pragma unroll
    for (int m = 0; m < 4; ++m)
#pragma unroll
        for (int n = 0; n < 4; ++n) epi(wr * 64 + m * 16 + fr, wc * 64 + n * 16 + fq * 4, acc[m][n]);
}

__device__ void phase_mix_gemm(const Params& p, char* lds) {
    const int tidx_ = tid_opaque();
    const int npool = (T_TOK / 128) * 4, nsgu = (T_TOK / 128) * 4;
    const int half = tidx_ >> 8, ht = tidx_ & 255; lds += half * MIXH_LDS;
    for (int tile = 2 * blockIdx.x + half; tile < npool + nsgu; tile += 2 * gridDim.x) {
        if (tile < npool) {
            const int tm = tile >> 2, g = tile & 3;
            const float* ps = p.pool_scale + g * 128; bf16_t* co = p.cB + (size_t)tm * 128 * D_MODEL + g * 128;
            const bf16_t* z0 = p.zb + (size_t)tm * 128 * D_IN + g * 128; const bf16_t* bt = p.poolT + (size_t)g * 16384;
            auto epi = [&](int r, int c, f32x4 v) {
                const float4 sc = *(const float4*)(ps + c);
                uint2 o; o.x = pack2(v[0] * sc.x, v[1] * sc.y); o.y = pack2(v[2] * sc.z, v[3] * sc.w);
                *(uint2*)(co + (size_t)r * D_MODEL + c) = o;
            };
            if (g == 0) pool_tile<2>(ht, z0, tm * 128, bt, lds, epi); else if (g == 1) pool_tile<4>(ht, z0, tm * 128, bt, lds, epi);
            else if (g == 2) pool_tile<8>(ht, z0, tm * 128, bt, lds, epi); else pool_tile<16>(ht, z0, tm * 128, bt, lds, epi);
        } else {
            const int t2 = tile - npool, blk = t2 >> 2, h = t2 & 3;
            float* stm = (float*)(lds + GEMM_LDS_BYTES); float* str = stm + 128;
            __syncthreads();
            {
                const int tok = ht >> 1, hh = ht & 1;
                const u32x4* vp = (const u32x4*)(p.zb + (size_t)(blk * 128 + tok) * D_IN + 1024 + hh * 256);
                float s1 = 0.f, s2 = 0.f;
#pragma unroll 8
                for (int i = 0; i < 32; ++i) {
                    const u32x4 v = vp[i];
#pragma unroll
                    for (int k = 0; k < 4; ++k) { const float a = bflo(v[k]), c = bfhi(v[k]); s1 += a + c; s2 += a * a + c * c; }
                }
                s1 += __shfl_xor(s1, 1); s2 += __shfl_xor(s2, 1);
                const float mean = s1 * (1.0f / 512.0f), var = fmaxf(s2 * (1.0f / 512.0f) - mean * mean, 0.f);
                if (hh == 0) { stm[tok] = mean; str[tok] = rsqrtf(var + EPS); }
            }
            __syncthreads();
            const float* sb = p.sgu_b + h * 128; const bf16_t* uo = p.zb + (size_t)blk * 128 * D_IN + 512 + h * 128;
            bf16_t* co = p.cB + (size_t)blk * 128 * D_MODEL + 512 + h * 128;
            gemm128_sgu(ht, p.wsM + (size_t)h * 16384, p.zb + (size_t)blk * 128 * D_IN + 1024 + h * 128, stm, str, p.sgu_norm_g + h * 128, lds,
                    [&](int r, int c, f32x4 v) {
                        const float bb = sb[r];
                        const uint2 uu = *(const uint2*)(uo + (size_t)r * D_IN + c);
                        uint2 o;
                        o.x = pack2((v[0] + bb) * bflo(uu.x), (v[1] + bb) * bfhi(uu.x));
                        o.y = pack2((v[2] + bb) * bflo(uu.y), (v[3] + bb) * bfhi(uu.y));
                        *(uint2*)(co + (size_t)r * D_MODEL + c) = o;
                    });
        }
    }
}

__device__ __forceinline__ int wave_sum_i_uniform(int s) {
    s += __builtin_amdgcn_update_dpp(0, s, 0xB1, 0xf, 0xf, false);
    s += __builtin_amdgcn_update_dpp(0, s, 0x4E, 0xf, 0xf, false);
    s += __builtin_amdgcn_update_dpp(0, s, 0x141, 0xf, 0xf, false);
    s += __builtin_amdgcn_update_dpp(0, s, 0x140, 0xf, 0xf, false);
    return __builtin_amdgcn_readlane(s, 0) + __builtin_amdgcn_readlane(s, 16) + __builtin_amdgcn_readlane(s, 32) + __builtin_amdgcn_readlane(s, 48);
}
__constant__ unsigned char kComb[64] = {
    0x00,0x01,0x02,0x03,0x04,0x05,0x06,0x07,0x08,0x09,0x0a,0x0b,0x0c,0x0d,0x0e,0x0f,
    0x10,0x11,0x12,0x13,0x14,0x15,0x16,0x17,
    0x20,0x21,0x22,0x23,0x24,
    0x30,0x31,0x32,0x33,
    0x40,0x41,0x42,
    0x50,0x51,
    0x60,0x61,
    0x70,0x71,
    0x80,0x90,0xa0,0xb0,0xc0,0xd0,0xe0,0xf0,
    0xff,0xff,0xff,0xff,0xff,0xff,0xff,0xff,0xff,0xff,0xff,0xff,0xff,0xff};

template <int CTRL> __device__ __forceinline__ int dpp_i(int v) { return __builtin_amdgcn_update_dpp(0, v, CTRL, 0xf, 0xf, false); }
__device__ __forceinline__ int row_allmax_i(int v) {
    v = max(v, dpp_i<0x128>(v)); v = max(v, dpp_i<0x124>(v)); v = max(v, dpp_i<0x122>(v)); v = max(v, dpp_i<0x121>(v));
    return v;
}
__device__ __forceinline__ float row_allsum_f(float v) {
    v += __int_as_float(dpp_i<0x128>(__float_as_int(v))); v += __int_as_float(dpp_i<0x124>(__float_as_int(v)));
    v += __int_as_float(dpp_i<0x122>(__float_as_int(v))); v += __int_as_float(dpp_i<0x121>(__float_as_int(v)));
    return v;
}
__device__ __forceinline__ int f2key(float f) { const int b = __float_as_int(f); return b ^ ((b >> 31) & 0x7fffffff); }
__device__ __forceinline__ float key2f(int k) { return __int_as_float(k ^ ((k >> 31) & 0x7fffffff)); }
#define KEY_MIN ((int)0x80000000)
#define CE(a, b) { const int hi_ = max(a, b), lo_ = min(a, b); a = hi_; b = lo_; }
__device__ __forceinline__ int top16_rows(int (&k)[8], int l15) {
    CE(k[0], k[1]) CE(k[2], k[3]) CE(k[4], k[5]) CE(k[6], k[7])
    CE(k[0], k[2]) CE(k[1], k[3]) CE(k[4], k[6]) CE(k[5], k[7])
    CE(k[1], k[2]) CE(k[5], k[6])
    CE(k[0], k[4]) CE(k[1], k[5]) CE(k[2], k[6]) CE(k[3], k[7])
    CE(k[2], k[4]) CE(k[3], k[5])
    CE(k[1], k[2]) CE(k[3], k[4]) CE(k[5], k[6])
    int res = KEY_MIN;
#pragma unroll
    for (int r = 0; r < 16; ++r) {
        const int m = row_allmax_i(k[0]);
        const bool own = (k[0] == m);
#pragma unroll
        for (int j = 0; j < 7; ++j) k[j] = own ? k[j + 1] : k[j];
        k[7] = own ? KEY_MIN : k[7];
        res = (l15 == r) ? m : res;
    }
    return res;
}
__device__ __forceinline__ void combine16(int A, int B, const int (&cbv)[4], int lane, int l15, int& eid_out, float& gate_out) {
    const int rowbase = lane & 48;
    int ck[4], eid[4];
#pragma unroll
    for (int c = 0; c < 4; ++c) {
        const int ci = (cbv[c] >> 4) & 15, cj = cbv[c] & 15;
        const int ka = __builtin_amdgcn_ds_bpermute((rowbase + ci) << 2, A);
        const int kb = __builtin_amdgcn_ds_bpermute((rowbase + cj) << 2, B);
        const float sm = key2f(ka & ~127) + key2f(kb & ~127);
        eid[c] = ((127 - (ka & 127)) << 7) | (127 - (kb & 127));
        ck[c] = (cbv[c] != 0xff) ? ((f2key(sm) & ~63) | (63 - (4 * l15 + c))) : KEY_MIN;
    }
    CE(ck[0], ck[1]) CE(ck[2], ck[3]) CE(ck[0], ck[2]) CE(ck[1], ck[3]) CE(ck[1], ck[2])
    int res = KEY_MIN;
#pragma unroll
    for (int r = 0; r < 16; ++r) {
        const int m = row_allmax_i(ck[0]);
        const bool own = (ck[0] == m);
        ck[0] = own ? ck[1] : ck[0]; ck[1] = own ? ck[2] : ck[1]; ck[2] = own ? ck[3] : ck[2]; ck[3] = own ? KEY_MIN : ck[3];
        res = (l15 == r) ? m : res;
    }
    const int slot = 63 - (res & 63);
    const int src = (rowbase + (slot >> 2)) << 2;
    const int e0 = __builtin_amdgcn_ds_bpermute(src, eid[0]), e1 = __builtin_amdgcn_ds_bpermute(src, eid[1]);
    const int e2 = __builtin_amdgcn_ds_bpermute(src, eid[2]), e3 = __builtin_amdgcn_ds_bpermute(src, eid[3]);
    const int sel = slot & 3;
    eid_out = sel == 0 ? e0 : (sel == 1 ? e1 : (sel == 2 ? e2 : e3));
    gate_out = key2f(res & ~63);
}

__device__ __forceinline__ int reduce16_rows(const int (&part)[16], bool b3, bool b2, bool b1, bool b0b) {
    int r8[8], r4[4], r2[2];
#pragma unroll
    for (int k = 0; k < 8; ++k) { const int keep = b3 ? part[8 + k] : part[k], send = b3 ? part[k] : part[8 + k]; r8[k] = keep + __builtin_amdgcn_update_dpp(0, send, 0x140, 0xf, 0xf, false); }
#pragma unroll
    for (int k = 0; k < 4; ++k) { const int keep = b2 ? r8[4 + k] : r8[k], send = b2 ? r8[k] : r8[4 + k]; r4[k] = keep + __builtin_amdgcn_update_dpp(0, send, 0x141, 0xf, 0xf, false); }
#pragma unroll
    for (int k = 0; k < 2; ++k) { const int keep = b1 ? r4[2 + k] : r4[k], send = b1 ? r4[k] : r4[2 + k]; r2[k] = keep + __builtin_amdgcn_update_dpp(0, send, 0x4E, 0xf, 0xf, false); }
    const int keep = b0b ? r2[1] : r2[0], send = b0b ? r2[0] : r2[1];
    int r1 = keep + __builtin_amdgcn_update_dpp(0, send, 0xB1, 0xf, 0xf, false);
    r1 += __shfl_xor(r1, 16); r1 += __shfl_xor(r1, 32);
    return r1;
}
#define TS_WBYTES (16384 + 128)
__device__ void phase_peer_dots(const Params& p, char* lds) {
    const int tidx_ = tid_opaque();
    const int lane = tidx_ & 63, wid = __builtin_amdgcn_readfirstlane((int)(tidx_ >> 6)), l15 = lane & 15;
    const bool b3 = (lane & 8) != 0, b2 = (lane & 4) != 0, b1 = (lane & 2) != 0, b0b = (lane & 1) != 0;
    const int gw = blockIdx.x * (blockDim.x >> 6) + wid, ngw = gridDim.x * (blockDim.x >> 6);
    char* wl = lds + wid * TS_WBYTES;
    unsigned* list = (unsigned*)wl; int* dotsl = (int*)(wl + 4096); char* hql = wl + 8192; int* tks = (int*)(wl + 16384);
    const unsigned lane16 = (unsigned)lane * 16u;
    for (int tb = gw * 8; tb < T_TOK; tb += ngw * 8) {
#pragma unroll 1
        for (int j0 = 0; j0 < 8; j0 += 4) {
            u32x4 hraw[4][2];
#pragma unroll
            for (int jj = 0; jj < 4; ++jj) { const u32x4* hr = (const u32x4*)(p.hb + (size_t)(tb + j0 + jj) * D_MODEL); hraw[jj][0] = hr[2 * lane]; hraw[jj][1] = hr[2 * lane + 1]; }
#pragma unroll
            for (int jj = 0; jj < 4; ++jj) {
                const int j = j0 + jj;
                const u32x4 a = hraw[jj][0], c = hraw[jj][1];
                const float f[16] = {bflo(a.x), bfhi(a.x), bflo(a.y), bfhi(a.y), bflo(a.z), bfhi(a.z), bflo(a.w), bfhi(a.w),
                                     bflo(c.x), bfhi(c.x), bflo(c.y), bfhi(c.y), bflo(c.z), bfhi(c.z), bflo(c.w), bfhi(c.w)};
                float ss = 0.f, am = 0.f;
#pragma unroll
                for (int k = 0; k < 16; ++k) { ss += f[k] * f[k]; am = fmaxf(am, fabsf(f[k])); }
                ss = wave_sum(ss); am = wave_max(am);
                const float inv = am > 0.f ? 127.0f / am : 0.f;
                u32x4 o; int hsum = 0;
#pragma unroll
                for (int i = 0; i < 4; ++i) {
                    unsigned w = 0;
#pragma unroll
                    for (int k = 0; k < 4; ++k) { const int qv = (int)rintf(f[4 * i + k] * inv); hsum += qv; w |= (unsigned)(qv & 0xff) << (8 * k); }
                    o[i] = w;
                }
                *(u32x4*)(hql + j * 1024 + lane * 16) = o;
                hsum = wave_sum_i_uniform(hsum);
                const float r2 = rsqrtf(ss * (1.0f / D_MODEL) + EPS);
                if (lane == 0) { tks[4 * j] = hsum; tks[4 * j + 1] = __float_as_int(am * (1.0f / 127.0f) * r2); tks[4 * j + 2] = __float_as_int(r2); }
            }
        }
        int idv[8][2];
#pragma unroll
        for (int j = 0; j < 8; ++j) { const int* ir = p.idx + (size_t)(tb + j) * 128; idv[j][0] = ir[lane]; idv[j][1] = ir[64 + lane]; }
#pragma unroll 1
        for (int x = 0; x < 8; ++x) {
            int n = 0;
#pragma unroll
            for (int j = 0; j < 8; ++j)
#pragma unroll
                for (int r = 0; r < 2; ++r) {
                    const int e = idv[j][r];
                    const bool in = (e >> 11) == x;
                    const unsigned long long mk = __ballot(in);
                    const int rank = (int)__builtin_amdgcn_mbcnt_hi((unsigned)(mk >> 32), __builtin_amdgcn_mbcnt_lo((unsigned)mk, 0u));
                    if (in) list[n + rank] = ((unsigned)j << 21) | ((unsigned)(r * 64 + lane) << 14) | (unsigned)e;
                    n += (int)__builtin_popcountll(mk);
                }
            asm volatile("s_waitcnt lgkmcnt(0)" ::: "memory");
            u32x4 ua[16], ubf[16]; int enta = 0, entb = 0;
            auto issue = [&](int b0, u32x4 (&uu)[16], int& entv) {
                const int i = (b0 + l15 < n) ? b0 + l15 : n - 1;
                entv = (int)list[i];
#pragma unroll
                for (int j = 0; j < 16; ++j) { const int e = __builtin_amdgcn_readlane(entv, j) & 0x3fff; uu[j] = *(const u32x4*)(p.u8 + (size_t)e * D_MODEL + lane16); }
            };
            auto reduce = [&](int b0, const u32x4 (&uu)[16], int entv) {
                int part[16];
#pragma unroll
                for (int j = 0; j < 16; ++j) {
                    const int tl = __builtin_amdgcn_readlane(entv, j) >> 21;
                    const u32x4 hqv = *(const u32x4*)(hql + tl * 1024 + lane * 16);
                    int sacc = __builtin_amdgcn_sdot4((int)uu[j].x, (int)hqv.x, 0, false);
                    sacc = __builtin_amdgcn_sdot4((int)uu[j].y, (int)hqv.y, sacc, false);
                    sacc = __builtin_amdgcn_sdot4((int)uu[j].z, (int)hqv.z, sacc, false);
                    part[j] = __builtin_amdgcn_sdot4((int)uu[j].w, (int)hqv.w, sacc, false);
                }
                const int r1 = reduce16_rows(part, b3, b2, b1, b0b);
                if (lane < 16 && b0 + lane < n) dotsl[((unsigned)entv >> 21) * 128 + (((unsigned)entv >> 14) & 127u)] = r1;
            };
            if (n > 0) issue(0, ua, enta);
            for (int b0 = 0; b0 < n; b0 += 32) {
                if (b0 + 16 < n) issue(b0 + 16, ubf, entb);
                reduce(b0, ua, enta);
                if (b0 + 16 < n) {
                    if (b0 + 32 < n) issue(b0 + 32, ua, enta);
                    reduce(b0 + 16, ubf, entb);
                }
            }
            asm volatile("s_waitcnt lgkmcnt(0)" ::: "memory");
        }
#pragma unroll
        for (int j = 0; j < 8; ++j) {
            const int hs_t = tks[4 * j]; const float cs_t = __int_as_float(tks[4 * j + 1]), r2_t = __int_as_float(tks[4 * j + 2]);
            const float* gr = p.gate + (size_t)(tb + j) * 128; float* cr = p.coef + (size_t)(tb + j) * 128;
#pragma unroll
            for (int r = 0; r < 2; ++r) {
                const int e = idv[j][r];
                const float sc = gr[r * 64 + lane] * r2_t;
                const float ex = __expf(sc - key2f(row_allmax_i(f2key(sc))));
                const float gt = ex / row_allsum_f(ex);
                const float2 sc2 = p.suv[e];
                const float dotf = (float)dotsl[j * 128 + r * 64 + lane] * cs_t * sc2.x;
                cr[r * 64 + lane] = gt * gelu_t(dotf) * sc2.y;
            }
        }
        asm volatile("s_waitcnt lgkmcnt(0)" ::: "memory");
    }
}

__device__ void phase_gather(const Params& p, char* lds) {
    const int tidx_ = tid_opaque();
    const int wave = __builtin_amdgcn_readfirstlane((int)((blockIdx.x * blockDim.x + tidx_) >> 6)), nwaves = (gridDim.x * blockDim.x) >> 6, lane = tidx_ & 63;
    const unsigned char* vb = p.v8 + lane * 12;
    for (int t = wave; t < T_TOK; t += nwaves) {
        int idr[2]; float coef[2];
        { const int* ir = p.idx + (size_t)t * 128; idr[0] = ir[lane]; idr[1] = ir[64 + lane]; }
        { const float* cr = p.coef + (size_t)t * 128; coef[0] = cr[lane]; coef[1] = cr[64 + lane]; }
        const float cmax = wave_max(fmaxf(fabsf(coef[0]), fabsf(coef[1])));
        const float qs = cmax > 0.f ? 127.0f / cmax : 0.f, cscale = cmax * (1.0f / 127.0f);
        const int cq0 = (int)rintf(coef[0] * qs), cq1 = (int)rintf(coef[1] * qs);
        const int csum_i = wave_sum_i_uniform(cq0 + cq1);
        unsigned cpk[2];
        {
            const int cqs[2] = {cq0, cq1};
#pragma unroll
            for (int hf = 0; hf < 2; ++hf) {
                const int bb = cqs[hf] & 0xff;
                cpk[hf] = (unsigned)__builtin_amdgcn_update_dpp(0, bb, 0x00, 0xf, 0xf, false) | ((unsigned)__builtin_amdgcn_update_dpp(0, bb, 0x55, 0xf, 0xf, false) << 8)
                        | ((unsigned)__builtin_amdgcn_update_dpp(0, bb, 0xAA, 0xf, 0xf, false) << 16) | ((unsigned)__builtin_amdgcn_update_dpp(0, bb, 0xFF, 0xf, 0xf, false) << 24);
            }
        }
        int acc[16];
#pragma unroll
        for (int j = 0; j < 16; ++j) acc[j] = 0;
        {
            u32x3 va[8], vbf[8];
            auto issue = [&](int pb, u32x3 (&vv)[8]) {
#pragma unroll
                for (int q = 0; q < 8; ++q) { const int e = __builtin_amdgcn_readlane(pb < 64 ? idr[0] : idr[1], (pb & 63) + q); vv[q] = *(const u32x3*)(vb + (size_t)e * ROWB); }
            };
            auto axpy = [&](int pb, const u32x3 (&vv)[8]) {
#pragma unroll
                for (int g4 = 0; g4 < 2; ++g4) {
                    const int cqd = __builtin_amdgcn_readlane((int)(pb < 64 ? cpk[0] : cpk[1]), (pb & 63) + 4 * g4);
                    unsigned dd[4][4];
#pragma unroll
                    for (int r = 0; r < 4; ++r) {
                        const unsigned w0 = vv[4 * g4 + r].x, w1 = vv[4 * g4 + r].y, w2 = vv[4 * g4 + r].z;
                        dd[r][0] = w0 & 0x3f3f3f3fu; dd[r][1] = w1 & 0x3f3f3f3fu; dd[r][2] = w2 & 0x3f3f3f3fu;
                        dd[r][3] = ((w0 >> 6) & 0x03030303u) | ((w1 >> 4) & 0x0c0c0c0cu) | ((w2 >> 2) & 0x30303030u);
                    }
#pragma unroll
                    for (int k = 0; k < 4; ++k) {
                        const unsigned p0 = __builtin_amdgcn_perm(dd[1][k], dd[0][k], 0x05010400u), p1 = __builtin_amdgcn_perm(dd[1][k], dd[0][k], 0x07030602u);
                        const unsigned q0 = __builtin_amdgcn_perm(dd[3][k], dd[2][k], 0x05010400u), q1 = __builtin_amdgcn_perm(dd[3][k], dd[2][k], 0x07030602u);
                        const unsigned t0 = __builtin_amdgcn_perm(q0, p0, 0x05040100u), t1 = __builtin_amdgcn_perm(q0, p0, 0x07060302u);
                        const unsigned t2 = __builtin_amdgcn_perm(q1, p1, 0x05040100u), t3 = __builtin_amdgcn_perm(q1, p1, 0x07060302u);
                        acc[4 * k + 0] = __builtin_amdgcn_sdot4((int)t0, cqd, acc[4 * k + 0], false);
                        acc[4 * k + 1] = __builtin_amdgcn_sdot4((int)t1, cqd, acc[4 * k + 1], false);
                        acc[4 * k + 2] = __builtin_amdgcn_sdot4((int)t2, cqd, acc[4 * k + 2], false);
                        acc[4 * k + 3] = __builtin_amdgcn_sdot4((int)t3, cqd, acc[4 * k + 3], false);
                    }
                }
            };
            issue(0, va);
#pragma unroll 1
            for (int pb = 0; pb < 128; pb += 16) {
                issue(pb + 8, vbf);
                axpy(pb, va);
                if (pb + 16 < 128) issue(pb + 16, va);
                axpy(pb + 8, vbf);
            }
        }
        const u32x4* hr = (const u32x4*)(p.hb + (size_t)t * D_MODEL + lane * 16);
        const u32x4 ha = hr[0], hc = hr[1];
        const float hf16[16] = {bflo(ha.x), bfhi(ha.x), bflo(ha.y), bfhi(ha.y), bflo(ha.z), bfhi(ha.z), bflo(ha.w), bfhi(ha.w),
                                bflo(hc.x), bfhi(hc.x), bflo(hc.y), bfhi(hc.y), bflo(hc.z), bfhi(hc.z), bflo(hc.w), bfhi(hc.w)};
        float res[16];
        float ss = 0.f;
#pragma unroll
        for (int j = 0; j < 16; ++j) { res[j] = hf16[j] + cscale * (float)(acc[j] - 32 * csum_i); ss += res[j] * res[j]; }
        ss = wave_sum(ss);
        const float r3 = rsqrtf(ss * (1.0f / D_MODEL) + EPS);
        float* o = p.out + (size_t)t * D_MODEL + lane * 16;
        const float* fg = p.final_g + lane * 16;
#pragma unroll
        for (int i = 0; i < 4; ++i) {
            const float4 g = ((const float4*)fg)[i];
            float4 ov; ov.x = res[4 * i] * r3 * g.x; ov.y = res[4 * i + 1] * r3 * g.y; ov.z = res[4 * i + 2] * r3 * g.z; ov.w = res[4 * i + 3] * r3 * g.w;
            ((float4*)o)[i] = ov;
        }
    }
}

namespace pg8 {
#define PG8_LAS __attribute__((address_space(3)))
constexpr int BM = 256, BK = 64, HALF = 128, HTB = HALF * BK * 2, STAGE_BYTES = 8 * HTB, NXCD = 8, WGM = 8;
__host__ __device__ __forceinline__ int lds_byte(int r, int c) { const int st = (r >> 4) * 2 + (c >> 5), rr = r & 15, cc = c & 31, ob = rr * 64 + cc * 2; return st * 1024 + (ob ^ (((ob >> 9) & 1) << 5)); }
__host__ __device__ __forceinline__ void stage_rc(int b, int& R, int& C) { const int st = b / 1024, sb = b % 1024, swz = sb ^ (((sb >> 9) & 1) << 5); R = (st >> 1) * 16 + swz / 64; C = (st & 1) * 32 + (swz % 64) / 2; }
__host__ __device__ __forceinline__ int perm32(int rho) { const int n = rho >> 4, i = rho & 15; return 8 * (i >> 2) + 4 * n + (i & 3); }
struct Unit { int pm, pn; };
struct Gemm { const bf16_t* A; const bf16_t* Bt; int M, N, K; };
struct StaticOrder {
    int nM, nN, nwg, G, c;
    __host__ __device__ void init(int M, int N, int G_, int c_) { nM = M / BM; nN = N / BM; nwg = nM * nN; G = G_; c = c_; }
    __host__ __device__ bool next(int i, Unit& u) const {
        const long L = (long)i * G + c; if (L >= nwg) return false;
        int wgid = (int)L; { const int q = nwg / NXCD, r = nwg % NXCD, xcd = wgid % NXCD, off = wgid / NXCD; wgid = (xcd < r ? xcd * (q + 1) : r * (q + 1) + (xcd - r) * q) + off; }
        const int nig = WGM * nN, gid = wgid / nig, fm = gid * WGM, gsz = (nM - fm) < WGM ? (nM - fm) : WGM;
        u.pm = fm + ((wgid % nig) % gsz); u.pn = (wgid % nig) / gsz; return true;
    }
    __device__ __forceinline__ void a_ready(const Unit&) const {}
    __device__ __forceinline__ void done(const Unit&) const {}
};
__device__ __forceinline__ unsigned cvt_pk_bf16(float lo, float hi) { unsigned r; asm volatile("v_cvt_pk_bf16_f32 %0, %1, %2" : "=v"(r) : "v"(lo), "v"(hi)); return r; }
template <bool I8> __device__ __forceinline__ typename std::conditional<I8, i32x4, f32x4>::type mma1(bf16x8 a, bf16x8 b, typename std::conditional<I8, i32x4, f32x4>::type c) {
    if constexpr (I8) return __builtin_amdgcn_mfma_i32_16x16x64_i8(*(const i32x4*)&a, *(const i32x4*)&b, c, 0, 0, 0);
    else return __builtin_amdgcn_mfma_f32_16x16x32_bf16(a, b, c, 0, 0, 0);
}
struct EpiZ8 {
    static constexpr bool PERM = true, AFTER_DRAIN = false, I8 = true; typedef i32x4 acc_t;
    bf16_t* O; const float* rsx; const unsigned* swb;
    __device__ __forceinline__ void operator()(const i32x4 (&acc)[2][2][4][2], const Unit& u, int wr, int wc, int fr, int fq) const {
        const int row0 = u.pm * BM + wr * 64 + fr, col0 = u.pn * BM + wc * 32 + 8 * fq; const bool act = u.pn >= 2;
        float sw[2][8];
#pragma unroll
        for (int bj = 0; bj < 2; ++bj) { const u32x4 a = *(const u32x4*)(swb + col0 + bj * HALF), c = *(const u32x4*)(swb + col0 + bj * HALF + 4);
#pragma unroll
            for (int i = 0; i < 4; ++i) { sw[bj][i] = __uint_as_float(a[i]) * (1.0f / 127.0f); sw[bj][4 + i] = __uint_as_float(c[i]) * (1.0f / 127.0f); } }
#pragma unroll
        for (int ai = 0; ai < 2; ++ai)
#pragma unroll
            for (int m = 0; m < 4; ++m) { const int r = row0 + ai * HALF + m * 16; const float sc = rsx[r]; bf16_t* rowp = O + (size_t)r * D_IN + col0;
#pragma unroll
                for (int bj = 0; bj < 2; ++bj) { f32x4 v0, v1;
#pragma unroll
                    for (int i = 0; i < 4; ++i) { v0[i] = (float)acc[ai][bj][m][0][i] * sc * sw[bj][i]; v1[i] = (float)acc[ai][bj][m][1][i] * sc * sw[bj][4 + i]; }
                    if (act) { v0 = (f32x4){gelu_t(v0[0]), gelu_t(v0[1]), gelu_t(v0[2]), gelu_t(v0[3])}; v1 = (f32x4){gelu_t(v1[0]), gelu_t(v1[1]), gelu_t(v1[2]), gelu_t(v1[3])}; }
                    u32x4 w; w.x = cvt_pk_bf16(v0[0], v0[1]); w.y = cvt_pk_bf16(v0[2], v0[3]); w.z = cvt_pk_bf16(v1[0], v1[1]); w.w = cvt_pk_bf16(v1[2], v1[3]);
                    *(u32x4*)(rowp + bj * HALF) = w; } }
    }
};
struct EpiZ {
    static constexpr bool PERM = true, AFTER_DRAIN = false, I8 = false; typedef f32x4 acc_t;
    bf16_t* O; const float* rs;
    __device__ __forceinline__ void operator()(const f32x4 (&acc)[2][2][4][2], const Unit& u, int wr, int wc, int fr, int fq) const {
        const int row0 = u.pm * BM + wr * 64 + fr, col0 = u.pn * BM + wc * 32 + 8 * fq; const bool act = u.pn >= 2;
#pragma unroll
        for (int ai = 0; ai < 2; ++ai)
#pragma unroll
            for (int m = 0; m < 4; ++m) { const int r = row0 + ai * HALF + m * 16; const float sc = rs[r]; bf16_t* rowp = O + (size_t)r * D_IN + col0;
#pragma unroll
                for (int bj = 0; bj < 2; ++bj) { f32x4 v0 = acc[ai][bj][m][0] * sc, v1 = acc[ai][bj][m][1] * sc;
                    if (act) { v0 = (f32x4){gelu_t(v0[0]), gelu_t(v0[1]), gelu_t(v0[2]), gelu_t(v0[3])}; v1 = (f32x4){gelu_t(v1[0]), gelu_t(v1[1]), gelu_t(v1[2]), gelu_t(v1[3])}; }
                    u32x4 w; w.x = cvt_pk_bf16(v0[0], v0[1]); w.y = cvt_pk_bf16(v0[2], v0[3]); w.z = cvt_pk_bf16(v1[0], v1[1]); w.w = cvt_pk_bf16(v1[2], v1[3]);
                    *(u32x4*)(rowp + bj * HALF) = w; } }
    }
};
struct EpiOut {
    static constexpr bool PERM = true, AFTER_DRAIN = false, I8 = false; typedef f32x4 acc_t;
    bf16_t* O; const bf16_t* X;
    __device__ __forceinline__ void operator()(const f32x4 (&acc)[2][2][4][2], const Unit& u, int wr, int wc, int fr, int fq) const {
        const int row0 = u.pm * BM + wr * 64 + fr, col0 = u.pn * BM + wc * 32 + 8 * fq;
#pragma unroll
        for (int ai = 0; ai < 2; ++ai)
#pragma unroll
            for (int m = 0; m < 4; ++m) { const size_t off = (size_t)(row0 + ai * HALF + m * 16) * D_MODEL + col0;
#pragma unroll
                for (int bj = 0; bj < 2; ++bj) { const u32x4 xx = *(const u32x4*)(X + off + bj * HALF);
                    const f32x4 v0 = acc[ai][bj][m][0] + (f32x4){bflo(xx.x), bfhi(xx.x), bflo(xx.y), bfhi(xx.y)}, v1 = acc[ai][bj][m][1] + (f32x4){bflo(xx.z), bfhi(xx.z), bflo(xx.w), bfhi(xx.w)};
                    u32x4 w; w.x = cvt_pk_bf16(v0[0], v0[1]); w.y = cvt_pk_bf16(v0[2], v0[3]); w.z = cvt_pk_bf16(v1[0], v1[1]); w.w = cvt_pk_bf16(v1[2], v1[3]);
                    *(u32x4*)(O + off + bj * HALF) = w; } }
    }
};
struct OneUnit {
    Unit u;
    __device__ __forceinline__ bool next(int i, Unit& o) const { if (i) return false; o = u; return true; }
    __device__ __forceinline__ void a_ready(const Unit&) const {}
    __device__ __forceinline__ void done(const Unit&) const {}
};
#define QT_PITCH 272
#define QT_LDS_BYTES (2 * 256 * QT_PITCH)
struct EpiQTopk {
    static constexpr bool PERM = true, AFTER_DRAIN = true, I8 = false; typedef f32x4 acc_t;
    const bf16_t* keysB; int* idx; float* gate;
    __device__ __forceinline__ void fused(f32x4 (&acc)[2][2][4][2], const Unit& u, int wr, int wc, int fr, int fq, PG8_LAS unsigned char* ldsp, int wid, int lane) const {
        char* sQ = (char*)ldsp;
        const int h = u.pn;
#pragma unroll
        for (int ai = 0; ai < 2; ++ai)
#pragma unroll
            for (int m = 0; m < 4; ++m) { const int r = ai * HALF + wr * 64 + m * 16 + fr;
#pragma unroll
                for (int bj = 0; bj < 2; ++bj) { const f32x4 v0 = acc[ai][bj][m][0], v1 = acc[ai][bj][m][1];
                    u32x4 w; w.x = cvt_pk_bf16(v0[0], v0[1]); w.y = cvt_pk_bf16(v0[2], v0[3]); w.z = cvt_pk_bf16(v1[0], v1[1]); w.w = cvt_pk_bf16(v1[2], v1[3]);
                    *(u32x4*)(sQ + bj * (256 * QT_PITCH) + r * QT_PITCH + (wc * 32 + fq * 8) * 2) = w; } }
        __syncthreads();
        int cbv[4];
#pragma unroll
        for (int c = 0; c < 4; ++c) cbv[c] = kComb[4 * fr + c];
        int tA[2][4], tB[2][4];
#pragma unroll
        for (int m = 0; m < 2; ++m)
#pragma unroll
            for (int j = 0; j < 4; ++j) { tA[m][j] = 0; tB[m][j] = 0; }
#pragma unroll 1
        for (int pp = 0; pp < 2; ++pp) {
            const bf16_t* kb = keysB + (size_t)(pp * 8 + h) * 16384 + lane * 8;
            const char* qa = sQ + pp * (256 * QT_PITCH) + (wid * 32 + fr) * QT_PITCH + fq * 16;
            f32x4 sc2[2][8];
#pragma unroll
            for (int m = 0; m < 2; ++m)
#pragma unroll
                for (int nb = 0; nb < 8; ++nb) sc2[m][nb] = (f32x4){0.f, 0.f, 0.f, 0.f};
#pragma unroll
            for (int kk = 0; kk < 4; ++kk) {
                bf16x8 kf[8], af[2];
#pragma unroll
                for (int nb = 0; nb < 8; ++nb) kf[nb] = *(const bf16x8*)(kb + (kk * 8 + nb) * 512);
#pragma unroll
                for (int m = 0; m < 2; ++m) af[m] = *(const bf16x8*)(qa + m * 16 * QT_PITCH + kk * 64);
#pragma unroll
                for (int m = 0; m < 2; ++m)
#pragma unroll
                    for (int nb = 0; nb < 8; ++nb) sc2[m][nb] = __builtin_amdgcn_mfma_f32_16x16x32_bf16(af[m], kf[nb], sc2[m][nb], 0, 0, 0);
            }
#pragma unroll
            for (int m = 0; m < 2; ++m)
#pragma unroll
                for (int j = 0; j < 4; ++j) tA[m][j] = tB[m][j];
#pragma unroll 2
            for (int it = 0; it < 4; ++it) {
#pragma unroll
                for (int m = 0; m < 2; ++m) {
                    int k[8];
#pragma unroll
                    for (int nb = 0; nb < 8; ++nb) k[nb] = (f2key(sc2[m][nb][0]) & ~127) | (127 - (16 * nb + fr));
                    const int r = top16_rows(k, fr);
                    tB[m][0] = tB[m][1]; tB[m][1] = tB[m][2]; tB[m][2] = tB[m][3]; tB[m][3] = r;
#pragma unroll
                    for (int nb = 0; nb < 8; ++nb) sc2[m][nb] = (f32x4){sc2[m][nb][1], sc2[m][nb][2], sc2[m][nb][3], sc2[m][nb][0]};
                }
            }
        }
#pragma unroll 2
        for (int it = 0; it < 4; ++it) {
#pragma unroll
            for (int m = 0; m < 2; ++m) {
                int eid; float gt;
                combine16(tA[m][0], tB[m][0], cbv, lane, fr, eid, gt);
                const int t = u.pm * BM + wid * 32 + m * 16 + fq * 4 + it;
                const size_t o = (size_t)t * 128 + h * 16 + fr;
                idx[o] = eid; gate[o] = gt;
                tA[m][0] = tA[m][1]; tA[m][1] = tA[m][2]; tA[m][2] = tA[m][3];
                tB[m][0] = tB[m][1]; tB[m][1] = tB[m][2]; tB[m][2] = tB[m][3];
            }
        }
        __syncthreads();
    }
};
template <class Epi, class Sched>
__device__ __forceinline__ void gemm_phase(PG8_LAS unsigned char* lds, const Gemm g, const Sched& S, const Epi& E) {
    const int tid = tid_opaque(), wid = __builtin_amdgcn_readfirstlane(tid >> 6), lane = tid & 63, wr = wid >> 2, wc = wid & 3, fr = lane & 15, fq = lane >> 4;
    const int K = g.K, nt = K / BK;
    unsigned voffA[2], voffB[2];
#pragma unroll
    for (int i = 0; i < 2; ++i) { int R, C; stage_rc(tid * 16 + i * 8192, R, C); const int Rb = Epi::PERM ? ((R & ~31) + perm32(R & 31)) : R;
        voffA[i] = (unsigned)(R * K + C) * 2u; voffB[i] = (unsigned)(Rb * K + C) * 2u; }
    const size_t kstep = (size_t)(BK * 2);
    const size_t hstep = (size_t)HALF * K * 2;
    const size_t tstep = 2 * hstep;
    const unsigned ldsw = (unsigned)wid * 1024u;
    const int aoff = lds_byte(wr * 64 + fr, fq * 8), boff = lds_byte(wc * 32 + fr, fq * 8);
#define PG8_SA(b, h) (((b) * 2 + (h)) * HTB)
#define PG8_SB(b, h) ((4 + (b) * 2 + (h)) * HTB)
#define PG8_STAGE(bufoff, gbase, voff) do { _Pragma("unroll") for (int _i = 0; _i < 2; ++_i) \
        __builtin_amdgcn_global_load_lds((const unsigned*)((const char*)(gbase) + (voff)[_i]), (PG8_LAS unsigned*)(lds + (bufoff) + ldsw + _i * 8192), 16, 0, 0); } while (0)
#define PG8_LDA(dst, b, h) do { _Pragma("unroll") for (int m = 0; m < 4; ++m) _Pragma("unroll") for (int k = 0; k < 2; ++k) dst[m][k] = *(const PG8_LAS bf16x8*)(lds + PG8_SA(b, h) + aoff + m * 2048 + k * 1024); } while (0)
#define PG8_LDB(dst, b, h) do { _Pragma("unroll") for (int n = 0; n < 2; ++n) _Pragma("unroll") for (int k = 0; k < 2; ++k) dst[n][k] = *(const PG8_LAS bf16x8*)(lds + PG8_SB(b, h) + boff + n * 2048 + k * 1024); } while (0)
#define PG8_MMA(ai, bj, At, Bt) do { __builtin_amdgcn_s_setprio(1); _Pragma("unroll") for (int m = 0; m < 4; ++m) _Pragma("unroll") for (int n = 0; n < 2; ++n) _Pragma("unroll") for (int k = 0; k < 2; ++k) \
        acc[ai][bj][m][n] = mma1<Epi::I8>(Bt[n][k], At[m][k], acc[ai][bj][m][n]); __builtin_amdgcn_s_setprio(0); } while (0)
#define PG8_WAIT_V(n) asm volatile("s_waitcnt vmcnt(" #n ")" ::: "memory")
#define PG8_WAIT_L(n) asm volatile("s_waitcnt lgkmcnt(" #n ")" ::: "memory")
#define PG8_BAR __builtin_amdgcn_s_barrier()
#define PG8_SCHED __builtin_amdgcn_sched_barrier(0)
    Unit cur, nxt; int ui = 0;
    if (!S.next(0, cur)) return;
    typedef typename Epi::acc_t acc_t;
    acc_t acc[2][2][4][2];
#pragma unroll
    for (int a = 0; a < 2; ++a)
#pragma unroll
        for (int b = 0; b < 2; ++b)
#pragma unroll
            for (int m = 0; m < 4; ++m)
#pragma unroll
                for (int n = 0; n < 2; ++n) acc[a][b][m][n] = (acc_t)(0);
    bf16x8 At[4][2], B0[2][2], B1[2][2];
    const char* cA = (const char*)g.A + (size_t)cur.pm * tstep; const char* cB = (const char*)g.Bt + (size_t)cur.pn * tstep;
    S.a_ready(cur);
    PG8_STAGE(PG8_SB(0, 0), cB, voffB); PG8_STAGE(PG8_SA(0, 0), cA, voffA); PG8_STAGE(PG8_SB(0, 1), cB + hstep, voffB); PG8_STAGE(PG8_SA(0, 1), cA + hstep, voffA);
    if (wr == 1) PG8_BAR;
    PG8_WAIT_V(4); PG8_BAR;
    PG8_STAGE(PG8_SB(1, 0), cB + kstep, voffB); PG8_STAGE(PG8_SA(1, 0), cA + kstep, voffA); PG8_STAGE(PG8_SB(1, 1), cB + hstep + kstep, voffB);
    PG8_WAIT_V(6); PG8_BAR;
    for (;;) {
        const bool has_next = S.next(ui + 1, nxt);
        const char* nA = has_next ? (const char*)g.A + (size_t)nxt.pm * tstep : cA; const char* nB = has_next ? (const char*)g.Bt + (size_t)nxt.pn * tstep : cB;
        for (int t = 0; t < nt; t += 2) {
            const bool last = (t == nt - 2);
            const char* a1 = cA + (size_t)(t + 1) * kstep;
            const char* a2 = last ? nA : cA + (size_t)(t + 2) * kstep; const char* b2 = last ? nB : cB + (size_t)(t + 2) * kstep;
            const char* a3 = a2 + kstep; const char* b3 = b2 + kstep;
            if (last && has_next) S.a_ready(nxt);
            PG8_LDB(B0, 0, 0); PG8_SCHED; PG8_LDA(At, 0, 0); PG8_STAGE(PG8_SA(1, 1), a1 + hstep, voffA);
            PG8_WAIT_L(8); PG8_BAR; PG8_WAIT_L(0); PG8_MMA(0, 0, At, B0); PG8_BAR; PG8_SCHED;
            PG8_LDB(B1, 0, 1); PG8_STAGE(PG8_SB(0, 0), b2, voffB);
            PG8_BAR; PG8_WAIT_L(0); PG8_MMA(0, 1, At, B1); PG8_BAR;
            PG8_LDA(At, 0, 1); PG8_STAGE(PG8_SA(0, 0), a2, voffA);
            PG8_BAR; PG8_WAIT_L(0); PG8_MMA(1, 0, At, B0); PG8_BAR; PG8_SCHED;
            PG8_STAGE(PG8_SB(0, 1), b2 + hstep, voffB);
            PG8_WAIT_V(6); PG8_BAR; PG8_MMA(1, 1, At, B1); PG8_BAR;
            PG8_LDB(B0, 1, 0); PG8_SCHED; PG8_LDA(At, 1, 0); PG8_STAGE(PG8_SA(0, 1), a2 + hstep, voffA);
            PG8_WAIT_L(8); PG8_BAR; PG8_WAIT_L(0); PG8_MMA(0, 0, At, B0); PG8_BAR; PG8_SCHED;
            PG8_LDB(B1, 1, 1); PG8_STAGE(PG8_SB(1, 0), b3, voffB);
            PG8_BAR; PG8_WAIT_L(0); PG8_MMA(0, 1, At, B1); PG8_BAR;
            PG8_LDA(At, 1, 1); PG8_STAGE(PG8_SA(1, 0), a3, voffA);
            PG8_BAR; PG8_WAIT_L(0); PG8_MMA(1, 0, At, B0); PG8_BAR; PG8_SCHED;
            PG8_STAGE(PG8_SB(1, 1), b3 + hstep, voffB);
            PG8_WAIT_V(6); PG8_BAR; PG8_MMA(1, 1, At, B1); PG8_BAR;
        }
            if constexpr (!Epi::AFTER_DRAIN) { E(acc, cur, wr, wc, fr, fq); S.done(cur); }
            if (!has_next) break;
#pragma unroll
        for (int a = 0; a < 2; ++a)
#pragma unroll
            for (int b = 0; b < 2; ++b)
#pragma unroll
                for (int m = 0; m < 4; ++m)
#pragma unroll
                    for (int n = 0; n < 2; ++n) acc[a][b][m][n] = (acc_t)(0);
        cur = nxt; cA = nA; cB = nB; ++ui;
    }
    PG8_WAIT_V(0);
    if (wr == 0) PG8_BAR;
    PG8_BAR;
    if constexpr (Epi::AFTER_DRAIN) { E.fused(acc, cur, wr, wc, fr, fq, lds, wid, lane); S.done(cur); }
#undef PG8_SA
#undef PG8_SB
#undef PG8_STAGE
#undef PG8_LDA
#undef PG8_LDB
#undef PG8_MMA
#undef PG8_WAIT_V
#undef PG8_WAIT_L
#undef PG8_BAR
#undef PG8_SCHED
}
}

__device__ void phase_gemm_z(const Params& p, char* lds) {
    pg8::StaticOrder S; S.init(T_TOK, D_IN, gridDim.x, blockIdx.x);
    pg8::gemm_phase<pg8::EpiZ8, pg8::StaticOrder>((PG8_LAS unsigned char*)lds, pg8::Gemm{(const bf16_t*)p.xq, (const bf16_t*)p.winT8, T_TOK, D_IN, D_MODEL / 2}, S, pg8::EpiZ8{p.zb, p.rstd1, p.swb});
}
__device__ void phase_gemm_out(const Params& p, char* lds) {
    pg8::StaticOrder S; S.init(T_TOK, D_MODEL, gridDim.x, blockIdx.x);
    pg8::gemm_phase<pg8::EpiOut, pg8::StaticOrder>((PG8_LAS unsigned char*)lds, pg8::Gemm{p.cB, p.woutT, T_TOK, D_MODEL, D_MODEL}, S, pg8::EpiOut{p.hb, p.xb});
}
__device__ void phase_gemm_q(const Params& p, char* lds) {
    pg8::StaticOrder S; S.init(T_TOK, 2048, gridDim.x, blockIdx.x);
    pg8::Unit u;
    for (int i = 0; S.next(i, u); ++i)
        pg8::gemm_phase<pg8::EpiQTopk, pg8::OneUnit>((PG8_LAS unsigned char*)lds, pg8::Gemm{p.hb, p.wqT, T_TOK, 2048, D_MODEL}, pg8::OneUnit{u}, pg8::EpiQTopk{p.keysB, p.idx, p.gate});
}

#define XB_TMO      128
#define XB_XCNT(j)  (256  + 64 * (j))
#define XB_XSUB(j)  (1280 + 64 * (j))
#define XB_XGEN(j)  (2304 + 64 * (j))
#define XB_TOP      3328
#define XB_TOPGEN   3392
#define XCD_BAR_WORDS 3456
#define XB_SPIN_CAP (1u << 20)
__device__ __forceinline__ unsigned xb_ld(unsigned* p)              { return __hip_atomic_load(p, __ATOMIC_RELAXED, __HIP_MEMORY_SCOPE_AGENT); }
__device__ __forceinline__ unsigned xb_add(unsigned* p, unsigned v) { return __hip_atomic_fetch_add(p, v, __ATOMIC_RELAXED, __HIP_MEMORY_SCOPE_AGENT); }
__device__ __forceinline__ unsigned xb_xcc_id() { return (unsigned)__builtin_amdgcn_s_getreg((3 << 11) | 20) & 0xFu; }
#define XB_SPIN(cond, bar) do { unsigned _sp = 0; while (cond) { __builtin_amdgcn_s_sleep(1); \
    if ((++_sp & 255u) == 0u) { if (xb_ld(&(bar)[XB_TMO])) break; if (_sp > XB_SPIN_CAP) { atomicAdd(&(bar)[XB_TMO], 1u); break; } } } } while (0)
struct XcdBarrier { unsigned* bar; unsigned x; volatile LAS unsigned* st; };
__device__ __forceinline__ XcdBarrier xcd_barrier_post(unsigned* bar, volatile LAS unsigned* st) {
    XcdBarrier b; b.bar = bar; b.x = xb_xcc_id(); b.st = st;
    if (threadIdx.x == 0) (void)xb_add(&bar[XB_XCNT(b.x)], 1u);
    return b;
}
__device__ __forceinline__ void xcd_barrier_complete(unsigned* bar, unsigned x, unsigned& nloc, unsigned& nx) {
    const unsigned G = gridDim.x * gridDim.y * gridDim.z;
    unsigned sum, cnt, mine, sp = 0u;
    for (;;) {
        sum = 0u; cnt = 0u; mine = 0u;
#pragma unroll
        for (unsigned j = 0; j < 16; ++j) { const unsigned c = xb_ld(&bar[XB_XCNT(j)]); sum += c; cnt += (c > 0u) ? 1u : 0u; mine = (j == x) ? c : mine; }
        if (sum == G) break;
        __builtin_amdgcn_s_sleep(1);
        if ((++sp & 255u) == 0u) { if (xb_ld(&bar[XB_TMO])) break; if (sp > XB_SPIN_CAP) { atomicAdd(&bar[XB_TMO], 1u); break; } }
    }
    nloc = mine > 0u ? mine : 1u; nx = cnt > 0u ? cnt : 1u;
}
__device__ __forceinline__ void xcd_barrier(const XcdBarrier& b) {
    asm volatile("s_waitcnt vmcnt(0)" ::: "memory");
    __syncthreads();
    if (threadIdx.x == 0) {
        unsigned* bar = b.bar;
        __builtin_amdgcn_s_waitcnt(0);
        unsigned nloc = b.st[0], nx = b.st[1];
        if (nloc == 0u) { xcd_barrier_complete(bar, b.x, nloc, nx); b.st[0] = nloc; b.st[1] = nx; }
        const unsigned old = xb_add(&bar[XB_XSUB(b.x)], 1u);
        const unsigned gen = old / nloc;
        if (old + 1u == (gen + 1u) * nloc) {
            __builtin_amdgcn_fence(__ATOMIC_RELEASE, "agent");
            asm volatile("s_waitcnt vmcnt(0)" ::: "memory");
            const unsigned og = xb_add(&bar[XB_TOP], 1u);
            const unsigned tg = og / nx;
            if (og + 1u == (tg + 1u) * nx) xb_add(&bar[XB_TOPGEN], 1u);
            else XB_SPIN(xb_ld(&bar[XB_TOPGEN]) == tg, bar);
            __builtin_amdgcn_fence(__ATOMIC_ACQUIRE, "agent");
            xb_add(&bar[XB_XGEN(b.x)], 1u);
            asm volatile("s_waitcnt vmcnt(0)" ::: "memory");
        } else {
            XB_SPIN(xb_ld(&bar[XB_XGEN(b.x)]) == gen, bar);
            __builtin_amdgcn_fence(__ATOMIC_ACQUIRE, "agent");
            asm volatile("s_waitcnt vmcnt(0)" ::: "memory");
        }
    }
    __syncthreads();
}

#define MEGA_LDS_MAX2(a, b) ((a) > (b) ? (a) : (b))
#define MEGA_LDS_MAIN MEGA_LDS_MAX2(MEGA_LDS_MAX2(QT_LDS_BYTES, pg8::STAGE_BYTES), MEGA_LDS_MAX2(8 * TS_WBYTES, 2 * MIXH_LDS))
#define MEGA_LDS_BYTES (MEGA_LDS_MAIN + 16)
extern __shared__ __attribute__((aligned(16))) char smem[];
__global__ void __launch_bounds__(512, 2) fwd_mega(Params p) {
    volatile LAS unsigned* st = (volatile LAS unsigned*)(smem + MEGA_LDS_MAIN);
    if (threadIdx.x < 4) st[threadIdx.x] = 0u;
    __syncthreads();
    const XcdBarrier xb = xcd_barrier_post(p.bar, st);
    phase_prep(p, smem);      xcd_barrier(xb);
    phase_gemm_z(p, smem);    xcd_barrier(xb);
    phase_mix_gemm(p, smem);  xcd_barrier(xb);
    phase_gemm_out(p, smem);  xcd_barrier(xb);
    phase_gemm_q(p, smem);    xcd_barrier(xb);
    phase_peer_dots(p, smem); xcd_barrier(xb);
    phase_gather(p, smem);
}

extern "C" void kernel_launch(void* const* d_in, const int* in_sizes, int n_in, void* d_out, int out_size, void* d_ws, size_t ws_size, hipStream_t stream) {
    static int grid_blocks = 0;
    if (grid_blocks == 0) {
        int dev = 0, cus = 0, per_cu = 0;
        (void)hipGetDevice(&dev);
        (void)hipDeviceGetAttribute(&cus, hipDeviceAttributeMultiprocessorCount, dev);
        (void)hipFuncSetAttribute((const void*)fwd_mega, hipFuncAttributeMaxDynamicSharedMemorySize, MEGA_LDS_BYTES);
        (void)hipOccupancyMaxActiveBlocksPerMultiprocessor(&per_cu, (const void*)fwd_mega, 512, MEGA_LDS_BYTES);
        if (per_cu > 1) per_cu = 1;
        if (per_cu < 1) per_cu = 1;
        grid_blocks = cus * per_cu;
    }
    Params p{};
    p.x = (const float*)d_in[0]; p.norm1_g = (const float*)d_in[1]; p.w_in = (const float*)d_in[2]; p.pool_w = (const float*)d_in[3];
    p.pool_scale = (const float*)d_in[4]; p.sgu_norm_g = (const float*)d_in[5]; p.sgu_w = (const float*)d_in[6]; p.sgu_b = (const float*)d_in[7];
    p.w_out = (const float*)d_in[8]; p.norm2_g = (const float*)d_in[9]; p.peer_wq = (const float*)d_in[10]; p.peer_keys = (const float*)d_in[11];
    p.peer_u = (const float*)d_in[12]; p.peer_v = (const float*)d_in[13]; p.final_g = (const float*)d_in[14];
    p.out = (float*)d_out;
    char* w = (char*)d_ws; size_t off = 0;
    auto take = [&](size_t bytes) { char* r = w + off; off += (bytes + 255) & ~(size_t)255; return r; };
    const size_t MiB = 1024 * 1024;
    p.u8 = (unsigned char*)take(16 * MiB); p.v8 = (unsigned char*)take(12 * MiB);
    p.suv = (float2*)take(128 * 1024);
    p.winT = (bf16_t*)take(3 * MiB); p.woutT = (bf16_t*)take(2 * MiB); p.wqT = (bf16_t*)take(4 * MiB);
    p.poolT = (bf16_t*)take(128 * 1024); p.wsM = (bf16_t*)take(128 * 1024); p.keysB = (bf16_t*)take(512 * 1024);
    p.bar = (unsigned*)take(XCD_BAR_WORDS * 4 + 2048 * 4); p.swb = p.bar + XCD_BAR_WORDS;
    p.rstd1 = (float*)take(128 * 1024); p.xq = (signed char*)take(32 * MiB); p.winT8 = (signed char*)take(1536 * 1024);
    p.idx = (int*)take(16 * MiB); p.gate = (float*)take(16 * MiB); p.coef = (float*)take(16 * MiB);
    p.xb = (bf16_t*)take(64 * MiB); p.zb = (bf16_t*)take(96 * MiB); p.cB = (bf16_t*)take(64 * MiB); p.hb = (bf16_t*)take(64 * MiB);
    (void)hipMemsetAsync(p.bar, 0, XCD_BAR_WORDS * 4 + 2048 * 4, stream);
    hipLaunchKernelGGL(fwd_mega, dim3(grid_blocks), dim3(512), MEGA_LDS_BYTES, stream, p);
}
```

```cpp
#include <hip/hip_runtime.h>
#include <stdint.h>
#include <type_traits>

typedef unsigned short bf16_t;
typedef short bf16x8 __attribute__((ext_vector_type(8)));
typedef float f32x4 __attribute__((ext_vector_type(4)));
typedef unsigned u32x4 __attribute__((ext_vector_type(4)));
typedef unsigned u32x2 __attribute__((ext_vector_type(2)));
typedef unsigned u32x3 __attribute__((ext_vector_type(3)));
typedef int i32x4 __attribute__((ext_vector_type(4)));
#define ROWB 768
typedef __bf16 bf2_t __attribute__((ext_vector_type(2)));
#define LAS __attribute__((address_space(3)))

#define T_TOK 32768
#define D_MODEL 1024
#define D_IN 1536
#define SEQ 2048
#define NEXP 16384
#define EPS 1e-6f

struct Params {
    const float *x, *norm1_g, *w_in, *pool_w, *pool_scale, *sgu_norm_g, *sgu_w, *sgu_b, *w_out, *norm2_g, *peer_wq, *peer_keys, *peer_u, *peer_v, *final_g;
    float* out;
    bf16_t *winT, *woutT, *wqT, *poolT, *wsM, *keysB;
    unsigned char *u8, *v8;
    float2* suv;
    float *rstd1, *sx;
    signed char *xq, *winT8; unsigned* swb;
    bf16_t *xb, *zb, *cB, *hb;
    int* idx; float* gate; float* coef;
    unsigned* bar;
};

__device__ __forceinline__ int tid_opaque() { int t = (int)threadIdx.x; asm volatile("" : "+v"(t)); return t; }
__device__ __forceinline__ unsigned short f2bf(float f) {
    unsigned u = __float_as_uint(f);
    u += 0x7fffu + ((u >> 16) & 1u);
    return (unsigned short)(u >> 16);
}
__device__ __forceinline__ float bf2f(unsigned short h) { return __uint_as_float(((unsigned)h) << 16); }
__device__ __forceinline__ unsigned pack2(float a, float b) { return (unsigned)f2bf(a) | ((unsigned)f2bf(b) << 16); }
__device__ __forceinline__ float bflo(unsigned w) { return __uint_as_float(w << 16); }
__device__ __forceinline__ float bfhi(unsigned w) { return __uint_as_float(w & 0xffff0000u); }
__device__ __forceinline__ float gelu_t(float x) {
    const float y = 1.5957691216057308f * (x + 0.044715f * x * x * x);
    return x * __builtin_amdgcn_rcpf(1.0f + __expf(-y));
}
__device__ __forceinline__ float wave_sum(float v) {
#pragma unroll
    for (int o = 32; o >= 1; o >>= 1) v += __shfl_xor(v, o);
    return v;
}
__device__ __forceinline__ float wave_max(float v) {
#pragma unroll
    for (int o = 32; o >= 1; o >>= 1) v = fmaxf(v, __shfl_xor(v, o));
    return v;
}

#define GEMM_LDS_BYTES (2 * 128 * 144)
__device__ __forceinline__ void transpose_tile(const int tid, const float* __restrict__ src, bf16_t* __restrict__ dst, int R, int C, const float* __restrict__ rscale, int tile, float* lds) {
    const int tilesC = C / 64, tr = tile / tilesC, tc = tile % tilesC;
    const int ty = tid >> 6, tx = tid & 63;
    __syncthreads();
#pragma unroll
    for (int i = 0; i < 16; ++i) {
        const int r = ty + 4 * i;
        float v = src[(size_t)(tr * 64 + r) * C + tc * 64 + tx];
        if (rscale) v *= rscale[tr * 64 + r];
        lds[r * 65 + tx] = v;
    }
    __syncthreads();
#pragma unroll
    for (int i = 0; i < 16; ++i) {
        const int c = ty + 4 * i;
        dst[(size_t)(tc * 64 + c) * R + tr * 64 + tx] = f2bf(lds[tx * 65 + c]);
    }
}

__device__ __forceinline__ void prep_w8_tiles(const Params& p, char* lds, int tid) {
    const int half = tid >> 8, ht = tid & 255, ty = ht >> 6, tx = ht & 63;
    float* fl = (float*)(lds + half * (64 * 65 * 4));
    for (int t = 2 * blockIdx.x + half; t < 16 * 24; t += 2 * gridDim.x) {
        const int tr = t / 24, tc = t % 24;
        if (ht == 0) {
            unsigned spins = 0;
            while (__hip_atomic_load(p.swb + 1536 + tc, __ATOMIC_RELAXED, __HIP_MEMORY_SCOPE_AGENT) < 16u && ++spins < (1u << 22)) __builtin_amdgcn_s_sleep(2);
        }
        __syncthreads();
#pragma unroll
        for (int i = 0; i < 16; ++i) {
            const int r = ty + 4 * i;
            fl[r * 65 + tx] = p.w_in[(size_t)(tr * 64 + r) * 1536 + tc * 64 + tx] * p.norm1_g[tr * 64 + r];
        }
        __syncthreads();
#pragma unroll
        for (int i = 0; i < 16; ++i) {
            const int c = ty + 4 * i;
            const float am = __uint_as_float(__hip_atomic_load(p.swb + tc * 64 + c, __ATOMIC_RELAXED, __HIP_MEMORY_SCOPE_AGENT));
            const float inv = am > 0.f ? 127.0f / am : 0.f;
            p.winT8[(size_t)(tc * 64 + c) * 1024 + tr * 64 + tx] = (signed char)(int)rintf(fl[tx * 65 + c] * inv);
        }
    }
}

__device__ void phase_prep(const Params& p, char* lds) {
    const int tidx_ = tid_opaque();
    const int nb = gridDim.x, b = blockIdx.x, tid = tidx_;
    const int half = tid >> 8, ht = tid & 255, nh = 2 * nb, hb2 = 2 * b + half;
    float* fl = (float*)(lds + half * (64 * 65 * 4));
    for (int t = hb2; t < 16 * 24; t += nh) {
        const int tr = t / 24, tc = t % 24, ty = ht >> 6, tx = ht & 63;
        float am = 0.f;
#pragma unroll
        for (int i = 0; i < 16; ++i) { const int r = tr * 64 + ty + 4 * i; am = fmaxf(am, fabsf(p.w_in[(size_t)r * 1536 + tc * 64 + tx] * p.norm1_g[r])); }
        (void)__hip_atomic_fetch_max(p.swb + tc * 64 + tx, __float_as_uint(am), __ATOMIC_RELAXED, __HIP_MEMORY_SCOPE_AGENT);
        asm volatile("s_waitcnt vmcnt(0)" ::: "memory");
        __syncthreads();
        if (ht == 0) (void)__hip_atomic_fetch_add(p.swb + 1536 + tc, 1u, __ATOMIC_RELAXED, __HIP_MEMORY_SCOPE_AGENT);
    }
    for (int t = hb2; t < 16 * 16; t += nh) transpose_tile(ht, p.w_out, p.woutT, 1024, 1024, nullptr, t, fl);
    for (int t = hb2; t < 16 * 32; t += nh) transpose_tile(ht, p.peer_wq, p.wqT, 1024, 2048, p.norm2_g, t, fl);
    for (int t = hb2; t < 16; t += nh) transpose_tile(ht, p.pool_w + (size_t)(t >> 2) * 16384, p.poolT + (size_t)(t >> 2) * 16384, 128, 128, nullptr, t & 3, fl);
    const size_t gtid = (size_t)b * blockDim.x + tid, gsz = (size_t)nb * blockDim.x;
    for (size_t i = gtid; i < 4 * 128 * 128; i += gsz) {
        const int j = (int)(i & 127), ii = (int)((i >> 7) & 127);
        const bool keep = (j >> 6) <= (ii >> 6);
        p.wsM[i] = keep ? f2bf(p.sgu_w[i]) : (bf16_t)0;
    }
    for (size_t o = gtid; o < 2 * 8 * 128 * 128; o += gsz) {
        const int j = (int)(o & 7), ln = (int)((o >> 3) & 63), nb = (int)((o >> 9) & 7), kk = (int)((o >> 12) & 3), ph = (int)(o >> 14);
        p.keysB[o] = f2bf(p.peer_keys[(size_t)ph * 16384 + (size_t)(16 * nb + (ln & 15)) * 128 + 32 * kk + 8 * (ln >> 4) + j]);
    }
    {
        const int wave = (b * blockDim.x + tid) >> 6, nwaves = (nb * blockDim.x) >> 6, lane = tid & 63;
        float g16[16];
#pragma unroll
        for (int i = 0; i < 4; ++i) { const float4 g = ((const float4*)(p.norm2_g + lane * 16))[i]; g16[4 * i] = g.x; g16[4 * i + 1] = g.y; g16[4 * i + 2] = g.z; g16[4 * i + 3] = g.w; }
        auto quant_row = [&](const float (&f)[16], unsigned char* dst, float* scale_out) {
            float am = 0.f;
#pragma unroll
            for (int j = 0; j < 16; ++j) am = fmaxf(am, fabsf(f[j]));
            am = wave_max(am);
            const float inv = am > 0.f ? 31.0f / am : 0.f;
            int q[16];
#pragma unroll
            for (int j = 0; j < 16; ++j) q[j] = (int)rintf(f[j] * inv) + 32;
            u32x3 o;
#pragma unroll
            for (int i = 0; i < 3; ++i) {
                unsigned w = 0;
#pragma unroll
                for (int k = 0; k < 4; ++k) w |= (unsigned)(q[4 * i + k] | (((q[12 + k] >> (2 * i)) & 3) << 6)) << (8 * k);
                o[i] = w;
            }
            *(u32x3*)(dst + lane * 12) = o;
            if (lane == 0) *scale_out = am * (1.0f / 31.0f);
        };
        for (int e = wave; e < NEXP; e += nwaves) {
            const float4* su4 = (const float4*)(p.peer_u + (size_t)e * D_MODEL + lane * 16);
            const float4* sv4 = (const float4*)(p.peer_v + (size_t)e * D_MODEL + lane * 16);
            float4 a4[4], b4[4];
#pragma unroll
            for (int i = 0; i < 4; ++i) { a4[i] = su4[i]; b4[i] = sv4[i]; }
            float fu[16], fv[16];
#pragma unroll
            for (int i = 0; i < 4; ++i) {
                fu[4 * i] = a4[i].x * g16[4 * i]; fu[4 * i + 1] = a4[i].y * g16[4 * i + 1]; fu[4 * i + 2] = a4[i].z * g16[4 * i + 2]; fu[4 * i + 3] = a4[i].w * g16[4 * i + 3];
                fv[4 * i] = b4[i].x; fv[4 * i + 1] = b4[i].y; fv[4 * i + 2] = b4[i].z; fv[4 * i + 3] = b4[i].w;
            }
            {
                float am = 0.f;
#pragma unroll
                for (int j = 0; j < 16; ++j) am = fmaxf(am, fabsf(fu[j]));
                am = wave_max(am);
                const float inv = am > 0.f ? 127.0f / am : 0.f;
                u32x4 o;
#pragma unroll
                for (int i = 0; i < 4; ++i) {
                    unsigned w = 0;
#pragma unroll
                    for (int k = 0; k < 4; ++k) w |= (unsigned)(((int)rintf(fu[4 * i + k] * inv)) & 0xff) << (8 * k);
                    o[i] = w;
                }
                *(u32x4*)(p.u8 + (size_t)e * D_MODEL + lane * 16) = o;
                if (lane == 0) p.suv[e].x = am * (1.0f / 127.0f);
            }
            quant_row(fv, p.v8 + (size_t)e * ROWB, &p.suv[e].y);
        }
    }
    const int wave = (b * blockDim.x + tid) >> 6, nwaves = (nb * blockDim.x) >> 6, lane = tid & 63;
    for (int t = wave; t < T_TOK; t += 2 * nwaves) {
        const int t1 = t + nwaves; const bool two = t1 < T_TOK;
        const float4* xr0 = (const float4*)(p.x + (size_t)t * D_MODEL);
        const float4* xr1 = (const float4*)(p.x + (size_t)(two ? t1 : t) * D_MODEL);
        float4 v0[4], v1[4];
#pragma unroll
        for (int i = 0; i < 4; ++i) { v0[i] = xr0[lane + 64 * i]; v1[i] = xr1[lane + 64 * i]; }
        float s0 = 0.f, s1 = 0.f, a0 = 0.f, a1 = 0.f;
#pragma unroll
        for (int i = 0; i < 4; ++i) {
            s0 += v0[i].x * v0[i].x + v0[i].y * v0[i].y + v0[i].z * v0[i].z + v0[i].w * v0[i].w;
            s1 += v1[i].x * v1[i].x + v1[i].y * v1[i].y + v1[i].z * v1[i].z + v1[i].w * v1[i].w;
            a0 = fmaxf(fmaxf(a0, fmaxf(fabsf(v0[i].x), fabsf(v0[i].y))), fmaxf(fabsf(v0[i].z), fabsf(v0[i].w)));
            a1 = fmaxf(fmaxf(a1, fmaxf(fabsf(v1[i].x), fabsf(v1[i].y))), fmaxf(fabsf(v1[i].z), fabsf(v1[i].w)));
        }
        s0 = wave_sum(s0); s1 = wave_sum(s1); a0 = wave_max(a0); a1 = wave_max(a1);
        const float i0 = a0 > 0.f ? 127.0f / a0 : 0.f, i1 = a1 > 0.f ? 127.0f / a1 : 0.f;
#pragma unroll
        for (int i = 0; i < 4; ++i) {
            const unsigned q0 = ((unsigned)((int)rintf(v0[i].x * i0) & 0xff)) | ((unsigned)((int)rintf(v0[i].y * i0) & 0xff) << 8) | ((unsigned)((int)rintf(v0[i].z * i0) & 0xff) << 16) | ((unsigned)((int)rintf(v0[i].w * i0) & 0xff) << 24);
            ((unsigned*)(p.xq + (size_t)t * D_MODEL))[lane + 64 * i] = q0;
            if (two) {
                const unsigned q1 = ((unsigned)((int)rintf(v1[i].x * i1) & 0xff)) | ((unsigned)((int)rintf(v1[i].y * i1) & 0xff) << 8) | ((unsigned)((int)rintf(v1[i].z * i1) & 0xff) << 16) | ((unsigned)((int)rintf(v1[i].w * i1) & 0xff) << 24);
                ((unsigned*)(p.xq + (size_t)t1 * D_MODEL))[lane + 64 * i] = q1;
            }
        }
        if (lane == 0) {
            p.rstd1[t] = rsqrtf(s0 * (1.0f / D_MODEL) + EPS) * a0 * (1.0f / 127.0f); p.sx[t] = a0 * (1.0f / 127.0f);
            if (two) { p.rstd1[t1] = rsqrtf(s1 * (1.0f / D_MODEL) + EPS) * a1 * (1.0f / 127.0f); p.sx[t1] = a1 * (1.0f / 127.0f); }
        }
    }
    prep_w8_tiles(p, lds, tid);
}

typedef short s16x4 __attribute__((ext_vector_type(4)));
template <class Epi>
__device__ __forceinline__ void gemm128_sgu(const int tid, const bf16_t* __restrict__ A, const bf16_t* __restrict__ V  ,
                                            const float* __restrict__ lnm, const float* __restrict__ lnr, const float* __restrict__ gch, char* lds, const Epi& epi) {
    const int lane = tid & 63, wid = tid >> 6, wr = wid >> 1, wc = wid & 1, fr = lane & 15, fq = lane >> 4;
    constexpr int PITCH = 144, P2 = 288;
    char* sA = lds; char* sB = lds + 128 * PITCH;
    f32x4 acc[4][4];
#pragma unroll
    for (int m = 0; m < 4; ++m)
#pragma unroll
        for (int n = 0; n < 4; ++n) acc[m][n] = (f32x4){0.f, 0.f, 0.f, 0.f};
    u32x4 ra[4], rb[4]; float rm[4], rr[4];
    const int lrow = tid >> 3, lch = tid & 7;
    const int btok = tid >> 4, bch = tid & 15;
    const bf16_t* ga = A + (size_t)lrow * 128 + lch * 8;
    const bf16_t* gb = V + (size_t)btok * D_IN + bch * 8;
    float g8[8];
    { const float4 g0 = *(const float4*)(gch + bch * 8), g1 = *(const float4*)(gch + bch * 8 + 4); g8[0] = g0.x; g8[1] = g0.y; g8[2] = g0.z; g8[3] = g0.w; g8[4] = g1.x; g8[5] = g1.y; g8[6] = g1.z; g8[7] = g1.w; }
#pragma unroll
    for (int j = 0; j < 4; ++j) { ra[j] = *(const u32x4*)(ga + (size_t)(32 * j) * 128); rb[j] = *(const u32x4*)(gb + (size_t)(16 * j) * D_IN); rm[j] = lnm[btok + 16 * j]; rr[j] = lnr[btok + 16 * j]; }
    for (int k0 = 0; k0 < 128; k0 += 64) {
        __syncthreads();
#pragma unroll
        for (int j = 0; j < 4; ++j) {
            *(u32x4*)(sA + (lrow + 32 * j) * PITCH + lch * 16) = ra[j];
            u32x4 o;
#pragma unroll
            for (int i = 0; i < 4; ++i) {
                const unsigned w = rb[j][i];
                o[i] = pack2((bflo(w) - rm[j]) * rr[j] * g8[2 * i], (bfhi(w) - rm[j]) * rr[j] * g8[2 * i + 1]);
            }
            *(u32x4*)(sB + (btok + 16 * j) * P2 + bch * 16) = o;
        }
        __syncthreads();
        if (k0 + 64 < 128) {
#pragma unroll
            for (int j = 0; j < 4; ++j) { ra[j] = *(const u32x4*)(ga + (size_t)(32 * j) * 128 + 64); rb[j] = *(const u32x4*)(gb + (size_t)(64 + 16 * j) * D_IN); rm[j] = lnm[64 + btok + 16 * j]; rr[j] = lnr[64 + btok + 16 * j]; }
        }
#pragma unroll
        for (int kk = 0; kk < 2; ++kk) {
            bf16x8 af[4], bfr[4];
#pragma unroll
            for (int m = 0; m < 4; ++m) af[m] = *(const bf16x8*)(sA + (wr * 64 + m * 16 + fr) * PITCH + (kk * 32 + fq * 8) * 2);
#pragma unroll
            for (int n = 0; n < 4; ++n) {
                const char* bp = sB + (kk * 32 + fq * 8 + (fr >> 2)) * P2 + (wc * 64 + n * 16 + 4 * (fr & 3)) * 2;
                const s16x4 lo = __builtin_amdgcn_ds_read_tr16_b64_v4i16((LAS s16x4*)(bp));
                const s16x4 hi = __builtin_amdgcn_ds_read_tr16_b64_v4i16((LAS s16x4*)(bp + 4 * P2));
                bfr[n] = (bf16x8){lo[0], lo[1], lo[2], lo[3], hi[0], hi[1], hi[2], hi[3]};
            }
#pragma unroll
            for (int m = 0; m < 4; ++m)
#pragma unroll
                for (int n = 0; n < 4; ++n) acc[m][n] = __builtin_amdgcn_mfma_f32_16x16x32_bf16(bfr[n], af[m], acc[m][n], 0, 0, 0);
        }
    }
#pragma unroll
    for (int m = 0; m < 4; ++m)
#pragma unroll
        for (int n = 0; n < 4; ++n) epi(wr * 64 + m * 16 + fr, wc * 64 + n * 16 + fq * 4, acc[m][n]);
}

#define PT_PITCH 272
#define MIXH_LDS (2 * 128 * PT_PITCH + 1024)
template <int W, class Epi>
__device__ __forceinline__ void pool_tile(const int tid, const bf16_t* __restrict__ zb0  , int pos0,
                                          const bf16_t* __restrict__ Bt, char* lds, const Epi& epi) {
    const int lane = tid & 63, wid = tid >> 6, wr = wid >> 1, wc = wid & 1, fr = lane & 15, fq = lane >> 4;
    char* sA = lds; char* sB = lds + 128 * PT_PITCH;
    __syncthreads();
#pragma unroll
    for (int j = 0; j < 8; ++j) { const int id = tid + 256 * j, row = id >> 4, ch = id & 15; *(u32x4*)(sB + row * PT_PITCH + ch * 16) = *(const u32x4*)(Bt + (size_t)row * 128 + ch * 8); }
    {
        const int seg = tid >> 5, hc = tid & 31, r0 = seg * 16;
        const bool at_start = (pos0 & (SEQ - 1)) == 0;
        const bf16_t* zp = zb0 + hc * 4;
        u32x2 v[W + 16];
#pragma unroll
        for (int i = 0; i < W + 16; ++i) { const int rr = r0 - W + i; const bool ok = !(at_start && rr < 0); v[i] = *(const u32x2*)(zp + (ptrdiff_t)(ok ? rr : 0) * D_IN); }
        float sm[4] = {0.f, 0.f, 0.f, 0.f};
#pragma unroll
        for (int i = 1; i <= W; ++i) {
            const float m = (at_start && (r0 - W + i) < 0) ? 0.f : 1.f;
            sm[0] += m * bflo(v[i].x); sm[1] += m * bfhi(v[i].x); sm[2] += m * bflo(v[i].y); sm[3] += m * bfhi(v[i].y);
        }
#pragma unroll
        for (int o = 0; o < 16; ++o) {
            if (o > 0) {
                const float md = (at_start && (r0 + o - W) < 0) ? 0.f : 1.f;
                sm[0] += bflo(v[W + o].x) - md * bflo(v[o].x); sm[1] += bfhi(v[W + o].x) - md * bfhi(v[o].x);
                sm[2] += bflo(v[W + o].y) - md * bflo(v[o].y); sm[3] += bfhi(v[W + o].y) - md * bfhi(v[o].y);
            }
            const int pos = (pos0 + r0 + o) & (SEQ - 1);
            const float rn = 1.0f / (float)((pos + 1 < W) ? pos + 1 : W);
            u32x2 ov;
            ov.x = pack2(sm[0] * rn - bflo(v[W + o].x), sm[1] * rn - bfhi(v[W + o].x));
            ov.y = pack2(sm[2] * rn - bflo(v[W + o].y), sm[3] * rn - bfhi(v[W + o].y));
            *(u32x2*)(sA + (r0 + o) * PT_PITCH + hc * 8) = ov;
        }
    }
    __syncthreads();
    f32x4 acc[4][4];
#pragma unroll
    for (int m = 0; m < 4; ++m)
#pragma unroll
        for (int n = 0; n < 4; ++n) acc[m][n] = (f32x4){0.f, 0.f, 0.f, 0.f};
#pragma unroll
    for (int kk = 0; kk < 4; ++kk) {
        bf16x8 af[4], bfr[4];
#pragma unroll
        for (int m = 0; m < 4; ++m) af[m] = *(const bf16x8*)(sA + (wr * 64 + m * 16 + fr) * PT_PITCH + (kk * 32 + fq * 8) * 2);
#pragma unroll
        for (int n = 0; n < 4; ++n) bfr[n] = *(const bf16x8*)(sB + (wc * 64 + n * 16 + fr) * PT_PITCH + (kk * 32 + fq * 8) * 2);
#pragma unroll
        for (int m = 0; m < 4; ++m)
#pragma unroll
            for (int n = 0; n < 4; ++n) acc[m][n] = __builtin_amdgcn_mfma_f32_16x16x32_bf16(bfr[n], af[m], acc[m][n], 0, 0, 0);
    }
#pragma unroll
    for (int m = 0; m < 4; ++m)
#pragma unroll
        for (int n = 0; n < 4; ++n) epi(wr * 64 + m * 16 + fr, wc * 64 + n * 16 + fq * 4, acc[m][n]);
}

__device__ void phase_mix_gemm(const Params& p, char* lds) {
    const int tidx_ = tid_opaque();
    const int npool = (T_TOK / 128) * 4, nsgu = (T_TOK / 128) * 4;
    const int half = tidx_ >> 8, ht = tidx_ & 255; lds += half * MIXH_LDS;
    for (int tile = 2 * blockIdx.x + half; tile < npool + nsgu; tile += 2 * gridDim.x) {
        if (tile < npool) {
            const int tm = tile >> 2, g = tile & 3;
            const float* ps = p.pool_scale + g * 128; bf16_t* co = p.cB + (size_t)tm * 128 * D_MODEL + g * 128;
            const bf16_t* z0 = p.zb + (size_t)tm * 128 * D_IN + g * 128; const bf16_t* bt = p.poolT + (size_t)g * 16384;
            auto epi = [&](int r, int c, f32x4 v) {
                const float4 sc = *(const float4*)(ps + c);
                uint2 o; o.x = pack2(v[0] * sc.x, v[1] * sc.y); o.y = pack2(v[2] * sc.z, v[3] * sc.w);
                *(uint2*)(co + (size_t)r * D_MODEL + c) = o;
            };
            if (g == 0) pool_tile<2>(ht, z0, tm * 128, bt, lds, epi); else if (g == 1) pool_tile<4>(ht, z0, tm * 128, bt, lds, epi);
            else if (g == 2) pool_tile<8>(ht, z0, tm * 128, bt, lds, epi); else pool_tile<16>(ht, z0, tm * 128, bt, lds, epi);
        } else {
            const int t2 = tile - npool, blk = t2 >> 2, h = t2 & 3;
            float* stm = (float*)(lds + GEMM_LDS_BYTES); float* str = stm + 128;
            __syncthreads();
            {
                const int tok = ht >> 1, hh = ht & 1;
                const u32x4* vp = (const u32x4*)(p.zb + (size_t)(blk * 128 + tok) * D_IN + 1024 + hh * 256);
                float s1 = 0.f, s2 = 0.f;
#pragma unroll 8
                for (int i = 0; i < 32; ++i) {
                    const u32x4 v = vp[i];
#pragma unroll
                    for (int k = 0; k < 4; ++k) { const float a = bflo(v[k]), c = bfhi(v[k]); s1 += a + c; s2 += a * a + c * c; }
                }
                s1 += __shfl_xor(s1, 1); s2 += __shfl_xor(s2, 1);
                const float mean = s1 * (1.0f / 512.0f), var = fmaxf(s2 * (1.0f / 512.0f) - mean * mean, 0.f);
                if (hh == 0) { stm[tok] = mean; str[tok] = rsqrtf(var + EPS); }
            }
            __syncthreads();
            const float* sb = p.sgu_b + h * 128; const bf16_t* uo = p.zb + (size_t)blk * 128 * D_IN + 512 + h * 128;
            bf16_t* co = p.cB + (size_t)blk * 128 * D_MODEL + 512 + h * 128;
            gemm128_sgu(ht, p.wsM + (size_t)h * 16384, p.zb + (size_t)blk * 128 * D_IN + 1024 + h * 128, stm, str, p.sgu_norm_g + h * 128, lds,
                    [&](int r, int c, f32x4 v) {
                        const float bb = sb[r];
                        const uint2 uu = *(const uint2*)(uo + (size_t)r * D_IN + c);
                        uint2 o;
                        o.x = pack2((v[0] + bb) * bflo(uu.x), (v[1] + bb) * bfhi(uu.x));
                        o.y = pack2((v[2] + bb) * bflo(uu.y), (v[3] + bb) * bfhi(uu.y));
                        *(uint2*)(co + (size_t)r * D_MODEL + c) = o;
                    });
        }
    }
}

__device__ __forceinline__ int wave_sum_i_uniform(int s) {
    s += __builtin_amdgcn_update_dpp(0, s, 0xB1, 0xf, 0xf, false);
    s += __builtin_amdgcn_update_dpp(0, s, 0x4E, 0xf, 0xf, false);
    s += __builtin_amdgcn_update_dpp(0, s, 0x141, 0xf, 0xf, false);
    s += __builtin_amdgcn_update_dpp(0, s, 0x140, 0xf, 0xf, false);
    return __builtin_amdgcn_readlane(s, 0) + __builtin_amdgcn_readlane(s, 16) + __builtin_amdgcn_readlane(s, 32) + __builtin_amdgcn_readlane(s, 48);
}
__constant__ unsigned char kComb[64] = {
    0x00,0x01,0x02,0x03,0x04,0x05,0x06,0x07,0x08,0x09,0x0a,0x0b,0x0c,0x0d,0x0e,0x0f,
    0x10,0x11,0x12,0x13,0x14,0x15,0x16,0x17,
    0x20,0x21,0x22,0x23,0x24,
    0x30,0x31,0x32,0x33,
    0x40,0x41,0x42,
    0x50,0x51,
    0x60,0x61,
    0x70,0x71,
    0x80,0x90,0xa0,0xb0,0xc0,0xd0,0xe0,0xf0,
    0xff,0xff,0xff,0xff,0xff,0xff,0xff,0xff,0xff,0xff,0xff,0xff,0xff,0xff};

template <int CTRL> __device__ __forceinline__ int dpp_i(int v) { return __builtin_amdgcn_update_dpp(0, v, CTRL, 0xf, 0xf, false); }
__device__ __forceinline__ int row_allmax_i(int v) {
    v = max(v, dpp_i<0x128>(v)); v = max(v, dpp_i<0x124>(v)); v = max(v, dpp_i<0x122>(v)); v = max(v, dpp_i<0x121>(v));
    return v;
}
__device__ __forceinline__ float row_allsum_f(float v) {
    v += __int_as_float(dpp_i<0x128>(__float_as_int(v))); v += __int_as_float(dpp_i<0x124>(__float_as_int(v)));
    v += __int_as_float(dpp_i<0x122>(__float_as_int(v))); v += __int_as_float(dpp_i<0x121>(__float_as_int(v)));
    return v;
}
__device__ __forceinline__ int f2key(float f) { const int b = __float_as_int(f); return b ^ ((b >> 31) & 0x7fffffff); }
__device__ __forceinline__ float key2f(int k) { return __int_as_float(k ^ ((k >> 31) & 0x7fffffff)); }
#define KEY_MIN ((int)0x80000000)
#define CE(a, b) { const int hi_ = max(a, b), lo_ = min(a, b); a = hi_; b = lo_; }
__device__ __forceinline__ int top16_rows(int (&k)[8], int l15) {
    CE(k[0], k[1]) CE(k[2], k[3]) CE(k[4], k[5]) CE(k[6], k[7])
    CE(k[0], k[2]) CE(k[1], k[3]) CE(k[4], k[6]) CE(k[5], k[7])
    CE(k[1], k[2]) CE(k[5], k[6])
    CE(k[0], k[4]) CE(k[1], k[5]) CE(k[2], k[6]) CE(k[3], k[7])
    CE(k[2], k[4]) CE(k[3], k[5])
    CE(k[1], k[2]) CE(k[3], k[4]) CE(k[5], k[6])
    int res = KEY_MIN;
#pragma unroll
    for (int r = 0; r < 16; ++r) {
        const int m = row_allmax_i(k[0]);
        const bool own = (k[0] == m);
#pragma unroll
        for (int j = 0; j < 7; ++j) k[j] = own ? k[j + 1] : k[j];
        k[7] = own ? KEY_MIN : k[7];
        res = (l15 == r) ? m : res;
    }
    return res;
}
__device__ __forceinline__ void combine16(int A, int B, const int (&cbv)[4], int lane, int l15, int& eid_out, float& gate_out) {
    const int rowbase = lane & 48;
    int ck[4], eid[4];
#pragma unroll
    for (int c = 0; c < 4; ++c) {
        const int ci = (cbv[c] >> 4) & 15, cj = cbv[c] & 15;
        const int ka = __builtin_amdgcn_ds_bpermute((rowbase + ci) << 2, A);
        const int kb = __builtin_amdgcn_ds_bpermute((rowbase + cj) << 2, B);
        const float sm = key2f(ka & ~127) + key2f(kb & ~127);
        eid[c] = ((127 - (ka & 127)) << 7) | (127 - (kb & 127));
        ck[c] = (cbv[c] != 0xff) ? ((f2key(sm) & ~63) | (63 - (4 * l15 + c))) : KEY_MIN;
    }
    CE(ck[0], ck[1]) CE(ck[2], ck[3]) CE(ck[0], ck[2]) CE(ck[1], ck[3]) CE(ck[1], ck[2])
    int res = KEY_MIN;
#pragma unroll
    for (int r = 0; r < 16; ++r) {
        const int m = row_allmax_i(ck[0]);
        const bool own = (ck[0] == m);
        ck[0] = own ? ck[1] : ck[0]; ck[1] = own ? ck[2] : ck[1]; ck[2] = own ? ck[3] : ck[2]; ck[3] = own ? KEY_MIN : ck[3];
        res = (l15 == r) ? m : res;
    }
    const int slot = 63 - (res & 63);
    const int src = (rowbase + (slot >> 2)) << 2;
    const int e0 = __builtin_amdgcn_ds_bpermute(src, eid[0]), e1 = __builtin_amdgcn_ds_bpermute(src, eid[1]);
    const int e2 = __builtin_amdgcn_ds_bpermute(src, eid[2]), e3 = __builtin_amdgcn_ds_bpermute(src, eid[3]);
    const int sel = slot & 3;
    eid_out = sel == 0 ? e0 : (sel == 1 ? e1 : (sel == 2 ? e2 : e3));
    gate_out = key2f(res & ~63);
}

__device__ __forceinline__ int reduce16_rows(const int (&part)[16], bool b3, bool b2, bool b1, bool b0b) {
    int r8[8], r4[4], r2[2];
#pragma unroll
    for (int k = 0; k < 8; ++k) { const int keep = b3 ? part[8 + k] : part[k], send = b3 ? part[k] : part[8 + k]; r8[k] = keep + __builtin_amdgcn_update_dpp(0, send, 0x140, 0xf, 0xf, false); }
#pragma unroll
    for (int k = 0; k < 4; ++k) { const int keep = b2 ? r8[4 + k] : r8[k], send = b2 ? r8[k] : r8[4 + k]; r4[k] = keep + __builtin_amdgcn_update_dpp(0, send, 0x141, 0xf, 0xf, false); }
#pragma unroll
    for (int k = 0; k < 2; ++k) { const int keep = b1 ? r4[2 + k] : r4[k], send = b1 ? r4[k] : r4[2 + k]; r2[k] = keep + __builtin_amdgcn_update_dpp(0, send, 0x4E, 0xf, 0xf, false); }
    const int keep = b0b ? r2[1] : r2[0], send = b0b ? r2[0] : r2[1];
    int r1 = keep + __builtin_amdgcn_update_dpp(0, send, 0xB1, 0xf, 0xf, false);
    r1 += __shfl_xor(r1, 16); r1 += __shfl_xor(r1, 32);
    return r1;
}
#define TS_WBYTES (16384 + 128)
__device__ void phase_peer_dots(const Params& p, char* lds) {
    const int tidx_ = tid_opaque();
    const int lane = tidx_ & 63, wid = __builtin_amdgcn_readfirstlane((int)(tidx_ >> 6)), l15 = lane & 15;
    const bool b3 = (lane & 8) != 0, b2 = (lane & 4) != 0, b1 = (lane & 2) != 0, b0b = (lane & 1) != 0;
    const int gw = blockIdx.x * (blockDim.x >> 6) + wid, ngw = gridDim.x * (blockDim.x >> 6);
    char* wl = lds + wid * TS_WBYTES;
    unsigned* list = (unsigned*)wl; int* dotsl = (int*)(wl + 4096); char* hql = wl + 8192; int* tks = (int*)(wl + 16384);
    const unsigned lane16 = (unsigned)lane * 16u;
    for (int tb = gw * 8; tb < T_TOK; tb += ngw * 8) {
#pragma unroll 1
        for (int j0 = 0; j0 < 8; j0 += 4) {
            u32x4 hraw[4][2];
#pragma unroll
            for (int jj = 0; jj < 4; ++jj) { const u32x4* hr = (const u32x4*)(p.hb + (size_t)(tb + j0 + jj) * D_MODEL); hraw[jj][0] = hr[2 * lane]; hraw[jj][1] = hr[2 * lane + 1]; }
#pragma unroll
            for (int jj = 0; jj < 4; ++jj) {
                const int j = j0 + jj;
                const u32x4 a = hraw[jj][0], c = hraw[jj][1];
                const float f[16] = {bflo(a.x), bfhi(a.x), bflo(a.y), bfhi(a.y), bflo(a.z), bfhi(a.z), bflo(a.w), bfhi(a.w),
                                     bflo(c.x), bfhi(c.x), bflo(c.y), bfhi(c.y), bflo(c.z), bfhi(c.z), bflo(c.w), bfhi(c.w)};
                float ss = 0.f, am = 0.f;
#pragma unroll
                for (int k = 0; k < 16; ++k) { ss += f[k] * f[k]; am = fmaxf(am, fabsf(f[k])); }
                ss = wave_sum(ss); am = wave_max(am);
                const float inv = am > 0.f ? 127.0f / am : 0.f;
                u32x4 o; int hsum = 0;
#pragma unroll
                for (int i = 0; i < 4; ++i) {
                    unsigned w = 0;
#pragma unroll
                    for (int k = 0; k < 4; ++k) { const int qv = (int)rintf(f[4 * i + k] * inv); hsum += qv; w |= (unsigned)(qv & 0xff) << (8 * k); }
                    o[i] = w;
                }
                *(u32x4*)(hql + j * 1024 + lane * 16) = o;
                hsum = wave_sum_i_uniform(hsum);
                const float r2 = rsqrtf(ss * (1.0f / D_MODEL) + EPS);
                if (lane == 0) { tks[4 * j] = hsum; tks[4 * j + 1] = __float_as_int(am * (1.0f / 127.0f) * r2); tks[4 * j + 2] = __float_as_int(r2); }
            }
        }
        int idv[8][2];
#pragma unroll
        for (int j = 0; j < 8; ++j) { const int* ir = p.idx + (size_t)(tb + j) * 128; idv[j][0] = ir[lane]; idv[j][1] = ir[64 + lane]; }
#pragma unroll 1
        for (int x = 0; x < 8; ++x) {
            int n = 0;
#pragma unroll
            for (int j = 0; j < 8; ++j)
#pragma unroll
                for (int r = 0; r < 2; ++r) {
                    const int e = idv[j][r];
                    const bool in = (e >> 11) == x;
                    const unsigned long long mk = __ballot(in);
                    const int rank = (int)__builtin_amdgcn_mbcnt_hi((unsigned)(mk >> 32), __builtin_amdgcn_mbcnt_lo((unsigned)mk, 0u));
                    if (in) list[n + rank] = ((unsigned)j << 21) | ((unsigned)(r * 64 + lane) << 14) | (unsigned)e;
                    n += (int)__builtin_popcountll(mk);
                }
            asm volatile("s_waitcnt lgkmcnt(0)" ::: "memory");
            u32x4 ua[16], ubf[16]; int enta = 0, entb = 0;
            auto issue = [&](int b0, u32x4 (&uu)[16], int& entv) {
                const int i = (b0 + l15 < n) ? b0 + l15 : n - 1;
                entv = (int)list[i];
#pragma unroll
                for (int j = 0; j < 16; ++j) { const int e = __builtin_amdgcn_readlane(entv, j) & 0x3fff; uu[j] = *(const u32x4*)(p.u8 + (size_t)e * D_MODEL + lane16); }
            };
            auto reduce = [&](int b0, const u32x4 (&uu)[16], int entv) {
                int part[16];
#pragma unroll
                for (int j = 0; j < 16; ++j) {
                    const int tl = __builtin_amdgcn_readlane(entv, j) >> 21;
                    const u32x4 hqv = *(const u32x4*)(hql + tl * 1024 + lane * 16);
                    int sacc = __builtin_amdgcn_sdot4((int)uu[j].x, (int)hqv.x, 0, false);
                    sacc = __builtin_amdgcn_sdot4((int)uu[j].y, (int)hqv.y, sacc, false);
                    sacc = __builtin_amdgcn_sdot4((int)uu[j].z, (int)hqv.z, sacc, false);
                    part[j] = __builtin_amdgcn_sdot4((int)uu[j].w, (int)hqv.w, sacc, false);
                }
                const int r1 = reduce16_rows(part, b3, b2, b1, b0b);
                if (lane < 16 && b0 + lane < n) dotsl[((unsigned)entv >> 21) * 128 + (((unsigned)entv >> 14) & 127u)] = r1;
            };
            if (n > 0) issue(0, ua, enta);
            for (int b0 = 0; b0 < n; b0 += 32) {
                if (b0 + 16 < n) issue(b0 + 16, ubf, entb);
                reduce(b0, ua, enta);
                if (b0 + 16 < n) {
                    if (b0 + 32 < n) issue(b0 + 32, ua, enta);
                    reduce(b0 + 16, ubf, entb);
                }
            }
            asm volatile("s_waitcnt lgkmcnt(0)" ::: "memory");
        }
#pragma unroll
        for (int j = 0; j < 8; ++j) {
            const int hs_t = tks[4 * j]; const float cs_t = __int_as_float(tks[4 * j + 1]), r2_t = __int_as_float(tks[4 * j + 2]);
            const float* gr = p.gate + (size_t)(tb + j) * 128; float* cr = p.coef + (size_t)(tb + j) * 128;
#pragma unroll
            for (int r = 0; r < 2; ++r) {
                const int e = idv[j][r];
                const float sc = gr[r * 64 + lane] * r2_t;
                const float ex = __expf(sc - key2f(row_allmax_i(f2key(sc))));
                const float gt = ex / row_allsum_f(ex);
                const float2 sc2 = p.suv[e];
                const float dotf = (float)dotsl[j * 128 + r * 64 + lane] * cs_t * sc2.x;
                cr[r * 64 + lane] = gt * gelu_t(dotf) * sc2.y;
            }
        }
        asm volatile("s_waitcnt lgkmcnt(0)" ::: "memory");
    }
}

__device__ void phase_gather(const Params& p, char* lds) {
    const int tidx_ = tid_opaque();
    const int wave = __builtin_amdgcn_readfirstlane((int)((blockIdx.x * blockDim.x + tidx_) >> 6)), nwaves = (gridDim.x * blockDim.x) >> 6, lane = tidx_ & 63;
    const unsigned char* vb = p.v8 + lane * 12;
    for (int t = wave; t < T_TOK; t += nwaves) {
        int idr[2]; float coef[2];
        { const int* ir = p.idx + (size_t)t * 128; idr[0] = ir[lane]; idr[1] = ir[64 + lane]; }
        { const float* cr = p.coef + (size_t)t * 128; coef[0] = cr[lane]; coef[1] = cr[64 + lane]; }
        const float cmax = wave_max(fmaxf(fabsf(coef[0]), fabsf(coef[1])));
        const float qs = cmax > 0.f ? 127.0f / cmax : 0.f, cscale = cmax * (1.0f / 127.0f);
        const int cq0 = (int)rintf(coef[0] * qs), cq1 = (int)rintf(coef[1] * qs);
        const int csum_i = wave_sum_i_uniform(cq0 + cq1);
        unsigned cpk[2];
        {
            const int cqs[2] = {cq0, cq1};
#pragma unroll
            for (int hf = 0; hf < 2; ++hf) {
                const int bb = cqs[hf] & 0xff;
                cpk[hf] = (unsigned)__builtin_amdgcn_update_dpp(0, bb, 0x00, 0xf, 0xf, false) | ((unsigned)__builtin_amdgcn_update_dpp(0, bb, 0x55, 0xf, 0xf, false) << 8)
                        | ((unsigned)__builtin_amdgcn_update_dpp(0, bb, 0xAA, 0xf, 0xf, false) << 16) | ((unsigned)__builtin_amdgcn_update_dpp(0, bb, 0xFF, 0xf, 0xf, false) << 24);
            }
        }
        int acc[16];
#pragma unroll
        for (int j = 0; j < 16; ++j) acc[j] = 0;
        {
            u32x3 va[8], vbf[8];
            auto issue = [&](int pb, u32x3 (&vv)[8]) {
#pragma unroll
                for (int q = 0; q < 8; ++q) { const int e = __builtin_amdgcn_readlane(pb < 64 ? idr[0] : idr[1], (pb & 63) + q); vv[q] = *(const u32x3*)(vb + (size_t)e * ROWB); }
            };
            auto axpy = [&](int pb, const u32x3 (&vv)[8]) {
#pragma unroll
                for (int g4 = 0; g4 < 2; ++g4) {
                    const int cqd = __builtin_amdgcn_readlane((int)(pb < 64 ? cpk[0] : cpk[1]), (pb & 63) + 4 * g4);
                    unsigned dd[4][4];
#pragma unroll
                    for (int r = 0; r < 4; ++r) {
                        const unsigned w0 = vv[4 * g4 + r].x, w1 = vv[4 * g4 + r].y, w2 = vv[4 * g4 + r].z;
                        dd[r][0] = w0 & 0x3f3f3f3fu; dd[r][1] = w1 & 0x3f3f3f3fu; dd[r][2] = w2 & 0x3f3f3f3fu;
                        dd[r][3] = ((w0 >> 6) & 0x03030303u) | ((w1 >> 4) & 0x0c0c0c0cu) | ((w2 >> 2) & 0x30303030u);
                    }
#pragma unroll
                    for (int k = 0; k < 4; ++k) {
                        const unsigned p0 = __builtin_amdgcn_perm(dd[1][k], dd[0][k], 0x05010400u), p1 = __builtin_amdgcn_perm(dd[1][k], dd[0][k], 0x07030602u);
                        const unsigned q0 = __builtin_amdgcn_perm(dd[3][k], dd[2][k], 0x05010400u), q1 = __builtin_amdgcn_perm(dd[3][k], dd[2][k], 0x07030602u);
                        const unsigned t0 = __builtin_amdgcn_perm(q0, p0, 0x05040100u), t1 = __builtin_amdgcn_perm(q0, p0, 0x07060302u);
                        const unsigned t2 = __builtin_amdgcn_perm(q1, p1, 0x05040100u), t3 = __builtin_amdgcn_perm(q1, p1, 0x07060302u);
                        acc[4 * k + 0] = __builtin_amdgcn_sdot4((int)t0, cqd, acc[4 * k + 0], false);
                        acc[4 * k + 1] = __builtin_amdgcn_sdot4((int)t1, cqd, acc[4 * k + 1], false);
                        acc[4 * k + 2] = __builtin_amdgcn_sdot4((int)t2, cqd, acc[4 * k + 2], false);
                        acc[4 * k + 3] = __builtin_amdgcn_sdot4((int)t3, cqd, acc[4 * k + 3], false);
                    }
                }
            };
            issue(0, va);
#pragma unroll 1
            for (int pb = 0; pb < 128; pb += 16) {
                issue(pb + 8, vbf);
                axpy(pb, va);
                if (pb + 16 < 128) issue(pb + 16, va);
                axpy(pb + 8, vbf);
            }
        }
        const u32x4* hr = (const u32x4*)(p.hb + (size_t)t * D_MODEL + lane * 16);
        const u32x4 ha = hr[0], hc = hr[1];
        const float hf16[16] = {bflo(ha.x), bfhi(ha.x), bflo(ha.y), bfhi(ha.y), bflo(ha.z), bfhi(ha.z), bflo(ha.w), bfhi(ha.w),
                                bflo(hc.x), bfhi(hc.x), bflo(hc.y), bfhi(hc.y), bflo(hc.z), bfhi(hc.z), bflo(hc.w), bfhi(hc.w)};
        float res[16];
        float ss = 0.f;
#pragma unroll
        for (int j = 0; j < 16; ++j) { res[j] = hf16[j] + cscale * (float)(acc[j] - 32 * csum_i); ss += res[j] * res[j]; }
        ss = wave_sum(ss);
        const float r3 = rsqrtf(ss * (1.0f / D_MODEL) + EPS);
        float* o = p.out + (size_t)t * D_MODEL + lane * 16;
        const float* fg = p.final_g + lane * 16;
#pragma unroll
        for (int i = 0; i < 4; ++i) {
            const float4 g = ((const float4*)fg)[i];
            float4 ov; ov.x = res[4 * i] * r3 * g.x; ov.y = res[4 * i + 1] * r3 * g.y; ov.z = res[4 * i + 2] * r3 * g.z; ov.w = res[4 * i + 3] * r3 * g.w;
            ((float4*)o)[i] = ov;
        }
    }
}

namespace pg8 {
#define PG8_LAS __attribute__((address_space(3)))
constexpr int BM = 256, BK = 64, HALF = 128, HTB = HALF * BK * 2, STAGE_BYTES = 8 * HTB, NXCD = 8, WGM = 8;
__host__ __device__ __forceinline__ int lds_byte(int r, int c) { const int st = (r >> 4) * 2 + (c >> 5), rr = r & 15, cc = c & 31, ob = rr * 64 + cc * 2; return st * 1024 + (ob ^ (((ob >> 9) & 1) << 5)); }
__host__ __device__ __forceinline__ void stage_rc(int b, int& R, int& C) { const int st = b / 1024, sb = b % 1024, swz = sb ^ (((sb >> 9) & 1) << 5); R = (st >> 1) * 16 + swz / 64; C = (st & 1) * 32 + (swz % 64) / 2; }
__host__ __device__ __forceinline__ int perm32(int rho) { const int n = rho >> 4, i = rho & 15; return 8 * (i >> 2) + 4 * n + (i & 3); }
struct Unit { int pm, pn; };
struct Gemm { const bf16_t* A; const bf16_t* Bt; int M, N, K; };
struct StaticOrder {
    int nM, nN, nwg, G, c;
    __host__ __device__ void init(int M, int N, int G_, int c_) { nM = M / BM; nN = N / BM; nwg = nM * nN; G = G_; c = c_; }
    __host__ __device__ bool next(int i, Unit& u) const {
        const long L = (long)i * G + c; if (L >= nwg) return false;
        int wgid = (int)L; { const int q = nwg / NXCD, r = nwg % NXCD, xcd = wgid % NXCD, off = wgid / NXCD; wgid = (xcd < r ? xcd * (q + 1) : r * (q + 1) + (xcd - r) * q) + off; }
        const int nig = WGM * nN, gid = wgid / nig, fm = gid * WGM, gsz = (nM - fm) < WGM ? (nM - fm) : WGM;
        u.pm = fm + ((wgid % nig) % gsz); u.pn = (wgid % nig) / gsz; return true;
    }
    __device__ __forceinline__ void a_ready(const Unit&) const {}
    __device__ __forceinline__ void done(const Unit&) const {}
};
__device__ __forceinline__ unsigned cvt_pk_bf16(float lo, float hi) { unsigned r; asm volatile("v_cvt_pk_bf16_f32 %0, %1, %2" : "=v"(r) : "v"(lo), "v"(hi)); return r; }
template <bool I8> __device__ __forceinline__ typename std::conditional<I8, i32x4, f32x4>::type mma1(bf16x8 a, bf16x8 b, typename std::conditional<I8, i32x4, f32x4>::type c) {
    if constexpr (I8) return __builtin_amdgcn_mfma_i32_16x16x64_i8(*(const i32x4*)&a, *(const i32x4*)&b, c, 0, 0, 0);
    else return __builtin_amdgcn_mfma_f32_16x16x32_bf16(a, b, c, 0, 0, 0);
}
struct EpiZ8 {
    static constexpr bool PERM = true, AFTER_DRAIN = false, I8 = true; typedef i32x4 acc_t;
    bf16_t* O; const float* rsx; const unsigned* swb;
    __device__ __forceinline__ void operator()(const i32x4 (&acc)[2][2][4][2], const Unit& u, int wr, int wc, int fr, int fq) const {
        const int row0 = u.pm * BM + wr * 64 + fr, col0 = u.pn * BM + wc * 32 + 8 * fq; const bool act = u.pn >= 2;
        float sw[2][8];
#pragma unroll
        for (int bj = 0; bj < 2; ++bj) { const u32x4 a = *(const u32x4*)(swb + col0 + bj * HALF), c = *(const u32x4*)(swb + col0 + bj * HALF + 4);
#pragma unroll
            for (int i = 0; i < 4; ++i) { sw[bj][i] = __uint_as_float(a[i]) * (1.0f / 127.0f); sw[bj][4 + i] = __uint_as_float(c[i]) * (1.0f / 127.0f); } }
#pragma unroll
        for (int ai = 0; ai < 2; ++ai)
#pragma unroll
            for (int m = 0; m < 4; ++m) { const int r = row0 + ai * HALF + m * 16; const float sc = rsx[r]; bf16_t* rowp = O + (size_t)r * D_IN + col0;
#pragma unroll
                for (int bj = 0; bj < 2; ++bj) { f32x4 v0, v1;
#pragma unroll
                    for (int i = 0; i < 4; ++i) { v0[i] = (float)acc[ai][bj][m][0][i] * sc * sw[bj][i]; v1[i] = (float)acc[ai][bj][m][1][i] * sc * sw[bj][4 + i]; }
                    if (act) { v0 = (f32x4){gelu_t(v0[0]), gelu_t(v0[1]), gelu_t(v0[2]), gelu_t(v0[3])}; v1 = (f32x4){gelu_t(v1[0]), gelu_t(v1[1]), gelu_t(v1[2]), gelu_t(v1[3])}; }
                    u32x4 w; w.x = cvt_pk_bf16(v0[0], v0[1]); w.y = cvt_pk_bf16(v0[2], v0[3]); w.z = cvt_pk_bf16(v1[0], v1[1]); w.w = cvt_pk_bf16(v1[2], v1[3]);
                    *(u32x4*)(rowp + bj * HALF) = w; } }
    }
};
struct EpiZ {
    static constexpr bool PERM = true, AFTER_DRAIN = false, I8 = false; typedef f32x4 acc_t;
    bf16_t* O; const float* rs;
    __device__ __forceinline__ void operator()(const f32x4 (&acc)[2][2][4][2], const Unit& u, int wr, int wc, int fr, int fq) const {
        const int row0 = u.pm * BM + wr * 64 + fr, col0 = u.pn * BM + wc * 32 + 8 * fq; const bool act = u.pn >= 2;
#pragma unroll
        for (int ai = 0; ai < 2; ++ai)
#pragma unroll
            for (int m = 0; m < 4; ++m) { const int r = row0 + ai * HALF + m * 16; const float sc = rs[r]; bf16_t* rowp = O + (size_t)r * D_IN + col0;
#pragma unroll
                for (int bj = 0; bj < 2; ++bj) { f32x4 v0 = acc[ai][bj][m][0] * sc, v1 = acc[ai][bj][m][1] * sc;
                    if (act) { v0 = (f32x4){gelu_t(v0[0]), gelu_t(v0[1]), gelu_t(v0[2]), gelu_t(v0[3])}; v1 = (f32x4){gelu_t(v1[0]), gelu_t(v1[1]), gelu_t(v1[2]), gelu_t(v1[3])}; }
                    u32x4 w; w.x = cvt_pk_bf16(v0[0], v0[1]); w.y = cvt_pk_bf16(v0[2], v0[3]); w.z = cvt_pk_bf16(v1[0], v1[1]); w.w = cvt_pk_bf16(v1[2], v1[3]);
                    *(u32x4*)(rowp + bj * HALF) = w; } }
    }
};
struct EpiOut {
    static constexpr bool PERM = true, AFTER_DRAIN = false, I8 = false; typedef f32x4 acc_t;
    bf16_t* O; const signed char* X; const float* sx;
    __device__ __forceinline__ void operator()(const f32x4 (&acc)[2][2][4][2], const Unit& u, int wr, int wc, int fr, int fq) const {
        const int row0 = u.pm * BM + wr * 64 + fr, col0 = u.pn * BM + wc * 32 + 8 * fq;
#pragma unroll
        for (int ai = 0; ai < 2; ++ai)
#pragma unroll
            for (int m = 0; m < 4; ++m) { const int r = row0 + ai * HALF + m * 16; const size_t off = (size_t)r * D_MODEL + col0; const float sc = sx[r];
#pragma unroll
                for (int bj = 0; bj < 2; ++bj) { const u32x2 xx = *(const u32x2*)(X + off + bj * HALF);
                    f32x4 x0, x1;
#pragma unroll
                    for (int i = 0; i < 4; ++i) { x0[i] = (float)(signed char)(xx.x >> (8 * i)) * sc; x1[i] = (float)(signed char)(xx.y >> (8 * i)) * sc; }
                    const f32x4 v0 = acc[ai][bj][m][0] + x0, v1 = acc[ai][bj][m][1] + x1;
                    u32x4 w; w.x = cvt_pk_bf16(v0[0], v0[1]); w.y = cvt_pk_bf16(v0[2], v0[3]); w.z = cvt_pk_bf16(v1[0], v1[1]); w.w = cvt_pk_bf16(v1[2], v1[3]);
                    *(u32x4*)(O + off + bj * HALF) = w; } }
    }
};
struct OneUnit {
    Unit u;
    __device__ __forceinline__ bool next(int i, Unit& o) const { if (i) return false; o = u; return true; }
    __device__ __forceinline__ void a_ready(const Unit&) const {}
    __device__ __forceinline__ void done(const Unit&) const {}
};
#define QT_PITCH 272
#define QT_LDS_BYTES (2 * 256 * QT_PITCH)
struct EpiQTopk {
    static constexpr bool PERM = true, AFTER_DRAIN = true, I8 = false; typedef f32x4 acc_t;
    const bf16_t* keysB; int* idx; float* gate;
    __device__ __forceinline__ void fused(f32x4 (&acc)[2][2][4][2], const Unit& u, int wr, int wc, int fr, int fq, PG8_LAS unsigned char* ldsp, int wid, int lane) const {
        char* sQ = (char*)ldsp;
        const int h = u.pn;
#pragma unroll
        for (int ai = 0; ai < 2; ++ai)
#pragma unroll
            for (int m = 0; m < 4; ++m) { const int r = ai * HALF + wr * 64 + m * 16 + fr;
#pragma unroll
                for (int bj = 0; bj < 2; ++bj) { const f32x4 v0 = acc[ai][bj][m][0], v1 = acc[ai][bj][m][1];
                    u32x4 w; w.x = cvt_pk_bf16(v0[0], v0[1]); w.y = cvt_pk_bf16(v0[2], v0[3]); w.z = cvt_pk_bf16(v1[0], v1[1]); w.w = cvt_pk_bf16(v1[2], v1[3]);
                    *(u32x4*)(sQ + bj * (256 * QT_PITCH) + r * QT_PITCH + (wc * 32 + fq * 8) * 2) = w; } }
        __syncthreads();
        int cbv[4];
#pragma unroll
        for (int c = 0; c < 4; ++c) cbv[c] = kComb[4 * fr + c];
        int tA[2][4], tB[2][4];
#pragma unroll
        for (int m = 0; m < 2; ++m)
#pragma unroll
            for (int j = 0; j < 4; ++j) { tA[m][j] = 0; tB[m][j] = 0; }
#pragma unroll 1
        for (int pp = 0; pp < 2; ++pp) {
            const bf16_t* kb = keysB + (size_t)(pp * 8 + h) * 16384 + lane * 8;
            const char* qa = sQ + pp * (256 * QT_PITCH) + (wid * 32 + fr) * QT_PITCH + fq * 16;
            f32x4 sc2[2][8];
#pragma unroll
            for (int m = 0; m < 2; ++m)
#pragma unroll
                for (int nb = 0; nb < 8; ++nb) sc2[m][nb] = (f32x4){0.f, 0.f, 0.f, 0.f};
#pragma unroll
            for (int kk = 0; kk < 4; ++kk) {
                bf16x8 kf[8], af[2];
#pragma unroll
                for (int nb = 0; nb < 8; ++nb) kf[nb] = *(const bf16x8*)(kb + (kk * 8 + nb) * 512);
#pragma unroll
                for (int m = 0; m < 2; ++m) af[m] = *(const bf16x8*)(qa + m * 16 * QT_PITCH + kk * 64);
#pragma unroll
                for (int m = 0; m < 2; ++m)
#pragma unroll
                    for (int nb = 0; nb < 8; ++nb) sc2[m][nb] = __builtin_amdgcn_mfma_f32_16x16x32_bf16(af[m], kf[nb], sc2[m][nb], 0, 0, 0);
            }
#pragma unroll
            for (int m = 0; m < 2; ++m)
#pragma unroll
                for (int j = 0; j < 4; ++j) tA[m][j] = tB[m][j];
#pragma unroll 2
            for (int it = 0; it < 4; ++it) {
#pragma unroll
                for (int m = 0; m < 2; ++m) {
                    int k[8];
#pragma unroll
                    for (int nb = 0; nb < 8; ++nb) k[nb] = (f2key(sc2[m][nb][0]) & ~127) | (127 - (16 * nb + fr));
                    const int r = top16_rows(k, fr);
                    tB[m][0] = tB[m][1]; tB[m][1] = tB[m][2]; tB[m][2] = tB[m][3]; tB[m][3] = r;
#pragma unroll
                    for (int nb = 0; nb < 8; ++nb) sc2[m][nb] = (f32x4){sc2[m][nb][1], sc2[m][nb][2], sc2[m][nb][3], sc2[m][nb][0]};
                }
            }
        }
#pragma unroll 2
        for (int it = 0; it < 4; ++it) {
#pragma unroll
            for (int m = 0; m < 2; ++m) {
                int eid; float gt;
                combine16(tA[m][0], tB[m][0], cbv, lane, fr, eid, gt);
                const int t = u.pm * BM + wid * 32 + m * 16 + fq * 4 + it;
                const size_t o = (size_t)t * 128 + h * 16 + fr;
                idx[o] = eid; gate[o] = gt;
                tA[m][0] = tA[m][1]; tA[m][1] = tA[m][2]; tA[m][2] = tA[m][3];
                tB[m][0] = tB[m][1]; tB[m][1] = tB[m][2]; tB[m][2] = tB[m][3];
            }
        }
        __syncthreads();
    }
};
template <class Epi, class Sched>
__device__ __forceinline__ void gemm_phase(PG8_LAS unsigned char* lds, const Gemm g, const Sched& S, const Epi& E) {
    const int tid = tid_opaque(), wid = __builtin_amdgcn_readfirstlane(tid >> 6), lane = tid & 63, wr = wid >> 2, wc = wid & 3, fr = lane & 15, fq = lane >> 4;
    const int K = g.K, nt = K / BK;
    unsigned voffA[2], voffB[2];
#pragma unroll
    for (int i = 0; i < 2; ++i) { int R, C; stage_rc(tid * 16 + i * 8192, R, C); const int Rb = Epi::PERM ? ((R & ~31) + perm32(R & 31)) : R;
        voffA[i] = (unsigned)(R * K + C) * 2u; voffB[i] = (unsigned)(Rb * K + C) * 2u; }
    const size_t kstep = (size_t)(BK * 2);
    const size_t hstep = (size_t)HALF * K * 2;
    const size_t tstep = 2 * hstep;
    const unsigned ldsw = (unsigned)wid * 1024u;
    const int aoff = lds_byte(wr * 64 + fr, fq * 8), boff = lds_byte(wc * 32 + fr, fq * 8);
#define PG8_SA(b, h) (((b) * 2 + (h)) * HTB)
#define PG8_SB(b, h) ((4 + (b) * 2 + (h)) * HTB)
#define PG8_STAGE(bufoff, gbase, voff) do { _Pragma("unroll") for (int _i = 0; _i < 2; ++_i) \
        __builtin_amdgcn_global_load_lds((const unsigned*)((const char*)(gbase) + (voff)[_i]), (PG8_LAS unsigned*)(lds + (bufoff) + ldsw + _i * 8192), 16, 0, 0); } while (0)
#define PG8_LDA(dst, b, h) do { _Pragma("unroll") for (int m = 0; m < 4; ++m) _Pragma("unroll") for (int k = 0; k < 2; ++k) dst[m][k] = *(const PG8_LAS bf16x8*)(lds + PG8_SA(b, h) + aoff + m * 2048 + k * 1024); } while (0)
#define PG8_LDB(dst, b, h) do { _Pragma("unroll") for (int n = 0; n < 2; ++n) _Pragma("unroll") for (int k = 0; k < 2; ++k) dst[n][k] = *(const PG8_LAS bf16x8*)(lds + PG8_SB(b, h) + boff + n * 2048 + k * 1024); } while (0)
#define PG8_MMA(ai, bj, At, Bt) do { __builtin_amdgcn_s_setprio(1); _Pragma("unroll") for (int m = 0; m < 4; ++m) _Pragma("unroll") for (int n = 0; n < 2; ++n) _Pragma("unroll") for (int k = 0; k < 2; ++k) \
        acc[ai][bj][m][n] = mma1<Epi::I8>(Bt[n][k], At[m][k], acc[ai][bj][m][n]); __builtin_amdgcn_s_setprio(0); } while (0)
#define PG8_WAIT_V(n) asm volatile("s_waitcnt vmcnt(" #n ")" ::: "memory")
#define PG8_WAIT_L(n) asm volatile("s_waitcnt lgkmcnt(" #n ")" ::: "memory")
#define PG8_BAR __builtin_amdgcn_s_barrier()
#define PG8_SCHED __builtin_amdgcn_sched_barrier(0)
    Unit cur, nxt; int ui = 0;
    if (!S.next(0, cur)) return;
    typedef typename Epi::acc_t acc_t;
    acc_t acc[2][2][4][2];
#pragma unroll
    for (int a = 0; a < 2; ++a)
#pragma unroll
        for (int b = 0; b < 2; ++b)
#pragma unroll
            for (int m = 0; m < 4; ++m)
#pragma unroll
                for (int n = 0; n < 2; ++n) acc[a][b][m][n] = (acc_t)(0);
    bf16x8 At[4][2], B0[2][2], B1[2][2];
    const char* cA = (const char*)g.A + (size_t)cur.pm * tstep; const char* cB = (const char*)g.Bt + (size_t)cur.pn * tstep;
    S.a_ready(cur);
    PG8_STAGE(PG8_SB(0, 0), cB, voffB); PG8_STAGE(PG8_SA(0, 0), cA, voffA); PG8_STAGE(PG8_SB(0, 1), cB + hstep, voffB); PG8_STAGE(PG8_SA(0, 1), cA + hstep, voffA);
    if (wr == 1) PG8_BAR;
    PG8_WAIT_V(4); PG8_BAR;
    PG8_STAGE(PG8_SB(1, 0), cB + kstep, voffB); PG8_STAGE(PG8_SA(1, 0), cA + kstep, voffA); PG8_STAGE(PG8_SB(1, 1), cB + hstep + kstep, voffB);
    PG8_WAIT_V(6); PG8_BAR;
    for (;;) {
        const bool has_next = S.next(ui + 1, nxt);
        const char* nA = has_next ? (const char*)g.A + (size_t)nxt.pm * tstep : cA; const char* nB = has_next ? (const char*)g.Bt + (size_t)nxt.pn * tstep : cB;
        for (int t = 0; t < nt; t += 2) {
            const bool last = (t == nt - 2);
            const char* a1 = cA + (size_t)(t + 1) * kstep;
            const char* a2 = last ? nA : cA + (size_t)(t + 2) * kstep; const char* b2 = last ? nB : cB + (size_t)(t + 2) * kstep;
            const char* a3 = a2 + kstep; const char* b3 = b2 + kstep;
            if (last && has_next) S.a_ready(nxt);
            PG8_LDB(B0, 0, 0); PG8_SCHED; PG8_LDA(At, 0, 0); PG8_STAGE(PG8_SA(1, 1), a1 + hstep, voffA);
            PG8_WAIT_L(8); PG8_BAR; PG8_WAIT_L(0); PG8_MMA(0, 0, At, B0); PG8_BAR; PG8_SCHED;
            PG8_LDB(B1, 0, 1); PG8_STAGE(PG8_SB(0, 0), b2, voffB);
            PG8_BAR; PG8_WAIT_L(0); PG8_MMA(0, 1, At, B1); PG8_BAR;
            PG8_LDA(At, 0, 1); PG8_STAGE(PG8_SA(0, 0), a2, voffA);
            PG8_BAR; PG8_WAIT_L(0); PG8_MMA(1, 0, At, B0); PG8_BAR; PG8_SCHED;
            PG8_STAGE(PG8_SB(0, 1), b2 + hstep, voffB);
            PG8_WAIT_V(6); PG8_BAR; PG8_MMA(1, 1, At, B1); PG8_BAR;
            PG8_LDB(B0, 1, 0); PG8_SCHED; PG8_LDA(At, 1, 0); PG8_STAGE(PG8_SA(0, 1), a2 + hstep, voffA);
            PG8_WAIT_L(8); PG8_BAR; PG8_WAIT_L(0); PG8_MMA(0, 0, At, B0); PG8_BAR; PG8_SCHED;
            PG8_LDB(B1, 1, 1); PG8_STAGE(PG8_SB(1, 0), b3, voffB);
            PG8_BAR; PG8_WAIT_L(0); PG8_MMA(0, 1, At, B1); PG8_BAR;
            PG8_LDA(At, 1, 1); PG8_STAGE(PG8_SA(1, 0), a3, voffA);
            PG8_BAR; PG8_WAIT_L(0); PG8_MMA(1, 0, At, B0); PG8_BAR; PG8_SCHED;
            PG8_STAGE(PG8_SB(1, 1), b3 + hstep, voffB);
            PG8_WAIT_V(6); PG8_BAR; PG8_MMA(1, 1, At, B1); PG8_BAR;
        }
            if constexpr (!Epi::AFTER_DRAIN) { E(acc, cur, wr, wc, fr, fq); S.done(cur); }
            if (!has_next) break;
#pragma unroll
        for (int a = 0; a < 2; ++a)
#pragma unroll
            for (int b = 0; b < 2; ++b)
#pragma unroll
                for (int m = 0; m < 4; ++m)
#pragma unroll
                    for (int n = 0; n < 2; ++n) acc[a][b][m][n] = (acc_t)(0);
        cur = nxt; cA = nA; cB = nB; ++ui;
    }
    PG8_WAIT_V(0);
    if (wr == 0) PG8_BAR;
    PG8_BAR;
    if constexpr (Epi::AFTER_DRAIN) { E.fused(acc, cur, wr, wc, fr, fq, lds, wid, lane); S.done(cur); }
#undef PG8_SA
#undef PG8_SB
#undef PG8_STAGE
#undef PG8_LDA
#undef PG8_LDB
#undef PG8_MMA
#undef PG8_WAIT_V
#undef PG8_WAIT_L
#undef PG8_BAR
#undef PG8_SCHED
}
}

__device__ void phase_gemm_z(const Params& p, char* lds) {
    pg8::StaticOrder S; S.init(T_TOK, D_IN, gridDim.x, blockIdx.x);
    pg8::gemm_phase<pg8::EpiZ8, pg8::StaticOrder>((PG8_LAS unsigned char*)lds, pg8::Gemm{(const bf16_t*)p.xq, (const bf16_t*)p.winT8, T_TOK, D_IN, D_MODEL / 2}, S, pg8::EpiZ8{p.zb, p.rstd1, p.swb});
}
__device__ void phase_gemm_out(const Params& p, char* lds) {
    pg8::StaticOrder S; S.init(T_TOK, D_MODEL, gridDim.x, blockIdx.x);
    pg8::gemm_phase<pg8::EpiOut, pg8::StaticOrder>((PG8_LAS unsigned char*)lds, pg8::Gemm{p.cB, p.woutT, T_TOK, D_MODEL, D_MODEL}, S, pg8::EpiOut{p.hb, p.xq, p.sx});
}
__device__ void phase_gemm_q(const Params& p, char* lds) {
    pg8::StaticOrder S; S.init(T_TOK, 2048, gridDim.x, blockIdx.x);
    pg8::Unit u;
    for (int i = 0; S.next(i, u); ++i)
        pg8::gemm_phase<pg8::EpiQTopk, pg8::OneUnit>((PG8_LAS unsigned char*)lds, pg8::Gemm{p.hb, p.wqT, T_TOK, 2048, D_MODEL}, pg8::OneUnit{u}, pg8::EpiQTopk{p.keysB, p.idx, p.gate});
}

#define XB_TMO      128
#define XB_XCNT(j)  (256  + 64 * (j))
#define XB_XSUB(j)  (1280 + 64 * (j))
#define XB_XGEN(j)  (2304 + 64 * (j))
#define XB_TOP      3328
#define XB_TOPGEN   3392
#define XCD_BAR_WORDS 3456
#define XB_SPIN_CAP (1u << 20)
__device__ __forceinline__ unsigned xb_ld(unsigned* p)              { return __hip_atomic_load(p, __ATOMIC_RELAXED, __HIP_MEMORY_SCOPE_AGENT); }
__device__ __forceinline__ unsigned xb_add(unsigned* p, unsigned v) { return __hip_atomic_fetch_add(p, v, __ATOMIC_RELAXED, __HIP_MEMORY_SCOPE_AGENT); }
__device__ __forceinline__ unsigned xb_xcc_id() { return (unsigned)__builtin_amdgcn_s_getreg((3 << 11) | 20) & 0xFu; }
#define XB_SPIN(cond, bar) do { unsigned _sp = 0; while (cond) { __builtin_amdgcn_s_sleep(1); \
    if ((++_sp & 255u) == 0u) { if (xb_ld(&(bar)[XB_TMO])) break; if (_sp > XB_SPIN_CAP) { atomicAdd(&(bar)[XB_TMO], 1u); break; } } } } while (0)
struct XcdBarrier { unsigned* bar; unsigned x; volatile LAS unsigned* st; };
__device__ __forceinline__ XcdBarrier xcd_barrier_post(unsigned* bar, volatile LAS unsigned* st) {
    XcdBarrier b; b.bar = bar; b.x = xb_xcc_id(); b.st = st;
    if (threadIdx.x == 0) (void)xb_add(&bar[XB_XCNT(b.x)], 1u);
    return b;
}
__device__ __forceinline__ void xcd_barrier_complete(unsigned* bar, unsigned x, unsigned& nloc, unsigned& nx) {
    const unsigned G = gridDim.x * gridDim.y * gridDim.z;
    unsigned sum, cnt, mine, sp = 0u;
    for (;;) {
        sum = 0u; cnt = 0u; mine = 0u;
#pragma unroll
        for (unsigned j = 0; j < 16; ++j) { const unsigned c = xb_ld(&bar[XB_XCNT(j)]); sum += c; cnt += (c > 0u) ? 1u : 0u; mine = (j == x) ? c : mine; }
        if (sum == G) break;
        __builtin_amdgcn_s_sleep(1);
        if ((++sp & 255u) == 0u) { if (xb_ld(&bar[XB_TMO])) break; if (sp > XB_SPIN_CAP) { atomicAdd(&bar[XB_TMO], 1u); break; } }
    }
    nloc = mine > 0u ? mine : 1u; nx = cnt > 0u ? cnt : 1u;
}
__device__ __forceinline__ void xcd_barrier(const XcdBarrier& b) {
    asm volatile("s_waitcnt vmcnt(0)" ::: "memory");
    __syncthreads();
    if (threadIdx.x == 0) {
        unsigned* bar = b.bar;
        __builtin_amdgcn_s_waitcnt(0);
        unsigned nloc = b.st[0], nx = b.st[1];
        if (nloc == 0u) { xcd_barrier_complete(bar, b.x, nloc, nx); b.st[0] = nloc; b.st[1] = nx; }
        const unsigned old = xb_add(&bar[XB_XSUB(b.x)], 1u);
        const unsigned gen = old / nloc;
        if (old + 1u == (gen + 1u) * nloc) {
            __builtin_amdgcn_fence(__ATOMIC_RELEASE, "agent");
            asm volatile("s_waitcnt vmcnt(0)" ::: "memory");
            const unsigned og = xb_add(&bar[XB_TOP], 1u);
            const unsigned tg = og / nx;
            if (og + 1u == (tg + 1u) * nx) xb_add(&bar[XB_TOPGEN], 1u);
            else XB_SPIN(xb_ld(&bar[XB_TOPGEN]) == tg, bar);
            __builtin_amdgcn_fence(__ATOMIC_ACQUIRE, "agent");
            xb_add(&bar[XB_XGEN(b.x)], 1u);
            asm volatile("s_waitcnt vmcnt(0)" ::: "memory");
        } else {
            XB_SPIN(xb_ld(&bar[XB_XGEN(b.x)]) == gen, bar);
            __builtin_amdgcn_fence(__ATOMIC_ACQUIRE, "agent");
            asm volatile("s_waitcnt vmcnt(0)" ::: "memory");
        }
    }
    __syncthreads();
}

#define MEGA_LDS_MAX2(a, b) ((a) > (b) ? (a) : (b))
#define MEGA_LDS_MAIN MEGA_LDS_MAX2(MEGA_LDS_MAX2(QT_LDS_BYTES, pg8::STAGE_BYTES), MEGA_LDS_MAX2(8 * TS_WBYTES, 2 * MIXH_LDS))
#define MEGA_LDS_BYTES (MEGA_LDS_MAIN + 16)
extern __shared__ __attribute__((aligned(16))) char smem[];
__global__ void __launch_bounds__(512, 2) fwd_mega(Params p) {
    volatile LAS unsigned* st = (volatile LAS unsigned*)(smem + MEGA_LDS_MAIN);
    if (threadIdx.x < 4) st[threadIdx.x] = 0u;
    __syncthreads();
    const XcdBarrier xb = xcd_barrier_post(p.bar, st);
    phase_prep(p, smem);      xcd_barrier(xb);
    phase_gemm_z(p, smem);    xcd_barrier(xb);
    phase_mix_gemm(p, smem);  xcd_barrier(xb);
    phase_gemm_out(p, smem);  xcd_barrier(xb);
    phase_gemm_q(p, smem);    xcd_barrier(xb);
    phase_peer_dots(p, smem); xcd_barrier(xb);
    phase_gather(p, smem);
}

extern "C" void kernel_launch(void* const* d_in, const int* in_sizes, int n_in, void* d_out, int out_size, void* d_ws, size_t ws_size, hipStream_t stream) {
    static int grid_blocks = 0;
    if (grid_blocks == 0) {
        int dev = 0, cus = 0, per_cu = 0;
        (void)hipGetDevice(&dev);
        (void)hipDeviceGetAttribute(&cus, hipDeviceAttributeMultiprocessorCount, dev);
        (void)hipFuncSetAttribute((const void*)fwd_mega, hipFuncAttributeMaxDynamicSharedMemorySize, MEGA_LDS_BYTES);
        (void)hipOccupancyMaxActiveBlocksPerMultiprocessor(&per_cu, (const void*)fwd_mega, 512, MEGA_LDS_BYTES);
        if (per_cu > 1) per_cu = 1;
        if (per_cu < 1) per_cu = 1;
        grid_blocks = cus * per_cu;
    }
    Params p{};
    p.x = (const float*)d_in[0]; p.norm1_g = (const float*)d_in[1]; p.w_in = (const float*)d_in[2]; p.pool_w = (const float*)d_in[3];
    p.pool_scale = (const float*)d_in[4]; p.sgu_norm_g = (const float*)d_in[5]; p.sgu_w = (const float*)d_in[6]; p.sgu_b = (const float*)d_in[7];
    p.w_out = (const float*)d_in[8]; p.norm2_g = (const float*)d_in[9]; p.peer_wq = (const float*)d_in[10]; p.peer_keys = (const float*)d_in[11];
    p.peer_u = (const float*)d_in[12]; p.peer_v = (const float*)d_in[13]; p.final_g = (const float*)d_in[14];
    p.out = (float*)d_out;
    char* w = (char*)d_ws; size_t off = 0;
    auto take = [&](size_t bytes) { char* r = w + off; off += (bytes + 255) & ~(size_t)255; return r; };
    const size_t MiB = 1024 * 1024;
    p.u8 = (unsigned char*)take(16 * MiB); p.v8 = (unsigned char*)take(12 * MiB);
    p.suv = (float2*)take(128 * 1024);
    p.winT = (bf16_t*)take(3 * MiB); p.woutT = (bf16_t*)take(2 * MiB); p.wqT = (bf16_t*)take(4 * MiB);
    p.poolT = (bf16_t*)take(128 * 1024); p.wsM = (bf16_t*)take(128 * 1024); p.keysB = (bf16_t*)take(512 * 1024);
    p.bar = (unsigned*)take(XCD_BAR_WORDS * 4 + 2048 * 4); p.swb = p.bar + XCD_BAR_WORDS;
    p.rstd1 = (float*)take(128 * 1024); p.sx = (float*)take(128 * 1024); p.xq = (signed char*)take(32 * MiB); p.winT8 = (signed char*)take(1536 * 1024);
    p.idx = (int*)take(16 * MiB); p.gate = (float*)take(16 * MiB); p.coef = (float*)take(16 * MiB);
    p.xb = (bf16_t*)take(64 * MiB); p.zb = (bf16_t*)take(96 * MiB); p.cB = (bf16_t*)take(64 * MiB); p.hb = (bf16_t*)take(64 * MiB);
    (void)hipMemsetAsync(p.bar, 0, XCD_BAR_WORDS * 4 + 2048 * 4, stream);
    hipLaunchKernelGGL(fwd_mega, dim3(grid_blocks), dim3(512), MEGA_LDS_BYTES, stream, p);
}
```

```cpp
#include <hip/hip_runtime.h>
#include <stdint.h>
#include <type_traits>

typedef unsigned short bf16_t;
typedef short bf16x8 __attribute__((ext_vector_type(8)));
typedef float f32x4 __attribute__((ext_vector_type(4)));
typedef unsigned u32x4 __attribute__((ext_vector_type(4)));
typedef unsigned u32x2 __attribute__((ext_vector_type(2)));
typedef unsigned u32x3 __attribute__((ext_vector_type(3)));
typedef int i32x4 __attribute__((ext_vector_type(4)));
#define ROWB 768
typedef __bf16 bf2_t __attribute__((ext_vector_type(2)));
#define LAS __attribute__((address_space(3)))

#define T_TOK 32768
#define D_MODEL 1024
#define D_IN 1536
#define SEQ 2048
#define NEXP 16384
#define EPS 1e-6f

struct Params {
    const float *x, *norm1_g, *w_in, *pool_w, *pool_scale, *sgu_norm_g, *sgu_w, *sgu_b, *w_out, *norm2_g, *peer_wq, *peer_keys, *peer_u, *peer_v, *final_g;
    float* out;
    bf16_t *winT, *woutT, *wqT, *poolT, *wsM, *keysB;
    unsigned char *u8, *v8;
    float2* suv;
    float *rstd1, *sx;
    signed char *xq, *winT8, *hq, *wqT8; unsigned *swb, *swq; float* hsc;
    bf16_t *xb, *zb, *cB, *hb;
    int* idx; float* gate; float* coef;
    unsigned* bar;
};

__device__ __forceinline__ int tid_opaque() { int t = (int)threadIdx.x; asm volatile("" : "+v"(t)); return t; }
__device__ __forceinline__ unsigned short f2bf(float f) {
    unsigned u = __float_as_uint(f);
    u += 0x7fffu + ((u >> 16) & 1u);
    return (unsigned short)(u >> 16);
}
__device__ __forceinline__ float bf2f(unsigned short h) { return __uint_as_float(((unsigned)h) << 16); }
__device__ __forceinline__ unsigned pack2(float a, float b) { return (unsigned)f2bf(a) | ((unsigned)f2bf(b) << 16); }
__device__ __forceinline__ float bflo(unsigned w) { return __uint_as_float(w << 16); }
__device__ __forceinline__ float bfhi(unsigned w) { return __uint_as_float(w & 0xffff0000u); }
__device__ __forceinline__ float gelu_t(float x) {
    const float y = 1.5957691216057308f * (x + 0.044715f * x * x * x);
    return x * __builtin_amdgcn_rcpf(1.0f + __expf(-y));
}
__device__ __forceinline__ float wave_sum(float v) {
#pragma unroll
    for (int o = 32; o >= 1; o >>= 1) v += __shfl_xor(v, o);
    return v;
}
__device__ __forceinline__ float wave_max(float v) {
#pragma unroll
    for (int o = 32; o >= 1; o >>= 1) v = fmaxf(v, __shfl_xor(v, o));
    return v;
}

#define GEMM_LDS_BYTES (2 * 128 * 144)
__device__ __forceinline__ void transpose_tile(const int tid, const float* __restrict__ src, bf16_t* __restrict__ dst, int R, int C, const float* __restrict__ rscale, int tile, float* lds) {
    const int tilesC = C / 64, tr = tile / tilesC, tc = tile % tilesC;
    const int ty = tid >> 6, tx = tid & 63;
    __syncthreads();
#pragma unroll
    for (int i = 0; i < 16; ++i) {
        const int r = ty + 4 * i;
        float v = src[(size_t)(tr * 64 + r) * C + tc * 64 + tx];
        if (rscale) v *= rscale[tr * 64 + r];
        lds[r * 65 + tx] = v;
    }
    __syncthreads();
#pragma unroll
    for (int i = 0; i < 16; ++i) {
        const int c = ty + 4 * i;
        dst[(size_t)(tc * 64 + c) * R + tr * 64 + tx] = f2bf(lds[tx * 65 + c]);
    }
}

__device__ __forceinline__ void w8_colmax(const float* __restrict__ src, const float* __restrict__ gain, int C, unsigned* mx, unsigned* cnt, int hb2, int nh, int ht) {
    const int ncb = C / 64;
    for (int t = hb2; t < 16 * ncb; t += nh) {
        const int tr = t / ncb, tc = t % ncb, ty = ht >> 6, tx = ht & 63;
        float am = 0.f;
#pragma unroll
        for (int i = 0; i < 16; ++i) { const int r = tr * 64 + ty + 4 * i; am = fmaxf(am, fabsf(src[(size_t)r * C + tc * 64 + tx] * gain[r])); }
        (void)__hip_atomic_fetch_max(mx + tc * 64 + tx, __float_as_uint(am), __ATOMIC_RELAXED, __HIP_MEMORY_SCOPE_AGENT);
        asm volatile("s_waitcnt vmcnt(0)" ::: "memory");
        __syncthreads();
        if (ht == 0) (void)__hip_atomic_fetch_add(cnt + tc, 1u, __ATOMIC_RELAXED, __HIP_MEMORY_SCOPE_AGENT);
    }
}
__device__ __forceinline__ void w8_tiles(const float* __restrict__ src, const float* __restrict__ gain, int C, signed char* __restrict__ dst, unsigned* mx, unsigned* cnt, char* lds, int tid) {
    const int half = tid >> 8, ht = tid & 255, ty = ht >> 6, tx = ht & 63, ncb = C / 64;
    float* fl = (float*)(lds + half * (64 * 65 * 4));
    for (int t = 2 * blockIdx.x + half; t < 16 * ncb; t += 2 * gridDim.x) {
        const int tr = t / ncb, tc = t % ncb;
        if (ht == 0) {
            unsigned spins = 0;
            while (__hip_atomic_load(cnt + tc, __ATOMIC_RELAXED, __HIP_MEMORY_SCOPE_AGENT) < 16u && ++spins < (1u << 22)) __builtin_amdgcn_s_sleep(2);
        }
        __syncthreads();
#pragma unroll
        for (int i = 0; i < 16; ++i) { const int r = ty + 4 * i; fl[r * 65 + tx] = src[(size_t)(tr * 64 + r) * C + tc * 64 + tx] * gain[tr * 64 + r]; }
        __syncthreads();
#pragma unroll
        for (int i = 0; i < 16; ++i) {
            const int c = ty + 4 * i;
            const float am = __uint_as_float(__hip_atomic_load(mx + tc * 64 + c, __ATOMIC_RELAXED, __HIP_MEMORY_SCOPE_AGENT));
            const float inv = am > 0.f ? 127.0f / am : 0.f;
            dst[(size_t)(tc * 64 + c) * 1024 + tr * 64 + tx] = (signed char)(int)rintf(fl[tx * 65 + c] * inv);
        }
    }
}

__device__ void phase_prep(const Params& p, char* lds) {
    const int tidx_ = tid_opaque();
    const int nb = gridDim.x, b = blockIdx.x, tid = tidx_;
    const int half = tid >> 8, ht = tid & 255, nh = 2 * nb, hb2 = 2 * b + half;
    float* fl = (float*)(lds + half * (64 * 65 * 4));
    w8_colmax(p.w_in, p.norm1_g, 1536, p.swb, p.swb + 1536, hb2, nh, ht);
    w8_colmax(p.peer_wq, p.norm2_g, 2048, p.swq, p.swq + 2048, hb2, nh, ht);
    for (int t = hb2; t < 16 * 16; t += nh) transpose_tile(ht, p.w_out, p.woutT, 1024, 1024, nullptr, t, fl);
    for (int t = hb2; t < 16; t += nh) transpose_tile(ht, p.pool_w + (size_t)(t >> 2) * 16384, p.poolT + (size_t)(t >> 2) * 16384, 128, 128, nullptr, t & 3, fl);
    const size_t gtid = (size_t)b * blockDim.x + tid, gsz = (size_t)nb * blockDim.x;
    for (size_t i = gtid; i < 4 * 128 * 128; i += gsz) {
        const int j = (int)(i & 127), ii = (int)((i >> 7) & 127);
        const bool keep = (j >> 6) <= (ii >> 6);
        p.wsM[i] = keep ? f2bf(p.sgu_w[i]) : (bf16_t)0;
    }
    for (size_t o = gtid; o < 2 * 8 * 128 * 128; o += gsz) {
        const int j = (int)(o & 7), ln = (int)((o >> 3) & 63), nb = (int)((o >> 9) & 7), kk = (int)((o >> 12) & 3), ph = (int)(o >> 14);
        p.keysB[o] = f2bf(p.peer_keys[(size_t)ph * 16384 + (size_t)(16 * nb + (ln & 15)) * 128 + 32 * kk + 8 * (ln >> 4) + j]);
    }
    {
        const int wave = (b * blockDim.x + tid) >> 6, nwaves = (nb * blockDim.x) >> 6, lane = tid & 63;
        float g16[16];
#pragma unroll
        for (int i = 0; i < 4; ++i) { const float4 g = ((const float4*)(p.norm2_g + lane * 16))[i]; g16[4 * i] = g.x; g16[4 * i + 1] = g.y; g16[4 * i + 2] = g.z; g16[4 * i + 3] = g.w; }
        auto quant_row = [&](const float (&f)[16], unsigned char* dst, float* scale_out) {
            float am = 0.f;
#pragma unroll
            for (int j = 0; j < 16; ++j) am = fmaxf(am, fabsf(f[j]));
            am = wave_max(am);
            const float inv = am > 0.f ? 31.0f / am : 0.f;
            int q[16];
#pragma unroll
            for (int j = 0; j < 16; ++j) q[j] = (int)rintf(f[j] * inv) + 32;
            u32x3 o;
#pragma unroll
            for (int i = 0; i < 3; ++i) {
                unsigned w = 0;
#pragma unroll
                for (int k = 0; k < 4; ++k) w |= (unsigned)(q[4 * i + k] | (((q[12 + k] >> (2 * i)) & 3) << 6)) << (8 * k);
                o[i] = w;
            }
            *(u32x3*)(dst + lane * 12) = o;
            if (lane == 0) *scale_out = am * (1.0f / 31.0f);
        };
        for (int e = wave; e < NEXP; e += nwaves) {
            const float4* su4 = (const float4*)(p.peer_u + (size_t)e * D_MODEL + lane * 16);
            const float4* sv4 = (const float4*)(p.peer_v + (size_t)e * D_MODEL + lane * 16);
            float4 a4[4], b4[4];
#pragma unroll
            for (int i = 0; i < 4; ++i) { a4[i] = su4[i]; b4[i] = sv4[i]; }
            float fu[16], fv[16];
#pragma unroll
            for (int i = 0; i < 4; ++i) {
                fu[4 * i] = a4[i].x * g16[4 * i]; fu[4 * i + 1] = a4[i].y * g16[4 * i + 1]; fu[4 * i + 2] = a4[i].z * g16[4 * i + 2]; fu[4 * i + 3] = a4[i].w * g16[4 * i + 3];
                fv[4 * i] = b4[i].x; fv[4 * i + 1] = b4[i].y; fv[4 * i + 2] = b4[i].z; fv[4 * i + 3] = b4[i].w;
            }
            {
                float am = 0.f;
#pragma unroll
                for (int j = 0; j < 16; ++j) am = fmaxf(am, fabsf(fu[j]));
                am = wave_max(am);
                const float inv = am > 0.f ? 127.0f / am : 0.f;
                u32x4 o;
#pragma unroll
                for (int i = 0; i < 4; ++i) {
                    unsigned w = 0;
#pragma unroll
                    for (int k = 0; k < 4; ++k) w |= (unsigned)(((int)rintf(fu[4 * i + k] * inv)) & 0xff) << (8 * k);
                    o[i] = w;
                }
                *(u32x4*)(p.u8 + (size_t)e * D_MODEL + lane * 16) = o;
                if (lane == 0) p.suv[e].x = am * (1.0f / 127.0f);
            }
            quant_row(fv, p.v8 + (size_t)e * ROWB, &p.suv[e].y);
        }
    }
    const int wave = (b * blockDim.x + tid) >> 6, nwaves = (nb * blockDim.x) >> 6, lane = tid & 63;
    for (int t = wave; t < T_TOK; t += 2 * nwaves) {
        const int t1 = t + nwaves; const bool two = t1 < T_TOK;
        const float4* xr0 = (const float4*)(p.x + (size_t)t * D_MODEL);
        const float4* xr1 = (const float4*)(p.x + (size_t)(two ? t1 : t) * D_MODEL);
        float4 v0[4], v1[4];
#pragma unroll
        for (int i = 0; i < 4; ++i) { v0[i] = xr0[lane + 64 * i]; v1[i] = xr1[lane + 64 * i]; }
        float s0 = 0.f, s1 = 0.f, a0 = 0.f, a1 = 0.f;
#pragma unroll
        for (int i = 0; i < 4; ++i) {
            s0 += v0[i].x * v0[i].x + v0[i].y * v0[i].y + v0[i].z * v0[i].z + v0[i].w * v0[i].w;
            s1 += v1[i].x * v1[i].x + v1[i].y * v1[i].y + v1[i].z * v1[i].z + v1[i].w * v1[i].w;
            a0 = fmaxf(fmaxf(a0, fmaxf(fabsf(v0[i].x), fabsf(v0[i].y))), fmaxf(fabsf(v0[i].z), fabsf(v0[i].w)));
            a1 = fmaxf(fmaxf(a1, fmaxf(fabsf(v1[i].x), fabsf(v1[i].y))), fmaxf(fabsf(v1[i].z), fabsf(v1[i].w)));
        }
        s0 = wave_sum(s0); s1 = wave_sum(s1); a0 = wave_max(a0); a1 = wave_max(a1);
        const float i0 = a0 > 0.f ? 127.0f / a0 : 0.f, i1 = a1 > 0.f ? 127.0f / a1 : 0.f;
#pragma unroll
        for (int i = 0; i < 4; ++i) {
            const unsigned q0 = ((unsigned)((int)rintf(v0[i].x * i0) & 0xff)) | ((unsigned)((int)rintf(v0[i].y * i0) & 0xff) << 8) | ((unsigned)((int)rintf(v0[i].z * i0) & 0xff) << 16) | ((unsigned)((int)rintf(v0[i].w * i0) & 0xff) << 24);
            ((unsigned*)(p.xq + (size_t)t * D_MODEL))[lane + 64 * i] = q0;
            if (two) {
                const unsigned q1 = ((unsigned)((int)rintf(v1[i].x * i1) & 0xff)) | ((unsigned)((int)rintf(v1[i].y * i1) & 0xff) << 8) | ((unsigned)((int)rintf(v1[i].z * i1) & 0xff) << 16) | ((unsigned)((int)rintf(v1[i].w * i1) & 0xff) << 24);
                ((unsigned*)(p.xq + (size_t)t1 * D_MODEL))[lane + 64 * i] = q1;
            }
        }
        if (lane == 0) {
            p.rstd1[t] = rsqrtf(s0 * (1.0f / D_MODEL) + EPS) * a0 * (1.0f / 127.0f); p.sx[t] = a0 * (1.0f / 127.0f);
            if (two) { p.rstd1[t1] = rsqrtf(s1 * (1.0f / D_MODEL) + EPS) * a1 * (1.0f / 127.0f); p.sx[t1] = a1 * (1.0f / 127.0f); }
        }
    }
    w8_tiles(p.w_in, p.norm1_g, 1536, p.winT8, p.swb, p.swb + 1536, lds, tid);
    w8_tiles(p.peer_wq, p.norm2_g, 2048, p.wqT8, p.swq, p.swq + 2048, lds, tid);
}

typedef short s16x4 __attribute__((ext_vector_type(4)));
template <class Epi>
__device__ __forceinline__ void gemm128_sgu(const int tid, const bf16_t* __restrict__ A, const bf16_t* __restrict__ V  ,
                                            const float* __restrict__ lnm, const float* __restrict__ lnr, const float* __restrict__ gch, char* lds, const Epi& epi) {
    const int lane = tid & 63, wid = tid >> 6, wr = wid >> 1, wc = wid & 1, fr = lane & 15, fq = lane >> 4;
    constexpr int PITCH = 144, P2 = 288;
    char* sA = lds; char* sB = lds + 128 * PITCH;
    f32x4 acc[4][4];
#pragma unroll
    for (int m = 0; m < 4; ++m)
#pragma unroll
        for (int n = 0; n < 4; ++n) acc[m][n] = (f32x4){0.f, 0.f, 0.f, 0.f};
    u32x4 ra[4], rb[4]; float rm[4], rr[4];
    const int lrow = tid >> 3, lch = tid & 7;
    const int btok = tid >> 4, bch = tid & 15;
    const bf16_t* ga = A + (size_t)lrow * 128 + lch * 8;
    const bf16_t* gb = V + (size_t)btok * D_IN + bch * 8;
    float g8[8];
    { const float4 g0 = *(const float4*)(gch + bch * 8), g1 = *(const float4*)(gch + bch * 8 + 4); g8[0] = g0.x; g8[1] = g0.y; g8[2] = g0.z; g8[3] = g0.w; g8[4] = g1.x; g8[5] = g1.y; g8[6] = g1.z; g8[7] = g1.w; }
#pragma unroll
    for (int j = 0; j < 4; ++j) { ra[j] = *(const u32x4*)(ga + (size_t)(32 * j) * 128); rb[j] = *(const u32x4*)(gb + (size_t)(16 * j) * D_IN); rm[j] = lnm[btok + 16 * j]; rr[j] = lnr[btok + 16 * j]; }
    for (int k0 = 0; k0 < 128; k0 += 64) {
        __syncthreads();
#pragma unroll
        for (int j = 0; j < 4; ++j) {
            *(u32x4*)(sA + (lrow + 32 * j) * PITCH + lch * 16) = ra[j];
            u32x4 o;
#pragma unroll
            for (int i = 0; i < 4; ++i) {
                const unsigned w = rb[j][i];
                o[i] = pack2((bflo(w) - rm[j]) * rr[j] * g8[2 * i], (bfhi(w) - rm[j]) * rr[j] * g8[2 * i + 1]);
            }
            *(u32x4*)(sB + (btok + 16 * j) * P2 + bch * 16) = o;
        }
        __syncthreads();
        if (k0 + 64 < 128) {
#pragma unroll
            for (int j = 0; j < 4; ++j) { ra[j] = *(const u32x4*)(ga + (size_t)(32 * j) * 128 + 64); rb[j] = *(const u32x4*)(gb + (size_t)(64 + 16 * j) * D_IN); rm[j] = lnm[64 + btok + 16 * j]; rr[j] = lnr[64 + btok + 16 * j]; }
        }
#pragma unroll
        for (int kk = 0; kk < 2; ++kk) {
            bf16x8 af[4], bfr[4];
#pragma unroll
            for (int m = 0; m < 4; ++m) af[m] = *(const bf16x8*)(sA + (wr * 64 + m * 16 + fr) * PITCH + (kk * 32 + fq * 8) * 2);
#pragma unroll
            for (int n = 0; n < 4; ++n) {
                const char* bp = sB + (kk * 32 + fq * 8 + (fr >> 2)) * P2 + (wc * 64 + n * 16 + 4 * (fr & 3)) * 2;
                const s16x4 lo = __builtin_amdgcn_ds_read_tr16_b64_v4i16((LAS s16x4*)(bp));
                const s16x4 hi = __builtin_amdgcn_ds_read_tr16_b64_v4i16((LAS s16x4*)(bp + 4 * P2));
                bfr[n] = (bf16x8){lo[0], lo[1], lo[2], lo[3], hi[0], hi[1], hi[2], hi[3]};
            }
#pragma unroll
            for (int m = 0; m < 4; ++m)
#pragma unroll
                for (int n = 0; n < 4; ++n) acc[m][n] = __builtin_amdgcn_mfma_f32_16x16x32_bf16(bfr[n], af[m], acc[m][n], 0, 0, 0);
        }
    }
#pragma unroll
    for (int m = 0; m < 4; ++m)
#pragma unroll
        for (int n = 0; n < 4; ++n) epi(wr * 64 + m * 16 + fr, wc * 64 + n * 16 + fq * 4, acc[m][n]);
}

#define PT_PITCH 272
#define MIXH_LDS (2 * 128 * PT_PITCH + 1024)
template <int W, class Epi>
__device__ __forceinline__ void pool_tile(const int tid, const bf16_t* __restrict__ zb0  , int pos0,
                                          const bf16_t* __restrict__ Bt, char* lds, const Epi& epi) {
    const int lane = tid & 63, wid = tid >> 6, wr = wid >> 1, wc = wid & 1, fr = lane & 15, fq = lane >> 4;
    char* sA = lds; char* sB = lds + 128 * PT_PITCH;
    __syncthreads();
#pragma unroll
    for (int j = 0; j < 8; ++j) { const int id = tid + 256 * j, row = id >> 4, ch = id & 15; *(u32x4*)(sB + row * PT_PITCH + ch * 16) = *(const u32x4*)(Bt + (size_t)row * 128 + ch * 8); }
    {
        const int seg = tid >> 5, hc = tid & 31, r0 = seg * 16;
        const bool at_start = (pos0 & (SEQ - 1)) == 0;
        const bf16_t* zp = zb0 + hc * 4;
        u32x2 v[W + 16];
#pragma unroll
        for (int i = 0; i < W + 16; ++i) { const int rr = r0 - W + i; const bool ok = !(at_start && rr < 0); v[i] = *(const u32x2*)(zp + (ptrdiff_t)(ok ? rr : 0) * D_IN); }
        float sm[4] = {0.f, 0.f, 0.f, 0.f};
#pragma unroll
        for (int i = 1; i <= W; ++i) {
            const float m = (at_start && (r0 - W + i) < 0) ? 0.f : 1.f;
            sm[0] += m * bflo(v[i].x); sm[1] += m * bfhi(v[i].x); sm[2] += m * bflo(v[i].y); sm[3] += m * bfhi(v[i].y);
        }
#pragma unroll
        for (int o = 0; o < 16; ++o) {
            if (o > 0) {
                const float md = (at_start && (r0 + o - W) < 0) ? 0.f : 1.f;
                sm[0] += bflo(v[W + o].x) - md * bflo(v[o].x); sm[1] += bfhi(v[W + o].x) - md * bfhi(v[o].x);
                sm[2] += bflo(v[W + o].y) - md * bflo(v[o].y); sm[3] += bfhi(v[W + o].y) - md * bfhi(v[o].y);
            }
            const int pos = (pos0 + r0 + o) & (SEQ - 1);
            const float rn = 1.0f / (float)((pos + 1 < W) ? pos + 1 : W);
            u32x2 ov;
            ov.x = pack2(sm[0] * rn - bflo(v[W + o].x), sm[1] * rn - bfhi(v[W + o].x));
            ov.y = pack2(sm[2] * rn - bflo(v[W + o].y), sm[3] * rn - bfhi(v[W + o].y));
            *(u32x2*)(sA + (r0 + o) * PT_PITCH + hc * 8) = ov;
        }
    }
    __syncthreads();
    f32x4 acc[4][4];
#pragma unroll
    for (int m = 0; m < 4; ++m)
#pragma unroll
        for (int n = 0; n < 4; ++n) acc[m][n] = (f32x4){0.f, 0.f, 0.f, 0.f};
#pragma unroll
    for (int kk = 0; kk < 4; ++kk) {
        bf16x8 af[4], bfr[4];
#pragma unroll
        for (int m = 0; m < 4; ++m) af[m] = *(const bf16x8*)(sA + (wr * 64 + m * 16 + fr) * PT_PITCH + (kk * 32 + fq * 8) * 2);
#pragma unroll
        for (int n = 0; n < 4; ++n) bfr[n] = *(const bf16x8*)(sB + (wc * 64 + n * 16 + fr) * PT_PITCH + (kk * 32 + fq * 8) * 2);
#pragma unroll
        for (int m = 0; m < 4; ++m)
#pragma unroll
            for (int n = 0; n < 4; ++n) acc[m][n] = __builtin_amdgcn_mfma_f32_16x16x32_bf16(bfr[n], af[m], acc[m][n], 0, 0, 0);
    }
#pragma unroll
    for (int m = 0; m < 4; ++m)
#pragma unroll
        for (int n = 0; n < 4; ++n) epi(wr * 64 + m * 16 + fr, wc * 64 + n * 16 + fq * 4, acc[m][n]);
}

__device__ void phase_mix_gemm(const Params& p, char* lds) {
    const int tidx_ = tid_opaque();
    const int npool = (T_TOK / 128) * 4, nsgu = (T_TOK / 128) * 4;
    const int half = tidx_ >> 8, ht = tidx_ & 255; lds += half * MIXH_LDS;
    for (int tile = 2 * blockIdx.x + half; tile < npool + nsgu; tile += 2 * gridDim.x) {
        if (tile < npool) {
            const int tm = tile >> 2, g = tile & 3;
            const float* ps = p.pool_scale + g * 128; bf16_t* co = p.cB + (size_t)tm * 128 * D_MODEL + g * 128;
            const bf16_t* z0 = p.zb + (size_t)tm * 128 * D_IN + g * 128; const bf16_t* bt = p.poolT + (size_t)g * 16384;
            auto epi = [&](int r, int c, f32x4 v) {
                const float4 sc = *(const float4*)(ps + c);
                uint2 o; o.x = pack2(v[0] * sc.x, v[1] * sc.y); o.y = pack2(v[2] * sc.z, v[3] * sc.w);
                *(uint2*)(co + (size_t)r * D_MODEL + c) = o;
            };
            if (g == 0) pool_tile<2>(ht, z0, tm * 128, bt, lds, epi); else if (g == 1) pool_tile<4>(ht, z0, tm * 128, bt, lds, epi);
            else if (g == 2) pool_tile<8>(ht, z0, tm * 128, bt, lds, epi); else pool_tile<16>(ht, z0, tm * 128, bt, lds, epi);
        } else {
            const int t2 = tile - npool, blk = t2 >> 2, h = t2 & 3;
            float* stm = (float*)(lds + GEMM_LDS_BYTES); float* str = stm + 128;
            __syncthreads();
            {
                const int tok = ht >> 1, hh = ht & 1;
                const u32x4* vp = (const u32x4*)(p.zb + (size_t)(blk * 128 + tok) * D_IN + 1024 + hh * 256);
                float s1 = 0.f, s2 = 0.f;
#pragma unroll 8
                for (int i = 0; i < 32; ++i) {
                    const u32x4 v = vp[i];
#pragma unroll
                    for (int k = 0; k < 4; ++k) { const float a = bflo(v[k]), c = bfhi(v[k]); s1 += a + c; s2 += a * a + c * c; }
                }
                s1 += __shfl_xor(s1, 1); s2 += __shfl_xor(s2, 1);
                const float mean = s1 * (1.0f / 512.0f), var = fmaxf(s2 * (1.0f / 512.0f) - mean * mean, 0.f);
                if (hh == 0) { stm[tok] = mean; str[tok] = rsqrtf(var + EPS); }
            }
            __syncthreads();
            const float* sb = p.sgu_b + h * 128; const bf16_t* uo = p.zb + (size_t)blk * 128 * D_IN + 512 + h * 128;
            bf16_t* co = p.cB + (size_t)blk * 128 * D_MODEL + 512 + h * 128;
            gemm128_sgu(ht, p.wsM + (size_t)h * 16384, p.zb + (size_t)blk * 128 * D_IN + 1024 + h * 128, stm, str, p.sgu_norm_g + h * 128, lds,
                    [&](int r, int c, f32x4 v) {
                        const float bb = sb[r];
                        const uint2 uu = *(const uint2*)(uo + (size_t)r * D_IN + c);
                        uint2 o;
                        o.x = pack2((v[0] + bb) * bflo(uu.x), (v[1] + bb) * bfhi(uu.x));
                        o.y = pack2((v[2] + bb) * bflo(uu.y), (v[3] + bb) * bfhi(uu.y));
                        *(uint2*)(co + (size_t)r * D_MODEL + c) = o;
                    });
        }
    }
}

__device__ __forceinline__ int wave_sum_i_uniform(int s) {
    s += __builtin_amdgcn_update_dpp(0, s, 0xB1, 0xf, 0xf, false);
    s += __builtin_amdgcn_update_dpp(0, s, 0x4E, 0xf, 0xf, false);
    s += __builtin_amdgcn_update_dpp(0, s, 0x141, 0xf, 0xf, false);
    s += __builtin_amdgcn_update_dpp(0, s, 0x140, 0xf, 0xf, false);
    return __builtin_amdgcn_readlane(s, 0) + __builtin_amdgcn_readlane(s, 16) + __builtin_amdgcn_readlane(s, 32) + __builtin_amdgcn_readlane(s, 48);
}
__constant__ unsigned char kComb[64] = {
    0x00,0x01,0x02,0x03,0x04,0x05,0x06,0x07,0x08,0x09,0x0a,0x0b,0x0c,0x0d,0x0e,0x0f,
    0x10,0x11,0x12,0x13,0x14,0x15,0x16,0x17,
    0x20,0x21,0x22,0x23,0x24,
    0x30,0x31,0x32,0x33,
    0x40,0x41,0x42,
    0x50,0x51,
    0x60,0x61,
    0x70,0x71,
    0x80,0x90,0xa0,0xb0,0xc0,0xd0,0xe0,0xf0,
    0xff,0xff,0xff,0xff,0xff,0xff,0xff,0xff,0xff,0xff,0xff,0xff,0xff,0xff};

template <int CTRL> __device__ __forceinline__ int dpp_i(int v) { return __builtin_amdgcn_update_dpp(0, v, CTRL, 0xf, 0xf, false); }
__device__ __forceinline__ int row_allmax_i(int v) {
    v = max(v, dpp_i<0x128>(v)); v = max(v, dpp_i<0x124>(v)); v = max(v, dpp_i<0x122>(v)); v = max(v, dpp_i<0x121>(v));
    return v;
}
__device__ __forceinline__ float row_allsum_f(float v) {
    v += __int_as_float(dpp_i<0x128>(__float_as_int(v))); v += __int_as_float(dpp_i<0x124>(__float_as_int(v)));
    v += __int_as_float(dpp_i<0x122>(__float_as_int(v))); v += __int_as_float(dpp_i<0x121>(__float_as_int(v)));
    return v;
}
__device__ __forceinline__ int f2key(float f) { const int b = __float_as_int(f); return b ^ ((b >> 31) & 0x7fffffff); }
__device__ __forceinline__ float key2f(int k) { return __int_as_float(k ^ ((k >> 31) & 0x7fffffff)); }
#define KEY_MIN ((int)0x80000000)
#define CE(a, b) { const int hi_ = max(a, b), lo_ = min(a, b); a = hi_; b = lo_; }
__device__ __forceinline__ int top16_rows(int (&k)[8], int l15) {
    CE(k[0], k[1]) CE(k[2], k[3]) CE(k[4], k[5]) CE(k[6], k[7])
    CE(k[0], k[2]) CE(k[1], k[3]) CE(k[4], k[6]) CE(k[5], k[7])
    CE(k[1], k[2]) CE(k[5], k[6])
    CE(k[0], k[4]) CE(k[1], k[5]) CE(k[2], k[6]) CE(k[3], k[7])
    CE(k[2], k[4]) CE(k[3], k[5])
    CE(k[1], k[2]) CE(k[3], k[4]) CE(k[5], k[6])
    int res = KEY_MIN;
#pragma unroll
    for (int r = 0; r < 16; ++r) {
        const int m = row_allmax_i(k[0]);
        const bool own = (k[0] == m);
#pragma unroll
        for (int j = 0; j < 7; ++j) k[j] = own ? k[j + 1] : k[j];
        k[7] = own ? KEY_MIN : k[7];
        res = (l15 == r) ? m : res;
    }
    return res;
}
__device__ __forceinline__ void combine16(int A, int B, const int (&cbv)[4], int lane, int l15, int& eid_out, float& gate_out) {
    const int rowbase = lane & 48;
    int ck[4], eid[4];
#pragma unroll
    for (int c = 0; c < 4; ++c) {
        const int ci = (cbv[c] >> 4) & 15, cj = cbv[c] & 15;
        const int ka = __builtin_amdgcn_ds_bpermute((rowbase + ci) << 2, A);
        const int kb = __builtin_amdgcn_ds_bpermute((rowbase + cj) << 2, B);
        const float sm = key2f(ka & ~127) + key2f(kb & ~127);
        eid[c] = ((127 - (ka & 127)) << 7) | (127 - (kb & 127));
        ck[c] = (cbv[c] != 0xff) ? ((f2key(sm) & ~63) | (63 - (4 * l15 + c))) : KEY_MIN;
    }
    CE(ck[0], ck[1]) CE(ck[2], ck[3]) CE(ck[0], ck[2]) CE(ck[1], ck[3]) CE(ck[1], ck[2])
    int res = KEY_MIN;
#pragma unroll
    for (int r = 0; r < 16; ++r) {
        const int m = row_allmax_i(ck[0]);
        const bool own = (ck[0] == m);
        ck[0] = own ? ck[1] : ck[0]; ck[1] = own ? ck[2] : ck[1]; ck[2] = own ? ck[3] : ck[2]; ck[3] = own ? KEY_MIN : ck[3];
        res = (l15 == r) ? m : res;
    }
    const int slot = 63 - (res & 63);
    const int src = (rowbase + (slot >> 2)) << 2;
    const int e0 = __builtin_amdgcn_ds_bpermute(src, eid[0]), e1 = __builtin_amdgcn_ds_bpermute(src, eid[1]);
    const int e2 = __builtin_amdgcn_ds_bpermute(src, eid[2]), e3 = __builtin_amdgcn_ds_bpermute(src, eid[3]);
    const int sel = slot & 3;
    eid_out = sel == 0 ? e0 : (sel == 1 ? e1 : (sel == 2 ? e2 : e3));
    gate_out = key2f(res & ~63);
}

__device__ __forceinline__ int reduce16_rows(const int (&part)[16], bool b3, bool b2, bool b1, bool b0b) {
    int r8[8], r4[4], r2[2];
#pragma unroll
    for (int k = 0; k < 8; ++k) { const int keep = b3 ? part[8 + k] : part[k], send = b3 ? part[k] : part[8 + k]; r8[k] = keep + __builtin_amdgcn_update_dpp(0, send, 0x140, 0xf, 0xf, false); }
#pragma unroll
    for (int k = 0; k < 4; ++k) { const int keep = b2 ? r8[4 + k] : r8[k], send = b2 ? r8[k] : r8[4 + k]; r4[k] = keep + __builtin_amdgcn_update_dpp(0, send, 0x141, 0xf, 0xf, false); }
#pragma unroll
    for (int k = 0; k < 2; ++k) { const int keep = b1 ? r4[2 + k] : r4[k], send = b1 ? r4[k] : r4[2 + k]; r2[k] = keep + __builtin_amdgcn_update_dpp(0, send, 0x4E, 0xf, 0xf, false); }
    const int keep = b0b ? r2[1] : r2[0], send = b0b ? r2[0] : r2[1];
    int r1 = keep + __builtin_amdgcn_update_dpp(0, send, 0xB1, 0xf, 0xf, false);
    r1 += __shfl_xor(r1, 16); r1 += __shfl_xor(r1, 32);
    return r1;
}
__device__ void phase_hquant(const Params& p, char* lds) {
    const int tid = tid_opaque();
    const int wave = __builtin_amdgcn_readfirstlane((int)((blockIdx.x * blockDim.x + tid) >> 6)), nwaves = (gridDim.x * blockDim.x) >> 6, lane = tid & 63;
    for (int t = wave; t < T_TOK; t += 2 * nwaves) {
        const int t1 = t + nwaves; const bool two = t1 < T_TOK;
        const u32x4* h0 = (const u32x4*)(p.hb + (size_t)t * D_MODEL); const u32x4* h1 = (const u32x4*)(p.hb + (size_t)(two ? t1 : t) * D_MODEL);
        u32x4 r[2][2] = {{h0[2 * lane], h0[2 * lane + 1]}, {h1[2 * lane], h1[2 * lane + 1]}};
#pragma unroll
        for (int q = 0; q < 2; ++q) {
            const u32x4 a = r[q][0], c = r[q][1];
            const float f[16] = {bflo(a.x), bfhi(a.x), bflo(a.y), bfhi(a.y), bflo(a.z), bfhi(a.z), bflo(a.w), bfhi(a.w),
                                 bflo(c.x), bfhi(c.x), bflo(c.y), bfhi(c.y), bflo(c.z), bfhi(c.z), bflo(c.w), bfhi(c.w)};
            float ss = 0.f, am = 0.f;
#pragma unroll
            for (int k = 0; k < 16; ++k) { ss += f[k] * f[k]; am = fmaxf(am, fabsf(f[k])); }
            ss = wave_sum(ss); am = wave_max(am);
            const float inv = am > 0.f ? 127.0f / am : 0.f;
            u32x4 o;
#pragma unroll
            for (int i = 0; i < 4; ++i) {
                unsigned w = 0;
#pragma unroll
                for (int k = 0; k < 4; ++k) w |= (unsigned)((int)rintf(f[4 * i + k] * inv) & 0xff) << (8 * k);
                o[i] = w;
            }
            const int tt = q ? t1 : t;
            if (q == 0 || two) {
                ((u32x4*)(p.hq + (size_t)tt * D_MODEL))[lane] = o;
                if (lane == 0) p.hsc[tt] = am * (1.0f / 127.0f) * rsqrtf(ss * (1.0f / D_MODEL) + EPS);
            }
        }
    }
}

#define TS_WBYTES (16384 + 128)
__device__ void phase_peer_dots(const Params& p, char* lds) {
    const int tidx_ = tid_opaque();
    const int lane = tidx_ & 63, wid = __builtin_amdgcn_readfirstlane((int)(tidx_ >> 6)), l15 = lane & 15;
    const bool b3 = (lane & 8) != 0, b2 = (lane & 4) != 0, b1 = (lane & 2) != 0, b0b = (lane & 1) != 0;
    const int gw = blockIdx.x * (blockDim.x >> 6) + wid, ngw = gridDim.x * (blockDim.x >> 6);
    char* wl = lds + wid * TS_WBYTES;
    unsigned* list = (unsigned*)wl; int* dotsl = (int*)(wl + 4096); char* hql = wl + 8192; int* tks = (int*)(wl + 16384);
    const unsigned lane16 = (unsigned)lane * 16u;
    for (int tb = gw * 8; tb < T_TOK; tb += ngw * 8) {
#pragma unroll
        for (int j = 0; j < 8; ++j) *(u32x4*)(hql + j * 1024 + lane * 16) = ((const u32x4*)(p.hq + (size_t)(tb + j) * D_MODEL))[lane];
        if (lane < 8) tks[lane] = __float_as_int(p.hsc[tb + lane]);
        int idv[8][2];
#pragma unroll
        for (int j = 0; j < 8; ++j) { const int* ir = p.idx + (size_t)(tb + j) * 128; idv[j][0] = ir[lane]; idv[j][1] = ir[64 + lane]; }
#pragma unroll 1
        for (int x = 0; x < 8; ++x) {
            int n = 0;
#pragma unroll
            for (int j = 0; j < 8; ++j)
#pragma unroll
                for (int r = 0; r < 2; ++r) {
                    const int e = idv[j][r];
                    const bool in = (e >> 11) == x;
                    const unsigned long long mk = __ballot(in);
                    const int rank = (int)__builtin_amdgcn_mbcnt_hi((unsigned)(mk >> 32), __builtin_amdgcn_mbcnt_lo((unsigned)mk, 0u));
                    if (in) list[n + rank] = ((unsigned)j << 21) | ((unsigned)(r * 64 + lane) << 14) | (unsigned)e;
                    n += (int)__builtin_popcountll(mk);
                }
            asm volatile("s_waitcnt lgkmcnt(0)" ::: "memory");
            u32x4 ua[16], ubf[16]; int enta = 0, entb = 0;
            auto issue = [&](int b0, u32x4 (&uu)[16], int& entv) {
                const int i = (b0 + l15 < n) ? b0 + l15 : n - 1;
                entv = (int)list[i];
#pragma unroll
                for (int j = 0; j < 16; ++j) { const int e = __builtin_amdgcn_readlane(entv, j) & 0x3fff; uu[j] = *(const u32x4*)(p.u8 + (size_t)e * D_MODEL + lane16); }
            };
            auto reduce = [&](int b0, const u32x4 (&uu)[16], int entv) {
                int part[16];
#pragma unroll
                for (int j = 0; j < 16; ++j) {
                    const int tl = __builtin_amdgcn_readlane(entv, j) >> 21;
                    const u32x4 hqv = *(const u32x4*)(hql + tl * 1024 + lane * 16);
                    int sacc = __builtin_amdgcn_sdot4((int)uu[j].x, (int)hqv.x, 0, false);
                    sacc = __builtin_amdgcn_sdot4((int)uu[j].y, (int)hqv.y, sacc, false);
                    sacc = __builtin_amdgcn_sdot4((int)uu[j].z, (int)hqv.z, sacc, false);
                    part[j] = __builtin_amdgcn_sdot4((int)uu[j].w, (int)hqv.w, sacc, false);
                }
                const int r1 = reduce16_rows(part, b3, b2, b1, b0b);
                if (lane < 16 && b0 + lane < n) dotsl[((unsigned)entv >> 21) * 128 + (((unsigned)entv >> 14) & 127u)] = r1;
            };
            if (n > 0) issue(0, ua, enta);
            for (int b0 = 0; b0 < n; b0 += 32) {
                if (b0 + 16 < n) issue(b0 + 16, ubf, entb);
                reduce(b0, ua, enta);
                if (b0 + 16 < n) {
                    if (b0 + 32 < n) issue(b0 + 32, ua, enta);
                    reduce(b0 + 16, ubf, entb);
                }
            }
            asm volatile("s_waitcnt lgkmcnt(0)" ::: "memory");
        }
#pragma unroll
        for (int j = 0; j < 8; ++j) {
            const float cs_t = __int_as_float(tks[j]), r2_t = cs_t;
            const float* gr = p.gate + (size_t)(tb + j) * 128; float* cr = p.coef + (size_t)(tb + j) * 128;
#pragma unroll
            for (int r = 0; r < 2; ++r) {
                const int e = idv[j][r];
                const float sc = gr[r * 64 + lane] * r2_t;
                const float ex = __expf(sc - key2f(row_allmax_i(f2key(sc))));
                const float gt = ex / row_allsum_f(ex);
                const float2 sc2 = p.suv[e];
                const float dotf = (float)dotsl[j * 128 + r * 64 + lane] * cs_t * sc2.x;
                cr[r * 64 + lane] = gt * gelu_t(dotf) * sc2.y;
            }
        }
        asm volatile("s_waitcnt lgkmcnt(0)" ::: "memory");
    }
}

__device__ void phase_gather(const Params& p, char* lds) {
    const int tidx_ = tid_opaque();
    const int wave = __builtin_amdgcn_readfirstlane((int)((blockIdx.x * blockDim.x + tidx_) >> 6)), nwaves = (gridDim.x * blockDim.x) >> 6, lane = tidx_ & 63;
    const unsigned char* vb = p.v8 + lane * 12;
    for (int t = wave; t < T_TOK; t += nwaves) {
        int idr[2]; float coef[2];
        { const int* ir = p.idx + (size_t)t * 128; idr[0] = ir[lane]; idr[1] = ir[64 + lane]; }
        { const float* cr = p.coef + (size_t)t * 128; coef[0] = cr[lane]; coef[1] = cr[64 + lane]; }
        const float cmax = wave_max(fmaxf(fabsf(coef[0]), fabsf(coef[1])));
        const float qs = cmax > 0.f ? 127.0f / cmax : 0.f, cscale = cmax * (1.0f / 127.0f);
        const int cq0 = (int)rintf(coef[0] * qs), cq1 = (int)rintf(coef[1] * qs);
        const int csum_i = wave_sum_i_uniform(cq0 + cq1);
        unsigned cpk[2];
        {
            const int cqs[2] = {cq0, cq1};
#pragma unroll
            for (int hf = 0; hf < 2; ++hf) {
                const int bb = cqs[hf] & 0xff;
                cpk[hf] = (unsigned)__builtin_amdgcn_update_dpp(0, bb, 0x00, 0xf, 0xf, false) | ((unsigned)__builtin_amdgcn_update_dpp(0, bb, 0x55, 0xf, 0xf, false) << 8)
                        | ((unsigned)__builtin_amdgcn_update_dpp(0, bb, 0xAA, 0xf, 0xf, false) << 16) | ((unsigned)__builtin_amdgcn_update_dpp(0, bb, 0xFF, 0xf, 0xf, false) << 24);
            }
        }
        int acc[16];
#pragma unroll
        for (int j = 0; j < 16; ++j) acc[j] = 0;
        {
            u32x3 va[8], vbf[8];
            auto issue = [&](int pb, u32x3 (&vv)[8]) {
#pragma unroll
                for (int q = 0; q < 8; ++q) { const int e = __builtin_amdgcn_readlane(pb < 64 ? idr[0] : idr[1], (pb & 63) + q); vv[q] = *(const u32x3*)(vb + (size_t)e * ROWB); }
            };
            auto axpy = [&](int pb, const u32x3 (&vv)[8]) {
#pragma unroll
                for (int g4 = 0; g4 < 2; ++g4) {
                    const int cqd = __builtin_amdgcn_readlane((int)(pb < 64 ? cpk[0] : cpk[1]), (pb & 63) + 4 * g4);
                    unsigned dd[4][4];
#pragma unroll
                    for (int r = 0; r < 4; ++r) {
                        const unsigned w0 = vv[4 * g4 + r].x, w1 = vv[4 * g4 + r].y, w2 = vv[4 * g4 + r].z;
                        dd[r][0] = w0 & 0x3f3f3f3fu; dd[r][1] = w1 & 0x3f3f3f3fu; dd[r][2] = w2 & 0x3f3f3f3fu;
                        dd[r][3] = ((w0 >> 6) & 0x03030303u) | ((w1 >> 4) & 0x0c0c0c0cu) | ((w2 >> 2) & 0x30303030u);
                    }
#pragma unroll
                    for (int k = 0; k < 4; ++k) {
                        const unsigned p0 = __builtin_amdgcn_perm(dd[1][k], dd[0][k], 0x05010400u), p1 = __builtin_amdgcn_perm(dd[1][k], dd[0][k], 0x07030602u);
                        const unsigned q0 = __builtin_amdgcn_perm(dd[3][k], dd[2][k], 0x05010400u), q1 = __builtin_amdgcn_perm(dd[3][k], dd[2][k], 0x07030602u);
                        const unsigned t0 = __builtin_amdgcn_perm(q0, p0, 0x05040100u), t1 = __builtin_amdgcn_perm(q0, p0, 0x07060302u);
                        const unsigned t2 = __builtin_amdgcn_perm(q1, p1, 0x05040100u), t3 = __builtin_amdgcn_perm(q1, p1, 0x07060302u);
                        acc[4 * k + 0] = __builtin_amdgcn_sdot4((int)t0, cqd, acc[4 * k + 0], false);
                        acc[4 * k + 1] = __builtin_amdgcn_sdot4((int)t1, cqd, acc[4 * k + 1], false);
                        acc[4 * k + 2] = __builtin_amdgcn_sdot4((int)t2, cqd, acc[4 * k + 2], false);
                        acc[4 * k + 3] = __builtin_amdgcn_sdot4((int)t3, cqd, acc[4 * k + 3], false);
                    }
                }
            };
            issue(0, va);
#pragma unroll 1
            for (int pb = 0; pb < 128; pb += 16) {
                issue(pb + 8, vbf);
                axpy(pb, va);
                if (pb + 16 < 128) issue(pb + 16, va);
                axpy(pb + 8, vbf);
            }
        }
        const u32x4* hr = (const u32x4*)(p.hb + (size_t)t * D_MODEL + lane * 16);
        const u32x4 ha = hr[0], hc = hr[1];
        const float hf16[16] = {bflo(ha.x), bfhi(ha.x), bflo(ha.y), bfhi(ha.y), bflo(ha.z), bfhi(ha.z), bflo(ha.w), bfhi(ha.w),
                                bflo(hc.x), bfhi(hc.x), bflo(hc.y), bfhi(hc.y), bflo(hc.z), bfhi(hc.z), bflo(hc.w), bfhi(hc.w)};
        float res[16];
        float ss = 0.f;
#pragma unroll
        for (int j = 0; j < 16; ++j) { res[j] = hf16[j] + cscale * (float)(acc[j] - 32 * csum_i); ss += res[j] * res[j]; }
        ss = wave_sum(ss);
        const float r3 = rsqrtf(ss * (1.0f / D_MODEL) + EPS);
        float* o = p.out + (size_t)t * D_MODEL + lane * 16;
        const float* fg = p.final_g + lane * 16;
#pragma unroll
        for (int i = 0; i < 4; ++i) {
            const float4 g = ((const float4*)fg)[i];
            float4 ov; ov.x = res[4 * i] * r3 * g.x; ov.y = res[4 * i + 1] * r3 * g.y; ov.z = res[4 * i + 2] * r3 * g.z; ov.w = res[4 * i + 3] * r3 * g.w;
            ((float4*)o)[i] = ov;
        }
    }
}

namespace pg8 {
#define PG8_LAS __attribute__((address_space(3)))
constexpr int BM = 256, BK = 64, HALF = 128, HTB = HALF * BK * 2, STAGE_BYTES = 8 * HTB, NXCD = 8, WGM = 8;
__host__ __device__ __forceinline__ int lds_byte(int r, int c) { const int st = (r >> 4) * 2 + (c >> 5), rr = r & 15, cc = c & 31, ob = rr * 64 + cc * 2; return st * 1024 + (ob ^ (((ob >> 9) & 1) << 5)); }
__host__ __device__ __forceinline__ void stage_rc(int b, int& R, int& C) { const int st = b / 1024, sb = b % 1024, swz = sb ^ (((sb >> 9) & 1) << 5); R = (st >> 1) * 16 + swz / 64; C = (st & 1) * 32 + (swz % 64) / 2; }
__host__ __device__ __forceinline__ int perm32(int rho) { const int n = rho >> 4, i = rho & 15; return 8 * (i >> 2) + 4 * n + (i & 3); }
struct Unit { int pm, pn; };
struct Gemm { const bf16_t* A; const bf16_t* Bt; int M, N, K; };
struct StaticOrder {
    int nM, nN, nwg, G, c;
    __host__ __device__ void init(int M, int N, int G_, int c_) { nM = M / BM; nN = N / BM; nwg = nM * nN; G = G_; c = c_; }
    __host__ __device__ bool next(int i, Unit& u) const {
        const long L = (long)i * G + c; if (L >= nwg) return false;
        int wgid = (int)L; { const int q = nwg / NXCD, r = nwg % NXCD, xcd = wgid % NXCD, off = wgid / NXCD; wgid = (xcd < r ? xcd * (q + 1) : r * (q + 1) + (xcd - r) * q) + off; }
        const int nig = WGM * nN, gid = wgid / nig, fm = gid * WGM, gsz = (nM - fm) < WGM ? (nM - fm) : WGM;
        u.pm = fm + ((wgid % nig) % gsz); u.pn = (wgid % nig) / gsz; return true;
    }
    __device__ __forceinline__ void a_ready(const Unit&) const {}
    __device__ __forceinline__ void done(const Unit&) const {}
};
__device__ __forceinline__ unsigned cvt_pk_bf16(float lo, float hi) { unsigned r; asm volatile("v_cvt_pk_bf16_f32 %0, %1, %2" : "=v"(r) : "v"(lo), "v"(hi)); return r; }
template <bool I8> __device__ __forceinline__ typename std::conditional<I8, i32x4, f32x4>::type mma1(bf16x8 a, bf16x8 b, typename std::conditional<I8, i32x4, f32x4>::type c) {
    if constexpr (I8) return __builtin_amdgcn_mfma_i32_16x16x64_i8(*(const i32x4*)&a, *(const i32x4*)&b, c, 0, 0, 0);
    else return __builtin_amdgcn_mfma_f32_16x16x32_bf16(a, b, c, 0, 0, 0);
}
struct EpiZ8 {
    static constexpr bool PERM = true, AFTER_DRAIN = false, I8 = true; typedef i32x4 acc_t;
    bf16_t* O; const float* rsx; const unsigned* swb;
    __device__ __forceinline__ void operator()(const i32x4 (&acc)[2][2][4][2], const Unit& u, int wr, int wc, int fr, int fq) const {
        const int row0 = u.pm * BM + wr * 64 + fr, col0 = u.pn * BM + wc * 32 + 8 * fq; const bool act = u.pn >= 2;
        float sw[2][8];
#pragma unroll
        for (int bj = 0; bj < 2; ++bj) { const u32x4 a = *(const u32x4*)(swb + col0 + bj * HALF), c = *(const u32x4*)(swb + col0 + bj * HALF + 4);
#pragma unroll
            for (int i = 0; i < 4; ++i) { sw[bj][i] = __uint_as_float(a[i]) * (1.0f / 127.0f); sw[bj][4 + i] = __uint_as_float(c[i]) * (1.0f / 127.0f); } }
#pragma unroll
        for (int ai = 0; ai < 2; ++ai)
#pragma unroll
            for (int m = 0; m < 4; ++m) { const int r = row0 + ai * HALF + m * 16; const float sc = rsx[r]; bf16_t* rowp = O + (size_t)r * D_IN + col0;
#pragma unroll
                for (int bj = 0; bj < 2; ++bj) { f32x4 v0, v1;
#pragma unroll
                    for (int i = 0; i < 4; ++i) { v0[i] = (float)acc[ai][bj][m][0][i] * sc * sw[bj][i]; v1[i] = (float)acc[ai][bj][m][1][i] * sc * sw[bj][4 + i]; }
                    if (act) { v0 = (f32x4){gelu_t(v0[0]), gelu_t(v0[1]), gelu_t(v0[2]), gelu_t(v0[3])}; v1 = (f32x4){gelu_t(v1[0]), gelu_t(v1[1]), gelu_t(v1[2]), gelu_t(v1[3])}; }
                    u32x4 w; w.x = cvt_pk_bf16(v0[0], v0[1]); w.y = cvt_pk_bf16(v0[2], v0[3]); w.z = cvt_pk_bf16(v1[0], v1[1]); w.w = cvt_pk_bf16(v1[2], v1[3]);
                    *(u32x4*)(rowp + bj * HALF) = w; } }
    }
};
struct EpiZ {
    static constexpr bool PERM = true, AFTER_DRAIN = false, I8 = false; typedef f32x4 acc_t;
    bf16_t* O; const float* rs;
    __device__ __forceinline__ void operator()(const f32x4 (&acc)[2][2][4][2], const Unit& u, int wr, int wc, int fr, int fq) const {
        const int row0 = u.pm * BM + wr * 64 + fr, col0 = u.pn * BM + wc * 32 + 8 * fq; const bool act = u.pn >= 2;
#pragma unroll
        for (int ai = 0; ai < 2; ++ai)
#pragma unroll
            for (int m = 0; m < 4; ++m) { const int r = row0 + ai * HALF + m * 16; const float sc = rs[r]; bf16_t* rowp = O + (size_t)r * D_IN + col0;
#pragma unroll
                for (int bj = 0; bj < 2; ++bj) { f32x4 v0 = acc[ai][bj][m][0] * sc, v1 = acc[ai][bj][m][1] * sc;
                    if (act) { v0 = (f32x4){gelu_t(v0[0]), gelu_t(v0[1]), gelu_t(v0[2]), gelu_t(v0[3])}; v1 = (f32x4){gelu_t(v1[0]), gelu_t(v1[1]), gelu_t(v1[2]), gelu_t(v1[3])}; }
                    u32x4 w; w.x = cvt_pk_bf16(v0[0], v0[1]); w.y = cvt_pk_bf16(v0[2], v0[3]); w.z = cvt_pk_bf16(v1[0], v1[1]); w.w = cvt_pk_bf16(v1[2], v1[3]);
                    *(u32x4*)(rowp + bj * HALF) = w; } }
    }
};
struct EpiOut {
    static constexpr bool PERM = true, AFTER_DRAIN = false, I8 = false; typedef f32x4 acc_t;
    bf16_t* O; const signed char* X; const float* sx;
    __device__ __forceinline__ void operator()(const f32x4 (&acc)[2][2][4][2], const Unit& u, int wr, int wc, int fr, int fq) const {
        const int row0 = u.pm * BM + wr * 64 + fr, col0 = u.pn * BM + wc * 32 + 8 * fq;
#pragma unroll
        for (int ai = 0; ai < 2; ++ai)
#pragma unroll
            for (int m = 0; m < 4; ++m) { const int r = row0 + ai * HALF + m * 16; const size_t off = (size_t)r * D_MODEL + col0; const float sc = sx[r];
#pragma unroll
                for (int bj = 0; bj < 2; ++bj) { const u32x2 xx = *(const u32x2*)(X + off + bj * HALF);
                    f32x4 x0, x1;
#pragma unroll
                    for (int i = 0; i < 4; ++i) { x0[i] = (float)(signed char)(xx.x >> (8 * i)) * sc; x1[i] = (float)(signed char)(xx.y >> (8 * i)) * sc; }
                    const f32x4 v0 = acc[ai][bj][m][0] + x0, v1 = acc[ai][bj][m][1] + x1;
                    u32x4 w; w.x = cvt_pk_bf16(v0[0], v0[1]); w.y = cvt_pk_bf16(v0[2], v0[3]); w.z = cvt_pk_bf16(v1[0], v1[1]); w.w = cvt_pk_bf16(v1[2], v1[3]);
                    *(u32x4*)(O + off + bj * HALF) = w; } }
    }
};
struct OneUnit {
    Unit u;
    __device__ __forceinline__ bool next(int i, Unit& o) const { if (i) return false; o = u; return true; }
    __device__ __forceinline__ void a_ready(const Unit&) const {}
    __device__ __forceinline__ void done(const Unit&) const {}
};
#define QT_PITCH 272
#define QT_LDS_BYTES (2 * 256 * QT_PITCH)
struct EpiQTopk {
    static constexpr bool PERM = true, AFTER_DRAIN = true, I8 = true; typedef i32x4 acc_t;
    const bf16_t* keysB; int* idx; float* gate; const unsigned* swq;
    __device__ __forceinline__ void fused(i32x4 (&acc)[2][2][4][2], const Unit& u, int wr, int wc, int fr, int fq, PG8_LAS unsigned char* ldsp, int wid, int lane) const {
        char* sQ = (char*)ldsp;
        const int h = u.pn;
        float sw[2][8];
#pragma unroll
        for (int bj = 0; bj < 2; ++bj) { const u32x4 a = *(const u32x4*)(swq + u.pn * BM + bj * HALF + wc * 32 + 8 * fq), c = *(const u32x4*)(swq + u.pn * BM + bj * HALF + wc * 32 + 8 * fq + 4);
#pragma unroll
            for (int i = 0; i < 4; ++i) { sw[bj][i] = __uint_as_float(a[i]) * (1.0f / 127.0f); sw[bj][4 + i] = __uint_as_float(c[i]) * (1.0f / 127.0f); } }
#pragma unroll
        for (int ai = 0; ai < 2; ++ai)
#pragma unroll
            for (int m = 0; m < 4; ++m) { const int r = ai * HALF + wr * 64 + m * 16 + fr;
#pragma unroll
                for (int bj = 0; bj < 2; ++bj) { f32x4 v0, v1;
#pragma unroll
                    for (int i = 0; i < 4; ++i) { v0[i] = (float)acc[ai][bj][m][0][i] * sw[bj][i]; v1[i] = (float)acc[ai][bj][m][1][i] * sw[bj][4 + i]; }
                    u32x4 w; w.x = cvt_pk_bf16(v0[0], v0[1]); w.y = cvt_pk_bf16(v0[2], v0[3]); w.z = cvt_pk_bf16(v1[0], v1[1]); w.w = cvt_pk_bf16(v1[2], v1[3]);
                    *(u32x4*)(sQ + bj * (256 * QT_PITCH) + r * QT_PITCH + (wc * 32 + fq * 8) * 2) = w; } }
        __syncthreads();
        int cbv[4];
#pragma unroll
        for (int c = 0; c < 4; ++c) cbv[c] = kComb[4 * fr + c];
        int tA[2][4], tB[2][4];
#pragma unroll
        for (int m = 0; m < 2; ++m)
#pragma unroll
            for (int j = 0; j < 4; ++j) { tA[m][j] = 0; tB[m][j] = 0; }
#pragma unroll 1
        for (int pp = 0; pp < 2; ++pp) {
            const bf16_t* kb = keysB + (size_t)(pp * 8 + h) * 16384 + lane * 8;
            const char* qa = sQ + pp * (256 * QT_PITCH) + (wid * 32 + fr) * QT_PITCH + fq * 16;
            f32x4 sc2[2][8];
#pragma unroll
            for (int m = 0; m < 2; ++m)
#pragma unroll
                for (int nb = 0; nb < 8; ++nb) sc2[m][nb] = (f32x4){0.f, 0.f, 0.f, 0.f};
#pragma unroll
            for (int kk = 0; kk < 4; ++kk) {
                bf16x8 kf[8], af[2];
#pragma unroll
                for (int nb = 0; nb < 8; ++nb) kf[nb] = *(const bf16x8*)(kb + (kk * 8 + nb) * 512);
#pragma unroll
                for (int m = 0; m < 2; ++m) af[m] = *(const bf16x8*)(qa + m * 16 * QT_PITCH + kk * 64);
#pragma unroll
                for (int m = 0; m < 2; ++m)
#pragma unroll
                    for (int nb = 0; nb < 8; ++nb) sc2[m][nb] = __builtin_amdgcn_mfma_f32_16x16x32_bf16(af[m], kf[nb], sc2[m][nb], 0, 0, 0);
            }
#pragma unroll
            for (int m = 0; m < 2; ++m)
#pragma unroll
                for (int j = 0; j < 4; ++j) tA[m][j] = tB[m][j];
#pragma unroll 2
            for (int it = 0; it < 4; ++it) {
#pragma unroll
                for (int m = 0; m < 2; ++m) {
                    int k[8];
#pragma unroll
                    for (int nb = 0; nb < 8; ++nb) k[nb] = (f2key(sc2[m][nb][0]) & ~127) | (127 - (16 * nb + fr));
                    const int r = top16_rows(k, fr);
                    tB[m][0] = tB[m][1]; tB[m][1] = tB[m][2]; tB[m][2] = tB[m][3]; tB[m][3] = r;
#pragma unroll
                    for (int nb = 0; nb < 8; ++nb) sc2[m][nb] = (f32x4){sc2[m][nb][1], sc2[m][nb][2], sc2[m][nb][3], sc2[m][nb][0]};
                }
            }
        }
#pragma unroll 2
        for (int it = 0; it < 4; ++it) {
#pragma unroll
            for (int m = 0; m < 2; ++m) {
                int eid; float gt;
                combine16(tA[m][0], tB[m][0], cbv, lane, fr, eid, gt);
                const int t = u.pm * BM + wid * 32 + m * 16 + fq * 4 + it;
                const size_t o = (size_t)t * 128 + h * 16 + fr;
                idx[o] = eid; gate[o] = gt;
                tA[m][0] = tA[m][1]; tA[m][1] = tA[m][2]; tA[m][2] = tA[m][3];
                tB[m][0] = tB[m][1]; tB[m][1] = tB[m][2]; tB[m][2] = tB[m][3];
            }
        }
        __syncthreads();
    }
};
template <class Epi, class Sched>
__device__ __forceinline__ void gemm_phase(PG8_LAS unsigned char* lds, const Gemm g, const Sched& S, const Epi& E) {
    const int tid = tid_opaque(), wid = __builtin_amdgcn_readfirstlane(tid >> 6), lane = tid & 63, wr = wid >> 2, wc = wid & 3, fr = lane & 15, fq = lane >> 4;
    const int K = g.K, nt = K / BK;
    unsigned voffA[2], voffB[2];
#pragma unroll
    for (int i = 0; i < 2; ++i) { int R, C; stage_rc(tid * 16 + i * 8192, R, C); const int Rb = Epi::PERM ? ((R & ~31) + perm32(R & 31)) : R;
        voffA[i] = (unsigned)(R * K + C) * 2u; voffB[i] = (unsigned)(Rb * K + C) * 2u; }
    const size_t kstep = (size_t)(BK * 2);
    const size_t hstep = (size_t)HALF * K * 2;
    const size_t tstep = 2 * hstep;
    const unsigned ldsw = (unsigned)wid * 1024u;
    const int aoff = lds_byte(wr * 64 + fr, fq * 8), boff = lds_byte(wc * 32 + fr, fq * 8);
#define PG8_SA(b, h) (((b) * 2 + (h)) * HTB)
#define PG8_SB(b, h) ((4 + (b) * 2 + (h)) * HTB)
#define PG8_STAGE(bufoff, gbase, voff) do { _Pragma("unroll") for (int _i = 0; _i < 2; ++_i) \
        __builtin_amdgcn_global_load_lds((const unsigned*)((const char*)(gbase) + (voff)[_i]), (PG8_LAS unsigned*)(lds + (bufoff) + ldsw + _i * 8192), 16, 0, 0); } while (0)
#define PG8_LDA(dst, b, h) do { _Pragma("unroll") for (int m = 0; m < 4; ++m) _Pragma("unroll") for (int k = 0; k < 2; ++k) dst[m][k] = *(const PG8_LAS bf16x8*)(lds + PG8_SA(b, h) + aoff + m * 2048 + k * 1024); } while (0)
#define PG8_LDB(dst, b, h) do { _Pragma("unroll") for (int n = 0; n < 2; ++n) _Pragma("unroll") for (int k = 0; k < 2; ++k) dst[n][k] = *(const PG8_LAS bf16x8*)(lds + PG8_SB(b, h) + boff + n * 2048 + k * 1024); } while (0)
#define PG8_MMA(ai, bj, At, Bt) do { __builtin_amdgcn_s_setprio(1); _Pragma("unroll") for (int m = 0; m < 4; ++m) _Pragma("unroll") for (int n = 0; n < 2; ++n) _Pragma("unroll") for (int k = 0; k < 2; ++k) \
        acc[ai][bj][m][n] = mma1<Epi::I8>(Bt[n][k], At[m][k], acc[ai][bj][m][n]); __builtin_amdgcn_s_setprio(0); } while (0)
#define PG8_WAIT_V(n) asm volatile("s_waitcnt vmcnt(" #n ")" ::: "memory")
#define PG8_WAIT_L(n) asm volatile("s_waitcnt lgkmcnt(" #n ")" ::: "memory")
#define PG8_BAR __builtin_amdgcn_s_barrier()
#define PG8_SCHED __builtin_amdgcn_sched_barrier(0)
    Unit cur, nxt; int ui = 0;
    if (!S.next(0, cur)) return;
    typedef typename Epi::acc_t acc_t;
    acc_t acc[2][2][4][2];
#pragma unroll
    for (int a = 0; a < 2; ++a)
#pragma unroll
        for (int b = 0; b < 2; ++b)
#pragma unroll
            for (int m = 0; m < 4; ++m)
#pragma unroll
                for (int n = 0; n < 2; ++n) acc[a][b][m][n] = (acc_t)(0);
    bf16x8 At[4][2], B0[2][2], B1[2][2];
    const char* cA = (const char*)g.A + (size_t)cur.pm * tstep; const char* cB = (const char*)g.Bt + (size_t)cur.pn * tstep;
    S.a_ready(cur);
    PG8_STAGE(PG8_SB(0, 0), cB, voffB); PG8_STAGE(PG8_SA(0, 0), cA, voffA); PG8_STAGE(PG8_SB(0, 1), cB + hstep, voffB); PG8_STAGE(PG8_SA(0, 1), cA + hstep, voffA);
    if (wr == 1) PG8_BAR;
    PG8_WAIT_V(4); PG8_BAR;
    PG8_STAGE(PG8_SB(1, 0), cB + kstep, voffB); PG8_STAGE(PG8_SA(1, 0), cA + kstep, voffA); PG8_STAGE(PG8_SB(1, 1), cB + hstep + kstep, voffB);
    PG8_WAIT_V(6); PG8_BAR;
    for (;;) {
        const bool has_next = S.next(ui + 1, nxt);
        const char* nA = has_next ? (const char*)g.A + (size_t)nxt.pm * tstep : cA; const char* nB = has_next ? (const char*)g.Bt + (size_t)nxt.pn * tstep : cB;
        for (int t = 0; t < nt; t += 2) {
            const bool last = (t == nt - 2);
            const char* a1 = cA + (size_t)(t + 1) * kstep;
            const char* a2 = last ? nA : cA + (size_t)(t + 2) * kstep; const char* b2 = last ? nB : cB + (size_t)(t + 2) * kstep;
            const char* a3 = a2 + kstep; const char* b3 = b2 + kstep;
            if (last && has_next) S.a_ready(nxt);
            PG8_LDB(B0, 0, 0); PG8_SCHED; PG8_LDA(At, 0, 0); PG8_STAGE(PG8_SA(1, 1), a1 + hstep, voffA);
            PG8_WAIT_L(8); PG8_BAR; PG8_WAIT_L(0); PG8_MMA(0, 0, At, B0); PG8_BAR; PG8_SCHED;
            PG8_LDB(B1, 0, 1); PG8_STAGE(PG8_SB(0, 0), b2, voffB);
            PG8_BAR; PG8_WAIT_L(0); PG8_MMA(0, 1, At, B1); PG8_BAR;
            PG8_LDA(At, 0, 1); PG8_STAGE(PG8_SA(0, 0), a2, voffA);
            PG8_BAR; PG8_WAIT_L(0); PG8_MMA(1, 0, At, B0); PG8_BAR; PG8_SCHED;
            PG8_STAGE(PG8_SB(0, 1), b2 + hstep, voffB);
            PG8_WAIT_V(6); PG8_BAR; PG8_MMA(1, 1, At, B1); PG8_BAR;
            PG8_LDB(B0, 1, 0); PG8_SCHED; PG8_LDA(At, 1, 0); PG8_STAGE(PG8_SA(0, 1), a2 + hstep, voffA);
            PG8_WAIT_L(8); PG8_BAR; PG8_WAIT_L(0); PG8_MMA(0, 0, At, B0); PG8_BAR; PG8_SCHED;
            PG8_LDB(B1, 1, 1); PG8_STAGE(PG8_SB(1, 0), b3, voffB);
            PG8_BAR; PG8_WAIT_L(0); PG8_MMA(0, 1, At, B1); PG8_BAR;
            PG8_LDA(At, 1, 1); PG8_STAGE(PG8_SA(1, 0), a3, voffA);
            PG8_BAR; PG8_WAIT_L(0); PG8_MMA(1, 0, At, B0); PG8_BAR; PG8_SCHED;
            PG8_STAGE(PG8_SB(1, 1), b3 + hstep, voffB);
            PG8_WAIT_V(6); PG8_BAR; PG8_MMA(1, 1, At, B1); PG8_BAR;
        }
            if constexpr (!Epi::AFTER_DRAIN) { E(acc, cur, wr, wc, fr, fq); S.done(cur); }
            if (!has_next) break;
#pragma unroll
        for (int a = 0; a < 2; ++a)
#pragma unroll
            for (int b = 0; b < 2; ++b)
#pragma unroll
                for (int m = 0; m < 4; ++m)
#pragma unroll
                    for (int n = 0; n < 2; ++n) acc[a][b][m][n] = (acc_t)(0);
        cur = nxt; cA = nA; cB = nB; ++ui;
    }
    PG8_WAIT_V(0);
    if (wr == 0) PG8_BAR;
    PG8_BAR;
    if constexpr (Epi::AFTER_DRAIN) { E.fused(acc, cur, wr, wc, fr, fq, lds, wid, lane); S.done(cur); }
#undef PG8_SA
#undef PG8_SB
#undef PG8_STAGE
#undef PG8_LDA
#undef PG8_LDB
#undef PG8_MMA
#undef PG8_WAIT_V
#undef PG8_WAIT_L
#undef PG8_BAR
#undef PG8_SCHED
}
}

__device__ void phase_gemm_z(const Params& p, char* lds) {
    pg8::StaticOrder S; S.init(T_TOK, D_IN, gridDim.x, blockIdx.x);
    pg8::gemm_phase<pg8::EpiZ8, pg8::StaticOrder>((PG8_LAS unsigned char*)lds, pg8::Gemm{(const bf16_t*)p.xq, (const bf16_t*)p.winT8, T_TOK, D_IN, D_MODEL / 2}, S, pg8::EpiZ8{p.zb, p.rstd1, p.swb});
}
__device__ void phase_gemm_out(const Params& p, char* lds) {
    pg8::StaticOrder S; S.init(T_TOK, D_MODEL, gridDim.x, blockIdx.x);
    pg8::gemm_phase<pg8::EpiOut, pg8::StaticOrder>((PG8_LAS unsigned char*)lds, pg8::Gemm{p.cB, p.woutT, T_TOK, D_MODEL, D_MODEL}, S, pg8::EpiOut{p.hb, p.xq, p.sx});
}
__device__ void phase_gemm_q(const Params& p, char* lds) {
    pg8::StaticOrder S; S.init(T_TOK, 2048, gridDim.x, blockIdx.x);
    pg8::Unit u;
    for (int i = 0; S.next(i, u); ++i)
        pg8::gemm_phase<pg8::EpiQTopk, pg8::OneUnit>((PG8_LAS unsigned char*)lds, pg8::Gemm{(const bf16_t*)p.hq, (const bf16_t*)p.wqT8, T_TOK, 2048, D_MODEL / 2}, pg8::OneUnit{u}, pg8::EpiQTopk{p.keysB, p.idx, p.gate, p.swq});
}

#define XB_TMO      128
#define XB_XCNT(j)  (256  + 64 * (j))
#define XB_XSUB(j)  (1280 + 64 * (j))
#define XB_XGEN(j)  (2304 + 64 * (j))
#define XB_TOP      3328
#define XB_TOPGEN   3392
#define XCD_BAR_WORDS 3456
#define XB_SPIN_CAP (1u << 20)
__device__ __forceinline__ unsigned xb_ld(unsigned* p)              { return __hip_atomic_load(p, __ATOMIC_RELAXED, __HIP_MEMORY_SCOPE_AGENT); }
__device__ __forceinline__ unsigned xb_add(unsigned* p, unsigned v) { return __hip_atomic_fetch_add(p, v, __ATOMIC_RELAXED, __HIP_MEMORY_SCOPE_AGENT); }
__device__ __forceinline__ unsigned xb_xcc_id() { return (unsigned)__builtin_amdgcn_s_getreg((3 << 11) | 20) & 0xFu; }
#define XB_SPIN(cond, bar) do { unsigned _sp = 0; while (cond) { __builtin_amdgcn_s_sleep(1); \
    if ((++_sp & 255u) == 0u) { if (xb_ld(&(bar)[XB_TMO])) break; if (_sp > XB_SPIN_CAP) { atomicAdd(&(bar)[XB_TMO], 1u); break; } } } } while (0)
struct XcdBarrier { unsigned* bar; unsigned x; volatile LAS unsigned* st; };
__device__ __forceinline__ XcdBarrier xcd_barrier_post(unsigned* bar, volatile LAS unsigned* st) {
    XcdBarrier b; b.bar = bar; b.x = xb_xcc_id(); b.st = st;
    if (threadIdx.x == 0) (void)xb_add(&bar[XB_XCNT(b.x)], 1u);
    return b;
}
__device__ __forceinline__ void xcd_barrier_complete(unsigned* bar, unsigned x, unsigned& nloc, unsigned& nx) {
    const unsigned G = gridDim.x * gridDim.y * gridDim.z;
    unsigned sum, cnt, mine, sp = 0u;
    for (;;) {
        sum = 0u; cnt = 0u; mine = 0u;
#pragma unroll
        for (unsigned j = 0; j < 16; ++j) { const unsigned c = xb_ld(&bar[XB_XCNT(j)]); sum += c; cnt += (c > 0u) ? 1u : 0u; mine = (j == x) ? c : mine; }
        if (sum == G) break;
        __builtin_amdgcn_s_sleep(1);
        if ((++sp & 255u) == 0u) { if (xb_ld(&bar[XB_TMO])) break; if (sp > XB_SPIN_CAP) { atomicAdd(&bar[XB_TMO], 1u); break; } }
    }
    nloc = mine > 0u ? mine : 1u; nx = cnt > 0u ? cnt : 1u;
}
__device__ __forceinline__ void xcd_barrier(const XcdBarrier& b) {
    asm volatile("s_waitcnt vmcnt(0)" ::: "memory");
    __syncthreads();
    if (threadIdx.x == 0) {
        unsigned* bar = b.bar;
        __builtin_amdgcn_s_waitcnt(0);
        unsigned nloc = b.st[0], nx = b.st[1];
        if (nloc == 0u) { xcd_barrier_complete(bar, b.x, nloc, nx); b.st[0] = nloc; b.st[1] = nx; }
        const unsigned old = xb_add(&bar[XB_XSUB(b.x)], 1u);
        const unsigned gen = old / nloc;
        if (old + 1u == (gen + 1u) * nloc) {
            __builtin_amdgcn_fence(__ATOMIC_RELEASE, "agent");
            asm volatile("s_waitcnt vmcnt(0)" ::: "memory");
            const unsigned og = xb_add(&bar[XB_TOP], 1u);
            const unsigned tg = og / nx;
            if (og + 1u == (tg + 1u) * nx) xb_add(&bar[XB_TOPGEN], 1u);
            else XB_SPIN(xb_ld(&bar[XB_TOPGEN]) == tg, bar);
            __builtin_amdgcn_fence(__ATOMIC_ACQUIRE, "agent");
            xb_add(&bar[XB_XGEN(b.x)], 1u);
            asm volatile("s_waitcnt vmcnt(0)" ::: "memory");
        } else {
            XB_SPIN(xb_ld(&bar[XB_XGEN(b.x)]) == gen, bar);
            __builtin_amdgcn_fence(__ATOMIC_ACQUIRE, "agent");
            asm volatile("s_waitcnt vmcnt(0)" ::: "memory");
        }
    }
    __syncthreads();
}

#define MEGA_LDS_MAX2(a, b) ((a) > (b) ? (a) : (b))
#define MEGA_LDS_MAIN MEGA_LDS_MAX2(MEGA_LDS_MAX2(QT_LDS_BYTES, pg8::STAGE_BYTES), MEGA_LDS_MAX2(8 * TS_WBYTES, 2 * MIXH_LDS))
#define MEGA_LDS_BYTES (MEGA_LDS_MAIN + 16)
extern __shared__ __attribute__((aligned(16))) char smem[];
__global__ void __launch_bounds__(512, 2) fwd_mega(Params p) {
    volatile LAS unsigned* st = (volatile LAS unsigned*)(smem + MEGA_LDS_MAIN);
    if (threadIdx.x < 4) st[threadIdx.x] = 0u;
    __syncthreads();
    const XcdBarrier xb = xcd_barrier_post(p.bar, st);
    phase_prep(p, smem);      xcd_barrier(xb);
    phase_gemm_z(p, smem);    xcd_barrier(xb);
    phase_mix_gemm(p, smem);  xcd_barrier(xb);
    phase_gemm_out(p, smem);  xcd_barrier(xb);
    phase_hquant(p, smem);    xcd_barrier(xb);
    phase_gemm_q(p, smem);    xcd_barrier(xb);
    phase_peer_dots(p, smem); xcd_barrier(xb);
    phase_gather(p, smem);
}

extern "C" void kernel_launch(void* const* d_in, const int* in_sizes, int n_in, void* d_out, int out_size, void* d_ws, size_t ws_size, hipStream_t stream) {
    static int grid_blocks = 0;
    if (grid_blocks == 0) {
        int dev = 0, cus = 0, per_cu = 0;
        (void)hipGetDevice(&dev);
        (void)hipDeviceGetAttribute(&cus, hipDeviceAttributeMultiprocessorCount, dev);
        (void)hipFuncSetAttribute((const void*)fwd_mega, hipFuncAttributeMaxDynamicSharedMemorySize, MEGA_LDS_BYTES);
        (void)hipOccupancyMaxActiveBlocksPerMultiprocessor(&per_cu, (const void*)fwd_mega, 512, MEGA_LDS_BYTES);
        if (per_cu > 1) per_cu = 1;
        if (per_cu < 1) per_cu = 1;
        grid_blocks = cus * per_cu;
    }
    Params p{};
    p.x = (const float*)d_in[0]; p.norm1_g = (const float*)d_in[1]; p.w_in = (const float*)d_in[2]; p.pool_w = (const float*)d_in[3];
    p.pool_scale = (const float*)d_in[4]; p.sgu_norm_g = (const float*)d_in[5]; p.sgu_w = (const float*)d_in[6]; p.sgu_b = (const float*)d_in[7];
    p.w_out = (const float*)d_in[8]; p.norm2_g = (const float*)d_in[9]; p.peer_wq = (const float*)d_in[10]; p.peer_keys = (const float*)d_in[11];
    p.peer_u = (const float*)d_in[12]; p.peer_v = (const float*)d_in[13]; p.final_g = (const float*)d_in[14];
    p.out = (float*)d_out;
    char* w = (char*)d_ws; size_t off = 0;
    auto take = [&](size_t bytes) { char* r = w + off; off += (bytes + 255) & ~(size_t)255; return r; };
    const size_t MiB = 1024 * 1024;
    p.u8 = (unsigned char*)take(16 * MiB); p.v8 = (unsigned char*)take(12 * MiB);
    p.suv = (float2*)take(128 * 1024);
    p.winT = (bf16_t*)take(3 * MiB); p.woutT = (bf16_t*)take(2 * MiB); p.wqT = (bf16_t*)take(4 * MiB);
    p.poolT = (bf16_t*)take(128 * 1024); p.wsM = (bf16_t*)take(128 * 1024); p.keysB = (bf16_t*)take(512 * 1024);
    p.bar = (unsigned*)take(XCD_BAR_WORDS * 4 + 4608 * 4); p.swb = p.bar + XCD_BAR_WORDS; p.swq = p.swb + 2048;
    p.rstd1 = (float*)take(128 * 1024); p.sx = (float*)take(128 * 1024); p.xq = (signed char*)take(32 * MiB); p.winT8 = (signed char*)take(1536 * 1024); p.wqT8 = (signed char*)take(2048 * 1024); p.hq = (signed char*)take(32 * MiB); p.hsc = (float*)take(128 * 1024);
    p.idx = (int*)take(16 * MiB); p.gate = (float*)take(16 * MiB); p.coef = (float*)take(16 * MiB);
    p.xb = (bf16_t*)take(64 * MiB); p.zb = (bf16_t*)take(96 * MiB); p.cB = (bf16_t*)take(64 * MiB); p.hb = (bf16_t*)take(64 * MiB);
    (void)hipMemsetAsync(p.bar, 0, XCD_BAR_WORDS * 4 + 4608 * 4, stream);
    hipLaunchKernelGGL(fwd_mega, dim3(grid_blocks), dim3(512), MEGA_LDS_BYTES, stream, p);
}
```

```cpp
#include <hip/hip_runtime.h>
#include <stdint.h>
#include <type_traits>

typedef unsigned short bf16_t;
typedef short bf16x8 __attribute__((ext_vector_type(8)));
typedef float f32x4 __attribute__((ext_vector_type(4)));
typedef unsigned u32x4 __attribute__((ext_vector_type(4)));
typedef unsigned u32x2 __attribute__((ext_vector_type(2)));
typedef unsigned u32x3 __attribute__((ext_vector_type(3)));
typedef int i32x4 __attribute__((ext_vector_type(4)));
#define ROWB 768
typedef __bf16 bf2_t __attribute__((ext_vector_type(2)));
#define LAS __attribute__((address_space(3)))

#define T_TOK 32768
#define D_MODEL 1024
#define D_IN 1536
#define SEQ 2048
#define NEXP 16384
#define EPS 1e-6f

struct Params {
    const float *x, *norm1_g, *w_in, *pool_w, *pool_scale, *sgu_norm_g, *sgu_w, *sgu_b, *w_out, *norm2_g, *peer_wq, *peer_keys, *peer_u, *peer_v, *final_g;
    float* out;
    bf16_t *winT, *woutT, *wqT, *poolT, *wsM, *keysB;
    unsigned char *u8, *v8;
    float2* suv;
    float *rstd1, *sx;
    signed char *xq, *winT8, *hq, *wqT8; unsigned *swb, *swq; float* hsc;
    bf16_t *xb, *zb, *cB, *hb;
    int* idx; float* gate; float* coef;
    unsigned* bar;
};

__device__ __forceinline__ int tid_opaque() { int t = (int)threadIdx.x; asm volatile("" : "+v"(t)); return t; }
__device__ __forceinline__ unsigned short f2bf(float f) {
    unsigned u = __float_as_uint(f);
    u += 0x7fffu + ((u >> 16) & 1u);
    return (unsigned short)(u >> 16);
}
__device__ __forceinline__ float bf2f(unsigned short h) { return __uint_as_float(((unsigned)h) << 16); }
__device__ __forceinline__ unsigned pack2(float a, float b) { return (unsigned)f2bf(a) | ((unsigned)f2bf(b) << 16); }
__device__ __forceinline__ float bflo(unsigned w) { return __uint_as_float(w << 16); }
__device__ __forceinline__ float bfhi(unsigned w) { return __uint_as_float(w & 0xffff0000u); }
__device__ __forceinline__ float gelu_t(float x) {
    const float y = 1.5957691216057308f * (x + 0.044715f * x * x * x);
    return x * __builtin_amdgcn_rcpf(1.0f + __expf(-y));
}
__device__ __forceinline__ float wave_sum(float v) {
#pragma unroll
    for (int o = 32; o >= 1; o >>= 1) v += __shfl_xor(v, o);
    return v;
}
__device__ __forceinline__ float wave_max(float v) {
#pragma unroll
    for (int o = 32; o >= 1; o >>= 1) v = fmaxf(v, __shfl_xor(v, o));
    return v;
}

#define GEMM_LDS_BYTES (2 * 128 * 144)
__device__ __forceinline__ void transpose_tile(const int tid, const float* __restrict__ src, bf16_t* __restrict__ dst, int R, int C, const float* __restrict__ rscale, int tile, float* lds) {
    const int tilesC = C / 64, tr = tile / tilesC, tc = tile % tilesC;
    const int ty = tid >> 6, tx = tid & 63;
    __syncthreads();
#pragma unroll
    for (int i = 0; i < 16; ++i) {
        const int r = ty + 4 * i;
        float v = src[(size_t)(tr * 64 + r) * C + tc * 64 + tx];
        if (rscale) v *= rscale[tr * 64 + r];
        lds[r * 65 + tx] = v;
    }
    __syncthreads();
#pragma unroll
    for (int i = 0; i < 16; ++i) {
        const int c = ty + 4 * i;
        dst[(size_t)(tc * 64 + c) * R + tr * 64 + tx] = f2bf(lds[tx * 65 + c]);
    }
}

__device__ __forceinline__ void w8_colmax(const float* __restrict__ src, const float* __restrict__ gain, int C, unsigned* mx, unsigned* cnt, int hb2, int nh, int ht) {
    const int ncb = C / 64;
    for (int t = hb2; t < 16 * ncb; t += nh) {
        const int tr = t / ncb, tc = t % ncb, ty = ht >> 6, tx = ht & 63;
        float am = 0.f;
#pragma unroll
        for (int i = 0; i < 16; ++i) { const int r = tr * 64 + ty + 4 * i; am = fmaxf(am, fabsf(src[(size_t)r * C + tc * 64 + tx] * gain[r])); }
        (void)__hip_atomic_fetch_max(mx + tc * 64 + tx, __float_as_uint(am), __ATOMIC_RELAXED, __HIP_MEMORY_SCOPE_AGENT);
        asm volatile("s_waitcnt vmcnt(0)" ::: "memory");
        __syncthreads();
        if (ht == 0) (void)__hip_atomic_fetch_add(cnt + tc, 1u, __ATOMIC_RELAXED, __HIP_MEMORY_SCOPE_AGENT);
    }
}
__device__ __forceinline__ void w8_tiles(const float* __restrict__ src, const float* __restrict__ gain, int C, signed char* __restrict__ dst, unsigned* mx, unsigned* cnt, char* lds, int tid) {
    const int half = tid >> 8, ht = tid & 255, ty = ht >> 6, tx = ht & 63, ncb = C / 64;
    float* fl = (float*)(lds + half * (64 * 65 * 4));
    for (int t = 2 * blockIdx.x + half; t < 16 * ncb; t += 2 * gridDim.x) {
        const int tr = t / ncb, tc = t % ncb;
        if (ht == 0) {
            unsigned spins = 0;
            while (__hip_atomic_load(cnt + tc, __ATOMIC_RELAXED, __HIP_MEMORY_SCOPE_AGENT) < 16u && ++spins < (1u << 22)) __builtin_amdgcn_s_sleep(2);
        }
        __syncthreads();
#pragma unroll
        for (int i = 0; i < 16; ++i) { const int r = ty + 4 * i; fl[r * 65 + tx] = src[(size_t)(tr * 64 + r) * C + tc * 64 + tx] * gain[tr * 64 + r]; }
        __syncthreads();
#pragma unroll
        for (int i = 0; i < 16; ++i) {
            const int c = ty + 4 * i;
            const float am = __uint_as_float(__hip_atomic_load(mx + tc * 64 + c, __ATOMIC_RELAXED, __HIP_MEMORY_SCOPE_AGENT));
            const float inv = am > 0.f ? 127.0f / am : 0.f;
            dst[(size_t)(tc * 64 + c) * 1024 + tr * 64 + tx] = (signed char)(int)rintf(fl[tx * 65 + c] * inv);
        }
    }
}

__device__ void phase_prep(const Params& p, char* lds) {
    const int tidx_ = tid_opaque();
    const int nb = gridDim.x, b = blockIdx.x, tid = tidx_;
    const int half = tid >> 8, ht = tid & 255, nh = 2 * nb, hb2 = 2 * b + half;
    float* fl = (float*)(lds + half * (64 * 65 * 4));
    w8_colmax(p.w_in, p.norm1_g, 1536, p.swb, p.swb + 1536, hb2, nh, ht);
    w8_colmax(p.peer_wq, p.norm2_g, 2048, p.swq, p.swq + 2048, hb2, nh, ht);
    for (int t = hb2; t < 16 * 16; t += nh) transpose_tile(ht, p.w_out, p.woutT, 1024, 1024, nullptr, t, fl);
    for (int t = hb2; t < 16; t += nh) transpose_tile(ht, p.pool_w + (size_t)(t >> 2) * 16384, p.poolT + (size_t)(t >> 2) * 16384, 128, 128, nullptr, t & 3, fl);
    const size_t gtid = (size_t)b * blockDim.x + tid, gsz = (size_t)nb * blockDim.x;
    for (size_t i = gtid; i < 4 * 128 * 128; i += gsz) {
        const int j = (int)(i & 127), ii = (int)((i >> 7) & 127);
        const bool keep = (j >> 6) <= (ii >> 6);
        p.wsM[i] = keep ? f2bf(p.sgu_w[i]) : (bf16_t)0;
    }
    for (size_t o = gtid; o < 2 * 8 * 128 * 128; o += gsz) {
        const int j = (int)(o & 7), ln = (int)((o >> 3) & 63), nb = (int)((o >> 9) & 7), kk = (int)((o >> 12) & 3), ph = (int)(o >> 14);
        p.keysB[o] = f2bf(p.peer_keys[(size_t)ph * 16384 + (size_t)(16 * nb + (ln & 15)) * 128 + 32 * kk + 8 * (ln >> 4) + j]);
    }
    {
        const int wave = (b * blockDim.x + tid) >> 6, nwaves = (nb * blockDim.x) >> 6, lane = tid & 63;
        float g16[16];
#pragma unroll
        for (int i = 0; i < 4; ++i) { const float4 g = ((const float4*)(p.norm2_g + lane * 16))[i]; g16[4 * i] = g.x; g16[4 * i + 1] = g.y; g16[4 * i + 2] = g.z; g16[4 * i + 3] = g.w; }
        auto quant_row = [&](const float (&f)[16], unsigned char* dst, float* scale_out) {
            float am = 0.f;
#pragma unroll
            for (int j = 0; j < 16; ++j) am = fmaxf(am, fabsf(f[j]));
            am = wave_max(am);
            const float inv = am > 0.f ? 31.0f / am : 0.f;
            int q[16];
#pragma unroll
            for (int j = 0; j < 16; ++j) q[j] = (int)rintf(f[j] * inv) + 32;
            unsigned dg[3][4];
#pragma unroll
            for (int k = 0; k < 4; ++k) {
                int e = q[12 + k] - 42;
#pragma unroll
                for (int i = 0; i < 3; ++i) { const int d = e & 3, D = d >= 2 ? d - 4 : d; dg[i][k] = (unsigned)d; e = (e - D) >> 2; }
            }
            u32x3 o;
#pragma unroll
            for (int i = 0; i < 3; ++i) {
                unsigned w = 0;
#pragma unroll
                for (int k = 0; k < 4; ++k) w |= (unsigned)(q[4 * i + k] | (dg[i][k] << 6)) << (8 * k);
                o[i] = w;
            }
            *(u32x3*)(dst + lane * 12) = o;
            if (lane == 0) *scale_out = am * (1.0f / 31.0f);
        };
        for (int e = wave; e < NEXP; e += nwaves) {
            const float4* su4 = (const float4*)(p.peer_u + (size_t)e * D_MODEL + lane * 16);
            const float4* sv4 = (const float4*)(p.peer_v + (size_t)e * D_MODEL + lane * 16);
            float4 a4[4], b4[4];
#pragma unroll
            for (int i = 0; i < 4; ++i) { a4[i] = su4[i]; b4[i] = sv4[i]; }
            float fu[16], fv[16];
#pragma unroll
            for (int i = 0; i < 4; ++i) {
                fu[4 * i] = a4[i].x * g16[4 * i]; fu[4 * i + 1] = a4[i].y * g16[4 * i + 1]; fu[4 * i + 2] = a4[i].z * g16[4 * i + 2]; fu[4 * i + 3] = a4[i].w * g16[4 * i + 3];
                fv[4 * i] = b4[i].x; fv[4 * i + 1] = b4[i].y; fv[4 * i + 2] = b4[i].z; fv[4 * i + 3] = b4[i].w;
            }
            {
                float am = 0.f;
#pragma unroll
                for (int j = 0; j < 16; ++j) am = fmaxf(am, fabsf(fu[j]));
                am = wave_max(am);
                const float inv = am > 0.f ? 127.0f / am : 0.f;
                u32x4 o;
#pragma unroll
                for (int i = 0; i < 4; ++i) {
                    unsigned w = 0;
#pragma unroll
                    for (int k = 0; k < 4; ++k) w |= (unsigned)(((int)rintf(fu[4 * i + k] * inv)) & 0xff) << (8 * k);
                    o[i] = w;
                }
                *(u32x4*)(p.u8 + (size_t)e * D_MODEL + lane * 16) = o;
                if (lane == 0) p.suv[e].x = am * (1.0f / 127.0f);
            }
            quant_row(fv, p.v8 + (size_t)e * ROWB, &p.suv[e].y);
        }
    }
    const int wave = (b * blockDim.x + tid) >> 6, nwaves = (nb * blockDim.x) >> 6, lane = tid & 63;
    for (int t = wave; t < T_TOK; t += 2 * nwaves) {
        const int t1 = t + nwaves; const bool two = t1 < T_TOK;
        const float4* xr0 = (const float4*)(p.x + (size_t)t * D_MODEL);
        const float4* xr1 = (const float4*)(p.x + (size_t)(two ? t1 : t) * D_MODEL);
        float4 v0[4], v1[4];
#pragma unroll
        for (int i = 0; i < 4; ++i) { v0[i] = xr0[lane + 64 * i]; v1[i] = xr1[lane + 64 * i]; }
        float s0 = 0.f, s1 = 0.f, a0 = 0.f, a1 = 0.f;
#pragma unroll
        for (int i = 0; i < 4; ++i) {
            s0 += v0[i].x * v0[i].x + v0[i].y * v0[i].y + v0[i].z * v0[i].z + v0[i].w * v0[i].w;
            s1 += v1[i].x * v1[i].x + v1[i].y * v1[i].y + v1[i].z * v1[i].z + v1[i].w * v1[i].w;
            a0 = fmaxf(fmaxf(a0, fmaxf(fabsf(v0[i].x), fabsf(v0[i].y))), fmaxf(fabsf(v0[i].z), fabsf(v0[i].w)));
            a1 = fmaxf(fmaxf(a1, fmaxf(fabsf(v1[i].x), fabsf(v1[i].y))), fmaxf(fabsf(v1[i].z), fabsf(v1[i].w)));
        }
        s0 = wave_sum(s0); s1 = wave_sum(s1); a0 = wave_max(a0); a1 = wave_max(a1);
        const float i0 = a0 > 0.f ? 127.0f / a0 : 0.f, i1 = a1 > 0.f ? 127.0f / a1 : 0.f;
#pragma unroll
        for (int i = 0; i < 4; ++i) {
            const unsigned q0 = ((unsigned)((int)rintf(v0[i].x * i0) & 0xff)) | ((unsigned)((int)rintf(v0[i].y * i0) & 0xff) << 8) | ((unsigned)((int)rintf(v0[i].z * i0) & 0xff) << 16) | ((unsigned)((int)rintf(v0[i].w * i0) & 0xff) << 24);
            ((unsigned*)(p.xq + (size_t)t * D_MODEL))[lane + 64 * i] = q0;
            if (two) {
                const unsigned q1 = ((unsigned)((int)rintf(v1[i].x * i1) & 0xff)) | ((unsigned)((int)rintf(v1[i].y * i1) & 0xff) << 8) | ((unsigned)((int)rintf(v1[i].z * i1) & 0xff) << 16) | ((unsigned)((int)rintf(v1[i].w * i1) & 0xff) << 24);
                ((unsigned*)(p.xq + (size_t)t1 * D_MODEL))[lane + 64 * i] = q1;
            }
        }
        if (lane == 0) {
            p.rstd1[t] = rsqrtf(s0 * (1.0f / D_MODEL) + EPS) * a0 * (1.0f / 127.0f); p.sx[t] = a0 * (1.0f / 127.0f);
            if (two) { p.rstd1[t1] = rsqrtf(s1 * (1.0f / D_MODEL) + EPS) * a1 * (1.0f / 127.0f); p.sx[t1] = a1 * (1.0f / 127.0f); }
        }
    }
    w8_tiles(p.w_in, p.norm1_g, 1536, p.winT8, p.swb, p.swb + 1536, lds, tid);
    w8_tiles(p.peer_wq, p.norm2_g, 2048, p.wqT8, p.swq, p.swq + 2048, lds, tid);
}

typedef short s16x4 __attribute__((ext_vector_type(4)));
template <class Epi>
__device__ __forceinline__ void gemm128_sgu(const int tid, const bf16_t* __restrict__ A, const bf16_t* __restrict__ V  ,
                                            const float* __restrict__ lnm, const float* __restrict__ lnr, const float* __restrict__ gch, char* lds, const Epi& epi) {
    const int lane = tid & 63, wid = tid >> 6, wr = wid >> 1, wc = wid & 1, fr = lane & 15, fq = lane >> 4;
    constexpr int PITCH = 144, P2 = 288;
    char* sA = lds; char* sB = lds + 128 * PITCH;
    f32x4 acc[4][4];
#pragma unroll
    for (int m = 0; m < 4; ++m)
#pragma unroll
        for (int n = 0; n < 4; ++n) acc[m][n] = (f32x4){0.f, 0.f, 0.f, 0.f};
    u32x4 ra[4], rb[4]; float rm[4], rr[4];
    const int lrow = tid >> 3, lch = tid & 7;
    const int btok = tid >> 4, bch = tid & 15;
    const bf16_t* ga = A + (size_t)lrow * 128 + lch * 8;
    const bf16_t* gb = V + (size_t)btok * D_IN + bch * 8;
    float g8[8];
    { const float4 g0 = *(const float4*)(gch + bch * 8), g1 = *(const float4*)(gch + bch * 8 + 4); g8[0] = g0.x; g8[1] = g0.y; g8[2] = g0.z; g8[3] = g0.w; g8[4] = g1.x; g8[5] = g1.y; g8[6] = g1.z; g8[7] = g1.w; }
#pragma unroll
    for (int j = 0; j < 4; ++j) { ra[j] = *(const u32x4*)(ga + (size_t)(32 * j) * 128); rb[j] = *(const u32x4*)(gb + (size_t)(16 * j) * D_IN); rm[j] = lnm[btok + 16 * j]; rr[j] = lnr[btok + 16 * j]; }
    for (int k0 = 0; k0 < 128; k0 += 64) {
        __syncthreads();
#pragma unroll
        for (int j = 0; j < 4; ++j) {
            *(u32x4*)(sA + (lrow + 32 * j) * PITCH + lch * 16) = ra[j];
            u32x4 o;
#pragma unroll
            for (int i = 0; i < 4; ++i) {
                const unsigned w = rb[j][i];
                o[i] = pack2((bflo(w) - rm[j]) * rr[j] * g8[2 * i], (bfhi(w) - rm[j]) * rr[j] * g8[2 * i + 1]);
            }
            *(u32x4*)(sB + (btok + 16 * j) * P2 + bch * 16) = o;
        }
        __syncthreads();
        if (k0 + 64 < 128) {
#pragma unroll
            for (int j = 0; j < 4; ++j) { ra[j] = *(const u32x4*)(ga + (size_t)(32 * j) * 128 + 64); rb[j] = *(const u32x4*)(gb + (size_t)(64 + 16 * j) * D_IN); rm[j] = lnm[64 + btok + 16 * j]; rr[j] = lnr[64 + btok + 16 * j]; }
        }
#pragma unroll
        for (int kk = 0; kk < 2; ++kk) {
            bf16x8 af[4], bfr[4];
#pragma unroll
            for (int m = 0; m < 4; ++m) af[m] = *(const bf16x8*)(sA + (wr * 64 + m * 16 + fr) * PITCH + (kk * 32 + fq * 8) * 2);
#pragma unroll
            for (int n = 0; n < 4; ++n) {
                const char* bp = sB + (kk * 32 + fq * 8 + (fr >> 2)) * P2 + (wc * 64 + n * 16 + 4 * (fr & 3)) * 2;
                const s16x4 lo = __builtin_amdgcn_ds_read_tr16_b64_v4i16((LAS s16x4*)(bp));
                const s16x4 hi = __builtin_amdgcn_ds_read_tr16_b64_v4i16((LAS s16x4*)(bp + 4 * P2));
                bfr[n] = (bf16x8){lo[0], lo[1], lo[2], lo[3], hi[0], hi[1], hi[2], hi[3]};
            }
#pragma unroll
            for (int m = 0; m < 4; ++m)
#pragma unroll
                for (int n = 0; n < 4; ++n) acc[m][n] = __builtin_amdgcn_mfma_f32_16x16x32_bf16(bfr[n], af[m], acc[m][n], 0, 0, 0);
        }
    }
#pragma unroll
    for (int m = 0; m < 4; ++m)
#pragma unroll
        for (int n = 0; n < 4; ++n) epi(wr * 64 + m * 16 + fr, wc * 64 + n * 16 + fq * 4, acc[m][n]);
}

#define PT_PITCH 272
#define MIXH_LDS (2 * 128 * PT_PITCH + 1024)
template <int W, class Epi>
__device__ __forceinline__ void pool_tile(const int tid, const bf16_t* __restrict__ zb0  , int pos0,
                                          const bf16_t* __restrict__ Bt, char* lds, const Epi& epi) {
    const int lane = tid & 63, wid = tid >> 6, wr = wid >> 1, wc = wid & 1, fr = lane & 15, fq = lane >> 4;
    char* sA = lds; char* sB = lds + 128 * PT_PITCH;
    __syncthreads();
#pragma unroll
    for (int j = 0; j < 8; ++j) { const int id = tid + 256 * j, row = id >> 4, ch = id & 15; *(u32x4*)(sB + row * PT_PITCH + ch * 16) = *(const u32x4*)(Bt + (size_t)row * 128 + ch * 8); }
    {
        const int seg = tid >> 5, hc = tid & 31, r0 = seg * 16;
        const bool at_start = (pos0 & (SEQ - 1)) == 0;
        const bf16_t* zp = zb0 + hc * 4;
        u32x2 v[W + 16];
#pragma unroll
        for (int i = 0; i < W + 16; ++i) { const int rr = r0 - W + i; const bool ok = !(at_start && rr < 0); v[i] = *(const u32x2*)(zp + (ptrdiff_t)(ok ? rr : 0) * D_IN); }
        float sm[4] = {0.f, 0.f, 0.f, 0.f};
#pragma unroll
        for (int i = 1; i <= W; ++i) {
            const float m = (at_start && (r0 - W + i) < 0) ? 0.f : 1.f;
            sm[0] += m * bflo(v[i].x); sm[1] += m * bfhi(v[i].x); sm[2] += m * bflo(v[i].y); sm[3] += m * bfhi(v[i].y);
        }
#pragma unroll
        for (int o = 0; o < 16; ++o) {
            if (o > 0) {
                const float md = (at_start && (r0 + o - W) < 0) ? 0.f : 1.f;
                sm[0] += bflo(v[W + o].x) - md * bflo(v[o].x); sm[1] += bfhi(v[W + o].x) - md * bfhi(v[o].x);
                sm[2] += bflo(v[W + o].y) - md * bflo(v[o].y); sm[3] += bfhi(v[W + o].y) - md * bfhi(v[o].y);
            }
            const int pos = (pos0 + r0 + o) & (SEQ - 1);
            const float rn = 1.0f / (float)((pos + 1 < W) ? pos + 1 : W);
            u32x2 ov;
            ov.x = pack2(sm[0] * rn - bflo(v[W + o].x), sm[1] * rn - bfhi(v[W + o].x));
            ov.y = pack2(sm[2] * rn - bflo(v[W + o].y), sm[3] * rn - bfhi(v[W + o].y));
            *(u32x2*)(sA + (r0 + o) * PT_PITCH + hc * 8) = ov;
        }
    }
    __syncthreads();
    f32x4 acc[4][4];
#pragma unroll
    for (int m = 0; m < 4; ++m)
#pragma unroll
        for (int n = 0; n < 4; ++n) acc[m][n] = (f32x4){0.f, 0.f, 0.f, 0.f};
#pragma unroll
    for (int kk = 0; kk < 4; ++kk) {
        bf16x8 af[4], bfr[4];
#pragma unroll
        for (int m = 0; m < 4; ++m) af[m] = *(const bf16x8*)(sA + (wr * 64 + m * 16 + fr) * PT_PITCH + (kk * 32 + fq * 8) * 2);
#pragma unroll
        for (int n = 0; n < 4; ++n) bfr[n] = *(const bf16x8*)(sB + (wc * 64 + n * 16 + fr) * PT_PITCH + (kk * 32 + fq * 8) * 2);
#pragma unroll
        for (int m = 0; m < 4; ++m)
#pragma unroll
            for (int n = 0; n < 4; ++n) acc[m][n] = __builtin_amdgcn_mfma_f32_16x16x32_bf16(bfr[n], af[m], acc[m][n], 0, 0, 0);
    }
#pragma unroll
    for (int m = 0; m < 4; ++m)
#pragma unroll
        for (int n = 0; n < 4; ++n) epi(wr * 64 + m * 16 + fr, wc * 64 + n * 16 + fq * 4, acc[m][n]);
}

__device__ void phase_mix_gemm(const Params& p, char* lds) {
    const int tidx_ = tid_opaque();
    const int npool = (T_TOK / 128) * 4, nsgu = (T_TOK / 128) * 4;
    const int half = tidx_ >> 8, ht = tidx_ & 255; lds += half * MIXH_LDS;
    for (int tile = 2 * blockIdx.x + half; tile < npool + nsgu; tile += 2 * gridDim.x) {
        if (tile < npool) {
            const int tm = tile >> 2, g = tile & 3;
            const float* ps = p.pool_scale + g * 128; bf16_t* co = p.cB + (size_t)tm * 128 * D_MODEL + g * 128;
            const bf16_t* z0 = p.zb + (size_t)tm * 128 * D_IN + g * 128; const bf16_t* bt = p.poolT + (size_t)g * 16384;
            auto epi = [&](int r, int c, f32x4 v) {
                const float4 sc = *(const float4*)(ps + c);
                uint2 o; o.x = pack2(v[0] * sc.x, v[1] * sc.y); o.y = pack2(v[2] * sc.z, v[3] * sc.w);
                *(uint2*)(co + (size_t)r * D_MODEL + c) = o;
            };
            if (g == 0) pool_tile<2>(ht, z0, tm * 128, bt, lds, epi); else if (g == 1) pool_tile<4>(ht, z0, tm * 128, bt, lds, epi);
            else if (g == 2) pool_tile<8>(ht, z0, tm * 128, bt, lds, epi); else pool_tile<16>(ht, z0, tm * 128, bt, lds, epi);
        } else {
            const int t2 = tile - npool, blk = t2 >> 2, h = t2 & 3;
            float* stm = (float*)(lds + GEMM_LDS_BYTES); float* str = stm + 128;
            __syncthreads();
            {
                const int tok = ht >> 1, hh = ht & 1;
                const u32x4* vp = (const u32x4*)(p.zb + (size_t)(blk * 128 + tok) * D_IN + 1024 + hh * 256);
                float s1 = 0.f, s2 = 0.f;
#pragma unroll 8
                for (int i = 0; i < 32; ++i) {
                    const u32x4 v = vp[i];
#pragma unroll
                    for (int k = 0; k < 4; ++k) { const float a = bflo(v[k]), c = bfhi(v[k]); s1 += a + c; s2 += a * a + c * c; }
                }
                s1 += __shfl_xor(s1, 1); s2 += __shfl_xor(s2, 1);
                const float mean = s1 * (1.0f / 512.0f), var = fmaxf(s2 * (1.0f / 512.0f) - mean * mean, 0.f);
                if (hh == 0) { stm[tok] = mean; str[tok] = rsqrtf(var + EPS); }
            }
            __syncthreads();
            const float* sb = p.sgu_b + h * 128; const bf16_t* uo = p.zb + (size_t)blk * 128 * D_IN + 512 + h * 128;
            bf16_t* co = p.cB + (size_t)blk * 128 * D_MODEL + 512 + h * 128;
            gemm128_sgu(ht, p.wsM + (size_t)h * 16384, p.zb + (size_t)blk * 128 * D_IN + 1024 + h * 128, stm, str, p.sgu_norm_g + h * 128, lds,
                    [&](int r, int c, f32x4 v) {
                        const float bb = sb[r];
                        const uint2 uu = *(const uint2*)(uo + (size_t)r * D_IN + c);
                        uint2 o;
                        o.x = pack2((v[0] + bb) * bflo(uu.x), (v[1] + bb) * bfhi(uu.x));
                        o.y = pack2((v[2] + bb) * bflo(uu.y), (v[3] + bb) * bfhi(uu.y));
                        *(uint2*)(co + (size_t)r * D_MODEL + c) = o;
                    });
        }
    }
}

__device__ __forceinline__ int wave_sum_i_uniform(int s) {
    s += __builtin_amdgcn_update_dpp(0, s, 0xB1, 0xf, 0xf, false);
    s += __builtin_amdgcn_update_dpp(0, s, 0x4E, 0xf, 0xf, false);
    s += __builtin_amdgcn_update_dpp(0, s, 0x141, 0xf, 0xf, false);
    s += __builtin_amdgcn_update_dpp(0, s, 0x140, 0xf, 0xf, false);
    return __builtin_amdgcn_readlane(s, 0) + __builtin_amdgcn_readlane(s, 16) + __builtin_amdgcn_readlane(s, 32) + __builtin_amdgcn_readlane(s, 48);
}
__constant__ unsigned char kComb[64] = {
    0x00,0x01,0x02,0x03,0x04,0x05,0x06,0x07,0x08,0x09,0x0a,0x0b,0x0c,0x0d,0x0e,0x0f,
    0x10,0x11,0x12,0x13,0x14,0x15,0x16,0x17,
    0x20,0x21,0x22,0x23,0x24,
    0x30,0x31,0x32,0x33,
    0x40,0x41,0x42,
    0x50,0x51,
    0x60,0x61,
    0x70,0x71,
    0x80,0x90,0xa0,0xb0,0xc0,0xd0,0xe0,0xf0,
    0xff,0xff,0xff,0xff,0xff,0xff,0xff,0xff,0xff,0xff,0xff,0xff,0xff,0xff};

template <int CTRL> __device__ __forceinline__ int dpp_i(int v) { return __builtin_amdgcn_update_dpp(0, v, CTRL, 0xf, 0xf, false); }
__device__ __forceinline__ int row_allmax_i(int v) {
    v = max(v, dpp_i<0x128>(v)); v = max(v, dpp_i<0x124>(v)); v = max(v, dpp_i<0x122>(v)); v = max(v, dpp_i<0x121>(v));
    return v;
}
__device__ __forceinline__ float row_allsum_f(float v) {
    v += __int_as_float(dpp_i<0x128>(__float_as_int(v))); v += __int_as_float(dpp_i<0x124>(__float_as_int(v)));
    v += __int_as_float(dpp_i<0x122>(__float_as_int(v))); v += __int_as_float(dpp_i<0x121>(__float_as_int(v)));
    return v;
}
__device__ __forceinline__ int f2key(float f) { const int b = __float_as_int(f); return b ^ ((b >> 31) & 0x7fffffff); }
__device__ __forceinline__ float key2f(int k) { return __int_as_float(k ^ ((k >> 31) & 0x7fffffff)); }
#define KEY_MIN ((int)0x80000000)
#define CE(a, b) { const int hi_ = max(a, b), lo_ = min(a, b); a = hi_; b = lo_; }
__device__ __forceinline__ int top16_rows(int (&k)[8], int l15) {
    CE(k[0], k[1]) CE(k[2], k[3]) CE(k[4], k[5]) CE(k[6], k[7])
    CE(k[0], k[2]) CE(k[1], k[3]) CE(k[4], k[6]) CE(k[5], k[7])
    CE(k[1], k[2]) CE(k[5], k[6])
    CE(k[0], k[4]) CE(k[1], k[5]) CE(k[2], k[6]) CE(k[3], k[7])
    CE(k[2], k[4]) CE(k[3], k[5])
    CE(k[1], k[2]) CE(k[3], k[4]) CE(k[5], k[6])
    int res = KEY_MIN;
#pragma unroll
    for (int r = 0; r < 16; ++r) {
        const int m = row_allmax_i(k[0]);
        const bool own = (k[0] == m);
#pragma unroll
        for (int j = 0; j < 7; ++j) k[j] = own ? k[j + 1] : k[j];
        k[7] = own ? KEY_MIN : k[7];
        res = (l15 == r) ? m : res;
    }
    return res;
}
__device__ __forceinline__ void combine16(int A, int B, const int (&cbv)[4], int lane, int l15, int& eid_out, float& gate_out) {
    const int rowbase = lane & 48;
    int ck[4], eid[4];
#pragma unroll
    for (int c = 0; c < 4; ++c) {
        const int ci = (cbv[c] >> 4) & 15, cj = cbv[c] & 15;
        const int ka = __builtin_amdgcn_ds_bpermute((rowbase + ci) << 2, A);
        const int kb = __builtin_amdgcn_ds_bpermute((rowbase + cj) << 2, B);
        const float sm = key2f(ka & ~127) + key2f(kb & ~127);
        eid[c] = ((127 - (ka & 127)) << 7) | (127 - (kb & 127));
        ck[c] = (cbv[c] != 0xff) ? ((f2key(sm) & ~63) | (63 - (4 * l15 + c))) : KEY_MIN;
    }
    CE(ck[0], ck[1]) CE(ck[2], ck[3]) CE(ck[0], ck[2]) CE(ck[1], ck[3]) CE(ck[1], ck[2])
    int res = KEY_MIN;
#pragma unroll
    for (int r = 0; r < 16; ++r) {
        const int m = row_allmax_i(ck[0]);
        const bool own = (ck[0] == m);
        ck[0] = own ? ck[1] : ck[0]; ck[1] = own ? ck[2] : ck[1]; ck[2] = own ? ck[3] : ck[2]; ck[3] = own ? KEY_MIN : ck[3];
        res = (l15 == r) ? m : res;
    }
    const int slot = 63 - (res & 63);
    const int src = (rowbase + (slot >> 2)) << 2;
    const int e0 = __builtin_amdgcn_ds_bpermute(src, eid[0]), e1 = __builtin_amdgcn_ds_bpermute(src, eid[1]);
    const int e2 = __builtin_amdgcn_ds_bpermute(src, eid[2]), e3 = __builtin_amdgcn_ds_bpermute(src, eid[3]);
    const int sel = slot & 3;
    eid_out = sel == 0 ? e0 : (sel == 1 ? e1 : (sel == 2 ? e2 : e3));
    gate_out = key2f(res & ~63);
}

__device__ __forceinline__ int reduce16_rows(const int (&part)[16], bool b3, bool b2, bool b1, bool b0b) {
    int r8[8], r4[4], r2[2];
#pragma unroll
    for (int k = 0; k < 8; ++k) { const int keep = b3 ? part[8 + k] : part[k], send = b3 ? part[k] : part[8 + k]; r8[k] = keep + __builtin_amdgcn_update_dpp(0, send, 0x140, 0xf, 0xf, false); }
#pragma unroll
    for (int k = 0; k < 4; ++k) { const int keep = b2 ? r8[4 + k] : r8[k], send = b2 ? r8[k] : r8[4 + k]; r4[k] = keep + __builtin_amdgcn_update_dpp(0, send, 0x141, 0xf, 0xf, false); }
#pragma unroll
    for (int k = 0; k < 2; ++k) { const int keep = b1 ? r4[2 + k] : r4[k], send = b1 ? r4[k] : r4[2 + k]; r2[k] = keep + __builtin_amdgcn_update_dpp(0, send, 0x4E, 0xf, 0xf, false); }
    const int keep = b0b ? r2[1] : r2[0], send = b0b ? r2[0] : r2[1];
    int r1 = keep + __builtin_amdgcn_update_dpp(0, send, 0xB1, 0xf, 0xf, false);
    r1 += __shfl_xor(r1, 16); r1 += __shfl_xor(r1, 32);
    return r1;
}
__device__ void phase_hquant(const Params& p, char* lds) {
    const int tid = tid_opaque();
    const int wave = __builtin_amdgcn_readfirstlane((int)((blockIdx.x * blockDim.x + tid) >> 6)), nwaves = (gridDim.x * blockDim.x) >> 6, lane = tid & 63;
    for (int t = wave; t < T_TOK; t += 2 * nwaves) {
        const int t1 = t + nwaves; const bool two = t1 < T_TOK;
        const u32x4* h0 = (const u32x4*)(p.hb + (size_t)t * D_MODEL); const u32x4* h1 = (const u32x4*)(p.hb + (size_t)(two ? t1 : t) * D_MODEL);
        u32x4 r[2][2] = {{h0[2 * lane], h0[2 * lane + 1]}, {h1[2 * lane], h1[2 * lane + 1]}};
#pragma unroll
        for (int q = 0; q < 2; ++q) {
            const u32x4 a = r[q][0], c = r[q][1];
            const float f[16] = {bflo(a.x), bfhi(a.x), bflo(a.y), bfhi(a.y), bflo(a.z), bfhi(a.z), bflo(a.w), bfhi(a.w),
                                 bflo(c.x), bfhi(c.x), bflo(c.y), bfhi(c.y), bflo(c.z), bfhi(c.z), bflo(c.w), bfhi(c.w)};
            float ss = 0.f, am = 0.f;
#pragma unroll
            for (int k = 0; k < 16; ++k) { ss += f[k] * f[k]; am = fmaxf(am, fabsf(f[k])); }
            ss = wave_sum(ss); am = wave_max(am);
            const float inv = am > 0.f ? 127.0f / am : 0.f;
            u32x4 o;
#pragma unroll
            for (int i = 0; i < 4; ++i) {
                unsigned w = 0;
#pragma unroll
                for (int k = 0; k < 4; ++k) w |= (unsigned)((int)rintf(f[4 * i + k] * inv) & 0xff) << (8 * k);
                o[i] = w;
            }
            const int tt = q ? t1 : t;
            if (q == 0 || two) {
                ((u32x4*)(p.hq + (size_t)tt * D_MODEL))[lane] = o;
                if (lane == 0) p.hsc[tt] = am * (1.0f / 127.0f) * rsqrtf(ss * (1.0f / D_MODEL) + EPS);
            }
        }
    }
}

#define TS_WBYTES (16384 + 128)
__device__ void phase_peer_dots(const Params& p, char* lds) {
    const int tidx_ = tid_opaque();
    const int lane = tidx_ & 63, wid = __builtin_amdgcn_readfirstlane((int)(tidx_ >> 6)), l15 = lane & 15;
    const bool b3 = (lane & 8) != 0, b2 = (lane & 4) != 0, b1 = (lane & 2) != 0, b0b = (lane & 1) != 0;
    const int gw = blockIdx.x * (blockDim.x >> 6) + wid, ngw = gridDim.x * (blockDim.x >> 6);
    char* wl = lds + wid * TS_WBYTES;
    unsigned* list = (unsigned*)wl; int* dotsl = (int*)(wl + 4096); char* hql = wl + 8192; int* tks = (int*)(wl + 16384);
    const unsigned lane16 = (unsigned)lane * 16u;
    for (int tb = gw * 8; tb < T_TOK; tb += ngw * 8) {
#pragma unroll
        for (int j = 0; j < 8; ++j) *(u32x4*)(hql + j * 1024 + lane * 16) = ((const u32x4*)(p.hq + (size_t)(tb + j) * D_MODEL))[lane];
        if (lane < 8) tks[lane] = __float_as_int(p.hsc[tb + lane]);
        int idv[8][2];
#pragma unroll
        for (int j = 0; j < 8; ++j) { const int* ir = p.idx + (size_t)(tb + j) * 128; idv[j][0] = ir[lane]; idv[j][1] = ir[64 + lane]; }
#pragma unroll 1
        for (int x = 0; x < 8; ++x) {
            int n = 0;
#pragma unroll
            for (int j = 0; j < 8; ++j)
#pragma unroll
                for (int r = 0; r < 2; ++r) {
                    const int e = idv[j][r];
                    const bool in = (e >> 11) == x;
                    const unsigned long long mk = __ballot(in);
                    const int rank = (int)__builtin_amdgcn_mbcnt_hi((unsigned)(mk >> 32), __builtin_amdgcn_mbcnt_lo((unsigned)mk, 0u));
                    if (in) list[n + rank] = ((unsigned)j << 21) | ((unsigned)(r * 64 + lane) << 14) | (unsigned)e;
                    n += (int)__builtin_popcountll(mk);
                }
            asm volatile("s_waitcnt lgkmcnt(0)" ::: "memory");
            u32x4 ua[16], ubf[16]; int enta = 0, entb = 0;
            auto issue = [&](int b0, u32x4 (&uu)[16], int& entv) {
                const int i = (b0 + l15 < n) ? b0 + l15 : n - 1;
                entv = (int)list[i];
#pragma unroll
                for (int j = 0; j < 16; ++j) { const int e = __builtin_amdgcn_readlane(entv, j) & 0x3fff; uu[j] = *(const u32x4*)(p.u8 + (size_t)e * D_MODEL + lane16); }
            };
            auto reduce = [&](int b0, const u32x4 (&uu)[16], int entv) {
                int part[16];
#pragma unroll
                for (int j = 0; j < 16; ++j) {
                    const int tl = __builtin_amdgcn_readlane(entv, j) >> 21;
                    const u32x4 hqv = *(const u32x4*)(hql + tl * 1024 + lane * 16);
                    int sacc = __builtin_amdgcn_sdot4((int)uu[j].x, (int)hqv.x, 0, false);
                    sacc = __builtin_amdgcn_sdot4((int)uu[j].y, (int)hqv.y, sacc, false);
                    sacc = __builtin_amdgcn_sdot4((int)uu[j].z, (int)hqv.z, sacc, false);
                    part[j] = __builtin_amdgcn_sdot4((int)uu[j].w, (int)hqv.w, sacc, false);
                }
                const int r1 = reduce16_rows(part, b3, b2, b1, b0b);
                if (lane < 16 && b0 + lane < n) dotsl[((unsigned)entv >> 21) * 128 + (((unsigned)entv >> 14) & 127u)] = r1;
            };
            if (n > 0) issue(0, ua, enta);
            for (int b0 = 0; b0 < n; b0 += 32) {
                if (b0 + 16 < n) issue(b0 + 16, ubf, entb);
                reduce(b0, ua, enta);
                if (b0 + 16 < n) {
                    if (b0 + 32 < n) issue(b0 + 32, ua, enta);
                    reduce(b0 + 16, ubf, entb);
                }
            }
            asm volatile("s_waitcnt lgkmcnt(0)" ::: "memory");
        }
#pragma unroll
        for (int j = 0; j < 8; ++j) {
            const float cs_t = __int_as_float(tks[j]), r2_t = cs_t;
            const float* gr = p.gate + (size_t)(tb + j) * 128; float* cr = p.coef + (size_t)(tb + j) * 128;
#pragma unroll
            for (int r = 0; r < 2; ++r) {
                const int e = idv[j][r];
                const float sc = gr[r * 64 + lane] * r2_t;
                const float ex = __expf(sc - key2f(row_allmax_i(f2key(sc))));
                const float gt = ex / row_allsum_f(ex);
                const float2 sc2 = p.suv[e];
                const float dotf = (float)dotsl[j * 128 + r * 64 + lane] * cs_t * sc2.x;
                cr[r * 64 + lane] = gt * gelu_t(dotf) * sc2.y;
            }
        }
        asm volatile("s_waitcnt lgkmcnt(0)" ::: "memory");
    }
}

__device__ void phase_gather(const Params& p, char* lds) {
    const int tidx_ = tid_opaque();
    const int wave = __builtin_amdgcn_readfirstlane((int)((blockIdx.x * blockDim.x + tidx_) >> 6)), nwaves = (gridDim.x * blockDim.x) >> 6, lane = tidx_ & 63;
    const unsigned char* vb = p.v8 + lane * 12;
    for (int t = wave; t < T_TOK; t += nwaves) {
        int idr[2]; float coef[2];
        { const int* ir = p.idx + (size_t)t * 128; idr[0] = ir[lane]; idr[1] = ir[64 + lane]; }
        { const float* cr = p.coef + (size_t)t * 128; coef[0] = cr[lane]; coef[1] = cr[64 + lane]; }
        const float cmax = wave_max(fmaxf(fabsf(coef[0]), fabsf(coef[1])));
        const float qs = cmax > 0.f ? 127.0f / cmax : 0.f, cscale = cmax * (1.0f / 127.0f);
        const int cq0 = (int)rintf(coef[0] * qs), cq1 = (int)rintf(coef[1] * qs);
        const int csum_i = wave_sum_i_uniform(cq0 + cq1);
        unsigned cpk[2];
        {
            const int cqs[2] = {cq0, cq1};
#pragma unroll
            for (int hf = 0; hf < 2; ++hf) {
                const int bb = cqs[hf] & 0xff;
                cpk[hf] = (unsigned)__builtin_amdgcn_update_dpp(0, bb, 0x00, 0xf, 0xf, false) | ((unsigned)__builtin_amdgcn_update_dpp(0, bb, 0x55, 0xf, 0xf, false) << 8)
                        | ((unsigned)__builtin_amdgcn_update_dpp(0, bb, 0xAA, 0xf, 0xf, false) << 16) | ((unsigned)__builtin_amdgcn_update_dpp(0, bb, 0xFF, 0xf, 0xf, false) << 24);
            }
        }
        int racc[12], jacc[12];
#pragma unroll
        for (int j = 0; j < 12; ++j) { racc[j] = 0; jacc[j] = 0; }
        {
            u32x3 va[8], vbf[8];
            auto issue = [&](int pb, u32x3 (&vv)[8]) {
#pragma unroll
                for (int q = 0; q < 8; ++q) { const int e = __builtin_amdgcn_readlane(pb < 64 ? idr[0] : idr[1], (pb & 63) + q); vv[q] = *(const u32x3*)(vb + (size_t)e * ROWB); }
            };
            auto axpy = [&](int pb, const u32x3 (&vv)[8]) {
#pragma unroll
                for (int g4 = 0; g4 < 2; ++g4) {
                    const int cqd = __builtin_amdgcn_readlane((int)(pb < 64 ? cpk[0] : cpk[1]), (pb & 63) + 4 * g4);
#pragma unroll
                    for (int i = 0; i < 3; ++i) {
                        const unsigned wa = vv[4 * g4 + 0][i], wb = vv[4 * g4 + 1][i], wc = vv[4 * g4 + 2][i], wd = vv[4 * g4 + 3][i];
                        const unsigned p0 = __builtin_amdgcn_perm(wb, wa, 0x05010400u), p1 = __builtin_amdgcn_perm(wb, wa, 0x07030602u);
                        const unsigned q0 = __builtin_amdgcn_perm(wd, wc, 0x05010400u), q1 = __builtin_amdgcn_perm(wd, wc, 0x07030602u);
                        const unsigned t0 = __builtin_amdgcn_perm(q0, p0, 0x05040100u), t1 = __builtin_amdgcn_perm(q0, p0, 0x07060302u);
                        const unsigned t2 = __builtin_amdgcn_perm(q1, p1, 0x05040100u), t3 = __builtin_amdgcn_perm(q1, p1, 0x07060302u);
                        racc[4 * i + 0] = __builtin_amdgcn_sdot4((int)t0, cqd, racc[4 * i + 0], false); jacc[4 * i + 0] = __builtin_amdgcn_sdot4((int)(t0 & 0xc0c0c0c0u), cqd, jacc[4 * i + 0], false);
                        racc[4 * i + 1] = __builtin_amdgcn_sdot4((int)t1, cqd, racc[4 * i + 1], false); jacc[4 * i + 1] = __builtin_amdgcn_sdot4((int)(t1 & 0xc0c0c0c0u), cqd, jacc[4 * i + 1], false);
                        racc[4 * i + 2] = __builtin_amdgcn_sdot4((int)t2, cqd, racc[4 * i + 2], false); jacc[4 * i + 2] = __builtin_amdgcn_sdot4((int)(t2 & 0xc0c0c0c0u), cqd, jacc[4 * i + 2], false);
                        racc[4 * i + 3] = __builtin_amdgcn_sdot4((int)t3, cqd, racc[4 * i + 3], false); jacc[4 * i + 3] = __builtin_amdgcn_sdot4((int)(t3 & 0xc0c0c0c0u), cqd, jacc[4 * i + 3], false);
                    }
                }
            };
            issue(0, va);
#pragma unroll 1
            for (int pb = 0; pb < 128; pb += 16) {
                issue(pb + 8, vbf);
                axpy(pb, va);
                if (pb + 16 < 128) issue(pb + 16, va);
                axpy(pb + 8, vbf);
            }
        }
        int acc[16];
#pragma unroll
        for (int j = 0; j < 12; ++j) acc[j] = (racc[j] - jacc[j]) - 32 * csum_i;
#pragma unroll
        for (int k = 0; k < 4; ++k) acc[12 + k] = ((jacc[k] + 4 * jacc[4 + k] + 16 * jacc[8 + k]) >> 6) + 10 * csum_i;
        const u32x4* hr = (const u32x4*)(p.hb + (size_t)t * D_MODEL + lane * 16);
        const u32x4 ha = hr[0], hc = hr[1];
        const float hf16[16] = {bflo(ha.x), bfhi(ha.x), bflo(ha.y), bfhi(ha.y), bflo(ha.z), bfhi(ha.z), bflo(ha.w), bfhi(ha.w),
                                bflo(hc.x), bfhi(hc.x), bflo(hc.y), bfhi(hc.y), bflo(hc.z), bfhi(hc.z), bflo(hc.w), bfhi(hc.w)};
        float res[16];
        float ss = 0.f;
#pragma unroll
        for (int j = 0; j < 16; ++j) { res[j] = hf16[j] + cscale * (float)acc[j]; ss += res[j] * res[j]; }
        ss = wave_sum(ss);
        const float r3 = rsqrtf(ss * (1.0f / D_MODEL) + EPS);
        float* o = p.out + (size_t)t * D_MODEL + lane * 16;
        const float* fg = p.final_g + lane * 16;
#pragma unroll
        for (int i = 0; i < 4; ++i) {
            const float4 g = ((const float4*)fg)[i];
            float4 ov; ov.x = res[4 * i] * r3 * g.x; ov.y = res[4 * i + 1] * r3 * g.y; ov.z = res[4 * i + 2] * r3 * g.z; ov.w = res[4 * i + 3] * r3 * g.w;
            ((float4*)o)[i] = ov;
        }
    }
}

namespace pg8 {
#define PG8_LAS __attribute__((address_space(3)))
constexpr int BM = 256, BK = 64, HALF = 128, HTB = HALF * BK * 2, STAGE_BYTES = 8 * HTB, NXCD = 8, WGM = 8;
__host__ __device__ __forceinline__ int lds_byte(int r, int c) { const int st = (r >> 4) * 2 + (c >> 5), rr = r & 15, cc = c & 31, ob = rr * 64 + cc * 2; return st * 1024 + (ob ^ (((ob >> 9) & 1) << 5)); }
__host__ __device__ __forceinline__ void stage_rc(int b, int& R, int& C) { const int st = b / 1024, sb = b % 1024, swz = sb ^ (((sb >> 9) & 1) << 5); R = (st >> 1) * 16 + swz / 64; C = (st & 1) * 32 + (swz % 64) / 2; }
__host__ __device__ __forceinline__ int perm32(int rho) { const int n = rho >> 4, i = rho & 15; return 8 * (i >> 2) + 4 * n + (i & 3); }
struct Unit { int pm, pn; };
struct Gemm { const bf16_t* A; const bf16_t* Bt; int M, N, K; };
struct StaticOrder {
    int nM, nN, nwg, G, c;
    __host__ __device__ void init(int M, int N, int G_, int c_) { nM = M / BM; nN = N / BM; nwg = nM * nN; G = G_; c = c_; }
    __host__ __device__ bool next(int i, Unit& u) const {
        const long L = (long)i * G + c; if (L >= nwg) return false;
        int wgid = (int)L; { const int q = nwg / NXCD, r = nwg % NXCD, xcd = wgid % NXCD, off = wgid / NXCD; wgid = (xcd < r ? xcd * (q + 1) : r * (q + 1) + (xcd - r) * q) + off; }
        const int nig = WGM * nN, gid = wgid / nig, fm = gid * WGM, gsz = (nM - fm) < WGM ? (nM - fm) : WGM;
        u.pm = fm + ((wgid % nig) % gsz); u.pn = (wgid % nig) / gsz; return true;
    }
    __device__ __forceinline__ void a_ready(const Unit&) const {}
    __device__ __forceinline__ void done(const Unit&) const {}
};
__device__ __forceinline__ unsigned cvt_pk_bf16(float lo, float hi) { unsigned r; asm volatile("v_cvt_pk_bf16_f32 %0, %1, %2" : "=v"(r) : "v"(lo), "v"(hi)); return r; }
template <bool I8> __device__ __forceinline__ typename std::conditional<I8, i32x4, f32x4>::type mma1(bf16x8 a, bf16x8 b, typename std::conditional<I8, i32x4, f32x4>::type c) {
    if constexpr (I8) return __builtin_amdgcn_mfma_i32_16x16x64_i8(*(const i32x4*)&a, *(const i32x4*)&b, c, 0, 0, 0);
    else return __builtin_amdgcn_mfma_f32_16x16x32_bf16(a, b, c, 0, 0, 0);
}
struct EpiZ8 {
    static constexpr bool PERM = true, AFTER_DRAIN = false, I8 = true; typedef i32x4 acc_t;
    bf16_t* O; const float* rsx; const unsigned* swb;
    __device__ __forceinline__ void operator()(const i32x4 (&acc)[2][2][4][2], const Unit& u, int wr, int wc, int fr, int fq) const {
        const int row0 = u.pm * BM + wr * 64 + fr, col0 = u.pn * BM + wc * 32 + 8 * fq; const bool act = u.pn >= 2;
        float sw[2][8];
#pragma unroll
        for (int bj = 0; bj < 2; ++bj) { const u32x4 a = *(const u32x4*)(swb + col0 + bj * HALF), c = *(const u32x4*)(swb + col0 + bj * HALF + 4);
#pragma unroll
            for (int i = 0; i < 4; ++i) { sw[bj][i] = __uint_as_float(a[i]) * (1.0f / 127.0f); sw[bj][4 + i] = __uint_as_float(c[i]) * (1.0f / 127.0f); } }
#pragma unroll
        for (int ai = 0; ai < 2; ++ai)
#pragma unroll
            for (int m = 0; m < 4; ++m) { const int r = row0 + ai * HALF + m * 16; const float sc = rsx[r]; bf16_t* rowp = O + (size_t)r * D_IN + col0;
#pragma unroll
                for (int bj = 0; bj < 2; ++bj) { f32x4 v0, v1;
#pragma unroll
                    for (int i = 0; i < 4; ++i) { v0[i] = (float)acc[ai][bj][m][0][i] * sc * sw[bj][i]; v1[i] = (float)acc[ai][bj][m][1][i] * sc * sw[bj][4 + i]; }
                    if (act) { v0 = (f32x4){gelu_t(v0[0]), gelu_t(v0[1]), gelu_t(v0[2]), gelu_t(v0[3])}; v1 = (f32x4){gelu_t(v1[0]), gelu_t(v1[1]), gelu_t(v1[2]), gelu_t(v1[3])}; }
                    u32x4 w; w.x = cvt_pk_bf16(v0[0], v0[1]); w.y = cvt_pk_bf16(v0[2], v0[3]); w.z = cvt_pk_bf16(v1[0], v1[1]); w.w = cvt_pk_bf16(v1[2], v1[3]);
                    *(u32x4*)(rowp + bj * HALF) = w; } }
    }
};
struct EpiZ {
    static constexpr bool PERM = true, AFTER_DRAIN = false, I8 = false; typedef f32x4 acc_t;
    bf16_t* O; const float* rs;
    __device__ __forceinline__ void operator()(const f32x4 (&acc)[2][2][4][2], const Unit& u, int wr, int wc, int fr, int fq) const {
        const int row0 = u.pm * BM + wr * 64 + fr, col0 = u.pn * BM + wc * 32 + 8 * fq; const bool act = u.pn >= 2;
#pragma unroll
        for (int ai = 0; ai < 2; ++ai)
#pragma unroll
            for (int m = 0; m < 4; ++m) { const int r = row0 + ai * HALF + m * 16; const float sc = rs[r]; bf16_t* rowp = O + (size_t)r * D_IN + col0;
#pragma unroll
                for (int bj = 0; bj < 2; ++bj) { f32x4 v0 = acc[ai][bj][m][0] * sc, v1 = acc[ai][bj][m][1] * sc;
                    if (act) { v0 = (f32x4){gelu_t(v0[0]), gelu_t(v0[1]), gelu_t(v0[2]), gelu_t(v0[3])}; v1 = (f32x4){gelu_t(v1[0]), gelu_t(v1[1]), gelu_t(v1[2]), gelu_t(v1[3])}; }
                    u32x4 w; w.x = cvt_pk_bf16(v0[0], v0[1]); w.y = cvt_pk_bf16(v0[2], v0[3]); w.z = cvt_pk_bf16(v1[0], v1[1]); w.w = cvt_pk_bf16(v1[2], v1[3]);
                    *(u32x4*)(rowp + bj * HALF) = w; } }
    }
};
struct EpiOut {
    static constexpr bool PERM = true, AFTER_DRAIN = false, I8 = false; typedef f32x4 acc_t;
    bf16_t* O; const signed char* X; const float* sx;
    __device__ __forceinline__ void operator()(const f32x4 (&acc)[2][2][4][2], const Unit& u, int wr, int wc, int fr, int fq) const {
        const int row0 = u.pm * BM + wr * 64 + fr, col0 = u.pn * BM + wc * 32 + 8 * fq;
#pragma unroll
        for (int ai = 0; ai < 2; ++ai)
#pragma unroll
            for (int m = 0; m < 4; ++m) { const int r = row0 + ai * HALF + m * 16; const size_t off = (size_t)r * D_MODEL + col0; const float sc = sx[r];
#pragma unroll
                for (int bj = 0; bj < 2; ++bj) { const u32x2 xx = *(const u32x2*)(X + off + bj * HALF);
                    f32x4 x0, x1;
#pragma unroll
                    for (int i = 0; i < 4; ++i) { x0[i] = (float)(signed char)(xx.x >> (8 * i)) * sc; x1[i] = (float)(signed char)(xx.y >> (8 * i)) * sc; }
                    const f32x4 v0 = acc[ai][bj][m][0] + x0, v1 = acc[ai][bj][m][1] + x1;
                    u32x4 w; w.x = cvt_pk_bf16(v0[0], v0[1]); w.y = cvt_pk_bf16(v0[2], v0[3]); w.z = cvt_pk_bf16(v1[0], v1[1]); w.w = cvt_pk_bf16(v1[2], v1[3]);
                    *(u32x4*)(O + off + bj * HALF) = w; } }
    }
};
struct OneUnit {
    Unit u;
    __device__ __forceinline__ bool next(int i, Unit& o) const { if (i) return false; o = u; return true; }
    __device__ __forceinline__ void a_ready(const Unit&) const {}
    __device__ __forceinline__ void done(const Unit&) const {}
};
#define QT_PITCH 272
#define QT_LDS_BYTES (2 * 256 * QT_PITCH)
struct EpiQTopk {
    static constexpr bool PERM = true, AFTER_DRAIN = true, I8 = true; typedef i32x4 acc_t;
    const bf16_t* keysB; int* idx; float* gate; const unsigned* swq;
    __device__ __forceinline__ void fused(i32x4 (&acc)[2][2][4][2], const Unit& u, int wr, int wc, int fr, int fq, PG8_LAS unsigned char* ldsp, int wid, int lane) const {
        char* sQ = (char*)ldsp;
        const int h = u.pn;
        float sw[2][8];
#pragma unroll
        for (int bj = 0; bj < 2; ++bj) { const u32x4 a = *(const u32x4*)(swq + u.pn * BM + bj * HALF + wc * 32 + 8 * fq), c = *(const u32x4*)(swq + u.pn * BM + bj * HALF + wc * 32 + 8 * fq + 4);
#pragma unroll
            for (int i = 0; i < 4; ++i) { sw[bj][i] = __uint_as_float(a[i]) * (1.0f / 127.0f); sw[bj][4 + i] = __uint_as_float(c[i]) * (1.0f / 127.0f); } }
#pragma unroll
        for (int ai = 0; ai < 2; ++ai)
#pragma unroll
            for (int m = 0; m < 4; ++m) { const int r = ai * HALF + wr * 64 + m * 16 + fr;
#pragma unroll
                for (int bj = 0; bj < 2; ++bj) { f32x4 v0, v1;
#pragma unroll
                    for (int i = 0; i < 4; ++i) { v0[i] = (float)acc[ai][bj][m][0][i] * sw[bj][i]; v1[i] = (float)acc[ai][bj][m][1][i] * sw[bj][4 + i]; }
                    u32x4 w; w.x = cvt_pk_bf16(v0[0], v0[1]); w.y = cvt_pk_bf16(v0[2], v0[3]); w.z = cvt_pk_bf16(v1[0], v1[1]); w.w = cvt_pk_bf16(v1[2], v1[3]);
                    *(u32x4*)(sQ + bj * (256 * QT_PITCH) + r * QT_PITCH + (wc * 32 + fq * 8) * 2) = w; } }
        __syncthreads();
        int cbv[4];
#pragma unroll
        for (int c = 0; c < 4; ++c) cbv[c] = kComb[4 * fr + c];
        int tA[2][4], tB[2][4];
#pragma unroll
        for (int m = 0; m < 2; ++m)
#pragma unroll
            for (int j = 0; j < 4; ++j) { tA[m][j] = 0; tB[m][j] = 0; }
#pragma unroll 1
        for (int pp = 0; pp < 2; ++pp) {
            const bf16_t* kb = keysB + (size_t)(pp * 8 + h) * 16384 + lane * 8;
            const char* qa = sQ + pp * (256 * QT_PITCH) + (wid * 32 + fr) * QT_PITCH + fq * 16;
            f32x4 sc2[2][8];
#pragma unroll
            for (int m = 0; m < 2; ++m)
#pragma unroll
                for (int nb = 0; nb < 8; ++nb) sc2[m][nb] = (f32x4){0.f, 0.f, 0.f, 0.f};
#pragma unroll
            for (int kk = 0; kk < 4; ++kk) {
                bf16x8 kf[8], af[2];
#pragma unroll
                for (int nb = 0; nb < 8; ++nb) kf[nb] = *(const bf16x8*)(kb + (kk * 8 + nb) * 512);
#pragma unroll
                for (int m = 0; m < 2; ++m) af[m] = *(const bf16x8*)(qa + m * 16 * QT_PITCH + kk * 64);
#pragma unroll
                for (int m = 0; m < 2; ++m)
#pragma unroll
                    for (int nb = 0; nb < 8; ++nb) sc2[m][nb] = __builtin_amdgcn_mfma_f32_16x16x32_bf16(af[m], kf[nb], sc2[m][nb], 0, 0, 0);
            }
#pragma unroll
            for (int m = 0; m < 2; ++m)
#pragma unroll
                for (int j = 0; j < 4; ++j) tA[m][j] = tB[m][j];
#pragma unroll 2
            for (int it = 0; it < 4; ++it) {
#pragma unroll
                for (int m = 0; m < 2; ++m) {
                    int k[8];
#pragma unroll
                    for (int nb = 0; nb < 8; ++nb) k[nb] = (f2key(sc2[m][nb][0]) & ~127) | (127 - (16 * nb + fr));
                    const int r = top16_rows(k, fr);
                    tB[m][0] = tB[m][1]; tB[m][1] = tB[m][2]; tB[m][2] = tB[m][3]; tB[m][3] = r;
#pragma unroll
                    for (int nb = 0; nb < 8; ++nb) sc2[m][nb] = (f32x4){sc2[m][nb][1], sc2[m][nb][2], sc2[m][nb][3], sc2[m][nb][0]};
                }
            }
        }
#pragma unroll 2
        for (int it = 0; it < 4; ++it) {
#pragma unroll
            for (int m = 0; m < 2; ++m) {
                int eid; float gt;
                combine16(tA[m][0], tB[m][0], cbv, lane, fr, eid, gt);
                const int t = u.pm * BM + wid * 32 + m * 16 + fq * 4 + it;
                const size_t o = (size_t)t * 128 + h * 16 + fr;
                idx[o] = eid; gate[o] = gt;
                tA[m][0] = tA[m][1]; tA[m][1] = tA[m][2]; tA[m][2] = tA[m][3];
                tB[m][0] = tB[m][1]; tB[m][1] = tB[m][2]; tB[m][2] = tB[m][3];
            }
        }
        __syncthreads();
    }
};
template <class Epi, class Sched>
__device__ __forceinline__ void gemm_phase(PG8_LAS unsigned char* lds, const Gemm g, const Sched& S, const Epi& E) {
    const int tid = tid_opaque(), wid = __builtin_amdgcn_readfirstlane(tid >> 6), lane = tid & 63, wr = wid >> 2, wc = wid & 3, fr = lane & 15, fq = lane >> 4;
    const int K = g.K, nt = K / BK;
    unsigned voffA[2], voffB[2];
#pragma unroll
    for (int i = 0; i < 2; ++i) { int R, C; stage_rc(tid * 16 + i * 8192, R, C); const int Rb = Epi::PERM ? ((R & ~31) + perm32(R & 31)) : R;
        voffA[i] = (unsigned)(R * K + C) * 2u; voffB[i] = (unsigned)(Rb * K + C) * 2u; }
    const size_t kstep = (size_t)(BK * 2);
    const size_t hstep = (size_t)HALF * K * 2;
    const size_t tstep = 2 * hstep;
    const unsigned ldsw = (unsigned)wid * 1024u;
    const int aoff = lds_byte(wr * 64 + fr, fq * 8), boff = lds_byte(wc * 32 + fr, fq * 8);
#define PG8_SA(b, h) (((b) * 2 + (h)) * HTB)
#define PG8_SB(b, h) ((4 + (b) * 2 + (h)) * HTB)
#define PG8_STAGE(bufoff, gbase, voff) do { _Pragma("unroll") for (int _i = 0; _i < 2; ++_i) \
        __builtin_amdgcn_global_load_lds((const unsigned*)((const char*)(gbase) + (voff)[_i]), (PG8_LAS unsigned*)(lds + (bufoff) + ldsw + _i * 8192), 16, 0, 0); } while (0)
#define PG8_LDA(dst, b, h) do { _Pragma("unroll") for (int m = 0; m < 4; ++m) _Pragma("unroll") for (int k = 0; k < 2; ++k) dst[m][k] = *(const PG8_LAS bf16x8*)(lds + PG8_SA(b, h) + aoff + m * 2048 + k * 1024); } while (0)
#define PG8_LDB(dst, b, h) do { _Pragma("unroll") for (int n = 0; n < 2; ++n) _Pragma("unroll") for (int k = 0; k < 2; ++k) dst[n][k] = *(const PG8_LAS bf16x8*)(lds + PG8_SB(b, h) + boff + n * 2048 + k * 1024); } while (0)
#define PG8_MMA(ai, bj, At, Bt) do { __builtin_amdgcn_s_setprio(1); _Pragma("unroll") for (int m = 0; m < 4; ++m) _Pragma("unroll") for (int n = 0; n < 2; ++n) _Pragma("unroll") for (int k = 0; k < 2; ++k) \
        acc[ai][bj][m][n] = mma1<Epi::I8>(Bt[n][k], At[m][k], acc[ai][bj][m][n]); __builtin_amdgcn_s_setprio(0); } while (0)
#define PG8_WAIT_V(n) asm volatile("s_waitcnt vmcnt(" #n ")" ::: "memory")
#define PG8_WAIT_L(n) asm volatile("s_waitcnt lgkmcnt(" #n ")" ::: "memory")
#define PG8_BAR __builtin_amdgcn_s_barrier()
#define PG8_SCHED __builtin_amdgcn_sched_barrier(0)
    Unit cur, nxt; int ui = 0;
    if (!S.next(0, cur)) return;
    typedef typename Epi::acc_t acc_t;
    acc_t acc[2][2][4][2];
#pragma unroll
    for (int a = 0; a < 2; ++a)
#pragma unroll
        for (int b = 0; b < 2; ++b)
#pragma unroll
            for (int m = 0; m < 4; ++m)
#pragma unroll
                for (int n = 0; n < 2; ++n) acc[a][b][m][n] = (acc_t)(0);
    bf16x8 At[4][2], B0[2][2], B1[2][2];
    const char* cA = (const char*)g.A + (size_t)cur.pm * tstep; const char* cB = (const char*)g.Bt + (size_t)cur.pn * tstep;
    S.a_ready(cur);
    PG8_STAGE(PG8_SB(0, 0), cB, voffB); PG8_STAGE(PG8_SA(0, 0), cA, voffA); PG8_STAGE(PG8_SB(0, 1), cB + hstep, voffB); PG8_STAGE(PG8_SA(0, 1), cA + hstep, voffA);
    if (wr == 1) PG8_BAR;
    PG8_WAIT_V(4); PG8_BAR;
    PG8_STAGE(PG8_SB(1, 0), cB + kstep, voffB); PG8_STAGE(PG8_SA(1, 0), cA + kstep, voffA); PG8_STAGE(PG8_SB(1, 1), cB + hstep + kstep, voffB);
    PG8_WAIT_V(6); PG8_BAR;
    for (;;) {
        const bool has_next = S.next(ui + 1, nxt);
        const char* nA = has_next ? (const char*)g.A + (size_t)nxt.pm * tstep : cA; const char* nB = has_next ? (const char*)g.Bt + (size_t)nxt.pn * tstep : cB;
        for (int t = 0; t < nt; t += 2) {
            const bool last = (t == nt - 2);
            const char* a1 = cA + (size_t)(t + 1) * kstep;
            const char* a2 = last ? nA : cA + (size_t)(t + 2) * kstep; const char* b2 = last ? nB : cB + (size_t)(t + 2) * kstep;
            const char* a3 = a2 + kstep; const char* b3 = b2 + kstep;
            if (last && has_next) S.a_ready(nxt);
            PG8_LDB(B0, 0, 0); PG8_SCHED; PG8_LDA(At, 0, 0); PG8_STAGE(PG8_SA(1, 1), a1 + hstep, voffA);
            PG8_WAIT_L(8); PG8_BAR; PG8_WAIT_L(0); PG8_MMA(0, 0, At, B0); PG8_BAR; PG8_SCHED;
            PG8_LDB(B1, 0, 1); PG8_STAGE(PG8_SB(0, 0), b2, voffB);
            PG8_BAR; PG8_WAIT_L(0); PG8_MMA(0, 1, At, B1); PG8_BAR;
            PG8_LDA(At, 0, 1); PG8_STAGE(PG8_SA(0, 0), a2, voffA);
            PG8_BAR; PG8_WAIT_L(0); PG8_MMA(1, 0, At, B0); PG8_BAR; PG8_SCHED;
            PG8_STAGE(PG8_SB(0, 1), b2 + hstep, voffB);
            PG8_WAIT_V(6); PG8_BAR; PG8_MMA(1, 1, At, B1); PG8_BAR;
            PG8_LDB(B0, 1, 0); PG8_SCHED; PG8_LDA(At, 1, 0); PG8_STAGE(PG8_SA(0, 1), a2 + hstep, voffA);
            PG8_WAIT_L(8); PG8_BAR; PG8_WAIT_L(0); PG8_MMA(0, 0, At, B0); PG8_BAR; PG8_SCHED;
            PG8_LDB(B1, 1, 1); PG8_STAGE(PG8_SB(1, 0), b3, voffB);
            PG8_BAR; PG8_WAIT_L(0); PG8_MMA(0, 1, At, B1); PG8_BAR;
            PG8_LDA(At, 1, 1); PG8_STAGE(PG8_SA(1, 0), a3, voffA);
            PG8_BAR; PG8_WAIT_L(0); PG8_MMA(1, 0, At, B0); PG8_BAR; PG8_SCHED;
            PG8_STAGE(PG8_SB(1, 1), b3 + hstep, voffB);
            PG8_WAIT_V(6); PG8_BAR; PG8_MMA(1, 1, At, B1); PG8_BAR;
        }
            if constexpr (!Epi::AFTER_DRAIN) { E(acc, cur, wr, wc, fr, fq); S.done(cur); }
            if (!has_next) break;
#pragma unroll
        for (int a = 0; a < 2; ++a)
#pragma unroll
            for (int b = 0; b < 2; ++b)
#pragma unroll
                for (int m = 0; m < 4; ++m)
#pragma unroll
                    for (int n = 0; n < 2; ++n) acc[a][b][m][n] = (acc_t)(0);
        cur = nxt; cA = nA; cB = nB; ++ui;
    }
    PG8_WAIT_V(0);
    if (wr == 0) PG8_BAR;
    PG8_BAR;
    if constexpr (Epi::AFTER_DRAIN) { E.fused(acc, cur, wr, wc, fr, fq, lds, wid, lane); S.done(cur); }
#undef PG8_SA
#undef PG8_SB
#undef PG8_STAGE
#undef PG8_LDA
#undef PG8_LDB
#undef PG8_MMA
#undef PG8_WAIT_V
#undef PG8_WAIT_L
#undef PG8_BAR
#undef PG8_SCHED
}
}

__device__ void phase_gemm_z(const Params& p, char* lds) {
    pg8::StaticOrder S; S.init(T_TOK, D_IN, gridDim.x, blockIdx.x);
    pg8::gemm_phase<pg8::EpiZ8, pg8::StaticOrder>((PG8_LAS unsigned char*)lds, pg8::Gemm{(const bf16_t*)p.xq, (const bf16_t*)p.winT8, T_TOK, D_IN, D_MODEL / 2}, S, pg8::EpiZ8{p.zb, p.rstd1, p.swb});
}
__device__ void phase_gemm_out(const Params& p, char* lds) {
    pg8::StaticOrder S; S.init(T_TOK, D_MODEL, gridDim.x, blockIdx.x);
    pg8::gemm_phase<pg8::EpiOut, pg8::StaticOrder>((PG8_LAS unsigned char*)lds, pg8::Gemm{p.cB, p.woutT, T_TOK, D_MODEL, D_MODEL}, S, pg8::EpiOut{p.hb, p.xq, p.sx});
}
__device__ void phase_gemm_q(const Params& p, char* lds) {
    pg8::StaticOrder S; S.init(T_TOK, 2048, gridDim.x, blockIdx.x);
    pg8::Unit u;
    for (int i = 0; S.next(i, u); ++i)
        pg8::gemm_phase<pg8::EpiQTopk, pg8::OneUnit>((PG8_LAS unsigned char*)lds, pg8::Gemm{(const bf16_t*)p.hq, (const bf16_t*)p.wqT8, T_TOK, 2048, D_MODEL / 2}, pg8::OneUnit{u}, pg8::EpiQTopk{p.keysB, p.idx, p.gate, p.swq});
}

#define XB_TMO      128
#define XB_XCNT(j)  (256  + 64 * (j))
#define XB_XSUB(j)  (1280 + 64 * (j))
#define XB_XGEN(j)  (2304 + 64 * (j))
#define XB_TOP      3328
#define XB_TOPGEN   3392
#define XCD_BAR_WORDS 3456
#define XB_SPIN_CAP (1u << 20)
__device__ __forceinline__ unsigned xb_ld(unsigned* p)              { return __hip_atomic_load(p, __ATOMIC_RELAXED, __HIP_MEMORY_SCOPE_AGENT); }
__device__ __forceinline__ unsigned xb_add(unsigned* p, unsigned v) { return __hip_atomic_fetch_add(p, v, __ATOMIC_RELAXED, __HIP_MEMORY_SCOPE_AGENT); }
__device__ __forceinline__ unsigned xb_xcc_id() { return (unsigned)__builtin_amdgcn_s_getreg((3 << 11) | 20) & 0xFu; }
#define XB_SPIN(cond, bar) do { unsigned _sp = 0; while (cond) { __builtin_amdgcn_s_sleep(1); \
    if ((++_sp & 255u) == 0u) { if (xb_ld(&(bar)[XB_TMO])) break; if (_sp > XB_SPIN_CAP) { atomicAdd(&(bar)[XB_TMO], 1u); break; } } } } while (0)
struct XcdBarrier { unsigned* bar; unsigned x; volatile LAS unsigned* st; };
__device__ __forceinline__ XcdBarrier xcd_barrier_post(unsigned* bar, volatile LAS unsigned* st) {
    XcdBarrier b; b.bar = bar; b.x = xb_xcc_id(); b.st = st;
    if (threadIdx.x == 0) (void)xb_add(&bar[XB_XCNT(b.x)], 1u);
    return b;
}
__device__ __forceinline__ void xcd_barrier_complete(unsigned* bar, unsigned x, unsigned& nloc, unsigned& nx) {
    const unsigned G = gridDim.x * gridDim.y * gridDim.z;
    unsigned sum, cnt, mine, sp = 0u;
    for (;;) {
        sum = 0u; cnt = 0u; mine = 0u;
#pragma unroll
        for (unsigned j = 0; j < 16; ++j) { const unsigned c = xb_ld(&bar[XB_XCNT(j)]); sum += c; cnt += (c > 0u) ? 1u : 0u; mine = (j == x) ? c : mine; }
        if (sum == G) break;
        __builtin_amdgcn_s_sleep(1);
        if ((++sp & 255u) == 0u) { if (xb_ld(&bar[XB_TMO])) break; if (sp > XB_SPIN_CAP) { atomicAdd(&bar[XB_TMO], 1u); break; } }
    }
    nloc = mine > 0u ? mine : 1u; nx = cnt > 0u ? cnt : 1u;
}
__device__ __forceinline__ void xcd_barrier(const XcdBarrier& b) {
    asm volatile("s_waitcnt vmcnt(0)" ::: "memory");
    __syncthreads();
    if (threadIdx.x == 0) {
        unsigned* bar = b.bar;
        __builtin_amdgcn_s_waitcnt(0);
        unsigned nloc = b.st[0], nx = b.st[1];
        if (nloc == 0u) { xcd_barrier_complete(bar, b.x, nloc, nx); b.st[0] = nloc; b.st[1] = nx; }
        const unsigned old = xb_add(&bar[XB_XSUB(b.x)], 1u);
        const unsigned gen = old / nloc;
        if (old + 1u == (gen + 1u) * nloc) {
            __builtin_amdgcn_fence(__ATOMIC_RELEASE, "agent");
            asm volatile("s_waitcnt vmcnt(0)" ::: "memory");
            const unsigned og = xb_add(&bar[XB_TOP], 1u);
            const unsigned tg = og / nx;
            if (og + 1u == (tg + 1u) * nx) xb_add(&bar[XB_TOPGEN], 1u);
            else XB_SPIN(xb_ld(&bar[XB_TOPGEN]) == tg, bar);
            __builtin_amdgcn_fence(__ATOMIC_ACQUIRE, "agent");
            xb_add(&bar[XB_XGEN(b.x)], 1u);
            asm volatile("s_waitcnt vmcnt(0)" ::: "memory");
        } else {
            XB_SPIN(xb_ld(&bar[XB_XGEN(b.x)]) == gen, bar);
            __builtin_amdgcn_fence(__ATOMIC_ACQUIRE, "agent");
            asm volatile("s_waitcnt vmcnt(0)" ::: "memory");
        }
    }
    __syncthreads();
}

#define MEGA_LDS_MAX2(a, b) ((a) > (b) ? (a) : (b))
#define MEGA_LDS_MAIN MEGA_LDS_MAX2(MEGA_LDS_MAX2(QT_LDS_BYTES, pg8::STAGE_BYTES), MEGA_LDS_MAX2(8 * TS_WBYTES, 2 * MIXH_LDS))
#define MEGA_LDS_BYTES (MEGA_LDS_MAIN + 16)
extern __shared__ __attribute__((aligned(16))) char smem[];
__global__ void __launch_bounds__(512, 2) fwd_mega(Params p) {
    volatile LAS unsigned* st = (volatile LAS unsigned*)(smem + MEGA_LDS_MAIN);
    if (threadIdx.x < 4) st[threadIdx.x] = 0u;
    __syncthreads();
    const XcdBarrier xb = xcd_barrier_post(p.bar, st);
    phase_prep(p, smem);      xcd_barrier(xb);
    phase_gemm_z(p, smem);    xcd_barrier(xb);
    phase_mix_gemm(p, smem);  xcd_barrier(xb);
    phase_gemm_out(p, smem);  xcd_barrier(xb);
    phase_hquant(p, smem);    xcd_barrier(xb);
    phase_gemm_q(p, smem);    xcd_barrier(xb);
    phase_peer_dots(p, smem); xcd_barrier(xb);
    phase_gather(p, smem);
}

extern "C" void kernel_launch(void* const* d_in, const int* in_sizes, int n_in, void* d_out, int out_size, void* d_ws, size_t ws_size, hipStream_t stream) {
    static int grid_blocks = 0;
    if (grid_blocks == 0) {
        int dev = 0, cus = 0, per_cu = 0;
        (void)hipGetDevice(&dev);
        (void)hipDeviceGetAttribute(&cus, hipDeviceAttributeMultiprocessorCount, dev);
        (void)hipFuncSetAttribute((const void*)fwd_mega, hipFuncAttributeMaxDynamicSharedMemorySize, MEGA_LDS_BYTES);
        (void)hipOccupancyMaxActiveBlocksPerMultiprocessor(&per_cu, (const void*)fwd_mega, 512, MEGA_LDS_BYTES);
        if (per_cu > 1) per_cu = 1;
        if (per_cu < 1) per_cu = 1;
        grid_blocks = cus * per_cu;
    }
    Params p{};
    p.x = (const float*)d_in[0]; p.norm1_g = (const float*)d_in[1]; p.w_in = (const float*)d_in[2]; p.pool_w = (const float*)d_in[3];
    p.pool_scale = (const float*)d_in[4]; p.sgu_norm_g = (const float*)d_in[5]; p.sgu_w = (const float*)d_in[6]; p.sgu_b = (const float*)d_in[7];
    p.w_out = (const float*)d_in[8]; p.norm2_g = (const float*)d_in[9]; p.peer_wq = (const float*)d_in[10]; p.peer_keys = (const float*)d_in[11];
    p.peer_u = (const float*)d_in[12]; p.peer_v = (const float*)d_in[13]; p.final_g = (const float*)d_in[14];
    p.out = (float*)d_out;
    char* w = (char*)d_ws; size_t off = 0;
    auto take = [&](size_t bytes) { char* r = w + off; off += (bytes + 255) & ~(size_t)255; return r; };
    const size_t MiB = 1024 * 1024;
    p.u8 = (unsigned char*)take(16 * MiB); p.v8 = (unsigned char*)take(12 * MiB);
    p.suv = (float2*)take(128 * 1024);
    p.winT = (bf16_t*)take(3 * MiB); p.woutT = (bf16_t*)take(2 * MiB); p.wqT = (bf16_t*)take(4 * MiB);
    p.poolT = (bf16_t*)take(128 * 1024); p.wsM = (bf16_t*)take(128 * 1024); p.keysB = (bf16_t*)take(512 * 1024);
    p.bar = (unsigned*)take(XCD_BAR_WORDS * 4 + 4608 * 4); p.swb = p.bar + XCD_BAR_WORDS; p.swq = p.swb + 2048;
    p.rstd1 = (float*)take(128 * 1024); p.sx = (float*)take(128 * 1024); p.xq = (signed char*)take(32 * MiB); p.winT8 = (signed char*)take(1536 * 1024); p.wqT8 = (signed char*)take(2048 * 1024); p.hq = (signed char*)take(32 * MiB); p.hsc = (float*)take(128 * 1024);
    p.idx = (int*)take(16 * MiB); p.gate = (float*)take(16 * MiB); p.coef = (float*)take(16 * MiB);
    p.xb = (bf16_t*)take(64 * MiB); p.zb = (bf16_t*)take(96 * MiB); p.cB = (bf16_t*)take(64 * MiB); p.hb = (bf16_t*)take(64 * MiB);
    (void)hipMemsetAsync(p.bar, 0, XCD_BAR_WORDS * 4 + 4608 * 4, stream);
    hipLaunchKernelGGL(fwd_mega, dim3(grid_blocks), dim3(512), MEGA_LDS_BYTES, stream, p);
}
```

```cpp
#include <hip/hip_runtime.h>
#include <stdint.h>
#include <type_traits>

typedef unsigned short bf16_t;
typedef short bf16x8 __attribute__((ext_vector_type(8)));
typedef float f32x4 __attribute__((ext_vector_type(4)));
typedef unsigned u32x4 __attribute__((ext_vector_type(4)));
typedef unsigned u32x2 __attribute__((ext_vector_type(2)));
typedef unsigned u32x3 __attribute__((ext_vector_type(3)));
typedef int i32x4 __attribute__((ext_vector_type(4)));
#define ROWB 768
typedef __bf16 bf2_t __attribute__((ext_vector_type(2)));
#define LAS __attribute__((address_space(3)))

#define T_TOK 32768
#define D_MODEL 1024
#define D_IN 1536
#define SEQ 2048
#define NEXP 16384
#define EPS 1e-6f

struct Params {
    const float *x, *norm1_g, *w_in, *pool_w, *pool_scale, *sgu_norm_g, *sgu_w, *sgu_b, *w_out, *norm2_g, *peer_wq, *peer_keys, *peer_u, *peer_v, *final_g;
    float* out;
    bf16_t *winT, *woutT, *wqT, *poolT, *wsM, *keysB;
    unsigned char *u8, *v8;
    float2* suv;
    float *rstd1, *sx;
    signed char *xq, *winT8, *hq, *wqT8; unsigned *swb, *swq; float* hsc;
    bf16_t *xb, *zb, *cB, *hb;
    int* idx; float* gate; float* coef;
    unsigned* bar;
};

__device__ __forceinline__ int tid_opaque() { int t = (int)threadIdx.x; asm volatile("" : "+v"(t)); return t; }
__device__ __forceinline__ unsigned short f2bf(float f) {
    unsigned u = __float_as_uint(f);
    u += 0x7fffu + ((u >> 16) & 1u);
    return (unsigned short)(u >> 16);
}
__device__ __forceinline__ float bf2f(unsigned short h) { return __uint_as_float(((unsigned)h) << 16); }
__device__ __forceinline__ unsigned pack2(float a, float b) { return (unsigned)f2bf(a) | ((unsigned)f2bf(b) << 16); }
__device__ __forceinline__ float bflo(unsigned w) { return __uint_as_float(w << 16); }
__device__ __forceinline__ float bfhi(unsigned w) { return __uint_as_float(w & 0xffff0000u); }
__device__ __forceinline__ float gelu_t(float x) {
    const float y = 1.5957691216057308f * (x + 0.044715f * x * x * x);
    return x * __builtin_amdgcn_rcpf(1.0f + __expf(-y));
}
__device__ __forceinline__ float wave_sum(float v) {
#pragma unroll
    for (int o = 32; o >= 1; o >>= 1) v += __shfl_xor(v, o);
    return v;
}
__device__ __forceinline__ float wave_max(float v) {
#pragma unroll
    for (int o = 32; o >= 1; o >>= 1) v = fmaxf(v, __shfl_xor(v, o));
    return v;
}

#define GEMM_LDS_BYTES (2 * 128 * 144)
__device__ __forceinline__ void transpose_tile(const int tid, const float* __restrict__ src, bf16_t* __restrict__ dst, int R, int C, const float* __restrict__ rscale, int tile, float* lds) {
    const int tilesC = C / 64, tr = tile / tilesC, tc = tile % tilesC;
    const int ty = tid >> 6, tx = tid & 63;
    __syncthreads();
#pragma unroll
    for (int i = 0; i < 16; ++i) {
        const int r = ty + 4 * i;
        float v = src[(size_t)(tr * 64 + r) * C + tc * 64 + tx];
        if (rscale) v *= rscale[tr * 64 + r];
        lds[r * 65 + tx] = v;
    }
    __syncthreads();
#pragma unroll
    for (int i = 0; i < 16; ++i) {
        const int c = ty + 4 * i;
        dst[(size_t)(tc * 64 + c) * R + tr * 64 + tx] = f2bf(lds[tx * 65 + c]);
    }
}

__device__ __forceinline__ void w8_colmax(const float* __restrict__ src, const float* __restrict__ gain, int C, unsigned* mx, unsigned* cnt, int hb2, int nh, int ht) {
    const int ncb = C / 64;
    for (int t = hb2; t < 16 * ncb; t += nh) {
        const int tr = t / ncb, tc = t % ncb, ty = ht >> 6, tx = ht & 63;
        float am = 0.f;
#pragma unroll
        for (int i = 0; i < 16; ++i) { const int r = tr * 64 + ty + 4 * i; am = fmaxf(am, fabsf(src[(size_t)r * C + tc * 64 + tx] * gain[r])); }
        (void)__hip_atomic_fetch_max(mx + tc * 64 + tx, __float_as_uint(am), __ATOMIC_RELAXED, __HIP_MEMORY_SCOPE_AGENT);
        asm volatile("s_waitcnt vmcnt(0)" ::: "memory");
        __syncthreads();
        if (ht == 0) (void)__hip_atomic_fetch_add(cnt + tc, 1u, __ATOMIC_RELAXED, __HIP_MEMORY_SCOPE_AGENT);
    }
}
__device__ __forceinline__ void w8_tiles(const float* __restrict__ src, const float* __restrict__ gain, int C, signed char* __restrict__ dst, unsigned* mx, unsigned* cnt, char* lds, int tid) {
    const int half = tid >> 8, ht = tid & 255, ty = ht >> 6, tx = ht & 63, ncb = C / 64;
    float* fl = (float*)(lds + half * (64 * 65 * 4));
    for (int t = 2 * blockIdx.x + half; t < 16 * ncb; t += 2 * gridDim.x) {
        const int tr = t / ncb, tc = t % ncb;
        if (ht == 0) {
            unsigned spins = 0;
            while (__hip_atomic_load(cnt + tc, __ATOMIC_RELAXED, __HIP_MEMORY_SCOPE_AGENT) < 16u && ++spins < (1u << 22)) __builtin_amdgcn_s_sleep(2);
        }
        __syncthreads();
#pragma unroll
        for (int i = 0; i < 16; ++i) { const int r = ty + 4 * i; fl[r * 65 + tx] = src[(size_t)(tr * 64 + r) * C + tc * 64 + tx] * gain[tr * 64 + r]; }
        __syncthreads();
#pragma unroll
        for (int i = 0; i < 16; ++i) {
            const int c = ty + 4 * i;
            const float am = __uint_as_float(__hip_atomic_load(mx + tc * 64 + c, __ATOMIC_RELAXED, __HIP_MEMORY_SCOPE_AGENT));
            const float inv = am > 0.f ? 127.0f / am : 0.f;
            dst[(size_t)(tc * 64 + c) * 1024 + tr * 64 + tx] = (signed char)(int)rintf(fl[tx * 65 + c] * inv);
        }
    }
}

__device__ void phase_prep(const Params& p, char* lds) {
    const int tidx_ = tid_opaque();
    const int nb = gridDim.x, b = blockIdx.x, tid = tidx_;
    const int half = tid >> 8, ht = tid & 255, nh = 2 * nb, hb2 = 2 * b + half;
    float* fl = (float*)(lds + half * (64 * 65 * 4));
    w8_colmax(p.w_in, p.norm1_g, 1536, p.swb, p.swb + 1536, hb2, nh, ht);
    w8_colmax(p.peer_wq, p.norm2_g, 2048, p.swq, p.swq + 2048, hb2, nh, ht);
    for (int t = hb2; t < 16 * 16; t += nh) transpose_tile(ht, p.w_out, p.woutT, 1024, 1024, nullptr, t, fl);
    for (int t = hb2; t < 16; t += nh) transpose_tile(ht, p.pool_w + (size_t)(t >> 2) * 16384, p.poolT + (size_t)(t >> 2) * 16384, 128, 128, nullptr, t & 3, fl);
    const size_t gtid = (size_t)b * blockDim.x + tid, gsz = (size_t)nb * blockDim.x;
    for (size_t i = gtid; i < 4 * 128 * 128; i += gsz) {
        const int j = (int)(i & 127), ii = (int)((i >> 7) & 127);
        const bool keep = (j >> 6) <= (ii >> 6);
        p.wsM[i] = keep ? f2bf(p.sgu_w[i]) : (bf16_t)0;
    }
    for (size_t o = gtid; o < 2 * 8 * 128 * 128; o += gsz) {
        const int j = (int)(o & 7), ln = (int)((o >> 3) & 63), nb = (int)((o >> 9) & 7), kk = (int)((o >> 12) & 3), ph = (int)(o >> 14);
        p.keysB[o] = f2bf(p.peer_keys[(size_t)ph * 16384 + (size_t)(16 * nb + (ln & 15)) * 128 + 32 * kk + 8 * (ln >> 4) + j]);
    }
    {
        const int wave = (b * blockDim.x + tid) >> 6, nwaves = (nb * blockDim.x) >> 6, lane = tid & 63;
        float g16[16];
#pragma unroll
        for (int i = 0; i < 4; ++i) { const float4 g = ((const float4*)(p.norm2_g + lane * 16))[i]; g16[4 * i] = g.x; g16[4 * i + 1] = g.y; g16[4 * i + 2] = g.z; g16[4 * i + 3] = g.w; }
        auto quant_row = [&](const float (&f)[16], unsigned char* dst, float* scale_out) {
            float am = 0.f;
#pragma unroll
            for (int j = 0; j < 16; ++j) am = fmaxf(am, fabsf(f[j]));
            am = wave_max(am);
            const float inv = am > 0.f ? 31.0f / am : 0.f;
            int q[16];
#pragma unroll
            for (int j = 0; j < 16; ++j) q[j] = (int)rintf(f[j] * inv) + 32;
            unsigned dg[3][4];
#pragma unroll
            for (int k = 0; k < 4; ++k) {
                int e = q[12 + k] - 42;
#pragma unroll
                for (int i = 0; i < 3; ++i) { const int d = e & 3, D = d >= 2 ? d - 4 : d; dg[i][k] = (unsigned)d; e = (e - D) >> 2; }
            }
            u32x3 o;
#pragma unroll
            for (int i = 0; i < 3; ++i) {
                unsigned w = 0;
#pragma unroll
                for (int k = 0; k < 4; ++k) w |= (unsigned)(q[4 * i + k] | (dg[i][k] << 6)) << (8 * k);
                o[i] = w;
            }
            *(u32x3*)(dst + lane * 12) = o;
            if (lane == 0) *scale_out = am * (1.0f / 31.0f);
        };
        for (int e = wave; e < NEXP; e += nwaves) {
            const float4* su4 = (const float4*)(p.peer_u + (size_t)e * D_MODEL + lane * 16);
            const float4* sv4 = (const float4*)(p.peer_v + (size_t)e * D_MODEL + lane * 16);
            float4 a4[4], b4[4];
#pragma unroll
            for (int i = 0; i < 4; ++i) { a4[i] = su4[i]; b4[i] = sv4[i]; }
            float fu[16], fv[16];
#pragma unroll
            for (int i = 0; i < 4; ++i) {
                fu[4 * i] = a4[i].x * g16[4 * i]; fu[4 * i + 1] = a4[i].y * g16[4 * i + 1]; fu[4 * i + 2] = a4[i].z * g16[4 * i + 2]; fu[4 * i + 3] = a4[i].w * g16[4 * i + 3];
                fv[4 * i] = b4[i].x; fv[4 * i + 1] = b4[i].y; fv[4 * i + 2] = b4[i].z; fv[4 * i + 3] = b4[i].w;
            }
            {
                float am = 0.f;
#pragma unroll
                for (int j = 0; j < 16; ++j) am = fmaxf(am, fabsf(fu[j]));
                am = wave_max(am);
                const float inv = am > 0.f ? 127.0f / am : 0.f;
                u32x4 o;
#pragma unroll
                for (int i = 0; i < 4; ++i) {
                    unsigned w = 0;
#pragma unroll
                    for (int k = 0; k < 4; ++k) w |= (unsigned)(((int)rintf(fu[4 * i + k] * inv)) & 0xff) << (8 * k);
                    o[i] = w;
                }
                *(u32x4*)(p.u8 + (size_t)e * D_MODEL + lane * 16) = o;
                if (lane == 0) p.suv[e].x = am * (1.0f / 127.0f);
            }
            quant_row(fv, p.v8 + (size_t)e * ROWB, &p.suv[e].y);
        }
    }
    const int wave = (b * blockDim.x + tid) >> 6, nwaves = (nb * blockDim.x) >> 6, lane = tid & 63;
    for (int t = wave; t < T_TOK; t += 2 * nwaves) {
        const int t1 = t + nwaves; const bool two = t1 < T_TOK;
        const float4* xr0 = (const float4*)(p.x + (size_t)t * D_MODEL);
        const float4* xr1 = (const float4*)(p.x + (size_t)(two ? t1 : t) * D_MODEL);
        float4 v0[4], v1[4];
#pragma unroll
        for (int i = 0; i < 4; ++i) { v0[i] = xr0[lane + 64 * i]; v1[i] = xr1[lane + 64 * i]; }
        float s0 = 0.f, s1 = 0.f, a0 = 0.f, a1 = 0.f;
#pragma unroll
        for (int i = 0; i < 4; ++i) {
            s0 += v0[i].x * v0[i].x + v0[i].y * v0[i].y + v0[i].z * v0[i].z + v0[i].w * v0[i].w;
            s1 += v1[i].x * v1[i].x + v1[i].y * v1[i].y + v1[i].z * v1[i].z + v1[i].w * v1[i].w;
            a0 = fmaxf(fmaxf(a0, fmaxf(fabsf(v0[i].x), fabsf(v0[i].y))), fmaxf(fabsf(v0[i].z), fabsf(v0[i].w)));
            a1 = fmaxf(fmaxf(a1, fmaxf(fabsf(v1[i].x), fabsf(v1[i].y))), fmaxf(fabsf(v1[i].z), fabsf(v1[i].w)));
        }
        s0 = wave_sum(s0); s1 = wave_sum(s1); a0 = wave_max(a0); a1 = wave_max(a1);
        const float i0 = a0 > 0.f ? 127.0f / a0 : 0.f, i1 = a1 > 0.f ? 127.0f / a1 : 0.f;
#pragma unroll
        for (int i = 0; i < 4; ++i) {
            const unsigned q0 = ((unsigned)((int)rintf(v0[i].x * i0) & 0xff)) | ((unsigned)((int)rintf(v0[i].y * i0) & 0xff) << 8) | ((unsigned)((int)rintf(v0[i].z * i0) & 0xff) << 16) | ((unsigned)((int)rintf(v0[i].w * i0) & 0xff) << 24);
            ((unsigned*)(p.xq + (size_t)t * D_MODEL))[lane + 64 * i] = q0;
            if (two) {
                const unsigned q1 = ((unsigned)((int)rintf(v1[i].x * i1) & 0xff)) | ((unsigned)((int)rintf(v1[i].y * i1) & 0xff) << 8) | ((unsigned)((int)rintf(v1[i].z * i1) & 0xff) << 16) | ((unsigned)((int)rintf(v1[i].w * i1) & 0xff) << 24);
                ((unsigned*)(p.xq + (size_t)t1 * D_MODEL))[lane + 64 * i] = q1;
            }
        }
        if (lane == 0) {
            p.rstd1[t] = rsqrtf(s0 * (1.0f / D_MODEL) + EPS) * a0 * (1.0f / 127.0f); p.sx[t] = a0 * (1.0f / 127.0f);
            if (two) { p.rstd1[t1] = rsqrtf(s1 * (1.0f / D_MODEL) + EPS) * a1 * (1.0f / 127.0f); p.sx[t1] = a1 * (1.0f / 127.0f); }
        }
    }
    w8_tiles(p.w_in, p.norm1_g, 1536, p.winT8, p.swb, p.swb + 1536, lds, tid);
    w8_tiles(p.peer_wq, p.norm2_g, 2048, p.wqT8, p.swq, p.swq + 2048, lds, tid);
}

typedef short s16x4 __attribute__((ext_vector_type(4)));
template <class Epi>
__device__ __forceinline__ void gemm128_sgu(const int tid, const bf16_t* __restrict__ A, const bf16_t* __restrict__ V  ,
                                            const float* __restrict__ lnm, const float* __restrict__ lnr, const float* __restrict__ gch, char* lds, const Epi& epi) {
    const int lane = tid & 63, wid = tid >> 6, wr = wid >> 1, wc = wid & 1, fr = lane & 15, fq = lane >> 4;
    constexpr int PITCH = 144, P2 = 288;
    char* sA = lds; char* sB = lds + 128 * PITCH;
    f32x4 acc[4][4];
#pragma unroll
    for (int m = 0; m < 4; ++m)
#pragma unroll
        for (int n = 0; n < 4; ++n) acc[m][n] = (f32x4){0.f, 0.f, 0.f, 0.f};
    u32x4 ra[4], rb[4]; float rm[4], rr[4];
    const int lrow = tid >> 3, lch = tid & 7;
    const int btok = tid >> 4, bch = tid & 15;
    const bf16_t* ga = A + (size_t)lrow * 128 + lch * 8;
    const bf16_t* gb = V + (size_t)btok * D_IN + bch * 8;
    float g8[8];
    { const float4 g0 = *(const float4*)(gch + bch * 8), g1 = *(const float4*)(gch + bch * 8 + 4); g8[0] = g0.x; g8[1] = g0.y; g8[2] = g0.z; g8[3] = g0.w; g8[4] = g1.x; g8[5] = g1.y; g8[6] = g1.z; g8[7] = g1.w; }
#pragma unroll
    for (int j = 0; j < 4; ++j) { ra[j] = *(const u32x4*)(ga + (size_t)(32 * j) * 128); rb[j] = *(const u32x4*)(gb + (size_t)(16 * j) * D_IN); rm[j] = lnm[btok + 16 * j]; rr[j] = lnr[btok + 16 * j]; }
    for (int k0 = 0; k0 < 128; k0 += 64) {
        __syncthreads();
#pragma unroll
        for (int j = 0; j < 4; ++j) {
            *(u32x4*)(sA + (lrow + 32 * j) * PITCH + lch * 16) = ra[j];
            u32x4 o;
#pragma unroll
            for (int i = 0; i < 4; ++i) {
                const unsigned w = rb[j][i];
                o[i] = pack2((bflo(w) - rm[j]) * rr[j] * g8[2 * i], (bfhi(w) - rm[j]) * rr[j] * g8[2 * i + 1]);
            }
            *(u32x4*)(sB + (btok + 16 * j) * P2 + bch * 16) = o;
        }
        __syncthreads();
        if (k0 + 64 < 128) {
#pragma unroll
            for (int j = 0; j < 4; ++j) { ra[j] = *(const u32x4*)(ga + (size_t)(32 * j) * 128 + 64); rb[j] = *(const u32x4*)(gb + (size_t)(64 + 16 * j) * D_IN); rm[j] = lnm[64 + btok + 16 * j]; rr[j] = lnr[64 + btok + 16 * j]; }
        }
#pragma unroll
        for (int kk = 0; kk < 2; ++kk) {
            bf16x8 af[4], bfr[4];
#pragma unroll
            for (int m = 0; m < 4; ++m) af[m] = *(const bf16x8*)(sA + (wr * 64 + m * 16 + fr) * PITCH + (kk * 32 + fq * 8) * 2);
#pragma unroll
            for (int n = 0; n < 4; ++n) {
                const char* bp = sB + (kk * 32 + fq * 8 + (fr >> 2)) * P2 + (wc * 64 + n * 16 + 4 * (fr & 3)) * 2;
                const s16x4 lo = __builtin_amdgcn_ds_read_tr16_b64_v4i16((LAS s16x4*)(bp));
                const s16x4 hi = __builtin_amdgcn_ds_read_tr16_b64_v4i16((LAS s16x4*)(bp + 4 * P2));
                bfr[n] = (bf16x8){lo[0], lo[1], lo[2], lo[3], hi[0], hi[1], hi[2], hi[3]};
            }
#pragma unroll
            for (int m = 0; m < 4; ++m)
#pragma unroll
                for (int n = 0; n < 4; ++n) acc[m][n] = __builtin_amdgcn_mfma_f32_16x16x32_bf16(bfr[n], af[m], acc[m][n], 0, 0, 0);
        }
    }
#pragma unroll
    for (int m = 0; m < 4; ++m)
#pragma unroll
        for (int n = 0; n < 4; ++n) epi(wr * 64 + m * 16 + fr, wc * 64 + n * 16 + fq * 4, acc[m][n]);
}

#define PT_PITCH 272
#define MIXH_LDS (2 * 128 * PT_PITCH + 1024)
template <int W, class Epi>
__device__ __forceinline__ void pool_tile(const int tid, const bf16_t* __restrict__ zb0  , int pos0,
                                          const bf16_t* __restrict__ Bt, char* lds, const Epi& epi) {
    const int lane = tid & 63, wid = tid >> 6, wr = wid >> 1, wc = wid & 1, fr = lane & 15, fq = lane >> 4;
    char* sA = lds; char* sB = lds + 128 * PT_PITCH;
    __syncthreads();
#pragma unroll
    for (int j = 0; j < 8; ++j) { const int id = tid + 256 * j, row = id >> 4, ch = id & 15; *(u32x4*)(sB + row * PT_PITCH + ch * 16) = *(const u32x4*)(Bt + (size_t)row * 128 + ch * 8); }
    {
        const int seg = tid >> 5, hc = tid & 31, r0 = seg * 16;
        const bool at_start = (pos0 & (SEQ - 1)) == 0;
        const bf16_t* zp = zb0 + hc * 4;
        u32x2 v[W + 16];
#pragma unroll
        for (int i = 0; i < W + 16; ++i) { const int rr = r0 - W + i; const bool ok = !(at_start && rr < 0); v[i] = *(const u32x2*)(zp + (ptrdiff_t)(ok ? rr : 0) * D_IN); }
        float sm[4] = {0.f, 0.f, 0.f, 0.f};
#pragma unroll
        for (int i = 1; i <= W; ++i) {
            const float m = (at_start && (r0 - W + i) < 0) ? 0.f : 1.f;
            sm[0] += m * bflo(v[i].x); sm[1] += m * bfhi(v[i].x); sm[2] += m * bflo(v[i].y); sm[3] += m * bfhi(v[i].y);
        }
#pragma unroll
        for (int o = 0; o < 16; ++o) {
            if (o > 0) {
                const float md = (at_start && (r0 + o - W) < 0) ? 0.f : 1.f;
                sm[0] += bflo(v[W + o].x) - md * bflo(v[o].x); sm[1] += bfhi(v[W + o].x) - md * bfhi(v[o].x);
                sm[2] += bflo(v[W + o].y) - md * bflo(v[o].y); sm[3] += bfhi(v[W + o].y) - md * bfhi(v[o].y);
            }
            const int pos = (pos0 + r0 + o) & (SEQ - 1);
            const float rn = 1.0f / (float)((pos + 1 < W) ? pos + 1 : W);
            u32x2 ov;
            ov.x = pack2(sm[0] * rn - bflo(v[W + o].x), sm[1] * rn - bfhi(v[W + o].x));
            ov.y = pack2(sm[2] * rn - bflo(v[W + o].y), sm[3] * rn - bfhi(v[W + o].y));
            *(u32x2*)(sA + (r0 + o) * PT_PITCH + hc * 8) = ov;
        }
    }
    __syncthreads();
    f32x4 acc[4][4];
#pragma unroll
    for (int m = 0; m < 4; ++m)
#pragma unroll
        for (int n = 0; n < 4; ++n) acc[m][n] = (f32x4){0.f, 0.f, 0.f, 0.f};
#pragma unroll
    for (int kk = 0; kk < 4; ++kk) {
        bf16x8 af[4], bfr[4];
#pragma unroll
        for (int m = 0; m < 4; ++m) af[m] = *(const bf16x8*)(sA + (wr * 64 + m * 16 + fr) * PT_PITCH + (kk * 32 + fq * 8) * 2);
#pragma unroll
        for (int n = 0; n < 4; ++n) bfr[n] = *(const bf16x8*)(sB + (wc * 64 + n * 16 + fr) * PT_PITCH + (kk * 32 + fq * 8) * 2);
#pragma unroll
        for (int m = 0; m < 4; ++m)
#pragma unroll
            for (int n = 0; n < 4; ++n) acc[m][n] = __builtin_amdgcn_mfma_f32_16x16x32_bf16(bfr[n], af[m], acc[m][n], 0, 0, 0);
    }
#pragma unroll
    for (int m = 0; m < 4; ++m)
#pragma unroll
        for (int n = 0; n < 4; ++n) epi(wr * 64 + m * 16 + fr, wc * 64 + n * 16 + fq * 4, acc[m][n]);
}

__device__ void phase_mix_gemm(const Params& p, char* lds) {
    const int tidx_ = tid_opaque();
    const int npool = (T_TOK / 128) * 4, nsgu = (T_TOK / 128) * 4;
    const int half = tidx_ >> 8, ht = tidx_ & 255; lds += half * MIXH_LDS;
    for (int tile = 2 * blockIdx.x + half; tile < npool + nsgu; tile += 2 * gridDim.x) {
        if (tile < npool) {
            const int tm = tile >> 2, g = tile & 3;
            const float* ps = p.pool_scale + g * 128; bf16_t* co = p.cB + (size_t)tm * 128 * D_MODEL + g * 128;
            const bf16_t* z0 = p.zb + (size_t)tm * 128 * D_IN + g * 128; const bf16_t* bt = p.poolT + (size_t)g * 16384;
            auto epi = [&](int r, int c, f32x4 v) {
                const float4 sc = *(const float4*)(ps + c);
                uint2 o; o.x = pack2(v[0] * sc.x, v[1] * sc.y); o.y = pack2(v[2] * sc.z, v[3] * sc.w);
                *(uint2*)(co + (size_t)r * D_MODEL + c) = o;
            };
            if (g == 0) pool_tile<2>(ht, z0, tm * 128, bt, lds, epi); else if (g == 1) pool_tile<4>(ht, z0, tm * 128, bt, lds, epi);
            else if (g == 2) pool_tile<8>(ht, z0, tm * 128, bt, lds, epi); else pool_tile<16>(ht, z0, tm * 128, bt, lds, epi);
        } else {
            const int t2 = tile - npool, blk = t2 >> 2, h = t2 & 3;
            float* stm = (float*)(lds + GEMM_LDS_BYTES); float* str = stm + 128;
            __syncthreads();
            {
                const int tok = ht >> 1, hh = ht & 1;
                const u32x4* vp = (const u32x4*)(p.zb + (size_t)(blk * 128 + tok) * D_IN + 1024 + hh * 256);
                float s1 = 0.f, s2 = 0.f;
#pragma unroll 8
                for (int i = 0; i < 32; ++i) {
                    const u32x4 v = vp[i];
#pragma unroll
                    for (int k = 0; k < 4; ++k) { const float a = bflo(v[k]), c = bfhi(v[k]); s1 += a + c; s2 += a * a + c * c; }
                }
                s1 += __shfl_xor(s1, 1); s2 += __shfl_xor(s2, 1);
                const float mean = s1 * (1.0f / 512.0f), var = fmaxf(s2 * (1.0f / 512.0f) - mean * mean, 0.f);
                if (hh == 0) { stm[tok] = mean; str[tok] = rsqrtf(var + EPS); }
            }
            __syncthreads();
            const float* sb = p.sgu_b + h * 128; const bf16_t* uo = p.zb + (size_t)blk * 128 * D_IN + 512 + h * 128;
            bf16_t* co = p.cB + (size_t)blk * 128 * D_MODEL + 512 + h * 128;
            gemm128_sgu(ht, p.wsM + (size_t)h * 16384, p.zb + (size_t)blk * 128 * D_IN + 1024 + h * 128, stm, str, p.sgu_norm_g + h * 128, lds,
                    [&](int r, int c, f32x4 v) {
                        const float bb = sb[r];
                        const uint2 uu = *(const uint2*)(uo + (size_t)r * D_IN + c);
                        uint2 o;
                        o.x = pack2((v[0] + bb) * bflo(uu.x), (v[1] + bb) * bfhi(uu.x));
                        o.y = pack2((v[2] + bb) * bflo(uu.y), (v[3] + bb) * bfhi(uu.y));
                        *(uint2*)(co + (size_t)r * D_MODEL + c) = o;
                    });
        }
    }
}

__device__ __forceinline__ int wave_sum_i_uniform(int s) {
    s += __builtin_amdgcn_update_dpp(0, s, 0xB1, 0xf, 0xf, false);
    s += __builtin_amdgcn_update_dpp(0, s, 0x4E, 0xf, 0xf, false);
    s += __builtin_amdgcn_update_dpp(0, s, 0x141, 0xf, 0xf, false);
    s += __builtin_amdgcn_update_dpp(0, s, 0x140, 0xf, 0xf, false);
    return __builtin_amdgcn_readlane(s, 0) + __builtin_amdgcn_readlane(s, 16) + __builtin_amdgcn_readlane(s, 32) + __builtin_amdgcn_readlane(s, 48);
}
__constant__ unsigned char kComb[64] = {
    0x00,0x01,0x02,0x03,0x04,0x05,0x06,0x07,0x08,0x09,0x0a,0x0b,0x0c,0x0d,0x0e,0x0f,
    0x10,0x11,0x12,0x13,0x14,0x15,0x16,0x17,
    0x20,0x21,0x22,0x23,0x24,
    0x30,0x31,0x32,0x33,
    0x40,0x41,0x42,
    0x50,0x51,
    0x60,0x61,
    0x70,0x71,
    0x80,0x90,0xa0,0xb0,0xc0,0xd0,0xe0,0xf0,
    0xff,0xff,0xff,0xff,0xff,0xff,0xff,0xff,0xff,0xff,0xff,0xff,0xff,0xff};

template <int CTRL> __device__ __forceinline__ int dpp_i(int v) { return __builtin_amdgcn_update_dpp(0, v, CTRL, 0xf, 0xf, false); }
__device__ __forceinline__ int row_allmax_i(int v) {
    v = max(v, dpp_i<0x128>(v)); v = max(v, dpp_i<0x124>(v)); v = max(v, dpp_i<0x122>(v)); v = max(v, dpp_i<0x121>(v));
    return v;
}
__device__ __forceinline__ float row_allsum_f(float v) {
    v += __int_as_float(dpp_i<0x128>(__float_as_int(v))); v += __int_as_float(dpp_i<0x124>(__float_as_int(v)));
    v += __int_as_float(dpp_i<0x122>(__float_as_int(v))); v += __int_as_float(dpp_i<0x121>(__float_as_int(v)));
    return v;
}
__device__ __forceinline__ int f2key(float f) { const int b = __float_as_int(f); return b ^ ((b >> 31) & 0x7fffffff); }
__device__ __forceinline__ float key2f(int k) { return __int_as_float(k ^ ((k >> 31) & 0x7fffffff)); }
#define KEY_MIN ((int)0x80000000)
#define CE(a, b) { const int hi_ = max(a, b), lo_ = min(a, b); a = hi_; b = lo_; }
__device__ __forceinline__ int top16_rows(int (&k)[8], int l15) {
    CE(k[0], k[1]) CE(k[2], k[3]) CE(k[4], k[5]) CE(k[6], k[7])
    CE(k[0], k[2]) CE(k[1], k[3]) CE(k[4], k[6]) CE(k[5], k[7])
    CE(k[1], k[2]) CE(k[5], k[6])
    CE(k[0], k[4]) CE(k[1], k[5]) CE(k[2], k[6]) CE(k[3], k[7])
    CE(k[2], k[4]) CE(k[3], k[5])
    CE(k[1], k[2]) CE(k[3], k[4]) CE(k[5], k[6])
    int res = KEY_MIN;
#pragma unroll
    for (int r = 0; r < 16; ++r) {
        const int m = row_allmax_i(k[0]);
        const bool own = (k[0] == m);
#pragma unroll
        for (int j = 0; j < 7; ++j) k[j] = own ? k[j + 1] : k[j];
        k[7] = own ? KEY_MIN : k[7];
        res = (l15 == r) ? m : res;
    }
    return res;
}
__device__ __forceinline__ void combine16(int A, int B, const int (&cbv)[4], int lane, int l15, int& eid_out, float& gate_out) {
    const int rowbase = lane & 48;
    int ck[4], eid[4];
#pragma unroll
    for (int c = 0; c < 4; ++c) {
        const int ci = (cbv[c] >> 4) & 15, cj = cbv[c] & 15;
        const int ka = __builtin_amdgcn_ds_bpermute((rowbase + ci) << 2, A);
        const int kb = __builtin_amdgcn_ds_bpermute((rowbase + cj) << 2, B);
        const float sm = key2f(ka & ~127) + key2f(kb & ~127);
        eid[c] = ((127 - (ka & 127)) << 7) | (127 - (kb & 127));
        ck[c] = (cbv[c] != 0xff) ? ((f2key(sm) & ~63) | (63 - (4 * l15 + c))) : KEY_MIN;
    }
    CE(ck[0], ck[1]) CE(ck[2], ck[3]) CE(ck[0], ck[2]) CE(ck[1], ck[3]) CE(ck[1], ck[2])
    int res = KEY_MIN;
#pragma unroll
    for (int r = 0; r < 16; ++r) {
        const int m = row_allmax_i(ck[0]);
        const bool own = (ck[0] == m);
        ck[0] = own ? ck[1] : ck[0]; ck[1] = own ? ck[2] : ck[1]; ck[2] = own ? ck[3] : ck[2]; ck[3] = own ? KEY_MIN : ck[3];
        res = (l15 == r) ? m : res;
    }
    const int slot = 63 - (res & 63);
    const int src = (rowbase + (slot >> 2)) << 2;
    const int e0 = __builtin_amdgcn_ds_bpermute(src, eid[0]), e1 = __builtin_amdgcn_ds_bpermute(src, eid[1]);
    const int e2 = __builtin_amdgcn_ds_bpermute(src, eid[2]), e3 = __builtin_amdgcn_ds_bpermute(src, eid[3]);
    const int sel = slot & 3;
    eid_out = sel == 0 ? e0 : (sel == 1 ? e1 : (sel == 2 ? e2 : e3));
    gate_out = key2f(res & ~63);
}

__device__ __forceinline__ int reduce16_rows(const int (&part)[16], bool b3, bool b2, bool b1, bool b0b) {
    int r8[8], r4[4], r2[2];
#pragma unroll
    for (int k = 0; k < 8; ++k) { const int keep = b3 ? part[8 + k] : part[k], send = b3 ? part[k] : part[8 + k]; r8[k] = keep + __builtin_amdgcn_update_dpp(0, send, 0x140, 0xf, 0xf, false); }
#pragma unroll
    for (int k = 0; k < 4; ++k) { const int keep = b2 ? r8[4 + k] : r8[k], send = b2 ? r8[k] : r8[4 + k]; r4[k] = keep + __builtin_amdgcn_update_dpp(0, send, 0x141, 0xf, 0xf, false); }
#pragma unroll
    for (int k = 0; k < 2; ++k) { const int keep = b1 ? r4[2 + k] : r4[k], send = b1 ? r4[k] : r4[2 + k]; r2[k] = keep + __builtin_amdgcn_update_dpp(0, send, 0x4E, 0xf, 0xf, false); }
    const int keep = b0b ? r2[1] : r2[0], send = b0b ? r2[0] : r2[1];
    int r1 = keep + __builtin_amdgcn_update_dpp(0, send, 0xB1, 0xf, 0xf, false);
    r1 += __shfl_xor(r1, 16); r1 += __shfl_xor(r1, 32);
    return r1;
}
__device__ void phase_hquant(const Params& p, char* lds) {
    const int tid = tid_opaque();
    const int wave = __builtin_amdgcn_readfirstlane((int)((blockIdx.x * blockDim.x + tid) >> 6)), nwaves = (gridDim.x * blockDim.x) >> 6, lane = tid & 63;
    for (int t = wave; t < T_TOK; t += 2 * nwaves) {
        const int t1 = t + nwaves; const bool two = t1 < T_TOK;
        const u32x4* h0 = (const u32x4*)(p.hb + (size_t)t * D_MODEL); const u32x4* h1 = (const u32x4*)(p.hb + (size_t)(two ? t1 : t) * D_MODEL);
        u32x4 r[2][2] = {{h0[2 * lane], h0[2 * lane + 1]}, {h1[2 * lane], h1[2 * lane + 1]}};
#pragma unroll
        for (int q = 0; q < 2; ++q) {
            const u32x4 a = r[q][0], c = r[q][1];
            const float f[16] = {bflo(a.x), bfhi(a.x), bflo(a.y), bfhi(a.y), bflo(a.z), bfhi(a.z), bflo(a.w), bfhi(a.w),
                                 bflo(c.x), bfhi(c.x), bflo(c.y), bfhi(c.y), bflo(c.z), bfhi(c.z), bflo(c.w), bfhi(c.w)};
            float ss = 0.f, am = 0.f;
#pragma unroll
            for (int k = 0; k < 16; ++k) { ss += f[k] * f[k]; am = fmaxf(am, fabsf(f[k])); }
            ss = wave_sum(ss); am = wave_max(am);
            const float inv = am > 0.f ? 127.0f / am : 0.f;
            u32x4 o;
#pragma unroll
            for (int i = 0; i < 4; ++i) {
                unsigned w = 0;
#pragma unroll
                for (int k = 0; k < 4; ++k) w |= (unsigned)((int)rintf(f[4 * i + k] * inv) & 0xff) << (8 * k);
                o[i] = w;
            }
            const int tt = q ? t1 : t;
            if (q == 0 || two) {
                ((u32x4*)(p.hq + (size_t)tt * D_MODEL))[lane] = o;
                if (lane == 0) p.hsc[tt] = am * (1.0f / 127.0f) * rsqrtf(ss * (1.0f / D_MODEL) + EPS);
            }
        }
    }
}

#define TS_WBYTES (16384 + 128)
__device__ void phase_peer_dots(const Params& p, char* lds) {
    const int tidx_ = tid_opaque();
    const int lane = tidx_ & 63, wid = __builtin_amdgcn_readfirstlane((int)(tidx_ >> 6)), l15 = lane & 15;
    const bool b3 = (lane & 8) != 0, b2 = (lane & 4) != 0, b1 = (lane & 2) != 0, b0b = (lane & 1) != 0;
    const int gw = blockIdx.x * (blockDim.x >> 6) + wid, ngw = gridDim.x * (blockDim.x >> 6);
    char* wl = lds + wid * TS_WBYTES;
    unsigned* list = (unsigned*)wl; int* dotsl = (int*)(wl + 4096); char* hql = wl + 8192; int* tks = (int*)(wl + 16384);
    const unsigned lane16 = (unsigned)lane * 16u;
    for (int tb = gw * 8; tb < T_TOK; tb += ngw * 8) {
#pragma unroll
        for (int j = 0; j < 8; ++j) *(u32x4*)(hql + j * 1024 + lane * 16) = ((const u32x4*)(p.hq + (size_t)(tb + j) * D_MODEL))[lane];
        if (lane < 8) tks[lane] = __float_as_int(p.hsc[tb + lane]);
        int idv[8][2];
#pragma unroll
        for (int j = 0; j < 8; ++j) { const int* ir = p.idx + (size_t)(tb + j) * 128; idv[j][0] = ir[lane]; idv[j][1] = ir[64 + lane]; }
#pragma unroll 1
        for (int x = 0; x < 8; ++x) {
            int n = 0;
#pragma unroll
            for (int j = 0; j < 8; ++j)
#pragma unroll
                for (int r = 0; r < 2; ++r) {
                    const int e = idv[j][r];
                    const bool in = (e >> 11) == x;
                    const unsigned long long mk = __ballot(in);
                    const int rank = (int)__builtin_amdgcn_mbcnt_hi((unsigned)(mk >> 32), __builtin_amdgcn_mbcnt_lo((unsigned)mk, 0u));
                    if (in) list[n + rank] = ((unsigned)j << 21) | ((unsigned)(r * 64 + lane) << 14) | (unsigned)e;
                    n += (int)__builtin_popcountll(mk);
                }
            asm volatile("s_waitcnt lgkmcnt(0)" ::: "memory");
            u32x4 ua[16], ubf[16]; int enta = 0, entb = 0;
            auto issue = [&](int b0, u32x4 (&uu)[16], int& entv) {
                const int i = (b0 + l15 < n) ? b0 + l15 : n - 1;
                entv = (int)list[i];
#pragma unroll
                for (int j = 0; j < 16; ++j) { const int e = __builtin_amdgcn_readlane(entv, j) & 0x3fff; uu[j] = *(const u32x4*)(p.u8 + (size_t)e * D_MODEL + lane16); }
            };
            auto reduce = [&](int b0, const u32x4 (&uu)[16], int entv) {
                int part[16];
#pragma unroll
                for (int j = 0; j < 16; ++j) {
                    const int tl = __builtin_amdgcn_readlane(entv, j) >> 21;
                    const u32x4 hqv = *(const u32x4*)(hql + tl * 1024 + lane * 16);
                    int sacc = __builtin_amdgcn_sdot4((int)uu[j].x, (int)hqv.x, 0, false);
                    sacc = __builtin_amdgcn_sdot4((int)uu[j].y, (int)hqv.y, sacc, false);
                    sacc = __builtin_amdgcn_sdot4((int)uu[j].z, (int)hqv.z, sacc, false);
                    part[j] = __builtin_amdgcn_sdot4((int)uu[j].w, (int)hqv.w, sacc, false);
                }
                const int r1 = reduce16_rows(part, b3, b2, b1, b0b);
                if (lane < 16 && b0 + lane < n) dotsl[((unsigned)entv >> 21) * 128 + (((unsigned)entv >> 14) & 127u)] = r1;
            };
            if (n > 0) issue(0, ua, enta);
            for (int b0 = 0; b0 < n; b0 += 32) {
                if (b0 + 16 < n) issue(b0 + 16, ubf, entb);
                reduce(b0, ua, enta);
                if (b0 + 16 < n) {
                    if (b0 + 32 < n) issue(b0 + 32, ua, enta);
                    reduce(b0 + 16, ubf, entb);
                }
            }
            asm volatile("s_waitcnt lgkmcnt(0)" ::: "memory");
        }
#pragma unroll
        for (int j = 0; j < 8; ++j) {
            const float cs_t = __int_as_float(tks[j]), r2_t = cs_t;
            const float* gr = p.gate + (size_t)(tb + j) * 128; float* cr = p.coef + (size_t)(tb + j) * 128;
#pragma unroll
            for (int r = 0; r < 2; ++r) {
                const int e = idv[j][r];
                const float sc = gr[r * 64 + lane] * r2_t;
                const float ex = __expf(sc - key2f(row_allmax_i(f2key(sc))));
                const float gt = ex / row_allsum_f(ex);
                const float2 sc2 = p.suv[e];
                const float dotf = (float)dotsl[j * 128 + r * 64 + lane] * cs_t * sc2.x;
                cr[r * 64 + lane] = gt * gelu_t(dotf) * sc2.y;
            }
        }
        asm volatile("s_waitcnt lgkmcnt(0)" ::: "memory");
    }
}

__device__ void phase_gather(const Params& p, char* lds) {
    const int tidx_ = tid_opaque();
    const int wave = __builtin_amdgcn_readfirstlane((int)((blockIdx.x * blockDim.x + tidx_) >> 6)), nwaves = (gridDim.x * blockDim.x) >> 6, lane = tidx_ & 63;
    const unsigned char* vb = p.v8 + lane * 12;
    const int ntok = (T_TOK - wave + nwaves - 1) / nwaves;
    auto tok = [&](int i) { const int ii = i < ntok ? i : ntok - 1; return wave + ii * nwaves; };
    if (ntok <= 0) return;
    u32x3 v0[8], v1[8], v2[8], v3[8];
    int ic0, ic1, in0, in1, ia0, ia1;
    float coef0, coef1, cn0, cn1;
    { const float* cr = p.coef + (size_t)tok(0) * 128; coef0 = cr[lane]; coef1 = cr[64 + lane]; }
    { const int* ir = p.idx + (size_t)tok(0) * 128; ic0 = ir[lane]; ic1 = ir[64 + lane]; }
    { const int* ir = p.idx + (size_t)tok(1) * 128; in0 = ir[lane]; in1 = ir[64 + lane]; }
    float g16[16];
#pragma unroll
    for (int i4 = 0; i4 < 4; ++i4) { const float4 g = ((const float4*)(p.final_g + lane * 16))[i4]; g16[4 * i4] = g.x; g16[4 * i4 + 1] = g.y; g16[4 * i4 + 2] = g.z; g16[4 * i4 + 3] = g.w; }
#define G2_ISSUE(vv, pbx) do { const int pbx_ = (pbx); const bool nx_ = pbx_ >= 128; const int pm_ = pbx_ & 127; \
        const int src_ = nx_ ? (pm_ < 64 ? in0 : in1) : (pm_ < 64 ? ic0 : ic1); \
        _Pragma("unroll") for (int q = 0; q < 8; ++q) { const int e = __builtin_amdgcn_readlane(src_, (pm_ & 63) + q); vv[q] = *(const u32x3*)(vb + (size_t)e * ROWB); } } while (0)
    __builtin_amdgcn_sched_barrier(0);
    G2_ISSUE(v0, 0); __builtin_amdgcn_sched_barrier(0); G2_ISSUE(v1, 8); __builtin_amdgcn_sched_barrier(0); G2_ISSUE(v2, 16); __builtin_amdgcn_sched_barrier(0);
#pragma unroll 1
    for (int i = 0; i < ntok; ++i) {
        const int t = tok(i);
        { const int* ir = p.idx + (size_t)tok(i + 2) * 128; ia0 = ir[lane]; ia1 = ir[64 + lane]; }
        const u32x4* hr = (const u32x4*)(p.hb + (size_t)t * D_MODEL + lane * 16);
        const u32x4 ha = hr[0], hc = hr[1];
        { const float* cr = p.coef + (size_t)tok(i + 1) * 128; cn0 = cr[lane]; cn1 = cr[64 + lane]; }
        const float cmax = wave_max(fmaxf(fabsf(coef0), fabsf(coef1)));
        const float qs = cmax > 0.f ? 127.0f / cmax : 0.f, cscale = cmax * (1.0f / 127.0f);
        const int cq0 = (int)rintf(coef0 * qs), cq1 = (int)rintf(coef1 * qs);
        const int csum_i = wave_sum_i_uniform(cq0 + cq1);
        unsigned cpk0, cpk1;
        {
            const int bb0 = cq0 & 0xff, bb1 = cq1 & 0xff;
            cpk0 = (unsigned)__builtin_amdgcn_update_dpp(0, bb0, 0x00, 0xf, 0xf, false) | ((unsigned)__builtin_amdgcn_update_dpp(0, bb0, 0x55, 0xf, 0xf, false) << 8)
                 | ((unsigned)__builtin_amdgcn_update_dpp(0, bb0, 0xAA, 0xf, 0xf, false) << 16) | ((unsigned)__builtin_amdgcn_update_dpp(0, bb0, 0xFF, 0xf, 0xf, false) << 24);
            cpk1 = (unsigned)__builtin_amdgcn_update_dpp(0, bb1, 0x00, 0xf, 0xf, false) | ((unsigned)__builtin_amdgcn_update_dpp(0, bb1, 0x55, 0xf, 0xf, false) << 8)
                 | ((unsigned)__builtin_amdgcn_update_dpp(0, bb1, 0xAA, 0xf, 0xf, false) << 16) | ((unsigned)__builtin_amdgcn_update_dpp(0, bb1, 0xFF, 0xf, 0xf, false) << 24);
        }
        int racc[12], jacc[12];
#pragma unroll
        for (int j = 0; j < 12; ++j) { racc[j] = 0; jacc[j] = 0; }
        auto axpy = [&](int pb, const u32x3 (&vv)[8]) __attribute__((always_inline)) {
#pragma unroll
            for (int g4 = 0; g4 < 2; ++g4) {
                const int cqd = __builtin_amdgcn_readlane((int)(pb < 64 ? cpk0 : cpk1), (pb & 63) + 4 * g4);
#pragma unroll
                for (int w = 0; w < 3; ++w) {
                    const unsigned wa = vv[4 * g4 + 0][w], wb = vv[4 * g4 + 1][w], wc = vv[4 * g4 + 2][w], wd = vv[4 * g4 + 3][w];
                    const unsigned p0 = __builtin_amdgcn_perm(wb, wa, 0x05010400u), p1 = __builtin_amdgcn_perm(wb, wa, 0x07030602u);
                    const unsigned q0 = __builtin_amdgcn_perm(wd, wc, 0x05010400u), q1 = __builtin_amdgcn_perm(wd, wc, 0x07030602u);
                    const unsigned t0 = __builtin_amdgcn_perm(q0, p0, 0x05040100u), t1 = __builtin_amdgcn_perm(q0, p0, 0x07060302u);
                    const unsigned t2 = __builtin_amdgcn_perm(q1, p1, 0x05040100u), t3 = __builtin_amdgcn_perm(q1, p1, 0x07060302u);
                    racc[4 * w + 0] = __builtin_amdgcn_sdot4((int)t0, cqd, racc[4 * w + 0], false); jacc[4 * w + 0] = __builtin_amdgcn_sdot4((int)(t0 & 0xc0c0c0c0u), cqd, jacc[4 * w + 0], false);
                    racc[4 * w + 1] = __builtin_amdgcn_sdot4((int)t1, cqd, racc[4 * w + 1], false); jacc[4 * w + 1] = __builtin_amdgcn_sdot4((int)(t1 & 0xc0c0c0c0u), cqd, jacc[4 * w + 1], false);
                    racc[4 * w + 2] = __builtin_amdgcn_sdot4((int)t2, cqd, racc[4 * w + 2], false); jacc[4 * w + 2] = __builtin_amdgcn_sdot4((int)(t2 & 0xc0c0c0c0u), cqd, jacc[4 * w + 2], false);
                    racc[4 * w + 3] = __builtin_amdgcn_sdot4((int)t3, cqd, racc[4 * w + 3], false); jacc[4 * w + 3] = __builtin_amdgcn_sdot4((int)(t3 & 0xc0c0c0c0u), cqd, jacc[4 * w + 3], false);
                }
            }
        };
#pragma unroll 1
        for (int pb = 0; pb < 128; pb += 32) {
            G2_ISSUE(v3, pb + 24); __builtin_amdgcn_sched_barrier(0); axpy(pb, v0); __builtin_amdgcn_sched_barrier(0);
            G2_ISSUE(v0, pb + 32); __builtin_amdgcn_sched_barrier(0); axpy(pb + 8, v1); __builtin_amdgcn_sched_barrier(0);
            G2_ISSUE(v1, pb + 40); __builtin_amdgcn_sched_barrier(0); axpy(pb + 16, v2); __builtin_amdgcn_sched_barrier(0);
            G2_ISSUE(v2, pb + 48); __builtin_amdgcn_sched_barrier(0); axpy(pb + 24, v3); __builtin_amdgcn_sched_barrier(0);
        }
        ic0 = in0; ic1 = in1; in0 = ia0; in1 = ia1;
        coef0 = cn0; coef1 = cn1;
        int acc[16];
#pragma unroll
        for (int j = 0; j < 12; ++j) acc[j] = (racc[j] - jacc[j]) - 32 * csum_i;
#pragma unroll
        for (int k = 0; k < 4; ++k) acc[12 + k] = ((jacc[k] + 4 * jacc[4 + k] + 16 * jacc[8 + k]) >> 6) + 10 * csum_i;
        const float hf16[16] = {bflo(ha.x), bfhi(ha.x), bflo(ha.y), bfhi(ha.y), bflo(ha.z), bfhi(ha.z), bflo(ha.w), bfhi(ha.w),
                                bflo(hc.x), bfhi(hc.x), bflo(hc.y), bfhi(hc.y), bflo(hc.z), bfhi(hc.z), bflo(hc.w), bfhi(hc.w)};
        float res[16];
        float ss = 0.f;
#pragma unroll
        for (int j = 0; j < 16; ++j) { res[j] = hf16[j] + cscale * (float)acc[j]; ss += res[j] * res[j]; }
        ss = wave_sum(ss);
        const float r3 = rsqrtf(ss * (1.0f / D_MODEL) + EPS);
        float* o = p.out + (size_t)t * D_MODEL + lane * 16;
#pragma unroll
        for (int i4 = 0; i4 < 4; ++i4) {
            float4 ov; ov.x = res[4 * i4] * r3 * g16[4 * i4]; ov.y = res[4 * i4 + 1] * r3 * g16[4 * i4 + 1]; ov.z = res[4 * i4 + 2] * r3 * g16[4 * i4 + 2]; ov.w = res[4 * i4 + 3] * r3 * g16[4 * i4 + 3];
            ((float4*)o)[i4] = ov;
        }
    }
#undef G2_ISSUE
}

namespace pg8 {
#define PG8_LAS __attribute__((address_space(3)))
constexpr int BM = 256, BK = 64, HALF = 128, HTB = HALF * BK * 2, STAGE_BYTES = 8 * HTB, NXCD = 8, WGM = 8;
__host__ __device__ __forceinline__ int lds_byte(int r, int c) { const int st = (r >> 4) * 2 + (c >> 5), rr = r & 15, cc = c & 31, ob = rr * 64 + cc * 2; return st * 1024 + (ob ^ (((ob >> 9) & 1) << 5)); }
__host__ __device__ __forceinline__ void stage_rc(int b, int& R, int& C) { const int st = b / 1024, sb = b % 1024, swz = sb ^ (((sb >> 9) & 1) << 5); R = (st >> 1) * 16 + swz / 64; C = (st & 1) * 32 + (swz % 64) / 2; }
__host__ __device__ __forceinline__ int perm32(int rho) { const int n = rho >> 4, i = rho & 15; return 8 * (i >> 2) + 4 * n + (i & 3); }
struct Unit { int pm, pn; };
struct Gemm { const bf16_t* A; const bf16_t* Bt; int M, N, K; };
struct StaticOrder {
    int nM, nN, nwg, G, c;
    __host__ __device__ void init(int M, int N, int G_, int c_) { nM = M / BM; nN = N / BM; nwg = nM * nN; G = G_; c = c_; }
    __host__ __device__ bool next(int i, Unit& u) const {
        const long L = (long)i * G + c; if (L >= nwg) return false;
        int wgid = (int)L; { const int q = nwg / NXCD, r = nwg % NXCD, xcd = wgid % NXCD, off = wgid / NXCD; wgid = (xcd < r ? xcd * (q + 1) : r * (q + 1) + (xcd - r) * q) + off; }
        const int nig = WGM * nN, gid = wgid / nig, fm = gid * WGM, gsz = (nM - fm) < WGM ? (nM - fm) : WGM;
        u.pm = fm + ((wgid % nig) % gsz); u.pn = (wgid % nig) / gsz; return true;
    }
    __device__ __forceinline__ void a_ready(const Unit&) const {}
    __device__ __forceinline__ void done(const Unit&) const {}
};
__device__ __forceinline__ unsigned cvt_pk_bf16(float lo, float hi) { unsigned r; asm volatile("v_cvt_pk_bf16_f32 %0, %1, %2" : "=v"(r) : "v"(lo), "v"(hi)); return r; }
template <bool I8> __device__ __forceinline__ typename std::conditional<I8, i32x4, f32x4>::type mma1(bf16x8 a, bf16x8 b, typename std::conditional<I8, i32x4, f32x4>::type c) {
    if constexpr (I8) return __builtin_amdgcn_mfma_i32_16x16x64_i8(*(const i32x4*)&a, *(const i32x4*)&b, c, 0, 0, 0);
    else return __builtin_amdgcn_mfma_f32_16x16x32_bf16(a, b, c, 0, 0, 0);
}
struct EpiZ8 {
    static constexpr bool PERM = true, AFTER_DRAIN = false, I8 = true; typedef i32x4 acc_t;
    bf16_t* O; const float* rsx; const unsigned* swb;
    __device__ __forceinline__ void operator()(const i32x4 (&acc)[2][2][4][2], const Unit& u, int wr, int wc, int fr, int fq) const {
        const int row0 = u.pm * BM + wr * 64 + fr, col0 = u.pn * BM + wc * 32 + 8 * fq; const bool act = u.pn >= 2;
        float sw[2][8];
#pragma unroll
        for (int bj = 0; bj < 2; ++bj) { const u32x4 a = *(const u32x4*)(swb + col0 + bj * HALF), c = *(const u32x4*)(swb + col0 + bj * HALF + 4);
#pragma unroll
            for (int i = 0; i < 4; ++i) { sw[bj][i] = __uint_as_float(a[i]) * (1.0f / 127.0f); sw[bj][4 + i] = __uint_as_float(c[i]) * (1.0f / 127.0f); } }
#pragma unroll
        for (int ai = 0; ai < 2; ++ai)
#pragma unroll
            for (int m = 0; m < 4; ++m) { const int r = row0 + ai * HALF + m * 16; const float sc = rsx[r]; bf16_t* rowp = O + (size_t)r * D_IN + col0;
#pragma unroll
                for (int bj = 0; bj < 2; ++bj) { f32x4 v0, v1;
#pragma unroll
                    for (int i = 0; i < 4; ++i) { v0[i] = (float)acc[ai][bj][m][0][i] * sc * sw[bj][i]; v1[i] = (float)acc[ai][bj][m][1][i] * sc * sw[bj][4 + i]; }
                    if (act) { v0 = (f32x4){gelu_t(v0[0]), gelu_t(v0[1]), gelu_t(v0[2]), gelu_t(v0[3])}; v1 = (f32x4){gelu_t(v1[0]), gelu_t(v1[1]), gelu_t(v1[2]), gelu_t(v1[3])}; }
                    u32x4 w; w.x = cvt_pk_bf16(v0[0], v0[1]); w.y = cvt_pk_bf16(v0[2], v0[3]); w.z = cvt_pk_bf16(v1[0], v1[1]); w.w = cvt_pk_bf16(v1[2], v1[3]);
                    *(u32x4*)(rowp + bj * HALF) = w; } }
    }
};
struct EpiZ {
    static constexpr bool PERM = true, AFTER_DRAIN = false, I8 = false; typedef f32x4 acc_t;
    bf16_t* O; const float* rs;
    __device__ __forceinline__ void operator()(const f32x4 (&acc)[2][2][4][2], const Unit& u, int wr, int wc, int fr, int fq) const {
        const int row0 = u.pm * BM + wr * 64 + fr, col0 = u.pn * BM + wc * 32 + 8 * fq; const bool act = u.pn >= 2;
#pragma unroll
        for (int ai = 0; ai < 2; ++ai)
#pragma unroll
            for (int m = 0; m < 4; ++m) { const int r = row0 + ai * HALF + m * 16; const float sc = rs[r]; bf16_t* rowp = O + (size_t)r * D_IN + col0;
#pragma unroll
                for (int bj = 0; bj < 2; ++bj) { f32x4 v0 = acc[ai][bj][m][0] * sc, v1 = acc[ai][bj][m][1] * sc;
                    if (act) { v0 = (f32x4){gelu_t(v0[0]), gelu_t(v0[1]), gelu_t(v0[2]), gelu_t(v0[3])}; v1 = (f32x4){gelu_t(v1[0]), gelu_t(v1[1]), gelu_t(v1[2]), gelu_t(v1[3])}; }
                    u32x4 w; w.x = cvt_pk_bf16(v0[0], v0[1]); w.y = cvt_pk_bf16(v0[2], v0[3]); w.z = cvt_pk_bf16(v1[0], v1[1]); w.w = cvt_pk_bf16(v1[2], v1[3]);
                    *(u32x4*)(rowp + bj * HALF) = w; } }
    }
};
struct EpiOut {
    static constexpr bool PERM = true, AFTER_DRAIN = false, I8 = false; typedef f32x4 acc_t;
    bf16_t* O; const signed char* X; const float* sx;
    __device__ __forceinline__ void operator()(const f32x4 (&acc)[2][2][4][2], const Unit& u, int wr, int wc, int fr, int fq) const {
        const int row0 = u.pm * BM + wr * 64 + fr, col0 = u.pn * BM + wc * 32 + 8 * fq;
#pragma unroll
        for (int ai = 0; ai < 2; ++ai)
#pragma unroll
            for (int m = 0; m < 4; ++m) { const int r = row0 + ai * HALF + m * 16; const size_t off = (size_t)r * D_MODEL + col0; const float sc = sx[r];
#pragma unroll
                for (int bj = 0; bj < 2; ++bj) { const u32x2 xx = *(const u32x2*)(X + off + bj * HALF);
                    f32x4 x0, x1;
#pragma unroll
                    for (int i = 0; i < 4; ++i) { x0[i] = (float)(signed char)(xx.x >> (8 * i)) * sc; x1[i] = (float)(signed char)(xx.y >> (8 * i)) * sc; }
                    const f32x4 v0 = acc[ai][bj][m][0] + x0, v1 = acc[ai][bj][m][1] + x1;
                    u32x4 w; w.x = cvt_pk_bf16(v0[0], v0[1]); w.y = cvt_pk_bf16(v0[2], v0[3]); w.z = cvt_pk_bf16(v1[0], v1[1]); w.w = cvt_pk_bf16(v1[2], v1[3]);
                    *(u32x4*)(O + off + bj * HALF) = w; } }
    }
};
struct OneUnit {
    Unit u;
    __device__ __forceinline__ bool next(int i, Unit& o) const { if (i) return false; o = u; return true; }
    __device__ __forceinline__ void a_ready(const Unit&) const {}
    __device__ __forceinline__ void done(const Unit&) const {}
};
#define QT_PITCH 272
#define QT_LDS_BYTES (2 * 256 * QT_PITCH)
struct EpiQTopk {
    static constexpr bool PERM = true, AFTER_DRAIN = true, I8 = true; typedef i32x4 acc_t;
    const bf16_t* keysB; int* idx; float* gate; const unsigned* swq;
    __device__ __forceinline__ void fused(i32x4 (&acc)[2][2][4][2], const Unit& u, int wr, int wc, int fr, int fq, PG8_LAS unsigned char* ldsp, int wid, int lane) const {
        char* sQ = (char*)ldsp;
        const int h = u.pn;
        float sw[2][8];
#pragma unroll
        for (int bj = 0; bj < 2; ++bj) { const u32x4 a = *(const u32x4*)(swq + u.pn * BM + bj * HALF + wc * 32 + 8 * fq), c = *(const u32x4*)(swq + u.pn * BM + bj * HALF + wc * 32 + 8 * fq + 4);
#pragma unroll
            for (int i = 0; i < 4; ++i) { sw[bj][i] = __uint_as_float(a[i]) * (1.0f / 127.0f); sw[bj][4 + i] = __uint_as_float(c[i]) * (1.0f / 127.0f); } }
#pragma unroll
        for (int ai = 0; ai < 2; ++ai)
#pragma unroll
            for (int m = 0; m < 4; ++m) { const int r = ai * HALF + wr * 64 + m * 16 + fr;
#pragma unroll
                for (int bj = 0; bj < 2; ++bj) { f32x4 v0, v1;
#pragma unroll
                    for (int i = 0; i < 4; ++i) { v0[i] = (float)acc[ai][bj][m][0][i] * sw[bj][i]; v1[i] = (float)acc[ai][bj][m][1][i] * sw[bj][4 + i]; }
                    u32x4 w; w.x = cvt_pk_bf16(v0[0], v0[1]); w.y = cvt_pk_bf16(v0[2], v0[3]); w.z = cvt_pk_bf16(v1[0], v1[1]); w.w = cvt_pk_bf16(v1[2], v1[3]);
                    *(u32x4*)(sQ + bj * (256 * QT_PITCH) + r * QT_PITCH + (wc * 32 + fq * 8) * 2) = w; } }
        __syncthreads();
        int cbv[4];
#pragma unroll
        for (int c = 0; c < 4; ++c) cbv[c] = kComb[4 * fr + c];
        int tA[2][4], tB[2][4];
#pragma unroll
        for (int m = 0; m < 2; ++m)
#pragma unroll
            for (int j = 0; j < 4; ++j) { tA[m][j] = 0; tB[m][j] = 0; }
#pragma unroll 1
        for (int pp = 0; pp < 2; ++pp) {
            const bf16_t* kb = keysB + (size_t)(pp * 8 + h) * 16384 + lane * 8;
            const char* qa = sQ + pp * (256 * QT_PITCH) + (wid * 32 + fr) * QT_PITCH + fq * 16;
            f32x4 sc2[2][8];
#pragma unroll
            for (int m = 0; m < 2; ++m)
#pragma unroll
                for (int nb = 0; nb < 8; ++nb) sc2[m][nb] = (f32x4){0.f, 0.f, 0.f, 0.f};
#pragma unroll
            for (int kk = 0; kk < 4; ++kk) {
                bf16x8 kf[8], af[2];
#pragma unroll
                for (int nb = 0; nb < 8; ++nb) kf[nb] = *(const bf16x8*)(kb + (kk * 8 + nb) * 512);
#pragma unroll
                for (int m = 0; m < 2; ++m) af[m] = *(const bf16x8*)(qa + m * 16 * QT_PITCH + kk * 64);
#pragma unroll
                for (int m = 0; m < 2; ++m)
#pragma unroll
                    for (int nb = 0; nb < 8; ++nb) sc2[m][nb] = __builtin_amdgcn_mfma_f32_16x16x32_bf16(af[m], kf[nb], sc2[m][nb], 0, 0, 0);
            }
#pragma unroll
            for (int m = 0; m < 2; ++m)
#pragma unroll
                for (int j = 0; j < 4; ++j) tA[m][j] = tB[m][j];
#pragma unroll 2
            for (int it = 0; it < 4; ++it) {
#pragma unroll
                for (int m = 0; m < 2; ++m) {
                    int k[8];
#pragma unroll
                    for (int nb = 0; nb < 8; ++nb) k[nb] = (f2key(sc2[m][nb][0]) & ~127) | (127 - (16 * nb + fr));
                    const int r = top16_rows(k, fr);
                    tB[m][0] = tB[m][1]; tB[m][1] = tB[m][2]; tB[m][2] = tB[m][3]; tB[m][3] = r;
#pragma unroll
                    for (int nb = 0; nb < 8; ++nb) sc2[m][nb] = (f32x4){sc2[m][nb][1], sc2[m][nb][2], sc2[m][nb][3], sc2[m][nb][0]};
                }
            }
        }
#pragma unroll 2
        for (int it = 0; it < 4; ++it) {
#pragma unroll
            for (int m = 0; m < 2; ++m) {
                int eid; float gt;
                combine16(tA[m][0], tB[m][0], cbv, lane, fr, eid, gt);
                const int t = u.pm * BM + wid * 32 + m * 16 + fq * 4 + it;
                const size_t o = (size_t)t * 128 + h * 16 + fr;
                idx[o] = eid; gate[o] = gt;
                tA[m][0] = tA[m][1]; tA[m][1] = tA[m][2]; tA[m][2] = tA[m][3];
                tB[m][0] = tB[m][1]; tB[m][1] = tB[m][2]; tB[m][2] = tB[m][3];
            }
        }
        __syncthreads();
    }
};
template <class Epi, class Sched>
__device__ __forceinline__ void gemm_phase(PG8_LAS unsigned char* lds, const Gemm g, const Sched& S, const Epi& E) {
    const int tid = tid_opaque(), wid = __builtin_amdgcn_readfirstlane(tid >> 6), lane = tid & 63, wr = wid >> 2, wc = wid & 3, fr = lane & 15, fq = lane >> 4;
    const int K = g.K, nt = K / BK;
    unsigned voffA[2], voffB[2];
#pragma unroll
    for (int i = 0; i < 2; ++i) { int R, C; stage_rc(tid * 16 + i * 8192, R, C); const int Rb = Epi::PERM ? ((R & ~31) + perm32(R & 31)) : R;
        voffA[i] = (unsigned)(R * K + C) * 2u; voffB[i] = (unsigned)(Rb * K + C) * 2u; }
    const size_t kstep = (size_t)(BK * 2);
    const size_t hstep = (size_t)HALF * K * 2;
    const size_t tstep = 2 * hstep;
    const unsigned ldsw = (unsigned)wid * 1024u;
    const int aoff = lds_byte(wr * 64 + fr, fq * 8), boff = lds_byte(wc * 32 + fr, fq * 8);
#define PG8_SA(b, h) (((b) * 2 + (h)) * HTB)
#define PG8_SB(b, h) ((4 + (b) * 2 + (h)) * HTB)
#define PG8_STAGE(bufoff, gbase, voff) do { _Pragma("unroll") for (int _i = 0; _i < 2; ++_i) \
        __builtin_amdgcn_global_load_lds((const unsigned*)((const char*)(gbase) + (voff)[_i]), (PG8_LAS unsigned*)(lds + (bufoff) + ldsw + _i * 8192), 16, 0, 0); } while (0)
#define PG8_LDA(dst, b, h) do { _Pragma("unroll") for (int m = 0; m < 4; ++m) _Pragma("unroll") for (int k = 0; k < 2; ++k) dst[m][k] = *(const PG8_LAS bf16x8*)(lds + PG8_SA(b, h) + aoff + m * 2048 + k * 1024); } while (0)
#define PG8_LDB(dst, b, h) do { _Pragma("unroll") for (int n = 0; n < 2; ++n) _Pragma("unroll") for (int k = 0; k < 2; ++k) dst[n][k] = *(const PG8_LAS bf16x8*)(lds + PG8_SB(b, h) + boff + n * 2048 + k * 1024); } while (0)
#define PG8_MMA(ai, bj, At, Bt) do { __builtin_amdgcn_s_setprio(1); _Pragma("unroll") for (int m = 0; m < 4; ++m) _Pragma("unroll") for (int n = 0; n < 2; ++n) _Pragma("unroll") for (int k = 0; k < 2; ++k) \
        acc[ai][bj][m][n] = mma1<Epi::I8>(Bt[n][k], At[m][k], acc[ai][bj][m][n]); __builtin_amdgcn_s_setprio(0); } while (0)
#define PG8_WAIT_V(n) asm volatile("s_waitcnt vmcnt(" #n ")" ::: "memory")
#define PG8_WAIT_L(n) asm volatile("s_waitcnt lgkmcnt(" #n ")" ::: "memory")
#define PG8_BAR __builtin_amdgcn_s_barrier()
#define PG8_SCHED __builtin_amdgcn_sched_barrier(0)
    Unit cur, nxt; int ui = 0;
    if (!S.next(0, cur)) return;
    typedef typename Epi::acc_t acc_t;
    acc_t acc[2][2][4][2];
#pragma unroll
    for (int a = 0; a < 2; ++a)
#pragma unroll
        for (int b = 0; b < 2; ++b)
#pragma unroll
            for (int m = 0; m < 4; ++m)
#pragma unroll
                for (int n = 0; n < 2; ++n) acc[a][b][m][n] = (acc_t)(0);
    bf16x8 At[4][2], B0[2][2], B1[2][2];
    const char* cA = (const char*)g.A + (size_t)cur.pm * tstep; const char* cB = (const char*)g.Bt + (size_t)cur.pn * tstep;
    S.a_ready(cur);
    PG8_STAGE(PG8_SB(0, 0), cB, voffB); PG8_STAGE(PG8_SA(0, 0), cA, voffA); PG8_STAGE(PG8_SB(0, 1), cB + hstep, voffB); PG8_STAGE(PG8_SA(0, 1), cA + hstep, voffA);
    if (wr == 1) PG8_BAR;
    PG8_WAIT_V(4); PG8_BAR;
    PG8_STAGE(PG8_SB(1, 0), cB + kstep, voffB); PG8_STAGE(PG8_SA(1, 0), cA + kstep, voffA); PG8_STAGE(PG8_SB(1, 1), cB + hstep + kstep, voffB);
    PG8_WAIT_V(6); PG8_BAR;
    for (;;) {
        const bool has_next = S.next(ui + 1, nxt);
        const char* nA = has_next ? (const char*)g.A + (size_t)nxt.pm * tstep : cA; const char* nB = has_next ? (const char*)g.Bt + (size_t)nxt.pn * tstep : cB;
        for (int t = 0; t < nt; t += 2) {
            const bool last = (t == nt - 2);
            const char* a1 = cA + (size_t)(t + 1) * kstep;
            const char* a2 = last ? nA : cA + (size_t)(t + 2) * kstep; const char* b2 = last ? nB : cB + (size_t)(t + 2) * kstep;
            const char* a3 = a2 + kstep; const char* b3 = b2 + kstep;
            if (last && has_next) S.a_ready(nxt);
            PG8_LDB(B0, 0, 0); PG8_SCHED; PG8_LDA(At, 0, 0); PG8_STAGE(PG8_SA(1, 1), a1 + hstep, voffA);
            PG8_WAIT_L(8); PG8_BAR; PG8_WAIT_L(0); PG8_MMA(0, 0, At, B0); PG8_BAR; PG8_SCHED;
            PG8_LDB(B1, 0, 1); PG8_STAGE(PG8_SB(0, 0), b2, voffB);
            PG8_BAR; PG8_WAIT_L(0); PG8_MMA(0, 1, At, B1); PG8_BAR;
            PG8_LDA(At, 0, 1); PG8_STAGE(PG8_SA(0, 0), a2, voffA);
            PG8_BAR; PG8_WAIT_L(0); PG8_MMA(1, 0, At, B0); PG8_BAR; PG8_SCHED;
            PG8_STAGE(PG8_SB(0, 1), b2 + hstep, voffB);
            PG8_WAIT_V(6); PG8_BAR; PG8_MMA(1, 1, At, B1); PG8_BAR;
            PG8_LDB(B0, 1, 0); PG8_SCHED; PG8_LDA(At, 1, 0); PG8_STAGE(PG8_SA(0, 1), a2 + hstep, voffA);
            PG8_WAIT_L(8); PG8_BAR; PG8_WAIT_L(0); PG8_MMA(0, 0, At, B0); PG8_BAR; PG8_SCHED;
            PG8_LDB(B1, 1, 1); PG8_STAGE(PG8_SB(1, 0), b3, voffB);
            PG8_BAR; PG8_WAIT_L(0); PG8_MMA(0, 1, At, B1); PG8_BAR;
            PG8_LDA(At, 1, 1); PG8_STAGE(PG8_SA(1, 0), a3, voffA);
            PG8_BAR; PG8_WAIT_L(0); PG8_MMA(1, 0, At, B0); PG8_BAR; PG8_SCHED;
            PG8_STAGE(PG8_SB(1, 1), b3 + hstep, voffB);
            PG8_WAIT_V(6); PG8_BAR; PG8_MMA(1, 1, At, B1); PG8_BAR;
        }
            if constexpr (!Epi::AFTER_DRAIN) { E(acc, cur, wr, wc, fr, fq); S.done(cur); }
            if (!has_next) break;
#pragma unroll
        for (int a = 0; a < 2; ++a)
#pragma unroll
            for (int b = 0; b < 2; ++b)
#pragma unroll
                for (int m = 0; m < 4; ++m)
#pragma unroll
                    for (int n = 0; n < 2; ++n) acc[a][b][m][n] = (acc_t)(0);
        cur = nxt; cA = nA; cB = nB; ++ui;
    }
    PG8_WAIT_V(0);
    if (wr == 0) PG8_BAR;
    PG8_BAR;
    if constexpr (Epi::AFTER_DRAIN) { E.fused(acc, cur, wr, wc, fr, fq, lds, wid, lane); S.done(cur); }
#undef PG8_SA
#undef PG8_SB
#undef PG8_STAGE
#undef PG8_LDA
#undef PG8_LDB
#undef PG8_MMA
#undef PG8_WAIT_V
#undef PG8_WAIT_L
#undef PG8_BAR
#undef PG8_SCHED
}
}

__device__ void phase_gemm_z(const Params& p, char* lds) {
    pg8::StaticOrder S; S.init(T_TOK, D_IN, gridDim.x, blockIdx.x);
    pg8::gemm_phase<pg8::EpiZ8, pg8::StaticOrder>((PG8_LAS unsigned char*)lds, pg8::Gemm{(const bf16_t*)p.xq, (const bf16_t*)p.winT8, T_TOK, D_IN, D_MODEL / 2}, S, pg8::EpiZ8{p.zb, p.rstd1, p.swb});
}
__device__ void phase_gemm_out(const Params& p, char* lds) {
    pg8::StaticOrder S; S.init(T_TOK, D_MODEL, gridDim.x, blockIdx.x);
    pg8::gemm_phase<pg8::EpiOut, pg8::StaticOrder>((PG8_LAS unsigned char*)lds, pg8::Gemm{p.cB, p.woutT, T_TOK, D_MODEL, D_MODEL}, S, pg8::EpiOut{p.hb, p.xq, p.sx});
}
__device__ void phase_gemm_q(const Params& p, char* lds) {
    pg8::StaticOrder S; S.init(T_TOK, 2048, gridDim.x, blockIdx.x);
    pg8::Unit u;
    for (int i = 0; S.next(i, u); ++i)
        pg8::gemm_phase<pg8::EpiQTopk, pg8::OneUnit>((PG8_LAS unsigned char*)lds, pg8::Gemm{(const bf16_t*)p.hq, (const bf16_t*)p.wqT8, T_TOK, 2048, D_MODEL / 2}, pg8::OneUnit{u}, pg8::EpiQTopk{p.keysB, p.idx, p.gate, p.swq});
}

#define XB_TMO      128
#define XB_XCNT(j)  (256  + 64 * (j))
#define XB_XSUB(j)  (1280 + 64 * (j))
#define XB_XGEN(j)  (2304 + 64 * (j))
#define XB_TOP      3328
#define XB_TOPGEN   3392
#define XCD_BAR_WORDS 3456
#define XB_SPIN_CAP (1u << 20)
__device__ __forceinline__ unsigned xb_ld(unsigned* p)              { return __hip_atomic_load(p, __ATOMIC_RELAXED, __HIP_MEMORY_SCOPE_AGENT); }
__device__ __forceinline__ unsigned xb_add(unsigned* p, unsigned v) { return __hip_atomic_fetch_add(p, v, __ATOMIC_RELAXED, __HIP_MEMORY_SCOPE_AGENT); }
__device__ __forceinline__ unsigned xb_xcc_id() { return (unsigned)__builtin_amdgcn_s_getreg((3 << 11) | 20) & 0xFu; }
#define XB_SPIN(cond, bar) do { unsigned _sp = 0; while (cond) { __builtin_amdgcn_s_sleep(1); \
    if ((++_sp & 255u) == 0u) { if (xb_ld(&(bar)[XB_TMO])) break; if (_sp > XB_SPIN_CAP) { atomicAdd(&(bar)[XB_TMO], 1u); break; } } } } while (0)
struct XcdBarrier { unsigned* bar; unsigned x; volatile LAS unsigned* st; };
__device__ __forceinline__ XcdBarrier xcd_barrier_post(unsigned* bar, volatile LAS unsigned* st) {
    XcdBarrier b; b.bar = bar; b.x = xb_xcc_id(); b.st = st;
    if (threadIdx.x == 0) (void)xb_add(&bar[XB_XCNT(b.x)], 1u);
    return b;
}
__device__ __forceinline__ void xcd_barrier_complete(unsigned* bar, unsigned x, unsigned& nloc, unsigned& nx) {
    const unsigned G = gridDim.x * gridDim.y * gridDim.z;
    unsigned sum, cnt, mine, sp = 0u;
    for (;;) {
        sum = 0u; cnt = 0u; mine = 0u;
#pragma unroll
        for (unsigned j = 0; j < 16; ++j) { const unsigned c = xb_ld(&bar[XB_XCNT(j)]); sum += c; cnt += (c > 0u) ? 1u : 0u; mine = (j == x) ? c : mine; }
        if (sum == G) break;
        __builtin_amdgcn_s_sleep(1);
        if ((++sp & 255u) == 0u) { if (xb_ld(&bar[XB_TMO])) break; if (sp > XB_SPIN_CAP) { atomicAdd(&bar[XB_TMO], 1u); break; } }
    }
    nloc = mine > 0u ? mine : 1u; nx = cnt > 0u ? cnt : 1u;
}
__device__ __forceinline__ void xcd_barrier(const XcdBarrier& b) {
    asm volatile("s_waitcnt vmcnt(0)" ::: "memory");
    __syncthreads();
    if (threadIdx.x == 0) {
        unsigned* bar = b.bar;
        __builtin_amdgcn_s_waitcnt(0);
        unsigned nloc = b.st[0], nx = b.st[1];
        if (nloc == 0u) { xcd_barrier_complete(bar, b.x, nloc, nx); b.st[0] = nloc; b.st[1] = nx; }
        const unsigned old = xb_add(&bar[XB_XSUB(b.x)], 1u);
        const unsigned gen = old / nloc;
        if (old + 1u == (gen + 1u) * nloc) {
            __builtin_amdgcn_fence(__ATOMIC_RELEASE, "agent");
            asm volatile("s_waitcnt vmcnt(0)" ::: "memory");
            const unsigned og = xb_add(&bar[XB_TOP], 1u);
            const unsigned tg = og / nx;
            if (og + 1u == (tg + 1u) * nx) xb_add(&bar[XB_TOPGEN], 1u);
            else XB_SPIN(xb_ld(&bar[XB_TOPGEN]) == tg, bar);
            __builtin_amdgcn_fence(__ATOMIC_ACQUIRE, "agent");
            xb_add(&bar[XB_XGEN(b.x)], 1u);
            asm volatile("s_waitcnt vmcnt(0)" ::: "memory");
        } else {
            XB_SPIN(xb_ld(&bar[XB_XGEN(b.x)]) == gen, bar);
            __builtin_amdgcn_fence(__ATOMIC_ACQUIRE, "agent");
            asm volatile("s_waitcnt vmcnt(0)" ::: "memory");
        }
    }
    __syncthreads();
}

#define MEGA_LDS_MAX2(a, b) ((a) > (b) ? (a) : (b))
#define MEGA_LDS_MAIN MEGA_LDS_MAX2(MEGA_LDS_MAX2(QT_LDS_BYTES, pg8::STAGE_BYTES), MEGA_LDS_MAX2(8 * TS_WBYTES, 2 * MIXH_LDS))
#define MEGA_LDS_BYTES (MEGA_LDS_MAIN + 16)
extern __shared__ __attribute__((aligned(16))) char smem[];
__global__ void __launch_bounds__(512, 2) fwd_mega(Params p) {
    volatile LAS unsigned* st = (volatile LAS unsigned*)(smem + MEGA_LDS_MAIN);
    if (threadIdx.x < 4) st[threadIdx.x] = 0u;
    __syncthreads();
    const XcdBarrier xb = xcd_barrier_post(p.bar, st);
    phase_prep(p, smem);      xcd_barrier(xb);
    phase_gemm_z(p, smem);    xcd_barrier(xb);
    phase_mix_gemm(p, smem);  xcd_barrier(xb);
    phase_gemm_out(p, smem);  xcd_barrier(xb);
    phase_hquant(p, smem);    xcd_barrier(xb);
    phase_gemm_q(p, smem);    xcd_barrier(xb);
    phase_peer_dots(p, smem); xcd_barrier(xb);
    phase_gather(p, smem);
}

extern "C" void kernel_launch(void* const* d_in, const int* in_sizes, int n_in, void* d_out, int out_size, void* d_ws, size_t ws_size, hipStream_t stream) {
    static int grid_blocks = 0;
    if (grid_blocks == 0) {
        int dev = 0, cus = 0, per_cu = 0;
        (void)hipGetDevice(&dev);
        (void)hipDeviceGetAttribute(&cus, hipDeviceAttributeMultiprocessorCount, dev);
        (void)hipFuncSetAttribute((const void*)fwd_mega, hipFuncAttributeMaxDynamicSharedMemorySize, MEGA_LDS_BYTES);
        (void)hipOccupancyMaxActiveBlocksPerMultiprocessor(&per_cu, (const void*)fwd_mega, 512, MEGA_LDS_BYTES);
        if (per_cu > 1) per_cu = 1;
        if (per_cu < 1) per_cu = 1;
        grid_blocks = cus * per_cu;
    }
    Params p{};
    p.x = (const float*)d_in[0]; p.norm1_g = (const float*)d_in[1]; p.w_in = (const float*)d_in[2]; p.pool_w = (const float*)d_in[3];
    p.pool_scale = (const float*)d_in[4]; p.sgu_norm_g = (const float*)d_in[5]; p.sgu_w = (const float*)d_in[6]; p.sgu_b = (const float*)d_in[7];
    p.w_out = (const float*)d_in[8]; p.norm2_g = (const float*)d_in[9]; p.peer_wq = (const float*)d_in[10]; p.peer_keys = (const float*)d_in[11];
    p.peer_u = (const float*)d_in[12]; p.peer_v = (const float*)d_in[13]; p.final_g = (const float*)d_in[14];
    p.out = (float*)d_out;
    char* w = (char*)d_ws; size_t off = 0;
    auto take = [&](size_t bytes) { char* r = w + off; off += (bytes + 255) & ~(size_t)255; return r; };
    const size_t MiB = 1024 * 1024;
    p.u8 = (unsigned char*)take(16 * MiB); p.v8 = (unsigned char*)take(12 * MiB);
    p.suv = (float2*)take(128 * 1024);
    p.winT = (bf16_t*)take(3 * MiB); p.woutT = (bf16_t*)take(2 * MiB); p.wqT = (bf16_t*)take(4 * MiB);
    p.poolT = (bf16_t*)take(128 * 1024); p.wsM = (bf16_t*)take(128 * 1024); p.keysB = (bf16_t*)take(512 * 1024);
    p.bar = (unsigned*)take(XCD_BAR_WORDS * 4 + 4608 * 4); p.swb = p.bar + XCD_BAR_WORDS; p.swq = p.swb + 2048;
    p.rstd1 = (float*)take(128 * 1024); p.sx = (float*)take(128 * 1024); p.xq = (signed char*)take(32 * MiB); p.winT8 = (signed char*)take(1536 * 1024); p.wqT8 = (signed char*)take(2048 * 1024); p.hq = (signed char*)take(32 * MiB); p.hsc = (float*)take(128 * 1024);
    p.idx = (int*)take(16 * MiB); p.gate = (float*)take(16 * MiB); p.coef = (float*)take(16 * MiB);
    p.xb = (bf16_t*)take(64 * MiB); p.zb = (bf16_t*)take(96 * MiB); p.cB = (bf16_t*)take(64 * MiB); p.hb = (bf16_t*)take(64 * MiB);
    (void)hipMemsetAsync(p.bar, 0, XCD_BAR_WORDS * 4 + 4608 * 4, stream);
    hipLaunchKernelGGL(fwd_mega, dim3(grid_blocks), dim3(512), MEGA_LDS_BYTES, stream, p);
}
```

```cpp
#include <hip/hip_runtime.h>
#include <stdint.h>
#include <type_traits>

typedef unsigned short bf16_t;
typedef short bf16x8 __attribute__((ext_vector_type(8)));
typedef float f32x4 __attribute__((ext_vector_type(4)));
typedef unsigned u32x4 __attribute__((ext_vector_type(4)));
typedef unsigned u32x2 __attribute__((ext_vector_type(2)));
typedef unsigned u32x3 __attribute__((ext_vector_type(3)));
typedef int i32x4 __attribute__((ext_vector_type(4)));
#define ROWB 768
typedef __bf16 bf2_t __attribute__((ext_vector_type(2)));
#define LAS __attribute__((address_space(3)))

#define T_TOK 32768
#define D_MODEL 1024
#define D_IN 1536
#define SEQ 2048
#define NEXP 16384
#define EPS 1e-6f

struct Params {
    const float *x, *norm1_g, *w_in, *pool_w, *pool_scale, *sgu_norm_g, *sgu_w, *sgu_b, *w_out, *norm2_g, *peer_wq, *peer_keys, *peer_u, *peer_v, *final_g;
    float* out;
    bf16_t *woutT, *poolT, *wsM, *keysB;
    unsigned char *u8, *v8;
    float2* suv;
    float *rstd1, *sx;
    signed char *xq, *winT8, *hq, *wqT8; unsigned *swb, *swq; float* hsc;
    bf16_t *zb, *cB, *hb;
    int* idx; float* gate; float* coef;
    unsigned* bar;
};

__device__ __forceinline__ int tid_opaque() { int t = (int)threadIdx.x; asm volatile("" : "+v"(t)); return t; }
__device__ __forceinline__ unsigned short f2bf(float f) {
    unsigned u = __float_as_uint(f);
    u += 0x7fffu + ((u >> 16) & 1u);
    return (unsigned short)(u >> 16);
}
__device__ __forceinline__ float bf2f(unsigned short h) { return __uint_as_float(((unsigned)h) << 16); }
__device__ __forceinline__ unsigned pack2(float a, float b) { return (unsigned)f2bf(a) | ((unsigned)f2bf(b) << 16); }
__device__ __forceinline__ float bflo(unsigned w) { return __uint_as_float(w << 16); }
__device__ __forceinline__ float bfhi(unsigned w) { return __uint_as_float(w & 0xffff0000u); }
__device__ __forceinline__ float gelu_t(float x) {
    const float y = 1.5957691216057308f * (x + 0.044715f * x * x * x);
    return x * __builtin_amdgcn_rcpf(1.0f + __expf(-y));
}
__device__ __forceinline__ float wave_sum(float v) {
#pragma unroll
    for (int o = 32; o >= 1; o >>= 1) v += __shfl_xor(v, o);
    return v;
}
__device__ __forceinline__ float wave_max(float v) {
#pragma unroll
    for (int o = 32; o >= 1; o >>= 1) v = fmaxf(v, __shfl_xor(v, o));
    return v;
}

#define GEMM_LDS_BYTES (2 * 128 * 144)
__device__ __forceinline__ void transpose_tile(const int tid, const float* __restrict__ src, bf16_t* __restrict__ dst, int R, int C, const float* __restrict__ rscale, int tile, float* lds) {
    const int tilesC = C / 64, tr = tile / tilesC, tc = tile % tilesC;
    const int ty = tid >> 6, tx = tid & 63;
    __syncthreads();
#pragma unroll
    for (int i = 0; i < 16; ++i) {
        const int r = ty + 4 * i;
        float v = src[(size_t)(tr * 64 + r) * C + tc * 64 + tx];
        if (rscale) v *= rscale[tr * 64 + r];
        lds[r * 65 + tx] = v;
    }
    __syncthreads();
#pragma unroll
    for (int i = 0; i < 16; ++i) {
        const int c = ty + 4 * i;
        dst[(size_t)(tc * 64 + c) * R + tr * 64 + tx] = f2bf(lds[tx * 65 + c]);
    }
}

__device__ __forceinline__ void w8_colmax(const float* __restrict__ src, const float* __restrict__ gain, int C, unsigned* mx, unsigned* cnt, int hb2, int nh, int ht) {
    const int ncb = C / 64;
    for (int t = hb2; t < 16 * ncb; t += nh) {
        const int tr = t / ncb, tc = t % ncb, ty = ht >> 6, tx = ht & 63;
        float am = 0.f;
#pragma unroll
        for (int i = 0; i < 16; ++i) { const int r = tr * 64 + ty + 4 * i; am = fmaxf(am, fabsf(src[(size_t)r * C + tc * 64 + tx] * gain[r])); }
        (void)__hip_atomic_fetch_max(mx + tc * 64 + tx, __float_as_uint(am), __ATOMIC_RELAXED, __HIP_MEMORY_SCOPE_AGENT);
        asm volatile("s_waitcnt vmcnt(0)" ::: "memory");
        __syncthreads();
        if (ht == 0) (void)__hip_atomic_fetch_add(cnt + tc, 1u, __ATOMIC_RELAXED, __HIP_MEMORY_SCOPE_AGENT);
    }
}
__device__ __forceinline__ void w8_tiles(const float* __restrict__ src, const float* __restrict__ gain, int C, signed char* __restrict__ dst, unsigned* mx, unsigned* cnt, char* lds, int tid) {
    const int half = tid >> 8, ht = tid & 255, ty = ht >> 6, tx = ht & 63, ncb = C / 64;
    float* fl = (float*)(lds + half * (64 * 65 * 4));
    for (int t = 2 * blockIdx.x + half; t < 16 * ncb; t += 2 * gridDim.x) {
        const int tr = t / ncb, tc = t % ncb;
        if (ht == 0) {
            unsigned spins = 0;
            while (__hip_atomic_load(cnt + tc, __ATOMIC_RELAXED, __HIP_MEMORY_SCOPE_AGENT) < 16u && ++spins < (1u << 22)) __builtin_amdgcn_s_sleep(2);
        }
        __syncthreads();
#pragma unroll
        for (int i = 0; i < 16; ++i) { const int r = ty + 4 * i; fl[r * 65 + tx] = src[(size_t)(tr * 64 + r) * C + tc * 64 + tx] * gain[tr * 64 + r]; }
        __syncthreads();
#pragma unroll
        for (int i = 0; i < 16; ++i) {
            const int c = ty + 4 * i;
            const float am = __uint_as_float(__hip_atomic_load(mx + tc * 64 + c, __ATOMIC_RELAXED, __HIP_MEMORY_SCOPE_AGENT));
            const float inv = am > 0.f ? 127.0f / am : 0.f;
            dst[(size_t)(tc * 64 + c) * 1024 + tr * 64 + tx] = (signed char)(int)rintf(fl[tx * 65 + c] * inv);
        }
    }
}

__device__ void phase_prep(const Params& p, char* lds) {
    const int tidx_ = tid_opaque();
    const int nb = gridDim.x, b = blockIdx.x, tid = tidx_;
    const int half = tid >> 8, ht = tid & 255, nh = 2 * nb, hb2 = 2 * b + half;
    float* fl = (float*)(lds + half * (64 * 65 * 4));
    w8_colmax(p.w_in, p.norm1_g, 1536, p.swb, p.swb + 1536, hb2, nh, ht);
    w8_colmax(p.peer_wq, p.norm2_g, 2048, p.swq, p.swq + 2048, hb2, nh, ht);
    for (int t = hb2; t < 16 * 16; t += nh) transpose_tile(ht, p.w_out, p.woutT, 1024, 1024, nullptr, t, fl);
    for (int t = hb2; t < 16; t += nh) transpose_tile(ht, p.pool_w + (size_t)(t >> 2) * 16384, p.poolT + (size_t)(t >> 2) * 16384, 128, 128, nullptr, t & 3, fl);
    const size_t gtid = (size_t)b * blockDim.x + tid, gsz = (size_t)nb * blockDim.x;
    for (size_t i = gtid; i < 4 * 128 * 128; i += gsz) {
        const int j = (int)(i & 127), ii = (int)((i >> 7) & 127);
        const bool keep = (j >> 6) <= (ii >> 6);
        p.wsM[i] = keep ? f2bf(p.sgu_w[i]) : (bf16_t)0;
    }
    for (size_t o = gtid; o < 2 * 8 * 128 * 128; o += gsz) {
        const int j = (int)(o & 7), ln = (int)((o >> 3) & 63), nb = (int)((o >> 9) & 7), kk = (int)((o >> 12) & 3), ph = (int)(o >> 14);
        p.keysB[o] = f2bf(p.peer_keys[(size_t)ph * 16384 + (size_t)(16 * nb + (ln & 15)) * 128 + 32 * kk + 8 * (ln >> 4) + j]);
    }
    {
        const int wave = (b * blockDim.x + tid) >> 6, nwaves = (nb * blockDim.x) >> 6, lane = tid & 63;
        float g16[16];
#pragma unroll
        for (int i = 0; i < 4; ++i) { const float4 g = ((const float4*)(p.norm2_g + lane * 16))[i]; g16[4 * i] = g.x; g16[4 * i + 1] = g.y; g16[4 * i + 2] = g.z; g16[4 * i + 3] = g.w; }
        auto quant_row = [&](const float (&f)[16], unsigned char* dst, float* scale_out) {
            float am = 0.f;
#pragma unroll
            for (int j = 0; j < 16; ++j) am = fmaxf(am, fabsf(f[j]));
            am = wave_max(am);
            const float inv = am > 0.f ? 31.0f / am : 0.f;
            int q[16];
#pragma unroll
            for (int j = 0; j < 16; ++j) q[j] = (int)rintf(f[j] * inv) + 32;
            unsigned dg[3][4];
#pragma unroll
            for (int k = 0; k < 4; ++k) {
                int e = q[12 + k] - 42;
#pragma unroll
                for (int i = 0; i < 3; ++i) { const int d = e & 3, D = d >= 2 ? d - 4 : d; dg[i][k] = (unsigned)d; e = (e - D) >> 2; }
            }
            u32x3 o;
#pragma unroll
            for (int i = 0; i < 3; ++i) {
                unsigned w = 0;
#pragma unroll
                for (int k = 0; k < 4; ++k) w |= (unsigned)(q[4 * i + k] | (dg[i][k] << 6)) << (8 * k);
                o[i] = w;
            }
            *(u32x3*)(dst + lane * 12) = o;
            if (lane == 0) *scale_out = am * (1.0f / 31.0f);
        };
        for (int e = wave; e < NEXP; e += nwaves) {
            const float4* su4 = (const float4*)(p.peer_u + (size_t)e * D_MODEL + lane * 16);
            const float4* sv4 = (const float4*)(p.peer_v + (size_t)e * D_MODEL + lane * 16);
            float4 a4[4], b4[4];
#pragma unroll
            for (int i = 0; i < 4; ++i) { a4[i] = su4[i]; b4[i] = sv4[i]; }
            float fu[16], fv[16];
#pragma unroll
            for (int i = 0; i < 4; ++i) {
                fu[4 * i] = a4[i].x * g16[4 * i]; fu[4 * i + 1] = a4[i].y * g16[4 * i + 1]; fu[4 * i + 2] = a4[i].z * g16[4 * i + 2]; fu[4 * i + 3] = a4[i].w * g16[4 * i + 3];
                fv[4 * i] = b4[i].x; fv[4 * i + 1] = b4[i].y; fv[4 * i + 2] = b4[i].z; fv[4 * i + 3] = b4[i].w;
            }
            {
                float am = 0.f;
#pragma unroll
                for (int j = 0; j < 16; ++j) am = fmaxf(am, fabsf(fu[j]));
                am = wave_max(am);
                const float inv = am > 0.f ? 127.0f / am : 0.f;
                u32x4 o;
#pragma unroll
                for (int i = 0; i < 4; ++i) {
                    unsigned w = 0;
#pragma unroll
                    for (int k = 0; k < 4; ++k) w |= (unsigned)(((int)rintf(fu[4 * i + k] * inv)) & 0xff) << (8 * k);
                    o[i] = w;
                }
                *(u32x4*)(p.u8 + (size_t)e * D_MODEL + lane * 16) = o;
                if (lane == 0) p.suv[e].x = am * (1.0f / 127.0f);
            }
            quant_row(fv, p.v8 + (size_t)e * ROWB, &p.suv[e].y);
        }
    }
    const int wave = (b * blockDim.x + tid) >> 6, nwaves = (nb * blockDim.x) >> 6, lane = tid & 63;
    for (int t = wave; t < T_TOK; t += 2 * nwaves) {
        const int t1 = t + nwaves; const bool two = t1 < T_TOK;
        const float4* xr0 = (const float4*)(p.x + (size_t)t * D_MODEL);
        const float4* xr1 = (const float4*)(p.x + (size_t)(two ? t1 : t) * D_MODEL);
        float4 v0[4], v1[4];
#pragma unroll
        for (int i = 0; i < 4; ++i) { v0[i] = xr0[lane + 64 * i]; v1[i] = xr1[lane + 64 * i]; }
        float s0 = 0.f, s1 = 0.f, a0 = 0.f, a1 = 0.f;
#pragma unroll
        for (int i = 0; i < 4; ++i) {
            s0 += v0[i].x * v0[i].x + v0[i].y * v0[i].y + v0[i].z * v0[i].z + v0[i].w * v0[i].w;
            s1 += v1[i].x * v1[i].x + v1[i].y * v1[i].y + v1[i].z * v1[i].z + v1[i].w * v1[i].w;
            a0 = fmaxf(fmaxf(a0, fmaxf(fabsf(v0[i].x), fabsf(v0[i].y))), fmaxf(fabsf(v0[i].z), fabsf(v0[i].w)));
            a1 = fmaxf(fmaxf(a1, fmaxf(fabsf(v1[i].x), fabsf(v1[i].y))), fmaxf(fabsf(v1[i].z), fabsf(v1[i].w)));
        }
        s0 = wave_sum(s0); s1 = wave_sum(s1); a0 = wave_max(a0); a1 = wave_max(a1);
        const float i0 = a0 > 0.f ? 127.0f / a0 : 0.f, i1 = a1 > 0.f ? 127.0f / a1 : 0.f;
#pragma unroll
        for (int i = 0; i < 4; ++i) {
            const unsigned q0 = ((unsigned)((int)rintf(v0[i].x * i0) & 0xff)) | ((unsigned)((int)rintf(v0[i].y * i0) & 0xff) << 8) | ((unsigned)((int)rintf(v0[i].z * i0) & 0xff) << 16) | ((unsigned)((int)rintf(v0[i].w * i0) & 0xff) << 24);
            ((unsigned*)(p.xq + (size_t)t * D_MODEL))[lane + 64 * i] = q0;
            if (two) {
                const unsigned q1 = ((unsigned)((int)rintf(v1[i].x * i1) & 0xff)) | ((unsigned)((int)rintf(v1[i].y * i1) & 0xff) << 8) | ((unsigned)((int)rintf(v1[i].z * i1) & 0xff) << 16) | ((unsigned)((int)rintf(v1[i].w * i1) & 0xff) << 24);
                ((unsigned*)(p.xq + (size_t)t1 * D_MODEL))[lane + 64 * i] = q1;
            }
        }
        if (lane == 0) {
            p.rstd1[t] = rsqrtf(s0 * (1.0f / D_MODEL) + EPS) * a0 * (1.0f / 127.0f); p.sx[t] = a0 * (1.0f / 127.0f);
            if (two) { p.rstd1[t1] = rsqrtf(s1 * (1.0f / D_MODEL) + EPS) * a1 * (1.0f / 127.0f); p.sx[t1] = a1 * (1.0f / 127.0f); }
        }
    }
    w8_tiles(p.w_in, p.norm1_g, 1536, p.winT8, p.swb, p.swb + 1536, lds, tid);
    w8_tiles(p.peer_wq, p.norm2_g, 2048, p.wqT8, p.swq, p.swq + 2048, lds, tid);
}

typedef short s16x4 __attribute__((ext_vector_type(4)));
template <class Epi>
__device__ __forceinline__ void gemm128_sgu(const int tid, const bf16_t* __restrict__ A, const bf16_t* __restrict__ V  ,
                                            const float* __restrict__ lnm, const float* __restrict__ lnr, const float* __restrict__ gch, char* lds, const Epi& epi) {
    const int lane = tid & 63, wid = tid >> 6, wr = wid >> 1, wc = wid & 1, fr = lane & 15, fq = lane >> 4;
    constexpr int PITCH = 144, P2 = 288;
    char* sA = lds; char* sB = lds + 128 * PITCH;
    f32x4 acc[4][4];
#pragma unroll
    for (int m = 0; m < 4; ++m)
#pragma unroll
        for (int n = 0; n < 4; ++n) acc[m][n] = (f32x4){0.f, 0.f, 0.f, 0.f};
    u32x4 ra[4], rb[4]; float rm[4], rr[4];
    const int lrow = tid >> 3, lch = tid & 7;
    const int btok = tid >> 4, bch = tid & 15;
    const bf16_t* ga = A + (size_t)lrow * 128 + lch * 8;
    const bf16_t* gb = V + (size_t)btok * D_IN + bch * 8;
    float g8[8];
    { const float4 g0 = *(const float4*)(gch + bch * 8), g1 = *(const float4*)(gch + bch * 8 + 4); g8[0] = g0.x; g8[1] = g0.y; g8[2] = g0.z; g8[3] = g0.w; g8[4] = g1.x; g8[5] = g1.y; g8[6] = g1.z; g8[7] = g1.w; }
#pragma unroll
    for (int j = 0; j < 4; ++j) { ra[j] = *(const u32x4*)(ga + (size_t)(32 * j) * 128); rb[j] = *(const u32x4*)(gb + (size_t)(16 * j) * D_IN); rm[j] = lnm[btok + 16 * j]; rr[j] = lnr[btok + 16 * j]; }
    for (int k0 = 0; k0 < 128; k0 += 64) {
        __syncthreads();
#pragma unroll
        for (int j = 0; j < 4; ++j) {
            *(u32x4*)(sA + (lrow + 32 * j) * PITCH + lch * 16) = ra[j];
            u32x4 o;
#pragma unroll
            for (int i = 0; i < 4; ++i) {
                const unsigned w = rb[j][i];
                o[i] = pack2((bflo(w) - rm[j]) * rr[j] * g8[2 * i], (bfhi(w) - rm[j]) * rr[j] * g8[2 * i + 1]);
            }
            *(u32x4*)(sB + (btok + 16 * j) * P2 + bch * 16) = o;
        }
        __syncthreads();
        if (k0 + 64 < 128) {
#pragma unroll
            for (int j = 0; j < 4; ++j) { ra[j] = *(const u32x4*)(ga + (size_t)(32 * j) * 128 + 64); rb[j] = *(const u32x4*)(gb + (size_t)(64 + 16 * j) * D_IN); rm[j] = lnm[64 + btok + 16 * j]; rr[j] = lnr[64 + btok + 16 * j]; }
        }
#pragma unroll
        for (int kk = 0; kk < 2; ++kk) {
            bf16x8 af[4], bfr[4];
#pragma unroll
            for (int m = 0; m < 4; ++m) af[m] = *(const bf16x8*)(sA + (wr * 64 + m * 16 + fr) * PITCH + (kk * 32 + fq * 8) * 2);
#pragma unroll
            for (int n = 0; n < 4; ++n) {
                const char* bp = sB + (kk * 32 + fq * 8 + (fr >> 2)) * P2 + (wc * 64 + n * 16 + 4 * (fr & 3)) * 2;
                const s16x4 lo = __builtin_amdgcn_ds_read_tr16_b64_v4i16((LAS s16x4*)(bp));
                const s16x4 hi = __builtin_amdgcn_ds_read_tr16_b64_v4i16((LAS s16x4*)(bp + 4 * P2));
                bfr[n] = (bf16x8){lo[0], lo[1], lo[2], lo[3], hi[0], hi[1], hi[2], hi[3]};
            }
#pragma unroll
            for (int m = 0; m < 4; ++m)
#pragma unroll
                for (int n = 0; n < 4; ++n) acc[m][n] = __builtin_amdgcn_mfma_f32_16x16x32_bf16(bfr[n], af[m], acc[m][n], 0, 0, 0);
        }
    }
#pragma unroll
    for (int m = 0; m < 4; ++m)
#pragma unroll
        for (int n = 0; n < 4; ++n) epi(wr * 64 + m * 16 + fr, wc * 64 + n * 16 + fq * 4, acc[m][n]);
}

#define PT_PITCH 272
#define MIXH_LDS (2 * 128 * PT_PITCH + 1024)
template <int W, class Epi>
__device__ __forceinline__ void pool_tile(const int tid, const bf16_t* __restrict__ zb0  , int pos0,
                                          const bf16_t* __restrict__ Bt, char* lds, const Epi& epi) {
    const int lane = tid & 63, wid = tid >> 6, wr = wid >> 1, wc = wid & 1, fr = lane & 15, fq = lane >> 4;
    char* sA = lds; char* sB = lds + 128 * PT_PITCH;
    __syncthreads();
#pragma unroll
    for (int j = 0; j < 8; ++j) { const int id = tid + 256 * j, row = id >> 4, ch = id & 15; *(u32x4*)(sB + row * PT_PITCH + ch * 16) = *(const u32x4*)(Bt + (size_t)row * 128 + ch * 8); }
    {
        const int seg = tid >> 5, hc = tid & 31, r0 = seg * 16;
        const bool at_start = (pos0 & (SEQ - 1)) == 0;
        const bf16_t* zp = zb0 + hc * 4;
        u32x2 v[W + 16];
#pragma unroll
        for (int i = 0; i < W + 16; ++i) { const int rr = r0 - W + i; const bool ok = !(at_start && rr < 0); v[i] = *(const u32x2*)(zp + (ptrdiff_t)(ok ? rr : 0) * D_IN); }
        float sm[4] = {0.f, 0.f, 0.f, 0.f};
#pragma unroll
        for (int i = 1; i <= W; ++i) {
            const float m = (at_start && (r0 - W + i) < 0) ? 0.f : 1.f;
            sm[0] += m * bflo(v[i].x); sm[1] += m * bfhi(v[i].x); sm[2] += m * bflo(v[i].y); sm[3] += m * bfhi(v[i].y);
        }
#pragma unroll
        for (int o = 0; o < 16; ++o) {
            if (o > 0) {
                const float md = (at_start && (r0 + o - W) < 0) ? 0.f : 1.f;
                sm[0] += bflo(v[W + o].x) - md * bflo(v[o].x); sm[1] += bfhi(v[W + o].x) - md * bfhi(v[o].x);
                sm[2] += bflo(v[W + o].y) - md * bflo(v[o].y); sm[3] += bfhi(v[W + o].y) - md * bfhi(v[o].y);
            }
            const int pos = (pos0 + r0 + o) & (SEQ - 1);
            const float rn = 1.0f / (float)((pos + 1 < W) ? pos + 1 : W);
            u32x2 ov;
            ov.x = pack2(sm[0] * rn - bflo(v[W + o].x), sm[1] * rn - bfhi(v[W + o].x));
            ov.y = pack2(sm[2] * rn - bflo(v[W + o].y), sm[3] * rn - bfhi(v[W + o].y));
            *(u32x2*)(sA + (r0 + o) * PT_PITCH + hc * 8) = ov;
        }
    }
    __syncthreads();
    f32x4 acc[4][4];
#pragma unroll
    for (int m = 0; m < 4; ++m)
#pragma unroll
        for (int n = 0; n < 4; ++n) acc[m][n] = (f32x4){0.f, 0.f, 0.f, 0.f};
#pragma unroll
    for (int kk = 0; kk < 4; ++kk) {
        bf16x8 af[4], bfr[4];
#pragma unroll
        for (int m = 0; m < 4; ++m) af[m] = *(const bf16x8*)(sA + (wr * 64 + m * 16 + fr) * PT_PITCH + (kk * 32 + fq * 8) * 2);
#pragma unroll
        for (int n = 0; n < 4; ++n) bfr[n] = *(const bf16x8*)(sB + (wc * 64 + n * 16 + fr) * PT_PITCH + (kk * 32 + fq * 8) * 2);
#pragma unroll
        for (int m = 0; m < 4; ++m)
#pragma unroll
            for (int n = 0; n < 4; ++n) acc[m][n] = __builtin_amdgcn_mfma_f32_16x16x32_bf16(bfr[n], af[m], acc[m][n], 0, 0, 0);
    }
#pragma unroll
    for (int m = 0; m < 4; ++m)
#pragma unroll
        for (int n = 0; n < 4; ++n) epi(wr * 64 + m * 16 + fr, wc * 64 + n * 16 + fq * 4, acc[m][n]);
}

__device__ void phase_mix_gemm(const Params& p, char* lds) {
    const int tidx_ = tid_opaque();
    const int npool = (T_TOK / 128) * 4, nsgu = (T_TOK / 128) * 4;
    const int half = tidx_ >> 8, ht = tidx_ & 255; lds += half * MIXH_LDS;
    for (int tile = 2 * blockIdx.x + half; tile < npool + nsgu; tile += 2 * gridDim.x) {
        if (tile < npool) {
            const int tm = tile >> 2, g = tile & 3;
            const float* ps = p.pool_scale + g * 128; bf16_t* co = p.cB + (size_t)tm * 128 * D_MODEL + g * 128;
            const bf16_t* z0 = p.zb + (size_t)tm * 128 * D_IN + g * 128; const bf16_t* bt = p.poolT + (size_t)g * 16384;
            auto epi = [&](int r, int c, f32x4 v) {
                const float4 sc = *(const float4*)(ps + c);
                uint2 o; o.x = pack2(v[0] * sc.x, v[1] * sc.y); o.y = pack2(v[2] * sc.z, v[3] * sc.w);
                *(uint2*)(co + (size_t)r * D_MODEL + c) = o;
            };
            if (g == 0) pool_tile<2>(ht, z0, tm * 128, bt, lds, epi); else if (g == 1) pool_tile<4>(ht, z0, tm * 128, bt, lds, epi);
            else if (g == 2) pool_tile<8>(ht, z0, tm * 128, bt, lds, epi); else pool_tile<16>(ht, z0, tm * 128, bt, lds, epi);
        } else {
            const int t2 = tile - npool, blk = t2 >> 2, h = t2 & 3;
            float* stm = (float*)(lds + GEMM_LDS_BYTES); float* str = stm + 128;
            __syncthreads();
            {
                const int tok = ht >> 1, hh = ht & 1;
                const u32x4* vp = (const u32x4*)(p.zb + (size_t)(blk * 128 + tok) * D_IN + 1024 + hh * 256);
                float s1 = 0.f, s2 = 0.f;
#pragma unroll 8
                for (int i = 0; i < 32; ++i) {
                    const u32x4 v = vp[i];
#pragma unroll
                    for (int k = 0; k < 4; ++k) { const float a = bflo(v[k]), c = bfhi(v[k]); s1 += a + c; s2 += a * a + c * c; }
                }
                s1 += __shfl_xor(s1, 1); s2 += __shfl_xor(s2, 1);
                const float mean = s1 * (1.0f / 512.0f), var = fmaxf(s2 * (1.0f / 512.0f) - mean * mean, 0.f);
                if (hh == 0) { stm[tok] = mean; str[tok] = rsqrtf(var + EPS); }
            }
            __syncthreads();
            const float* sb = p.sgu_b + h * 128; const bf16_t* uo = p.zb + (size_t)blk * 128 * D_IN + 512 + h * 128;
            bf16_t* co = p.cB + (size_t)blk * 128 * D_MODEL + 512 + h * 128;
            gemm128_sgu(ht, p.wsM + (size_t)h * 16384, p.zb + (size_t)blk * 128 * D_IN + 1024 + h * 128, stm, str, p.sgu_norm_g + h * 128, lds,
                    [&](int r, int c, f32x4 v) {
                        const float bb = sb[r];
                        const uint2 uu = *(const uint2*)(uo + (size_t)r * D_IN + c);
                        uint2 o;
                        o.x = pack2((v[0] + bb) * bflo(uu.x), (v[1] + bb) * bfhi(uu.x));
                        o.y = pack2((v[2] + bb) * bflo(uu.y), (v[3] + bb) * bfhi(uu.y));
                        *(uint2*)(co + (size_t)r * D_MODEL + c) = o;
                    });
        }
    }
}

__device__ __forceinline__ int wave_sum_i_uniform(int s) {
    s += __builtin_amdgcn_update_dpp(0, s, 0xB1, 0xf, 0xf, false);
    s += __builtin_amdgcn_update_dpp(0, s, 0x4E, 0xf, 0xf, false);
    s += __builtin_amdgcn_update_dpp(0, s, 0x141, 0xf, 0xf, false);
    s += __builtin_amdgcn_update_dpp(0, s, 0x140, 0xf, 0xf, false);
    return __builtin_amdgcn_readlane(s, 0) + __builtin_amdgcn_readlane(s, 16) + __builtin_amdgcn_readlane(s, 32) + __builtin_amdgcn_readlane(s, 48);
}
__constant__ unsigned char kComb[64] = {
    0x00,0x01,0x02,0x03,0x04,0x05,0x06,0x07,0x08,0x09,0x0a,0x0b,0x0c,0x0d,0x0e,0x0f,
    0x10,0x11,0x12,0x13,0x14,0x15,0x16,0x17,
    0x20,0x21,0x22,0x23,0x24,
    0x30,0x31,0x32,0x33,
    0x40,0x41,0x42,
    0x50,0x51,
    0x60,0x61,
    0x70,0x71,
    0x80,0x90,0xa0,0xb0,0xc0,0xd0,0xe0,0xf0,
    0xff,0xff,0xff,0xff,0xff,0xff,0xff,0xff,0xff,0xff,0xff,0xff,0xff,0xff};

template <int CTRL> __device__ __forceinline__ int dpp_i(int v) { return __builtin_amdgcn_update_dpp(0, v, CTRL, 0xf, 0xf, false); }
__device__ __forceinline__ int row_allmax_i(int v) {
    v = max(v, dpp_i<0x128>(v)); v = max(v, dpp_i<0x124>(v)); v = max(v, dpp_i<0x122>(v)); v = max(v, dpp_i<0x121>(v));
    return v;
}
__device__ __forceinline__ float row_allsum_f(float v) {
    v += __int_as_float(dpp_i<0x128>(__float_as_int(v))); v += __int_as_float(dpp_i<0x124>(__float_as_int(v)));
    v += __int_as_float(dpp_i<0x122>(__float_as_int(v))); v += __int_as_float(dpp_i<0x121>(__float_as_int(v)));
    return v;
}
__device__ __forceinline__ int f2key(float f) { const int b = __float_as_int(f); return b ^ ((b >> 31) & 0x7fffffff); }
__device__ __forceinline__ float key2f(int k) { return __int_as_float(k ^ ((k >> 31) & 0x7fffffff)); }
#define KEY_MIN ((int)0x80000000)
#define CE(a, b) { const int hi_ = max(a, b), lo_ = min(a, b); a = hi_; b = lo_; }
__device__ __forceinline__ int top16_rows(int (&k)[8], int l15) {
    CE(k[0], k[1]) CE(k[2], k[3]) CE(k[4], k[5]) CE(k[6], k[7])
    CE(k[0], k[2]) CE(k[1], k[3]) CE(k[4], k[6]) CE(k[5], k[7])
    CE(k[1], k[2]) CE(k[5], k[6])
    CE(k[0], k[4]) CE(k[1], k[5]) CE(k[2], k[6]) CE(k[3], k[7])
    CE(k[2], k[4]) CE(k[3], k[5])
    CE(k[1], k[2]) CE(k[3], k[4]) CE(k[5], k[6])
    int res = KEY_MIN;
#pragma unroll
    for (int r = 0; r < 16; ++r) {
        const int m = row_allmax_i(k[0]);
        const bool own = (k[0] == m);
#pragma unroll
        for (int j = 0; j < 7; ++j) k[j] = own ? k[j + 1] : k[j];
        k[7] = own ? KEY_MIN : k[7];
        res = (l15 == r) ? m : res;
    }
    return res;
}
__device__ __forceinline__ void combine16(int A, int B, const int (&cbv)[4], int lane, int l15, int& eid_out, float& gate_out) {
    const int rowbase = lane & 48;
    int ck[4], eid[4];
#pragma unroll
    for (int c = 0; c < 4; ++c) {
        const int ci = (cbv[c] >> 4) & 15, cj = cbv[c] & 15;
        const int ka = __builtin_amdgcn_ds_bpermute((rowbase + ci) << 2, A);
        const int kb = __builtin_amdgcn_ds_bpermute((rowbase + cj) << 2, B);
        const float sm = key2f(ka & ~127) + key2f(kb & ~127);
        eid[c] = ((127 - (ka & 127)) << 7) | (127 - (kb & 127));
        ck[c] = (cbv[c] != 0xff) ? ((f2key(sm) & ~63) | (63 - (4 * l15 + c))) : KEY_MIN;
    }
    CE(ck[0], ck[1]) CE(ck[2], ck[3]) CE(ck[0], ck[2]) CE(ck[1], ck[3]) CE(ck[1], ck[2])
    int res = KEY_MIN;
#pragma unroll
    for (int r = 0; r < 16; ++r) {
        const int m = row_allmax_i(ck[0]);
        const bool own = (ck[0] == m);
        ck[0] = own ? ck[1] : ck[0]; ck[1] = own ? ck[2] : ck[1]; ck[2] = own ? ck[3] : ck[2]; ck[3] = own ? KEY_MIN : ck[3];
        res = (l15 == r) ? m : res;
    }
    const int slot = 63 - (res & 63);
    const int src = (rowbase + (slot >> 2)) << 2;
    const int e0 = __builtin_amdgcn_ds_bpermute(src, eid[0]), e1 = __builtin_amdgcn_ds_bpermute(src, eid[1]);
    const int e2 = __builtin_amdgcn_ds_bpermute(src, eid[2]), e3 = __builtin_amdgcn_ds_bpermute(src, eid[3]);
    const int sel = slot & 3;
    eid_out = sel == 0 ? e0 : (sel == 1 ? e1 : (sel == 2 ? e2 : e3));
    gate_out = key2f(res & ~63);
}

__device__ __forceinline__ int reduce16_rows(const int (&part)[16], bool b3, bool b2, bool b1, bool b0b) {
    int r8[8], r4[4], r2[2];
#pragma unroll
    for (int k = 0; k < 8; ++k) { const int keep = b3 ? part[8 + k] : part[k], send = b3 ? part[k] : part[8 + k]; r8[k] = keep + __builtin_amdgcn_update_dpp(0, send, 0x140, 0xf, 0xf, false); }
#pragma unroll
    for (int k = 0; k < 4; ++k) { const int keep = b2 ? r8[4 + k] : r8[k], send = b2 ? r8[k] : r8[4 + k]; r4[k] = keep + __builtin_amdgcn_update_dpp(0, send, 0x141, 0xf, 0xf, false); }
#pragma unroll
    for (int k = 0; k < 2; ++k) { const int keep = b1 ? r4[2 + k] : r4[k], send = b1 ? r4[k] : r4[2 + k]; r2[k] = keep + __builtin_amdgcn_update_dpp(0, send, 0x4E, 0xf, 0xf, false); }
    const int keep = b0b ? r2[1] : r2[0], send = b0b ? r2[0] : r2[1];
    int r1 = keep + __builtin_amdgcn_update_dpp(0, send, 0xB1, 0xf, 0xf, false);
    r1 += __shfl_xor(r1, 16); r1 += __shfl_xor(r1, 32);
    return r1;
}
__device__ void phase_hquant(const Params& p, char* lds) {
    const int tid = tid_opaque();
    const int wave = __builtin_amdgcn_readfirstlane((int)((blockIdx.x * blockDim.x + tid) >> 6)), nwaves = (gridDim.x * blockDim.x) >> 6, lane = tid & 63;
    for (int t = wave; t < T_TOK; t += 2 * nwaves) {
        const int t1 = t + nwaves; const bool two = t1 < T_TOK;
        const u32x4* h0 = (const u32x4*)(p.hb + (size_t)t * D_MODEL); const u32x4* h1 = (const u32x4*)(p.hb + (size_t)(two ? t1 : t) * D_MODEL);
        u32x4 r[2][2] = {{h0[2 * lane], h0[2 * lane + 1]}, {h1[2 * lane], h1[2 * lane + 1]}};
#pragma unroll
        for (int q = 0; q < 2; ++q) {
            const u32x4 a = r[q][0], c = r[q][1];
            const float f[16] = {bflo(a.x), bfhi(a.x), bflo(a.y), bfhi(a.y), bflo(a.z), bfhi(a.z), bflo(a.w), bfhi(a.w),
                                 bflo(c.x), bfhi(c.x), bflo(c.y), bfhi(c.y), bflo(c.z), bfhi(c.z), bflo(c.w), bfhi(c.w)};
            float ss = 0.f, am = 0.f;
#pragma unroll
            for (int k = 0; k < 16; ++k) { ss += f[k] * f[k]; am = fmaxf(am, fabsf(f[k])); }
            ss = wave_sum(ss); am = wave_max(am);
            const float inv = am > 0.f ? 127.0f / am : 0.f;
            u32x4 o;
#pragma unroll
            for (int i = 0; i < 4; ++i) {
                unsigned w = 0;
#pragma unroll
                for (int k = 0; k < 4; ++k) w |= (unsigned)((int)rintf(f[4 * i + k] * inv) & 0xff) << (8 * k);
                o[i] = w;
            }
            const int tt = q ? t1 : t;
            if (q == 0 || two) {
                ((u32x4*)(p.hq + (size_t)tt * D_MODEL))[lane] = o;
                if (lane == 0) p.hsc[tt] = am * (1.0f / 127.0f) * rsqrtf(ss * (1.0f / D_MODEL) + EPS);
            }
        }
    }
}

#define TS_WBYTES (16384 + 128)
__device__ void phase_peer_dots(const Params& p, char* lds) {
    const int tidx_ = tid_opaque();
    const int lane = tidx_ & 63, wid = __builtin_amdgcn_readfirstlane((int)(tidx_ >> 6)), l15 = lane & 15;
    const bool b3 = (lane & 8) != 0, b2 = (lane & 4) != 0, b1 = (lane & 2) != 0, b0b = (lane & 1) != 0;
    const int gw = blockIdx.x * (blockDim.x >> 6) + wid, ngw = gridDim.x * (blockDim.x >> 6);
    char* wl = lds + wid * TS_WBYTES;
    unsigned* list = (unsigned*)wl; int* dotsl = (int*)(wl + 4096); char* hql = wl + 8192; int* tks = (int*)(wl + 16384);
    const unsigned lane16 = (unsigned)lane * 16u;
    for (int tb = gw * 8; tb < T_TOK; tb += ngw * 8) {
#pragma unroll
        for (int j = 0; j < 8; ++j) *(u32x4*)(hql + j * 1024 + lane * 16) = ((const u32x4*)(p.hq + (size_t)(tb + j) * D_MODEL))[lane];
        if (lane < 8) tks[lane] = __float_as_int(p.hsc[tb + lane]);
        int idv[8][2];
#pragma unroll
        for (int j = 0; j < 8; ++j) { const int* ir = p.idx + (size_t)(tb + j) * 128; idv[j][0] = ir[lane]; idv[j][1] = ir[64 + lane]; }
#pragma unroll 1
        for (int x = 0; x < 8; ++x) {
            int n = 0;
#pragma unroll
            for (int j = 0; j < 8; ++j)
#pragma unroll
                for (int r = 0; r < 2; ++r) {
                    const int e = idv[j][r];
                    const bool in = (e >> 11) == x;
                    const unsigned long long mk = __ballot(in);
                    const int rank = (int)__builtin_amdgcn_mbcnt_hi((unsigned)(mk >> 32), __builtin_amdgcn_mbcnt_lo((unsigned)mk, 0u));
                    if (in) list[n + rank] = ((unsigned)j << 21) | ((unsigned)(r * 64 + lane) << 14) | (unsigned)e;
                    n += (int)__builtin_popcountll(mk);
                }
            asm volatile("s_waitcnt lgkmcnt(0)" ::: "memory");
            u32x4 ua[16], ubf[16]; int enta = 0, entb = 0;
            auto issue = [&](int b0, u32x4 (&uu)[16], int& entv) {
                const int i = (b0 + l15 < n) ? b0 + l15 : n - 1;
                entv = (int)list[i];
#pragma unroll
                for (int j = 0; j < 16; ++j) { const int e = __builtin_amdgcn_readlane(entv, j) & 0x3fff; uu[j] = *(const u32x4*)(p.u8 + (size_t)e * D_MODEL + lane16); }
            };
            auto reduce = [&](int b0, const u32x4 (&uu)[16], int entv) {
                int part[16];
#pragma unroll
                for (int j = 0; j < 16; ++j) {
                    const int tl = __builtin_amdgcn_readlane(entv, j) >> 21;
                    const u32x4 hqv = *(const u32x4*)(hql + tl * 1024 + lane * 16);
                    int sacc = __builtin_amdgcn_sdot4((int)uu[j].x, (int)hqv.x, 0, false);
                    sacc = __builtin_amdgcn_sdot4((int)uu[j].y, (int)hqv.y, sacc, false);
                    sacc = __builtin_amdgcn_sdot4((int)uu[j].z, (int)hqv.z, sacc, false);
                    part[j] = __builtin_amdgcn_sdot4((int)uu[j].w, (int)hqv.w, sacc, false);
                }
                const int r1 = reduce16_rows(part, b3, b2, b1, b0b);
                if (lane < 16 && b0 + lane < n) dotsl[((unsigned)entv >> 21) * 128 + (((unsigned)entv >> 14) & 127u)] = r1;
            };
            if (n > 0) issue(0, ua, enta);
            for (int b0 = 0; b0 < n; b0 += 32) {
                if (b0 + 16 < n) issue(b0 + 16, ubf, entb);
                reduce(b0, ua, enta);
                if (b0 + 16 < n) {
                    if (b0 + 32 < n) issue(b0 + 32, ua, enta);
                    reduce(b0 + 16, ubf, entb);
                }
            }
            asm volatile("s_waitcnt lgkmcnt(0)" ::: "memory");
        }
#pragma unroll
        for (int j = 0; j < 8; ++j) {
            const float cs_t = __int_as_float(tks[j]), r2_t = cs_t;
            const float* gr = p.gate + (size_t)(tb + j) * 128; float* cr = p.coef + (size_t)(tb + j) * 128;
#pragma unroll
            for (int r = 0; r < 2; ++r) {
                const int e = idv[j][r];
                const float sc = gr[r * 64 + lane] * r2_t;
                const float ex = __expf(sc - key2f(row_allmax_i(f2key(sc))));
                const float gt = ex / row_allsum_f(ex);
                const float2 sc2 = p.suv[e];
                const float dotf = (float)dotsl[j * 128 + r * 64 + lane] * cs_t * sc2.x;
                cr[r * 64 + lane] = gt * gelu_t(dotf) * sc2.y;
            }
        }
        asm volatile("s_waitcnt lgkmcnt(0)" ::: "memory");
    }
}

__device__ void phase_gather(const Params& p, char* lds) {
    const int tidx_ = tid_opaque();
    const int wave = __builtin_amdgcn_readfirstlane((int)((blockIdx.x * blockDim.x + tidx_) >> 6)), nwaves = (gridDim.x * blockDim.x) >> 6, lane = tidx_ & 63;
    const unsigned char* vb = p.v8 + lane * 12;
    const int ntok = (T_TOK - wave + nwaves - 1) / nwaves;
    auto tok = [&](int i) { const int ii = i < ntok ? i : ntok - 1; return wave + ii * nwaves; };
    if (ntok <= 0) return;
    u32x3 v0[8], v1[8], v2[8], v3[8];
    int ic0, ic1, in0, in1, ia0, ia1;
    float coef0, coef1, cn0, cn1;
    { const float* cr = p.coef + (size_t)tok(0) * 128; coef0 = cr[lane]; coef1 = cr[64 + lane]; }
    { const int* ir = p.idx + (size_t)tok(0) * 128; ic0 = ir[lane]; ic1 = ir[64 + lane]; }
    { const int* ir = p.idx + (size_t)tok(1) * 128; in0 = ir[lane]; in1 = ir[64 + lane]; }
    float g16[16];
#pragma unroll
    for (int i4 = 0; i4 < 4; ++i4) { const float4 g = ((const float4*)(p.final_g + lane * 16))[i4]; g16[4 * i4] = g.x; g16[4 * i4 + 1] = g.y; g16[4 * i4 + 2] = g.z; g16[4 * i4 + 3] = g.w; }
#define G2_ISSUE(vv, pbx) do { const int pbx_ = (pbx); const bool nx_ = pbx_ >= 128; const int pm_ = pbx_ & 127; \
        const int src_ = nx_ ? (pm_ < 64 ? in0 : in1) : (pm_ < 64 ? ic0 : ic1); \
        _Pragma("unroll") for (int q = 0; q < 8; ++q) { const int e = __builtin_amdgcn_readlane(src_, (pm_ & 63) + q); vv[q] = *(const u32x3*)(vb + (size_t)e * ROWB); } } while (0)
    __builtin_amdgcn_sched_barrier(0);
    G2_ISSUE(v0, 0); __builtin_amdgcn_sched_barrier(0); G2_ISSUE(v1, 8); __builtin_amdgcn_sched_barrier(0); G2_ISSUE(v2, 16); __builtin_amdgcn_sched_barrier(0);
#pragma unroll 1
    for (int i = 0; i < ntok; ++i) {
        const int t = tok(i);
        { const int* ir = p.idx + (size_t)tok(i + 2) * 128; ia0 = ir[lane]; ia1 = ir[64 + lane]; }
        const u32x4* hr = (const u32x4*)(p.hb + (size_t)t * D_MODEL + lane * 16);
        const u32x4 ha = hr[0], hc = hr[1];
        { const float* cr = p.coef + (size_t)tok(i + 1) * 128; cn0 = cr[lane]; cn1 = cr[64 + lane]; }
        const float cmax = wave_max(fmaxf(fabsf(coef0), fabsf(coef1)));
        const float qs = cmax > 0.f ? 127.0f / cmax : 0.f, cscale = cmax * (1.0f / 127.0f);
        const int cq0 = (int)rintf(coef0 * qs), cq1 = (int)rintf(coef1 * qs);
        const int csum_i = wave_sum_i_uniform(cq0 + cq1);
        unsigned cpk0, cpk1;
        {
            const int bb0 = cq0 & 0xff, bb1 = cq1 & 0xff;
            cpk0 = (unsigned)__builtin_amdgcn_update_dpp(0, bb0, 0x00, 0xf, 0xf, false) | ((unsigned)__builtin_amdgcn_update_dpp(0, bb0, 0x55, 0xf, 0xf, false) << 8)
                 | ((unsigned)__builtin_amdgcn_update_dpp(0, bb0, 0xAA, 0xf, 0xf, false) << 16) | ((unsigned)__builtin_amdgcn_update_dpp(0, bb0, 0xFF, 0xf, 0xf, false) << 24);
            cpk1 = (unsigned)__builtin_amdgcn_update_dpp(0, bb1, 0x00, 0xf, 0xf, false) | ((unsigned)__builtin_amdgcn_update_dpp(0, bb1, 0x55, 0xf, 0xf, false) << 8)
                 | ((unsigned)__builtin_amdgcn_update_dpp(0, bb1, 0xAA, 0xf, 0xf, false) << 16) | ((unsigned)__builtin_amdgcn_update_dpp(0, bb1, 0xFF, 0xf, 0xf, false) << 24);
        }
        int racc[12], jacc[12];
#pragma unroll
        for (int j = 0; j < 12; ++j) { racc[j] = 0; jacc[j] = 0; }
        auto axpy = [&](int pb, const u32x3 (&vv)[8]) __attribute__((always_inline)) {
#pragma unroll
            for (int g4 = 0; g4 < 2; ++g4) {
                const int cqd = __builtin_amdgcn_readlane((int)(pb < 64 ? cpk0 : cpk1), (pb & 63) + 4 * g4);
#pragma unroll
                for (int w = 0; w < 3; ++w) {
                    const unsigned wa = vv[4 * g4 + 0][w], wb = vv[4 * g4 + 1][w], wc = vv[4 * g4 + 2][w], wd = vv[4 * g4 + 3][w];
                    const unsigned p0 = __builtin_amdgcn_perm(wb, wa, 0x05010400u), p1 = __builtin_amdgcn_perm(wb, wa, 0x07030602u);
                    const unsigned q0 = __builtin_amdgcn_perm(wd, wc, 0x05010400u), q1 = __builtin_amdgcn_perm(wd, wc, 0x07030602u);
                    const unsigned t0 = __builtin_amdgcn_perm(q0, p0, 0x05040100u), t1 = __builtin_amdgcn_perm(q0, p0, 0x07060302u);
                    const unsigned t2 = __builtin_amdgcn_perm(q1, p1, 0x05040100u), t3 = __builtin_amdgcn_perm(q1, p1, 0x07060302u);
                    racc[4 * w + 0] = __builtin_amdgcn_sdot4((int)t0, cqd, racc[4 * w + 0], false); jacc[4 * w + 0] = __builtin_amdgcn_sdot4((int)(t0 & 0xc0c0c0c0u), cqd, jacc[4 * w + 0], false);
                    racc[4 * w + 1] = __builtin_amdgcn_sdot4((int)t1, cqd, racc[4 * w + 1], false); jacc[4 * w + 1] = __builtin_amdgcn_sdot4((int)(t1 & 0xc0c0c0c0u), cqd, jacc[4 * w + 1], false);
                    racc[4 * w + 2] = __builtin_amdgcn_sdot4((int)t2, cqd, racc[4 * w + 2], false); jacc[4 * w + 2] = __builtin_amdgcn_sdot4((int)(t2 & 0xc0c0c0c0u), cqd, jacc[4 * w + 2], false);
                    racc[4 * w + 3] = __builtin_amdgcn_sdot4((int)t3, cqd, racc[4 * w + 3], false); jacc[4 * w + 3] = __builtin_amdgcn_sdot4((int)(t3 & 0xc0c0c0c0u), cqd, jacc[4 * w + 3], false);
                }
            }
        };
#pragma unroll 1
        for (int pb = 0; pb < 128; pb += 32) {
            G2_ISSUE(v3, pb + 24); __builtin_amdgcn_sched_barrier(0); axpy(pb, v0); __builtin_amdgcn_sched_barrier(0);
            G2_ISSUE(v0, pb + 32); __builtin_amdgcn_sched_barrier(0); axpy(pb + 8, v1); __builtin_amdgcn_sched_barrier(0);
            G2_ISSUE(v1, pb + 40); __builtin_amdgcn_sched_barrier(0); axpy(pb + 16, v2); __builtin_amdgcn_sched_barrier(0);
            G2_ISSUE(v2, pb + 48); __builtin_amdgcn_sched_barrier(0); axpy(pb + 24, v3); __builtin_amdgcn_sched_barrier(0);
        }
        ic0 = in0; ic1 = in1; in0 = ia0; in1 = ia1;
        coef0 = cn0; coef1 = cn1;
        int acc[16];
#pragma unroll
        for (int j = 0; j < 12; ++j) acc[j] = (racc[j] - jacc[j]) - 32 * csum_i;
#pragma unroll
        for (int k = 0; k < 4; ++k) acc[12 + k] = ((jacc[k] + 4 * jacc[4 + k] + 16 * jacc[8 + k]) >> 6) + 10 * csum_i;
        const float hf16[16] = {bflo(ha.x), bfhi(ha.x), bflo(ha.y), bfhi(ha.y), bflo(ha.z), bfhi(ha.z), bflo(ha.w), bfhi(ha.w),
                                bflo(hc.x), bfhi(hc.x), bflo(hc.y), bfhi(hc.y), bflo(hc.z), bfhi(hc.z), bflo(hc.w), bfhi(hc.w)};
        float res[16];
        float ss = 0.f;
#pragma unroll
        for (int j = 0; j < 16; ++j) { res[j] = hf16[j] + cscale * (float)acc[j]; ss += res[j] * res[j]; }
        ss = wave_sum(ss);
        const float r3 = rsqrtf(ss * (1.0f / D_MODEL) + EPS);
        float* o = p.out + (size_t)t * D_MODEL + lane * 16;
#pragma unroll
        for (int i4 = 0; i4 < 4; ++i4) {
            float4 ov; ov.x = res[4 * i4] * r3 * g16[4 * i4]; ov.y = res[4 * i4 + 1] * r3 * g16[4 * i4 + 1]; ov.z = res[4 * i4 + 2] * r3 * g16[4 * i4 + 2]; ov.w = res[4 * i4 + 3] * r3 * g16[4 * i4 + 3];
            ((float4*)o)[i4] = ov;
        }
    }
#undef G2_ISSUE
}

namespace pg8 {
#define PG8_LAS __attribute__((address_space(3)))
constexpr int BM = 256, BK = 64, HALF = 128, HTB = HALF * BK * 2, STAGE_BYTES = 8 * HTB, NXCD = 8, WGM = 8;
__host__ __device__ __forceinline__ int lds_byte(int r, int c) { const int st = (r >> 4) * 2 + (c >> 5), rr = r & 15, cc = c & 31, ob = rr * 64 + cc * 2; return st * 1024 + (ob ^ (((ob >> 9) & 1) << 5)); }
__host__ __device__ __forceinline__ void stage_rc(int b, int& R, int& C) { const int st = b / 1024, sb = b % 1024, swz = sb ^ (((sb >> 9) & 1) << 5); R = (st >> 1) * 16 + swz / 64; C = (st & 1) * 32 + (swz % 64) / 2; }
__host__ __device__ __forceinline__ int perm32(int rho) { const int n = rho >> 4, i = rho & 15; return 8 * (i >> 2) + 4 * n + (i & 3); }
struct Unit { int pm, pn; };
struct Gemm { const bf16_t* A; const bf16_t* Bt; int M, N, K; };
struct StaticOrder {
    int nM, nN, nwg, G, c;
    __host__ __device__ void init(int M, int N, int G_, int c_) { nM = M / BM; nN = N / BM; nwg = nM * nN; G = G_; c = c_; }
    __host__ __device__ bool next(int i, Unit& u) const {
        const long L = (long)i * G + c; if (L >= nwg) return false;
        int wgid = (int)L; { const int q = nwg / NXCD, r = nwg % NXCD, xcd = wgid % NXCD, off = wgid / NXCD; wgid = (xcd < r ? xcd * (q + 1) : r * (q + 1) + (xcd - r) * q) + off; }
        const int nig = WGM * nN, gid = wgid / nig, fm = gid * WGM, gsz = (nM - fm) < WGM ? (nM - fm) : WGM;
        u.pm = fm + ((wgid % nig) % gsz); u.pn = (wgid % nig) / gsz; return true;
    }
    __device__ __forceinline__ void a_ready(const Unit&) const {}
    __device__ __forceinline__ void done(const Unit&) const {}
};
__device__ __forceinline__ unsigned cvt_pk_bf16(float lo, float hi) { unsigned r; asm volatile("v_cvt_pk_bf16_f32 %0, %1, %2" : "=v"(r) : "v"(lo), "v"(hi)); return r; }
template <bool I8> __device__ __forceinline__ typename std::conditional<I8, i32x4, f32x4>::type mma1(bf16x8 a, bf16x8 b, typename std::conditional<I8, i32x4, f32x4>::type c) {
    if constexpr (I8) return __builtin_amdgcn_mfma_i32_16x16x64_i8(*(const i32x4*)&a, *(const i32x4*)&b, c, 0, 0, 0);
    else return __builtin_amdgcn_mfma_f32_16x16x32_bf16(a, b, c, 0, 0, 0);
}
struct EpiZ8 {
    static constexpr bool PERM = true, AFTER_DRAIN = false, I8 = true; typedef i32x4 acc_t;
    bf16_t* O; const float* rsx; const unsigned* swb;
    __device__ __forceinline__ void operator()(const i32x4 (&acc)[2][2][4][2], const Unit& u, int wr, int wc, int fr, int fq) const {
        const int row0 = u.pm * BM + wr * 64 + fr, col0 = u.pn * BM + wc * 32 + 8 * fq; const bool act = u.pn >= 2;
        float sw[2][8];
#pragma unroll
        for (int bj = 0; bj < 2; ++bj) { const u32x4 a = *(const u32x4*)(swb + col0 + bj * HALF), c = *(const u32x4*)(swb + col0 + bj * HALF + 4);
#pragma unroll
            for (int i = 0; i < 4; ++i) { sw[bj][i] = __uint_as_float(a[i]) * (1.0f / 127.0f); sw[bj][4 + i] = __uint_as_float(c[i]) * (1.0f / 127.0f); } }
#pragma unroll
        for (int ai = 0; ai < 2; ++ai)
#pragma unroll
            for (int m = 0; m < 4; ++m) { const int r = row0 + ai * HALF + m * 16; const float sc = rsx[r]; bf16_t* rowp = O + (size_t)r * D_IN + col0;
#pragma unroll
                for (int bj = 0; bj < 2; ++bj) { f32x4 v0, v1;
#pragma unroll
                    for (int i = 0; i < 4; ++i) { v0[i] = (float)acc[ai][bj][m][0][i] * sc * sw[bj][i]; v1[i] = (float)acc[ai][bj][m][1][i] * sc * sw[bj][4 + i]; }
                    if (act) { v0 = (f32x4){gelu_t(v0[0]), gelu_t(v0[1]), gelu_t(v0[2]), gelu_t(v0[3])}; v1 = (f32x4){gelu_t(v1[0]), gelu_t(v1[1]), gelu_t(v1[2]), gelu_t(v1[3])}; }
                    u32x4 w; w.x = cvt_pk_bf16(v0[0], v0[1]); w.y = cvt_pk_bf16(v0[2], v0[3]); w.z = cvt_pk_bf16(v1[0], v1[1]); w.w = cvt_pk_bf16(v1[2], v1[3]);
                    *(u32x4*)(rowp + bj * HALF) = w; } }
    }
};
struct EpiOut {
    static constexpr bool PERM = true, AFTER_DRAIN = false, I8 = false; typedef f32x4 acc_t;
    bf16_t* O; const signed char* X; const float* sx;
    __device__ __forceinline__ void operator()(const f32x4 (&acc)[2][2][4][2], const Unit& u, int wr, int wc, int fr, int fq) const {
        const int row0 = u.pm * BM + wr * 64 + fr, col0 = u.pn * BM + wc * 32 + 8 * fq;
#pragma unroll
        for (int ai = 0; ai < 2; ++ai)
#pragma unroll
            for (int m = 0; m < 4; ++m) { const int r = row0 + ai * HALF + m * 16; const size_t off = (size_t)r * D_MODEL + col0; const float sc = sx[r];
#pragma unroll
                for (int bj = 0; bj < 2; ++bj) { const u32x2 xx = *(const u32x2*)(X + off + bj * HALF);
                    f32x4 x0, x1;
#pragma unroll
                    for (int i = 0; i < 4; ++i) { x0[i] = (float)(signed char)(xx.x >> (8 * i)) * sc; x1[i] = (float)(signed char)(xx.y >> (8 * i)) * sc; }
                    const f32x4 v0 = acc[ai][bj][m][0] + x0, v1 = acc[ai][bj][m][1] + x1;
                    u32x4 w; w.x = cvt_pk_bf16(v0[0], v0[1]); w.y = cvt_pk_bf16(v0[2], v0[3]); w.z = cvt_pk_bf16(v1[0], v1[1]); w.w = cvt_pk_bf16(v1[2], v1[3]);
                    *(u32x4*)(O + off + bj * HALF) = w; } }
    }
};
struct OneUnit {
    Unit u;
    __device__ __forceinline__ bool next(int i, Unit& o) const { if (i) return false; o = u; return true; }
    __device__ __forceinline__ void a_ready(const Unit&) const {}
    __device__ __forceinline__ void done(const Unit&) const {}
};
#define QT_PITCH 272
#define QT_LDS_BYTES (2 * 256 * QT_PITCH)
struct EpiQTopk {
    static constexpr bool PERM = true, AFTER_DRAIN = true, I8 = true; typedef i32x4 acc_t;
    const bf16_t* keysB; int* idx; float* gate; const unsigned* swq;
    __device__ __forceinline__ void fused(i32x4 (&acc)[2][2][4][2], const Unit& u, int wr, int wc, int fr, int fq, PG8_LAS unsigned char* ldsp, int wid, int lane) const {
        char* sQ = (char*)ldsp;
        const int h = u.pn;
        float sw[2][8];
#pragma unroll
        for (int bj = 0; bj < 2; ++bj) { const u32x4 a = *(const u32x4*)(swq + u.pn * BM + bj * HALF + wc * 32 + 8 * fq), c = *(const u32x4*)(swq + u.pn * BM + bj * HALF + wc * 32 + 8 * fq + 4);
#pragma unroll
            for (int i = 0; i < 4; ++i) { sw[bj][i] = __uint_as_float(a[i]) * (1.0f / 127.0f); sw[bj][4 + i] = __uint_as_float(c[i]) * (1.0f / 127.0f); } }
#pragma unroll
        for (int ai = 0; ai < 2; ++ai)
#pragma unroll
            for (int m = 0; m < 4; ++m) { const int r = ai * HALF + wr * 64 + m * 16 + fr;
#pragma unroll
                for (int bj = 0; bj < 2; ++bj) { f32x4 v0, v1;
#pragma unroll
                    for (int i = 0; i < 4; ++i) { v0[i] = (float)acc[ai][bj][m][0][i] * sw[bj][i]; v1[i] = (float)acc[ai][bj][m][1][i] * sw[bj][4 + i]; }
                    u32x4 w; w.x = cvt_pk_bf16(v0[0], v0[1]); w.y = cvt_pk_bf16(v0[2], v0[3]); w.z = cvt_pk_bf16(v1[0], v1[1]); w.w = cvt_pk_bf16(v1[2], v1[3]);
                    *(u32x4*)(sQ + bj * (256 * QT_PITCH) + r * QT_PITCH + (wc * 32 + fq * 8) * 2) = w; } }
        __syncthreads();
        int cbv[4];
#pragma unroll
        for (int c = 0; c < 4; ++c) cbv[c] = kComb[4 * fr + c];
        int tA[2][4], tB[2][4];
#pragma unroll
        for (int m = 0; m < 2; ++m)
#pragma unroll
            for (int j = 0; j < 4; ++j) { tA[m][j] = 0; tB[m][j] = 0; }
#pragma unroll 1
        for (int pp = 0; pp < 2; ++pp) {
            const bf16_t* kb = keysB + (size_t)(pp * 8 + h) * 16384 + lane * 8;
            const char* qa = sQ + pp * (256 * QT_PITCH) + (wid * 32 + fr) * QT_PITCH + fq * 16;
            f32x4 sc2[2][8];
#pragma unroll
            for (int m = 0; m < 2; ++m)
#pragma unroll
                for (int nb = 0; nb < 8; ++nb) sc2[m][nb] = (f32x4){0.f, 0.f, 0.f, 0.f};
#pragma unroll
            for (int kk = 0; kk < 4; ++kk) {
                bf16x8 kf[8], af[2];
#pragma unroll
                for (int nb = 0; nb < 8; ++nb) kf[nb] = *(const bf16x8*)(kb + (kk * 8 + nb) * 512);
#pragma unroll
                for (int m = 0; m < 2; ++m) af[m] = *(const bf16x8*)(qa + m * 16 * QT_PITCH + kk * 64);
#pragma unroll
                for (int m = 0; m < 2; ++m)
#pragma unroll
                    for (int nb = 0; nb < 8; ++nb) sc2[m][nb] = __builtin_amdgcn_mfma_f32_16x16x32_bf16(af[m], kf[nb], sc2[m][nb], 0, 0, 0);
            }
#pragma unroll
            for (int m = 0; m < 2; ++m)
#pragma unroll
                for (int j = 0; j < 4; ++j) tA[m][j] = tB[m][j];
#pragma unroll 2
            for (int it = 0; it < 4; ++it) {
#pragma unroll
                for (int m = 0; m < 2; ++m) {
                    int k[8];
#pragma unroll
                    for (int nb = 0; nb < 8; ++nb) k[nb] = (f2key(sc2[m][nb][0]) & ~127) | (127 - (16 * nb + fr));
                    const int r = top16_rows(k, fr);
                    tB[m][0] = tB[m][1]; tB[m][1] = tB[m][2]; tB[m][2] = tB[m][3]; tB[m][3] = r;
#pragma unroll
                    for (int nb = 0; nb < 8; ++nb) sc2[m][nb] = (f32x4){sc2[m][nb][1], sc2[m][nb][2], sc2[m][nb][3], sc2[m][nb][0]};
                }
            }
        }
#pragma unroll 2
        for (int it = 0; it < 4; ++it) {
#pragma unroll
            for (int m = 0; m < 2; ++m) {
                int eid; float gt;
                combine16(tA[m][0], tB[m][0], cbv, lane, fr, eid, gt);
                const int t = u.pm * BM + wid * 32 + m * 16 + fq * 4 + it;
                const size_t o = (size_t)t * 128 + h * 16 + fr;
                idx[o] = eid; gate[o] = gt;
                tA[m][0] = tA[m][1]; tA[m][1] = tA[m][2]; tA[m][2] = tA[m][3];
                tB[m][0] = tB[m][1]; tB[m][1] = tB[m][2]; tB[m][2] = tB[m][3];
            }
        }
        __syncthreads();
    }
};
template <class Epi, class Sched>
__device__ __forceinline__ void gemm_phase(PG8_LAS unsigned char* lds, const Gemm g, const Sched& S, const Epi& E) {
    const int tid = tid_opaque(), wid = __builtin_amdgcn_readfirstlane(tid >> 6), lane = tid & 63, wr = wid >> 2, wc = wid & 3, fr = lane & 15, fq = lane >> 4;
    const int K = g.K, nt = K / BK;
    unsigned voffA[2], voffB[2];
#pragma unroll
    for (int i = 0; i < 2; ++i) { int R, C; stage_rc(tid * 16 + i * 8192, R, C); const int Rb = Epi::PERM ? ((R & ~31) + perm32(R & 31)) : R;
        voffA[i] = (unsigned)(R * K + C) * 2u; voffB[i] = (unsigned)(Rb * K + C) * 2u; }
    const size_t kstep = (size_t)(BK * 2);
    const size_t hstep = (size_t)HALF * K * 2;
    const size_t tstep = 2 * hstep;
    const unsigned ldsw = (unsigned)wid * 1024u;
    const int aoff = lds_byte(wr * 64 + fr, fq * 8), boff = lds_byte(wc * 32 + fr, fq * 8);
#define PG8_SA(b, h) (((b) * 2 + (h)) * HTB)
#define PG8_SB(b, h) ((4 + (b) * 2 + (h)) * HTB)
#define PG8_STAGE(bufoff, gbase, voff) do { _Pragma("unroll") for (int _i = 0; _i < 2; ++_i) \
        __builtin_amdgcn_global_load_lds((const unsigned*)((const char*)(gbase) + (voff)[_i]), (PG8_LAS unsigned*)(lds + (bufoff) + ldsw + _i * 8192), 16, 0, 0); } while (0)
#define PG8_LDA(dst, b, h) do { _Pragma("unroll") for (int m = 0; m < 4; ++m) _Pragma("unroll") for (int k = 0; k < 2; ++k) dst[m][k] = *(const PG8_LAS bf16x8*)(lds + PG8_SA(b, h) + aoff + m * 2048 + k * 1024); } while (0)
#define PG8_LDB(dst, b, h) do { _Pragma("unroll") for (int n = 0; n < 2; ++n) _Pragma("unroll") for (int k = 0; k < 2; ++k) dst[n][k] = *(const PG8_LAS bf16x8*)(lds + PG8_SB(b, h) + boff + n * 2048 + k * 1024); } while (0)
#define PG8_MMA(ai, bj, At, Bt) do { __builtin_amdgcn_s_setprio(1); _Pragma("unroll") for (int m = 0; m < 4; ++m) _Pragma("unroll") for (int n = 0; n < 2; ++n) _Pragma("unroll") for (int k = 0; k < 2; ++k) \
        acc[ai][bj][m][n] = mma1<Epi::I8>(Bt[n][k], At[m][k], acc[ai][bj][m][n]); __builtin_amdgcn_s_setprio(0); } while (0)
#define PG8_WAIT_V(n) asm volatile("s_waitcnt vmcnt(" #n ")" ::: "memory")
#define PG8_WAIT_L(n) asm volatile("s_waitcnt lgkmcnt(" #n ")" ::: "memory")
#define PG8_BAR __builtin_amdgcn_s_barrier()
#define PG8_SCHED __builtin_amdgcn_sched_barrier(0)
    Unit cur, nxt; int ui = 0;
    if (!S.next(0, cur)) return;
    typedef typename Epi::acc_t acc_t;
    acc_t acc[2][2][4][2];
#pragma unroll
    for (int a = 0; a < 2; ++a)
#pragma unroll
        for (int b = 0; b < 2; ++b)
#pragma unroll
            for (int m = 0; m < 4; ++m)
#pragma unroll
                for (int n = 0; n < 2; ++n) acc[a][b][m][n] = (acc_t)(0);
    bf16x8 At[4][2], B0[2][2], B1[2][2];
    const char* cA = (const char*)g.A + (size_t)cur.pm * tstep; const char* cB = (const char*)g.Bt + (size_t)cur.pn * tstep;
    S.a_ready(cur);
    PG8_STAGE(PG8_SB(0, 0), cB, voffB); PG8_STAGE(PG8_SA(0, 0), cA, voffA); PG8_STAGE(PG8_SB(0, 1), cB + hstep, voffB); PG8_STAGE(PG8_SA(0, 1), cA + hstep, voffA);
    if (wr == 1) PG8_BAR;
    PG8_WAIT_V(4); PG8_BAR;
    PG8_STAGE(PG8_SB(1, 0), cB + kstep, voffB); PG8_STAGE(PG8_SA(1, 0), cA + kstep, voffA); PG8_STAGE(PG8_SB(1, 1), cB + hstep + kstep, voffB);
    PG8_WAIT_V(6); PG8_BAR;
    for (;;) {
        const bool has_next = S.next(ui + 1, nxt);
        const char* nA = has_next ? (const char*)g.A + (size_t)nxt.pm * tstep : cA; const char* nB = has_next ? (const char*)g.Bt + (size_t)nxt.pn * tstep : cB;
        for (int t = 0; t < nt; t += 2) {
            const bool last = (t == nt - 2);
            const char* a1 = cA + (size_t)(t + 1) * kstep;
            const char* a2 = last ? nA : cA + (size_t)(t + 2) * kstep; const char* b2 = last ? nB : cB + (size_t)(t + 2) * kstep;
            const char* a3 = a2 + kstep; const char* b3 = b2 + kstep;
            if (last && has_next) S.a_ready(nxt);
            PG8_LDB(B0, 0, 0); PG8_SCHED; PG8_LDA(At, 0, 0); PG8_STAGE(PG8_SA(1, 1), a1 + hstep, voffA);
            PG8_WAIT_L(8); PG8_BAR; PG8_WAIT_L(0); PG8_MMA(0, 0, At, B0); PG8_BAR; PG8_SCHED;
            PG8_LDB(B1, 0, 1); PG8_STAGE(PG8_SB(0, 0), b2, voffB);
            PG8_BAR; PG8_WAIT_L(0); PG8_MMA(0, 1, At, B1); PG8_BAR;
            PG8_LDA(At, 0, 1); PG8_STAGE(PG8_SA(0, 0), a2, voffA);
            PG8_BAR; PG8_WAIT_L(0); PG8_MMA(1, 0, At, B0); PG8_BAR; PG8_SCHED;
            PG8_STAGE(PG8_SB(0, 1), b2 + hstep, voffB);
            PG8_WAIT_V(6); PG8_BAR; PG8_MMA(1, 1, At, B1); PG8_BAR;
            PG8_LDB(B0, 1, 0); PG8_SCHED; PG8_LDA(At, 1, 0); PG8_STAGE(PG8_SA(0, 1), a2 + hstep, voffA);
            PG8_WAIT_L(8); PG8_BAR; PG8_WAIT_L(0); PG8_MMA(0, 0, At, B0); PG8_BAR; PG8_SCHED;
            PG8_LDB(B1, 1, 1); PG8_STAGE(PG8_SB(1, 0), b3, voffB);
            PG8_BAR; PG8_WAIT_L(0); PG8_MMA(0, 1, At, B1); PG8_BAR;
            PG8_LDA(At, 1, 1); PG8_STAGE(PG8_SA(1, 0), a3, voffA);
            PG8_BAR; PG8_WAIT_L(0); PG8_MMA(1, 0, At, B0); PG8_BAR; PG8_SCHED;
            PG8_STAGE(PG8_SB(1, 1), b3 + hstep, voffB);
            PG8_WAIT_V(6); PG8_BAR; PG8_MMA(1, 1, At, B1); PG8_BAR;
        }
            if constexpr (!Epi::AFTER_DRAIN) { E(acc, cur, wr, wc, fr, fq); S.done(cur); }
            if (!has_next) break;
#pragma unroll
        for (int a = 0; a < 2; ++a)
#pragma unroll
            for (int b = 0; b < 2; ++b)
#pragma unroll
                for (int m = 0; m < 4; ++m)
#pragma unroll
                    for (int n = 0; n < 2; ++n) acc[a][b][m][n] = (acc_t)(0);
        cur = nxt; cA = nA; cB = nB; ++ui;
    }
    PG8_WAIT_V(0);
    if (wr == 0) PG8_BAR;
    PG8_BAR;
    if constexpr (Epi::AFTER_DRAIN) { E.fused(acc, cur, wr, wc, fr, fq, lds, wid, lane); S.done(cur); }
#undef PG8_SA
#undef PG8_SB
#undef PG8_STAGE
#undef PG8_LDA
#undef PG8_LDB
#undef PG8_MMA
#undef PG8_WAIT_V
#undef PG8_WAIT_L
#undef PG8_BAR
#undef PG8_SCHED
}
}

__device__ void phase_gemm_z(const Params& p, char* lds) {
    pg8::StaticOrder S; S.init(T_TOK, D_IN, gridDim.x, blockIdx.x);
    pg8::gemm_phase<pg8::EpiZ8, pg8::StaticOrder>((PG8_LAS unsigned char*)lds, pg8::Gemm{(const bf16_t*)p.xq, (const bf16_t*)p.winT8, T_TOK, D_IN, D_MODEL / 2}, S, pg8::EpiZ8{p.zb, p.rstd1, p.swb});
}
__device__ void phase_gemm_out(const Params& p, char* lds) {
    pg8::StaticOrder S; S.init(T_TOK, D_MODEL, gridDim.x, blockIdx.x);
    pg8::gemm_phase<pg8::EpiOut, pg8::StaticOrder>((PG8_LAS unsigned char*)lds, pg8::Gemm{p.cB, p.woutT, T_TOK, D_MODEL, D_MODEL}, S, pg8::EpiOut{p.hb, p.xq, p.sx});
}
__device__ void phase_gemm_q(const Params& p, char* lds) {
    pg8::StaticOrder S; S.init(T_TOK, 2048, gridDim.x, blockIdx.x);
    pg8::Unit u;
    for (int i = 0; S.next(i, u); ++i)
        pg8::gemm_phase<pg8::EpiQTopk, pg8::OneUnit>((PG8_LAS unsigned char*)lds, pg8::Gemm{(const bf16_t*)p.hq, (const bf16_t*)p.wqT8, T_TOK, 2048, D_MODEL / 2}, pg8::OneUnit{u}, pg8::EpiQTopk{p.keysB, p.idx, p.gate, p.swq});
}

#define XB_TMO      128
#define XB_XCNT(j)  (256  + 64 * (j))
#define XB_XSUB(j)  (1280 + 64 * (j))
#define XB_XGEN(j)  (2304 + 64 * (j))
#define XB_TOP      3328
#define XB_TOPGEN   3392
#define XCD_BAR_WORDS 3456
#define XB_SPIN_CAP (1u << 20)
__device__ __forceinline__ unsigned xb_ld(unsigned* p)              { return __hip_atomic_load(p, __ATOMIC_RELAXED, __HIP_MEMORY_SCOPE_AGENT); }
__device__ __forceinline__ unsigned xb_add(unsigned* p, unsigned v) { return __hip_atomic_fetch_add(p, v, __ATOMIC_RELAXED, __HIP_MEMORY_SCOPE_AGENT); }
__device__ __forceinline__ unsigned xb_xcc_id() { return (unsigned)__builtin_amdgcn_s_getreg((3 << 11) | 20) & 0xFu; }
#define XB_SPIN(cond, bar) do { unsigned _sp = 0; while (cond) { __builtin_amdgcn_s_sleep(1); \
    if ((++_sp & 255u) == 0u) { if (xb_ld(&(bar)[XB_TMO])) break; if (_sp > XB_SPIN_CAP) { atomicAdd(&(bar)[XB_TMO], 1u); break; } } } } while (0)
struct XcdBarrier { unsigned* bar; unsigned x; volatile LAS unsigned* st; };
__device__ __forceinline__ XcdBarrier xcd_barrier_post(unsigned* bar, volatile LAS unsigned* st) {
    XcdBarrier b; b.bar = bar; b.x = xb_xcc_id(); b.st = st;
    if (threadIdx.x == 0) (void)xb_add(&bar[XB_XCNT(b.x)], 1u);
    return b;
}
__device__ __forceinline__ void xcd_barrier_complete(unsigned* bar, unsigned x, unsigned& nloc, unsigned& nx) {
    const unsigned G = gridDim.x * gridDim.y * gridDim.z;
    unsigned sum, cnt, mine, sp = 0u;
    for (;;) {
        sum = 0u; cnt = 0u; mine = 0u;
#pragma unroll
        for (unsigned j = 0; j < 16; ++j) { const unsigned c = xb_ld(&bar[XB_XCNT(j)]); sum += c; cnt += (c > 0u) ? 1u : 0u; mine = (j == x) ? c : mine; }
        if (sum == G) break;
        __builtin_amdgcn_s_sleep(1);
        if ((++sp & 255u) == 0u) { if (xb_ld(&bar[XB_TMO])) break; if (sp > XB_SPIN_CAP) { atomicAdd(&bar[XB_TMO], 1u); break; } }
    }
    nloc = mine > 0u ? mine : 1u; nx = cnt > 0u ? cnt : 1u;
}
__device__ __forceinline__ void xcd_barrier(const XcdBarrier& b) {
    asm volatile("s_waitcnt vmcnt(0)" ::: "memory");
    __syncthreads();
    if (threadIdx.x == 0) {
        unsigned* bar = b.bar;
        __builtin_amdgcn_s_waitcnt(0);
        unsigned nloc = b.st[0], nx = b.st[1];
        if (nloc == 0u) { xcd_barrier_complete(bar, b.x, nloc, nx); b.st[0] = nloc; b.st[1] = nx; }
        const unsigned old = xb_add(&bar[XB_XSUB(b.x)], 1u);
        const unsigned gen = old / nloc;
        if (old + 1u == (gen + 1u) * nloc) {
            __builtin_amdgcn_fence(__ATOMIC_RELEASE, "agent");
            asm volatile("s_waitcnt vmcnt(0)" ::: "memory");
            const unsigned og = xb_add(&bar[XB_TOP], 1u);
            const unsigned tg = og / nx;
            if (og + 1u == (tg + 1u) * nx) xb_add(&bar[XB_TOPGEN], 1u);
            else XB_SPIN(xb_ld(&bar[XB_TOPGEN]) == tg, bar);
            __builtin_amdgcn_fence(__ATOMIC_ACQUIRE, "agent");
            xb_add(&bar[XB_XGEN(b.x)], 1u);
            asm volatile("s_waitcnt vmcnt(0)" ::: "memory");
        } else {
            XB_SPIN(xb_ld(&bar[XB_XGEN(b.x)]) == gen, bar);
            __builtin_amdgcn_fence(__ATOMIC_ACQUIRE, "agent");
            asm volatile("s_waitcnt vmcnt(0)" ::: "memory");
        }
    }
    __syncthreads();
}

#define MEGA_LDS_MAX2(a, b) ((a) > (b) ? (a) : (b))
#define MEGA_LDS_MAIN MEGA_LDS_MAX2(MEGA_LDS_MAX2(QT_LDS_BYTES, pg8::STAGE_BYTES), MEGA_LDS_MAX2(8 * TS_WBYTES, 2 * MIXH_LDS))
#define MEGA_LDS_BYTES (MEGA_LDS_MAIN + 16)
extern __shared__ __attribute__((aligned(16))) char smem[];
__global__ void __launch_bounds__(512, 2) fwd_mega(Params p) {
    volatile LAS unsigned* st = (volatile LAS unsigned*)(smem + MEGA_LDS_MAIN);
    if (threadIdx.x < 4) st[threadIdx.x] = 0u;
    __syncthreads();
    const XcdBarrier xb = xcd_barrier_post(p.bar, st);
    phase_prep(p, smem);      xcd_barrier(xb);
    phase_gemm_z(p, smem);    xcd_barrier(xb);
    phase_mix_gemm(p, smem);  xcd_barrier(xb);
    phase_gemm_out(p, smem);  xcd_barrier(xb);
    phase_hquant(p, smem);    xcd_barrier(xb);
    phase_gemm_q(p, smem);    xcd_barrier(xb);
    phase_peer_dots(p, smem); xcd_barrier(xb);
    phase_gather(p, smem);
}

extern "C" void kernel_launch(void* const* d_in, const int* in_sizes, int n_in, void* d_out, int out_size, void* d_ws, size_t ws_size, hipStream_t stream) {
    static int grid_blocks = 0;
    if (grid_blocks == 0) {
        int dev = 0, cus = 0, per_cu = 0;
        (void)hipGetDevice(&dev);
        (void)hipDeviceGetAttribute(&cus, hipDeviceAttributeMultiprocessorCount, dev);
        (void)hipFuncSetAttribute((const void*)fwd_mega, hipFuncAttributeMaxDynamicSharedMemorySize, MEGA_LDS_BYTES);
        (void)hipOccupancyMaxActiveBlocksPerMultiprocessor(&per_cu, (const void*)fwd_mega, 512, MEGA_LDS_BYTES);
        if (per_cu > 1) per_cu = 1;
        if (per_cu < 1) per_cu = 1;
        grid_blocks = cus * per_cu;
    }
    Params p{};
    p.x = (const float*)d_in[0]; p.norm1_g = (const float*)d_in[1]; p.w_in = (const float*)d_in[2]; p.pool_w = (const float*)d_in[3];
    p.pool_scale = (const float*)d_in[4]; p.sgu_norm_g = (const float*)d_in[5]; p.sgu_w = (const float*)d_in[6]; p.sgu_b = (const float*)d_in[7];
    p.w_out = (const float*)d_in[8]; p.norm2_g = (const float*)d_in[9]; p.peer_wq = (const float*)d_in[10]; p.peer_keys = (const float*)d_in[11];
    p.peer_u = (const float*)d_in[12]; p.peer_v = (const float*)d_in[13]; p.final_g = (const float*)d_in[14];
    p.out = (float*)d_out;
    char* w = (char*)d_ws; size_t off = 0;
    auto take = [&](size_t bytes) { char* r = w + off; off += (bytes + 255) & ~(size_t)255; return r; };
    const size_t MiB = 1024 * 1024;
    p.u8 = (unsigned char*)take(16 * MiB); p.v8 = (unsigned char*)take(12 * MiB);
    p.suv = (float2*)take(128 * 1024);
    p.woutT = (bf16_t*)take(2 * MiB);
    p.poolT = (bf16_t*)take(128 * 1024); p.wsM = (bf16_t*)take(128 * 1024); p.keysB = (bf16_t*)take(512 * 1024);
    p.bar = (unsigned*)take(XCD_BAR_WORDS * 4 + 4608 * 4); p.swb = p.bar + XCD_BAR_WORDS; p.swq = p.swb + 2048;
    p.rstd1 = (float*)take(128 * 1024); p.sx = (float*)take(128 * 1024); p.xq = (signed char*)take(32 * MiB); p.winT8 = (signed char*)take(1536 * 1024); p.wqT8 = (signed char*)take(2048 * 1024); p.hq = (signed char*)take(32 * MiB); p.hsc = (float*)take(128 * 1024);
    p.idx = (int*)take(16 * MiB); p.gate = (float*)take(16 * MiB); p.coef = (float*)take(16 * MiB);
    p.zb = (bf16_t*)take(96 * MiB); p.cB = (bf16_t*)take(64 * MiB); p.hb = (bf16_t*)take(64 * MiB);
    (void)hipMemsetAsync(p.bar, 0, XCD_BAR_WORDS * 4 + 4608 * 4, stream);
    hipLaunchKernelGGL(fwd_mega, dim3(grid_blocks), dim3(512), MEGA_LDS_BYTES, stream, p);
}
```

```cpp
#include <hip/hip_runtime.h>
#include <stdint.h>
#include <type_traits>

typedef unsigned short bf16_t;
typedef short bf16x8 __attribute__((ext_vector_type(8)));
typedef float f32x4 __attribute__((ext_vector_type(4)));
typedef unsigned u32x4 __attribute__((ext_vector_type(4)));
typedef unsigned u32x2 __attribute__((ext_vector_type(2)));
typedef unsigned u32x3 __attribute__((ext_vector_type(3)));
typedef int i32x4 __attribute__((ext_vector_type(4)));
#define ROWB 768
typedef __bf16 bf2_t __attribute__((ext_vector_type(2)));
#define LAS __attribute__((address_space(3)))

#define T_TOK 32768
#define D_MODEL 1024
#define D_IN 1536
#define SEQ 2048
#define NEXP 16384
#define EPS 1e-6f

struct Params {
    const float *x, *norm1_g, *w_in, *pool_w, *pool_scale, *sgu_norm_g, *sgu_w, *sgu_b, *w_out, *norm2_g, *peer_wq, *peer_keys, *peer_u, *peer_v, *final_g;
    float* out;
    bf16_t *woutT, *poolT, *wsM, *keysB;
    unsigned char *u8, *v8;
    float2* suv;
    float *rstd1, *sx;
    signed char *xq, *winT8, *hq, *wqT8; unsigned *swb, *swq; float* hsc;
    bf16_t *zb, *cB, *hb;
    int* idx; float* gate; float* coef;
    unsigned* bar;
};

__device__ __forceinline__ int tid_opaque() { int t = (int)threadIdx.x; asm volatile("" : "+v"(t)); return t; }
__device__ __forceinline__ unsigned short f2bf(float f) {
    unsigned u = __float_as_uint(f);
    u += 0x7fffu + ((u >> 16) & 1u);
    return (unsigned short)(u >> 16);
}
__device__ __forceinline__ float bf2f(unsigned short h) { return __uint_as_float(((unsigned)h) << 16); }
__device__ __forceinline__ unsigned pack2(float a, float b) { return (unsigned)f2bf(a) | ((unsigned)f2bf(b) << 16); }
__device__ __forceinline__ float bflo(unsigned w) { return __uint_as_float(w << 16); }
__device__ __forceinline__ float bfhi(unsigned w) { return __uint_as_float(w & 0xffff0000u); }
__device__ __forceinline__ float gelu_t(float x) {
    const float y = 1.5957691216057308f * (x + 0.044715f * x * x * x);
    return x * __builtin_amdgcn_rcpf(1.0f + __expf(-y));
}
__device__ __forceinline__ float wave_sum(float v) {
#pragma unroll
    for (int o = 32; o >= 1; o >>= 1) v += __shfl_xor(v, o);
    return v;
}
__device__ __forceinline__ float wave_max(float v) {
#pragma unroll
    for (int o = 32; o >= 1; o >>= 1) v = fmaxf(v, __shfl_xor(v, o));
    return v;
}

#define GEMM_LDS_BYTES (2 * 128 * 144)
__device__ __forceinline__ void transpose_tile(const int tid, const float* __restrict__ src, bf16_t* __restrict__ dst, int R, int C, const float* __restrict__ rscale, int tile, float* lds) {
    const int tilesC = C / 64, tr = tile / tilesC, tc = tile % tilesC;
    const int ty = tid >> 6, tx = tid & 63;
    __syncthreads();
#pragma unroll
    for (int i = 0; i < 16; ++i) {
        const int r = ty + 4 * i;
        float v = src[(size_t)(tr * 64 + r) * C + tc * 64 + tx];
        if (rscale) v *= rscale[tr * 64 + r];
        lds[r * 65 + tx] = v;
    }
    __syncthreads();
#pragma unroll
    for (int i = 0; i < 16; ++i) {
        const int c = ty + 4 * i;
        dst[(size_t)(tc * 64 + c) * R + tr * 64 + tx] = f2bf(lds[tx * 65 + c]);
    }
}

__device__ __forceinline__ void w8_colmax(const float* __restrict__ src, const float* __restrict__ gain, int C, unsigned* mx, unsigned* cnt, int hb2, int nh, int ht) {
    const int ncb = C / 64;
    for (int t = hb2; t < 16 * ncb; t += nh) {
        const int tr = t / ncb, tc = t % ncb, ty = ht >> 6, tx = ht & 63;
        float am = 0.f;
#pragma unroll
        for (int i = 0; i < 16; ++i) { const int r = tr * 64 + ty + 4 * i; am = fmaxf(am, fabsf(src[(size_t)r * C + tc * 64 + tx] * gain[r])); }
        (void)__hip_atomic_fetch_max(mx + tc * 64 + tx, __float_as_uint(am), __ATOMIC_RELAXED, __HIP_MEMORY_SCOPE_AGENT);
        asm volatile("s_waitcnt vmcnt(0)" ::: "memory");
        __syncthreads();
        if (ht == 0) (void)__hip_atomic_fetch_add(cnt + tc, 1u, __ATOMIC_RELAXED, __HIP_MEMORY_SCOPE_AGENT);
    }
}
__device__ __forceinline__ void w8_tiles(const float* __restrict__ src, const float* __restrict__ gain, int C, signed char* __restrict__ dst, unsigned* mx, unsigned* cnt, char* lds, int tid) {
    const int half = tid >> 8, ht = tid & 255, ty = ht >> 6, tx = ht & 63, ncb = C / 64;
    float* fl = (float*)(lds + half * (64 * 65 * 4));
    for (int t = 2 * blockIdx.x + half; t < 16 * ncb; t += 2 * gridDim.x) {
        const int tr = t / ncb, tc = t % ncb;
        if (ht == 0) {
            unsigned spins = 0;
            while (__hip_atomic_load(cnt + tc, __ATOMIC_RELAXED, __HIP_MEMORY_SCOPE_AGENT) < 16u && ++spins < (1u << 22)) __builtin_amdgcn_s_sleep(2);
        }
        __syncthreads();
#pragma unroll
        for (int i = 0; i < 16; ++i) { const int r = ty + 4 * i; fl[r * 65 + tx] = src[(size_t)(tr * 64 + r) * C + tc * 64 + tx] * gain[tr * 64 + r]; }
        __syncthreads();
#pragma unroll
        for (int i = 0; i < 16; ++i) {
            const int c = ty + 4 * i;
            const float am = __uint_as_float(__hip_atomic_load(mx + tc * 64 + c, __ATOMIC_RELAXED, __HIP_MEMORY_SCOPE_AGENT));
            const float inv = am > 0.f ? 127.0f / am : 0.f;
            dst[(size_t)(tc * 64 + c) * 1024 + tr * 64 + tx] = (signed char)(int)rintf(fl[tx * 65 + c] * inv);
        }
    }
}

__device__ __forceinline__ void quant_expert(const Params& p, const int e, const int lane, const float4 (&a4)[4], const float4 (&b4)[4]) {
    float fu[16], fv[16];
#pragma unroll
    for (int i = 0; i < 4; ++i) {
        const float4 g = ((const float4*)(p.norm2_g + lane * 16))[i];
        fu[4 * i] = a4[i].x * g.x; fu[4 * i + 1] = a4[i].y * g.y; fu[4 * i + 2] = a4[i].z * g.z; fu[4 * i + 3] = a4[i].w * g.w;
        fv[4 * i] = b4[i].x; fv[4 * i + 1] = b4[i].y; fv[4 * i + 2] = b4[i].z; fv[4 * i + 3] = b4[i].w;
    }
    {
        float am = 0.f;
#pragma unroll
        for (int j = 0; j < 16; ++j) am = fmaxf(am, fabsf(fu[j]));
        am = wave_max(am);
        const float inv = am > 0.f ? 127.0f / am : 0.f;
        u32x4 o;
#pragma unroll
        for (int i = 0; i < 4; ++i) {
            unsigned w = 0;
#pragma unroll
            for (int k = 0; k < 4; ++k) w |= (unsigned)(((int)rintf(fu[4 * i + k] * inv)) & 0xff) << (8 * k);
            o[i] = w;
        }
        *(u32x4*)(p.u8 + (size_t)e * D_MODEL + lane * 16) = o;
        if (lane == 0) p.suv[e].x = am * (1.0f / 127.0f);
    }
    {
        float am = 0.f;
#pragma unroll
        for (int j = 0; j < 16; ++j) am = fmaxf(am, fabsf(fv[j]));
        am = wave_max(am);
        const float inv = am > 0.f ? 31.0f / am : 0.f;
        int q[16];
#pragma unroll
        for (int j = 0; j < 16; ++j) q[j] = (int)rintf(fv[j] * inv) + 32;
        unsigned dg[3][4];
#pragma unroll
        for (int k = 0; k < 4; ++k) {
            int ee = q[12 + k] - 42;
#pragma unroll
            for (int i = 0; i < 3; ++i) { const int d = ee & 3, D = d >= 2 ? d - 4 : d; dg[i][k] = (unsigned)d; ee = (ee - D) >> 2; }
        }
        u32x3 o;
#pragma unroll
        for (int i = 0; i < 3; ++i) {
            unsigned w = 0;
#pragma unroll
            for (int k = 0; k < 4; ++k) w |= (unsigned)(q[4 * i + k] | (dg[i][k] << 6)) << (8 * k);
            o[i] = w;
        }
        *(u32x3*)(p.v8 + (size_t)e * ROWB + lane * 12) = o;
        if (lane == 0) p.suv[e].y = am * (1.0f / 31.0f);
    }
}

__device__ void phase_prep(const Params& p, char* lds) {
    const int tidx_ = tid_opaque();
    const int nb = gridDim.x, b = blockIdx.x, tid = tidx_;
    const int half = tid >> 8, ht = tid & 255, nh = 2 * nb, hb2 = 2 * b + half;
    float* fl = (float*)(lds + half * (64 * 65 * 4));
    w8_colmax(p.w_in, p.norm1_g, 1536, p.swb, p.swb + 1536, hb2, nh, ht);
    w8_colmax(p.peer_wq, p.norm2_g, 2048, p.swq, p.swq + 2048, hb2, nh, ht);
    for (int t = hb2; t < 16 * 16; t += nh) transpose_tile(ht, p.w_out, p.woutT, 1024, 1024, nullptr, t, fl);
    for (int t = hb2; t < 16; t += nh) transpose_tile(ht, p.pool_w + (size_t)(t >> 2) * 16384, p.poolT + (size_t)(t >> 2) * 16384, 128, 128, nullptr, t & 3, fl);
    const size_t gtid = (size_t)b * blockDim.x + tid, gsz = (size_t)nb * blockDim.x;
    for (size_t i = gtid; i < 4 * 128 * 128; i += gsz) {
        const int j = (int)(i & 127), ii = (int)((i >> 7) & 127);
        const bool keep = (j >> 6) <= (ii >> 6);
        p.wsM[i] = keep ? f2bf(p.sgu_w[i]) : (bf16_t)0;
    }
    for (size_t o = gtid; o < 2 * 8 * 128 * 128; o += gsz) {
        const int j = (int)(o & 7), ln = (int)((o >> 3) & 63), nb = (int)((o >> 9) & 7), kk = (int)((o >> 12) & 3), ph = (int)(o >> 14);
        p.keysB[o] = f2bf(p.peer_keys[(size_t)ph * 16384 + (size_t)(16 * nb + (ln & 15)) * 128 + 32 * kk + 8 * (ln >> 4) + j]);
    }
    const int wave = (b * blockDim.x + tid) >> 6, nwaves = (nb * blockDim.x) >> 6, lane = tid & 63;
    for (int t = wave; t < T_TOK; t += 2 * nwaves) {
        const int t1 = t + nwaves; const bool two = t1 < T_TOK;
        const float4* xr0 = (const float4*)(p.x + (size_t)t * D_MODEL);
        const float4* xr1 = (const float4*)(p.x + (size_t)(two ? t1 : t) * D_MODEL);
        float4 v0[4], v1[4];
#pragma unroll
        for (int i = 0; i < 4; ++i) { v0[i] = xr0[lane + 64 * i]; v1[i] = xr1[lane + 64 * i]; }
        float s0 = 0.f, s1 = 0.f, a0 = 0.f, a1 = 0.f;
#pragma unroll
        for (int i = 0; i < 4; ++i) {
            s0 += v0[i].x * v0[i].x + v0[i].y * v0[i].y + v0[i].z * v0[i].z + v0[i].w * v0[i].w;
            s1 += v1[i].x * v1[i].x + v1[i].y * v1[i].y + v1[i].z * v1[i].z + v1[i].w * v1[i].w;
            a0 = fmaxf(fmaxf(a0, fmaxf(fabsf(v0[i].x), fabsf(v0[i].y))), fmaxf(fabsf(v0[i].z), fabsf(v0[i].w)));
            a1 = fmaxf(fmaxf(a1, fmaxf(fabsf(v1[i].x), fabsf(v1[i].y))), fmaxf(fabsf(v1[i].z), fabsf(v1[i].w)));
        }
        s0 = wave_sum(s0); s1 = wave_sum(s1); a0 = wave_max(a0); a1 = wave_max(a1);
        const float i0 = a0 > 0.f ? 127.0f / a0 : 0.f, i1 = a1 > 0.f ? 127.0f / a1 : 0.f;
#pragma unroll
        for (int i = 0; i < 4; ++i) {
            const unsigned q0 = ((unsigned)((int)rintf(v0[i].x * i0) & 0xff)) | ((unsigned)((int)rintf(v0[i].y * i0) & 0xff) << 8) | ((unsigned)((int)rintf(v0[i].z * i0) & 0xff) << 16) | ((unsigned)((int)rintf(v0[i].w * i0) & 0xff) << 24);
            ((unsigned*)(p.xq + (size_t)t * D_MODEL))[lane + 64 * i] = q0;
            if (two) {
                const unsigned q1 = ((unsigned)((int)rintf(v1[i].x * i1) & 0xff)) | ((unsigned)((int)rintf(v1[i].y * i1) & 0xff) << 8) | ((unsigned)((int)rintf(v1[i].z * i1) & 0xff) << 16) | ((unsigned)((int)rintf(v1[i].w * i1) & 0xff) << 24);
                ((unsigned*)(p.xq + (size_t)t1 * D_MODEL))[lane + 64 * i] = q1;
            }
        }
        if (lane == 0) {
            p.rstd1[t] = rsqrtf(s0 * (1.0f / D_MODEL) + EPS) * a0 * (1.0f / 127.0f); p.sx[t] = a0 * (1.0f / 127.0f);
            if (two) { p.rstd1[t1] = rsqrtf(s1 * (1.0f / D_MODEL) + EPS) * a1 * (1.0f / 127.0f); p.sx[t1] = a1 * (1.0f / 127.0f); }
        }
    }
    w8_tiles(p.w_in, p.norm1_g, 1536, p.winT8, p.swb, p.swb + 1536, lds, tid);
    w8_tiles(p.peer_wq, p.norm2_g, 2048, p.wqT8, p.swq, p.swq + 2048, lds, tid);
}

typedef short s16x4 __attribute__((ext_vector_type(4)));
template <class Epi>
__device__ __forceinline__ void gemm128_sgu(const int tid, const bf16_t* __restrict__ A, const bf16_t* __restrict__ V  ,
                                            const float* __restrict__ lnm, const float* __restrict__ lnr, const float* __restrict__ gch, char* lds, const Epi& epi) {
    const int lane = tid & 63, wid = tid >> 6, wr = wid >> 1, wc = wid & 1, fr = lane & 15, fq = lane >> 4;
    constexpr int PITCH = 144, P2 = 288;
    char* sA = lds; char* sB = lds + 128 * PITCH;
    f32x4 acc[4][4];
#pragma unroll
    for (int m = 0; m < 4; ++m)
#pragma unroll
        for (int n = 0; n < 4; ++n) acc[m][n] = (f32x4){0.f, 0.f, 0.f, 0.f};
    u32x4 ra[4], rb[4]; float rm[4], rr[4];
    const int lrow = tid >> 3, lch = tid & 7;
    const int btok = tid >> 4, bch = tid & 15;
    const bf16_t* ga = A + (size_t)lrow * 128 + lch * 8;
    const bf16_t* gb = V + (size_t)btok * D_IN + bch * 8;
    float g8[8];
    { const float4 g0 = *(const float4*)(gch + bch * 8), g1 = *(const float4*)(gch + bch * 8 + 4); g8[0] = g0.x; g8[1] = g0.y; g8[2] = g0.z; g8[3] = g0.w; g8[4] = g1.x; g8[5] = g1.y; g8[6] = g1.z; g8[7] = g1.w; }
#pragma unroll
    for (int j = 0; j < 4; ++j) { ra[j] = *(const u32x4*)(ga + (size_t)(32 * j) * 128); rb[j] = *(const u32x4*)(gb + (size_t)(16 * j) * D_IN); rm[j] = lnm[btok + 16 * j]; rr[j] = lnr[btok + 16 * j]; }
    for (int k0 = 0; k0 < 128; k0 += 64) {
        __syncthreads();
#pragma unroll
        for (int j = 0; j < 4; ++j) {
            *(u32x4*)(sA + (lrow + 32 * j) * PITCH + lch * 16) = ra[j];
            u32x4 o;
#pragma unroll
            for (int i = 0; i < 4; ++i) {
                const unsigned w = rb[j][i];
                o[i] = pack2((bflo(w) - rm[j]) * rr[j] * g8[2 * i], (bfhi(w) - rm[j]) * rr[j] * g8[2 * i + 1]);
            }
            *(u32x4*)(sB + (btok + 16 * j) * P2 + bch * 16) = o;
        }
        __syncthreads();
        if (k0 + 64 < 128) {
#pragma unroll
            for (int j = 0; j < 4; ++j) { ra[j] = *(const u32x4*)(ga + (size_t)(32 * j) * 128 + 64); rb[j] = *(const u32x4*)(gb + (size_t)(64 + 16 * j) * D_IN); rm[j] = lnm[64 + btok + 16 * j]; rr[j] = lnr[64 + btok + 16 * j]; }
        }
#pragma unroll
        for (int kk = 0; kk < 2; ++kk) {
            bf16x8 af[4], bfr[4];
#pragma unroll
            for (int m = 0; m < 4; ++m) af[m] = *(const bf16x8*)(sA + (wr * 64 + m * 16 + fr) * PITCH + (kk * 32 + fq * 8) * 2);
#pragma unroll
            for (int n = 0; n < 4; ++n) {
                const char* bp = sB + (kk * 32 + fq * 8 + (fr >> 2)) * P2 + (wc * 64 + n * 16 + 4 * (fr & 3)) * 2;
                const s16x4 lo = __builtin_amdgcn_ds_read_tr16_b64_v4i16((LAS s16x4*)(bp));
                const s16x4 hi = __builtin_amdgcn_ds_read_tr16_b64_v4i16((LAS s16x4*)(bp + 4 * P2));
                bfr[n] = (bf16x8){lo[0], lo[1], lo[2], lo[3], hi[0], hi[1], hi[2], hi[3]};
            }
#pragma unroll
            for (int m = 0; m < 4; ++m)
#pragma unroll
                for (int n = 0; n < 4; ++n) acc[m][n] = __builtin_amdgcn_mfma_f32_16x16x32_bf16(bfr[n], af[m], acc[m][n], 0, 0, 0);
        }
    }
#pragma unroll
    for (int m = 0; m < 4; ++m)
#pragma unroll
        for (int n = 0; n < 4; ++n) epi(wr * 64 + m * 16 + fr, wc * 64 + n * 16 + fq * 4, acc[m][n]);
}

#define PT_PITCH 272
#define MIXH_LDS (2 * 128 * PT_PITCH + 1024)
template <int W, class Epi>
__device__ __forceinline__ void pool_tile(const int tid, const bf16_t* __restrict__ zb0  , int pos0,
                                          const bf16_t* __restrict__ Bt, char* lds, const Epi& epi) {
    const int lane = tid & 63, wid = tid >> 6, wr = wid >> 1, wc = wid & 1, fr = lane & 15, fq = lane >> 4;
    char* sA = lds; char* sB = lds + 128 * PT_PITCH;
    __syncthreads();
#pragma unroll
    for (int j = 0; j < 8; ++j) { const int id = tid + 256 * j, row = id >> 4, ch = id & 15; *(u32x4*)(sB + row * PT_PITCH + ch * 16) = *(const u32x4*)(Bt + (size_t)row * 128 + ch * 8); }
    {
        const int seg = tid >> 5, hc = tid & 31, r0 = seg * 16;
        const bool at_start = (pos0 & (SEQ - 1)) == 0;
        const bf16_t* zp = zb0 + hc * 4;
        u32x2 v[W + 16];
#pragma unroll
        for (int i = 0; i < W + 16; ++i) { const int rr = r0 - W + i; const bool ok = !(at_start && rr < 0); v[i] = *(const u32x2*)(zp + (ptrdiff_t)(ok ? rr : 0) * D_IN); }
        float sm[4] = {0.f, 0.f, 0.f, 0.f};
#pragma unroll
        for (int i = 1; i <= W; ++i) {
            const float m = (at_start && (r0 - W + i) < 0) ? 0.f : 1.f;
            sm[0] += m * bflo(v[i].x); sm[1] += m * bfhi(v[i].x); sm[2] += m * bflo(v[i].y); sm[3] += m * bfhi(v[i].y);
        }
#pragma unroll
        for (int o = 0; o < 16; ++o) {
            if (o > 0) {
                const float md = (at_start && (r0 + o - W) < 0) ? 0.f : 1.f;
                sm[0] += bflo(v[W + o].x) - md * bflo(v[o].x); sm[1] += bfhi(v[W + o].x) - md * bfhi(v[o].x);
                sm[2] += bflo(v[W + o].y) - md * bflo(v[o].y); sm[3] += bfhi(v[W + o].y) - md * bfhi(v[o].y);
            }
            const int pos = (pos0 + r0 + o) & (SEQ - 1);
            const float rn = 1.0f / (float)((pos + 1 < W) ? pos + 1 : W);
            u32x2 ov;
            ov.x = pack2(sm[0] * rn - bflo(v[W + o].x), sm[1] * rn - bfhi(v[W + o].x));
            ov.y = pack2(sm[2] * rn - bflo(v[W + o].y), sm[3] * rn - bfhi(v[W + o].y));
            *(u32x2*)(sA + (r0 + o) * PT_PITCH + hc * 8) = ov;
        }
    }
    __syncthreads();
    f32x4 acc[4][4];
#pragma unroll
    for (int m = 0; m < 4; ++m)
#pragma unroll
        for (int n = 0; n < 4; ++n) acc[m][n] = (f32x4){0.f, 0.f, 0.f, 0.f};
#pragma unroll
    for (int kk = 0; kk < 4; ++kk) {
        bf16x8 af[4], bfr[4];
#pragma unroll
        for (int m = 0; m < 4; ++m) af[m] = *(const bf16x8*)(sA + (wr * 64 + m * 16 + fr) * PT_PITCH + (kk * 32 + fq * 8) * 2);
#pragma unroll
        for (int n = 0; n < 4; ++n) bfr[n] = *(const bf16x8*)(sB + (wc * 64 + n * 16 + fr) * PT_PITCH + (kk * 32 + fq * 8) * 2);
#pragma unroll
        for (int m = 0; m < 4; ++m)
#pragma unroll
            for (int n = 0; n < 4; ++n) acc[m][n] = __builtin_amdgcn_mfma_f32_16x16x32_bf16(bfr[n], af[m], acc[m][n], 0, 0, 0);
    }
#pragma unroll
    for (int m = 0; m < 4; ++m)
#pragma unroll
        for (int n = 0; n < 4; ++n) epi(wr * 64 + m * 16 + fr, wc * 64 + n * 16 + fq * 4, acc[m][n]);
}

__device__ void phase_mix_gemm(const Params& p, char* lds) {
    const int tidx_ = tid_opaque();
    const int npool = (T_TOK / 128) * 4, nsgu = (T_TOK / 128) * 4;
    const int half = tidx_ >> 8, ht = tidx_ & 255; lds += half * MIXH_LDS;
    for (int tile = 2 * blockIdx.x + half; tile < npool + nsgu; tile += 2 * gridDim.x) {
        if (tile < npool) {
            const int tm = tile >> 2, g = tile & 3;
            const float* ps = p.pool_scale + g * 128; bf16_t* co = p.cB + (size_t)tm * 128 * D_MODEL + g * 128;
            const bf16_t* z0 = p.zb + (size_t)tm * 128 * D_IN + g * 128; const bf16_t* bt = p.poolT + (size_t)g * 16384;
            auto epi = [&](int r, int c, f32x4 v) {
                const float4 sc = *(const float4*)(ps + c);
                uint2 o; o.x = pack2(v[0] * sc.x, v[1] * sc.y); o.y = pack2(v[2] * sc.z, v[3] * sc.w);
                *(uint2*)(co + (size_t)r * D_MODEL + c) = o;
            };
            if (g == 0) pool_tile<2>(ht, z0, tm * 128, bt, lds, epi); else if (g == 1) pool_tile<4>(ht, z0, tm * 128, bt, lds, epi);
            else if (g == 2) pool_tile<8>(ht, z0, tm * 128, bt, lds, epi); else pool_tile<16>(ht, z0, tm * 128, bt, lds, epi);
        } else {
            const int t2 = tile - npool, blk = t2 >> 2, h = t2 & 3;
            float* stm = (float*)(lds + GEMM_LDS_BYTES); float* str = stm + 128;
            __syncthreads();
            {
                const int tok = ht >> 1, hh = ht & 1;
                const u32x4* vp = (const u32x4*)(p.zb + (size_t)(blk * 128 + tok) * D_IN + 1024 + hh * 256);
                float s1 = 0.f, s2 = 0.f;
#pragma unroll 8
                for (int i = 0; i < 32; ++i) {
                    const u32x4 v = vp[i];
#pragma unroll
                    for (int k = 0; k < 4; ++k) { const float a = bflo(v[k]), c = bfhi(v[k]); s1 += a + c; s2 += a * a + c * c; }
                }
                s1 += __shfl_xor(s1, 1); s2 += __shfl_xor(s2, 1);
                const float mean = s1 * (1.0f / 512.0f), var = fmaxf(s2 * (1.0f / 512.0f) - mean * mean, 0.f);
                if (hh == 0) { stm[tok] = mean; str[tok] = rsqrtf(var + EPS); }
            }
            __syncthreads();
            const float* sb = p.sgu_b + h * 128; const bf16_t* uo = p.zb + (size_t)blk * 128 * D_IN + 512 + h * 128;
            bf16_t* co = p.cB + (size_t)blk * 128 * D_MODEL + 512 + h * 128;
            gemm128_sgu(ht, p.wsM + (size_t)h * 16384, p.zb + (size_t)blk * 128 * D_IN + 1024 + h * 128, stm, str, p.sgu_norm_g + h * 128, lds,
                    [&](int r, int c, f32x4 v) {
                        const float bb = sb[r];
                        const uint2 uu = *(const uint2*)(uo + (size_t)r * D_IN + c);
                        uint2 o;
                        o.x = pack2((v[0] + bb) * bflo(uu.x), (v[1] + bb) * bfhi(uu.x));
                        o.y = pack2((v[2] + bb) * bflo(uu.y), (v[3] + bb) * bfhi(uu.y));
                        *(uint2*)(co + (size_t)r * D_MODEL + c) = o;
                    });
        }
    }
}

__device__ __forceinline__ int wave_sum_i_uniform(int s) {
    s += __builtin_amdgcn_update_dpp(0, s, 0xB1, 0xf, 0xf, false);
    s += __builtin_amdgcn_update_dpp(0, s, 0x4E, 0xf, 0xf, false);
    s += __builtin_amdgcn_update_dpp(0, s, 0x141, 0xf, 0xf, false);
    s += __builtin_amdgcn_update_dpp(0, s, 0x140, 0xf, 0xf, false);
    return __builtin_amdgcn_readlane(s, 0) + __builtin_amdgcn_readlane(s, 16) + __builtin_amdgcn_readlane(s, 32) + __builtin_amdgcn_readlane(s, 48);
}
__constant__ unsigned char kComb[64] = {
    0x00,0x01,0x02,0x03,0x04,0x05,0x06,0x07,0x08,0x09,0x0a,0x0b,0x0c,0x0d,0x0e,0x0f,
    0x10,0x11,0x12,0x13,0x14,0x15,0x16,0x17,
    0x20,0x21,0x22,0x23,0x24,
    0x30,0x31,0x32,0x33,
    0x40,0x41,0x42,
    0x50,0x51,
    0x60,0x61,
    0x70,0x71,
    0x80,0x90,0xa0,0xb0,0xc0,0xd0,0xe0,0xf0,
    0xff,0xff,0xff,0xff,0xff,0xff,0xff,0xff,0xff,0xff,0xff,0xff,0xff,0xff};

template <int CTRL> __device__ __forceinline__ int dpp_i(int v) { return __builtin_amdgcn_update_dpp(0, v, CTRL, 0xf, 0xf, false); }
__device__ __forceinline__ int row_allmax_i(int v) {
    v = max(v, dpp_i<0x128>(v)); v = max(v, dpp_i<0x124>(v)); v = max(v, dpp_i<0x122>(v)); v = max(v, dpp_i<0x121>(v));
    return v;
}
__device__ __forceinline__ float row_allsum_f(float v) {
    v += __int_as_float(dpp_i<0x128>(__float_as_int(v))); v += __int_as_float(dpp_i<0x124>(__float_as_int(v)));
    v += __int_as_float(dpp_i<0x122>(__float_as_int(v))); v += __int_as_float(dpp_i<0x121>(__float_as_int(v)));
    return v;
}
__device__ __forceinline__ int f2key(float f) { const int b = __float_as_int(f); return b ^ ((b >> 31) & 0x7fffffff); }
__device__ __forceinline__ float key2f(int k) { return __int_as_float(k ^ ((k >> 31) & 0x7fffffff)); }
#define KEY_MIN ((int)0x80000000)
#define CE(a, b) { const int hi_ = max(a, b), lo_ = min(a, b); a = hi_; b = lo_; }
__device__ __forceinline__ int top16_rows(int (&k)[8], int l15) {
    CE(k[0], k[1]) CE(k[2], k[3]) CE(k[4], k[5]) CE(k[6], k[7])
    CE(k[0], k[2]) CE(k[1], k[3]) CE(k[4], k[6]) CE(k[5], k[7])
    CE(k[1], k[2]) CE(k[5], k[6])
    CE(k[0], k[4]) CE(k[1], k[5]) CE(k[2], k[6]) CE(k[3], k[7])
    CE(k[2], k[4]) CE(k[3], k[5])
    CE(k[1], k[2]) CE(k[3], k[4]) CE(k[5], k[6])
    int res = KEY_MIN;
#pragma unroll
    for (int r = 0; r < 16; ++r) {
        const int m = row_allmax_i(k[0]);
        const bool own = (k[0] == m);
#pragma unroll
        for (int j = 0; j < 7; ++j) k[j] = own ? k[j + 1] : k[j];
        k[7] = own ? KEY_MIN : k[7];
        res = (l15 == r) ? m : res;
    }
    return res;
}
__device__ __forceinline__ void combine16(int A, int B, const int (&cbv)[4], int lane, int l15, int& eid_out, float& gate_out) {
    const int rowbase = lane & 48;
    int ck[4], eid[4];
#pragma unroll
    for (int c = 0; c < 4; ++c) {
        const int ci = (cbv[c] >> 4) & 15, cj = cbv[c] & 15;
        const int ka = __builtin_amdgcn_ds_bpermute((rowbase + ci) << 2, A);
        const int kb = __builtin_amdgcn_ds_bpermute((rowbase + cj) << 2, B);
        const float sm = key2f(ka & ~127) + key2f(kb & ~127);
        eid[c] = ((127 - (ka & 127)) << 7) | (127 - (kb & 127));
        ck[c] = (cbv[c] != 0xff) ? ((f2key(sm) & ~63) | (63 - (4 * l15 + c))) : KEY_MIN;
    }
    CE(ck[0], ck[1]) CE(ck[2], ck[3]) CE(ck[0], ck[2]) CE(ck[1], ck[3]) CE(ck[1], ck[2])
    int res = KEY_MIN;
#pragma unroll
    for (int r = 0; r < 16; ++r) {
        const int m = row_allmax_i(ck[0]);
        const bool own = (ck[0] == m);
        ck[0] = own ? ck[1] : ck[0]; ck[1] = own ? ck[2] : ck[1]; ck[2] = own ? ck[3] : ck[2]; ck[3] = own ? KEY_MIN : ck[3];
        res = (l15 == r) ? m : res;
    }
    const int slot = 63 - (res & 63);
    const int src = (rowbase + (slot >> 2)) << 2;
    const int e0 = __builtin_amdgcn_ds_bpermute(src, eid[0]), e1 = __builtin_amdgcn_ds_bpermute(src, eid[1]);
    const int e2 = __builtin_amdgcn_ds_bpermute(src, eid[2]), e3 = __builtin_amdgcn_ds_bpermute(src, eid[3]);
    const int sel = slot & 3;
    eid_out = sel == 0 ? e0 : (sel == 1 ? e1 : (sel == 2 ? e2 : e3));
    gate_out = key2f(res & ~63);
}

__device__ __forceinline__ int reduce16_rows(const int (&part)[16], bool b3, bool b2, bool b1, bool b0b) {
    int r8[8], r4[4], r2[2];
#pragma unroll
    for (int k = 0; k < 8; ++k) { const int keep = b3 ? part[8 + k] : part[k], send = b3 ? part[k] : part[8 + k]; r8[k] = keep + __builtin_amdgcn_update_dpp(0, send, 0x140, 0xf, 0xf, false); }
#pragma unroll
    for (int k = 0; k < 4; ++k) { const int keep = b2 ? r8[4 + k] : r8[k], send = b2 ? r8[k] : r8[4 + k]; r4[k] = keep + __builtin_amdgcn_update_dpp(0, send, 0x141, 0xf, 0xf, false); }
#pragma unroll
    for (int k = 0; k < 2; ++k) { const int keep = b1 ? r4[2 + k] : r4[k], send = b1 ? r4[k] : r4[2 + k]; r2[k] = keep + __builtin_amdgcn_update_dpp(0, send, 0x4E, 0xf, 0xf, false); }
    const int keep = b0b ? r2[1] : r2[0], send = b0b ? r2[0] : r2[1];
    int r1 = keep + __builtin_amdgcn_update_dpp(0, send, 0xB1, 0xf, 0xf, false);
    r1 += __shfl_xor(r1, 16); r1 += __shfl_xor(r1, 32);
    return r1;
}
__device__ void phase_hquant(const Params& p, char* lds) {
    const int tid = tid_opaque();
    const int wave = __builtin_amdgcn_readfirstlane((int)((blockIdx.x * blockDim.x + tid) >> 6)), nwaves = (gridDim.x * blockDim.x) >> 6, lane = tid & 63;
    for (int t = wave; t < T_TOK; t += 2 * nwaves) {
        const int t1 = t + nwaves; const bool two = t1 < T_TOK;
        const u32x4* h0 = (const u32x4*)(p.hb + (size_t)t * D_MODEL); const u32x4* h1 = (const u32x4*)(p.hb + (size_t)(two ? t1 : t) * D_MODEL);
        u32x4 r[2][2] = {{h0[2 * lane], h0[2 * lane + 1]}, {h1[2 * lane], h1[2 * lane + 1]}};
#pragma unroll
        for (int q = 0; q < 2; ++q) {
            const u32x4 a = r[q][0], c = r[q][1];
            const float f[16] = {bflo(a.x), bfhi(a.x), bflo(a.y), bfhi(a.y), bflo(a.z), bfhi(a.z), bflo(a.w), bfhi(a.w),
                                 bflo(c.x), bfhi(c.x), bflo(c.y), bfhi(c.y), bflo(c.z), bfhi(c.z), bflo(c.w), bfhi(c.w)};
            float ss = 0.f, am = 0.f;
#pragma unroll
            for (int k = 0; k < 16; ++k) { ss += f[k] * f[k]; am = fmaxf(am, fabsf(f[k])); }
            ss = wave_sum(ss); am = wave_max(am);
            const float inv = am > 0.f ? 127.0f / am : 0.f;
            u32x4 o;
#pragma unroll
            for (int i = 0; i < 4; ++i) {
                unsigned w = 0;
#pragma unroll
                for (int k = 0; k < 4; ++k) w |= (unsigned)((int)rintf(f[4 * i + k] * inv) & 0xff) << (8 * k);
                o[i] = w;
            }
            const int tt = q ? t1 : t;
            if (q == 0 || two) {
                ((u32x4*)(p.hq + (size_t)tt * D_MODEL))[lane] = o;
                if (lane == 0) p.hsc[tt] = am * (1.0f / 127.0f) * rsqrtf(ss * (1.0f / D_MODEL) + EPS);
            }
        }
    }
}

#define TS_WBYTES (16384 + 128)
__device__ void phase_peer_dots(const Params& p, char* lds) {
    const int tidx_ = tid_opaque();
    const int lane = tidx_ & 63, wid = __builtin_amdgcn_readfirstlane((int)(tidx_ >> 6)), l15 = lane & 15;
    const bool b3 = (lane & 8) != 0, b2 = (lane & 4) != 0, b1 = (lane & 2) != 0, b0b = (lane & 1) != 0;
    const int gw = blockIdx.x * (blockDim.x >> 6) + wid, ngw = gridDim.x * (blockDim.x >> 6);
    char* wl = lds + wid * TS_WBYTES;
    unsigned* list = (unsigned*)wl; int* dotsl = (int*)(wl + 4096); char* hql = wl + 8192; int* tks = (int*)(wl + 16384);
    const unsigned lane16 = (unsigned)lane * 16u;
    for (int tb = gw * 8; tb < T_TOK; tb += ngw * 8) {
#pragma unroll
        for (int j = 0; j < 8; ++j) *(u32x4*)(hql + j * 1024 + lane * 16) = ((const u32x4*)(p.hq + (size_t)(tb + j) * D_MODEL))[lane];
        if (lane < 8) tks[lane] = __float_as_int(p.hsc[tb + lane]);
        int idv[8][2];
#pragma unroll
        for (int j = 0; j < 8; ++j) { const int* ir = p.idx + (size_t)(tb + j) * 128; idv[j][0] = ir[lane]; idv[j][1] = ir[64 + lane]; }
#pragma unroll 1
        for (int x = 0; x < 8; ++x) {
            int n = 0;
#pragma unroll
            for (int j = 0; j < 8; ++j)
#pragma unroll
                for (int r = 0; r < 2; ++r) {
                    const int e = idv[j][r];
                    const bool in = (e >> 11) == x;
                    const unsigned long long mk = __ballot(in);
                    const int rank = (int)__builtin_amdgcn_mbcnt_hi((unsigned)(mk >> 32), __builtin_amdgcn_mbcnt_lo((unsigned)mk, 0u));
                    if (in) list[n + rank] = ((unsigned)j << 21) | ((unsigned)(r * 64 + lane) << 14) | (unsigned)e;
                    n += (int)__builtin_popcountll(mk);
                }
            asm volatile("s_waitcnt lgkmcnt(0)" ::: "memory");
            u32x4 ua[16], ubf[16]; int enta = 0, entb = 0;
            auto issue = [&](int b0, u32x4 (&uu)[16], int& entv) {
                const int i = (b0 + l15 < n) ? b0 + l15 : n - 1;
                entv = (int)list[i];
#pragma unroll
                for (int j = 0; j < 16; ++j) { const int e = __builtin_amdgcn_readlane(entv, j) & 0x3fff; uu[j] = *(const u32x4*)(p.u8 + (size_t)e * D_MODEL + lane16); }
            };
            auto reduce = [&](int b0, const u32x4 (&uu)[16], int entv) {
                int part[16];
#pragma unroll
                for (int j = 0; j < 16; ++j) {
                    const int tl = __builtin_amdgcn_readlane(entv, j) >> 21;
                    const u32x4 hqv = *(const u32x4*)(hql + tl * 1024 + lane * 16);
                    int sacc = __builtin_amdgcn_sdot4((int)uu[j].x, (int)hqv.x, 0, false);
                    sacc = __builtin_amdgcn_sdot4((int)uu[j].y, (int)hqv.y, sacc, false);
                    sacc = __builtin_amdgcn_sdot4((int)uu[j].z, (int)hqv.z, sacc, false);
                    part[j] = __builtin_amdgcn_sdot4((int)uu[j].w, (int)hqv.w, sacc, false);
                }
                const int r1 = reduce16_rows(part, b3, b2, b1, b0b);
                if (lane < 16 && b0 + lane < n) dotsl[((unsigned)entv >> 21) * 128 + (((unsigned)entv >> 14) & 127u)] = r1;
            };
            if (n > 0) issue(0, ua, enta);
            for (int b0 = 0; b0 < n; b0 += 32) {
                if (b0 + 16 < n) issue(b0 + 16, ubf, entb);
                reduce(b0, ua, enta);
                if (b0 + 16 < n) {
                    if (b0 + 32 < n) issue(b0 + 32, ua, enta);
                    reduce(b0 + 16, ubf, entb);
                }
            }
            asm volatile("s_waitcnt lgkmcnt(0)" ::: "memory");
        }
#pragma unroll
        for (int j = 0; j < 8; ++j) {
            const float cs_t = __int_as_float(tks[j]), r2_t = cs_t;
            const float* gr = p.gate + (size_t)(tb + j) * 128; float* cr = p.coef + (size_t)(tb + j) * 128;
#pragma unroll
            for (int r = 0; r < 2; ++r) {
                const int e = idv[j][r];
                const float sc = gr[r * 64 + lane] * r2_t;
                const float ex = __expf(sc - key2f(row_allmax_i(f2key(sc))));
                const float gt = ex / row_allsum_f(ex);
                const float2 sc2 = p.suv[e];
                const float dotf = (float)dotsl[j * 128 + r * 64 + lane] * cs_t * sc2.x;
                cr[r * 64 + lane] = gt * gelu_t(dotf) * sc2.y;
            }
        }
        asm volatile("s_waitcnt lgkmcnt(0)" ::: "memory");
    }
}

__device__ void phase_gather(const Params& p, char* lds) {
    const int tidx_ = tid_opaque();
    const int wave = __builtin_amdgcn_readfirstlane((int)((blockIdx.x * blockDim.x + tidx_) >> 6)), nwaves = (gridDim.x * blockDim.x) >> 6, lane = tidx_ & 63;
    const unsigned char* vb = p.v8 + lane * 12;
    const int ntok = (T_TOK - wave + nwaves - 1) / nwaves;
    auto tok = [&](int i) { const int ii = i < ntok ? i : ntok - 1; return wave + ii * nwaves; };
    if (ntok <= 0) return;
    u32x3 v0[8], v1[8], v2[8], v3[8];
    int ic0, ic1, in0, in1, ia0, ia1;
    float coef0, coef1, cn0, cn1;
    { const float* cr = p.coef + (size_t)tok(0) * 128; coef0 = cr[lane]; coef1 = cr[64 + lane]; }
    { const int* ir = p.idx + (size_t)tok(0) * 128; ic0 = ir[lane]; ic1 = ir[64 + lane]; }
    { const int* ir = p.idx + (size_t)tok(1) * 128; in0 = ir[lane]; in1 = ir[64 + lane]; }
    float g16[16];
#pragma unroll
    for (int i4 = 0; i4 < 4; ++i4) { const float4 g = ((const float4*)(p.final_g + lane * 16))[i4]; g16[4 * i4] = g.x; g16[4 * i4 + 1] = g.y; g16[4 * i4 + 2] = g.z; g16[4 * i4 + 3] = g.w; }
#define G2_ISSUE(vv, pbx) do { const int pbx_ = (pbx); const bool nx_ = pbx_ >= 128; const int pm_ = pbx_ & 127; \
        const int src_ = nx_ ? (pm_ < 64 ? in0 : in1) : (pm_ < 64 ? ic0 : ic1); \
        _Pragma("unroll") for (int q = 0; q < 8; ++q) { const int e = __builtin_amdgcn_readlane(src_, (pm_ & 63) + q); vv[q] = *(const u32x3*)(vb + (size_t)e * ROWB); } } while (0)
    __builtin_amdgcn_sched_barrier(0);
    G2_ISSUE(v0, 0); __builtin_amdgcn_sched_barrier(0); G2_ISSUE(v1, 8); __builtin_amdgcn_sched_barrier(0); G2_ISSUE(v2, 16); __builtin_amdgcn_sched_barrier(0);
#pragma unroll 1
    for (int i = 0; i < ntok; ++i) {
        const int t = tok(i);
        { const int* ir = p.idx + (size_t)tok(i + 2) * 128; ia0 = ir[lane]; ia1 = ir[64 + lane]; }
        const u32x4* hr = (const u32x4*)(p.hb + (size_t)t * D_MODEL + lane * 16);
        const u32x4 ha = hr[0], hc = hr[1];
        { const float* cr = p.coef + (size_t)tok(i + 1) * 128; cn0 = cr[lane]; cn1 = cr[64 + lane]; }
        const float cmax = wave_max(fmaxf(fabsf(coef0), fabsf(coef1)));
        const float qs = cmax > 0.f ? 127.0f / cmax : 0.f, cscale = cmax * (1.0f / 127.0f);
        const int cq0 = (int)rintf(coef0 * qs), cq1 = (int)rintf(coef1 * qs);
        const int csum_i = wave_sum_i_uniform(cq0 + cq1);
        unsigned cpk0, cpk1;
        {
            const int bb0 = cq0 & 0xff, bb1 = cq1 & 0xff;
            cpk0 = (unsigned)__builtin_amdgcn_update_dpp(0, bb0, 0x00, 0xf, 0xf, false) | ((unsigned)__builtin_amdgcn_update_dpp(0, bb0, 0x55, 0xf, 0xf, false) << 8)
                 | ((unsigned)__builtin_amdgcn_update_dpp(0, bb0, 0xAA, 0xf, 0xf, false) << 16) | ((unsigned)__builtin_amdgcn_update_dpp(0, bb0, 0xFF, 0xf, 0xf, false) << 24);
            cpk1 = (unsigned)__builtin_amdgcn_update_dpp(0, bb1, 0x00, 0xf, 0xf, false) | ((unsigned)__builtin_amdgcn_update_dpp(0, bb1, 0x55, 0xf, 0xf, false) << 8)
                 | ((unsigned)__builtin_amdgcn_update_dpp(0, bb1, 0xAA, 0xf, 0xf, false) << 16) | ((unsigned)__builtin_amdgcn_update_dpp(0, bb1, 0xFF, 0xf, 0xf, false) << 24);
        }
        int racc[12], jacc[12];
#pragma unroll
        for (int j = 0; j < 12; ++j) { racc[j] = 0; jacc[j] = 0; }
        auto axpy = [&](int pb, const u32x3 (&vv)[8]) __attribute__((always_inline)) {
#pragma unroll
            for (int g4 = 0; g4 < 2; ++g4) {
                const int cqd = __builtin_amdgcn_readlane((int)(pb < 64 ? cpk0 : cpk1), (pb & 63) + 4 * g4);
#pragma unroll
                for (int w = 0; w < 3; ++w) {
                    const unsigned wa = vv[4 * g4 + 0][w], wb = vv[4 * g4 + 1][w], wc = vv[4 * g4 + 2][w], wd = vv[4 * g4 + 3][w];
                    const unsigned p0 = __builtin_amdgcn_perm(wb, wa, 0x05010400u), p1 = __builtin_amdgcn_perm(wb, wa, 0x07030602u);
                    const unsigned q0 = __builtin_amdgcn_perm(wd, wc, 0x05010400u), q1 = __builtin_amdgcn_perm(wd, wc, 0x07030602u);
                    const unsigned t0 = __builtin_amdgcn_perm(q0, p0, 0x05040100u), t1 = __builtin_amdgcn_perm(q0, p0, 0x07060302u);
                    const unsigned t2 = __builtin_amdgcn_perm(q1, p1, 0x05040100u), t3 = __builtin_amdgcn_perm(q1, p1, 0x07060302u);
                    racc[4 * w + 0] = __builtin_amdgcn_sdot4((int)t0, cqd, racc[4 * w + 0], false); jacc[4 * w + 0] = __builtin_amdgcn_sdot4((int)(t0 & 0xc0c0c0c0u), cqd, jacc[4 * w + 0], false);
                    racc[4 * w + 1] = __builtin_amdgcn_sdot4((int)t1, cqd, racc[4 * w + 1], false); jacc[4 * w + 1] = __builtin_amdgcn_sdot4((int)(t1 & 0xc0c0c0c0u), cqd, jacc[4 * w + 1], false);
                    racc[4 * w + 2] = __builtin_amdgcn_sdot4((int)t2, cqd, racc[4 * w + 2], false); jacc[4 * w + 2] = __builtin_amdgcn_sdot4((int)(t2 & 0xc0c0c0c0u), cqd, jacc[4 * w + 2], false);
                    racc[4 * w + 3] = __builtin_amdgcn_sdot4((int)t3, cqd, racc[4 * w + 3], false); jacc[4 * w + 3] = __builtin_amdgcn_sdot4((int)(t3 & 0xc0c0c0c0u), cqd, jacc[4 * w + 3], false);
                }
            }
        };
#pragma unroll 1
        for (int pb = 0; pb < 128; pb += 32) {
            G2_ISSUE(v3, pb + 24); __builtin_amdgcn_sched_barrier(0); axpy(pb, v0); __builtin_amdgcn_sched_barrier(0);
            G2_ISSUE(v0, pb + 32); __builtin_amdgcn_sched_barrier(0); axpy(pb + 8, v1); __builtin_amdgcn_sched_barrier(0);
            G2_ISSUE(v1, pb + 40); __builtin_amdgcn_sched_barrier(0); axpy(pb + 16, v2); __builtin_amdgcn_sched_barrier(0);
            G2_ISSUE(v2, pb + 48); __builtin_amdgcn_sched_barrier(0); axpy(pb + 24, v3); __builtin_amdgcn_sched_barrier(0);
        }
        ic0 = in0; ic1 = in1; in0 = ia0; in1 = ia1;
        coef0 = cn0; coef1 = cn1;
        int acc[16];
#pragma unroll
        for (int j = 0; j < 12; ++j) acc[j] = (racc[j] - jacc[j]) - 32 * csum_i;
#pragma unroll
        for (int k = 0; k < 4; ++k) acc[12 + k] = ((jacc[k] + 4 * jacc[4 + k] + 16 * jacc[8 + k]) >> 6) + 10 * csum_i;
        const float hf16[16] = {bflo(ha.x), bfhi(ha.x), bflo(ha.y), bfhi(ha.y), bflo(ha.z), bfhi(ha.z), bflo(ha.w), bfhi(ha.w),
                                bflo(hc.x), bfhi(hc.x), bflo(hc.y), bfhi(hc.y), bflo(hc.z), bfhi(hc.z), bflo(hc.w), bfhi(hc.w)};
        float res[16];
        float ss = 0.f;
#pragma unroll
        for (int j = 0; j < 16; ++j) { res[j] = hf16[j] + cscale * (float)acc[j]; ss += res[j] * res[j]; }
        ss = wave_sum(ss);
        const float r3 = rsqrtf(ss * (1.0f / D_MODEL) + EPS);
        float* o = p.out + (size_t)t * D_MODEL + lane * 16;
#pragma unroll
        for (int i4 = 0; i4 < 4; ++i4) {
            float4 ov; ov.x = res[4 * i4] * r3 * g16[4 * i4]; ov.y = res[4 * i4 + 1] * r3 * g16[4 * i4 + 1]; ov.z = res[4 * i4 + 2] * r3 * g16[4 * i4 + 2]; ov.w = res[4 * i4 + 3] * r3 * g16[4 * i4 + 3];
            ((float4*)o)[i4] = ov;
        }
    }
#undef G2_ISSUE
}

namespace pg8 {
#define PG8_LAS __attribute__((address_space(3)))
constexpr int BM = 256, BK = 64, HALF = 128, HTB = HALF * BK * 2, STAGE_BYTES = 8 * HTB, NXCD = 8, WGM = 8;
__host__ __device__ __forceinline__ int lds_byte(int r, int c) { const int st = (r >> 4) * 2 + (c >> 5), rr = r & 15, cc = c & 31, ob = rr * 64 + cc * 2; return st * 1024 + (ob ^ (((ob >> 9) & 1) << 5)); }
__host__ __device__ __forceinline__ void stage_rc(int b, int& R, int& C) { const int st = b / 1024, sb = b % 1024, swz = sb ^ (((sb >> 9) & 1) << 5); R = (st >> 1) * 16 + swz / 64; C = (st & 1) * 32 + (swz % 64) / 2; }
__host__ __device__ __forceinline__ int perm32(int rho) { const int n = rho >> 4, i = rho & 15; return 8 * (i >> 2) + 4 * n + (i & 3); }
struct Unit { int pm, pn; };
struct Gemm { const bf16_t* A; const bf16_t* Bt; int M, N, K; };
struct StaticOrder {
    int nM, nN, nwg, G, c;
    __host__ __device__ void init(int M, int N, int G_, int c_) { nM = M / BM; nN = N / BM; nwg = nM * nN; G = G_; c = c_; }
    __host__ __device__ bool next(int i, Unit& u) const {
        const long L = (long)i * G + c; if (L >= nwg) return false;
        int wgid = (int)L; { const int q = nwg / NXCD, r = nwg % NXCD, xcd = wgid % NXCD, off = wgid / NXCD; wgid = (xcd < r ? xcd * (q + 1) : r * (q + 1) + (xcd - r) * q) + off; }
        const int nig = WGM * nN, gid = wgid / nig, fm = gid * WGM, gsz = (nM - fm) < WGM ? (nM - fm) : WGM;
        u.pm = fm + ((wgid % nig) % gsz); u.pn = (wgid % nig) / gsz; return true;
    }
    __device__ __forceinline__ void a_ready(const Unit&) const {}
    __device__ __forceinline__ void done(const Unit&) const {}
};
__device__ __forceinline__ unsigned cvt_pk_bf16(float lo, float hi) { unsigned r; asm volatile("v_cvt_pk_bf16_f32 %0, %1, %2" : "=v"(r) : "v"(lo), "v"(hi)); return r; }
template <bool I8> __device__ __forceinline__ typename std::conditional<I8, i32x4, f32x4>::type mma1(bf16x8 a, bf16x8 b, typename std::conditional<I8, i32x4, f32x4>::type c) {
    if constexpr (I8) return __builtin_amdgcn_mfma_i32_16x16x64_i8(*(const i32x4*)&a, *(const i32x4*)&b, c, 0, 0, 0);
    else return __builtin_amdgcn_mfma_f32_16x16x32_bf16(a, b, c, 0, 0, 0);
}
struct EpiZ8 {
    static constexpr bool PERM = true, AFTER_DRAIN = false, I8 = true; typedef i32x4 acc_t;
    bf16_t* O; const float* rsx; const unsigned* swb;
    __device__ __forceinline__ void operator()(const i32x4 (&acc)[2][2][4][2], const Unit& u, int wr, int wc, int fr, int fq) const {
        const int row0 = u.pm * BM + wr * 64 + fr, col0 = u.pn * BM + wc * 32 + 8 * fq; const bool act = u.pn >= 2;
        float sw[2][8];
#pragma unroll
        for (int bj = 0; bj < 2; ++bj) { const u32x4 a = *(const u32x4*)(swb + col0 + bj * HALF), c = *(const u32x4*)(swb + col0 + bj * HALF + 4);
#pragma unroll
            for (int i = 0; i < 4; ++i) { sw[bj][i] = __uint_as_float(a[i]) * (1.0f / 127.0f); sw[bj][4 + i] = __uint_as_float(c[i]) * (1.0f / 127.0f); } }
#pragma unroll
        for (int ai = 0; ai < 2; ++ai)
#pragma unroll
            for (int m = 0; m < 4; ++m) { const int r = row0 + ai * HALF + m * 16; const float sc = rsx[r]; bf16_t* rowp = O + (size_t)r * D_IN + col0;
#pragma unroll
                for (int bj = 0; bj < 2; ++bj) { f32x4 v0, v1;
#pragma unroll
                    for (int i = 0; i < 4; ++i) { v0[i] = (float)acc[ai][bj][m][0][i] * sc * sw[bj][i]; v1[i] = (float)acc[ai][bj][m][1][i] * sc * sw[bj][4 + i]; }
                    if (act) { v0 = (f32x4){gelu_t(v0[0]), gelu_t(v0[1]), gelu_t(v0[2]), gelu_t(v0[3])}; v1 = (f32x4){gelu_t(v1[0]), gelu_t(v1[1]), gelu_t(v1[2]), gelu_t(v1[3])}; }
                    u32x4 w; w.x = cvt_pk_bf16(v0[0], v0[1]); w.y = cvt_pk_bf16(v0[2], v0[3]); w.z = cvt_pk_bf16(v1[0], v1[1]); w.w = cvt_pk_bf16(v1[2], v1[3]);
                    *(u32x4*)(rowp + bj * HALF) = w; } }
    }
};
struct EpiOut {
    static constexpr bool PERM = true, AFTER_DRAIN = false, I8 = false; typedef f32x4 acc_t;
    bf16_t* O; const signed char* X; const float* sx;
    __device__ __forceinline__ void operator()(const f32x4 (&acc)[2][2][4][2], const Unit& u, int wr, int wc, int fr, int fq) const {
        const int row0 = u.pm * BM + wr * 64 + fr, col0 = u.pn * BM + wc * 32 + 8 * fq;
#pragma unroll
        for (int ai = 0; ai < 2; ++ai)
#pragma unroll
            for (int m = 0; m < 4; ++m) { const int r = row0 + ai * HALF + m * 16; const size_t off = (size_t)r * D_MODEL + col0; const float sc = sx[r];
#pragma unroll
                for (int bj = 0; bj < 2; ++bj) { const u32x2 xx = *(const u32x2*)(X + off + bj * HALF);
                    f32x4 x0, x1;
#pragma unroll
                    for (int i = 0; i < 4; ++i) { x0[i] = (float)(signed char)(xx.x >> (8 * i)) * sc; x1[i] = (float)(signed char)(xx.y >> (8 * i)) * sc; }
                    const f32x4 v0 = acc[ai][bj][m][0] + x0, v1 = acc[ai][bj][m][1] + x1;
                    u32x4 w; w.x = cvt_pk_bf16(v0[0], v0[1]); w.y = cvt_pk_bf16(v0[2], v0[3]); w.z = cvt_pk_bf16(v1[0], v1[1]); w.w = cvt_pk_bf16(v1[2], v1[3]);
                    *(u32x4*)(O + off + bj * HALF) = w; } }
    }
};
struct OneUnit {
    Unit u;
    __device__ __forceinline__ bool next(int i, Unit& o) const { if (i) return false; o = u; return true; }
    __device__ __forceinline__ void a_ready(const Unit&) const {}
    __device__ __forceinline__ void done(const Unit&) const {}
};
#define QT_PITCH 272
#define QT_LDS_BYTES (2 * 256 * QT_PITCH)
struct EpiQTopk {
    static constexpr bool PERM = true, AFTER_DRAIN = true, I8 = true; typedef i32x4 acc_t;
    const bf16_t* keysB; int* idx; float* gate; const unsigned* swq;
    const Params* pp_;
    __device__ __forceinline__ void fused(i32x4 (&acc)[2][2][4][2], const Unit& u, int wr, int wc, int fr, int fq, PG8_LAS unsigned char* ldsp, int wid, int lane) const {
        char* sQ = (char*)ldsp;
        const int h = u.pn;
        float sw[2][8];
#pragma unroll
        for (int bj = 0; bj < 2; ++bj) { const u32x4 a = *(const u32x4*)(swq + u.pn * BM + bj * HALF + wc * 32 + 8 * fq), c = *(const u32x4*)(swq + u.pn * BM + bj * HALF + wc * 32 + 8 * fq + 4);
#pragma unroll
            for (int i = 0; i < 4; ++i) { sw[bj][i] = __uint_as_float(a[i]) * (1.0f / 127.0f); sw[bj][4 + i] = __uint_as_float(c[i]) * (1.0f / 127.0f); } }
#pragma unroll
        for (int ai = 0; ai < 2; ++ai)
#pragma unroll
            for (int m = 0; m < 4; ++m) { const int r = ai * HALF + wr * 64 + m * 16 + fr;
#pragma unroll
                for (int bj = 0; bj < 2; ++bj) { f32x4 v0, v1;
#pragma unroll
                    for (int i = 0; i < 4; ++i) { v0[i] = (float)acc[ai][bj][m][0][i] * sw[bj][i]; v1[i] = (float)acc[ai][bj][m][1][i] * sw[bj][4 + i]; }
                    u32x4 w; w.x = cvt_pk_bf16(v0[0], v0[1]); w.y = cvt_pk_bf16(v0[2], v0[3]); w.z = cvt_pk_bf16(v1[0], v1[1]); w.w = cvt_pk_bf16(v1[2], v1[3]);
                    *(u32x4*)(sQ + bj * (256 * QT_PITCH) + r * QT_PITCH + (wc * 32 + fq * 8) * 2) = w; } }
        __syncthreads();
        int cbv[4];
#pragma unroll
        for (int c = 0; c < 4; ++c) cbv[c] = kComb[4 * fr + c];
        int tA[2][4], tB[2][4];
#pragma unroll
        for (int m = 0; m < 2; ++m)
#pragma unroll
            for (int j = 0; j < 4; ++j) { tA[m][j] = 0; tB[m][j] = 0; }
        static_assert((T_TOK / 256) * 8 * 8 * 2 == NEXP, "units x waves x 2 must cover the expert table");
        const int qe0 = ((u.pm * 8 + u.pn) * 8 + wid) * 2;
        float4 qa4[2][4], qb4[2][4];
#pragma unroll 1
        for (int pp = 0; pp < 2; ++pp) {
            const bf16_t* kb = keysB + (size_t)(pp * 8 + h) * 16384 + lane * 8;
            const char* qa = sQ + pp * (256 * QT_PITCH) + (wid * 32 + fr) * QT_PITCH + fq * 16;
            f32x4 sc2[2][8];
#pragma unroll
            for (int m = 0; m < 2; ++m)
#pragma unroll
                for (int nb = 0; nb < 8; ++nb) sc2[m][nb] = (f32x4){0.f, 0.f, 0.f, 0.f};
#pragma unroll
            for (int kk = 0; kk < 4; ++kk) {
                bf16x8 kf[8], af[2];
#pragma unroll
                for (int nb = 0; nb < 8; ++nb) kf[nb] = *(const bf16x8*)(kb + (kk * 8 + nb) * 512);
#pragma unroll
                for (int m = 0; m < 2; ++m) af[m] = *(const bf16x8*)(qa + m * 16 * QT_PITCH + kk * 64);
#pragma unroll
                for (int m = 0; m < 2; ++m)
#pragma unroll
                    for (int nb = 0; nb < 8; ++nb) sc2[m][nb] = __builtin_amdgcn_mfma_f32_16x16x32_bf16(af[m], kf[nb], sc2[m][nb], 0, 0, 0);
            }
#pragma unroll
            for (int m = 0; m < 2; ++m)
#pragma unroll
                for (int j = 0; j < 4; ++j) tA[m][j] = tB[m][j];
            if (pp == 1) {
#pragma unroll
                for (int x = 0; x < 2; ++x) {
                    const float4* su4 = (const float4*)(pp_->peer_u + (size_t)(qe0 + x) * D_MODEL + lane * 16);
                    const float4* sv4 = (const float4*)(pp_->peer_v + (size_t)(qe0 + x) * D_MODEL + lane * 16);
#pragma unroll
                    for (int i = 0; i < 4; ++i) { qa4[x][i] = su4[i]; qb4[x][i] = sv4[i]; }
                }
            }
#pragma unroll 2
            for (int it = 0; it < 4; ++it) {
#pragma unroll
                for (int m = 0; m < 2; ++m) {
                    int k[8];
#pragma unroll
                    for (int nb = 0; nb < 8; ++nb) k[nb] = (f2key(sc2[m][nb][0]) & ~127) | (127 - (16 * nb + fr));
                    const int r = top16_rows(k, fr);
                    tB[m][0] = tB[m][1]; tB[m][1] = tB[m][2]; tB[m][2] = tB[m][3]; tB[m][3] = r;
#pragma unroll
                    for (int nb = 0; nb < 8; ++nb) sc2[m][nb] = (f32x4){sc2[m][nb][1], sc2[m][nb][2], sc2[m][nb][3], sc2[m][nb][0]};
                }
            }
        }
#pragma unroll 2
        for (int it = 0; it < 4; ++it) {
#pragma unroll
            for (int m = 0; m < 2; ++m) {
                int eid; float gt;
                combine16(tA[m][0], tB[m][0], cbv, lane, fr, eid, gt);
                const int t = u.pm * BM + wid * 32 + m * 16 + fq * 4 + it;
                const size_t o = (size_t)t * 128 + h * 16 + fr;
                idx[o] = eid; gate[o] = gt;
                tA[m][0] = tA[m][1]; tA[m][1] = tA[m][2]; tA[m][2] = tA[m][3];
                tB[m][0] = tB[m][1]; tB[m][1] = tB[m][2]; tB[m][2] = tB[m][3];
            }
        }
        quant_expert(*pp_, qe0, lane, qa4[0], qb4[0]);
        quant_expert(*pp_, qe0 + 1, lane, qa4[1], qb4[1]);
        __syncthreads();
    }
};
template <class Epi, class Sched>
__device__ __forceinline__ void gemm_phase(PG8_LAS unsigned char* lds, const Gemm g, const Sched& S, const Epi& E) {
    const int tid = tid_opaque(), wid = __builtin_amdgcn_readfirstlane(tid >> 6), lane = tid & 63, wr = wid >> 2, wc = wid & 3, fr = lane & 15, fq = lane >> 4;
    const int K = g.K, nt = K / BK;
    unsigned voffA[2], voffB[2];
#pragma unroll
    for (int i = 0; i < 2; ++i) { int R, C; stage_rc(tid * 16 + i * 8192, R, C); const int Rb = Epi::PERM ? ((R & ~31) + perm32(R & 31)) : R;
        voffA[i] = (unsigned)(R * K + C) * 2u; voffB[i] = (unsigned)(Rb * K + C) * 2u; }
    const size_t kstep = (size_t)(BK * 2);
    const size_t hstep = (size_t)HALF * K * 2;
    const size_t tstep = 2 * hstep;
    const unsigned ldsw = (unsigned)wid * 1024u;
    const int aoff = lds_byte(wr * 64 + fr, fq * 8), boff = lds_byte(wc * 32 + fr, fq * 8);
#define PG8_SA(b, h) (((b) * 2 + (h)) * HTB)
#define PG8_SB(b, h) ((4 + (b) * 2 + (h)) * HTB)
#define PG8_STAGE(bufoff, gbase, voff) do { _Pragma("unroll") for (int _i = 0; _i < 2; ++_i) \
        __builtin_amdgcn_global_load_lds((const unsigned*)((const char*)(gbase) + (voff)[_i]), (PG8_LAS unsigned*)(lds + (bufoff) + ldsw + _i * 8192), 16, 0, 0); } while (0)
#define PG8_LDA(dst, b, h) do { _Pragma("unroll") for (int m = 0; m < 4; ++m) _Pragma("unroll") for (int k = 0; k < 2; ++k) dst[m][k] = *(const PG8_LAS bf16x8*)(lds + PG8_SA(b, h) + aoff + m * 2048 + k * 1024); } while (0)
#define PG8_LDB(dst, b, h) do { _Pragma("unroll") for (int n = 0; n < 2; ++n) _Pragma("unroll") for (int k = 0; k < 2; ++k) dst[n][k] = *(const PG8_LAS bf16x8*)(lds + PG8_SB(b, h) + boff + n * 2048 + k * 1024); } while (0)
#define PG8_MMA(ai, bj, At, Bt) do { __builtin_amdgcn_s_setprio(1); _Pragma("unroll") for (int m = 0; m < 4; ++m) _Pragma("unroll") for (int n = 0; n < 2; ++n) _Pragma("unroll") for (int k = 0; k < 2; ++k) \
        acc[ai][bj][m][n] = mma1<Epi::I8>(Bt[n][k], At[m][k], acc[ai][bj][m][n]); __builtin_amdgcn_s_setprio(0); } while (0)
#define PG8_WAIT_V(n) asm volatile("s_waitcnt vmcnt(" #n ")" ::: "memory")
#define PG8_WAIT_L(n) asm volatile("s_waitcnt lgkmcnt(" #n ")" ::: "memory")
#define PG8_BAR __builtin_amdgcn_s_barrier()
#define PG8_SCHED __builtin_amdgcn_sched_barrier(0)
    Unit cur, nxt; int ui = 0;
    if (!S.next(0, cur)) return;
    typedef typename Epi::acc_t acc_t;
    acc_t acc[2][2][4][2];
#pragma unroll
    for (int a = 0; a < 2; ++a)
#pragma unroll
        for (int b = 0; b < 2; ++b)
#pragma unroll
            for (int m = 0; m < 4; ++m)
#pragma unroll
                for (int n = 0; n < 2; ++n) acc[a][b][m][n] = (acc_t)(0);
    bf16x8 At[4][2], B0[2][2], B1[2][2];
    const char* cA = (const char*)g.A + (size_t)cur.pm * tstep; const char* cB = (const char*)g.Bt + (size_t)cur.pn * tstep;
    S.a_ready(cur);
    PG8_STAGE(PG8_SB(0, 0), cB, voffB); PG8_STAGE(PG8_SA(0, 0), cA, voffA); PG8_STAGE(PG8_SB(0, 1), cB + hstep, voffB); PG8_STAGE(PG8_SA(0, 1), cA + hstep, voffA);
    if (wr == 1) PG8_BAR;
    PG8_WAIT_V(4); PG8_BAR;
    PG8_STAGE(PG8_SB(1, 0), cB + kstep, voffB); PG8_STAGE(PG8_SA(1, 0), cA + kstep, voffA); PG8_STAGE(PG8_SB(1, 1), cB + hstep + kstep, voffB);
    PG8_WAIT_V(6); PG8_BAR;
    for (;;) {
        const bool has_next = S.next(ui + 1, nxt);
        const char* nA = has_next ? (const char*)g.A + (size_t)nxt.pm * tstep : cA; const char* nB = has_next ? (const char*)g.Bt + (size_t)nxt.pn * tstep : cB;
        for (int t = 0; t < nt; t += 2) {
            const bool last = (t == nt - 2);
            const char* a1 = cA + (size_t)(t + 1) * kstep;
            const char* a2 = last ? nA : cA + (size_t)(t + 2) * kstep; const char* b2 = last ? nB : cB + (size_t)(t + 2) * kstep;
            const char* a3 = a2 + kstep; const char* b3 = b2 + kstep;
            if (last && has_next) S.a_ready(nxt);
            PG8_LDB(B0, 0, 0); PG8_SCHED; PG8_LDA(At, 0, 0); PG8_STAGE(PG8_SA(1, 1), a1 + hstep, voffA);
            PG8_WAIT_L(8); PG8_BAR; PG8_WAIT_L(0); PG8_MMA(0, 0, At, B0); PG8_BAR; PG8_SCHED;
            PG8_LDB(B1, 0, 1); PG8_STAGE(PG8_SB(0, 0), b2, voffB);
            PG8_BAR; PG8_WAIT_L(0); PG8_MMA(0, 1, At, B1); PG8_BAR;
            PG8_LDA(At, 0, 1); PG8_STAGE(PG8_SA(0, 0), a2, voffA);
            PG8_BAR; PG8_WAIT_L(0); PG8_MMA(1, 0, At, B0); PG8_BAR; PG8_SCHED;
            PG8_STAGE(PG8_SB(0, 1), b2 + hstep, voffB);
            PG8_WAIT_V(6); PG8_BAR; PG8_MMA(1, 1, At, B1); PG8_BAR;
            PG8_LDB(B0, 1, 0); PG8_SCHED; PG8_LDA(At, 1, 0); PG8_STAGE(PG8_SA(0, 1), a2 + hstep, voffA);
            PG8_WAIT_L(8); PG8_BAR; PG8_WAIT_L(0); PG8_MMA(0, 0, At, B0); PG8_BAR; PG8_SCHED;
            PG8_LDB(B1, 1, 1); PG8_STAGE(PG8_SB(1, 0), b3, voffB);
            PG8_BAR; PG8_WAIT_L(0); PG8_MMA(0, 1, At, B1); PG8_BAR;
            PG8_LDA(At, 1, 1); PG8_STAGE(PG8_SA(1, 0), a3, voffA);
            PG8_BAR; PG8_WAIT_L(0); PG8_MMA(1, 0, At, B0); PG8_BAR; PG8_SCHED;
            PG8_STAGE(PG8_SB(1, 1), b3 + hstep, voffB);
            PG8_WAIT_V(6); PG8_BAR; PG8_MMA(1, 1, At, B1); PG8_BAR;
        }
            if constexpr (!Epi::AFTER_DRAIN) { E(acc, cur, wr, wc, fr, fq); S.done(cur); }
            if (!has_next) break;
#pragma unroll
        for (int a = 0; a < 2; ++a)
#pragma unroll
            for (int b = 0; b < 2; ++b)
#pragma unroll
                for (int m = 0; m < 4; ++m)
#pragma unroll
                    for (int n = 0; n < 2; ++n) acc[a][b][m][n] = (acc_t)(0);
        cur = nxt; cA = nA; cB = nB; ++ui;
    }
    PG8_WAIT_V(0);
    if (wr == 0) PG8_BAR;
    PG8_BAR;
    if constexpr (Epi::AFTER_DRAIN) { E.fused(acc, cur, wr, wc, fr, fq, lds, wid, lane); S.done(cur); }
#undef PG8_SA
#undef PG8_SB
#undef PG8_STAGE
#undef PG8_LDA
#undef PG8_LDB
#undef PG8_MMA
#undef PG8_WAIT_V
#undef PG8_WAIT_L
#undef PG8_BAR
#undef PG8_SCHED
}
}

__device__ void phase_gemm_z(const Params& p, char* lds) {
    pg8::StaticOrder S; S.init(T_TOK, D_IN, gridDim.x, blockIdx.x);
    pg8::gemm_phase<pg8::EpiZ8, pg8::StaticOrder>((PG8_LAS unsigned char*)lds, pg8::Gemm{(const bf16_t*)p.xq, (const bf16_t*)p.winT8, T_TOK, D_IN, D_MODEL / 2}, S, pg8::EpiZ8{p.zb, p.rstd1, p.swb});
}
__device__ void phase_gemm_out(const Params& p, char* lds) {
    pg8::StaticOrder S; S.init(T_TOK, D_MODEL, gridDim.x, blockIdx.x);
    pg8::gemm_phase<pg8::EpiOut, pg8::StaticOrder>((PG8_LAS unsigned char*)lds, pg8::Gemm{p.cB, p.woutT, T_TOK, D_MODEL, D_MODEL}, S, pg8::EpiOut{p.hb, p.xq, p.sx});
}
__device__ void phase_gemm_q(const Params& p, char* lds) {
    pg8::StaticOrder S; S.init(T_TOK, 2048, gridDim.x, blockIdx.x);
    pg8::Unit u;
    for (int i = 0; S.next(i, u); ++i)
        pg8::gemm_phase<pg8::EpiQTopk, pg8::OneUnit>((PG8_LAS unsigned char*)lds, pg8::Gemm{(const bf16_t*)p.hq, (const bf16_t*)p.wqT8, T_TOK, 2048, D_MODEL / 2}, pg8::OneUnit{u}, pg8::EpiQTopk{p.keysB, p.idx, p.gate, p.swq, &p});
}

#define XB_TMO      128
#define XB_XCNT(j)  (256  + 64 * (j))
#define XB_XSUB(j)  (1280 + 64 * (j))
#define XB_XGEN(j)  (2304 + 64 * (j))
#define XB_TOP      3328
#define XB_TOPGEN   3392
#define XCD_BAR_WORDS 3456
#define XB_SPIN_CAP (1u << 20)
__device__ __forceinline__ unsigned xb_ld(unsigned* p)              { return __hip_atomic_load(p, __ATOMIC_RELAXED, __HIP_MEMORY_SCOPE_AGENT); }
__device__ __forceinline__ unsigned xb_add(unsigned* p, unsigned v) { return __hip_atomic_fetch_add(p, v, __ATOMIC_RELAXED, __HIP_MEMORY_SCOPE_AGENT); }
__device__ __forceinline__ unsigned xb_xcc_id() { return (unsigned)__builtin_amdgcn_s_getreg((3 << 11) | 20) & 0xFu; }
#define XB_SPIN(cond, bar) do { unsigned _sp = 0; while (cond) { __builtin_amdgcn_s_sleep(1); \
    if ((++_sp & 255u) == 0u) { if (xb_ld(&(bar)[XB_TMO])) break; if (_sp > XB_SPIN_CAP) { atomicAdd(&(bar)[XB_TMO], 1u); break; } } } } while (0)
struct XcdBarrier { unsigned* bar; unsigned x; volatile LAS unsigned* st; };
__device__ __forceinline__ XcdBarrier xcd_barrier_post(unsigned* bar, volatile LAS unsigned* st) {
    XcdBarrier b; b.bar = bar; b.x = xb_xcc_id(); b.st = st;
    if (threadIdx.x == 0) (void)xb_add(&bar[XB_XCNT(b.x)], 1u);
    return b;
}
__device__ __forceinline__ void xcd_barrier_complete(unsigned* bar, unsigned x, unsigned& nloc, unsigned& nx) {
    const unsigned G = gridDim.x * gridDim.y * gridDim.z;
    unsigned sum, cnt, mine, sp = 0u;
    for (;;) {
        sum = 0u; cnt = 0u; mine = 0u;
#pragma unroll
        for (unsigned j = 0; j < 16; ++j) { const unsigned c = xb_ld(&bar[XB_XCNT(j)]); sum += c; cnt += (c > 0u) ? 1u : 0u; mine = (j == x) ? c : mine; }
        if (sum == G) break;
        __builtin_amdgcn_s_sleep(1);
        if ((++sp & 255u) == 0u) { if (xb_ld(&bar[XB_TMO])) break; if (sp > XB_SPIN_CAP) { atomicAdd(&bar[XB_TMO], 1u); break; } }
    }
    nloc = mine > 0u ? mine : 1u; nx = cnt > 0u ? cnt : 1u;
}
__device__ __forceinline__ void xcd_barrier(const XcdBarrier& b) {
    asm volatile("s_waitcnt vmcnt(0)" ::: "memory");
    __syncthreads();
    if (threadIdx.x == 0) {
        unsigned* bar = b.bar;
        __builtin_amdgcn_s_waitcnt(0);
        unsigned nloc = b.st[0], nx = b.st[1];
        if (nloc == 0u) { xcd_barrier_complete(bar, b.x, nloc, nx); b.st[0] = nloc; b.st[1] = nx; }
        const unsigned old = xb_add(&bar[XB_XSUB(b.x)], 1u);
        const unsigned gen = old / nloc;
        if (old + 1u == (gen + 1u) * nloc) {
            __builtin_amdgcn_fence(__ATOMIC_RELEASE, "agent");
            asm volatile("s_waitcnt vmcnt(0)" ::: "memory");
            const unsigned og = xb_add(&bar[XB_TOP], 1u);
            const unsigned tg = og / nx;
            if (og + 1u == (tg + 1u) * nx) xb_add(&bar[XB_TOPGEN], 1u);
            else XB_SPIN(xb_ld(&bar[XB_TOPGEN]) == tg, bar);
            __builtin_amdgcn_fence(__ATOMIC_ACQUIRE, "agent");
            xb_add(&bar[XB_XGEN(b.x)], 1u);
            asm volatile("s_waitcnt vmcnt(0)" ::: "memory");
        } else {
            XB_SPIN(xb_ld(&bar[XB_XGEN(b.x)]) == gen, bar);
            __builtin_amdgcn_fence(__ATOMIC_ACQUIRE, "agent");
            asm volatile("s_waitcnt vmcnt(0)" ::: "memory");
        }
    }
    __syncthreads();
}

#define MEGA_LDS_MAX2(a, b) ((a) > (b) ? (a) : (b))
#define MEGA_LDS_MAIN MEGA_LDS_MAX2(MEGA_LDS_MAX2(QT_LDS_BYTES, pg8::STAGE_BYTES), MEGA_LDS_MAX2(8 * TS_WBYTES, 2 * MIXH_LDS))
#define MEGA_LDS_BYTES (MEGA_LDS_MAIN + 16)
extern __shared__ __attribute__((aligned(16))) char smem[];
__global__ void __launch_bounds__(512, 2) fwd_mega(Params p) {
    volatile LAS unsigned* st = (volatile LAS unsigned*)(smem + MEGA_LDS_MAIN);
    if (threadIdx.x < 4) st[threadIdx.x] = 0u;
    __syncthreads();
    const XcdBarrier xb = xcd_barrier_post(p.bar, st);
    phase_prep(p, smem);      xcd_barrier(xb);
    phase_gemm_z(p, smem);    xcd_barrier(xb);
    phase_mix_gemm(p, smem);  xcd_barrier(xb);
    phase_gemm_out(p, smem);  xcd_barrier(xb);
    phase_hquant(p, smem);    xcd_barrier(xb);
    phase_gemm_q(p, smem);    xcd_barrier(xb);
    phase_peer_dots(p, smem); xcd_barrier(xb);
    phase_gather(p, smem);
}

extern "C" void kernel_launch(void* const* d_in, const int* in_sizes, int n_in, void* d_out, int out_size, void* d_ws, size_t ws_size, hipStream_t stream) {
    static int grid_blocks = 0;
    if (grid_blocks == 0) {
        int dev = 0, cus = 0, per_cu = 0;
        (void)hipGetDevice(&dev);
        (void)hipDeviceGetAttribute(&cus, hipDeviceAttributeMultiprocessorCount, dev);
        (void)hipFuncSetAttribute((const void*)fwd_mega, hipFuncAttributeMaxDynamicSharedMemorySize, MEGA_LDS_BYTES);
        (void)hipOccupancyMaxActiveBlocksPerMultiprocessor(&per_cu, (const void*)fwd_mega, 512, MEGA_LDS_BYTES);
        if (per_cu > 1) per_cu = 1;
        if (per_cu < 1) per_cu = 1;
        grid_blocks = cus * per_cu;
    }
    Params p{};
    p.x = (const float*)d_in[0]; p.norm1_g = (const float*)d_in[1]; p.w_in = (const float*)d_in[2]; p.pool_w = (const float*)d_in[3];
    p.pool_scale = (const float*)d_in[4]; p.sgu_norm_g = (const float*)d_in[5]; p.sgu_w = (const float*)d_in[6]; p.sgu_b = (const float*)d_in[7];
    p.w_out = (const float*)d_in[8]; p.norm2_g = (const float*)d_in[9]; p.peer_wq = (const float*)d_in[10]; p.peer_keys = (const float*)d_in[11];
    p.peer_u = (const float*)d_in[12]; p.peer_v = (const float*)d_in[13]; p.final_g = (const float*)d_in[14];
    p.out = (float*)d_out;
    char* w = (char*)d_ws; size_t off = 0;
    auto take = [&](size_t bytes) { char* r = w + off; off += (bytes + 255) & ~(size_t)255; return r; };
    const size_t MiB = 1024 * 1024;
    p.u8 = (unsigned char*)take(16 * MiB); p.v8 = (unsigned char*)take(12 * MiB);
    p.suv = (float2*)take(128 * 1024);
    p.woutT = (bf16_t*)take(2 * MiB);
    p.poolT = (bf16_t*)take(128 * 1024); p.wsM = (bf16_t*)take(128 * 1024); p.keysB = (bf16_t*)take(512 * 1024);
    p.bar = (unsigned*)take(XCD_BAR_WORDS * 4 + 4608 * 4); p.swb = p.bar + XCD_BAR_WORDS; p.swq = p.swb + 2048;
    p.rstd1 = (float*)take(128 * 1024); p.sx = (float*)take(128 * 1024); p.xq = (signed char*)take(32 * MiB); p.winT8 = (signed char*)take(1536 * 1024); p.wqT8 = (signed char*)take(2048 * 1024); p.hq = (signed char*)take(32 * MiB); p.hsc = (float*)take(128 * 1024);
    p.idx = (int*)take(16 * MiB); p.gate = (float*)take(16 * MiB); p.coef = (float*)take(16 * MiB);
    p.zb = (bf16_t*)take(96 * MiB); p.cB = (bf16_t*)take(64 * MiB); p.hb = (bf16_t*)take(64 * MiB);
    (void)hipMemsetAsync(p.bar, 0, XCD_BAR_WORDS * 4 + 4608 * 4, stream);
    hipLaunchKernelGGL(fwd_mega, dim3(grid_blocks), dim3(512), MEGA_LDS_BYTES, stream, p);
}
```

```cpp
#include <hip/hip_runtime.h>
#include <stdint.h>
#include <type_traits>

typedef unsigned short bf16_t;
typedef short bf16x8 __attribute__((ext_vector_type(8)));
typedef float f32x4 __attribute__((ext_vector_type(4)));
typedef unsigned u32x4 __attribute__((ext_vector_type(4)));
typedef unsigned u32x2 __attribute__((ext_vector_type(2)));
typedef unsigned u32x3 __attribute__((ext_vector_type(3)));
typedef int i32x4 __attribute__((ext_vector_type(4)));
#define ROWB 768
typedef __bf16 bf2_t __attribute__((ext_vector_type(2)));
#define LAS __attribute__((address_space(3)))

#define T_TOK 32768
#define D_MODEL 1024
#define D_IN 1536
#define SEQ 2048
#define NEXP 16384
#define EPS 1e-6f

struct Params {
    const float *x, *norm1_g, *w_in, *pool_w, *pool_scale, *sgu_norm_g, *sgu_w, *sgu_b, *w_out, *norm2_g, *peer_wq, *peer_keys, *peer_u, *peer_v, *final_g;
    float* out;
    bf16_t *woutT, *poolT, *wsM, *keysB;
    unsigned char *u8, *v8;
    float2* suv;
    float *rstd1, *sx;
    signed char *xq, *winT8, *hq, *wqT8; unsigned *swb, *swq; float* hsc;
    bf16_t *zb, *cB, *hb;
    float2* lnp;
    int* idx; float* gate; float* coef;
    unsigned* bar;
};

__device__ __forceinline__ int tid_opaque() { int t = (int)threadIdx.x; asm volatile("" : "+v"(t)); return t; }
__device__ __forceinline__ unsigned short f2bf(float f) {
    unsigned u = __float_as_uint(f);
    u += 0x7fffu + ((u >> 16) & 1u);
    return (unsigned short)(u >> 16);
}
__device__ __forceinline__ float bf2f(unsigned short h) { return __uint_as_float(((unsigned)h) << 16); }
__device__ __forceinline__ unsigned pack2(float a, float b) { return (unsigned)f2bf(a) | ((unsigned)f2bf(b) << 16); }
__device__ __forceinline__ float bflo(unsigned w) { return __uint_as_float(w << 16); }
__device__ __forceinline__ float bfhi(unsigned w) { return __uint_as_float(w & 0xffff0000u); }
__device__ __forceinline__ float gelu_t(float x) {
    const float y = 1.5957691216057308f * (x + 0.044715f * x * x * x);
    return x * __builtin_amdgcn_rcpf(1.0f + __expf(-y));
}
__device__ __forceinline__ float wave_sum(float v) {
#pragma unroll
    for (int o = 32; o >= 1; o >>= 1) v += __shfl_xor(v, o);
    return v;
}
__device__ __forceinline__ float wave_max(float v) {
#pragma unroll
    for (int o = 32; o >= 1; o >>= 1) v = fmaxf(v, __shfl_xor(v, o));
    return v;
}

#define GEMM_LDS_BYTES (2 * 128 * 144)
__device__ __forceinline__ void transpose_tile(const int tid, const float* __restrict__ src, bf16_t* __restrict__ dst, int R, int C, const float* __restrict__ rscale, int tile, float* lds) {
    const int tilesC = C / 64, tr = tile / tilesC, tc = tile % tilesC;
    const int ty = tid >> 6, tx = tid & 63;
    __syncthreads();
#pragma unroll
    for (int i = 0; i < 16; ++i) {
        const int r = ty + 4 * i;
        float v = src[(size_t)(tr * 64 + r) * C + tc * 64 + tx];
        if (rscale) v *= rscale[tr * 64 + r];
        lds[r * 65 + tx] = v;
    }
    __syncthreads();
#pragma unroll
    for (int i = 0; i < 16; ++i) {
        const int c = ty + 4 * i;
        dst[(size_t)(tc * 64 + c) * R + tr * 64 + tx] = f2bf(lds[tx * 65 + c]);
    }
}

__device__ __forceinline__ void w8_colmax(const float* __restrict__ src, const float* __restrict__ gain, int C, unsigned* mx, unsigned* cnt, int hb2, int nh, int ht) {
    const int ncb = C / 64;
    for (int t = hb2; t < 16 * ncb; t += nh) {
        const int tr = t / ncb, tc = t % ncb, ty = ht >> 6, tx = ht & 63;
        float am = 0.f;
#pragma unroll
        for (int i = 0; i < 16; ++i) { const int r = tr * 64 + ty + 4 * i; am = fmaxf(am, fabsf(src[(size_t)r * C + tc * 64 + tx] * gain[r])); }
        (void)__hip_atomic_fetch_max(mx + tc * 64 + tx, __float_as_uint(am), __ATOMIC_RELAXED, __HIP_MEMORY_SCOPE_AGENT);
        asm volatile("s_waitcnt vmcnt(0)" ::: "memory");
        __syncthreads();
        if (ht == 0) (void)__hip_atomic_fetch_add(cnt + tc, 1u, __ATOMIC_RELAXED, __HIP_MEMORY_SCOPE_AGENT);
    }
}
__device__ __forceinline__ void w8_tiles(const float* __restrict__ src, const float* __restrict__ gain, int C, signed char* __restrict__ dst, unsigned* mx, unsigned* cnt, char* lds, int tid) {
    const int half = tid >> 8, ht = tid & 255, ty = ht >> 6, tx = ht & 63, ncb = C / 64;
    float* fl = (float*)(lds + half * (64 * 65 * 4));
    for (int t = 2 * blockIdx.x + half; t < 16 * ncb; t += 2 * gridDim.x) {
        const int tr = t / ncb, tc = t % ncb;
        if (ht == 0) {
            unsigned spins = 0;
            while (__hip_atomic_load(cnt + tc, __ATOMIC_RELAXED, __HIP_MEMORY_SCOPE_AGENT) < 16u && ++spins < (1u << 22)) __builtin_amdgcn_s_sleep(2);
        }
        __syncthreads();
#pragma unroll
        for (int i = 0; i < 16; ++i) { const int r = ty + 4 * i; fl[r * 65 + tx] = src[(size_t)(tr * 64 + r) * C + tc * 64 + tx] * gain[tr * 64 + r]; }
        __syncthreads();
#pragma unroll
        for (int i = 0; i < 16; ++i) {
            const int c = ty + 4 * i;
            const float am = __uint_as_float(__hip_atomic_load(mx + tc * 64 + c, __ATOMIC_RELAXED, __HIP_MEMORY_SCOPE_AGENT));
            const float inv = am > 0.f ? 127.0f / am : 0.f;
            dst[(size_t)(tc * 64 + c) * 1024 + tr * 64 + tx] = (signed char)(int)rintf(fl[tx * 65 + c] * inv);
        }
    }
}

__device__ __forceinline__ void quant_expert(const Params& p, const int e, const int lane, const float4 (&a4)[4], const float4 (&b4)[4]) {
    float fu[16], fv[16];
#pragma unroll
    for (int i = 0; i < 4; ++i) {
        const float4 g = ((const float4*)(p.norm2_g + lane * 16))[i];
        fu[4 * i] = a4[i].x * g.x; fu[4 * i + 1] = a4[i].y * g.y; fu[4 * i + 2] = a4[i].z * g.z; fu[4 * i + 3] = a4[i].w * g.w;
        fv[4 * i] = b4[i].x; fv[4 * i + 1] = b4[i].y; fv[4 * i + 2] = b4[i].z; fv[4 * i + 3] = b4[i].w;
    }
    {
        float am = 0.f;
#pragma unroll
        for (int j = 0; j < 16; ++j) am = fmaxf(am, fabsf(fu[j]));
        am = wave_max(am);
        const float inv = am > 0.f ? 127.0f / am : 0.f;
        u32x4 o;
#pragma unroll
        for (int i = 0; i < 4; ++i) {
            unsigned w = 0;
#pragma unroll
            for (int k = 0; k < 4; ++k) w |= (unsigned)(((int)rintf(fu[4 * i + k] * inv)) & 0xff) << (8 * k);
            o[i] = w;
        }
        *(u32x4*)(p.u8 + (size_t)e * D_MODEL + lane * 16) = o;
        if (lane == 0) p.suv[e].x = am * (1.0f / 127.0f);
    }
    {
        float am = 0.f;
#pragma unroll
        for (int j = 0; j < 16; ++j) am = fmaxf(am, fabsf(fv[j]));
        am = wave_max(am);
        const float inv = am > 0.f ? 31.0f / am : 0.f;
        int q[16];
#pragma unroll
        for (int j = 0; j < 16; ++j) q[j] = (int)rintf(fv[j] * inv) + 32;
        unsigned dg[3][4];
#pragma unroll
        for (int k = 0; k < 4; ++k) {
            int ee = q[12 + k] - 42;
#pragma unroll
            for (int i = 0; i < 3; ++i) { const int d = ee & 3, D = d >= 2 ? d - 4 : d; dg[i][k] = (unsigned)d; ee = (ee - D) >> 2; }
        }
        u32x3 o;
#pragma unroll
        for (int i = 0; i < 3; ++i) {
            unsigned w = 0;
#pragma unroll
            for (int k = 0; k < 4; ++k) w |= (unsigned)(q[4 * i + k] | (dg[i][k] << 6)) << (8 * k);
            o[i] = w;
        }
        *(u32x3*)(p.v8 + (size_t)e * ROWB + lane * 12) = o;
        if (lane == 0) p.suv[e].y = am * (1.0f / 31.0f);
    }
}

__device__ void phase_prep(const Params& p, char* lds) {
    const int tidx_ = tid_opaque();
    const int nb = gridDim.x, b = blockIdx.x, tid = tidx_;
    const int half = tid >> 8, ht = tid & 255, nh = 2 * nb, hb2 = 2 * b + half;
    float* fl = (float*)(lds + half * (64 * 65 * 4));
    w8_colmax(p.w_in, p.norm1_g, 1536, p.swb, p.swb + 1536, hb2, nh, ht);
    w8_colmax(p.peer_wq, p.norm2_g, 2048, p.swq, p.swq + 2048, hb2, nh, ht);
    for (int t = hb2; t < 16 * 16; t += nh) transpose_tile(ht, p.w_out, p.woutT, 1024, 1024, nullptr, t, fl);
    for (int t = hb2; t < 16; t += nh) transpose_tile(ht, p.pool_w + (size_t)(t >> 2) * 16384, p.poolT + (size_t)(t >> 2) * 16384, 128, 128, nullptr, t & 3, fl);
    const size_t gtid = (size_t)b * blockDim.x + tid, gsz = (size_t)nb * blockDim.x;
    for (size_t i = gtid; i < 4 * 128 * 128; i += gsz) {
        const int j = (int)(i & 127), ii = (int)((i >> 7) & 127);
        const bool keep = (j >> 6) <= (ii >> 6);
        p.wsM[i] = keep ? f2bf(p.sgu_w[i]) : (bf16_t)0;
    }
    for (size_t o = gtid; o < 2 * 8 * 128 * 128; o += gsz) {
        const int j = (int)(o & 7), ln = (int)((o >> 3) & 63), nb = (int)((o >> 9) & 7), kk = (int)((o >> 12) & 3), ph = (int)(o >> 14);
        p.keysB[o] = f2bf(p.peer_keys[(size_t)ph * 16384 + (size_t)(16 * nb + (ln & 15)) * 128 + 32 * kk + 8 * (ln >> 4) + j]);
    }
    const int wave = (b * blockDim.x + tid) >> 6, nwaves = (nb * blockDim.x) >> 6, lane = tid & 63;
    for (int t = wave; t < T_TOK; t += 2 * nwaves) {
        const int t1 = t + nwaves; const bool two = t1 < T_TOK;
        const float4* xr0 = (const float4*)(p.x + (size_t)t * D_MODEL);
        const float4* xr1 = (const float4*)(p.x + (size_t)(two ? t1 : t) * D_MODEL);
        float4 v0[4], v1[4];
#pragma unroll
        for (int i = 0; i < 4; ++i) { v0[i] = xr0[lane + 64 * i]; v1[i] = xr1[lane + 64 * i]; }
        float s0 = 0.f, s1 = 0.f, a0 = 0.f, a1 = 0.f;
#pragma unroll
        for (int i = 0; i < 4; ++i) {
            s0 += v0[i].x * v0[i].x + v0[i].y * v0[i].y + v0[i].z * v0[i].z + v0[i].w * v0[i].w;
            s1 += v1[i].x * v1[i].x + v1[i].y * v1[i].y + v1[i].z * v1[i].z + v1[i].w * v1[i].w;
            a0 = fmaxf(fmaxf(a0, fmaxf(fabsf(v0[i].x), fabsf(v0[i].y))), fmaxf(fabsf(v0[i].z), fabsf(v0[i].w)));
            a1 = fmaxf(fmaxf(a1, fmaxf(fabsf(v1[i].x), fabsf(v1[i].y))), fmaxf(fabsf(v1[i].z), fabsf(v1[i].w)));
        }
        s0 = wave_sum(s0); s1 = wave_sum(s1); a0 = wave_max(a0); a1 = wave_max(a1);
        const float i0 = a0 > 0.f ? 127.0f / a0 : 0.f, i1 = a1 > 0.f ? 127.0f / a1 : 0.f;
#pragma unroll
        for (int i = 0; i < 4; ++i) {
            const unsigned q0 = ((unsigned)((int)rintf(v0[i].x * i0) & 0xff)) | ((unsigned)((int)rintf(v0[i].y * i0) & 0xff) << 8) | ((unsigned)((int)rintf(v0[i].z * i0) & 0xff) << 16) | ((unsigned)((int)rintf(v0[i].w * i0) & 0xff) << 24);
            ((unsigned*)(p.xq + (size_t)t * D_MODEL))[lane + 64 * i] = q0;
            if (two) {
                const unsigned q1 = ((unsigned)((int)rintf(v1[i].x * i1) & 0xff)) | ((unsigned)((int)rintf(v1[i].y * i1) & 0xff) << 8) | ((unsigned)((int)rintf(v1[i].z * i1) & 0xff) << 16) | ((unsigned)((int)rintf(v1[i].w * i1) & 0xff) << 24);
                ((unsigned*)(p.xq + (size_t)t1 * D_MODEL))[lane + 64 * i] = q1;
            }
        }
        if (lane == 0) {
            p.rstd1[t] = rsqrtf(s0 * (1.0f / D_MODEL) + EPS) * a0 * (1.0f / 127.0f); p.sx[t] = a0 * (1.0f / 127.0f);
            if (two) { p.rstd1[t1] = rsqrtf(s1 * (1.0f / D_MODEL) + EPS) * a1 * (1.0f / 127.0f); p.sx[t1] = a1 * (1.0f / 127.0f); }
        }
    }
    w8_tiles(p.w_in, p.norm1_g, 1536, p.winT8, p.swb, p.swb + 1536, lds, tid);
    w8_tiles(p.peer_wq, p.norm2_g, 2048, p.wqT8, p.swq, p.swq + 2048, lds, tid);
}

typedef short s16x4 __attribute__((ext_vector_type(4)));
template <class Epi>
__device__ __forceinline__ void gemm128_sgu(const int tid, const bf16_t* __restrict__ A, const bf16_t* __restrict__ V  ,
                                            const float* __restrict__ lnm, const float* __restrict__ lnr, const float* __restrict__ gch, char* lds, const Epi& epi) {
    const int lane = tid & 63, wid = tid >> 6, wr = wid >> 1, wc = wid & 1, fr = lane & 15, fq = lane >> 4;
    constexpr int PITCH = 144, P2 = 288;
    char* sA = lds; char* sB = lds + 128 * PITCH;
    f32x4 acc[4][4];
#pragma unroll
    for (int m = 0; m < 4; ++m)
#pragma unroll
        for (int n = 0; n < 4; ++n) acc[m][n] = (f32x4){0.f, 0.f, 0.f, 0.f};
    u32x4 ra[4], rb[4]; float rm[4], rr[4];
    const int lrow = tid >> 3, lch = tid & 7;
    const int btok = tid >> 4, bch = tid & 15;
    const bf16_t* ga = A + (size_t)lrow * 128 + lch * 8;
    const bf16_t* gb = V + (size_t)btok * D_IN + bch * 8;
    float g8[8];
    { const float4 g0 = *(const float4*)(gch + bch * 8), g1 = *(const float4*)(gch + bch * 8 + 4); g8[0] = g0.x; g8[1] = g0.y; g8[2] = g0.z; g8[3] = g0.w; g8[4] = g1.x; g8[5] = g1.y; g8[6] = g1.z; g8[7] = g1.w; }
#pragma unroll
    for (int j = 0; j < 4; ++j) { ra[j] = *(const u32x4*)(ga + (size_t)(32 * j) * 128); rb[j] = *(const u32x4*)(gb + (size_t)(16 * j) * D_IN); rm[j] = lnm[btok + 16 * j]; rr[j] = lnr[btok + 16 * j]; }
    for (int k0 = 0; k0 < 128; k0 += 64) {
        __syncthreads();
#pragma unroll
        for (int j = 0; j < 4; ++j) {
            *(u32x4*)(sA + (lrow + 32 * j) * PITCH + lch * 16) = ra[j];
            u32x4 o;
#pragma unroll
            for (int i = 0; i < 4; ++i) {
                const unsigned w = rb[j][i];
                o[i] = pack2((bflo(w) - rm[j]) * rr[j] * g8[2 * i], (bfhi(w) - rm[j]) * rr[j] * g8[2 * i + 1]);
            }
            *(u32x4*)(sB + (btok + 16 * j) * P2 + bch * 16) = o;
        }
        __syncthreads();
        if (k0 + 64 < 128) {
#pragma unroll
            for (int j = 0; j < 4; ++j) { ra[j] = *(const u32x4*)(ga + (size_t)(32 * j) * 128 + 64); rb[j] = *(const u32x4*)(gb + (size_t)(64 + 16 * j) * D_IN); rm[j] = lnm[64 + btok + 16 * j]; rr[j] = lnr[64 + btok + 16 * j]; }
        }
#pragma unroll
        for (int kk = 0; kk < 2; ++kk) {
            bf16x8 af[4], bfr[4];
#pragma unroll
            for (int m = 0; m < 4; ++m) af[m] = *(const bf16x8*)(sA + (wr * 64 + m * 16 + fr) * PITCH + (kk * 32 + fq * 8) * 2);
#pragma unroll
            for (int n = 0; n < 4; ++n) {
                const char* bp = sB + (kk * 32 + fq * 8 + (fr >> 2)) * P2 + (wc * 64 + n * 16 + 4 * (fr & 3)) * 2;
                const s16x4 lo = __builtin_amdgcn_ds_read_tr16_b64_v4i16((LAS s16x4*)(bp));
                const s16x4 hi = __builtin_amdgcn_ds_read_tr16_b64_v4i16((LAS s16x4*)(bp + 4 * P2));
                bfr[n] = (bf16x8){lo[0], lo[1], lo[2], lo[3], hi[0], hi[1], hi[2], hi[3]};
            }
#pragma unroll
            for (int m = 0; m < 4; ++m)
#pragma unroll
                for (int n = 0; n < 4; ++n) acc[m][n] = __builtin_amdgcn_mfma_f32_16x16x32_bf16(bfr[n], af[m], acc[m][n], 0, 0, 0);
        }
    }
#pragma unroll
    for (int m = 0; m < 4; ++m)
#pragma unroll
        for (int n = 0; n < 4; ++n) epi(wr * 64 + m * 16 + fr, wc * 64 + n * 16 + fq * 4, acc[m][n]);
}

#define PT_PITCH 272
#define MIXH_LDS (2 * 128 * PT_PITCH + 1024)
template <int W, class Epi>
__device__ __forceinline__ void pool_tile(const int tid, const bf16_t* __restrict__ zb0  , int pos0,
                                          const bf16_t* __restrict__ Bt, char* lds, const Epi& epi) {
    const int lane = tid & 63, wid = tid >> 6, wr = wid >> 1, wc = wid & 1, fr = lane & 15, fq = lane >> 4;
    char* sA = lds; char* sB = lds + 128 * PT_PITCH;
    __syncthreads();
#pragma unroll
    for (int j = 0; j < 8; ++j) { const int id = tid + 256 * j, row = id >> 4, ch = id & 15; *(u32x4*)(sB + row * PT_PITCH + ch * 16) = *(const u32x4*)(Bt + (size_t)row * 128 + ch * 8); }
    {
        const int seg = tid >> 5, hc = tid & 31, r0 = seg * 16;
        const bool at_start = (pos0 & (SEQ - 1)) == 0;
        const bf16_t* zp = zb0 + hc * 4;
        u32x2 v[W + 16];
#pragma unroll
        for (int i = 0; i < W + 16; ++i) { const int rr = r0 - W + i; const bool ok = !(at_start && rr < 0); v[i] = *(const u32x2*)(zp + (ptrdiff_t)(ok ? rr : 0) * D_IN); }
        float sm[4] = {0.f, 0.f, 0.f, 0.f};
#pragma unroll
        for (int i = 1; i <= W; ++i) {
            const float m = (at_start && (r0 - W + i) < 0) ? 0.f : 1.f;
            sm[0] += m * bflo(v[i].x); sm[1] += m * bfhi(v[i].x); sm[2] += m * bflo(v[i].y); sm[3] += m * bfhi(v[i].y);
        }
#pragma unroll
        for (int o = 0; o < 16; ++o) {
            if (o > 0) {
                const float md = (at_start && (r0 + o - W) < 0) ? 0.f : 1.f;
                sm[0] += bflo(v[W + o].x) - md * bflo(v[o].x); sm[1] += bfhi(v[W + o].x) - md * bfhi(v[o].x);
                sm[2] += bflo(v[W + o].y) - md * bflo(v[o].y); sm[3] += bfhi(v[W + o].y) - md * bfhi(v[o].y);
            }
            const int pos = (pos0 + r0 + o) & (SEQ - 1);
            const float rn = 1.0f / (float)((pos + 1 < W) ? pos + 1 : W);
            u32x2 ov;
            ov.x = pack2(sm[0] * rn - bflo(v[W + o].x), sm[1] * rn - bfhi(v[W + o].x));
            ov.y = pack2(sm[2] * rn - bflo(v[W + o].y), sm[3] * rn - bfhi(v[W + o].y));
            *(u32x2*)(sA + (r0 + o) * PT_PITCH + hc * 8) = ov;
        }
    }
    __syncthreads();
    f32x4 acc[4][4];
#pragma unroll
    for (int m = 0; m < 4; ++m)
#pragma unroll
        for (int n = 0; n < 4; ++n) acc[m][n] = (f32x4){0.f, 0.f, 0.f, 0.f};
#pragma unroll
    for (int kk = 0; kk < 4; ++kk) {
        bf16x8 af[4], bfr[4];
#pragma unroll
        for (int m = 0; m < 4; ++m) af[m] = *(const bf16x8*)(sA + (wr * 64 + m * 16 + fr) * PT_PITCH + (kk * 32 + fq * 8) * 2);
#pragma unroll
        for (int n = 0; n < 4; ++n) bfr[n] = *(const bf16x8*)(sB + (wc * 64 + n * 16 + fr) * PT_PITCH + (kk * 32 + fq * 8) * 2);
#pragma unroll
        for (int m = 0; m < 4; ++m)
#pragma unroll
            for (int n = 0; n < 4; ++n) acc[m][n] = __builtin_amdgcn_mfma_f32_16x16x32_bf16(bfr[n], af[m], acc[m][n], 0, 0, 0);
    }
#pragma unroll
    for (int m = 0; m < 4; ++m)
#pragma unroll
        for (int n = 0; n < 4; ++n) epi(wr * 64 + m * 16 + fr, wc * 64 + n * 16 + fq * 4, acc[m][n]);
}

__device__ void phase_mix_gemm(const Params& p, char* lds) {
    const int tidx_ = tid_opaque();
    const int npool = (T_TOK / 128) * 4, nsgu = (T_TOK / 128) * 4;
    const int half = tidx_ >> 8, ht = tidx_ & 255; lds += half * MIXH_LDS;
    for (int tile = 2 * blockIdx.x + half; tile < npool + nsgu; tile += 2 * gridDim.x) {
        if (tile < npool) {
            const int tm = tile >> 2, g = tile & 3;
            const float* ps = p.pool_scale + g * 128; bf16_t* co = p.cB + (size_t)tm * 128 * D_MODEL + g * 128;
            const bf16_t* z0 = p.zb + (size_t)tm * 128 * D_IN + g * 128; const bf16_t* bt = p.poolT + (size_t)g * 16384;
            auto epi = [&](int r, int c, f32x4 v) {
                const float4 sc = *(const float4*)(ps + c);
                uint2 o; o.x = pack2(v[0] * sc.x, v[1] * sc.y); o.y = pack2(v[2] * sc.z, v[3] * sc.w);
                *(uint2*)(co + (size_t)r * D_MODEL + c) = o;
            };
            if (g == 0) pool_tile<2>(ht, z0, tm * 128, bt, lds, epi); else if (g == 1) pool_tile<4>(ht, z0, tm * 128, bt, lds, epi);
            else if (g == 2) pool_tile<8>(ht, z0, tm * 128, bt, lds, epi); else pool_tile<16>(ht, z0, tm * 128, bt, lds, epi);
        } else {
            const int t2 = tile - npool, blk = t2 >> 2, h = t2 & 3;
            float* stm = (float*)(lds + GEMM_LDS_BYTES); float* str = stm + 128;
            __syncthreads();
            if (ht < 128) {
                const float4* pp = (const float4*)(p.lnp + (size_t)(blk * 128 + ht) * 8);
                const float4 a0 = pp[0], a1 = pp[1], a2 = pp[2], a3 = pp[3];
                const float s1 = ((a0.x + a0.z) + (a1.x + a1.z)) + ((a2.x + a2.z) + (a3.x + a3.z)), s2 = ((a0.y + a0.w) + (a1.y + a1.w)) + ((a2.y + a2.w) + (a3.y + a3.w));
                const float mean = s1 * (1.0f / 512.0f), var = fmaxf(s2 * (1.0f / 512.0f) - mean * mean, 0.f);
                stm[ht] = mean; str[ht] = rsqrtf(var + EPS);
            }
            __syncthreads();
            const float* sb = p.sgu_b + h * 128; const bf16_t* uo = p.zb + (size_t)blk * 128 * D_IN + 512 + h * 128;
            bf16_t* co = p.cB + (size_t)blk * 128 * D_MODEL + 512 + h * 128;
            gemm128_sgu(ht, p.wsM + (size_t)h * 16384, p.zb + (size_t)blk * 128 * D_IN + 1024 + h * 128, stm, str, p.sgu_norm_g + h * 128, lds,
                    [&](int r, int c, f32x4 v) {
                        const float bb = sb[r];
                        const uint2 uu = *(const uint2*)(uo + (size_t)r * D_IN + c);
                        uint2 o;
                        o.x = pack2((v[0] + bb) * bflo(uu.x), (v[1] + bb) * bfhi(uu.x));
                        o.y = pack2((v[2] + bb) * bflo(uu.y), (v[3] + bb) * bfhi(uu.y));
                        *(uint2*)(co + (size_t)r * D_MODEL + c) = o;
                    });
        }
    }
}

__device__ __forceinline__ int wave_sum_i_uniform(int s) {
    s += __builtin_amdgcn_update_dpp(0, s, 0xB1, 0xf, 0xf, false);
    s += __builtin_amdgcn_update_dpp(0, s, 0x4E, 0xf, 0xf, false);
    s += __builtin_amdgcn_update_dpp(0, s, 0x141, 0xf, 0xf, false);
    s += __builtin_amdgcn_update_dpp(0, s, 0x140, 0xf, 0xf, false);
    return __builtin_amdgcn_readlane(s, 0) + __builtin_amdgcn_readlane(s, 16) + __builtin_amdgcn_readlane(s, 32) + __builtin_amdgcn_readlane(s, 48);
}
__constant__ unsigned char kComb[64] = {
    0x00,0x01,0x02,0x03,0x04,0x05,0x06,0x07,0x08,0x09,0x0a,0x0b,0x0c,0x0d,0x0e,0x0f,
    0x10,0x11,0x12,0x13,0x14,0x15,0x16,0x17,
    0x20,0x21,0x22,0x23,0x24,
    0x30,0x31,0x32,0x33,
    0x40,0x41,0x42,
    0x50,0x51,
    0x60,0x61,
    0x70,0x71,
    0x80,0x90,0xa0,0xb0,0xc0,0xd0,0xe0,0xf0,
    0xff,0xff,0xff,0xff,0xff,0xff,0xff,0xff,0xff,0xff,0xff,0xff,0xff,0xff};

template <int CTRL> __device__ __forceinline__ int dpp_i(int v) { return __builtin_amdgcn_update_dpp(0, v, CTRL, 0xf, 0xf, false); }
__device__ __forceinline__ int row_allmax_i(int v) {
    v = max(v, dpp_i<0x128>(v)); v = max(v, dpp_i<0x124>(v)); v = max(v, dpp_i<0x122>(v)); v = max(v, dpp_i<0x121>(v));
    return v;
}
__device__ __forceinline__ float row_allsum_f(float v) {
    v += __int_as_float(dpp_i<0x128>(__float_as_int(v))); v += __int_as_float(dpp_i<0x124>(__float_as_int(v)));
    v += __int_as_float(dpp_i<0x122>(__float_as_int(v))); v += __int_as_float(dpp_i<0x121>(__float_as_int(v)));
    return v;
}
__device__ __forceinline__ int f2key(float f) { const int b = __float_as_int(f); return b ^ ((b >> 31) & 0x7fffffff); }
__device__ __forceinline__ float key2f(int k) { return __int_as_float(k ^ ((k >> 31) & 0x7fffffff)); }
#define KEY_MIN ((int)0x80000000)
#define CE(a, b) { const int hi_ = max(a, b), lo_ = min(a, b); a = hi_; b = lo_; }
__device__ __forceinline__ int top16_rows(int (&k)[8], int l15) {
    CE(k[0], k[1]) CE(k[2], k[3]) CE(k[4], k[5]) CE(k[6], k[7])
    CE(k[0], k[2]) CE(k[1], k[3]) CE(k[4], k[6]) CE(k[5], k[7])
    CE(k[1], k[2]) CE(k[5], k[6])
    CE(k[0], k[4]) CE(k[1], k[5]) CE(k[2], k[6]) CE(k[3], k[7])
    CE(k[2], k[4]) CE(k[3], k[5])
    CE(k[1], k[2]) CE(k[3], k[4]) CE(k[5], k[6])
    int res = KEY_MIN;
#pragma unroll
    for (int r = 0; r < 16; ++r) {
        const int m = row_allmax_i(k[0]);
        const bool own = (k[0] == m);
#pragma unroll
        for (int j = 0; j < 7; ++j) k[j] = own ? k[j + 1] : k[j];
        k[7] = own ? KEY_MIN : k[7];
        res = (l15 == r) ? m : res;
    }
    return res;
}
__device__ __forceinline__ void combine16(int A, int B, const int (&cbv)[4], int lane, int l15, int& eid_out, float& gate_out) {
    const int rowbase = lane & 48;
    int ck[4], eid[4];
#pragma unroll
    for (int c = 0; c < 4; ++c) {
        const int ci = (cbv[c] >> 4) & 15, cj = cbv[c] & 15;
        const int ka = __builtin_amdgcn_ds_bpermute((rowbase + ci) << 2, A);
        const int kb = __builtin_amdgcn_ds_bpermute((rowbase + cj) << 2, B);
        const float sm = key2f(ka & ~127) + key2f(kb & ~127);
        eid[c] = ((127 - (ka & 127)) << 7) | (127 - (kb & 127));
        ck[c] = (cbv[c] != 0xff) ? ((f2key(sm) & ~63) | (63 - (4 * l15 + c))) : KEY_MIN;
    }
    CE(ck[0], ck[1]) CE(ck[2], ck[3]) CE(ck[0], ck[2]) CE(ck[1], ck[3]) CE(ck[1], ck[2])
    int res = KEY_MIN;
#pragma unroll
    for (int r = 0; r < 16; ++r) {
        const int m = row_allmax_i(ck[0]);
        const bool own = (ck[0] == m);
        ck[0] = own ? ck[1] : ck[0]; ck[1] = own ? ck[2] : ck[1]; ck[2] = own ? ck[3] : ck[2]; ck[3] = own ? KEY_MIN : ck[3];
        res = (l15 == r) ? m : res;
    }
    const int slot = 63 - (res & 63);
    const int src = (rowbase + (slot >> 2)) << 2;
    const int e0 = __builtin_amdgcn_ds_bpermute(src, eid[0]), e1 = __builtin_amdgcn_ds_bpermute(src, eid[1]);
    const int e2 = __builtin_amdgcn_ds_bpermute(src, eid[2]), e3 = __builtin_amdgcn_ds_bpermute(src, eid[3]);
    const int sel = slot & 3;
    eid_out = sel == 0 ? e0 : (sel == 1 ? e1 : (sel == 2 ? e2 : e3));
    gate_out = key2f(res & ~63);
}

__device__ __forceinline__ int reduce16_rows(const int (&part)[16], bool b3, bool b2, bool b1, bool b0b) {
    int r8[8], r4[4], r2[2];
#pragma unroll
    for (int k = 0; k < 8; ++k) { const int keep = b3 ? part[8 + k] : part[k], send = b3 ? part[k] : part[8 + k]; r8[k] = keep + __builtin_amdgcn_update_dpp(0, send, 0x140, 0xf, 0xf, false); }
#pragma unroll
    for (int k = 0; k < 4; ++k) { const int keep = b2 ? r8[4 + k] : r8[k], send = b2 ? r8[k] : r8[4 + k]; r4[k] = keep + __builtin_amdgcn_update_dpp(0, send, 0x141, 0xf, 0xf, false); }
#pragma unroll
    for (int k = 0; k < 2; ++k) { const int keep = b1 ? r4[2 + k] : r4[k], send = b1 ? r4[k] : r4[2 + k]; r2[k] = keep + __builtin_amdgcn_update_dpp(0, send, 0x4E, 0xf, 0xf, false); }
    const int keep = b0b ? r2[1] : r2[0], send = b0b ? r2[0] : r2[1];
    int r1 = keep + __builtin_amdgcn_update_dpp(0, send, 0xB1, 0xf, 0xf, false);
    r1 += __shfl_xor(r1, 16); r1 += __shfl_xor(r1, 32);
    return r1;
}
__device__ void phase_hquant(const Params& p, char* lds) {
    const int tid = tid_opaque();
    const int wave = __builtin_amdgcn_readfirstlane((int)((blockIdx.x * blockDim.x + tid) >> 6)), nwaves = (gridDim.x * blockDim.x) >> 6, lane = tid & 63;
    for (int t = wave; t < T_TOK; t += 2 * nwaves) {
        const int t1 = t + nwaves; const bool two = t1 < T_TOK;
        const u32x4* h0 = (const u32x4*)(p.hb + (size_t)t * D_MODEL); const u32x4* h1 = (const u32x4*)(p.hb + (size_t)(two ? t1 : t) * D_MODEL);
        u32x4 r[2][2] = {{h0[2 * lane], h0[2 * lane + 1]}, {h1[2 * lane], h1[2 * lane + 1]}};
#pragma unroll
        for (int q = 0; q < 2; ++q) {
            const u32x4 a = r[q][0], c = r[q][1];
            const float f[16] = {bflo(a.x), bfhi(a.x), bflo(a.y), bfhi(a.y), bflo(a.z), bfhi(a.z), bflo(a.w), bfhi(a.w),
                                 bflo(c.x), bfhi(c.x), bflo(c.y), bfhi(c.y), bflo(c.z), bfhi(c.z), bflo(c.w), bfhi(c.w)};
            float ss = 0.f, am = 0.f;
#pragma unroll
            for (int k = 0; k < 16; ++k) { ss += f[k] * f[k]; am = fmaxf(am, fabsf(f[k])); }
            ss = wave_sum(ss); am = wave_max(am);
            const float inv = am > 0.f ? 127.0f / am : 0.f;
            u32x4 o;
#pragma unroll
            for (int i = 0; i < 4; ++i) {
                unsigned w = 0;
#pragma unroll
                for (int k = 0; k < 4; ++k) w |= (unsigned)((int)rintf(f[4 * i + k] * inv) & 0xff) << (8 * k);
                o[i] = w;
            }
            const int tt = q ? t1 : t;
            if (q == 0 || two) {
                ((u32x4*)(p.hq + (size_t)tt * D_MODEL))[lane] = o;
                if (lane == 0) p.hsc[tt] = am * (1.0f / 127.0f) * rsqrtf(ss * (1.0f / D_MODEL) + EPS);
            }
        }
    }
}

#define TS_WBYTES (16384 + 128)
__device__ void phase_peer_dots(const Params& p, char* lds) {
    const int tidx_ = tid_opaque();
    const int lane = tidx_ & 63, wid = __builtin_amdgcn_readfirstlane((int)(tidx_ >> 6)), l15 = lane & 15;
    const bool b3 = (lane & 8) != 0, b2 = (lane & 4) != 0, b1 = (lane & 2) != 0, b0b = (lane & 1) != 0;
    const int gw = blockIdx.x * (blockDim.x >> 6) + wid, ngw = gridDim.x * (blockDim.x >> 6);
    char* wl = lds + wid * TS_WBYTES;
    unsigned* list = (unsigned*)wl; int* dotsl = (int*)(wl + 4096); char* hql = wl + 8192; int* tks = (int*)(wl + 16384);
    const unsigned lane16 = (unsigned)lane * 16u;
    for (int tb = gw * 8; tb < T_TOK; tb += ngw * 8) {
#pragma unroll
        for (int j = 0; j < 8; ++j) *(u32x4*)(hql + j * 1024 + lane * 16) = ((const u32x4*)(p.hq + (size_t)(tb + j) * D_MODEL))[lane];
        if (lane < 8) tks[lane] = __float_as_int(p.hsc[tb + lane]);
        int idv[8][2];
#pragma unroll
        for (int j = 0; j < 8; ++j) { const int* ir = p.idx + (size_t)(tb + j) * 128; idv[j][0] = ir[lane]; idv[j][1] = ir[64 + lane]; }
#pragma unroll 1
        for (int x = 0; x < 8; ++x) {
            int n = 0;
#pragma unroll
            for (int j = 0; j < 8; ++j)
#pragma unroll
                for (int r = 0; r < 2; ++r) {
                    const int e = idv[j][r];
                    const bool in = (e >> 11) == x;
                    const unsigned long long mk = __ballot(in);
                    const int rank = (int)__builtin_amdgcn_mbcnt_hi((unsigned)(mk >> 32), __builtin_amdgcn_mbcnt_lo((unsigned)mk, 0u));
                    if (in) list[n + rank] = ((unsigned)j << 21) | ((unsigned)(r * 64 + lane) << 14) | (unsigned)e;
                    n += (int)__builtin_popcountll(mk);
                }
            asm volatile("s_waitcnt lgkmcnt(0)" ::: "memory");
            u32x4 ua[16], ubf[16]; int enta = 0, entb = 0;
            auto issue = [&](int b0, u32x4 (&uu)[16], int& entv) {
                const int i = (b0 + l15 < n) ? b0 + l15 : n - 1;
                entv = (int)list[i];
#pragma unroll
                for (int j = 0; j < 16; ++j) { const int e = __builtin_amdgcn_readlane(entv, j) & 0x3fff; uu[j] = *(const u32x4*)(p.u8 + (size_t)e * D_MODEL + lane16); }
            };
            auto reduce = [&](int b0, const u32x4 (&uu)[16], int entv) {
                int part[16];
#pragma unroll
                for (int j = 0; j < 16; ++j) {
                    const int tl = __builtin_amdgcn_readlane(entv, j) >> 21;
                    const u32x4 hqv = *(const u32x4*)(hql + tl * 1024 + lane * 16);
                    int sacc = __builtin_amdgcn_sdot4((int)uu[j].x, (int)hqv.x, 0, false);
                    sacc = __builtin_amdgcn_sdot4((int)uu[j].y, (int)hqv.y, sacc, false);
                    sacc = __builtin_amdgcn_sdot4((int)uu[j].z, (int)hqv.z, sacc, false);
                    part[j] = __builtin_amdgcn_sdot4((int)uu[j].w, (int)hqv.w, sacc, false);
                }
                const int r1 = reduce16_rows(part, b3, b2, b1, b0b);
                if (lane < 16 && b0 + lane < n) dotsl[((unsigned)entv >> 21) * 128 + (((unsigned)entv >> 14) & 127u)] = r1;
            };
            if (n > 0) issue(0, ua, enta);
            for (int b0 = 0; b0 < n; b0 += 32) {
                if (b0 + 16 < n) issue(b0 + 16, ubf, entb);
                reduce(b0, ua, enta);
                if (b0 + 16 < n) {
                    if (b0 + 32 < n) issue(b0 + 32, ua, enta);
                    reduce(b0 + 16, ubf, entb);
                }
            }
            asm volatile("s_waitcnt lgkmcnt(0)" ::: "memory");
        }
#pragma unroll
        for (int j = 0; j < 8; ++j) {
            const float cs_t = __int_as_float(tks[j]), r2_t = cs_t;
            const float* gr = p.gate + (size_t)(tb + j) * 128; float* cr = p.coef + (size_t)(tb + j) * 128;
#pragma unroll
            for (int r = 0; r < 2; ++r) {
                const int e = idv[j][r];
                const float sc = gr[r * 64 + lane] * r2_t;
                const float ex = __expf(sc - key2f(row_allmax_i(f2key(sc))));
                const float gt = ex / row_allsum_f(ex);
                const float2 sc2 = p.suv[e];
                const float dotf = (float)dotsl[j * 128 + r * 64 + lane] * cs_t * sc2.x;
                cr[r * 64 + lane] = gt * gelu_t(dotf) * sc2.y;
            }
        }
        asm volatile("s_waitcnt lgkmcnt(0)" ::: "memory");
    }
}

__device__ void phase_gather(const Params& p, char* lds) {
    const int tidx_ = tid_opaque();
    const int wave = __builtin_amdgcn_readfirstlane((int)((blockIdx.x * blockDim.x + tidx_) >> 6)), nwaves = (gridDim.x * blockDim.x) >> 6, lane = tidx_ & 63;
    const unsigned char* vb = p.v8 + lane * 12;
    const int ntok = (T_TOK - wave + nwaves - 1) / nwaves;
    auto tok = [&](int i) { const int ii = i < ntok ? i : ntok - 1; return wave + ii * nwaves; };
    if (ntok <= 0) return;
    u32x3 v0[8], v1[8], v2[8], v3[8];
    int ic0, ic1, in0, in1, ia0, ia1;
    float coef0, coef1, cn0, cn1;
    { const float* cr = p.coef + (size_t)tok(0) * 128; coef0 = cr[lane]; coef1 = cr[64 + lane]; }
    { const int* ir = p.idx + (size_t)tok(0) * 128; ic0 = ir[lane]; ic1 = ir[64 + lane]; }
    { const int* ir = p.idx + (size_t)tok(1) * 128; in0 = ir[lane]; in1 = ir[64 + lane]; }
    float g16[16];
#pragma unroll
    for (int i4 = 0; i4 < 4; ++i4) { const float4 g = ((const float4*)(p.final_g + lane * 16))[i4]; g16[4 * i4] = g.x; g16[4 * i4 + 1] = g.y; g16[4 * i4 + 2] = g.z; g16[4 * i4 + 3] = g.w; }
#define G2_ISSUE(vv, pbx) do { const int pbx_ = (pbx); const bool nx_ = pbx_ >= 128; const int pm_ = pbx_ & 127; \
        const int src_ = nx_ ? (pm_ < 64 ? in0 : in1) : (pm_ < 64 ? ic0 : ic1); \
        _Pragma("unroll") for (int q = 0; q < 8; ++q) { const int e = __builtin_amdgcn_readlane(src_, (pm_ & 63) + q); vv[q] = *(const u32x3*)(vb + (size_t)e * ROWB); } } while (0)
    __builtin_amdgcn_sched_barrier(0);
    G2_ISSUE(v0, 0); __builtin_amdgcn_sched_barrier(0); G2_ISSUE(v1, 8); __builtin_amdgcn_sched_barrier(0); G2_ISSUE(v2, 16); __builtin_amdgcn_sched_barrier(0);
#pragma unroll 1
    for (int i = 0; i < ntok; ++i) {
        const int t = tok(i);
        { const int* ir = p.idx + (size_t)tok(i + 2) * 128; ia0 = ir[lane]; ia1 = ir[64 + lane]; }
        const u32x4* hr = (const u32x4*)(p.hb + (size_t)t * D_MODEL + lane * 16);
        const u32x4 ha = hr[0], hc = hr[1];
        { const float* cr = p.coef + (size_t)tok(i + 1) * 128; cn0 = cr[lane]; cn1 = cr[64 + lane]; }
        const float cmax = wave_max(fmaxf(fabsf(coef0), fabsf(coef1)));
        const float qs = cmax > 0.f ? 127.0f / cmax : 0.f, cscale = cmax * (1.0f / 127.0f);
        const int cq0 = (int)rintf(coef0 * qs), cq1 = (int)rintf(coef1 * qs);
        const int csum_i = wave_sum_i_uniform(cq0 + cq1);
        unsigned cpk0, cpk1;
        {
            const int bb0 = cq0 & 0xff, bb1 = cq1 & 0xff;
            cpk0 = (unsigned)__builtin_amdgcn_update_dpp(0, bb0, 0x00, 0xf, 0xf, false) | ((unsigned)__builtin_amdgcn_update_dpp(0, bb0, 0x55, 0xf, 0xf, false) << 8)
                 | ((unsigned)__builtin_amdgcn_update_dpp(0, bb0, 0xAA, 0xf, 0xf, false) << 16) | ((unsigned)__builtin_amdgcn_update_dpp(0, bb0, 0xFF, 0xf, 0xf, false) << 24);
            cpk1 = (unsigned)__builtin_amdgcn_update_dpp(0, bb1, 0x00, 0xf, 0xf, false) | ((unsigned)__builtin_amdgcn_update_dpp(0, bb1, 0x55, 0xf, 0xf, false) << 8)
                 | ((unsigned)__builtin_amdgcn_update_dpp(0, bb1, 0xAA, 0xf, 0xf, false) << 16) | ((unsigned)__builtin_amdgcn_update_dpp(0, bb1, 0xFF, 0xf, 0xf, false) << 24);
        }
        int racc[12], jacc[12];
#pragma unroll
        for (int j = 0; j < 12; ++j) { racc[j] = 0; jacc[j] = 0; }
        auto axpy = [&](int pb, const u32x3 (&vv)[8]) __attribute__((always_inline)) {
#pragma unroll
            for (int g4 = 0; g4 < 2; ++g4) {
                const int cqd = __builtin_amdgcn_readlane((int)(pb < 64 ? cpk0 : cpk1), (pb & 63) + 4 * g4);
#pragma unroll
                for (int w = 0; w < 3; ++w) {
                    const unsigned wa = vv[4 * g4 + 0][w], wb = vv[4 * g4 + 1][w], wc = vv[4 * g4 + 2][w], wd = vv[4 * g4 + 3][w];
                    const unsigned p0 = __builtin_amdgcn_perm(wb, wa, 0x05010400u), p1 = __builtin_amdgcn_perm(wb, wa, 0x07030602u);
                    const unsigned q0 = __builtin_amdgcn_perm(wd, wc, 0x05010400u), q1 = __builtin_amdgcn_perm(wd, wc, 0x07030602u);
                    const unsigned t0 = __builtin_amdgcn_perm(q0, p0, 0x05040100u), t1 = __builtin_amdgcn_perm(q0, p0, 0x07060302u);
                    const unsigned t2 = __builtin_amdgcn_perm(q1, p1, 0x05040100u), t3 = __builtin_amdgcn_perm(q1, p1, 0x07060302u);
                    racc[4 * w + 0] = __builtin_amdgcn_sdot4((int)t0, cqd, racc[4 * w + 0], false); jacc[4 * w + 0] = __builtin_amdgcn_sdot4((int)(t0 & 0xc0c0c0c0u), cqd, jacc[4 * w + 0], false);
                    racc[4 * w + 1] = __builtin_amdgcn_sdot4((int)t1, cqd, racc[4 * w + 1], false); jacc[4 * w + 1] = __builtin_amdgcn_sdot4((int)(t1 & 0xc0c0c0c0u), cqd, jacc[4 * w + 1], false);
                    racc[4 * w + 2] = __builtin_amdgcn_sdot4((int)t2, cqd, racc[4 * w + 2], false); jacc[4 * w + 2] = __builtin_amdgcn_sdot4((int)(t2 & 0xc0c0c0c0u), cqd, jacc[4 * w + 2], false);
                    racc[4 * w + 3] = __builtin_amdgcn_sdot4((int)t3, cqd, racc[4 * w + 3], false); jacc[4 * w + 3] = __builtin_amdgcn_sdot4((int)(t3 & 0xc0c0c0c0u), cqd, jacc[4 * w + 3], false);
                }
            }
        };
#pragma unroll 1
        for (int pb = 0; pb < 128; pb += 32) {
            G2_ISSUE(v3, pb + 24); __builtin_amdgcn_sched_barrier(0); axpy(pb, v0); __builtin_amdgcn_sched_barrier(0);
            G2_ISSUE(v0, pb + 32); __builtin_amdgcn_sched_barrier(0); axpy(pb + 8, v1); __builtin_amdgcn_sched_barrier(0);
            G2_ISSUE(v1, pb + 40); __builtin_amdgcn_sched_barrier(0); axpy(pb + 16, v2); __builtin_amdgcn_sched_barrier(0);
            G2_ISSUE(v2, pb + 48); __builtin_amdgcn_sched_barrier(0); axpy(pb + 24, v3); __builtin_amdgcn_sched_barrier(0);
        }
        ic0 = in0; ic1 = in1; in0 = ia0; in1 = ia1;
        coef0 = cn0; coef1 = cn1;
        int acc[16];
#pragma unroll
        for (int j = 0; j < 12; ++j) acc[j] = (racc[j] - jacc[j]) - 32 * csum_i;
#pragma unroll
        for (int k = 0; k < 4; ++k) acc[12 + k] = ((jacc[k] + 4 * jacc[4 + k] + 16 * jacc[8 + k]) >> 6) + 10 * csum_i;
        const float hf16[16] = {bflo(ha.x), bfhi(ha.x), bflo(ha.y), bfhi(ha.y), bflo(ha.z), bfhi(ha.z), bflo(ha.w), bfhi(ha.w),
                                bflo(hc.x), bfhi(hc.x), bflo(hc.y), bfhi(hc.y), bflo(hc.z), bfhi(hc.z), bflo(hc.w), bfhi(hc.w)};
        float res[16];
        float ss = 0.f;
#pragma unroll
        for (int j = 0; j < 16; ++j) { res[j] = hf16[j] + cscale * (float)acc[j]; ss += res[j] * res[j]; }
        ss = wave_sum(ss);
        const float r3 = rsqrtf(ss * (1.0f / D_MODEL) + EPS);
        float* o = p.out + (size_t)t * D_MODEL + lane * 16;
#pragma unroll
        for (int i4 = 0; i4 < 4; ++i4) {
            float4 ov; ov.x = res[4 * i4] * r3 * g16[4 * i4]; ov.y = res[4 * i4 + 1] * r3 * g16[4 * i4 + 1]; ov.z = res[4 * i4 + 2] * r3 * g16[4 * i4 + 2]; ov.w = res[4 * i4 + 3] * r3 * g16[4 * i4 + 3];
            ((float4*)o)[i4] = ov;
        }
    }
#undef G2_ISSUE
}

namespace pg8 {
#define PG8_LAS __attribute__((address_space(3)))
constexpr int BM = 256, BK = 64, HALF = 128, HTB = HALF * BK * 2, STAGE_BYTES = 8 * HTB, NXCD = 8, WGM = 8;
__host__ __device__ __forceinline__ int lds_byte(int r, int c) { const int st = (r >> 4) * 2 + (c >> 5), rr = r & 15, cc = c & 31, ob = rr * 64 + cc * 2; return st * 1024 + (ob ^ (((ob >> 9) & 1) << 5)); }
__host__ __device__ __forceinline__ void stage_rc(int b, int& R, int& C) { const int st = b / 1024, sb = b % 1024, swz = sb ^ (((sb >> 9) & 1) << 5); R = (st >> 1) * 16 + swz / 64; C = (st & 1) * 32 + (swz % 64) / 2; }
__host__ __device__ __forceinline__ int perm32(int rho) { const int n = rho >> 4, i = rho & 15; return 8 * (i >> 2) + 4 * n + (i & 3); }
struct Unit { int pm, pn; };
struct Gemm { const bf16_t* A; const bf16_t* Bt; int M, N, K; };
struct StaticOrder {
    int nM, nN, nwg, G, c;
    __host__ __device__ void init(int M, int N, int G_, int c_) { nM = M / BM; nN = N / BM; nwg = nM * nN; G = G_; c = c_; }
    __host__ __device__ bool next(int i, Unit& u) const {
        const long L = (long)i * G + c; if (L >= nwg) return false;
        int wgid = (int)L; { const int q = nwg / NXCD, r = nwg % NXCD, xcd = wgid % NXCD, off = wgid / NXCD; wgid = (xcd < r ? xcd * (q + 1) : r * (q + 1) + (xcd - r) * q) + off; }
        const int nig = WGM * nN, gid = wgid / nig, fm = gid * WGM, gsz = (nM - fm) < WGM ? (nM - fm) : WGM;
        u.pm = fm + ((wgid % nig) % gsz); u.pn = (wgid % nig) / gsz; return true;
    }
    __device__ __forceinline__ void a_ready(const Unit&) const {}
    __device__ __forceinline__ void done(const Unit&) const {}
};
__device__ __forceinline__ unsigned cvt_pk_bf16(float lo, float hi) { unsigned r; asm volatile("v_cvt_pk_bf16_f32 %0, %1, %2" : "=v"(r) : "v"(lo), "v"(hi)); return r; }
template <bool I8> __device__ __forceinline__ typename std::conditional<I8, i32x4, f32x4>::type mma1(bf16x8 a, bf16x8 b, typename std::conditional<I8, i32x4, f32x4>::type c) {
    if constexpr (I8) return __builtin_amdgcn_mfma_i32_16x16x64_i8(*(const i32x4*)&a, *(const i32x4*)&b, c, 0, 0, 0);
    else return __builtin_amdgcn_mfma_f32_16x16x32_bf16(a, b, c, 0, 0, 0);
}
struct EpiZ8 {
    static constexpr bool PERM = true, AFTER_DRAIN = false, I8 = true; typedef i32x4 acc_t;
    bf16_t* O; const float* rsx; const unsigned* swb; float2* lnp;
    __device__ __forceinline__ void operator()(const i32x4 (&acc)[2][2][4][2], const Unit& u, int wr, int wc, int fr, int fq) const {
        const int row0 = u.pm * BM + wr * 64 + fr, col0 = u.pn * BM + wc * 32 + 8 * fq; const bool act = u.pn >= 2, vpart = u.pn >= 4;
        float sw[2][8];
#pragma unroll
        for (int bj = 0; bj < 2; ++bj) { const u32x4 a = *(const u32x4*)(swb + col0 + bj * HALF), c = *(const u32x4*)(swb + col0 + bj * HALF + 4);
#pragma unroll
            for (int i = 0; i < 4; ++i) { sw[bj][i] = __uint_as_float(a[i]) * (1.0f / 127.0f); sw[bj][4 + i] = __uint_as_float(c[i]) * (1.0f / 127.0f); } }
#pragma unroll
        for (int ai = 0; ai < 2; ++ai)
#pragma unroll
            for (int m = 0; m < 4; ++m) { const int r = row0 + ai * HALF + m * 16; const float sc = rsx[r]; bf16_t* rowp = O + (size_t)r * D_IN + col0;
                float s1 = 0.f, s2 = 0.f;
#pragma unroll
                for (int bj = 0; bj < 2; ++bj) { f32x4 v0, v1;
#pragma unroll
                    for (int i = 0; i < 4; ++i) { v0[i] = (float)acc[ai][bj][m][0][i] * sc * sw[bj][i]; v1[i] = (float)acc[ai][bj][m][1][i] * sc * sw[bj][4 + i]; }
                    if (act) { v0 = (f32x4){gelu_t(v0[0]), gelu_t(v0[1]), gelu_t(v0[2]), gelu_t(v0[3])}; v1 = (f32x4){gelu_t(v1[0]), gelu_t(v1[1]), gelu_t(v1[2]), gelu_t(v1[3])}; }
#pragma unroll
                    for (int i = 0; i < 4; ++i) { s1 += v0[i] + v1[i]; s2 += v0[i] * v0[i] + v1[i] * v1[i]; }
                    u32x4 w; w.x = cvt_pk_bf16(v0[0], v0[1]); w.y = cvt_pk_bf16(v0[2], v0[3]); w.z = cvt_pk_bf16(v1[0], v1[1]); w.w = cvt_pk_bf16(v1[2], v1[3]);
                    *(u32x4*)(rowp + bj * HALF) = w; }
                if (vpart) {
                    s1 += __shfl_xor(s1, 16); s2 += __shfl_xor(s2, 16); s1 += __shfl_xor(s1, 32); s2 += __shfl_xor(s2, 32);
                    if (fq == 0) lnp[(size_t)r * 8 + (u.pn - 4) * 4 + wc] = make_float2(s1, s2);
                } }
    }
};
struct EpiOut {
    static constexpr bool PERM = true, AFTER_DRAIN = false, I8 = false; typedef f32x4 acc_t;
    bf16_t* O; const signed char* X; const float* sx;
    __device__ __forceinline__ void operator()(const f32x4 (&acc)[2][2][4][2], const Unit& u, int wr, int wc, int fr, int fq) const {
        const int row0 = u.pm * BM + wr * 64 + fr, col0 = u.pn * BM + wc * 32 + 8 * fq;
#pragma unroll
        for (int ai = 0; ai < 2; ++ai)
#pragma unroll
            for (int m = 0; m < 4; ++m) { const int r = row0 + ai * HALF + m * 16; const size_t off = (size_t)r * D_MODEL + col0; const float sc = sx[r];
#pragma unroll
                for (int bj = 0; bj < 2; ++bj) { const u32x2 xx = *(const u32x2*)(X + off + bj * HALF);
                    f32x4 x0, x1;
#pragma unroll
                    for (int i = 0; i < 4; ++i) { x0[i] = (float)(signed char)(xx.x >> (8 * i)) * sc; x1[i] = (float)(signed char)(xx.y >> (8 * i)) * sc; }
                    const f32x4 v0 = acc[ai][bj][m][0] + x0, v1 = acc[ai][bj][m][1] + x1;
                    u32x4 w; w.x = cvt_pk_bf16(v0[0], v0[1]); w.y = cvt_pk_bf16(v0[2], v0[3]); w.z = cvt_pk_bf16(v1[0], v1[1]); w.w = cvt_pk_bf16(v1[2], v1[3]);
                    *(u32x4*)(O + off + bj * HALF) = w; } }
    }
};
struct OneUnit {
    Unit u;
    __device__ __forceinline__ bool next(int i, Unit& o) const { if (i) return false; o = u; return true; }
    __device__ __forceinline__ void a_ready(const Unit&) const {}
    __device__ __forceinline__ void done(const Unit&) const {}
};
#define QT_PITCH 272
#define QT_LDS_BYTES (2 * 256 * QT_PITCH)
struct EpiQTopk {
    static constexpr bool PERM = true, AFTER_DRAIN = true, I8 = true; typedef i32x4 acc_t;
    const bf16_t* keysB; int* idx; float* gate; const unsigned* swq;
    const Params* pp_;
    __device__ __forceinline__ void fused(i32x4 (&acc)[2][2][4][2], const Unit& u, int wr, int wc, int fr, int fq, PG8_LAS unsigned char* ldsp, int wid, int lane) const {
        char* sQ = (char*)ldsp;
        const int h = u.pn;
        float sw[2][8];
#pragma unroll
        for (int bj = 0; bj < 2; ++bj) { const u32x4 a = *(const u32x4*)(swq + u.pn * BM + bj * HALF + wc * 32 + 8 * fq), c = *(const u32x4*)(swq + u.pn * BM + bj * HALF + wc * 32 + 8 * fq + 4);
#pragma unroll
            for (int i = 0; i < 4; ++i) { sw[bj][i] = __uint_as_float(a[i]) * (1.0f / 127.0f); sw[bj][4 + i] = __uint_as_float(c[i]) * (1.0f / 127.0f); } }
#pragma unroll
        for (int ai = 0; ai < 2; ++ai)
#pragma unroll
            for (int m = 0; m < 4; ++m) { const int r = ai * HALF + wr * 64 + m * 16 + fr;
#pragma unroll
                for (int bj = 0; bj < 2; ++bj) { f32x4 v0, v1;
#pragma unroll
                    for (int i = 0; i < 4; ++i) { v0[i] = (float)acc[ai][bj][m][0][i] * sw[bj][i]; v1[i] = (float)acc[ai][bj][m][1][i] * sw[bj][4 + i]; }
                    u32x4 w; w.x = cvt_pk_bf16(v0[0], v0[1]); w.y = cvt_pk_bf16(v0[2], v0[3]); w.z = cvt_pk_bf16(v1[0], v1[1]); w.w = cvt_pk_bf16(v1[2], v1[3]);
                    *(u32x4*)(sQ + bj * (256 * QT_PITCH) + r * QT_PITCH + (wc * 32 + fq * 8) * 2) = w; } }
        __syncthreads();
        int cbv[4];
#pragma unroll
        for (int c = 0; c < 4; ++c) cbv[c] = kComb[4 * fr + c];
        int tA[2][4], tB[2][4];
#pragma unroll
        for (int m = 0; m < 2; ++m)
#pragma unroll
            for (int j = 0; j < 4; ++j) { tA[m][j] = 0; tB[m][j] = 0; }
        static_assert((T_TOK / 256) * 8 * 8 * 2 == NEXP, "units x waves x 2 must cover the expert table");
        const int qe0 = ((u.pm * 8 + u.pn) * 8 + wid) * 2;
        float4 qa4[2][4], qb4[2][4];
#pragma unroll 1
        for (int pp = 0; pp < 2; ++pp) {
            const bf16_t* kb = keysB + (size_t)(pp * 8 + h) * 16384 + lane * 8;
            const char* qa = sQ + pp * (256 * QT_PITCH) + (wid * 32 + fr) * QT_PITCH + fq * 16;
            f32x4 sc2[2][8];
#pragma unroll
            for (int m = 0; m < 2; ++m)
#pragma unroll
                for (int nb = 0; nb < 8; ++nb) sc2[m][nb] = (f32x4){0.f, 0.f, 0.f, 0.f};
#pragma unroll
            for (int kk = 0; kk < 4; ++kk) {
                bf16x8 kf[8], af[2];
#pragma unroll
                for (int nb = 0; nb < 8; ++nb) kf[nb] = *(const bf16x8*)(kb + (kk * 8 + nb) * 512);
#pragma unroll
                for (int m = 0; m < 2; ++m) af[m] = *(const bf16x8*)(qa + m * 16 * QT_PITCH + kk * 64);
#pragma unroll
                for (int m = 0; m < 2; ++m)
#pragma unroll
                    for (int nb = 0; nb < 8; ++nb) sc2[m][nb] = __builtin_amdgcn_mfma_f32_16x16x32_bf16(af[m], kf[nb], sc2[m][nb], 0, 0, 0);
            }
#pragma unroll
            for (int m = 0; m < 2; ++m)
#pragma unroll
                for (int j = 0; j < 4; ++j) tA[m][j] = tB[m][j];
            if (pp == 1) {
#pragma unroll
                for (int x = 0; x < 2; ++x) {
                    const float4* su4 = (const float4*)(pp_->peer_u + (size_t)(qe0 + x) * D_MODEL + lane * 16);
                    const float4* sv4 = (const float4*)(pp_->peer_v + (size_t)(qe0 + x) * D_MODEL + lane * 16);
#pragma unroll
                    for (int i = 0; i < 4; ++i) { qa4[x][i] = su4[i]; qb4[x][i] = sv4[i]; }
                }
            }
#pragma unroll 2
            for (int it = 0; it < 4; ++it) {
#pragma unroll
                for (int m = 0; m < 2; ++m) {
                    int k[8];
#pragma unroll
                    for (int nb = 0; nb < 8; ++nb) k[nb] = (f2key(sc2[m][nb][0]) & ~127) | (127 - (16 * nb + fr));
                    const int r = top16_rows(k, fr);
                    tB[m][0] = tB[m][1]; tB[m][1] = tB[m][2]; tB[m][2] = tB[m][3]; tB[m][3] = r;
#pragma unroll
                    for (int nb = 0; nb < 8; ++nb) sc2[m][nb] = (f32x4){sc2[m][nb][1], sc2[m][nb][2], sc2[m][nb][3], sc2[m][nb][0]};
                }
            }
        }
#pragma unroll 2
        for (int it = 0; it < 4; ++it) {
#pragma unroll
            for (int m = 0; m < 2; ++m) {
                int eid; float gt;
                combine16(tA[m][0], tB[m][0], cbv, lane, fr, eid, gt);
                const int t = u.pm * BM + wid * 32 + m * 16 + fq * 4 + it;
                const size_t o = (size_t)t * 128 + h * 16 + fr;
                idx[o] = eid; gate[o] = gt;
                tA[m][0] = tA[m][1]; tA[m][1] = tA[m][2]; tA[m][2] = tA[m][3];
                tB[m][0] = tB[m][1]; tB[m][1] = tB[m][2]; tB[m][2] = tB[m][3];
            }
        }
        quant_expert(*pp_, qe0, lane, qa4[0], qb4[0]);
        quant_expert(*pp_, qe0 + 1, lane, qa4[1], qb4[1]);
        __syncthreads();
    }
};
template <class Epi, class Sched>
__device__ __forceinline__ void gemm_phase(PG8_LAS unsigned char* lds, const Gemm g, const Sched& S, const Epi& E) {
    const int tid = tid_opaque(), wid = __builtin_amdgcn_readfirstlane(tid >> 6), lane = tid & 63, wr = wid >> 2, wc = wid & 3, fr = lane & 15, fq = lane >> 4;
    const int K = g.K, nt = K / BK;
    unsigned voffA[2], voffB[2];
#pragma unroll
    for (int i = 0; i < 2; ++i) { int R, C; stage_rc(tid * 16 + i * 8192, R, C); const int Rb = Epi::PERM ? ((R & ~31) + perm32(R & 31)) : R;
        voffA[i] = (unsigned)(R * K + C) * 2u; voffB[i] = (unsigned)(Rb * K + C) * 2u; }
    const size_t kstep = (size_t)(BK * 2);
    const size_t hstep = (size_t)HALF * K * 2;
    const size_t tstep = 2 * hstep;
    const unsigned ldsw = (unsigned)wid * 1024u;
    const int aoff = lds_byte(wr * 64 + fr, fq * 8), boff = lds_byte(wc * 32 + fr, fq * 8);
#define PG8_SA(b, h) (((b) * 2 + (h)) * HTB)
#define PG8_SB(b, h) ((4 + (b) * 2 + (h)) * HTB)
#define PG8_STAGE(bufoff, gbase, voff) do { _Pragma("unroll") for (int _i = 0; _i < 2; ++_i) \
        __builtin_amdgcn_global_load_lds((const unsigned*)((const char*)(gbase) + (voff)[_i]), (PG8_LAS unsigned*)(lds + (bufoff) + ldsw + _i * 8192), 16, 0, 0); } while (0)
#define PG8_LDA(dst, b, h) do { _Pragma("unroll") for (int m = 0; m < 4; ++m) _Pragma("unroll") for (int k = 0; k < 2; ++k) dst[m][k] = *(const PG8_LAS bf16x8*)(lds + PG8_SA(b, h) + aoff + m * 2048 + k * 1024); } while (0)
#define PG8_LDB(dst, b, h) do { _Pragma("unroll") for (int n = 0; n < 2; ++n) _Pragma("unroll") for (int k = 0; k < 2; ++k) dst[n][k] = *(const PG8_LAS bf16x8*)(lds + PG8_SB(b, h) + boff + n * 2048 + k * 1024); } while (0)
#define PG8_MMA(ai, bj, At, Bt) do { __builtin_amdgcn_s_setprio(1); _Pragma("unroll") for (int m = 0; m < 4; ++m) _Pragma("unroll") for (int n = 0; n < 2; ++n) _Pragma("unroll") for (int k = 0; k < 2; ++k) \
        acc[ai][bj][m][n] = mma1<Epi::I8>(Bt[n][k], At[m][k], acc[ai][bj][m][n]); __builtin_amdgcn_s_setprio(0); } while (0)
#define PG8_WAIT_V(n) asm volatile("s_waitcnt vmcnt(" #n ")" ::: "memory")
#define PG8_WAIT_L(n) asm volatile("s_waitcnt lgkmcnt(" #n ")" ::: "memory")
#define PG8_BAR __builtin_amdgcn_s_barrier()
#define PG8_SCHED __builtin_amdgcn_sched_barrier(0)
    Unit cur, nxt; int ui = 0;
    if (!S.next(0, cur)) return;
    typedef typename Epi::acc_t acc_t;
    acc_t acc[2][2][4][2];
#pragma unroll
    for (int a = 0; a < 2; ++a)
#pragma unroll
        for (int b = 0; b < 2; ++b)
#pragma unroll
            for (int m = 0; m < 4; ++m)
#pragma unroll
                for (int n = 0; n < 2; ++n) acc[a][b][m][n] = (acc_t)(0);
    bf16x8 At[4][2], B0[2][2], B1[2][2];
    const char* cA = (const char*)g.A + (size_t)cur.pm * tstep; const char* cB = (const char*)g.Bt + (size_t)cur.pn * tstep;
    S.a_ready(cur);
    PG8_STAGE(PG8_SB(0, 0), cB, voffB); PG8_STAGE(PG8_SA(0, 0), cA, voffA); PG8_STAGE(PG8_SB(0, 1), cB + hstep, voffB); PG8_STAGE(PG8_SA(0, 1), cA + hstep, voffA);
    if (wr == 1) PG8_BAR;
    PG8_WAIT_V(4); PG8_BAR;
    PG8_STAGE(PG8_SB(1, 0), cB + kstep, voffB); PG8_STAGE(PG8_SA(1, 0), cA + kstep, voffA); PG8_STAGE(PG8_SB(1, 1), cB + hstep + kstep, voffB);
    PG8_WAIT_V(6); PG8_BAR;
    for (;;) {
        const bool has_next = S.next(ui + 1, nxt);
        const char* nA = has_next ? (const char*)g.A + (size_t)nxt.pm * tstep : cA; const char* nB = has_next ? (const char*)g.Bt + (size_t)nxt.pn * tstep : cB;
        for (int t = 0; t < nt; t += 2) {
            const bool last = (t == nt - 2);
            const char* a1 = cA + (size_t)(t + 1) * kstep;
            const char* a2 = last ? nA : cA + (size_t)(t + 2) * kstep; const char* b2 = last ? nB : cB + (size_t)(t + 2) * kstep;
            const char* a3 = a2 + kstep; const char* b3 = b2 + kstep;
            if (last && has_next) S.a_ready(nxt);
            PG8_LDB(B0, 0, 0); PG8_SCHED; PG8_LDA(At, 0, 0); PG8_STAGE(PG8_SA(1, 1), a1 + hstep, voffA);
            PG8_WAIT_L(8); PG8_BAR; PG8_WAIT_L(0); PG8_MMA(0, 0, At, B0); PG8_BAR; PG8_SCHED;
            PG8_LDB(B1, 0, 1); PG8_STAGE(PG8_SB(0, 0), b2, voffB);
            PG8_BAR; PG8_WAIT_L(0); PG8_MMA(0, 1, At, B1); PG8_BAR;
            PG8_LDA(At, 0, 1); PG8_STAGE(PG8_SA(0, 0), a2, voffA);
            PG8_BAR; PG8_WAIT_L(0); PG8_MMA(1, 0, At, B0); PG8_BAR; PG8_SCHED;
            PG8_STAGE(PG8_SB(0, 1), b2 + hstep, voffB);
            PG8_WAIT_V(6); PG8_BAR; PG8_MMA(1, 1, At, B1); PG8_BAR;
            PG8_LDB(B0, 1, 0); PG8_SCHED; PG8_LDA(At, 1, 0); PG8_STAGE(PG8_SA(0, 1), a2 + hstep, voffA);
            PG8_WAIT_L(8); PG8_BAR; PG8_WAIT_L(0); PG8_MMA(0, 0, At, B0); PG8_BAR; PG8_SCHED;
            PG8_LDB(B1, 1, 1); PG8_STAGE(PG8_SB(1, 0), b3, voffB);
            PG8_BAR; PG8_WAIT_L(0); PG8_MMA(0, 1, At, B1); PG8_BAR;
            PG8_LDA(At, 1, 1); PG8_STAGE(PG8_SA(1, 0), a3, voffA);
            PG8_BAR; PG8_WAIT_L(0); PG8_MMA(1, 0, At, B0); PG8_BAR; PG8_SCHED;
            PG8_STAGE(PG8_SB(1, 1), b3 + hstep, voffB);
            PG8_WAIT_V(6); PG8_BAR; PG8_MMA(1, 1, At, B1); PG8_BAR;
        }
            if constexpr (!Epi::AFTER_DRAIN) { E(acc, cur, wr, wc, fr, fq); S.done(cur); }
            if (!has_next) break;
#pragma unroll
        for (int a = 0; a < 2; ++a)
#pragma unroll
            for (int b = 0; b < 2; ++b)
#pragma unroll
                for (int m = 0; m < 4; ++m)
#pragma unroll
                    for (int n = 0; n < 2; ++n) acc[a][b][m][n] = (acc_t)(0);
        cur = nxt; cA = nA; cB = nB; ++ui;
    }
    PG8_WAIT_V(0);
    if (wr == 0) PG8_BAR;
    PG8_BAR;
    if constexpr (Epi::AFTER_DRAIN) { E.fused(acc, cur, wr, wc, fr, fq, lds, wid, lane); S.done(cur); }
#undef PG8_SA
#undef PG8_SB
#undef PG8_STAGE
#undef PG8_LDA
#undef PG8_LDB
#undef PG8_MMA
#undef PG8_WAIT_V
#undef PG8_WAIT_L
#undef PG8_BAR
#undef PG8_SCHED
}
}

__device__ void phase_gemm_z(const Params& p, char* lds) {
    pg8::StaticOrder S; S.init(T_TOK, D_IN, gridDim.x, blockIdx.x);
    pg8::gemm_phase<pg8::EpiZ8, pg8::StaticOrder>((PG8_LAS unsigned char*)lds, pg8::Gemm{(const bf16_t*)p.xq, (const bf16_t*)p.winT8, T_TOK, D_IN, D_MODEL / 2}, S, pg8::EpiZ8{p.zb, p.rstd1, p.swb, p.lnp});
}
__device__ void phase_gemm_out(const Params& p, char* lds) {
    pg8::StaticOrder S; S.init(T_TOK, D_MODEL, gridDim.x, blockIdx.x);
    pg8::gemm_phase<pg8::EpiOut, pg8::StaticOrder>((PG8_LAS unsigned char*)lds, pg8::Gemm{p.cB, p.woutT, T_TOK, D_MODEL, D_MODEL}, S, pg8::EpiOut{p.hb, p.xq, p.sx});
}
__device__ void phase_gemm_q(const Params& p, char* lds) {
    pg8::StaticOrder S; S.init(T_TOK, 2048, gridDim.x, blockIdx.x);
    pg8::Unit u;
    for (int i = 0; S.next(i, u); ++i)
        pg8::gemm_phase<pg8::EpiQTopk, pg8::OneUnit>((PG8_LAS unsigned char*)lds, pg8::Gemm{(const bf16_t*)p.hq, (const bf16_t*)p.wqT8, T_TOK, 2048, D_MODEL / 2}, pg8::OneUnit{u}, pg8::EpiQTopk{p.keysB, p.idx, p.gate, p.swq, &p});
}

#define XB_TMO      128
#define XB_XCNT(j)  (256  + 64 * (j))
#define XB_XSUB(j)  (1280 + 64 * (j))
#define XB_XGEN(j)  (2304 + 64 * (j))
#define XB_TOP      3328
#define XB_TOPGEN   3392
#define XCD_BAR_WORDS 3456
#define XB_SPIN_CAP (1u << 20)
__device__ __forceinline__ unsigned xb_ld(unsigned* p)              { return __hip_atomic_load(p, __ATOMIC_RELAXED, __HIP_MEMORY_SCOPE_AGENT); }
__device__ __forceinline__ unsigned xb_add(unsigned* p, unsigned v) { return __hip_atomic_fetch_add(p, v, __ATOMIC_RELAXED, __HIP_MEMORY_SCOPE_AGENT); }
__device__ __forceinline__ unsigned xb_xcc_id() { return (unsigned)__builtin_amdgcn_s_getreg((3 << 11) | 20) & 0xFu; }
#define XB_SPIN(cond, bar) do { unsigned _sp = 0; while (cond) { __builtin_amdgcn_s_sleep(1); \
    if ((++_sp & 255u) == 0u) { if (xb_ld(&(bar)[XB_TMO])) break; if (_sp > XB_SPIN_CAP) { atomicAdd(&(bar)[XB_TMO], 1u); break; } } } } while (0)
struct XcdBarrier { unsigned* bar; unsigned x; volatile LAS unsigned* st; };
__device__ __forceinline__ XcdBarrier xcd_barrier_post(unsigned* bar, volatile LAS unsigned* st) {
    XcdBarrier b; b.bar = bar; b.x = xb_xcc_id(); b.st = st;
    if (threadIdx.x == 0) (void)xb_add(&bar[XB_XCNT(b.x)], 1u);
    return b;
}
__device__ __forceinline__ void xcd_barrier_complete(unsigned* bar, unsigned x, unsigned& nloc, unsigned& nx) {
    const unsigned G = gridDim.x * gridDim.y * gridDim.z;
    unsigned sum, cnt, mine, sp = 0u;
    for (;;) {
        sum = 0u; cnt = 0u; mine = 0u;
#pragma unroll
        for (unsigned j = 0; j < 16; ++j) { const unsigned c = xb_ld(&bar[XB_XCNT(j)]); sum += c; cnt += (c > 0u) ? 1u : 0u; mine = (j == x) ? c : mine; }
        if (sum == G) break;
        __builtin_amdgcn_s_sleep(1);
        if ((++sp & 255u) == 0u) { if (xb_ld(&bar[XB_TMO])) break; if (sp > XB_SPIN_CAP) { atomicAdd(&bar[XB_TMO], 1u); break; } }
    }
    nloc = mine > 0u ? mine : 1u; nx = cnt > 0u ? cnt : 1u;
}
__device__ __forceinline__ void xcd_barrier(const XcdBarrier& b) {
    asm volatile("s_waitcnt vmcnt(0)" ::: "memory");
    __syncthreads();
    if (threadIdx.x == 0) {
        unsigned* bar = b.bar;
        __builtin_amdgcn_s_waitcnt(0);
        unsigned nloc = b.st[0], nx = b.st[1];
        if (nloc == 0u) { xcd_barrier_complete(bar, b.x, nloc, nx); b.st[0] = nloc; b.st[1] = nx; }
        const unsigned old = xb_add(&bar[XB_XSUB(b.x)], 1u);
        const unsigned gen = old / nloc;
        if (old + 1u == (gen + 1u) * nloc) {
            __builtin_amdgcn_fence(__ATOMIC_RELEASE, "agent");
            asm volatile("s_waitcnt vmcnt(0)" ::: "memory");
            const unsigned og = xb_add(&bar[XB_TOP], 1u);
            const unsigned tg = og / nx;
            if (og + 1u == (tg + 1u) * nx) xb_add(&bar[XB_TOPGEN], 1u);
            else XB_SPIN(xb_ld(&bar[XB_TOPGEN]) == tg, bar);
            __builtin_amdgcn_fence(__ATOMIC_ACQUIRE, "agent");
            xb_add(&bar[XB_XGEN(b.x)], 1u);
            asm volatile("s_waitcnt vmcnt(0)" ::: "memory");
        } else {
            XB_SPIN(xb_ld(&bar[XB_XGEN(b.x)]) == gen, bar);
            __builtin_amdgcn_fence(__ATOMIC_ACQUIRE, "agent");
            asm volatile("s_waitcnt vmcnt(0)" ::: "memory");
        }
    }
    __syncthreads();
}

#define MEGA_LDS_MAX2(a, b) ((a) > (b) ? (a) : (b))
#define MEGA_LDS_MAIN MEGA_LDS_MAX2(MEGA_LDS_MAX2(QT_LDS_BYTES, pg8::STAGE_BYTES), MEGA_LDS_MAX2(8 * TS_WBYTES, 2 * MIXH_LDS))
#define MEGA_LDS_BYTES (MEGA_LDS_MAIN + 16)
extern __shared__ __attribute__((aligned(16))) char smem[];
__global__ void __launch_bounds__(512, 2) fwd_mega(Params p) {
    volatile LAS unsigned* st = (volatile LAS unsigned*)(smem + MEGA_LDS_MAIN);
    if (threadIdx.x < 4) st[threadIdx.x] = 0u;
    __syncthreads();
    const XcdBarrier xb = xcd_barrier_post(p.bar, st);
    phase_prep(p, smem);      xcd_barrier(xb);
    phase_gemm_z(p, smem);    xcd_barrier(xb);
    phase_mix_gemm(p, smem);  xcd_barrier(xb);
    phase_gemm_out(p, smem);  xcd_barrier(xb);
    phase_hquant(p, smem);    xcd_barrier(xb);
    phase_gemm_q(p, smem);    xcd_barrier(xb);
    phase_peer_dots(p, smem); xcd_barrier(xb);
    phase_gather(p, smem);
}

extern "C" void kernel_launch(void* const* d_in, const int* in_sizes, int n_in, void* d_out, int out_size, void* d_ws, size_t ws_size, hipStream_t stream) {
    static int grid_blocks = 0;
    if (grid_blocks == 0) {
        int dev = 0, cus = 0, per_cu = 0;
        (void)hipGetDevice(&dev);
        (void)hipDeviceGetAttribute(&cus, hipDeviceAttributeMultiprocessorCount, dev);
        (void)hipFuncSetAttribute((const void*)fwd_mega, hipFuncAttributeMaxDynamicSharedMemorySize, MEGA_LDS_BYTES);
        (void)hipOccupancyMaxActiveBlocksPerMultiprocessor(&per_cu, (const void*)fwd_mega, 512, MEGA_LDS_BYTES);
        if (per_cu > 1) per_cu = 1;
        if (per_cu < 1) per_cu = 1;
        grid_blocks = cus * per_cu;
    }
    Params p{};
    p.x = (const float*)d_in[0]; p.norm1_g = (const float*)d_in[1]; p.w_in = (const float*)d_in[2]; p.pool_w = (const float*)d_in[3];
    p.pool_scale = (const float*)d_in[4]; p.sgu_norm_g = (const float*)d_in[5]; p.sgu_w = (const float*)d_in[6]; p.sgu_b = (const float*)d_in[7];
    p.w_out = (const float*)d_in[8]; p.norm2_g = (const float*)d_in[9]; p.peer_wq = (const float*)d_in[10]; p.peer_keys = (const float*)d_in[11];
    p.peer_u = (const float*)d_in[12]; p.peer_v = (const float*)d_in[13]; p.final_g = (const float*)d_in[14];
    p.out = (float*)d_out;
    char* w = (char*)d_ws; size_t off = 0;
    auto take = [&](size_t bytes) { char* r = w + off; off += (bytes + 255) & ~(size_t)255; return r; };
    const size_t MiB = 1024 * 1024;
    p.u8 = (unsigned char*)take(16 * MiB); p.v8 = (unsigned char*)take(12 * MiB);
    p.suv = (float2*)take(128 * 1024);
    p.woutT = (bf16_t*)take(2 * MiB);
    p.poolT = (bf16_t*)take(128 * 1024); p.wsM = (bf16_t*)take(128 * 1024); p.keysB = (bf16_t*)take(512 * 1024);
    p.bar = (unsigned*)take(XCD_BAR_WORDS * 4 + 4608 * 4); p.swb = p.bar + XCD_BAR_WORDS; p.swq = p.swb + 2048;
    p.rstd1 = (float*)take(128 * 1024); p.sx = (float*)take(128 * 1024); p.xq = (signed char*)take(32 * MiB); p.winT8 = (signed char*)take(1536 * 1024); p.wqT8 = (signed char*)take(2048 * 1024); p.hq = (signed char*)take(32 * MiB); p.hsc = (float*)take(128 * 1024);
    p.idx = (int*)take(16 * MiB); p.gate = (float*)take(16 * MiB); p.coef = (float*)take(16 * MiB);
    p.lnp = (float2*)take(2 * MiB); p.zb = (bf16_t*)take(96 * MiB); p.cB = (bf16_t*)take(64 * MiB); p.hb = (bf16_t*)take(64 * MiB);
    (void)hipMemsetAsync(p.bar, 0, XCD_BAR_WORDS * 4 + 4608 * 4, stream);
    hipLaunchKernelGGL(fwd_mega, dim3(grid_blocks), dim3(512), MEGA_LDS_BYTES, stream, p);
}
```

```cpp
#include <hip/hip_runtime.h>
#include <stdint.h>
#include <type_traits>

typedef unsigned short bf16_t;
typedef short bf16x8 __attribute__((ext_vector_type(8)));
typedef float f32x4 __attribute__((ext_vector_type(4)));
typedef unsigned u32x4 __attribute__((ext_vector_type(4)));
typedef unsigned u32x2 __attribute__((ext_vector_type(2)));
typedef unsigned u32x3 __attribute__((ext_vector_type(3)));
typedef int i32x4 __attribute__((ext_vector_type(4)));
#define ROWB 768
typedef __bf16 bf2_t __attribute__((ext_vector_type(2)));
#define LAS __attribute__((address_space(3)))

#define T_TOK 32768
#define D_MODEL 1024
#define D_IN 1536
#define SEQ 2048
#define NEXP 16384
#define EPS 1e-6f

struct Params {
    const float *x, *norm1_g, *w_in, *pool_w, *pool_scale, *sgu_norm_g, *sgu_w, *sgu_b, *w_out, *norm2_g, *peer_wq, *peer_keys, *peer_u, *peer_v, *final_g;
    float* out;
    bf16_t *woutT, *poolT, *wsM, *keysB;
    unsigned char *u8, *v8;
    float2* suv;
    float *rstd1, *sx;
    signed char *xq, *winT8, *hq, *wqT8; unsigned *swb, *swq; float* hsc;
    bf16_t *zb, *cB, *hb;
    float2* lnp;
    int* idx; float* gate; float* coef;
    unsigned* bar;
};

__device__ __forceinline__ int tid_opaque() { int t = (int)threadIdx.x; asm volatile("" : "+v"(t)); return t; }
__device__ __forceinline__ unsigned short f2bf(float f) {
    unsigned u = __float_as_uint(f);
    u += 0x7fffu + ((u >> 16) & 1u);
    return (unsigned short)(u >> 16);
}
__device__ __forceinline__ float bf2f(unsigned short h) { return __uint_as_float(((unsigned)h) << 16); }
__device__ __forceinline__ unsigned pack2(float a, float b) { return (unsigned)f2bf(a) | ((unsigned)f2bf(b) << 16); }
__device__ __forceinline__ float bflo(unsigned w) { return __uint_as_float(w << 16); }
__device__ __forceinline__ float bfhi(unsigned w) { return __uint_as_float(w & 0xffff0000u); }
__device__ __forceinline__ float gelu_t(float x) {
    const float y = 1.5957691216057308f * (x + 0.044715f * x * x * x);
    return x * __builtin_amdgcn_rcpf(1.0f + __expf(-y));
}
__device__ __forceinline__ float wave_sum(float v) {
#pragma unroll
    for (int o = 32; o >= 1; o >>= 1) v += __shfl_xor(v, o);
    return v;
}
__device__ __forceinline__ float wave_max(float v) {
#pragma unroll
    for (int o = 32; o >= 1; o >>= 1) v = fmaxf(v, __shfl_xor(v, o));
    return v;
}

#define GEMM_LDS_BYTES (2 * 128 * 144)
__device__ __forceinline__ void transpose_tile(const int tid, const float* __restrict__ src, bf16_t* __restrict__ dst, int R, int C, const float* __restrict__ rscale, int tile, float* lds) {
    const int tilesC = C / 64, tr = tile / tilesC, tc = tile % tilesC;
    const int ty = tid >> 6, tx = tid & 63;
    __syncthreads();
#pragma unroll
    for (int i = 0; i < 16; ++i) {
        const int r = ty + 4 * i;
        float v = src[(size_t)(tr * 64 + r) * C + tc * 64 + tx];
        if (rscale) v *= rscale[tr * 64 + r];
        lds[r * 65 + tx] = v;
    }
    __syncthreads();
#pragma unroll
    for (int i = 0; i < 16; ++i) {
        const int c = ty + 4 * i;
        dst[(size_t)(tc * 64 + c) * R + tr * 64 + tx] = f2bf(lds[tx * 65 + c]);
    }
}

__device__ __forceinline__ void w8_colmax(const float* __restrict__ src, const float* __restrict__ gain, int C, unsigned* mx, unsigned* cnt, int hb2, int nh, int ht) {
    const int ncb = C / 64;
    for (int t = hb2; t < 16 * ncb; t += nh) {
        const int tr = t / ncb, tc = t % ncb, ty = ht >> 6, tx = ht & 63;
        float am = 0.f;
#pragma unroll
        for (int i = 0; i < 16; ++i) { const int r = tr * 64 + ty + 4 * i; am = fmaxf(am, fabsf(src[(size_t)r * C + tc * 64 + tx] * gain[r])); }
        (void)__hip_atomic_fetch_max(mx + tc * 64 + tx, __float_as_uint(am), __ATOMIC_RELAXED, __HIP_MEMORY_SCOPE_AGENT);
        asm volatile("s_waitcnt vmcnt(0)" ::: "memory");
        __syncthreads();
        if (ht == 0) (void)__hip_atomic_fetch_add(cnt + tc, 1u, __ATOMIC_RELAXED, __HIP_MEMORY_SCOPE_AGENT);
    }
}
__device__ __forceinline__ void w8_tiles(const float* __restrict__ src, const float* __restrict__ gain, int C, signed char* __restrict__ dst, unsigned* mx, unsigned* cnt, char* lds, int tid) {
    const int half = tid >> 8, ht = tid & 255, ty = ht >> 6, tx = ht & 63, ncb = C / 64;
    float* fl = (float*)(lds + half * (64 * 65 * 4));
    for (int t = 2 * blockIdx.x + half; t < 16 * ncb; t += 2 * gridDim.x) {
        const int tr = t / ncb, tc = t % ncb;
        if (ht == 0) {
            unsigned spins = 0;
            while (__hip_atomic_load(cnt + tc, __ATOMIC_RELAXED, __HIP_MEMORY_SCOPE_AGENT) < 16u && ++spins < (1u << 22)) __builtin_amdgcn_s_sleep(2);
        }
        __syncthreads();
#pragma unroll
        for (int i = 0; i < 16; ++i) { const int r = ty + 4 * i; fl[r * 65 + tx] = src[(size_t)(tr * 64 + r) * C + tc * 64 + tx] * gain[tr * 64 + r]; }
        __syncthreads();
#pragma unroll
        for (int i = 0; i < 16; ++i) {
            const int c = ty + 4 * i;
            const float am = __uint_as_float(__hip_atomic_load(mx + tc * 64 + c, __ATOMIC_RELAXED, __HIP_MEMORY_SCOPE_AGENT));
            const float inv = am > 0.f ? 127.0f / am : 0.f;
            dst[(size_t)(tc * 64 + c) * 1024 + tr * 64 + tx] = (signed char)(int)rintf(fl[tx * 65 + c] * inv);
        }
    }
}

__device__ __forceinline__ void quant_expert(const Params& p, const int e, const int lane, const float4 (&a4)[4], const float4 (&b4)[4]) {
    float fu[16], fv[16];
#pragma unroll
    for (int i = 0; i < 4; ++i) {
        const float4 g = ((const float4*)(p.norm2_g + lane * 16))[i];
        fu[4 * i] = a4[i].x * g.x; fu[4 * i + 1] = a4[i].y * g.y; fu[4 * i + 2] = a4[i].z * g.z; fu[4 * i + 3] = a4[i].w * g.w;
        fv[4 * i] = b4[i].x; fv[4 * i + 1] = b4[i].y; fv[4 * i + 2] = b4[i].z; fv[4 * i + 3] = b4[i].w;
    }
    {
        float am = 0.f;
#pragma unroll
        for (int j = 0; j < 16; ++j) am = fmaxf(am, fabsf(fu[j]));
        am = wave_max(am);
        const float inv = am > 0.f ? 127.0f / am : 0.f;
        u32x4 o;
#pragma unroll
        for (int i = 0; i < 4; ++i) {
            unsigned w = 0;
#pragma unroll
            for (int k = 0; k < 4; ++k) w |= (unsigned)(((int)rintf(fu[4 * i + k] * inv)) & 0xff) << (8 * k);
            o[i] = w;
        }
        *(u32x4*)(p.u8 + (size_t)e * D_MODEL + lane * 16) = o;
        if (lane == 0) p.suv[e].x = am * (1.0f / 127.0f);
    }
    {
        float am = 0.f;
#pragma unroll
        for (int j = 0; j < 16; ++j) am = fmaxf(am, fabsf(fv[j]));
        am = wave_max(am);
        const float inv = am > 0.f ? 31.0f / am : 0.f;
        int q[16];
#pragma unroll
        for (int j = 0; j < 16; ++j) q[j] = (int)rintf(fv[j] * inv) + 32;
        unsigned dg[3][4];
#pragma unroll
        for (int k = 0; k < 4; ++k) {
            int ee = q[12 + k] - 42;
#pragma unroll
            for (int i = 0; i < 3; ++i) { const int d = ee & 3, D = d >= 2 ? d - 4 : d; dg[i][k] = (unsigned)d; ee = (ee - D) >> 2; }
        }
        u32x3 o;
#pragma unroll
        for (int i = 0; i < 3; ++i) {
            unsigned w = 0;
#pragma unroll
            for (int k = 0; k < 4; ++k) w |= (unsigned)(q[4 * i + k] | (dg[i][k] << 6)) << (8 * k);
            o[i] = w;
        }
        *(u32x3*)(p.v8 + (size_t)e * ROWB + lane * 12) = o;
        if (lane == 0) p.suv[e].y = am * (1.0f / 31.0f);
    }
}

__device__ void phase_prep(const Params& p, char* lds) {
    const int tidx_ = tid_opaque();
    const int nb = gridDim.x, b = blockIdx.x, tid = tidx_;
    const int half = tid >> 8, ht = tid & 255, nh = 2 * nb, hb2 = 2 * b + half;
    float* fl = (float*)(lds + half * (64 * 65 * 4));
    w8_colmax(p.w_in, p.norm1_g, 1536, p.swb, p.swb + 1536, hb2, nh, ht);
    w8_colmax(p.peer_wq, p.norm2_g, 2048, p.swq, p.swq + 2048, hb2, nh, ht);
    for (int t = hb2; t < 16 * 16; t += nh) transpose_tile(ht, p.w_out, p.woutT, 1024, 1024, nullptr, t, fl);
    for (int t = hb2; t < 16; t += nh) transpose_tile(ht, p.pool_w + (size_t)(t >> 2) * 16384, p.poolT + (size_t)(t >> 2) * 16384, 128, 128, nullptr, t & 3, fl);
    const size_t gtid = (size_t)b * blockDim.x + tid, gsz = (size_t)nb * blockDim.x;
    for (size_t i = gtid; i < 4 * 128 * 128; i += gsz) {
        const int j = (int)(i & 127), ii = (int)((i >> 7) & 127);
        const bool keep = (j >> 6) <= (ii >> 6);
        p.wsM[i] = keep ? f2bf(p.sgu_w[i]) : (bf16_t)0;
    }
    for (size_t o = gtid; o < 2 * 8 * 128 * 128; o += gsz) {
        const int j = (int)(o & 7), ln = (int)((o >> 3) & 63), nb = (int)((o >> 9) & 7), kk = (int)((o >> 12) & 3), ph = (int)(o >> 14);
        p.keysB[o] = f2bf(p.peer_keys[(size_t)ph * 16384 + (size_t)(16 * nb + (ln & 15)) * 128 + 32 * kk + 8 * (ln >> 4) + j]);
    }
    const int wave = (b * blockDim.x + tid) >> 6, nwaves = (nb * blockDim.x) >> 6, lane = tid & 63;
    for (int t = wave; t < T_TOK; t += 2 * nwaves) {
        const int t1 = t + nwaves; const bool two = t1 < T_TOK;
        const float4* xr0 = (const float4*)(p.x + (size_t)t * D_MODEL);
        const float4* xr1 = (const float4*)(p.x + (size_t)(two ? t1 : t) * D_MODEL);
        float4 v0[4], v1[4];
#pragma unroll
        for (int i = 0; i < 4; ++i) { v0[i] = xr0[lane + 64 * i]; v1[i] = xr1[lane + 64 * i]; }
        float s0 = 0.f, s1 = 0.f, a0 = 0.f, a1 = 0.f;
#pragma unroll
        for (int i = 0; i < 4; ++i) {
            s0 += v0[i].x * v0[i].x + v0[i].y * v0[i].y + v0[i].z * v0[i].z + v0[i].w * v0[i].w;
            s1 += v1[i].x * v1[i].x + v1[i].y * v1[i].y + v1[i].z * v1[i].z + v1[i].w * v1[i].w;
            a0 = fmaxf(fmaxf(a0, fmaxf(fabsf(v0[i].x), fabsf(v0[i].y))), fmaxf(fabsf(v0[i].z), fabsf(v0[i].w)));
            a1 = fmaxf(fmaxf(a1, fmaxf(fabsf(v1[i].x), fabsf(v1[i].y))), fmaxf(fabsf(v1[i].z), fabsf(v1[i].w)));
        }
        s0 = wave_sum(s0); s1 = wave_sum(s1); a0 = wave_max(a0); a1 = wave_max(a1);
        const float i0 = a0 > 0.f ? 127.0f / a0 : 0.f, i1 = a1 > 0.f ? 127.0f / a1 : 0.f;
#pragma unroll
        for (int i = 0; i < 4; ++i) {
            const unsigned q0 = ((unsigned)((int)rintf(v0[i].x * i0) & 0xff)) | ((unsigned)((int)rintf(v0[i].y * i0) & 0xff) << 8) | ((unsigned)((int)rintf(v0[i].z * i0) & 0xff) << 16) | ((unsigned)((int)rintf(v0[i].w * i0) & 0xff) << 24);
            ((unsigned*)(p.xq + (size_t)t * D_MODEL))[lane + 64 * i] = q0;
            if (two) {
                const unsigned q1 = ((unsigned)((int)rintf(v1[i].x * i1) & 0xff)) | ((unsigned)((int)rintf(v1[i].y * i1) & 0xff) << 8) | ((unsigned)((int)rintf(v1[i].z * i1) & 0xff) << 16) | ((unsigned)((int)rintf(v1[i].w * i1) & 0xff) << 24);
                ((unsigned*)(p.xq + (size_t)t1 * D_MODEL))[lane + 64 * i] = q1;
            }
        }
        if (lane == 0) {
            p.rstd1[t] = rsqrtf(s0 * (1.0f / D_MODEL) + EPS) * a0 * (1.0f / 127.0f); p.sx[t] = a0 * (1.0f / 127.0f);
            if (two) { p.rstd1[t1] = rsqrtf(s1 * (1.0f / D_MODEL) + EPS) * a1 * (1.0f / 127.0f); p.sx[t1] = a1 * (1.0f / 127.0f); }
        }
    }
    w8_tiles(p.w_in, p.norm1_g, 1536, p.winT8, p.swb, p.swb + 1536, lds, tid);
    w8_tiles(p.peer_wq, p.norm2_g, 2048, p.wqT8, p.swq, p.swq + 2048, lds, tid);
}

typedef short s16x4 __attribute__((ext_vector_type(4)));
template <class Epi, class Fin>
__device__ __forceinline__ void gemm128_sgu(const int tid, const bf16_t* __restrict__ A, const bf16_t* __restrict__ V  ,
                                            const float* __restrict__ lnm, const float* __restrict__ lnr, const float* __restrict__ gch, char* lds, const Epi& epi, const Fin& fin) {
    const int lane = tid & 63, wid = tid >> 6, wr = wid >> 1, wc = wid & 1, fr = lane & 15, fq = lane >> 4;
    constexpr int PITCH = 144, P2 = 288;
    char* sA = lds; char* sB = lds + 128 * PITCH;
    f32x4 acc[4][4];
#pragma unroll
    for (int m = 0; m < 4; ++m)
#pragma unroll
        for (int n = 0; n < 4; ++n) acc[m][n] = (f32x4){0.f, 0.f, 0.f, 0.f};
    u32x4 ra[4], rb[4]; float rm[4], rr[4];
    const int lrow = tid >> 3, lch = tid & 7;
    const int btok = tid >> 4, bch = tid & 15;
    const bf16_t* ga = A + (size_t)lrow * 128 + lch * 8;
    const bf16_t* gb = V + (size_t)btok * D_IN + bch * 8;
    float g8[8];
    { const float4 g0 = *(const float4*)(gch + bch * 8), g1 = *(const float4*)(gch + bch * 8 + 4); g8[0] = g0.x; g8[1] = g0.y; g8[2] = g0.z; g8[3] = g0.w; g8[4] = g1.x; g8[5] = g1.y; g8[6] = g1.z; g8[7] = g1.w; }
#pragma unroll
    for (int j = 0; j < 4; ++j) { ra[j] = *(const u32x4*)(ga + (size_t)(32 * j) * 128); rb[j] = *(const u32x4*)(gb + (size_t)(16 * j) * D_IN); rm[j] = lnm[btok + 16 * j]; rr[j] = lnr[btok + 16 * j]; }
    for (int k0 = 0; k0 < 128; k0 += 64) {
        __syncthreads();
#pragma unroll
        for (int j = 0; j < 4; ++j) {
            *(u32x4*)(sA + (lrow + 32 * j) * PITCH + lch * 16) = ra[j];
            u32x4 o;
#pragma unroll
            for (int i = 0; i < 4; ++i) {
                const unsigned w = rb[j][i];
                o[i] = pack2((bflo(w) - rm[j]) * rr[j] * g8[2 * i], (bfhi(w) - rm[j]) * rr[j] * g8[2 * i + 1]);
            }
            *(u32x4*)(sB + (btok + 16 * j) * P2 + bch * 16) = o;
        }
        __syncthreads();
        if (k0 + 64 < 128) {
#pragma unroll
            for (int j = 0; j < 4; ++j) { ra[j] = *(const u32x4*)(ga + (size_t)(32 * j) * 128 + 64); rb[j] = *(const u32x4*)(gb + (size_t)(64 + 16 * j) * D_IN); rm[j] = lnm[64 + btok + 16 * j]; rr[j] = lnr[64 + btok + 16 * j]; }
        }
#pragma unroll
        for (int kk = 0; kk < 2; ++kk) {
            bf16x8 af[4], bfr[4];
#pragma unroll
            for (int m = 0; m < 4; ++m) af[m] = *(const bf16x8*)(sA + (wr * 64 + m * 16 + fr) * PITCH + (kk * 32 + fq * 8) * 2);
#pragma unroll
            for (int n = 0; n < 4; ++n) {
                const char* bp = sB + (kk * 32 + fq * 8 + (fr >> 2)) * P2 + (wc * 64 + n * 16 + 4 * (fr & 3)) * 2;
                const s16x4 lo = __builtin_amdgcn_ds_read_tr16_b64_v4i16((LAS s16x4*)(bp));
                const s16x4 hi = __builtin_amdgcn_ds_read_tr16_b64_v4i16((LAS s16x4*)(bp + 4 * P2));
                bfr[n] = (bf16x8){lo[0], lo[1], lo[2], lo[3], hi[0], hi[1], hi[2], hi[3]};
            }
#pragma unroll
            for (int m = 0; m < 4; ++m)
#pragma unroll
                for (int n = 0; n < 4; ++n) acc[m][n] = __builtin_amdgcn_mfma_f32_16x16x32_bf16(bfr[n], af[m], acc[m][n], 0, 0, 0);
        }
    }
    __syncthreads();
#pragma unroll
    for (int m = 0; m < 4; ++m)
#pragma unroll
        for (int n = 0; n < 4; ++n) { const int r = wr * 64 + m * 16 + fr, c = wc * 64 + n * 16 + fq * 4; *(uint2*)(lds + r * 272 + c * 2) = epi(r, c, acc[m][n]); }
    u32x4 pre[8];
#pragma unroll
    for (int j = 0; j < 8; ++j) { const int id = tid + 256 * j; pre[j] = fin.prefetch(id >> 4, id & 15); }
    __syncthreads();
#pragma unroll
    for (int j = 0; j < 8; ++j) { const int id = tid + 256 * j, row = id >> 4, ch = id & 15; fin.store(row, ch, *(const u32x4*)(lds + row * 272 + ch * 16), pre[j]); }
}

#define PT_PITCH 272
#define MIXH_LDS (2 * 128 * PT_PITCH + 1024)
template <int W, class Epi>
__device__ __forceinline__ void pool_tile(const int tid, const bf16_t* __restrict__ zb0  , int pos0,
                                          const bf16_t* __restrict__ Bt, char* lds, const Epi& epi, bf16_t* __restrict__ co  ) {
    const int lane = tid & 63, wid = tid >> 6, wr = wid >> 1, wc = wid & 1, fr = lane & 15, fq = lane >> 4;
    char* sA = lds; char* sB = lds + 128 * PT_PITCH;
    __syncthreads();
#pragma unroll
    for (int j = 0; j < 8; ++j) { const int id = tid + 256 * j, row = id >> 4, ch = id & 15; *(u32x4*)(sB + row * PT_PITCH + ch * 16) = *(const u32x4*)(Bt + (size_t)row * 128 + ch * 8); }
    {
        const int seg = tid >> 5, hc = tid & 31, r0 = seg * 16;
        const bool at_start = (pos0 & (SEQ - 1)) == 0;
        const bf16_t* zp = zb0 + hc * 4;
        u32x2 v[W + 16];
#pragma unroll
        for (int i = 0; i < W + 16; ++i) { const int rr = r0 - W + i; const bool ok = !(at_start && rr < 0); v[i] = *(const u32x2*)(zp + (ptrdiff_t)(ok ? rr : 0) * D_IN); }
        float sm[4] = {0.f, 0.f, 0.f, 0.f};
#pragma unroll
        for (int i = 1; i <= W; ++i) {
            const float m = (at_start && (r0 - W + i) < 0) ? 0.f : 1.f;
            sm[0] += m * bflo(v[i].x); sm[1] += m * bfhi(v[i].x); sm[2] += m * bflo(v[i].y); sm[3] += m * bfhi(v[i].y);
        }
#pragma unroll
        for (int o = 0; o < 16; ++o) {
            if (o > 0) {
                const float md = (at_start && (r0 + o - W) < 0) ? 0.f : 1.f;
                sm[0] += bflo(v[W + o].x) - md * bflo(v[o].x); sm[1] += bfhi(v[W + o].x) - md * bfhi(v[o].x);
                sm[2] += bflo(v[W + o].y) - md * bflo(v[o].y); sm[3] += bfhi(v[W + o].y) - md * bfhi(v[o].y);
            }
            const int pos = (pos0 + r0 + o) & (SEQ - 1);
            const float rn = 1.0f / (float)((pos + 1 < W) ? pos + 1 : W);
            u32x2 ov;
            ov.x = pack2(sm[0] * rn - bflo(v[W + o].x), sm[1] * rn - bfhi(v[W + o].x));
            ov.y = pack2(sm[2] * rn - bflo(v[W + o].y), sm[3] * rn - bfhi(v[W + o].y));
            *(u32x2*)(sA + (r0 + o) * PT_PITCH + hc * 8) = ov;
        }
    }
    __syncthreads();
    f32x4 acc[4][4];
#pragma unroll
    for (int m = 0; m < 4; ++m)
#pragma unroll
        for (int n = 0; n < 4; ++n) acc[m][n] = (f32x4){0.f, 0.f, 0.f, 0.f};
#pragma unroll
    for (int kk = 0; kk < 4; ++kk) {
        bf16x8 af[4], bfr[4];
#pragma unroll
        for (int m = 0; m < 4; ++m) af[m] = *(const bf16x8*)(sA + (wr * 64 + m * 16 + fr) * PT_PITCH + (kk * 32 + fq * 8) * 2);
#pragma unroll
        for (int n = 0; n < 4; ++n) bfr[n] = *(const bf16x8*)(sB + (wc * 64 + n * 16 + fr) * PT_PITCH + (kk * 32 + fq * 8) * 2);
#pragma unroll
        for (int m = 0; m < 4; ++m)
#pragma unroll
            for (int n = 0; n < 4; ++n) acc[m][n] = __builtin_amdgcn_mfma_f32_16x16x32_bf16(bfr[n], af[m], acc[m][n], 0, 0, 0);
    }
    __syncthreads();
#pragma unroll
    for (int m = 0; m < 4; ++m)
#pragma unroll
        for (int n = 0; n < 4; ++n) { const int r = wr * 64 + m * 16 + fr, c = wc * 64 + n * 16 + fq * 4; *(uint2*)(lds + r * PT_PITCH + c * 2) = epi(r, c, acc[m][n]); }
    __syncthreads();
#pragma unroll
    for (int j = 0; j < 8; ++j) { const int id = tid + 256 * j, row = id >> 4, ch = id & 15; *(u32x4*)(co + (size_t)row * D_MODEL + ch * 8) = *(const u32x4*)(lds + row * PT_PITCH + ch * 16); }
}

struct SguFin {
    const bf16_t* uo; bf16_t* co;
    __device__ __forceinline__ u32x4 prefetch(int row, int ch) const { return *(const u32x4*)(uo + (size_t)row * D_IN + ch * 8); }
    __device__ __forceinline__ void store(int row, int ch, const u32x4 w, const u32x4 uu) const {
        u32x4 o;
#pragma unroll
        for (int i = 0; i < 4; ++i) o[i] = pack2(bflo(w[i]) * bflo(uu[i]), bfhi(w[i]) * bfhi(uu[i]));
        *(u32x4*)(co + (size_t)row * D_MODEL + ch * 8) = o;
    }
};
__device__ void phase_mix_gemm(const Params& p, char* lds) {
    const int tidx_ = tid_opaque();
    const int npool = (T_TOK / 128) * 4, nsgu = (T_TOK / 128) * 4;
    const int half = tidx_ >> 8, ht_ = tidx_ & 255; lds += half * MIXH_LDS;
    for (int tile = 2 * blockIdx.x + half; tile < npool + nsgu; tile += 2 * gridDim.x) {
        int ht = ht_; asm volatile("" : "+v"(ht));
        if (tile < npool) {
            const int tm = tile >> 2, g = tile & 3;
            const float* ps = p.pool_scale + g * 128; bf16_t* co = p.cB + (size_t)tm * 128 * D_MODEL + g * 128;
            const bf16_t* z0 = p.zb + (size_t)tm * 128 * D_IN + g * 128; const bf16_t* bt = p.poolT + (size_t)g * 16384;
            auto epi = [&](int r, int c, f32x4 v) {
                const float4 sc = *(const float4*)(ps + c);
                uint2 o; o.x = pack2(v[0] * sc.x, v[1] * sc.y); o.y = pack2(v[2] * sc.z, v[3] * sc.w);
                return o;
            };
            if (g == 0) pool_tile<2>(ht, z0, tm * 128, bt, lds, epi, co); else if (g == 1) pool_tile<4>(ht, z0, tm * 128, bt, lds, epi, co);
            else if (g == 2) pool_tile<8>(ht, z0, tm * 128, bt, lds, epi, co); else pool_tile<16>(ht, z0, tm * 128, bt, lds, epi, co);
        } else {
            const int t2 = tile - npool, blk = t2 >> 2, h = t2 & 3;
            float* stm = (float*)(lds + GEMM_LDS_BYTES); float* str = stm + 128;
            __syncthreads();
            if (ht < 128) {
                const float4* pp = (const float4*)(p.lnp + (size_t)(blk * 128 + ht) * 8);
                const float4 a0 = pp[0], a1 = pp[1], a2 = pp[2], a3 = pp[3];
                const float s1 = ((a0.x + a0.z) + (a1.x + a1.z)) + ((a2.x + a2.z) + (a3.x + a3.z)), s2 = ((a0.y + a0.w) + (a1.y + a1.w)) + ((a2.y + a2.w) + (a3.y + a3.w));
                const float mean = s1 * (1.0f / 512.0f), var = fmaxf(s2 * (1.0f / 512.0f) - mean * mean, 0.f);
                stm[ht] = mean; str[ht] = rsqrtf(var + EPS);
            }
            __syncthreads();
            const float* sb = p.sgu_b + h * 128; const bf16_t* uo = p.zb + (size_t)blk * 128 * D_IN + 512 + h * 128;
            bf16_t* co = p.cB + (size_t)blk * 128 * D_MODEL + 512 + h * 128;
            gemm128_sgu(ht, p.wsM + (size_t)h * 16384, p.zb + (size_t)blk * 128 * D_IN + 1024 + h * 128, stm, str, p.sgu_norm_g + h * 128, lds,
                    [&](int r, int c, f32x4 v) {
                        const float bb = sb[r];
                        uint2 o; o.x = pack2(v[0] + bb, v[1] + bb); o.y = pack2(v[2] + bb, v[3] + bb);
                        return o;
                    }, SguFin{uo, co});
        }
    }
}

__device__ __forceinline__ int wave_sum_i_uniform(int s) {
    s += __builtin_amdgcn_update_dpp(0, s, 0xB1, 0xf, 0xf, false);
    s += __builtin_amdgcn_update_dpp(0, s, 0x4E, 0xf, 0xf, false);
    s += __builtin_amdgcn_update_dpp(0, s, 0x141, 0xf, 0xf, false);
    s += __builtin_amdgcn_update_dpp(0, s, 0x140, 0xf, 0xf, false);
    return __builtin_amdgcn_readlane(s, 0) + __builtin_amdgcn_readlane(s, 16) + __builtin_amdgcn_readlane(s, 32) + __builtin_amdgcn_readlane(s, 48);
}
__constant__ unsigned char kComb[64] = {
    0x00,0x01,0x02,0x03,0x04,0x05,0x06,0x07,0x08,0x09,0x0a,0x0b,0x0c,0x0d,0x0e,0x0f,
    0x10,0x11,0x12,0x13,0x14,0x15,0x16,0x17,
    0x20,0x21,0x22,0x23,0x24,
    0x30,0x31,0x32,0x33,
    0x40,0x41,0x42,
    0x50,0x51,
    0x60,0x61,
    0x70,0x71,
    0x80,0x90,0xa0,0xb0,0xc0,0xd0,0xe0,0xf0,
    0xff,0xff,0xff,0xff,0xff,0xff,0xff,0xff,0xff,0xff,0xff,0xff,0xff,0xff};

template <int CTRL> __device__ __forceinline__ int dpp_i(int v) { return __builtin_amdgcn_update_dpp(0, v, CTRL, 0xf, 0xf, false); }
__device__ __forceinline__ int row_allmax_i(int v) {
    v = max(v, dpp_i<0x128>(v)); v = max(v, dpp_i<0x124>(v)); v = max(v, dpp_i<0x122>(v)); v = max(v, dpp_i<0x121>(v));
    return v;
}
__device__ __forceinline__ float row_allsum_f(float v) {
    v += __int_as_float(dpp_i<0x128>(__float_as_int(v))); v += __int_as_float(dpp_i<0x124>(__float_as_int(v)));
    v += __int_as_float(dpp_i<0x122>(__float_as_int(v))); v += __int_as_float(dpp_i<0x121>(__float_as_int(v)));
    return v;
}
__device__ __forceinline__ int f2key(float f) { const int b = __float_as_int(f); return b ^ ((b >> 31) & 0x7fffffff); }
__device__ __forceinline__ float key2f(int k) { return __int_as_float(k ^ ((k >> 31) & 0x7fffffff)); }
#define KEY_MIN ((int)0x80000000)
#define CE(a, b) { const int hi_ = max(a, b), lo_ = min(a, b); a = hi_; b = lo_; }
__device__ __forceinline__ int top16_rows(int (&k)[8], int l15) {
    CE(k[0], k[1]) CE(k[2], k[3]) CE(k[4], k[5]) CE(k[6], k[7])
    CE(k[0], k[2]) CE(k[1], k[3]) CE(k[4], k[6]) CE(k[5], k[7])
    CE(k[1], k[2]) CE(k[5], k[6])
    CE(k[0], k[4]) CE(k[1], k[5]) CE(k[2], k[6]) CE(k[3], k[7])
    CE(k[2], k[4]) CE(k[3], k[5])
    CE(k[1], k[2]) CE(k[3], k[4]) CE(k[5], k[6])
    int res = KEY_MIN;
#pragma unroll
    for (int r = 0; r < 16; ++r) {
        const int m = row_allmax_i(k[0]);
        const bool own = (k[0] == m);
#pragma unroll
        for (int j = 0; j < 7; ++j) k[j] = own ? k[j + 1] : k[j];
        k[7] = own ? KEY_MIN : k[7];
        res = (l15 == r) ? m : res;
    }
    return res;
}
__device__ __forceinline__ void combine16(int A, int B, const int (&cbv)[4], int lane, int l15, int& eid_out, float& gate_out) {
    const int rowbase = lane & 48;
    int ck[4], eid[4];
#pragma unroll
    for (int c = 0; c < 4; ++c) {
        const int ci = (cbv[c] >> 4) & 15, cj = cbv[c] & 15;
        const int ka = __builtin_amdgcn_ds_bpermute((rowbase + ci) << 2, A);
        const int kb = __builtin_amdgcn_ds_bpermute((rowbase + cj) << 2, B);
        const float sm = key2f(ka & ~127) + key2f(kb & ~127);
        eid[c] = ((127 - (ka & 127)) << 7) | (127 - (kb & 127));
        ck[c] = (cbv[c] != 0xff) ? ((f2key(sm) & ~63) | (63 - (4 * l15 + c))) : KEY_MIN;
    }
    CE(ck[0], ck[1]) CE(ck[2], ck[3]) CE(ck[0], ck[2]) CE(ck[1], ck[3]) CE(ck[1], ck[2])
    int res = KEY_MIN;
#pragma unroll
    for (int r = 0; r < 16; ++r) {
        const int m = row_allmax_i(ck[0]);
        const bool own = (ck[0] == m);
        ck[0] = own ? ck[1] : ck[0]; ck[1] = own ? ck[2] : ck[1]; ck[2] = own ? ck[3] : ck[2]; ck[3] = own ? KEY_MIN : ck[3];
        res = (l15 == r) ? m : res;
    }
    const int slot = 63 - (res & 63);
    const int src = (rowbase + (slot >> 2)) << 2;
    const int e0 = __builtin_amdgcn_ds_bpermute(src, eid[0]), e1 = __builtin_amdgcn_ds_bpermute(src, eid[1]);
    const int e2 = __builtin_amdgcn_ds_bpermute(src, eid[2]), e3 = __builtin_amdgcn_ds_bpermute(src, eid[3]);
    const int sel = slot & 3;
    eid_out = sel == 0 ? e0 : (sel == 1 ? e1 : (sel == 2 ? e2 : e3));
    gate_out = key2f(res & ~63);
}

__device__ __forceinline__ int reduce16_rows(const int (&part)[16], bool b3, bool b2, bool b1, bool b0b) {
    int r8[8], r4[4], r2[2];
#pragma unroll
    for (int k = 0; k < 8; ++k) { const int keep = b3 ? part[8 + k] : part[k], send = b3 ? part[k] : part[8 + k]; r8[k] = keep + __builtin_amdgcn_update_dpp(0, send, 0x140, 0xf, 0xf, false); }
#pragma unroll
    for (int k = 0; k < 4; ++k) { const int keep = b2 ? r8[4 + k] : r8[k], send = b2 ? r8[k] : r8[4 + k]; r4[k] = keep + __builtin_amdgcn_update_dpp(0, send, 0x141, 0xf, 0xf, false); }
#pragma unroll
    for (int k = 0; k < 2; ++k) { const int keep = b1 ? r4[2 + k] : r4[k], send = b1 ? r4[k] : r4[2 + k]; r2[k] = keep + __builtin_amdgcn_update_dpp(0, send, 0x4E, 0xf, 0xf, false); }
    const int keep = b0b ? r2[1] : r2[0], send = b0b ? r2[0] : r2[1];
    int r1 = keep + __builtin_amdgcn_update_dpp(0, send, 0xB1, 0xf, 0xf, false);
    r1 += __shfl_xor(r1, 16); r1 += __shfl_xor(r1, 32);
    return r1;
}
__device__ void phase_hquant(const Params& p, char* lds) {
    const int tid = tid_opaque();
    const int wave = __builtin_amdgcn_readfirstlane((int)((blockIdx.x * blockDim.x + tid) >> 6)), nwaves = (gridDim.x * blockDim.x) >> 6, lane = tid & 63;
    for (int t = wave; t < T_TOK; t += 2 * nwaves) {
        const int t1 = t + nwaves; const bool two = t1 < T_TOK;
        const u32x4* h0 = (const u32x4*)(p.hb + (size_t)t * D_MODEL); const u32x4* h1 = (const u32x4*)(p.hb + (size_t)(two ? t1 : t) * D_MODEL);
        u32x4 r[2][2] = {{h0[2 * lane], h0[2 * lane + 1]}, {h1[2 * lane], h1[2 * lane + 1]}};
#pragma unroll
        for (int q = 0; q < 2; ++q) {
            const u32x4 a = r[q][0], c = r[q][1];
            const float f[16] = {bflo(a.x), bfhi(a.x), bflo(a.y), bfhi(a.y), bflo(a.z), bfhi(a.z), bflo(a.w), bfhi(a.w),
                                 bflo(c.x), bfhi(c.x), bflo(c.y), bfhi(c.y), bflo(c.z), bfhi(c.z), bflo(c.w), bfhi(c.w)};
            float ss = 0.f, am = 0.f;
#pragma unroll
            for (int k = 0; k < 16; ++k) { ss += f[k] * f[k]; am = fmaxf(am, fabsf(f[k])); }
            ss = wave_sum(ss); am = wave_max(am);
            const float inv = am > 0.f ? 127.0f / am : 0.f;
            u32x4 o;
#pragma unroll
            for (int i = 0; i < 4; ++i) {
                unsigned w = 0;
#pragma unroll
                for (int k = 0; k < 4; ++k) w |= (unsigned)((int)rintf(f[4 * i + k] * inv) & 0xff) << (8 * k);
                o[i] = w;
            }
            const int tt = q ? t1 : t;
            if (q == 0 || two) {
                ((u32x4*)(p.hq + (size_t)tt * D_MODEL))[lane] = o;
                if (lane == 0) p.hsc[tt] = am * (1.0f / 127.0f) * rsqrtf(ss * (1.0f / D_MODEL) + EPS);
            }
        }
    }
}

#define TS_WBYTES (16384 + 128)
__device__ void phase_peer_dots(const Params& p, char* lds) {
    const int tidx_ = tid_opaque();
    const int lane = tidx_ & 63, wid = __builtin_amdgcn_readfirstlane((int)(tidx_ >> 6)), l15 = lane & 15;
    const bool b3 = (lane & 8) != 0, b2 = (lane & 4) != 0, b1 = (lane & 2) != 0, b0b = (lane & 1) != 0;
    const int gw = blockIdx.x * (blockDim.x >> 6) + wid, ngw = gridDim.x * (blockDim.x >> 6);
    char* wl = lds + wid * TS_WBYTES;
    unsigned* list = (unsigned*)wl; int* dotsl = (int*)(wl + 4096); char* hql = wl + 8192; int* tks = (int*)(wl + 16384);
    const unsigned lane16 = (unsigned)lane * 16u;
    for (int tb = gw * 8; tb < T_TOK; tb += ngw * 8) {
#pragma unroll
        for (int j = 0; j < 8; ++j) *(u32x4*)(hql + j * 1024 + lane * 16) = ((const u32x4*)(p.hq + (size_t)(tb + j) * D_MODEL))[lane];
        if (lane < 8) tks[lane] = __float_as_int(p.hsc[tb + lane]);
        int idv[8][2];
#pragma unroll
        for (int j = 0; j < 8; ++j) { const int* ir = p.idx + (size_t)(tb + j) * 128; idv[j][0] = ir[lane]; idv[j][1] = ir[64 + lane]; }
#pragma unroll 1
        for (int x = 0; x < 8; ++x) {
            int n = 0;
#pragma unroll
            for (int j = 0; j < 8; ++j)
#pragma unroll
                for (int r = 0; r < 2; ++r) {
                    const int e = idv[j][r];
                    const bool in = (e >> 11) == x;
                    const unsigned long long mk = __ballot(in);
                    const int rank = (int)__builtin_amdgcn_mbcnt_hi((unsigned)(mk >> 32), __builtin_amdgcn_mbcnt_lo((unsigned)mk, 0u));
                    if (in) list[n + rank] = ((unsigned)j << 21) | ((unsigned)(r * 64 + lane) << 14) | (unsigned)e;
                    n += (int)__builtin_popcountll(mk);
                }
            asm volatile("s_waitcnt lgkmcnt(0)" ::: "memory");
            u32x4 ua[16], ubf[16]; int enta = 0, entb = 0;
            auto issue = [&](int b0, u32x4 (&uu)[16], int& entv) {
                const int i = (b0 + l15 < n) ? b0 + l15 : n - 1;
                entv = (int)list[i];
#pragma unroll
                for (int j = 0; j < 16; ++j) { const int e = __builtin_amdgcn_readlane(entv, j) & 0x3fff; uu[j] = *(const u32x4*)(p.u8 + (size_t)e * D_MODEL + lane16); }
            };
            auto reduce = [&](int b0, const u32x4 (&uu)[16], int entv) {
                int part[16];
#pragma unroll
                for (int j = 0; j < 16; ++j) {
                    const int tl = __builtin_amdgcn_readlane(entv, j) >> 21;
                    const u32x4 hqv = *(const u32x4*)(hql + tl * 1024 + lane * 16);
                    int sacc = __builtin_amdgcn_sdot4((int)uu[j].x, (int)hqv.x, 0, false);
                    sacc = __builtin_amdgcn_sdot4((int)uu[j].y, (int)hqv.y, sacc, false);
                    sacc = __builtin_amdgcn_sdot4((int)uu[j].z, (int)hqv.z, sacc, false);
                    part[j] = __builtin_amdgcn_sdot4((int)uu[j].w, (int)hqv.w, sacc, false);
                }
                const int r1 = reduce16_rows(part, b3, b2, b1, b0b);
                if (lane < 16 && b0 + lane < n) dotsl[((unsigned)entv >> 21) * 128 + (((unsigned)entv >> 14) & 127u)] = r1;
            };
            if (n > 0) issue(0, ua, enta);
            for (int b0 = 0; b0 < n; b0 += 32) {
                if (b0 + 16 < n) issue(b0 + 16, ubf, entb);
                reduce(b0, ua, enta);
                if (b0 + 16 < n) {
                    if (b0 + 32 < n) issue(b0 + 32, ua, enta);
                    reduce(b0 + 16, ubf, entb);
                }
            }
            asm volatile("s_waitcnt lgkmcnt(0)" ::: "memory");
        }
#pragma unroll
        for (int j = 0; j < 8; ++j) {
            const float cs_t = __int_as_float(tks[j]), r2_t = cs_t;
            const float* gr = p.gate + (size_t)(tb + j) * 128; float* cr = p.coef + (size_t)(tb + j) * 128;
#pragma unroll
            for (int r = 0; r < 2; ++r) {
                const int e = idv[j][r];
                const float sc = gr[r * 64 + lane] * r2_t;
                const float ex = __expf(sc - key2f(row_allmax_i(f2key(sc))));
                const float gt = ex / row_allsum_f(ex);
                const float2 sc2 = p.suv[e];
                const float dotf = (float)dotsl[j * 128 + r * 64 + lane] * cs_t * sc2.x;
                cr[r * 64 + lane] = gt * gelu_t(dotf) * sc2.y;
            }
        }
        asm volatile("s_waitcnt lgkmcnt(0)" ::: "memory");
    }
}

__device__ void phase_gather(const Params& p, char* lds) {
    const int tidx_ = tid_opaque();
    const int wave = __builtin_amdgcn_readfirstlane((int)((blockIdx.x * blockDim.x + tidx_) >> 6)), nwaves = (gridDim.x * blockDim.x) >> 6, lane = tidx_ & 63;
    const unsigned char* vb = p.v8 + lane * 12;
    const int ntok = (T_TOK - wave + nwaves - 1) / nwaves;
    auto tok = [&](int i) { const int ii = i < ntok ? i : ntok - 1; return wave + ii * nwaves; };
    if (ntok <= 0) return;
    u32x3 v0[8], v1[8], v2[8], v3[8];
    int ic0, ic1, in0, in1, ia0, ia1;
    float coef0, coef1, cn0, cn1;
    { const float* cr = p.coef + (size_t)tok(0) * 128; coef0 = cr[lane]; coef1 = cr[64 + lane]; }
    { const int* ir = p.idx + (size_t)tok(0) * 128; ic0 = ir[lane]; ic1 = ir[64 + lane]; }
    { const int* ir = p.idx + (size_t)tok(1) * 128; in0 = ir[lane]; in1 = ir[64 + lane]; }
    float g16[16];
#pragma unroll
    for (int i4 = 0; i4 < 4; ++i4) { const float4 g = ((const float4*)(p.final_g + lane * 16))[i4]; g16[4 * i4] = g.x; g16[4 * i4 + 1] = g.y; g16[4 * i4 + 2] = g.z; g16[4 * i4 + 3] = g.w; }
#define G2_ISSUE(vv, pbx) do { const int pbx_ = (pbx); const bool nx_ = pbx_ >= 128; const int pm_ = pbx_ & 127; \
        const int src_ = nx_ ? (pm_ < 64 ? in0 : in1) : (pm_ < 64 ? ic0 : ic1); \
        _Pragma("unroll") for (int q = 0; q < 8; ++q) { const int e = __builtin_amdgcn_readlane(src_, (pm_ & 63) + q); vv[q] = *(const u32x3*)(vb + (size_t)e * ROWB); } } while (0)
    __builtin_amdgcn_sched_barrier(0);
    G2_ISSUE(v0, 0); __builtin_amdgcn_sched_barrier(0); G2_ISSUE(v1, 8); __builtin_amdgcn_sched_barrier(0); G2_ISSUE(v2, 16); __builtin_amdgcn_sched_barrier(0);
#pragma unroll 1
    for (int i = 0; i < ntok; ++i) {
        const int t = tok(i);
        { const int* ir = p.idx + (size_t)tok(i + 2) * 128; ia0 = ir[lane]; ia1 = ir[64 + lane]; }
        const u32x4* hr = (const u32x4*)(p.hb + (size_t)t * D_MODEL + lane * 16);
        const u32x4 ha = hr[0], hc = hr[1];
        { const float* cr = p.coef + (size_t)tok(i + 1) * 128; cn0 = cr[lane]; cn1 = cr[64 + lane]; }
        const float cmax = wave_max(fmaxf(fabsf(coef0), fabsf(coef1)));
        const float qs = cmax > 0.f ? 127.0f / cmax : 0.f, cscale = cmax * (1.0f / 127.0f);
        const int cq0 = (int)rintf(coef0 * qs), cq1 = (int)rintf(coef1 * qs);
        const int csum_i = wave_sum_i_uniform(cq0 + cq1);
        unsigned cpk0, cpk1;
        {
            const int bb0 = cq0 & 0xff, bb1 = cq1 & 0xff;
            cpk0 = (unsigned)__builtin_amdgcn_update_dpp(0, bb0, 0x00, 0xf, 0xf, false) | ((unsigned)__builtin_amdgcn_update_dpp(0, bb0, 0x55, 0xf, 0xf, false) << 8)
                 | ((unsigned)__builtin_amdgcn_update_dpp(0, bb0, 0xAA, 0xf, 0xf, false) << 16) | ((unsigned)__builtin_amdgcn_update_dpp(0, bb0, 0xFF, 0xf, 0xf, false) << 24);
            cpk1 = (unsigned)__builtin_amdgcn_update_dpp(0, bb1, 0x00, 0xf, 0xf, false) | ((unsigned)__builtin_amdgcn_update_dpp(0, bb1, 0x55, 0xf, 0xf, false) << 8)
                 | ((unsigned)__builtin_amdgcn_update_dpp(0, bb1, 0xAA, 0xf, 0xf, false) << 16) | ((unsigned)__builtin_amdgcn_update_dpp(0, bb1, 0xFF, 0xf, 0xf, false) << 24);
        }
        int racc[12], jacc[12];
#pragma unroll
        for (int j = 0; j < 12; ++j) { racc[j] = 0; jacc[j] = 0; }
        auto axpy = [&](int pb, const u32x3 (&vv)[8]) __attribute__((always_inline)) {
#pragma unroll
            for (int g4 = 0; g4 < 2; ++g4) {
                const int cqd = __builtin_amdgcn_readlane((int)(pb < 64 ? cpk0 : cpk1), (pb & 63) + 4 * g4);
#pragma unroll
                for (int w = 0; w < 3; ++w) {
                    const unsigned wa = vv[4 * g4 + 0][w], wb = vv[4 * g4 + 1][w], wc = vv[4 * g4 + 2][w], wd = vv[4 * g4 + 3][w];
                    const unsigned p0 = __builtin_amdgcn_perm(wb, wa, 0x05010400u), p1 = __builtin_amdgcn_perm(wb, wa, 0x07030602u);
                    const unsigned q0 = __builtin_amdgcn_perm(wd, wc, 0x05010400u), q1 = __builtin_amdgcn_perm(wd, wc, 0x07030602u);
                    const unsigned t0 = __builtin_amdgcn_perm(q0, p0, 0x05040100u), t1 = __builtin_amdgcn_perm(q0, p0, 0x07060302u);
                    const unsigned t2 = __builtin_amdgcn_perm(q1, p1, 0x05040100u), t3 = __builtin_amdgcn_perm(q1, p1, 0x07060302u);
                    racc[4 * w + 0] = __builtin_amdgcn_sdot4((int)t0, cqd, racc[4 * w + 0], false); jacc[4 * w + 0] = __builtin_amdgcn_sdot4((int)(t0 & 0xc0c0c0c0u), cqd, jacc[4 * w + 0], false);
                    racc[4 * w + 1] = __builtin_amdgcn_sdot4((int)t1, cqd, racc[4 * w + 1], false); jacc[4 * w + 1] = __builtin_amdgcn_sdot4((int)(t1 & 0xc0c0c0c0u), cqd, jacc[4 * w + 1], false);
                    racc[4 * w + 2] = __builtin_amdgcn_sdot4((int)t2, cqd, racc[4 * w + 2], false); jacc[4 * w + 2] = __builtin_amdgcn_sdot4((int)(t2 & 0xc0c0c0c0u), cqd, jacc[4 * w + 2], false);
                    racc[4 * w + 3] = __builtin_amdgcn_sdot4((int)t3, cqd, racc[4 * w + 3], false); jacc[4 * w + 3] = __builtin_amdgcn_sdot4((int)(t3 & 0xc0c0c0c0u), cqd, jacc[4 * w + 3], false);
                }
            }
        };
#pragma unroll 1
        for (int pb = 0; pb < 128; pb += 32) {
            G2_ISSUE(v3, pb + 24); __builtin_amdgcn_sched_barrier(0); axpy(pb, v0); __builtin_amdgcn_sched_barrier(0);
            G2_ISSUE(v0, pb + 32); __builtin_amdgcn_sched_barrier(0); axpy(pb + 8, v1); __builtin_amdgcn_sched_barrier(0);
            G2_ISSUE(v1, pb + 40); __builtin_amdgcn_sched_barrier(0); axpy(pb + 16, v2); __builtin_amdgcn_sched_barrier(0);
            G2_ISSUE(v2, pb + 48); __builtin_amdgcn_sched_barrier(0); axpy(pb + 24, v3); __builtin_amdgcn_sched_barrier(0);
        }
        ic0 = in0; ic1 = in1; in0 = ia0; in1 = ia1;
        coef0 = cn0; coef1 = cn1;
        int acc[16];
#pragma unroll
        for (int j = 0; j < 12; ++j) acc[j] = (racc[j] - jacc[j]) - 32 * csum_i;
#pragma unroll
        for (int k = 0; k < 4; ++k) acc[12 + k] = ((jacc[k] + 4 * jacc[4 + k] + 16 * jacc[8 + k]) >> 6) + 10 * csum_i;
        const float hf16[16] = {bflo(ha.x), bfhi(ha.x), bflo(ha.y), bfhi(ha.y), bflo(ha.z), bfhi(ha.z), bflo(ha.w), bfhi(ha.w),
                                bflo(hc.x), bfhi(hc.x), bflo(hc.y), bfhi(hc.y), bflo(hc.z), bfhi(hc.z), bflo(hc.w), bfhi(hc.w)};
        float res[16];
        float ss = 0.f;
#pragma unroll
        for (int j = 0; j < 16; ++j) { res[j] = hf16[j] + cscale * (float)acc[j]; ss += res[j] * res[j]; }
        ss = wave_sum(ss);
        const float r3 = rsqrtf(ss * (1.0f / D_MODEL) + EPS);
        float* o = p.out + (size_t)t * D_MODEL + lane * 16;
#pragma unroll
        for (int i4 = 0; i4 < 4; ++i4) {
            float4 ov; ov.x = res[4 * i4] * r3 * g16[4 * i4]; ov.y = res[4 * i4 + 1] * r3 * g16[4 * i4 + 1]; ov.z = res[4 * i4 + 2] * r3 * g16[4 * i4 + 2]; ov.w = res[4 * i4 + 3] * r3 * g16[4 * i4 + 3];
            ((float4*)o)[i4] = ov;
        }
    }
#undef G2_ISSUE
}

namespace pg8 {
#define PG8_LAS __attribute__((address_space(3)))
constexpr int BM = 256, BK = 64, HALF = 128, HTB = HALF * BK * 2, STAGE_BYTES = 8 * HTB, NXCD = 8, WGM = 8;
__host__ __device__ __forceinline__ int lds_byte(int r, int c) { const int st = (r >> 4) * 2 + (c >> 5), rr = r & 15, cc = c & 31, ob = rr * 64 + cc * 2; return st * 1024 + (ob ^ (((ob >> 9) & 1) << 5)); }
__host__ __device__ __forceinline__ void stage_rc(int b, int& R, int& C) { const int st = b / 1024, sb = b % 1024, swz = sb ^ (((sb >> 9) & 1) << 5); R = (st >> 1) * 16 + swz / 64; C = (st & 1) * 32 + (swz % 64) / 2; }
__host__ __device__ __forceinline__ int perm32(int rho) { const int n = rho >> 4, i = rho & 15; return 8 * (i >> 2) + 4 * n + (i & 3); }
struct Unit { int pm, pn; };
struct Gemm { const bf16_t* A; const bf16_t* Bt; int M, N, K; };
struct StaticOrder {
    int nM, nN, nwg, G, c;
    __host__ __device__ void init(int M, int N, int G_, int c_) { nM = M / BM; nN = N / BM; nwg = nM * nN; G = G_; c = c_; }
    __host__ __device__ bool next(int i, Unit& u) const {
        const long L = (long)i * G + c; if (L >= nwg) return false;
        int wgid = (int)L; { const int q = nwg / NXCD, r = nwg % NXCD, xcd = wgid % NXCD, off = wgid / NXCD; wgid = (xcd < r ? xcd * (q + 1) : r * (q + 1) + (xcd - r) * q) + off; }
        const int nig = WGM * nN, gid = wgid / nig, fm = gid * WGM, gsz = (nM - fm) < WGM ? (nM - fm) : WGM;
        u.pm = fm + ((wgid % nig) % gsz); u.pn = (wgid % nig) / gsz; return true;
    }
    __device__ __forceinline__ void a_ready(const Unit&) const {}
    __device__ __forceinline__ void done(const Unit&) const {}
};
__device__ __forceinline__ unsigned cvt_pk_bf16(float lo, float hi) { unsigned r; asm volatile("v_cvt_pk_bf16_f32 %0, %1, %2" : "=v"(r) : "v"(lo), "v"(hi)); return r; }
template <bool I8> __device__ __forceinline__ typename std::conditional<I8, i32x4, f32x4>::type mma1(bf16x8 a, bf16x8 b, typename std::conditional<I8, i32x4, f32x4>::type c) {
    if constexpr (I8) return __builtin_amdgcn_mfma_i32_16x16x64_i8(*(const i32x4*)&a, *(const i32x4*)&b, c, 0, 0, 0);
    else return __builtin_amdgcn_mfma_f32_16x16x32_bf16(a, b, c, 0, 0, 0);
}
struct EpiZ8 {
    static constexpr bool PERM = true, AFTER_DRAIN = false, I8 = true; typedef i32x4 acc_t;
    bf16_t* O; const float* rsx; const unsigned* swb; float2* lnp;
    __device__ __forceinline__ void operator()(const i32x4 (&acc)[2][2][4][2], const Unit& u, int wr, int wc, int fr, int fq) const {
        const int row0 = u.pm * BM + wr * 64 + fr, col0 = u.pn * BM + wc * 32 + 8 * fq; const bool act = u.pn >= 2, vpart = u.pn >= 4;
        float sw[2][8];
#pragma unroll
        for (int bj = 0; bj < 2; ++bj) { const u32x4 a = *(const u32x4*)(swb + col0 + bj * HALF), c = *(const u32x4*)(swb + col0 + bj * HALF + 4);
#pragma unroll
            for (int i = 0; i < 4; ++i) { sw[bj][i] = __uint_as_float(a[i]) * (1.0f / 127.0f); sw[bj][4 + i] = __uint_as_float(c[i]) * (1.0f / 127.0f); } }
#pragma unroll
        for (int ai = 0; ai < 2; ++ai)
#pragma unroll
            for (int m = 0; m < 4; ++m) { const int r = row0 + ai * HALF + m * 16; const float sc = rsx[r]; bf16_t* rowp = O + (size_t)r * D_IN + col0;
                float s1 = 0.f, s2 = 0.f;
#pragma unroll
                for (int bj = 0; bj < 2; ++bj) { f32x4 v0, v1;
#pragma unroll
                    for (int i = 0; i < 4; ++i) { v0[i] = (float)acc[ai][bj][m][0][i] * sc * sw[bj][i]; v1[i] = (float)acc[ai][bj][m][1][i] * sc * sw[bj][4 + i]; }
                    if (act) { v0 = (f32x4){gelu_t(v0[0]), gelu_t(v0[1]), gelu_t(v0[2]), gelu_t(v0[3])}; v1 = (f32x4){gelu_t(v1[0]), gelu_t(v1[1]), gelu_t(v1[2]), gelu_t(v1[3])}; }
#pragma unroll
                    for (int i = 0; i < 4; ++i) { s1 += v0[i] + v1[i]; s2 += v0[i] * v0[i] + v1[i] * v1[i]; }
                    u32x4 w; w.x = cvt_pk_bf16(v0[0], v0[1]); w.y = cvt_pk_bf16(v0[2], v0[3]); w.z = cvt_pk_bf16(v1[0], v1[1]); w.w = cvt_pk_bf16(v1[2], v1[3]);
                    *(u32x4*)(rowp + bj * HALF) = w; }
                if (vpart) {
                    s1 += __shfl_xor(s1, 16); s2 += __shfl_xor(s2, 16); s1 += __shfl_xor(s1, 32); s2 += __shfl_xor(s2, 32);
                    if (fq == 0) lnp[(size_t)r * 8 + (u.pn - 4) * 4 + wc] = make_float2(s1, s2);
                } }
    }
};
struct EpiOut {
    static constexpr bool PERM = true, AFTER_DRAIN = false, I8 = false; typedef f32x4 acc_t;
    bf16_t* O; const signed char* X; const float* sx;
    __device__ __forceinline__ void operator()(const f32x4 (&acc)[2][2][4][2], const Unit& u, int wr, int wc, int fr, int fq) const {
        const int row0 = u.pm * BM + wr * 64 + fr, col0 = u.pn * BM + wc * 32 + 8 * fq;
#pragma unroll
        for (int ai = 0; ai < 2; ++ai)
#pragma unroll
            for (int m = 0; m < 4; ++m) { const int r = row0 + ai * HALF + m * 16; const size_t off = (size_t)r * D_MODEL + col0; const float sc = sx[r];
#pragma unroll
                for (int bj = 0; bj < 2; ++bj) { const u32x2 xx = *(const u32x2*)(X + off + bj * HALF);
                    f32x4 x0, x1;
#pragma unroll
                    for (int i = 0; i < 4; ++i) { x0[i] = (float)(signed char)(xx.x >> (8 * i)) * sc; x1[i] = (float)(signed char)(xx.y >> (8 * i)) * sc; }
                    const f32x4 v0 = acc[ai][bj][m][0] + x0, v1 = acc[ai][bj][m][1] + x1;
                    u32x4 w; w.x = cvt_pk_bf16(v0[0], v0[1]); w.y = cvt_pk_bf16(v0[2], v0[3]); w.z = cvt_pk_bf16(v1[0], v1[1]); w.w = cvt_pk_bf16(v1[2], v1[3]);
                    *(u32x4*)(O + off + bj * HALF) = w; } }
    }
};
struct OneUnit {
    Unit u;
    __device__ __forceinline__ bool next(int i, Unit& o) const { if (i) return false; o = u; return true; }
    __device__ __forceinline__ void a_ready(const Unit&) const {}
    __device__ __forceinline__ void done(const Unit&) const {}
};
#define QT_PITCH 272
#define QT_LDS_BYTES (2 * 256 * QT_PITCH)
struct EpiQTopk {
    static constexpr bool PERM = true, AFTER_DRAIN = true, I8 = true; typedef i32x4 acc_t;
    const bf16_t* keysB; int* idx; float* gate; const unsigned* swq;
    const Params* pp_;
    __device__ __forceinline__ void fused(i32x4 (&acc)[2][2][4][2], const Unit& u, int wr, int wc, int fr, int fq, PG8_LAS unsigned char* ldsp, int wid, int lane) const {
        char* sQ = (char*)ldsp;
        const int h = u.pn;
        float sw[2][8];
#pragma unroll
        for (int bj = 0; bj < 2; ++bj) { const u32x4 a = *(const u32x4*)(swq + u.pn * BM + bj * HALF + wc * 32 + 8 * fq), c = *(const u32x4*)(swq + u.pn * BM + bj * HALF + wc * 32 + 8 * fq + 4);
#pragma unroll
            for (int i = 0; i < 4; ++i) { sw[bj][i] = __uint_as_float(a[i]) * (1.0f / 127.0f); sw[bj][4 + i] = __uint_as_float(c[i]) * (1.0f / 127.0f); } }
#pragma unroll
        for (int ai = 0; ai < 2; ++ai)
#pragma unroll
            for (int m = 0; m < 4; ++m) { const int r = ai * HALF + wr * 64 + m * 16 + fr;
#pragma unroll
                for (int bj = 0; bj < 2; ++bj) { f32x4 v0, v1;
#pragma unroll
                    for (int i = 0; i < 4; ++i) { v0[i] = (float)acc[ai][bj][m][0][i] * sw[bj][i]; v1[i] = (float)acc[ai][bj][m][1][i] * sw[bj][4 + i]; }
                    u32x4 w; w.x = cvt_pk_bf16(v0[0], v0[1]); w.y = cvt_pk_bf16(v0[2], v0[3]); w.z = cvt_pk_bf16(v1[0], v1[1]); w.w = cvt_pk_bf16(v1[2], v1[3]);
                    *(u32x4*)(sQ + bj * (256 * QT_PITCH) + r * QT_PITCH + (wc * 32 + fq * 8) * 2) = w; } }
        __syncthreads();
        int cbv[4];
#pragma unroll
        for (int c = 0; c < 4; ++c) cbv[c] = kComb[4 * fr + c];
        int tA[2][4], tB[2][4];
#pragma unroll
        for (int m = 0; m < 2; ++m)
#pragma unroll
            for (int j = 0; j < 4; ++j) { tA[m][j] = 0; tB[m][j] = 0; }
        static_assert((T_TOK / 256) * 8 * 8 * 2 == NEXP, "units x waves x 2 must cover the expert table");
        const int qe0 = ((u.pm * 8 + u.pn) * 8 + wid) * 2;
        float4 qa4[2][4], qb4[2][4];
#pragma unroll 1
        for (int pp = 0; pp < 2; ++pp) {
            const bf16_t* kb = keysB + (size_t)(pp * 8 + h) * 16384 + lane * 8;
            const char* qa = sQ + pp * (256 * QT_PITCH) + (wid * 32 + fr) * QT_PITCH + fq * 16;
            f32x4 sc2[2][8];
#pragma unroll
            for (int m = 0; m < 2; ++m)
#pragma unroll
                for (int nb = 0; nb < 8; ++nb) sc2[m][nb] = (f32x4){0.f, 0.f, 0.f, 0.f};
#pragma unroll
            for (int kk = 0; kk < 4; ++kk) {
                bf16x8 kf[8], af[2];
#pragma unroll
                for (int nb = 0; nb < 8; ++nb) kf[nb] = *(const bf16x8*)(kb + (kk * 8 + nb) * 512);
#pragma unroll
                for (int m = 0; m < 2; ++m) af[m] = *(const bf16x8*)(qa + m * 16 * QT_PITCH + kk * 64);
#pragma unroll
                for (int m = 0; m < 2; ++m)
#pragma unroll
                    for (int nb = 0; nb < 8; ++nb) sc2[m][nb] = __builtin_amdgcn_mfma_f32_16x16x32_bf16(af[m], kf[nb], sc2[m][nb], 0, 0, 0);
            }
#pragma unroll
            for (int m = 0; m < 2; ++m)
#pragma unroll
                for (int j = 0; j < 4; ++j) tA[m][j] = tB[m][j];
            if (pp == 1) {
#pragma unroll
                for (int x = 0; x < 2; ++x) {
                    const float4* su4 = (const float4*)(pp_->peer_u + (size_t)(qe0 + x) * D_MODEL + lane * 16);
                    const float4* sv4 = (const float4*)(pp_->peer_v + (size_t)(qe0 + x) * D_MODEL + lane * 16);
#pragma unroll
                    for (int i = 0; i < 4; ++i) { qa4[x][i] = su4[i]; qb4[x][i] = sv4[i]; }
                }
            }
#pragma unroll 2
            for (int it = 0; it < 4; ++it) {
#pragma unroll
                for (int m = 0; m < 2; ++m) {
                    int k[8];
#pragma unroll
                    for (int nb = 0; nb < 8; ++nb) k[nb] = (f2key(sc2[m][nb][0]) & ~127) | (127 - (16 * nb + fr));
                    const int r = top16_rows(k, fr);
                    tB[m][0] = tB[m][1]; tB[m][1] = tB[m][2]; tB[m][2] = tB[m][3]; tB[m][3] = r;
#pragma unroll
                    for (int nb = 0; nb < 8; ++nb) sc2[m][nb] = (f32x4){sc2[m][nb][1], sc2[m][nb][2], sc2[m][nb][3], sc2[m][nb][0]};
                }
            }
        }
#pragma unroll 2
        for (int it = 0; it < 4; ++it) {
#pragma unroll
            for (int m = 0; m < 2; ++m) {
                int eid; float gt;
                combine16(tA[m][0], tB[m][0], cbv, lane, fr, eid, gt);
                const int t = u.pm * BM + wid * 32 + m * 16 + fq * 4 + it;
                const size_t o = (size_t)t * 128 + h * 16 + fr;
                idx[o] = eid; gate[o] = gt;
                tA[m][0] = tA[m][1]; tA[m][1] = tA[m][2]; tA[m][2] = tA[m][3];
                tB[m][0] = tB[m][1]; tB[m][1] = tB[m][2]; tB[m][2] = tB[m][3];
            }
        }
        quant_expert(*pp_, qe0, lane, qa4[0], qb4[0]);
        quant_expert(*pp_, qe0 + 1, lane, qa4[1], qb4[1]);
        __syncthreads();
    }
};
template <class Epi, class Sched>
__device__ __forceinline__ void gemm_phase(PG8_LAS unsigned char* lds, const Gemm g, const Sched& S, const Epi& E) {
    const int tid = tid_opaque(), wid = __builtin_amdgcn_readfirstlane(tid >> 6), lane = tid & 63, wr = wid >> 2, wc = wid & 3, fr = lane & 15, fq = lane >> 4;
    const int K = g.K, nt = K / BK;
    unsigned voffA[2], voffB[2];
#pragma unroll
    for (int i = 0; i < 2; ++i) { int R, C; stage_rc(tid * 16 + i * 8192, R, C); const int Rb = Epi::PERM ? ((R & ~31) + perm32(R & 31)) : R;
        voffA[i] = (unsigned)(R * K + C) * 2u; voffB[i] = (unsigned)(Rb * K + C) * 2u; }
    const size_t kstep = (size_t)(BK * 2);
    const size_t hstep = (size_t)HALF * K * 2;
    const size_t tstep = 2 * hstep;
    const unsigned ldsw = (unsigned)wid * 1024u;
    const int aoff = lds_byte(wr * 64 + fr, fq * 8), boff = lds_byte(wc * 32 + fr, fq * 8);
#define PG8_SA(b, h) (((b) * 2 + (h)) * HTB)
#define PG8_SB(b, h) ((4 + (b) * 2 + (h)) * HTB)
#define PG8_STAGE(bufoff, gbase, voff) do { _Pragma("unroll") for (int _i = 0; _i < 2; ++_i) \
        __builtin_amdgcn_global_load_lds((const unsigned*)((const char*)(gbase) + (voff)[_i]), (PG8_LAS unsigned*)(lds + (bufoff) + ldsw + _i * 8192), 16, 0, 0); } while (0)
#define PG8_LDA(dst, b, h) do { _Pragma("unroll") for (int m = 0; m < 4; ++m) _Pragma("unroll") for (int k = 0; k < 2; ++k) dst[m][k] = *(const PG8_LAS bf16x8*)(lds + PG8_SA(b, h) + aoff + m * 2048 + k * 1024); } while (0)
#define PG8_LDB(dst, b, h) do { _Pragma("unroll") for (int n = 0; n < 2; ++n) _Pragma("unroll") for (int k = 0; k < 2; ++k) dst[n][k] = *(const PG8_LAS bf16x8*)(lds + PG8_SB(b, h) + boff + n * 2048 + k * 1024); } while (0)
#define PG8_MMA(ai, bj, At, Bt) do { __builtin_amdgcn_s_setprio(1); _Pragma("unroll") for (int m = 0; m < 4; ++m) _Pragma("unroll") for (int n = 0; n < 2; ++n) _Pragma("unroll") for (int k = 0; k < 2; ++k) \
        acc[ai][bj][m][n] = mma1<Epi::I8>(Bt[n][k], At[m][k], acc[ai][bj][m][n]); __builtin_amdgcn_s_setprio(0); } while (0)
#define PG8_WAIT_V(n) asm volatile("s_waitcnt vmcnt(" #n ")" ::: "memory")
#define PG8_WAIT_L(n) asm volatile("s_waitcnt lgkmcnt(" #n ")" ::: "memory")
#define PG8_BAR __builtin_amdgcn_s_barrier()
#define PG8_SCHED __builtin_amdgcn_sched_barrier(0)
    Unit cur, nxt; int ui = 0;
    if (!S.next(0, cur)) return;
    typedef typename Epi::acc_t acc_t;
    acc_t acc[2][2][4][2];
#pragma unroll
    for (int a = 0; a < 2; ++a)
#pragma unroll
        for (int b = 0; b < 2; ++b)
#pragma unroll
            for (int m = 0; m < 4; ++m)
#pragma unroll
                for (int n = 0; n < 2; ++n) acc[a][b][m][n] = (acc_t)(0);
    bf16x8 At[4][2], B0[2][2], B1[2][2];
    const char* cA = (const char*)g.A + (size_t)cur.pm * tstep; const char* cB = (const char*)g.Bt + (size_t)cur.pn * tstep;
    S.a_ready(cur);
    PG8_STAGE(PG8_SB(0, 0), cB, voffB); PG8_STAGE(PG8_SA(0, 0), cA, voffA); PG8_STAGE(PG8_SB(0, 1), cB + hstep, voffB); PG8_STAGE(PG8_SA(0, 1), cA + hstep, voffA);
    if (wr == 1) PG8_BAR;
    PG8_WAIT_V(4); PG8_BAR;
    PG8_STAGE(PG8_SB(1, 0), cB + kstep, voffB); PG8_STAGE(PG8_SA(1, 0), cA + kstep, voffA); PG8_STAGE(PG8_SB(1, 1), cB + hstep + kstep, voffB);
    PG8_WAIT_V(6); PG8_BAR;
    for (;;) {
        const bool has_next = S.next(ui + 1, nxt);
        const char* nA = has_next ? (const char*)g.A + (size_t)nxt.pm * tstep : cA; const char* nB = has_next ? (const char*)g.Bt + (size_t)nxt.pn * tstep : cB;
        for (int t = 0; t < nt; t += 2) {
            const bool last = (t == nt - 2);
            const char* a1 = cA + (size_t)(t + 1) * kstep;
            const char* a2 = last ? nA : cA + (size_t)(t + 2) * kstep; const char* b2 = last ? nB : cB + (size_t)(t + 2) * kstep;
            const char* a3 = a2 + kstep; const char* b3 = b2 + kstep;
            if (last && has_next) S.a_ready(nxt);
            PG8_LDB(B0, 0, 0); PG8_SCHED; PG8_LDA(At, 0, 0); PG8_STAGE(PG8_SA(1, 1), a1 + hstep, voffA);
            PG8_WAIT_L(8); PG8_BAR; PG8_WAIT_L(0); PG8_MMA(0, 0, At, B0); PG8_BAR; PG8_SCHED;
            PG8_LDB(B1, 0, 1); PG8_STAGE(PG8_SB(0, 0), b2, voffB);
            PG8_BAR; PG8_WAIT_L(0); PG8_MMA(0, 1, At, B1); PG8_BAR;
            PG8_LDA(At, 0, 1); PG8_STAGE(PG8_SA(0, 0), a2, voffA);
            PG8_BAR; PG8_WAIT_L(0); PG8_MMA(1, 0, At, B0); PG8_BAR; PG8_SCHED;
            PG8_STAGE(PG8_SB(0, 1), b2 + hstep, voffB);
            PG8_WAIT_V(6); PG8_BAR; PG8_MMA(1, 1, At, B1); PG8_BAR;
            PG8_LDB(B0, 1, 0); PG8_SCHED; PG8_LDA(At, 1, 0); PG8_STAGE(PG8_SA(0, 1), a2 + hstep, voffA);
            PG8_WAIT_L(8); PG8_BAR; PG8_WAIT_L(0); PG8_MMA(0, 0, At, B0); PG8_BAR; PG8_SCHED;
            PG8_LDB(B1, 1, 1); PG8_STAGE(PG8_SB(1, 0), b3, voffB);
            PG8_BAR; PG8_WAIT_L(0); PG8_MMA(0, 1, At, B1); PG8_BAR;
            PG8_LDA(At, 1, 1); PG8_STAGE(PG8_SA(1, 0), a3, voffA);
            PG8_BAR; PG8_WAIT_L(0); PG8_MMA(1, 0, At, B0); PG8_BAR; PG8_SCHED;
            PG8_STAGE(PG8_SB(1, 1), b3 + hstep, voffB);
            PG8_WAIT_V(6); PG8_BAR; PG8_MMA(1, 1, At, B1); PG8_BAR;
        }
            if constexpr (!Epi::AFTER_DRAIN) { E(acc, cur, wr, wc, fr, fq); S.done(cur); }
            if (!has_next) break;
#pragma unroll
        for (int a = 0; a < 2; ++a)
#pragma unroll
            for (int b = 0; b < 2; ++b)
#pragma unroll
                for (int m = 0; m < 4; ++m)
#pragma unroll
                    for (int n = 0; n < 2; ++n) acc[a][b][m][n] = (acc_t)(0);
        cur = nxt; cA = nA; cB = nB; ++ui;
    }
    PG8_WAIT_V(0);
    if (wr == 0) PG8_BAR;
    PG8_BAR;
    if constexpr (Epi::AFTER_DRAIN) { E.fused(acc, cur, wr, wc, fr, fq, lds, wid, lane); S.done(cur); }
#undef PG8_SA
#undef PG8_SB
#undef PG8_STAGE
#undef PG8_LDA
#undef PG8_LDB
#undef PG8_MMA
#undef PG8_WAIT_V
#undef PG8_WAIT_L
#undef PG8_BAR
#undef PG8_SCHED
}
}

__device__ void phase_gemm_z(const Params& p, char* lds) {
    pg8::StaticOrder S; S.init(T_TOK, D_IN, gridDim.x, blockIdx.x);
    pg8::gemm_phase<pg8::EpiZ8, pg8::StaticOrder>((PG8_LAS unsigned char*)lds, pg8::Gemm{(const bf16_t*)p.xq, (const bf16_t*)p.winT8, T_TOK, D_IN, D_MODEL / 2}, S, pg8::EpiZ8{p.zb, p.rstd1, p.swb, p.lnp});
}
__device__ void phase_gemm_out(const Params& p, char* lds) {
    pg8::StaticOrder S; S.init(T_TOK, D_MODEL, gridDim.x, blockIdx.x);
    pg8::gemm_phase<pg8::EpiOut, pg8::StaticOrder>((PG8_LAS unsigned char*)lds, pg8::Gemm{p.cB, p.woutT, T_TOK, D_MODEL, D_MODEL}, S, pg8::EpiOut{p.hb, p.xq, p.sx});
}
__device__ void phase_gemm_q(const Params& p, char* lds) {
    pg8::StaticOrder S; S.init(T_TOK, 2048, gridDim.x, blockIdx.x);
    pg8::Unit u;
    for (int i = 0; S.next(i, u); ++i)
        pg8::gemm_phase<pg8::EpiQTopk, pg8::OneUnit>((PG8_LAS unsigned char*)lds, pg8::Gemm{(const bf16_t*)p.hq, (const bf16_t*)p.wqT8, T_TOK, 2048, D_MODEL / 2}, pg8::OneUnit{u}, pg8::EpiQTopk{p.keysB, p.idx, p.gate, p.swq, &p});
}

#define XB_TMO      128
#define XB_XCNT(j)  (256  + 64 * (j))
#define XB_XSUB(j)  (1280 + 64 * (j))
#define XB_XGEN(j)  (2304 + 64 * (j))
#define XB_TOP      3328
#define XB_TOPGEN   3392
#define XCD_BAR_WORDS 3456
#define XB_SPIN_CAP (1u << 20)
__device__ __forceinline__ unsigned xb_ld(unsigned* p)              { return __hip_atomic_load(p, __ATOMIC_RELAXED, __HIP_MEMORY_SCOPE_AGENT); }
__device__ __forceinline__ unsigned xb_add(unsigned* p, unsigned v) { return __hip_atomic_fetch_add(p, v, __ATOMIC_RELAXED, __HIP_MEMORY_SCOPE_AGENT); }
__device__ __forceinline__ unsigned xb_xcc_id() { return (unsigned)__builtin_amdgcn_s_getreg((3 << 11) | 20) & 0xFu; }
#define XB_SPIN(cond, bar) do { unsigned _sp = 0; while (cond) { __builtin_amdgcn_s_sleep(1); \
    if ((++_sp & 255u) == 0u) { if (xb_ld(&(bar)[XB_TMO])) break; if (_sp > XB_SPIN_CAP) { atomicAdd(&(bar)[XB_TMO], 1u); break; } } } } while (0)
struct XcdBarrier { unsigned* bar; unsigned x; volatile LAS unsigned* st; };
__device__ __forceinline__ XcdBarrier xcd_barrier_post(unsigned* bar, volatile LAS unsigned* st) {
    XcdBarrier b; b.bar = bar; b.x = xb_xcc_id(); b.st = st;
    if (threadIdx.x == 0) (void)xb_add(&bar[XB_XCNT(b.x)], 1u);
    return b;
}
__device__ __forceinline__ void xcd_barrier_complete(unsigned* bar, unsigned x, unsigned& nloc, unsigned& nx) {
    const unsigned G = gridDim.x * gridDim.y * gridDim.z;
    unsigned sum, cnt, mine, sp = 0u;
    for (;;) {
        sum = 0u; cnt = 0u; mine = 0u;
#pragma unroll
        for (unsigned j = 0; j < 16; ++j) { const unsigned c = xb_ld(&bar[XB_XCNT(j)]); sum += c; cnt += (c > 0u) ? 1u : 0u; mine = (j == x) ? c : mine; }
        if (sum == G) break;
        __builtin_amdgcn_s_sleep(1);
        if ((++sp & 255u) == 0u) { if (xb_ld(&bar[XB_TMO])) break; if (sp > XB_SPIN_CAP) { atomicAdd(&bar[XB_TMO], 1u); break; } }
    }
    nloc = mine > 0u ? mine : 1u; nx = cnt > 0u ? cnt : 1u;
}
__device__ __forceinline__ void xcd_barrier(const XcdBarrier& b) {
    asm volatile("s_waitcnt vmcnt(0)" ::: "memory");
    __syncthreads();
    if (threadIdx.x == 0) {
        unsigned* bar = b.bar;
        __builtin_amdgcn_s_waitcnt(0);
        unsigned nloc = b.st[0], nx = b.st[1];
        if (nloc == 0u) { xcd_barrier_complete(bar, b.x, nloc, nx); b.st[0] = nloc; b.st[1] = nx; }
        const unsigned old = xb_add(&bar[XB_XSUB(b.x)], 1u);
        const unsigned gen = old / nloc;
        if (old + 1u == (gen + 1u) * nloc) {
            __builtin_amdgcn_fence(__ATOMIC_RELEASE, "agent");
            asm volatile("s_waitcnt vmcnt(0)" ::: "memory");
            const unsigned og = xb_add(&bar[XB_TOP], 1u);
            const unsigned tg = og / nx;
            if (og + 1u == (tg + 1u) * nx) xb_add(&bar[XB_TOPGEN], 1u);
            else XB_SPIN(xb_ld(&bar[XB_TOPGEN]) == tg, bar);
            __builtin_amdgcn_fence(__ATOMIC_ACQUIRE, "agent");
            xb_add(&bar[XB_XGEN(b.x)], 1u);
            asm volatile("s_waitcnt vmcnt(0)" ::: "memory");
        } else {
            XB_SPIN(xb_ld(&bar[XB_XGEN(b.x)]) == gen, bar);
            __builtin_amdgcn_fence(__ATOMIC_ACQUIRE, "agent");
            asm volatile("s_waitcnt vmcnt(0)" ::: "memory");
        }
    }
    __syncthreads();
}

#define MEGA_LDS_MAX2(a, b) ((a) > (b) ? (a) : (b))
#define MEGA_LDS_MAIN MEGA_LDS_MAX2(MEGA_LDS_MAX2(QT_LDS_BYTES, pg8::STAGE_BYTES), MEGA_LDS_MAX2(8 * TS_WBYTES, 2 * MIXH_LDS))
#define MEGA_LDS_BYTES (MEGA_LDS_MAIN + 16)
extern __shared__ __attribute__((aligned(16))) char smem[];
__global__ void __launch_bounds__(512, 2) fwd_mega(Params p) {
    volatile LAS unsigned* st = (volatile LAS unsigned*)(smem + MEGA_LDS_MAIN);
    if (threadIdx.x < 4) st[threadIdx.x] = 0u;
    __syncthreads();
    const XcdBarrier xb = xcd_barrier_post(p.bar, st);
    phase_prep(p, smem);      xcd_barrier(xb);
    phase_gemm_z(p, smem);    xcd_barrier(xb);
    phase_mix_gemm(p, smem);  xcd_barrier(xb);
    phase_gemm_out(p, smem);  xcd_barrier(xb);
    phase_hquant(p, smem);    xcd_barrier(xb);
    phase_gemm_q(p, smem);    xcd_barrier(xb);
    phase_peer_dots(p, smem); xcd_barrier(xb);
    phase_gather(p, smem);
}

extern "C" void kernel_launch(void* const* d_in, const int* in_sizes, int n_in, void* d_out, int out_size, void* d_ws, size_t ws_size, hipStream_t stream) {
    static int grid_blocks = 0;
    if (grid_blocks == 0) {
        int dev = 0, cus = 0, per_cu = 0;
        (void)hipGetDevice(&dev);
        (void)hipDeviceGetAttribute(&cus, hipDeviceAttributeMultiprocessorCount, dev);
        (void)hipFuncSetAttribute((const void*)fwd_mega, hipFuncAttributeMaxDynamicSharedMemorySize, MEGA_LDS_BYTES);
        (void)hipOccupancyMaxActiveBlocksPerMultiprocessor(&per_cu, (const void*)fwd_mega, 512, MEGA_LDS_BYTES);
        if (per_cu > 1) per_cu = 1;
        if (per_cu < 1) per_cu = 1;
        grid_blocks = cus * per_cu;
    }
    Params p{};
    p.x = (const float*)d_in[0]; p.norm1_g = (const float*)d_in[1]; p.w_in = (const float*)d_in[2]; p.pool_w = (const float*)d_in[3];
    p.pool_scale = (const float*)d_in[4]; p.sgu_norm_g = (const float*)d_in[5]; p.sgu_w = (const float*)d_in[6]; p.sgu_b = (const float*)d_in[7];
    p.w_out = (const float*)d_in[8]; p.norm2_g = (const float*)d_in[9]; p.peer_wq = (const float*)d_in[10]; p.peer_keys = (const float*)d_in[11];
    p.peer_u = (const float*)d_in[12]; p.peer_v = (const float*)d_in[13]; p.final_g = (const float*)d_in[14];
    p.out = (float*)d_out;
    char* w = (char*)d_ws; size_t off = 0;
    auto take = [&](size_t bytes) { char* r = w + off; off += (bytes + 255) & ~(size_t)255; return r; };
    const size_t MiB = 1024 * 1024;
    p.u8 = (unsigned char*)take(16 * MiB); p.v8 = (unsigned char*)take(12 * MiB);
    p.suv = (float2*)take(128 * 1024);
    p.woutT = (bf16_t*)take(2 * MiB);
    p.poolT = (bf16_t*)take(128 * 1024); p.wsM = (bf16_t*)take(128 * 1024); p.keysB = (bf16_t*)take(512 * 1024);
    p.bar = (unsigned*)take(XCD_BAR_WORDS * 4 + 4608 * 4); p.swb = p.bar + XCD_BAR_WORDS; p.swq = p.swb + 2048;
    p.rstd1 = (float*)take(128 * 1024); p.sx = (float*)take(128 * 1024); p.xq = (signed char*)take(32 * MiB); p.winT8 = (signed char*)take(1536 * 1024); p.wqT8 = (signed char*)take(2048 * 1024); p.hq = (signed char*)take(32 * MiB); p.hsc = (float*)take(128 * 1024);
    p.idx = (int*)take(16 * MiB); p.gate = (float*)take(16 * MiB); p.coef = (float*)take(16 * MiB);
    p.lnp = (float2*)take(2 * MiB); p.zb = (bf16_t*)take(96 * MiB); p.cB = (bf16_t*)take(64 * MiB); p.hb = (bf16_t*)take(64 * MiB);
    (void)hipMemsetAsync(p.bar, 0, XCD_BAR_WORDS * 4 + 4608 * 4, stream);
    hipLaunchKernelGGL(fwd_mega, dim3(grid_blocks), dim3(512), MEGA_LDS_BYTES, stream, p);
}
```

```cpp
#include <hip/hip_runtime.h>
#include <stdint.h>
#include <type_traits>

typedef unsigned short bf16_t;
typedef short bf16x8 __attribute__((ext_vector_type(8)));
typedef float f32x4 __attribute__((ext_vector_type(4)));
typedef unsigned u32x4 __attribute__((ext_vector_type(4)));
typedef unsigned u32x2 __attribute__((ext_vector_type(2)));
typedef unsigned u32x3 __attribute__((ext_vector_type(3)));
typedef int i32x4 __attribute__((ext_vector_type(4)));
#define ROWB 768
typedef __bf16 bf2_t __attribute__((ext_vector_type(2)));
#define LAS __attribute__((address_space(3)))

#define T_TOK 32768
#define D_MODEL 1024
#define D_IN 1536
#define SEQ 2048
#define NEXP 16384
#define EPS 1e-6f

struct Params {
    const float *x, *norm1_g, *w_in, *pool_w, *pool_scale, *sgu_norm_g, *sgu_w, *sgu_b, *w_out, *norm2_g, *peer_wq, *peer_keys, *peer_u, *peer_v, *final_g;
    float* out;
    bf16_t *woutT, *poolT, *wsM, *keysB;
    unsigned char *u8, *v8;
    float2* suv;
    float *rstd1, *sx;
    signed char *xq, *winT8, *hq, *wqT8; unsigned *swb, *swq; float* hsc;
    bf16_t *zb, *cB, *hb;
    float2* lnp;
    int* idx; float* gate; float* coef;
    unsigned* bar;
};

__device__ __forceinline__ int tid_opaque() { int t = (int)threadIdx.x; asm volatile("" : "+v"(t)); return t; }
__device__ __forceinline__ unsigned short f2bf(float f) {
    unsigned u = __float_as_uint(f);
    u += 0x7fffu + ((u >> 16) & 1u);
    return (unsigned short)(u >> 16);
}
__device__ __forceinline__ float bf2f(unsigned short h) { return __uint_as_float(((unsigned)h) << 16); }
__device__ __forceinline__ unsigned pack2(float a, float b) { return (unsigned)f2bf(a) | ((unsigned)f2bf(b) << 16); }
__device__ __forceinline__ float bflo(unsigned w) { return __uint_as_float(w << 16); }
__device__ __forceinline__ float bfhi(unsigned w) { return __uint_as_float(w & 0xffff0000u); }
__device__ __forceinline__ float gelu_t(float x) {
    const float y = 1.5957691216057308f * (x + 0.044715f * x * x * x);
    return x * __builtin_amdgcn_rcpf(1.0f + __expf(-y));
}
__device__ __forceinline__ float wave_sum(float v) {
#pragma unroll
    for (int o = 32; o >= 1; o >>= 1) v += __shfl_xor(v, o);
    return v;
}
__device__ __forceinline__ float wave_max(float v) {
#pragma unroll
    for (int o = 32; o >= 1; o >>= 1) v = fmaxf(v, __shfl_xor(v, o));
    return v;
}

#define GEMM_LDS_BYTES (2 * 128 * 144)
__device__ __forceinline__ void transpose_tile(const int tid, const float* __restrict__ src, bf16_t* __restrict__ dst, int R, int C, const float* __restrict__ rscale, int tile, float* lds) {
    const int tilesC = C / 64, tr = tile / tilesC, tc = tile % tilesC;
    const int ty = tid >> 6, tx = tid & 63;
    __syncthreads();
#pragma unroll
    for (int i = 0; i < 16; ++i) {
        const int r = ty + 4 * i;
        float v = src[(size_t)(tr * 64 + r) * C + tc * 64 + tx];
        if (rscale) v *= rscale[tr * 64 + r];
        lds[r * 65 + tx] = v;
    }
    __syncthreads();
#pragma unroll
    for (int i = 0; i < 16; ++i) {
        const int c = ty + 4 * i;
        dst[(size_t)(tc * 64 + c) * R + tr * 64 + tx] = f2bf(lds[tx * 65 + c]);
    }
}

__device__ __forceinline__ void w8_colmax(const float* __restrict__ src, const float* __restrict__ gain, int C, unsigned* mx, unsigned* cnt, int hb2, int nh, int ht) {
    const int ncb = C / 64;
    for (int t = hb2; t < 16 * ncb; t += nh) {
        const int tr = t / ncb, tc = t % ncb, ty = ht >> 6, tx = ht & 63;
        float am = 0.f;
#pragma unroll
        for (int i = 0; i < 16; ++i) { const int r = tr * 64 + ty + 4 * i; am = fmaxf(am, fabsf(src[(size_t)r * C + tc * 64 + tx] * gain[r])); }
        (void)__hip_atomic_fetch_max(mx + tc * 64 + tx, __float_as_uint(am), __ATOMIC_RELAXED, __HIP_MEMORY_SCOPE_AGENT);
        asm volatile("s_waitcnt vmcnt(0)" ::: "memory");
        __syncthreads();
        if (ht == 0) (void)__hip_atomic_fetch_add(cnt + tc, 1u, __ATOMIC_RELAXED, __HIP_MEMORY_SCOPE_AGENT);
    }
}
__device__ __forceinline__ void w8_tiles(const float* __restrict__ src, const float* __restrict__ gain, int C, signed char* __restrict__ dst, unsigned* mx, unsigned* cnt, char* lds, int tid) {
    const int half = tid >> 8, ht = tid & 255, ty = ht >> 6, tx = ht & 63, ncb = C / 64;
    float* fl = (float*)(lds + half * (64 * 65 * 4));
    for (int t = 2 * blockIdx.x + half; t < 16 * ncb; t += 2 * gridDim.x) {
        const int tr = t / ncb, tc = t % ncb;
        if (ht == 0) {
            unsigned spins = 0;
            while (__hip_atomic_load(cnt + tc, __ATOMIC_RELAXED, __HIP_MEMORY_SCOPE_AGENT) < 16u && ++spins < (1u << 22)) __builtin_amdgcn_s_sleep(2);
        }
        __syncthreads();
#pragma unroll
        for (int i = 0; i < 16; ++i) { const int r = ty + 4 * i; fl[r * 65 + tx] = src[(size_t)(tr * 64 + r) * C + tc * 64 + tx] * gain[tr * 64 + r]; }
        __syncthreads();
#pragma unroll
        for (int i = 0; i < 16; ++i) {
            const int c = ty + 4 * i;
            const float am = __uint_as_float(__hip_atomic_load(mx + tc * 64 + c, __ATOMIC_RELAXED, __HIP_MEMORY_SCOPE_AGENT));
            const float inv = am > 0.f ? 127.0f / am : 0.f;
            dst[(size_t)(tc * 64 + c) * 1024 + tr * 64 + tx] = (signed char)(int)rintf(fl[tx * 65 + c] * inv);
        }
    }
}

__device__ __forceinline__ void quant_expert(const Params& p, const int e, const int lane, const float4 (&a4)[4], const float4 (&b4)[4]) {
    float fu[16], fv[16];
#pragma unroll
    for (int i = 0; i < 4; ++i) {
        const float4 g = ((const float4*)(p.norm2_g + lane * 16))[i];
        fu[4 * i] = a4[i].x * g.x; fu[4 * i + 1] = a4[i].y * g.y; fu[4 * i + 2] = a4[i].z * g.z; fu[4 * i + 3] = a4[i].w * g.w;
        fv[4 * i] = b4[i].x; fv[4 * i + 1] = b4[i].y; fv[4 * i + 2] = b4[i].z; fv[4 * i + 3] = b4[i].w;
    }
    {
        float am = 0.f;
#pragma unroll
        for (int j = 0; j < 16; ++j) am = fmaxf(am, fabsf(fu[j]));
        am = wave_max(am);
        const float inv = am > 0.f ? 127.0f / am : 0.f;
        u32x4 o;
#pragma unroll
        for (int i = 0; i < 4; ++i) {
            unsigned w = 0;
#pragma unroll
            for (int k = 0; k < 4; ++k) w |= (unsigned)(((int)rintf(fu[4 * i + k] * inv)) & 0xff) << (8 * k);
            o[i] = w;
        }
        *(u32x4*)(p.u8 + (size_t)e * D_MODEL + lane * 16) = o;
        if (lane == 0) p.suv[e].x = am * (1.0f / 127.0f);
    }
    {
        float am = 0.f;
#pragma unroll
        for (int j = 0; j < 16; ++j) am = fmaxf(am, fabsf(fv[j]));
        am = wave_max(am);
        const float inv = am > 0.f ? 31.0f / am : 0.f;
        int q[16];
#pragma unroll
        for (int j = 0; j < 16; ++j) q[j] = (int)rintf(fv[j] * inv) + 32;
        unsigned dg[3][4];
#pragma unroll
        for (int k = 0; k < 4; ++k) {
            int ee = q[12 + k] - 42;
#pragma unroll
            for (int i = 0; i < 3; ++i) { const int d = ee & 3, D = d >= 2 ? d - 4 : d; dg[i][k] = (unsigned)d; ee = (ee - D) >> 2; }
        }
        u32x3 o;
#pragma unroll
        for (int i = 0; i < 3; ++i) {
            unsigned w = 0;
#pragma unroll
            for (int k = 0; k < 4; ++k) w |= (unsigned)(q[4 * i + k] | (dg[i][k] << 6)) << (8 * k);
            o[i] = w;
        }
        *(u32x3*)(p.v8 + (size_t)e * ROWB + lane * 12) = o;
        if (lane == 0) p.suv[e].y = am * (1.0f / 31.0f);
    }
}

__device__ void phase_prep(const Params& p, char* lds) {
    const int tidx_ = tid_opaque();
    const int nb = gridDim.x, b = blockIdx.x, tid = tidx_;
    const int half = tid >> 8, ht = tid & 255, nh = 2 * nb, hb2 = 2 * b + half;
    float* fl = (float*)(lds + half * (64 * 65 * 4));
    w8_colmax(p.w_in, p.norm1_g, 1536, p.swb, p.swb + 1536, hb2, nh, ht);
    w8_colmax(p.peer_wq, p.norm2_g, 2048, p.swq, p.swq + 2048, hb2, nh, ht);
    for (int t = hb2; t < 16 * 16; t += nh) transpose_tile(ht, p.w_out, p.woutT, 1024, 1024, nullptr, t, fl);
    for (int t = hb2; t < 16; t += nh) transpose_tile(ht, p.pool_w + (size_t)(t >> 2) * 16384, p.poolT + (size_t)(t >> 2) * 16384, 128, 128, nullptr, t & 3, fl);
    const size_t gtid = (size_t)b * blockDim.x + tid, gsz = (size_t)nb * blockDim.x;
    for (size_t i = gtid; i < 4 * 128 * 128; i += gsz) {
        const int j = (int)(i & 127), ii = (int)((i >> 7) & 127);
        const bool keep = (j >> 6) <= (ii >> 6);
        p.wsM[i] = keep ? f2bf(p.sgu_w[i]) : (bf16_t)0;
    }
    for (size_t o = gtid; o < 2 * 8 * 128 * 128; o += gsz) {
        const int j = (int)(o & 7), ln = (int)((o >> 3) & 63), nb = (int)((o >> 9) & 7), kk = (int)((o >> 12) & 3), ph = (int)(o >> 14);
        p.keysB[o] = f2bf(p.peer_keys[(size_t)ph * 16384 + (size_t)(16 * nb + (ln & 15)) * 128 + 32 * kk + 8 * (ln >> 4) + j]);
    }
    const int wave = (b * blockDim.x + tid) >> 6, nwaves = (nb * blockDim.x) >> 6, lane = tid & 63;
    for (int t = wave; t < T_TOK; t += 2 * nwaves) {
        const int t1 = t + nwaves; const bool two = t1 < T_TOK;
        const float4* xr0 = (const float4*)(p.x + (size_t)t * D_MODEL);
        const float4* xr1 = (const float4*)(p.x + (size_t)(two ? t1 : t) * D_MODEL);
        float4 v0[4], v1[4];
#pragma unroll
        for (int i = 0; i < 4; ++i) { v0[i] = xr0[lane + 64 * i]; v1[i] = xr1[lane + 64 * i]; }
        float s0 = 0.f, s1 = 0.f, a0 = 0.f, a1 = 0.f;
#pragma unroll
        for (int i = 0; i < 4; ++i) {
            s0 += v0[i].x * v0[i].x + v0[i].y * v0[i].y + v0[i].z * v0[i].z + v0[i].w * v0[i].w;
            s1 += v1[i].x * v1[i].x + v1[i].y * v1[i].y + v1[i].z * v1[i].z + v1[i].w * v1[i].w;
            a0 = fmaxf(fmaxf(a0, fmaxf(fabsf(v0[i].x), fabsf(v0[i].y))), fmaxf(fabsf(v0[i].z), fabsf(v0[i].w)));
            a1 = fmaxf(fmaxf(a1, fmaxf(fabsf(v1[i].x), fabsf(v1[i].y))), fmaxf(fabsf(v1[i].z), fabsf(v1[i].w)));
        }
        s0 = wave_sum(s0); s1 = wave_sum(s1); a0 = wave_max(a0); a1 = wave_max(a1);
        const float i0 = a0 > 0.f ? 127.0f / a0 : 0.f, i1 = a1 > 0.f ? 127.0f / a1 : 0.f;
#pragma unroll
        for (int i = 0; i < 4; ++i) {
            const unsigned q0 = ((unsigned)((int)rintf(v0[i].x * i0) & 0xff)) | ((unsigned)((int)rintf(v0[i].y * i0) & 0xff) << 8) | ((unsigned)((int)rintf(v0[i].z * i0) & 0xff) << 16) | ((unsigned)((int)rintf(v0[i].w * i0) & 0xff) << 24);
            ((unsigned*)(p.xq + (size_t)t * D_MODEL))[lane + 64 * i] = q0;
            if (two) {
                const unsigned q1 = ((unsigned)((int)rintf(v1[i].x * i1) & 0xff)) | ((unsigned)((int)rintf(v1[i].y * i1) & 0xff) << 8) | ((unsigned)((int)rintf(v1[i].z * i1) & 0xff) << 16) | ((unsigned)((int)rintf(v1[i].w * i1) & 0xff) << 24);
                ((unsigned*)(p.xq + (size_t)t1 * D_MODEL))[lane + 64 * i] = q1;
            }
        }
        if (lane == 0) {
            p.rstd1[t] = rsqrtf(s0 * (1.0f / D_MODEL) + EPS) * a0 * (1.0f / 127.0f); p.sx[t] = a0 * (1.0f / 127.0f);
            if (two) { p.rstd1[t1] = rsqrtf(s1 * (1.0f / D_MODEL) + EPS) * a1 * (1.0f / 127.0f); p.sx[t1] = a1 * (1.0f / 127.0f); }
        }
    }
    w8_tiles(p.w_in, p.norm1_g, 1536, p.winT8, p.swb, p.swb + 1536, lds, tid);
    w8_tiles(p.peer_wq, p.norm2_g, 2048, p.wqT8, p.swq, p.swq + 2048, lds, tid);
}

typedef short s16x4 __attribute__((ext_vector_type(4)));
template <class Epi, class Fin>
__device__ __forceinline__ void gemm128_sgu(const int tid, const bf16_t* __restrict__ A, const bf16_t* __restrict__ V  ,
                                            const float* __restrict__ lnm, const float* __restrict__ lnr, const float* __restrict__ gch, char* lds, const Epi& epi, const Fin& fin) {
    const int lane = tid & 63, wid = tid >> 6, wr = wid >> 1, wc = wid & 1, fr = lane & 15, fq = lane >> 4;
    constexpr int PITCH = 144, P2 = 288;
    char* sA = lds; char* sB = lds + 128 * PITCH;
    f32x4 acc[4][4];
#pragma unroll
    for (int m = 0; m < 4; ++m)
#pragma unroll
        for (int n = 0; n < 4; ++n) acc[m][n] = (f32x4){0.f, 0.f, 0.f, 0.f};
    u32x4 ra[4], rb[4]; float rm[4], rr[4];
    const int lrow = tid >> 3, lch = tid & 7;
    const int btok = tid >> 4, bch = tid & 15;
    const bf16_t* ga = A + (size_t)lrow * 128 + lch * 8;
    const bf16_t* gb = V + (size_t)btok * D_IN + bch * 8;
    float g8[8];
    { const float4 g0 = *(const float4*)(gch + bch * 8), g1 = *(const float4*)(gch + bch * 8 + 4); g8[0] = g0.x; g8[1] = g0.y; g8[2] = g0.z; g8[3] = g0.w; g8[4] = g1.x; g8[5] = g1.y; g8[6] = g1.z; g8[7] = g1.w; }
#pragma unroll
    for (int j = 0; j < 4; ++j) { ra[j] = *(const u32x4*)(ga + (size_t)(32 * j) * 128); rb[j] = *(const u32x4*)(gb + (size_t)(16 * j) * D_IN); rm[j] = lnm[btok + 16 * j]; rr[j] = lnr[btok + 16 * j]; }
    for (int k0 = 0; k0 < 128; k0 += 64) {
        __syncthreads();
#pragma unroll
        for (int j = 0; j < 4; ++j) {
            *(u32x4*)(sA + (lrow + 32 * j) * PITCH + lch * 16) = ra[j];
            u32x4 o;
#pragma unroll
            for (int i = 0; i < 4; ++i) {
                const unsigned w = rb[j][i];
                o[i] = pack2((bflo(w) - rm[j]) * rr[j] * g8[2 * i], (bfhi(w) - rm[j]) * rr[j] * g8[2 * i + 1]);
            }
            *(u32x4*)(sB + (btok + 16 * j) * P2 + bch * 16) = o;
        }
        __syncthreads();
        if (k0 + 64 < 128) {
#pragma unroll
            for (int j = 0; j < 4; ++j) { ra[j] = *(const u32x4*)(ga + (size_t)(32 * j) * 128 + 64); rb[j] = *(const u32x4*)(gb + (size_t)(64 + 16 * j) * D_IN); rm[j] = lnm[64 + btok + 16 * j]; rr[j] = lnr[64 + btok + 16 * j]; }
        }
#pragma unroll
        for (int kk = 0; kk < 2; ++kk) {
            bf16x8 af[4], bfr[4];
#pragma unroll
            for (int m = 0; m < 4; ++m) af[m] = *(const bf16x8*)(sA + (wr * 64 + m * 16 + fr) * PITCH + (kk * 32 + fq * 8) * 2);
#pragma unroll
            for (int n = 0; n < 4; ++n) {
                const char* bp = sB + (kk * 32 + fq * 8 + (fr >> 2)) * P2 + (wc * 64 + n * 16 + 4 * (fr & 3)) * 2;
                const s16x4 lo = __builtin_amdgcn_ds_read_tr16_b64_v4i16((LAS s16x4*)(bp));
                const s16x4 hi = __builtin_amdgcn_ds_read_tr16_b64_v4i16((LAS s16x4*)(bp + 4 * P2));
                bfr[n] = (bf16x8){lo[0], lo[1], lo[2], lo[3], hi[0], hi[1], hi[2], hi[3]};
            }
#pragma unroll
            for (int m = 0; m < 4; ++m)
#pragma unroll
                for (int n = 0; n < 4; ++n) acc[m][n] = __builtin_amdgcn_mfma_f32_16x16x32_bf16(bfr[n], af[m], acc[m][n], 0, 0, 0);
        }
    }
    __syncthreads();
#pragma unroll
    for (int m = 0; m < 4; ++m)
#pragma unroll
        for (int n = 0; n < 4; ++n) { const int r = wr * 64 + m * 16 + fr, c = wc * 64 + n * 16 + fq * 4; *(uint2*)(lds + r * 272 + c * 2) = epi(r, c, acc[m][n]); }
    u32x4 pre[8];
#pragma unroll
    for (int j = 0; j < 8; ++j) { const int id = tid + 256 * j; pre[j] = fin.prefetch(id >> 4, id & 15); }
    __syncthreads();
#pragma unroll
    for (int j = 0; j < 8; ++j) { const int id = tid + 256 * j, row = id >> 4, ch = id & 15; fin.store(row, ch, *(const u32x4*)(lds + row * 272 + ch * 16), pre[j]); }
}

#define PT_PITCH 272
#define MIXH_LDS (2 * 128 * PT_PITCH + 1024)
template <int W, class Epi>
__device__ __forceinline__ void pool_tile(const int tid, const bf16_t* __restrict__ zb0  , int pos0,
                                          const bf16_t* __restrict__ Bt, char* lds, const Epi& epi, bf16_t* __restrict__ co  ) {
    const int lane = tid & 63, wid = tid >> 6, wr = wid >> 1, wc = wid & 1, fr = lane & 15, fq = lane >> 4;
    char* sA = lds; char* sB = lds + 128 * PT_PITCH;
    __syncthreads();
#pragma unroll
    for (int j = 0; j < 8; ++j) { const int id = tid + 256 * j, row = id >> 4, ch = id & 15; *(u32x4*)(sB + row * PT_PITCH + ch * 16) = *(const u32x4*)(Bt + (size_t)row * 128 + ch * 8); }
    {
        const int seg = tid >> 5, hc = tid & 31, r0 = seg * 16;
        const bool at_start = (pos0 & (SEQ - 1)) == 0;
        const bf16_t* zp = zb0 + hc * 4;
        u32x2 v[W + 16];
#pragma unroll
        for (int i = 0; i < W + 16; ++i) { const int rr = r0 - W + i; const bool ok = !(at_start && rr < 0); v[i] = *(const u32x2*)(zp + (ptrdiff_t)(ok ? rr : 0) * D_IN); }
        float sm[4] = {0.f, 0.f, 0.f, 0.f};
#pragma unroll
        for (int i = 1; i <= W; ++i) {
            const float m = (at_start && (r0 - W + i) < 0) ? 0.f : 1.f;
            sm[0] += m * bflo(v[i].x); sm[1] += m * bfhi(v[i].x); sm[2] += m * bflo(v[i].y); sm[3] += m * bfhi(v[i].y);
        }
#pragma unroll
        for (int o = 0; o < 16; ++o) {
            if (o > 0) {
                const float md = (at_start && (r0 + o - W) < 0) ? 0.f : 1.f;
                sm[0] += bflo(v[W + o].x) - md * bflo(v[o].x); sm[1] += bfhi(v[W + o].x) - md * bfhi(v[o].x);
                sm[2] += bflo(v[W + o].y) - md * bflo(v[o].y); sm[3] += bfhi(v[W + o].y) - md * bfhi(v[o].y);
            }
            const int pos = (pos0 + r0 + o) & (SEQ - 1);
            const float rn = 1.0f / (float)((pos + 1 < W) ? pos + 1 : W);
            u32x2 ov;
            ov.x = pack2(sm[0] * rn - bflo(v[W + o].x), sm[1] * rn - bfhi(v[W + o].x));
            ov.y = pack2(sm[2] * rn - bflo(v[W + o].y), sm[3] * rn - bfhi(v[W + o].y));
            *(u32x2*)(sA + (r0 + o) * PT_PITCH + hc * 8) = ov;
        }
    }
    __syncthreads();
    f32x4 acc[4][4];
#pragma unroll
    for (int m = 0; m < 4; ++m)
#pragma unroll
        for (int n = 0; n < 4; ++n) acc[m][n] = (f32x4){0.f, 0.f, 0.f, 0.f};
#pragma unroll
    for (int kk = 0; kk < 4; ++kk) {
        bf16x8 af[4], bfr[4];
#pragma unroll
        for (int m = 0; m < 4; ++m) af[m] = *(const bf16x8*)(sA + (wr * 64 + m * 16 + fr) * PT_PITCH + (kk * 32 + fq * 8) * 2);
#pragma unroll
        for (int n = 0; n < 4; ++n) bfr[n] = *(const bf16x8*)(sB + (wc * 64 + n * 16 + fr) * PT_PITCH + (kk * 32 + fq * 8) * 2);
#pragma unroll
        for (int m = 0; m < 4; ++m)
#pragma unroll
            for (int n = 0; n < 4; ++n) acc[m][n] = __builtin_amdgcn_mfma_f32_16x16x32_bf16(bfr[n], af[m], acc[m][n], 0, 0, 0);
    }
    __syncthreads();
#pragma unroll
    for (int m = 0; m < 4; ++m)
#pragma unroll
        for (int n = 0; n < 4; ++n) { const int r = wr * 64 + m * 16 + fr, c = wc * 64 + n * 16 + fq * 4; *(uint2*)(lds + r * PT_PITCH + c * 2) = epi(r, c, acc[m][n]); }
    __syncthreads();
#pragma unroll
    for (int j = 0; j < 8; ++j) { const int id = tid + 256 * j, row = id >> 4, ch = id & 15; *(u32x4*)(co + (size_t)row * D_MODEL + ch * 8) = *(const u32x4*)(lds + row * PT_PITCH + ch * 16); }
}

struct SguFin {
    const bf16_t* uo; bf16_t* co;
    __device__ __forceinline__ u32x4 prefetch(int row, int ch) const { return *(const u32x4*)(uo + (size_t)row * D_IN + ch * 8); }
    __device__ __forceinline__ void store(int row, int ch, const u32x4 w, const u32x4 uu) const {
        u32x4 o;
#pragma unroll
        for (int i = 0; i < 4; ++i) o[i] = pack2(bflo(w[i]) * bflo(uu[i]), bfhi(w[i]) * bfhi(uu[i]));
        *(u32x4*)(co + (size_t)row * D_MODEL + ch * 8) = o;
    }
};
__device__ void phase_mix_gemm(const Params& p, char* lds) {
    const int tidx_ = tid_opaque();
    const int npool = (T_TOK / 128) * 4, nsgu = (T_TOK / 128) * 4;
    const int half = tidx_ >> 8, ht_ = tidx_ & 255; lds += half * MIXH_LDS;
    for (int tile = 2 * blockIdx.x + half; tile < npool + nsgu; tile += 2 * gridDim.x) {
        int ht = ht_; asm volatile("" : "+v"(ht));
        if (tile < npool) {
            const int tm = tile >> 2, g = tile & 3;
            const float* ps = p.pool_scale + g * 128; bf16_t* co = p.cB + (size_t)tm * 128 * D_MODEL + g * 128;
            const bf16_t* z0 = p.zb + (size_t)tm * 128 * D_IN + g * 128; const bf16_t* bt = p.poolT + (size_t)g * 16384;
            auto epi = [&](int r, int c, f32x4 v) {
                const float4 sc = *(const float4*)(ps + c);
                uint2 o; o.x = pack2(v[0] * sc.x, v[1] * sc.y); o.y = pack2(v[2] * sc.z, v[3] * sc.w);
                return o;
            };
            if (g == 0) pool_tile<2>(ht, z0, tm * 128, bt, lds, epi, co); else if (g == 1) pool_tile<4>(ht, z0, tm * 128, bt, lds, epi, co);
            else if (g == 2) pool_tile<8>(ht, z0, tm * 128, bt, lds, epi, co); else pool_tile<16>(ht, z0, tm * 128, bt, lds, epi, co);
        } else {
            const int t2 = tile - npool, blk = t2 >> 2, h = t2 & 3;
            float* stm = (float*)(lds + GEMM_LDS_BYTES); float* str = stm + 128;
            __syncthreads();
            if (ht < 128) {
                const float4* pp = (const float4*)(p.lnp + (size_t)(blk * 128 + ht) * 8);
                const float4 a0 = pp[0], a1 = pp[1], a2 = pp[2], a3 = pp[3];
                const float s1 = ((a0.x + a0.z) + (a1.x + a1.z)) + ((a2.x + a2.z) + (a3.x + a3.z)), s2 = ((a0.y + a0.w) + (a1.y + a1.w)) + ((a2.y + a2.w) + (a3.y + a3.w));
                const float mean = s1 * (1.0f / 512.0f), var = fmaxf(s2 * (1.0f / 512.0f) - mean * mean, 0.f);
                stm[ht] = mean; str[ht] = rsqrtf(var + EPS);
            }
            __syncthreads();
            const float* sb = p.sgu_b + h * 128; const bf16_t* uo = p.zb + (size_t)blk * 128 * D_IN + 512 + h * 128;
            bf16_t* co = p.cB + (size_t)blk * 128 * D_MODEL + 512 + h * 128;
            gemm128_sgu(ht, p.wsM + (size_t)h * 16384, p.zb + (size_t)blk * 128 * D_IN + 1024 + h * 128, stm, str, p.sgu_norm_g + h * 128, lds,
                    [&](int r, int c, f32x4 v) {
                        const float bb = sb[r];
                        uint2 o; o.x = pack2(v[0] + bb, v[1] + bb); o.y = pack2(v[2] + bb, v[3] + bb);
                        return o;
                    }, SguFin{uo, co});
        }
    }
}

__device__ __forceinline__ int wave_sum_i_uniform(int s) {
    s += __builtin_amdgcn_update_dpp(0, s, 0xB1, 0xf, 0xf, false);
    s += __builtin_amdgcn_update_dpp(0, s, 0x4E, 0xf, 0xf, false);
    s += __builtin_amdgcn_update_dpp(0, s, 0x141, 0xf, 0xf, false);
    s += __builtin_amdgcn_update_dpp(0, s, 0x140, 0xf, 0xf, false);
    return __builtin_amdgcn_readlane(s, 0) + __builtin_amdgcn_readlane(s, 16) + __builtin_amdgcn_readlane(s, 32) + __builtin_amdgcn_readlane(s, 48);
}
__constant__ unsigned char kComb[64] = {
    0x00,0x01,0x02,0x03,0x04,0x05,0x06,0x07,0x08,0x09,0x0a,0x0b,0x0c,0x0d,0x0e,0x0f,
    0x10,0x11,0x12,0x13,0x14,0x15,0x16,0x17,
    0x20,0x21,0x22,0x23,0x24,
    0x30,0x31,0x32,0x33,
    0x40,0x41,0x42,
    0x50,0x51,
    0x60,0x61,
    0x70,0x71,
    0x80,0x90,0xa0,0xb0,0xc0,0xd0,0xe0,0xf0,
    0xff,0xff,0xff,0xff,0xff,0xff,0xff,0xff,0xff,0xff,0xff,0xff,0xff,0xff};

template <int CTRL> __device__ __forceinline__ int dpp_i(int v) { return __builtin_amdgcn_update_dpp(0, v, CTRL, 0xf, 0xf, false); }
__device__ __forceinline__ int row_allmax_i(int v) {
    v = max(v, dpp_i<0x128>(v)); v = max(v, dpp_i<0x124>(v)); v = max(v, dpp_i<0x122>(v)); v = max(v, dpp_i<0x121>(v));
    return v;
}
__device__ __forceinline__ float row_allsum_f(float v) {
    v += __int_as_float(dpp_i<0x128>(__float_as_int(v))); v += __int_as_float(dpp_i<0x124>(__float_as_int(v)));
    v += __int_as_float(dpp_i<0x122>(__float_as_int(v))); v += __int_as_float(dpp_i<0x121>(__float_as_int(v)));
    return v;
}
__device__ __forceinline__ int f2key(float f) { const int b = __float_as_int(f); return b ^ ((b >> 31) & 0x7fffffff); }
__device__ __forceinline__ float key2f(int k) { return __int_as_float(k ^ ((k >> 31) & 0x7fffffff)); }
#define KEY_MIN ((int)0x80000000)
#define CE(a, b) { const int hi_ = max(a, b), lo_ = min(a, b); a = hi_; b = lo_; }
__device__ __forceinline__ int top16_rows(int (&k)[8], int l15) {
    CE(k[0], k[1]) CE(k[2], k[3]) CE(k[4], k[5]) CE(k[6], k[7])
    CE(k[0], k[2]) CE(k[1], k[3]) CE(k[4], k[6]) CE(k[5], k[7])
    CE(k[1], k[2]) CE(k[5], k[6])
    CE(k[0], k[4]) CE(k[1], k[5]) CE(k[2], k[6]) CE(k[3], k[7])
    CE(k[2], k[4]) CE(k[3], k[5])
    CE(k[1], k[2]) CE(k[3], k[4]) CE(k[5], k[6])
    int res = KEY_MIN;
#pragma unroll
    for (int r = 0; r < 16; ++r) {
        const int m = row_allmax_i(k[0]);
        const bool own = (k[0] == m);
#pragma unroll
        for (int j = 0; j < 7; ++j) k[j] = own ? k[j + 1] : k[j];
        k[7] = own ? KEY_MIN : k[7];
        res = (l15 == r) ? m : res;
    }
    return res;
}
__device__ __forceinline__ void combine16(int A, int B, const int (&cbv)[4], int lane, int l15, int& eid_out, float& gate_out) {
    const int rowbase = lane & 48;
    int ck[4], eid[4];
#pragma unroll
    for (int c = 0; c < 4; ++c) {
        const int ci = (cbv[c] >> 4) & 15, cj = cbv[c] & 15;
        const int ka = __builtin_amdgcn_ds_bpermute((rowbase + ci) << 2, A);
        const int kb = __builtin_amdgcn_ds_bpermute((rowbase + cj) << 2, B);
        const float sm = key2f(ka & ~127) + key2f(kb & ~127);
        eid[c] = ((127 - (ka & 127)) << 7) | (127 - (kb & 127));
        ck[c] = (cbv[c] != 0xff) ? ((f2key(sm) & ~63) | (63 - (4 * l15 + c))) : KEY_MIN;
    }
    CE(ck[0], ck[1]) CE(ck[2], ck[3]) CE(ck[0], ck[2]) CE(ck[1], ck[3]) CE(ck[1], ck[2])
    int res = KEY_MIN;
#pragma unroll
    for (int r = 0; r < 16; ++r) {
        const int m = row_allmax_i(ck[0]);
        const bool own = (ck[0] == m);
        ck[0] = own ? ck[1] : ck[0]; ck[1] = own ? ck[2] : ck[1]; ck[2] = own ? ck[3] : ck[2]; ck[3] = own ? KEY_MIN : ck[3];
        res = (l15 == r) ? m : res;
    }
    const int slot = 63 - (res & 63);
    const int src = (rowbase + (slot >> 2)) << 2;
    const int e0 = __builtin_amdgcn_ds_bpermute(src, eid[0]), e1 = __builtin_amdgcn_ds_bpermute(src, eid[1]);
    const int e2 = __builtin_amdgcn_ds_bpermute(src, eid[2]), e3 = __builtin_amdgcn_ds_bpermute(src, eid[3]);
    const int sel = slot & 3;
    eid_out = sel == 0 ? e0 : (sel == 1 ? e1 : (sel == 2 ? e2 : e3));
    gate_out = key2f(res & ~63);
}

__device__ __forceinline__ int reduce16_rows(const int (&part)[16], bool b3, bool b2, bool b1, bool b0b) {
    int r8[8], r4[4], r2[2];
#pragma unroll
    for (int k = 0; k < 8; ++k) { const int keep = b3 ? part[8 + k] : part[k], send = b3 ? part[k] : part[8 + k]; r8[k] = keep + __builtin_amdgcn_update_dpp(0, send, 0x140, 0xf, 0xf, false); }
#pragma unroll
    for (int k = 0; k < 4; ++k) { const int keep = b2 ? r8[4 + k] : r8[k], send = b2 ? r8[k] : r8[4 + k]; r4[k] = keep + __builtin_amdgcn_update_dpp(0, send, 0x141, 0xf, 0xf, false); }
#pragma unroll
    for (int k = 0; k < 2; ++k) { const int keep = b1 ? r4[2 + k] : r4[k], send = b1 ? r4[k] : r4[2 + k]; r2[k] = keep + __builtin_amdgcn_update_dpp(0, send, 0x4E, 0xf, 0xf, false); }
    const int keep = b0b ? r2[1] : r2[0], send = b0b ? r2[0] : r2[1];
    int r1 = keep + __builtin_amdgcn_update_dpp(0, send, 0xB1, 0xf, 0xf, false);
    r1 += __shfl_xor(r1, 16); r1 += __shfl_xor(r1, 32);
    return r1;
}
__device__ void phase_hquant(const Params& p, char* lds) {
    const int tid = tid_opaque();
    const int wave = __builtin_amdgcn_readfirstlane((int)((blockIdx.x * blockDim.x + tid) >> 6)), nwaves = (gridDim.x * blockDim.x) >> 6, lane = tid & 63;
    for (int t = wave; t < T_TOK; t += 2 * nwaves) {
        const int t1 = t + nwaves; const bool two = t1 < T_TOK;
        const u32x4* h0 = (const u32x4*)(p.hb + (size_t)t * D_MODEL); const u32x4* h1 = (const u32x4*)(p.hb + (size_t)(two ? t1 : t) * D_MODEL);
        u32x4 r[2][2] = {{h0[2 * lane], h0[2 * lane + 1]}, {h1[2 * lane], h1[2 * lane + 1]}};
#pragma unroll
        for (int q = 0; q < 2; ++q) {
            const u32x4 a = r[q][0], c = r[q][1];
            const float f[16] = {bflo(a.x), bfhi(a.x), bflo(a.y), bfhi(a.y), bflo(a.z), bfhi(a.z), bflo(a.w), bfhi(a.w),
                                 bflo(c.x), bfhi(c.x), bflo(c.y), bfhi(c.y), bflo(c.z), bfhi(c.z), bflo(c.w), bfhi(c.w)};
            float ss = 0.f, am = 0.f;
#pragma unroll
            for (int k = 0; k < 16; ++k) { ss += f[k] * f[k]; am = fmaxf(am, fabsf(f[k])); }
            ss = wave_sum(ss); am = wave_max(am);
            const float inv = am > 0.f ? 127.0f / am : 0.f;
            u32x4 o;
#pragma unroll
            for (int i = 0; i < 4; ++i) {
                unsigned w = 0;
#pragma unroll
                for (int k = 0; k < 4; ++k) w |= (unsigned)((int)rintf(f[4 * i + k] * inv) & 0xff) << (8 * k);
                o[i] = w;
            }
            const int tt = q ? t1 : t;
            if (q == 0 || two) {
                ((u32x4*)(p.hq + (size_t)tt * D_MODEL))[lane] = o;
                if (lane == 0) p.hsc[tt] = am * (1.0f / 127.0f) * rsqrtf(ss * (1.0f / D_MODEL) + EPS);
            }
        }
    }
}

#define TS_WBYTES (16384 + 128)
__device__ void phase_peer_dots(const Params& p, char* lds) {
    const int tidx_ = tid_opaque();
    const int lane = tidx_ & 63, wid = __builtin_amdgcn_readfirstlane((int)(tidx_ >> 6)), l15 = lane & 15;
    const bool b3 = (lane & 8) != 0, b2 = (lane & 4) != 0, b1 = (lane & 2) != 0, b0b = (lane & 1) != 0;
    const int gw = blockIdx.x * (blockDim.x >> 6) + wid, ngw = gridDim.x * (blockDim.x >> 6);
    char* wl = lds + wid * TS_WBYTES;
    unsigned* list = (unsigned*)wl; int* dotsl = (int*)(wl + 4096); char* hql = wl + 8192; int* tks = (int*)(wl + 16384);
    const unsigned lane16 = (unsigned)lane * 16u;
    for (int tb = gw * 8; tb < T_TOK; tb += ngw * 8) {
#pragma unroll
        for (int j = 0; j < 8; ++j) *(u32x4*)(hql + j * 1024 + lane * 16) = ((const u32x4*)(p.hq + (size_t)(tb + j) * D_MODEL))[lane];
        if (lane < 8) tks[lane] = __float_as_int(p.hsc[tb + lane]);
        int idv[8][2];
#pragma unroll
        for (int j = 0; j < 8; ++j) { const int* ir = p.idx + (size_t)(tb + j) * 128; idv[j][0] = ir[lane]; idv[j][1] = ir[64 + lane]; }
#pragma unroll 1
        for (int x = 0; x < 8; ++x) {
            int n = 0;
#pragma unroll
            for (int j = 0; j < 8; ++j)
#pragma unroll
                for (int r = 0; r < 2; ++r) {
                    const int e = idv[j][r];
                    const bool in = (e >> 11) == x;
                    const unsigned long long mk = __ballot(in);
                    const int rank = (int)__builtin_amdgcn_mbcnt_hi((unsigned)(mk >> 32), __builtin_amdgcn_mbcnt_lo((unsigned)mk, 0u));
                    if (in) list[n + rank] = ((unsigned)j << 21) | ((unsigned)(r * 64 + lane) << 14) | (unsigned)e;
                    n += (int)__builtin_popcountll(mk);
                }
            asm volatile("s_waitcnt lgkmcnt(0)" ::: "memory");
            u32x4 ua[16], ubf[16]; int enta = 0, entb = 0;
            auto issue = [&](int b0, u32x4 (&uu)[16], int& entv) {
                const int i = (b0 + l15 < n) ? b0 + l15 : n - 1;
                entv = (int)list[i];
#pragma unroll
                for (int j = 0; j < 16; ++j) { const int e = __builtin_amdgcn_readlane(entv, j) & 0x3fff; uu[j] = *(const u32x4*)(p.u8 + (size_t)e * D_MODEL + lane16); }
            };
            auto reduce = [&](int b0, const u32x4 (&uu)[16], int entv) {
                int part[16];
#pragma unroll
                for (int j = 0; j < 16; ++j) {
                    const int tl = __builtin_amdgcn_readlane(entv, j) >> 21;
                    const u32x4 hqv = *(const u32x4*)(hql + tl * 1024 + lane * 16);
                    int sacc = __builtin_amdgcn_sdot4((int)uu[j].x, (int)hqv.x, 0, false);
                    sacc = __builtin_amdgcn_sdot4((int)uu[j].y, (int)hqv.y, sacc, false);
                    sacc = __builtin_amdgcn_sdot4((int)uu[j].z, (int)hqv.z, sacc, false);
                    part[j] = __builtin_amdgcn_sdot4((int)uu[j].w, (int)hqv.w, sacc, false);
                }
                const int r1 = reduce16_rows(part, b3, b2, b1, b0b);
                if (lane < 16 && b0 + lane < n) dotsl[((unsigned)entv >> 21) * 128 + (((unsigned)entv >> 14) & 127u)] = r1;
            };
            if (n > 0) issue(0, ua, enta);
            for (int b0 = 0; b0 < n; b0 += 32) {
                if (b0 + 16 < n) issue(b0 + 16, ubf, entb);
                reduce(b0, ua, enta);
                if (b0 + 16 < n) {
                    if (b0 + 32 < n) issue(b0 + 32, ua, enta);
                    reduce(b0 + 16, ubf, entb);
                }
            }
            asm volatile("s_waitcnt lgkmcnt(0)" ::: "memory");
        }
#pragma unroll
        for (int j = 0; j < 8; ++j) {
            const float cs_t = __int_as_float(tks[j]), r2_t = cs_t;
            const float* gr = p.gate + (size_t)(tb + j) * 128; float* cr = p.coef + (size_t)(tb + j) * 128;
#pragma unroll
            for (int r = 0; r < 2; ++r) {
                const int e = idv[j][r];
                const float sc = gr[r * 64 + lane] * r2_t;
                const float ex = __expf(sc - key2f(row_allmax_i(f2key(sc))));
                const float gt = ex / row_allsum_f(ex);
                const float2 sc2 = p.suv[e];
                const float dotf = (float)dotsl[j * 128 + r * 64 + lane] * cs_t * sc2.x;
                cr[r * 64 + lane] = gt * gelu_t(dotf) * sc2.y;
            }
        }
        asm volatile("s_waitcnt lgkmcnt(0)" ::: "memory");
    }
    asm volatile("s_waitcnt vmcnt(0)" ::: "memory");
}

__device__ void phase_gather(const Params& p, char* lds) {
    const int tidx_ = tid_opaque();
    const int wave = __builtin_amdgcn_readfirstlane((int)((blockIdx.x * blockDim.x + tidx_) >> 6)), nwaves = (gridDim.x * blockDim.x) >> 6, lane = tidx_ & 63;
    const unsigned char* vb = p.v8 + lane * 12;
    const int ntok = 8 * ((T_TOK / 8 - wave + nwaves - 1) / nwaves);
    auto tok = [&](int i) { const int ii = i < ntok ? i : ntok - 1; return 8 * (wave + nwaves * (ii >> 3)) + (ii & 7); };
    if (ntok <= 0) return;
    u32x3 v0[8], v1[8], v2[8], v3[8];
    int ic0, ic1, in0, in1, ia0, ia1;
    float coef0, coef1, cn0, cn1;
    { const float* cr = p.coef + (size_t)tok(0) * 128; coef0 = cr[lane]; coef1 = cr[64 + lane]; }
    { const int* ir = p.idx + (size_t)tok(0) * 128; ic0 = ir[lane]; ic1 = ir[64 + lane]; }
    { const int* ir = p.idx + (size_t)tok(1) * 128; in0 = ir[lane]; in1 = ir[64 + lane]; }
    float g16[16];
#pragma unroll
    for (int i4 = 0; i4 < 4; ++i4) { const float4 g = ((const float4*)(p.final_g + lane * 16))[i4]; g16[4 * i4] = g.x; g16[4 * i4 + 1] = g.y; g16[4 * i4 + 2] = g.z; g16[4 * i4 + 3] = g.w; }
#define G2_ISSUE(vv, pbx) do { const int pbx_ = (pbx); const bool nx_ = pbx_ >= 128; const int pm_ = pbx_ & 127; \
        const int src_ = nx_ ? (pm_ < 64 ? in0 : in1) : (pm_ < 64 ? ic0 : ic1); \
        _Pragma("unroll") for (int q = 0; q < 8; ++q) { const int e = __builtin_amdgcn_readlane(src_, (pm_ & 63) + q); vv[q] = *(const u32x3*)(vb + (size_t)e * ROWB); } } while (0)
    __builtin_amdgcn_sched_barrier(0);
    G2_ISSUE(v0, 0); __builtin_amdgcn_sched_barrier(0); G2_ISSUE(v1, 8); __builtin_amdgcn_sched_barrier(0); G2_ISSUE(v2, 16); __builtin_amdgcn_sched_barrier(0);
#pragma unroll 1
    for (int i = 0; i < ntok; ++i) {
        const int t = tok(i);
        { const int* ir = p.idx + (size_t)tok(i + 2) * 128; ia0 = ir[lane]; ia1 = ir[64 + lane]; }
        const u32x4* hr = (const u32x4*)(p.hb + (size_t)t * D_MODEL + lane * 16);
        const u32x4 ha = hr[0], hc = hr[1];
        { const float* cr = p.coef + (size_t)tok(i + 1) * 128; cn0 = cr[lane]; cn1 = cr[64 + lane]; }
        const float cmax = wave_max(fmaxf(fabsf(coef0), fabsf(coef1)));
        const float qs = cmax > 0.f ? 127.0f / cmax : 0.f, cscale = cmax * (1.0f / 127.0f);
        const int cq0 = (int)rintf(coef0 * qs), cq1 = (int)rintf(coef1 * qs);
        const int csum_i = wave_sum_i_uniform(cq0 + cq1);
        unsigned cpk0, cpk1;
        {
            const int bb0 = cq0 & 0xff, bb1 = cq1 & 0xff;
            cpk0 = (unsigned)__builtin_amdgcn_update_dpp(0, bb0, 0x00, 0xf, 0xf, false) | ((unsigned)__builtin_amdgcn_update_dpp(0, bb0, 0x55, 0xf, 0xf, false) << 8)
                 | ((unsigned)__builtin_amdgcn_update_dpp(0, bb0, 0xAA, 0xf, 0xf, false) << 16) | ((unsigned)__builtin_amdgcn_update_dpp(0, bb0, 0xFF, 0xf, 0xf, false) << 24);
            cpk1 = (unsigned)__builtin_amdgcn_update_dpp(0, bb1, 0x00, 0xf, 0xf, false) | ((unsigned)__builtin_amdgcn_update_dpp(0, bb1, 0x55, 0xf, 0xf, false) << 8)
                 | ((unsigned)__builtin_amdgcn_update_dpp(0, bb1, 0xAA, 0xf, 0xf, false) << 16) | ((unsigned)__builtin_amdgcn_update_dpp(0, bb1, 0xFF, 0xf, 0xf, false) << 24);
        }
        int racc[12], jacc[12];
#pragma unroll
        for (int j = 0; j < 12; ++j) { racc[j] = 0; jacc[j] = 0; }
        auto axpy = [&](int pb, const u32x3 (&vv)[8]) __attribute__((always_inline)) {
#pragma unroll
            for (int g4 = 0; g4 < 2; ++g4) {
                const int cqd = __builtin_amdgcn_readlane((int)(pb < 64 ? cpk0 : cpk1), (pb & 63) + 4 * g4);
#pragma unroll
                for (int w = 0; w < 3; ++w) {
                    const unsigned wa = vv[4 * g4 + 0][w], wb = vv[4 * g4 + 1][w], wc = vv[4 * g4 + 2][w], wd = vv[4 * g4 + 3][w];
                    const unsigned p0 = __builtin_amdgcn_perm(wb, wa, 0x05010400u), p1 = __builtin_amdgcn_perm(wb, wa, 0x07030602u);
                    const unsigned q0 = __builtin_amdgcn_perm(wd, wc, 0x05010400u), q1 = __builtin_amdgcn_perm(wd, wc, 0x07030602u);
                    const unsigned t0 = __builtin_amdgcn_perm(q0, p0, 0x05040100u), t1 = __builtin_amdgcn_perm(q0, p0, 0x07060302u);
                    const unsigned t2 = __builtin_amdgcn_perm(q1, p1, 0x05040100u), t3 = __builtin_amdgcn_perm(q1, p1, 0x07060302u);
                    racc[4 * w + 0] = __builtin_amdgcn_sdot4((int)t0, cqd, racc[4 * w + 0], false); jacc[4 * w + 0] = __builtin_amdgcn_sdot4((int)(t0 & 0xc0c0c0c0u), cqd, jacc[4 * w + 0], false);
                    racc[4 * w + 1] = __builtin_amdgcn_sdot4((int)t1, cqd, racc[4 * w + 1], false); jacc[4 * w + 1] = __builtin_amdgcn_sdot4((int)(t1 & 0xc0c0c0c0u), cqd, jacc[4 * w + 1], false);
                    racc[4 * w + 2] = __builtin_amdgcn_sdot4((int)t2, cqd, racc[4 * w + 2], false); jacc[4 * w + 2] = __builtin_amdgcn_sdot4((int)(t2 & 0xc0c0c0c0u), cqd, jacc[4 * w + 2], false);
                    racc[4 * w + 3] = __builtin_amdgcn_sdot4((int)t3, cqd, racc[4 * w + 3], false); jacc[4 * w + 3] = __builtin_amdgcn_sdot4((int)(t3 & 0xc0c0c0c0u), cqd, jacc[4 * w + 3], false);
                }
            }
        };
#pragma unroll 1
        for (int pb = 0; pb < 128; pb += 32) {
            G2_ISSUE(v3, pb + 24); __builtin_amdgcn_sched_barrier(0); axpy(pb, v0); __builtin_amdgcn_sched_barrier(0);
            G2_ISSUE(v0, pb + 32); __builtin_amdgcn_sched_barrier(0); axpy(pb + 8, v1); __builtin_amdgcn_sched_barrier(0);
            G2_ISSUE(v1, pb + 40); __builtin_amdgcn_sched_barrier(0); axpy(pb + 16, v2); __builtin_amdgcn_sched_barrier(0);
            G2_ISSUE(v2, pb + 48); __builtin_amdgcn_sched_barrier(0); axpy(pb + 24, v3); __builtin_amdgcn_sched_barrier(0);
        }
        ic0 = in0; ic1 = in1; in0 = ia0; in1 = ia1;
        coef0 = cn0; coef1 = cn1;
        int acc[16];
#pragma unroll
        for (int j = 0; j < 12; ++j) acc[j] = (racc[j] - jacc[j]) - 32 * csum_i;
#pragma unroll
        for (int k = 0; k < 4; ++k) acc[12 + k] = ((jacc[k] + 4 * jacc[4 + k] + 16 * jacc[8 + k]) >> 6) + 10 * csum_i;
        const float hf16[16] = {bflo(ha.x), bfhi(ha.x), bflo(ha.y), bfhi(ha.y), bflo(ha.z), bfhi(ha.z), bflo(ha.w), bfhi(ha.w),
                                bflo(hc.x), bfhi(hc.x), bflo(hc.y), bfhi(hc.y), bflo(hc.z), bfhi(hc.z), bflo(hc.w), bfhi(hc.w)};
        float res[16];
        float ss = 0.f;
#pragma unroll
        for (int j = 0; j < 16; ++j) { res[j] = hf16[j] + cscale * (float)acc[j]; ss += res[j] * res[j]; }
        ss = wave_sum(ss);
        const float r3 = rsqrtf(ss * (1.0f / D_MODEL) + EPS);
        float* o = p.out + (size_t)t * D_MODEL + lane * 16;
#pragma unroll
        for (int i4 = 0; i4 < 4; ++i4) {
            float4 ov; ov.x = res[4 * i4] * r3 * g16[4 * i4]; ov.y = res[4 * i4 + 1] * r3 * g16[4 * i4 + 1]; ov.z = res[4 * i4 + 2] * r3 * g16[4 * i4 + 2]; ov.w = res[4 * i4 + 3] * r3 * g16[4 * i4 + 3];
            ((float4*)o)[i4] = ov;
        }
    }
#undef G2_ISSUE
}

namespace pg8 {
#define PG8_LAS __attribute__((address_space(3)))
constexpr int BM = 256, BK = 64, HALF = 128, HTB = HALF * BK * 2, STAGE_BYTES = 8 * HTB, NXCD = 8, WGM = 8;
__host__ __device__ __forceinline__ int lds_byte(int r, int c) { const int st = (r >> 4) * 2 + (c >> 5), rr = r & 15, cc = c & 31, ob = rr * 64 + cc * 2; return st * 1024 + (ob ^ (((ob >> 9) & 1) << 5)); }
__host__ __device__ __forceinline__ void stage_rc(int b, int& R, int& C) { const int st = b / 1024, sb = b % 1024, swz = sb ^ (((sb >> 9) & 1) << 5); R = (st >> 1) * 16 + swz / 64; C = (st & 1) * 32 + (swz % 64) / 2; }
__host__ __device__ __forceinline__ int perm32(int rho) { const int n = rho >> 4, i = rho & 15; return 8 * (i >> 2) + 4 * n + (i & 3); }
struct Unit { int pm, pn; };
struct Gemm { const bf16_t* A; const bf16_t* Bt; int M, N, K; };
struct StaticOrder {
    int nM, nN, nwg, G, c;
    __host__ __device__ void init(int M, int N, int G_, int c_) { nM = M / BM; nN = N / BM; nwg = nM * nN; G = G_; c = c_; }
    __host__ __device__ bool next(int i, Unit& u) const {
        const long L = (long)i * G + c; if (L >= nwg) return false;
        int wgid = (int)L; { const int q = nwg / NXCD, r = nwg % NXCD, xcd = wgid % NXCD, off = wgid / NXCD; wgid = (xcd < r ? xcd * (q + 1) : r * (q + 1) + (xcd - r) * q) + off; }
        const int nig = WGM * nN, gid = wgid / nig, fm = gid * WGM, gsz = (nM - fm) < WGM ? (nM - fm) : WGM;
        u.pm = fm + ((wgid % nig) % gsz); u.pn = (wgid % nig) / gsz; return true;
    }
    __device__ __forceinline__ void a_ready(const Unit&) const {}
    __device__ __forceinline__ void done(const Unit&) const {}
};
__device__ __forceinline__ unsigned cvt_pk_bf16(float lo, float hi) { unsigned r; asm volatile("v_cvt_pk_bf16_f32 %0, %1, %2" : "=v"(r) : "v"(lo), "v"(hi)); return r; }
template <bool I8> __device__ __forceinline__ typename std::conditional<I8, i32x4, f32x4>::type mma1(bf16x8 a, bf16x8 b, typename std::conditional<I8, i32x4, f32x4>::type c) {
    if constexpr (I8) return __builtin_amdgcn_mfma_i32_16x16x64_i8(*(const i32x4*)&a, *(const i32x4*)&b, c, 0, 0, 0);
    else return __builtin_amdgcn_mfma_f32_16x16x32_bf16(a, b, c, 0, 0, 0);
}
struct EpiZ8 {
    static constexpr bool PERM = true, AFTER_DRAIN = false, I8 = true; typedef i32x4 acc_t;
    bf16_t* O; const float* rsx; const unsigned* swb; float2* lnp;
    __device__ __forceinline__ void operator()(const i32x4 (&acc)[2][2][4][2], const Unit& u, int wr, int wc, int fr, int fq) const {
        const int row0 = u.pm * BM + wr * 64 + fr, col0 = u.pn * BM + wc * 32 + 8 * fq; const bool act = u.pn >= 2, vpart = u.pn >= 4;
        float sw[2][8];
#pragma unroll
        for (int bj = 0; bj < 2; ++bj) { const u32x4 a = *(const u32x4*)(swb + col0 + bj * HALF), c = *(const u32x4*)(swb + col0 + bj * HALF + 4);
#pragma unroll
            for (int i = 0; i < 4; ++i) { sw[bj][i] = __uint_as_float(a[i]) * (1.0f / 127.0f); sw[bj][4 + i] = __uint_as_float(c[i]) * (1.0f / 127.0f); } }
#pragma unroll
        for (int ai = 0; ai < 2; ++ai)
#pragma unroll
            for (int m = 0; m < 4; ++m) { const int r = row0 + ai * HALF + m * 16; const float sc = rsx[r]; bf16_t* rowp = O + (size_t)r * D_IN + col0;
                float s1 = 0.f, s2 = 0.f;
#pragma unroll
                for (int bj = 0; bj < 2; ++bj) { f32x4 v0, v1;
#pragma unroll
                    for (int i = 0; i < 4; ++i) { v0[i] = (float)acc[ai][bj][m][0][i] * sc * sw[bj][i]; v1[i] = (float)acc[ai][bj][m][1][i] * sc * sw[bj][4 + i]; }
                    if (act) { v0 = (f32x4){gelu_t(v0[0]), gelu_t(v0[1]), gelu_t(v0[2]), gelu_t(v0[3])}; v1 = (f32x4){gelu_t(v1[0]), gelu_t(v1[1]), gelu_t(v1[2]), gelu_t(v1[3])}; }
#pragma unroll
                    for (int i = 0; i < 4; ++i) { s1 += v0[i] + v1[i]; s2 += v0[i] * v0[i] + v1[i] * v1[i]; }
                    u32x4 w; w.x = cvt_pk_bf16(v0[0], v0[1]); w.y = cvt_pk_bf16(v0[2], v0[3]); w.z = cvt_pk_bf16(v1[0], v1[1]); w.w = cvt_pk_bf16(v1[2], v1[3]);
                    *(u32x4*)(rowp + bj * HALF) = w; }
                if (vpart) {
                    s1 += __shfl_xor(s1, 16); s2 += __shfl_xor(s2, 16); s1 += __shfl_xor(s1, 32); s2 += __shfl_xor(s2, 32);
                    if (fq == 0) lnp[(size_t)r * 8 + (u.pn - 4) * 4 + wc] = make_float2(s1, s2);
                } }
    }
};
struct EpiOut {
    static constexpr bool PERM = true, AFTER_DRAIN = false, I8 = false; typedef f32x4 acc_t;
    bf16_t* O; const signed char* X; const float* sx;
    __device__ __forceinline__ void operator()(const f32x4 (&acc)[2][2][4][2], const Unit& u, int wr, int wc, int fr, int fq) const {
        const int row0 = u.pm * BM + wr * 64 + fr, col0 = u.pn * BM + wc * 32 + 8 * fq;
#pragma unroll
        for (int ai = 0; ai < 2; ++ai)
#pragma unroll
            for (int m = 0; m < 4; ++m) { const int r = row0 + ai * HALF + m * 16; const size_t off = (size_t)r * D_MODEL + col0; const float sc = sx[r];
#pragma unroll
                for (int bj = 0; bj < 2; ++bj) { const u32x2 xx = *(const u32x2*)(X + off + bj * HALF);
                    f32x4 x0, x1;
#pragma unroll
                    for (int i = 0; i < 4; ++i) { x0[i] = (float)(signed char)(xx.x >> (8 * i)) * sc; x1[i] = (float)(signed char)(xx.y >> (8 * i)) * sc; }
                    const f32x4 v0 = acc[ai][bj][m][0] + x0, v1 = acc[ai][bj][m][1] + x1;
                    u32x4 w; w.x = cvt_pk_bf16(v0[0], v0[1]); w.y = cvt_pk_bf16(v0[2], v0[3]); w.z = cvt_pk_bf16(v1[0], v1[1]); w.w = cvt_pk_bf16(v1[2], v1[3]);
                    *(u32x4*)(O + off + bj * HALF) = w; } }
    }
};
struct OneUnit {
    Unit u;
    __device__ __forceinline__ bool next(int i, Unit& o) const { if (i) return false; o = u; return true; }
    __device__ __forceinline__ void a_ready(const Unit&) const {}
    __device__ __forceinline__ void done(const Unit&) const {}
};
#define QT_PITCH 272
#define QT_LDS_BYTES (2 * 256 * QT_PITCH)
struct EpiQTopk {
    static constexpr bool PERM = true, AFTER_DRAIN = true, I8 = true; typedef i32x4 acc_t;
    const bf16_t* keysB; int* idx; float* gate; const unsigned* swq;
    const Params* pp_;
    __device__ __forceinline__ void fused(i32x4 (&acc)[2][2][4][2], const Unit& u, int wr, int wc, int fr, int fq, PG8_LAS unsigned char* ldsp, int wid, int lane) const {
        char* sQ = (char*)ldsp;
        const int h = u.pn;
        float sw[2][8];
#pragma unroll
        for (int bj = 0; bj < 2; ++bj) { const u32x4 a = *(const u32x4*)(swq + u.pn * BM + bj * HALF + wc * 32 + 8 * fq), c = *(const u32x4*)(swq + u.pn * BM + bj * HALF + wc * 32 + 8 * fq + 4);
#pragma unroll
            for (int i = 0; i < 4; ++i) { sw[bj][i] = __uint_as_float(a[i]) * (1.0f / 127.0f); sw[bj][4 + i] = __uint_as_float(c[i]) * (1.0f / 127.0f); } }
#pragma unroll
        for (int ai = 0; ai < 2; ++ai)
#pragma unroll
            for (int m = 0; m < 4; ++m) { const int r = ai * HALF + wr * 64 + m * 16 + fr;
#pragma unroll
                for (int bj = 0; bj < 2; ++bj) { f32x4 v0, v1;
#pragma unroll
                    for (int i = 0; i < 4; ++i) { v0[i] = (float)acc[ai][bj][m][0][i] * sw[bj][i]; v1[i] = (float)acc[ai][bj][m][1][i] * sw[bj][4 + i]; }
                    u32x4 w; w.x = cvt_pk_bf16(v0[0], v0[1]); w.y = cvt_pk_bf16(v0[2], v0[3]); w.z = cvt_pk_bf16(v1[0], v1[1]); w.w = cvt_pk_bf16(v1[2], v1[3]);
                    *(u32x4*)(sQ + bj * (256 * QT_PITCH) + r * QT_PITCH + (wc * 32 + fq * 8) * 2) = w; } }
        __syncthreads();
        int cbv[4];
#pragma unroll
        for (int c = 0; c < 4; ++c) cbv[c] = kComb[4 * fr + c];
        int tA[2][4], tB[2][4];
#pragma unroll
        for (int m = 0; m < 2; ++m)
#pragma unroll
            for (int j = 0; j < 4; ++j) { tA[m][j] = 0; tB[m][j] = 0; }
        static_assert((T_TOK / 256) * 8 * 8 * 2 == NEXP, "units x waves x 2 must cover the expert table");
        const int qe0 = ((u.pm * 8 + u.pn) * 8 + wid) * 2;
        float4 qa4[2][4], qb4[2][4];
#pragma unroll 1
        for (int pp = 0; pp < 2; ++pp) {
            const bf16_t* kb = keysB + (size_t)(pp * 8 + h) * 16384 + lane * 8;
            const char* qa = sQ + pp * (256 * QT_PITCH) + (wid * 32 + fr) * QT_PITCH + fq * 16;
            f32x4 sc2[2][8];
#pragma unroll
            for (int m = 0; m < 2; ++m)
#pragma unroll
                for (int nb = 0; nb < 8; ++nb) sc2[m][nb] = (f32x4){0.f, 0.f, 0.f, 0.f};
#pragma unroll
            for (int kk = 0; kk < 4; ++kk) {
                bf16x8 kf[8], af[2];
#pragma unroll
                for (int nb = 0; nb < 8; ++nb) kf[nb] = *(const bf16x8*)(kb + (kk * 8 + nb) * 512);
#pragma unroll
                for (int m = 0; m < 2; ++m) af[m] = *(const bf16x8*)(qa + m * 16 * QT_PITCH + kk * 64);
#pragma unroll
                for (int m = 0; m < 2; ++m)
#pragma unroll
                    for (int nb = 0; nb < 8; ++nb) sc2[m][nb] = __builtin_amdgcn_mfma_f32_16x16x32_bf16(af[m], kf[nb], sc2[m][nb], 0, 0, 0);
            }
#pragma unroll
            for (int m = 0; m < 2; ++m)
#pragma unroll
                for (int j = 0; j < 4; ++j) tA[m][j] = tB[m][j];
            if (pp == 1) {
#pragma unroll
                for (int x = 0; x < 2; ++x) {
                    const float4* su4 = (const float4*)(pp_->peer_u + (size_t)(qe0 + x) * D_MODEL + lane * 16);
                    const float4* sv4 = (const float4*)(pp_->peer_v + (size_t)(qe0 + x) * D_MODEL + lane * 16);
#pragma unroll
                    for (int i = 0; i < 4; ++i) { qa4[x][i] = su4[i]; qb4[x][i] = sv4[i]; }
                }
            }
#pragma unroll 2
            for (int it = 0; it < 4; ++it) {
#pragma unroll
                for (int m = 0; m < 2; ++m) {
                    int k[8];
#pragma unroll
                    for (int nb = 0; nb < 8; ++nb) k[nb] = (f2key(sc2[m][nb][0]) & ~127) | (127 - (16 * nb + fr));
                    const int r = top16_rows(k, fr);
                    tB[m][0] = tB[m][1]; tB[m][1] = tB[m][2]; tB[m][2] = tB[m][3]; tB[m][3] = r;
#pragma unroll
                    for (int nb = 0; nb < 8; ++nb) sc2[m][nb] = (f32x4){sc2[m][nb][1], sc2[m][nb][2], sc2[m][nb][3], sc2[m][nb][0]};
                }
            }
        }
#pragma unroll 2
        for (int it = 0; it < 4; ++it) {
#pragma unroll
            for (int m = 0; m < 2; ++m) {
                int eid; float gt;
                combine16(tA[m][0], tB[m][0], cbv, lane, fr, eid, gt);
                const int t = u.pm * BM + wid * 32 + m * 16 + fq * 4 + it;
                const size_t o = (size_t)t * 128 + h * 16 + fr;
                idx[o] = eid; gate[o] = gt;
                tA[m][0] = tA[m][1]; tA[m][1] = tA[m][2]; tA[m][2] = tA[m][3];
                tB[m][0] = tB[m][1]; tB[m][1] = tB[m][2]; tB[m][2] = tB[m][3];
            }
        }
        quant_expert(*pp_, qe0, lane, qa4[0], qb4[0]);
        quant_expert(*pp_, qe0 + 1, lane, qa4[1], qb4[1]);
        __syncthreads();
    }
};
template <class Epi, class Sched>
__device__ __forceinline__ void gemm_phase(PG8_LAS unsigned char* lds, const Gemm g, const Sched& S, const Epi& E) {
    const int tid = tid_opaque(), wid = __builtin_amdgcn_readfirstlane(tid >> 6), lane = tid & 63, wr = wid >> 2, wc = wid & 3, fr = lane & 15, fq = lane >> 4;
    const int K = g.K, nt = K / BK;
    unsigned voffA[2], voffB[2];
#pragma unroll
    for (int i = 0; i < 2; ++i) { int R, C; stage_rc(tid * 16 + i * 8192, R, C); const int Rb = Epi::PERM ? ((R & ~31) + perm32(R & 31)) : R;
        voffA[i] = (unsigned)(R * K + C) * 2u; voffB[i] = (unsigned)(Rb * K + C) * 2u; }
    const size_t kstep = (size_t)(BK * 2);
    const size_t hstep = (size_t)HALF * K * 2;
    const size_t tstep = 2 * hstep;
    const unsigned ldsw = (unsigned)wid * 1024u;
    const int aoff = lds_byte(wr * 64 + fr, fq * 8), boff = lds_byte(wc * 32 + fr, fq * 8);
#define PG8_SA(b, h) (((b) * 2 + (h)) * HTB)
#define PG8_SB(b, h) ((4 + (b) * 2 + (h)) * HTB)
#define PG8_STAGE(bufoff, gbase, voff) do { _Pragma("unroll") for (int _i = 0; _i < 2; ++_i) \
        __builtin_amdgcn_global_load_lds((const unsigned*)((const char*)(gbase) + (voff)[_i]), (PG8_LAS unsigned*)(lds + (bufoff) + ldsw + _i * 8192), 16, 0, 0); } while (0)
#define PG8_LDA(dst, b, h) do { _Pragma("unroll") for (int m = 0; m < 4; ++m) _Pragma("unroll") for (int k = 0; k < 2; ++k) dst[m][k] = *(const PG8_LAS bf16x8*)(lds + PG8_SA(b, h) + aoff + m * 2048 + k * 1024); } while (0)
#define PG8_LDB(dst, b, h) do { _Pragma("unroll") for (int n = 0; n < 2; ++n) _Pragma("unroll") for (int k = 0; k < 2; ++k) dst[n][k] = *(const PG8_LAS bf16x8*)(lds + PG8_SB(b, h) + boff + n * 2048 + k * 1024); } while (0)
#define PG8_MMA(ai, bj, At, Bt) do { __builtin_amdgcn_s_setprio(1); _Pragma("unroll") for (int m = 0; m < 4; ++m) _Pragma("unroll") for (int n = 0; n < 2; ++n) _Pragma("unroll") for (int k = 0; k < 2; ++k) \
        acc[ai][bj][m][n] = mma1<Epi::I8>(Bt[n][k], At[m][k], acc[ai][bj][m][n]); __builtin_amdgcn_s_setprio(0); } while (0)
#define PG8_WAIT_V(n) asm volatile("s_waitcnt vmcnt(" #n ")" ::: "memory")
#define PG8_WAIT_L(n) asm volatile("s_waitcnt lgkmcnt(" #n ")" ::: "memory")
#define PG8_BAR __builtin_amdgcn_s_barrier()
#define PG8_SCHED __builtin_amdgcn_sched_barrier(0)
    Unit cur, nxt; int ui = 0;
    if (!S.next(0, cur)) return;
    typedef typename Epi::acc_t acc_t;
    acc_t acc[2][2][4][2];
#pragma unroll
    for (int a = 0; a < 2; ++a)
#pragma unroll
        for (int b = 0; b < 2; ++b)
#pragma unroll
            for (int m = 0; m < 4; ++m)
#pragma unroll
                for (int n = 0; n < 2; ++n) acc[a][b][m][n] = (acc_t)(0);
    bf16x8 At[4][2], B0[2][2], B1[2][2];
    const char* cA = (const char*)g.A + (size_t)cur.pm * tstep; const char* cB = (const char*)g.Bt + (size_t)cur.pn * tstep;
    S.a_ready(cur);
    PG8_STAGE(PG8_SB(0, 0), cB, voffB); PG8_STAGE(PG8_SA(0, 0), cA, voffA); PG8_STAGE(PG8_SB(0, 1), cB + hstep, voffB); PG8_STAGE(PG8_SA(0, 1), cA + hstep, voffA);
    if (wr == 1) PG8_BAR;
    PG8_WAIT_V(4); PG8_BAR;
    PG8_STAGE(PG8_SB(1, 0), cB + kstep, voffB); PG8_STAGE(PG8_SA(1, 0), cA + kstep, voffA); PG8_STAGE(PG8_SB(1, 1), cB + hstep + kstep, voffB);
    PG8_WAIT_V(6); PG8_BAR;
    for (;;) {
        const bool has_next = S.next(ui + 1, nxt);
        const char* nA = has_next ? (const char*)g.A + (size_t)nxt.pm * tstep : cA; const char* nB = has_next ? (const char*)g.Bt + (size_t)nxt.pn * tstep : cB;
        for (int t = 0; t < nt; t += 2) {
            const bool last = (t == nt - 2);
            const char* a1 = cA + (size_t)(t + 1) * kstep;
            const char* a2 = last ? nA : cA + (size_t)(t + 2) * kstep; const char* b2 = last ? nB : cB + (size_t)(t + 2) * kstep;
            const char* a3 = a2 + kstep; const char* b3 = b2 + kstep;
            if (last && has_next) S.a_ready(nxt);
            PG8_LDB(B0, 0, 0); PG8_SCHED; PG8_LDA(At, 0, 0); PG8_STAGE(PG8_SA(1, 1), a1 + hstep, voffA);
            PG8_WAIT_L(8); PG8_BAR; PG8_WAIT_L(0); PG8_MMA(0, 0, At, B0); PG8_BAR; PG8_SCHED;
            PG8_LDB(B1, 0, 1); PG8_STAGE(PG8_SB(0, 0), b2, voffB);
            PG8_BAR; PG8_WAIT_L(0); PG8_MMA(0, 1, At, B1); PG8_BAR;
            PG8_LDA(At, 0, 1); PG8_STAGE(PG8_SA(0, 0), a2, voffA);
            PG8_BAR; PG8_WAIT_L(0); PG8_MMA(1, 0, At, B0); PG8_BAR; PG8_SCHED;
            PG8_STAGE(PG8_SB(0, 1), b2 + hstep, voffB);
            PG8_WAIT_V(6); PG8_BAR; PG8_MMA(1, 1, At, B1); PG8_BAR;
            PG8_LDB(B0, 1, 0); PG8_SCHED; PG8_LDA(At, 1, 0); PG8_STAGE(PG8_SA(0, 1), a2 + hstep, voffA);
            PG8_WAIT_L(8); PG8_BAR; PG8_WAIT_L(0); PG8_MMA(0, 0, At, B0); PG8_BAR; PG8_SCHED;
            PG8_LDB(B1, 1, 1); PG8_STAGE(PG8_SB(1, 0), b3, voffB);
            PG8_BAR; PG8_WAIT_L(0); PG8_MMA(0, 1, At, B1); PG8_BAR;
            PG8_LDA(At, 1, 1); PG8_STAGE(PG8_SA(1, 0), a3, voffA);
            PG8_BAR; PG8_WAIT_L(0); PG8_MMA(1, 0, At, B0); PG8_BAR; PG8_SCHED;
            PG8_STAGE(PG8_SB(1, 1), b3 + hstep, voffB);
            PG8_WAIT_V(6); PG8_BAR; PG8_MMA(1, 1, At, B1); PG8_BAR;
        }
            if constexpr (!Epi::AFTER_DRAIN) { E(acc, cur, wr, wc, fr, fq); S.done(cur); }
            if (!has_next) break;
#pragma unroll
        for (int a = 0; a < 2; ++a)
#pragma unroll
            for (int b = 0; b < 2; ++b)
#pragma unroll
                for (int m = 0; m < 4; ++m)
#pragma unroll
                    for (int n = 0; n < 2; ++n) acc[a][b][m][n] = (acc_t)(0);
        cur = nxt; cA = nA; cB = nB; ++ui;
    }
    PG8_WAIT_V(0);
    if (wr == 0) PG8_BAR;
    PG8_BAR;
    if constexpr (Epi::AFTER_DRAIN) { E.fused(acc, cur, wr, wc, fr, fq, lds, wid, lane); S.done(cur); }
#undef PG8_SA
#undef PG8_SB
#undef PG8_STAGE
#undef PG8_LDA
#undef PG8_LDB
#undef PG8_MMA
#undef PG8_WAIT_V
#undef PG8_WAIT_L
#undef PG8_BAR
#undef PG8_SCHED
}
}

__device__ void phase_gemm_z(const Params& p, char* lds) {
    pg8::StaticOrder S; S.init(T_TOK, D_IN, gridDim.x, blockIdx.x);
    pg8::gemm_phase<pg8::EpiZ8, pg8::StaticOrder>((PG8_LAS unsigned char*)lds, pg8::Gemm{(const bf16_t*)p.xq, (const bf16_t*)p.winT8, T_TOK, D_IN, D_MODEL / 2}, S, pg8::EpiZ8{p.zb, p.rstd1, p.swb, p.lnp});
}
__device__ void phase_gemm_out(const Params& p, char* lds) {
    pg8::StaticOrder S; S.init(T_TOK, D_MODEL, gridDim.x, blockIdx.x);
    pg8::gemm_phase<pg8::EpiOut, pg8::StaticOrder>((PG8_LAS unsigned char*)lds, pg8::Gemm{p.cB, p.woutT, T_TOK, D_MODEL, D_MODEL}, S, pg8::EpiOut{p.hb, p.xq, p.sx});
}
__device__ void phase_gemm_q(const Params& p, char* lds) {
    pg8::StaticOrder S; S.init(T_TOK, 2048, gridDim.x, blockIdx.x);
    pg8::Unit u;
    for (int i = 0; S.next(i, u); ++i)
        pg8::gemm_phase<pg8::EpiQTopk, pg8::OneUnit>((PG8_LAS unsigned char*)lds, pg8::Gemm{(const bf16_t*)p.hq, (const bf16_t*)p.wqT8, T_TOK, 2048, D_MODEL / 2}, pg8::OneUnit{u}, pg8::EpiQTopk{p.keysB, p.idx, p.gate, p.swq, &p});
}

#define XB_TMO      128
#define XB_XCNT(j)  (256  + 64 * (j))
#define XB_XSUB(j)  (1280 + 64 * (j))
#define XB_XGEN(j)  (2304 + 64 * (j))
#define XB_TOP      3328
#define XB_TOPGEN   3392
#define XCD_BAR_WORDS 3456
#define XB_SPIN_CAP (1u << 20)
__device__ __forceinline__ unsigned xb_ld(unsigned* p)              { return __hip_atomic_load(p, __ATOMIC_RELAXED, __HIP_MEMORY_SCOPE_AGENT); }
__device__ __forceinline__ unsigned xb_add(unsigned* p, unsigned v) { return __hip_atomic_fetch_add(p, v, __ATOMIC_RELAXED, __HIP_MEMORY_SCOPE_AGENT); }
__device__ __forceinline__ unsigned xb_xcc_id() { return (unsigned)__builtin_amdgcn_s_getreg((3 << 11) | 20) & 0xFu; }
#define XB_SPIN(cond, bar) do { unsigned _sp = 0; while (cond) { __builtin_amdgcn_s_sleep(1); \
    if ((++_sp & 255u) == 0u) { if (xb_ld(&(bar)[XB_TMO])) break; if (_sp > XB_SPIN_CAP) { atomicAdd(&(bar)[XB_TMO], 1u); break; } } } } while (0)
struct XcdBarrier { unsigned* bar; unsigned x; volatile LAS unsigned* st; };
__device__ __forceinline__ XcdBarrier xcd_barrier_post(unsigned* bar, volatile LAS unsigned* st) {
    XcdBarrier b; b.bar = bar; b.x = xb_xcc_id(); b.st = st;
    if (threadIdx.x == 0) (void)xb_add(&bar[XB_XCNT(b.x)], 1u);
    return b;
}
__device__ __forceinline__ void xcd_barrier_complete(unsigned* bar, unsigned x, unsigned& nloc, unsigned& nx) {
    const unsigned G = gridDim.x * gridDim.y * gridDim.z;
    unsigned sum, cnt, mine, sp = 0u;
    for (;;) {
        sum = 0u; cnt = 0u; mine = 0u;
#pragma unroll
        for (unsigned j = 0; j < 16; ++j) { const unsigned c = xb_ld(&bar[XB_XCNT(j)]); sum += c; cnt += (c > 0u) ? 1u : 0u; mine = (j == x) ? c : mine; }
        if (sum == G) break;
        __builtin_amdgcn_s_sleep(1);
        if ((++sp & 255u) == 0u) { if (xb_ld(&bar[XB_TMO])) break; if (sp > XB_SPIN_CAP) { atomicAdd(&bar[XB_TMO], 1u); break; } }
    }
    nloc = mine > 0u ? mine : 1u; nx = cnt > 0u ? cnt : 1u;
}
__device__ __forceinline__ void xcd_barrier(const XcdBarrier& b) {
    asm volatile("s_waitcnt vmcnt(0)" ::: "memory");
    __syncthreads();
    if (threadIdx.x == 0) {
        unsigned* bar = b.bar;
        __builtin_amdgcn_s_waitcnt(0);
        unsigned nloc = b.st[0], nx = b.st[1];
        if (nloc == 0u) { xcd_barrier_complete(bar, b.x, nloc, nx); b.st[0] = nloc; b.st[1] = nx; }
        const unsigned old = xb_add(&bar[XB_XSUB(b.x)], 1u);
        const unsigned gen = old / nloc;
        if (old + 1u == (gen + 1u) * nloc) {
            __builtin_amdgcn_fence(__ATOMIC_RELEASE, "agent");
            asm volatile("s_waitcnt vmcnt(0)" ::: "memory");
            const unsigned og = xb_add(&bar[XB_TOP], 1u);
            const unsigned tg = og / nx;
            if (og + 1u == (tg + 1u) * nx) xb_add(&bar[XB_TOPGEN], 1u);
            else XB_SPIN(xb_ld(&bar[XB_TOPGEN]) == tg, bar);
            __builtin_amdgcn_fence(__ATOMIC_ACQUIRE, "agent");
            xb_add(&bar[XB_XGEN(b.x)], 1u);
            asm volatile("s_waitcnt vmcnt(0)" ::: "memory");
        } else {
            XB_SPIN(xb_ld(&bar[XB_XGEN(b.x)]) == gen, bar);
            __builtin_amdgcn_fence(__ATOMIC_ACQUIRE, "agent");
            asm volatile("s_waitcnt vmcnt(0)" ::: "memory");
        }
    }
    __syncthreads();
}

#define MEGA_LDS_MAX2(a, b) ((a) > (b) ? (a) : (b))
#define MEGA_LDS_MAIN MEGA_LDS_MAX2(MEGA_LDS_MAX2(QT_LDS_BYTES, pg8::STAGE_BYTES), MEGA_LDS_MAX2(8 * TS_WBYTES, 2 * MIXH_LDS))
#define MEGA_LDS_BYTES (MEGA_LDS_MAIN + 16)
extern __shared__ __attribute__((aligned(16))) char smem[];
__global__ void __launch_bounds__(512, 2) fwd_mega(Params p) {
    volatile LAS unsigned* st = (volatile LAS unsigned*)(smem + MEGA_LDS_MAIN);
    if (threadIdx.x < 4) st[threadIdx.x] = 0u;
    __syncthreads();
    const XcdBarrier xb = xcd_barrier_post(p.bar, st);
    phase_prep(p, smem);      xcd_barrier(xb);
    phase_gemm_z(p, smem);    xcd_barrier(xb);
    phase_mix_gemm(p, smem);  xcd_barrier(xb);
    phase_gemm_out(p, smem);  xcd_barrier(xb);
    phase_hquant(p, smem);    xcd_barrier(xb);
    phase_gemm_q(p, smem);    xcd_barrier(xb);
    phase_peer_dots(p, smem);
    phase_gather(p, smem);
}

extern "C" void kernel_launch(void* const* d_in, const int* in_sizes, int n_in, void* d_out, int out_size, void* d_ws, size_t ws_size, hipStream_t stream) {
    static int grid_blocks = 0;
    if (grid_blocks == 0) {
        int dev = 0, cus = 0, per_cu = 0;
        (void)hipGetDevice(&dev);
        (void)hipDeviceGetAttribute(&cus, hipDeviceAttributeMultiprocessorCount, dev);
        (void)hipFuncSetAttribute((const void*)fwd_mega, hipFuncAttributeMaxDynamicSharedMemorySize, MEGA_LDS_BYTES);
        (void)hipOccupancyMaxActiveBlocksPerMultiprocessor(&per_cu, (const void*)fwd_mega, 512, MEGA_LDS_BYTES);
        if (per_cu > 1) per_cu = 1;
        if (per_cu < 1) per_cu = 1;
        grid_blocks = cus * per_cu;
    }
    Params p{};
    p.x = (const float*)d_in[0]; p.norm1_g = (const float*)d_in[1]; p.w_in = (const float*)d_in[2]; p.pool_w = (const float*)d_in[3];
    p.pool_scale = (const float*)d_in[4]; p.sgu_norm_g = (const float*)d_in[5]; p.sgu_w = (const float*)d_in[6]; p.sgu_b = (const float*)d_in[7];
    p.w_out = (const float*)d_in[8]; p.norm2_g = (const float*)d_in[9]; p.peer_wq = (const float*)d_in[10]; p.peer_keys = (const float*)d_in[11];
    p.peer_u = (const float*)d_in[12]; p.peer_v = (const float*)d_in[13]; p.final_g = (const float*)d_in[14];
    p.out = (float*)d_out;
    char* w = (char*)d_ws; size_t off = 0;
    auto take = [&](size_t bytes) { char* r = w + off; off += (bytes + 255) & ~(size_t)255; return r; };
    const size_t MiB = 1024 * 1024;
    p.u8 = (unsigned char*)take(16 * MiB); p.v8 = (unsigned char*)take(12 * MiB);
    p.suv = (float2*)take(128 * 1024);
    p.woutT = (bf16_t*)take(2 * MiB);
    p.poolT = (bf16_t*)take(128 * 1024); p.wsM = (bf16_t*)take(128 * 1024); p.keysB = (bf16_t*)take(512 * 1024);
    p.bar = (unsigned*)take(XCD_BAR_WORDS * 4 + 4608 * 4); p.swb = p.bar + XCD_BAR_WORDS; p.swq = p.swb + 2048;
    p.rstd1 = (float*)take(128 * 1024); p.sx = (float*)take(128 * 1024); p.xq = (signed char*)take(32 * MiB); p.winT8 = (signed char*)take(1536 * 1024); p.wqT8 = (signed char*)take(2048 * 1024); p.hq = (signed char*)take(32 * MiB); p.hsc = (float*)take(128 * 1024);
    p.idx = (int*)take(16 * MiB); p.gate = (float*)take(16 * MiB); p.coef = (float*)take(16 * MiB);
    p.lnp = (float2*)take(2 * MiB); p.zb = (bf16_t*)take(96 * MiB); p.cB = (bf16_t*)take(64 * MiB); p.hb = (bf16_t*)take(64 * MiB);
    (void)hipMemsetAsync(p.bar, 0, XCD_BAR_WORDS * 4 + 4608 * 4, stream);
    hipLaunchKernelGGL(fwd_mega, dim3(grid_blocks), dim3(512), MEGA_LDS_BYTES, stream, p);
}
```
